# Optimizing an MI355X kernel written in HIP

```python
import jax, jax.numpy as jnp
from jax import lax
import numpy as np

D_MODEL = 4096
BATCH = 4
SEQ = 4096
DEPTH = 1

D_A = D_MODEL // 2
HA_DK = 128
H_A = D_A // HA_DK
HA_DV = D_A // H_A
D_B = D_MODEL // 2
H_B = 8
DV_B = D_B // H_B
DK_B = DV_B // 2
D_QK_B = H_B * DK_B
CONV_W = 4
CHUNK = 64
EPS = 1e-6

COLS = (D_A, D_A, D_A, D_A, D_A,
        D_QK_B, D_QK_B, D_B, D_B, D_B, H_B, H_B,
        D_MODEL, D_MODEL)
D_IN = sum(COLS)
SPLIT_IDX = tuple(int(v) for v in np.cumsum(COLS)[:-1])

kernel_name = "hgrn2_mlstm_gated_parallel_hybrid"


def rmsnorm(x, g):
    xf = x.astype(jnp.float32)
    r = lax.rsqrt(jnp.mean(xf * xf, axis=-1, keepdims=True) + EPS)
    return (xf * r).astype(x.dtype) * g


def head_rmsnorm(o, g, n_heads):
    B, S, W = o.shape
    of = o.astype(jnp.float32).reshape(B, S, n_heads, W // n_heads)
    of = of * lax.rsqrt(jnp.mean(of * of, axis=-1, keepdims=True) + EPS)
    return of.reshape(B, S, W).astype(o.dtype) * g


def to_chunks(a, n_heads, d):
    B, S, _ = a.shape
    return a.reshape(B, S // CHUNK, CHUNK, n_heads, d).transpose(0, 3, 1, 2, 4)


def from_chunks(a):
    B, H, N, C, d = a.shape
    return a.transpose(0, 2, 3, 1, 4).reshape(B, N * C, H * d)


def causal_conv(u, w, b):
    S = u.shape[1]
    up = jnp.pad(u, ((0, 0), (CONV_W - 1, 0), (0, 0)))
    y = b
    for k in range(CONV_W):
        y = y + w[k] * up[:, k:k + S]
    return y


MASK = np.tril(np.ones((CHUNK, CHUNK), dtype=bool))


def hgrn2_mixer(q, f_pre, i, lb):
    dt = q.dtype
    q, f_pre, i, lb = (a.astype(jnp.float32) for a in (q, f_pre, i, lb))
    f = lb + (1.0 - lb) * jax.nn.sigmoid(f_pre)
    logf = jnp.log(f)
    k = 1.0 - f
    qc, kc, vc, lfc = (to_chunks(a, H_A, HA_DK if a is not i else HA_DV) for a in (q, k, i, logf))
    b = jnp.cumsum(lfc, axis=-2)
    b_mid = b[..., CHUNK // 2 - 1:CHUNK // 2, :]
    q_rel = qc * jnp.exp(b - b_mid)
    k_rel = kc * jnp.exp(b_mid - b)
    scores = jnp.einsum('bhncd,bhnsd->bhncs', q_rel, k_rel)
    scores = jnp.where(MASK, scores, 0.0)
    o_intra = jnp.einsum('bhncs,bhnsv->bhncv', scores, vc)
    g = b[..., -1, :]
    q_in = qc * jnp.exp(b)
    k_out = kc * jnp.exp(g[..., None, :] - b)
    U = jnp.einsum('bhncd,bhncv->bhndv', k_out, vc)

    def step(S, inp):
        q_in_j, g_j, U_j = inp
        o = jnp.einsum('bhcd,bhdv->bhcv', q_in_j, S)
        S = jnp.exp(g_j)[..., None] * S + U_j
        return S, o

    B = q.shape[0]
    S0 = jnp.zeros((B, H_A, HA_DK, HA_DV), jnp.float32)
    xs = (jnp.moveaxis(q_in, 2, 0), jnp.moveaxis(g, 2, 0), jnp.moveaxis(U, 2, 0))
    _, o_inter = lax.scan(step, S0, xs)
    o = o_intra + jnp.moveaxis(o_inter, 0, 2)
    return from_chunks(o).astype(dt)


def mlstm_mixer(q, k, v, i_pre, f_pre):
    dt = v.dtype
    q, k, v, i_pre, f_pre = (a.astype(jnp.float32) for a in (q, k, v, i_pre, f_pre))
    B, S, _ = v.shape
    N = S // CHUNK
    qc = to_chunks(q, H_B, DK_B)
    kc = to_chunks(k, H_B, DK_B) * (DK_B ** -0.5)
    vc = to_chunks(v, H_B, DV_B)
    logf = jax.nn.log_sigmoid(f_pre).reshape(B, N, CHUNK, H_B).transpose(0, 3, 1, 2)
    ig = i_pre.reshape(B, N, CHUNK, H_B).transpose(0, 3, 1, 2)
    b = jnp.cumsum(logf, axis=-1)

    def step(carry, inp):
        Cs, ns, m = carry
        q_j, k_j, v_j, b_j, ig_j = inp
        g_j = b_j[..., -1]
        logD = b_j[..., :, None] - b_j[..., None, :] + ig_j[..., None, :]
        logD = jnp.where(MASK, logD, -jnp.inf)
        m_t = jnp.maximum(b_j + m[..., None], jnp.max(logD, axis=-1))
        inter = jnp.exp(b_j + m[..., None] - m_t)
        Dw = jnp.exp(logD - m_t[..., None]) * jnp.einsum('bhcd,bhsd->bhcs', q_j, k_j)
        num = inter[..., None] * jnp.einsum('bhcd,bhdv->bhcv', q_j, Cs) \
            + jnp.einsum('bhcs,bhsv->bhcv', Dw, v_j)
        den = inter * jnp.einsum('bhcd,bhd->bhc', q_j, ns) + jnp.sum(Dw, axis=-1)
        h = num / jnp.maximum(jnp.abs(den), jnp.exp(-m_t))[..., None]
        log_w = g_j[..., None] - b_j + ig_j
        m_new = jnp.maximum(g_j + m, jnp.max(log_w, axis=-1))
        decay = jnp.exp(g_j + m - m_new)
        w = jnp.exp(log_w - m_new[..., None])
        Cs = decay[..., None, None] * Cs + jnp.einsum('bhc,bhcd,bhcv->bhdv', w, k_j, v_j)
        ns = decay[..., None] * ns + jnp.einsum('bhc,bhcd->bhd', w, k_j)
        return (Cs, ns, m_new), h

    carry0 = (jnp.zeros((B, H_B, DK_B, DV_B), jnp.float32),
              jnp.zeros((B, H_B, DK_B), jnp.float32),
              jnp.zeros((B, H_B), jnp.float32))
    xs = tuple(jnp.moveaxis(a, 2, 0) for a in (qc, kc, vc, b, ig))
    _, h = lax.scan(step, carry0, xs)
    return from_chunks(jnp.moveaxis(h, 0, 2)).astype(dt)


def setup_inputs(seed: int = 0) -> dict:
    key = jax.random.key(seed)
    ks = jax.random.split(key, 16)
    f32 = jnp.float32
    nrm = lambda k, shape, s: jax.random.normal(k, shape, f32) * s
    x = nrm(ks[0], (BATCH, SEQ, D_MODEL), 1.0)
    g_pre = 1.0 + nrm(ks[1], (DEPTH, D_MODEL), 0.02)
    w_in = nrm(ks[2], (DEPTH, D_MODEL, D_IN), D_MODEL ** -0.5)
    lb_logits = nrm(ks[3], (DEPTH + 1, D_A), 0.5)
    conv_w = nrm(ks[4], (DEPTH, CONV_W, 2 * D_QK_B), CONV_W ** -0.5)
    conv_b = nrm(ks[5], (DEPTH, 2 * D_QK_B), 0.02)
    b_ig = nrm(ks[6], (DEPTH, H_B), 0.1)
    b_fg = jnp.linspace(3.0, 6.0, H_B, dtype=f32)[None, :] + nrm(ks[7], (DEPTH, H_B), 0.1)
    g_norm_a = 1.0 + nrm(ks[8], (DEPTH, D_A), 0.02)
    g_norm_b = 1.0 + nrm(ks[9], (DEPTH, D_B), 0.02)
    w_up_a = nrm(ks[10], (DEPTH, D_A, D_MODEL), D_A ** -0.5)
    w_up_b = nrm(ks[11], (DEPTH, D_B, D_MODEL), D_B ** -0.5)
    w_out = nrm(ks[12], (DEPTH, D_MODEL, D_MODEL), D_MODEL ** -0.5)
    g_post = 1.0 + nrm(ks[13], (DEPTH, D_MODEL), 0.02)
    return {"x": x, "g_pre": g_pre, "w_in": w_in, "lb_logits": lb_logits,
            "conv_w": conv_w, "conv_b": conv_b, "b_ig": b_ig, "b_fg": b_fg,
            "g_norm_a": g_norm_a, "g_norm_b": g_norm_b, "w_up_a": w_up_a,
            "w_up_b": w_up_b, "w_out": w_out, "g_post": g_post}


def reference(x, g_pre, w_in, lb_logits, conv_w, conv_b, b_ig, b_fg,
              g_norm_a, g_norm_b, w_up_a, w_up_b, w_out, g_post):
    lb_all = jnp.cumsum(jax.nn.softmax(lb_logits.astype(jnp.float32), axis=0), axis=0)
    for l in range(DEPTH):
        h = rmsnorm(x, g_pre[l])
        p = jnp.einsum('bsd,de->bse', h, w_in[l])
        (qa, fa, ia, oga, za, qb, kb, vb, ogb, zb, igb, fgb, gate_a, gate_b) = \
            jnp.split(p, SPLIT_IDX, axis=-1)
        oa = hgrn2_mixer(qa, fa, ia, lb_all[l].astype(x.dtype))
        oa = head_rmsnorm(oa, g_norm_a[l], H_A) * jax.nn.sigmoid(oga) * jax.nn.silu(za)
        qk = jax.nn.silu(causal_conv(jnp.concatenate([qb, kb], axis=-1), conv_w[l], conv_b[l]))
        qb_c, kb_c = qk[..., :D_QK_B], qk[..., D_QK_B:]
        ob = mlstm_mixer(qb_c, kb_c, vb, igb + b_ig[l], fgb + b_fg[l])
        ob = head_rmsnorm(ob, g_norm_b[l], H_B) * jax.nn.sigmoid(ogb) * jax.nn.silu(zb)
        ya = jnp.einsum('bse,ed->bsd', oa, w_up_a[l])
        yb = jnp.einsum('bse,ed->bsd', ob, w_up_b[l])
        y = jax.nn.sigmoid(gate_a) * ya + jax.nn.sigmoid(gate_b) * yb
        out = jnp.einsum('bsd,de->bse', y, w_out[l])
        x = x + rmsnorm(out, g_post[l])
    return x
```

```cpp
#ifndef EMU
#include <hip/hip_runtime.h>
#include <cstdio>
#include <cstdint>
#define LAS __attribute__((address_space(3)))
#define GAS __attribute__((address_space(1)))
typedef short bf16x8 __attribute__((ext_vector_type(8)));
typedef short bf16x4 __attribute__((ext_vector_type(4)));
typedef float f32x4 __attribute__((ext_vector_type(4)));
#define DEV __device__ __forceinline__
#define LDS_RD(T, p) (*(const LAS T*)(p))
#define LDS_WR(T, p, v) (*(LAS T*)(p) = (v))
#define WAVE_SYNC() asm volatile("s_waitcnt lgkmcnt(0)" ::: "memory")
#define BLOCK_BAR() __syncthreads()
#define RAW_BAR() __builtin_amdgcn_s_barrier()
#define WAIT_V(n) asm volatile("s_waitcnt vmcnt(" #n ")" ::: "memory")
#define WAIT_L(n) asm volatile("s_waitcnt lgkmcnt(" #n ")" ::: "memory")
#define SCHED_BAR() __builtin_amdgcn_sched_barrier(0)
#define SETPRIO(n) __builtin_amdgcn_s_setprio(n)
#define GLDS16(g, l) __builtin_amdgcn_global_load_lds((const unsigned*)(g), (LAS unsigned*)(l), 16, 0, 0)
#define MFMA16(a, b, c) __builtin_amdgcn_mfma_f32_16x16x32_bf16(a, b, c, 0, 0, 0)
#define RFL(x) __builtin_amdgcn_readfirstlane(x)
#define COMPILER_FENCE() asm volatile("" ::: "memory")
#define OPAQUE(x) asm volatile("" : "+v"(x))
DEV float fexp2(float x) { return __builtin_amdgcn_exp2f(x); }
DEV float flog2(float x) { return __builtin_amdgcn_logf(x); }
DEV float frcp(float x) { return __builtin_amdgcn_rcpf(x); }
DEV float frsq(float x) { return __builtin_amdgcn_rsqf(x); }
DEV unsigned cvt_pk_bf16(float lo, float hi) { unsigned r; asm volatile("v_cvt_pk_bf16_f32 %0, %1, %2" : "=v"(r) : "v"(lo), "v"(hi)); return r; }
typedef __amdgpu_buffer_rsrc_t rsrc_t;
DEV rsrc_t make_rsrc(const void* p, unsigned bytes) { return __builtin_amdgcn_make_buffer_rsrc((void*)p, (short)0, (int)bytes, 0x00020000); }
DEV unsigned short bload16(rsrc_t r, unsigned voff, unsigned soff) { return (unsigned short)__builtin_amdgcn_raw_buffer_load_b16(r, (int)voff, (int)soff, 0); }
DEV void bstore16(rsrc_t r, unsigned voff, unsigned soff, unsigned short v) { __builtin_amdgcn_raw_buffer_store_b16(v, r, (int)voff, (int)soff, 0); }
#else
#define LAS
#define GAS
#define DEV inline
#define LDS_RD(T, p) emu_lds_rd<T>((const void*)(p), #p)
#define LDS_WR(T, p, v) emu_lds_wr<T>((void*)(p), (T)(v), #p)
#define WAVE_SYNC() emu_wavesync()
#define BLOCK_BAR() emu_syncthreads()
#define RAW_BAR() emu_syncthreads()
#define WAIT_V(n)
#define WAIT_L(n)
#define SCHED_BAR()
#define SETPRIO(n)
#define GLDS16(g, l) memcpy((unsigned char*)(l) + 16 * (emu_cur & 63), (const void*)(g), 16)
#define MFMA16(a, b, c) emu_mfma16(a, b, c)
#define RFL(x) (x)
#define COMPILER_FENCE()
#define OPAQUE(x)
DEV float fexp2(float x) { return exp2f(x); }
DEV float flog2(float x) { return log2f(x); }
DEV float frcp(float x) { return 1.0f / x; }
DEV float frsq(float x) { return 1.0f / sqrtf(x); }
DEV unsigned cvt_pk_bf16(float lo, float hi) { return (unsigned)emu_f2bf(lo) | ((unsigned)emu_f2bf(hi) << 16); }
typedef unsigned char* rsrc_t;
DEV rsrc_t make_rsrc(const void* p, unsigned) { return (unsigned char*)p; }
DEV unsigned short bload16(rsrc_t r, unsigned voff, unsigned soff) { unsigned short v; memcpy(&v, r + (size_t)voff + soff, 2); return v; }
DEV void bstore16(rsrc_t r, unsigned voff, unsigned soff, unsigned short v) { memcpy(r + (size_t)voff + soff, &v, 2); }
#endif

typedef unsigned short bf16;
typedef unsigned u32x4 __attribute__((ext_vector_type(4)));
typedef unsigned u32x2 __attribute__((ext_vector_type(2)));
typedef float f32x2 __attribute__((ext_vector_type(2)));
typedef LAS unsigned char* ldsp;

#ifndef CFG_D
#define CFG_D 4096
#define CFG_B 4
#define CFG_S 4096
#define CFG_HB 8
#endif
constexpr int D = CFG_D, NB = CFG_B, SEQ = CFG_S, M = NB * SEQ;
constexpr int DA = D / 2, HA = DA / 128, DB = D / 2, HB = CFG_HB, DVB = DB / HB, DKB = 128, DQK = HB * DKB;
constexpr int NSG = 2 * HB;
constexpr int NCH = SEQ / 64;
static_assert(DVB == 256 && NSG <= 16 && SEQ % 64 == 0 && M % 256 == 0 && D % 256 == 0, "shape");
constexpr int C_QA = 0, C_FA = DA, C_IA = 2 * DA, C_OGA = 3 * DA, C_ZA = 4 * DA, C_QB = 5 * DA, C_KB = C_QB + DQK, C_VB = C_KB + DQK, C_OGB = C_VB + DB, C_ZB = C_OGB + DB;
constexpr int NPM = C_ZB + DB, C_GA = NPM, C_GB = NPM + D, NP = NPM + 2 * D, D_IN = NP + NSG;
static_assert(NPM % 256 == 0 && NP % 256 == 0, "column map");
constexpr float EPS = 1e-6f;
constexpr float LOG2E = 1.4426950408889634f, LN2 = 0.6931471805599453f;
constexpr int NRS = D / 64;

constexpr size_t al256(size_t x) { return (x + 255) & ~(size_t)255; }
constexpr size_t WS_CTL = 0, CTL_ZERO_BYTES = 65536;
constexpr size_t WS_W1T = 1u << 20;
constexpr size_t WS_WUT = al256(WS_W1T + (size_t)(NP + 16) * D * 2);
constexpr size_t WS_WOT = al256(WS_WUT + (size_t)2 * D * DA * 2);
constexpr size_t WS_HB = al256(WS_WOT + (size_t)D * D * 2);
constexpr size_t WS_P = al256(WS_HB + (size_t)M * D * 2);
constexpr size_t WS_SG = al256(WS_P + (size_t)M * NP * 2);
constexpr size_t WS_OAB = al256(WS_SG + (size_t)M * 16 * 4);
constexpr size_t WS_RSS = al256(WS_OAB + (size_t)2 * M * DA * 2);
constexpr size_t WS_SSB = al256(WS_RSS + (size_t)M * NRS * 4);
constexpr size_t WS_END = al256(WS_SSB + (size_t)M * HB * 2 * 4);
constexpr int CW_BAR = 1024;

constexpr int RING_BYTES = 131072, LDSCTL_OFF = RING_BYTES, MISC_OFF = LDSCTL_OFF + 320, LDS_BYTES = 147456;
constexpr int NWAVES = 8, NTHREADS = 512;

DEV unsigned f2bf(float f) { unsigned u = __builtin_bit_cast(unsigned, f); return (u + 0x7fffu + ((u >> 16) & 1u)) >> 16; }
DEV float bf2f(unsigned b) { return __builtin_bit_cast(float, b << 16); }
DEV unsigned pk2(float lo, float hi) { return f2bf(lo) | (f2bf(hi) << 16); }
DEV float fexp(float x) { return fexp2(x * LOG2E); }
DEV float flog(float x) { return flog2(x) * LN2; }
DEV float sigm(float x) { return frcp(1.0f + fexp(-x)); }
DEV float logsig(float x) { return fminf(x, 0.f) - flog(1.0f + fexp(-fabsf(x))); }
DEV float wave_sum(float v) {
#pragma unroll
    for (int o = 1; o < 64; o <<= 1) v += __shfl_xor(v, o);
    return v;
}

namespace pg8 {
constexpr int BM = 256, BK = 64, HALF = 128, HTB = HALF * BK * 2, STAGE_BYTES = 8 * HTB, NXCD = 8, WGM = 8;
DEV int lds_byte(int r, int c) { const int st = (r >> 4) * 2 + (c >> 5), rr = r & 15, cc = c & 31, ob = rr * 64 + cc * 2; return st * 1024 + (ob ^ (((ob >> 9) & 1) << 5)); }
DEV void stage_rc(int b, int& R, int& C) { const int st = b / 1024, sb = b % 1024, swz = sb ^ (((sb >> 9) & 1) << 5); R = (st >> 1) * 16 + swz / 64; C = (st & 1) * 32 + (swz % 64) / 2; }
DEV int perm32(int rho) { const int n = rho >> 4, i = rho & 15; return 8 * (i >> 2) + 4 * n + (i & 3); }
struct Unit { int pm, pn; };
struct Gemm { const bf16* A; const bf16* Bt; int M, N, K; };
struct StaticOrder {
    int nM, nN, nwg, G, c;
    DEV void init(int M_, int N_, int G_, int c_) { nM = M_ / BM; nN = N_ / BM; nwg = nM * nN; G = G_; c = c_; }
    DEV bool next(int i, Unit& u) const {
        const long L = (long)i * G + c; if (L >= nwg) return false;
        int wgid = (int)L; { const int q = nwg / NXCD, r = nwg % NXCD, xcd = wgid % NXCD, off = wgid / NXCD; wgid = (xcd < r ? xcd * (q + 1) : r * (q + 1) + (xcd - r) * q) + off; }
        const int nig = WGM * nN, gid = wgid / nig, fm = gid * WGM, gsz = (nM - fm) < WGM ? (nM - fm) : WGM;
        u.pm = fm + ((wgid % nig) % gsz); u.pn = (wgid % nig) / gsz; return true;
    }
};
template <class Epi, class Sched>
DEV void gemm_phase(ldsp lds, const Gemm g, const Sched& S, const Epi& E) {
    const int tid = threadIdx.x, wid = RFL(tid >> 6), lane = tid & 63, wr = wid >> 2, wc = wid & 3, fr = lane & 15, fq = lane >> 4;
    const int K = g.K, nt = K / BK;
    unsigned voffA[2], voffB[2];
#pragma unroll
    for (int i = 0; i < 2; ++i) { int R, C; stage_rc(tid * 16 + i * 8192, R, C); const int Rb = Epi::PERM ? ((R & ~31) + perm32(R & 31)) : R;
        voffA[i] = (unsigned)(R * K + C) * 2u; voffB[i] = (unsigned)(Rb * K + C) * 2u; }
    const size_t kstep = (size_t)(BK * 2);
    const size_t hstep = (size_t)HALF * K * 2;
    const size_t tstep = 2 * hstep;
    const unsigned ldsw = (unsigned)wid * 1024u;
    const int aoff = lds_byte(wr * 64 + fr, fq * 8), boff = lds_byte(wc * 32 + fr, fq * 8);
#define PG8_SA(b, h) (((b) * 2 + (h)) * HTB)
#define PG8_SB(b, h) ((4 + (b) * 2 + (h)) * HTB)
#define PG8_STAGE(bufoff, gbase, voff) do { _Pragma("unroll") for (int _i = 0; _i < 2; ++_i) \
        GLDS16((const char*)(gbase) + (voff)[_i], lds + (bufoff) + ldsw + _i * 8192); } while (0)
#define PG8_LDA(dst, b, h) do { _Pragma("unroll") for (int m = 0; m < 4; ++m) _Pragma("unroll") for (int k = 0; k < 2; ++k) dst[m][k] = *(const LAS bf16x8*)(lds + PG8_SA(b, h) + aoff + m * 2048 + k * 1024); } while (0)
#define PG8_LDB(dst, b, h) do { _Pragma("unroll") for (int n = 0; n < 2; ++n) _Pragma("unroll") for (int k = 0; k < 2; ++k) dst[n][k] = *(const LAS bf16x8*)(lds + PG8_SB(b, h) + boff + n * 2048 + k * 1024); } while (0)
#define PG8_MMA(ai, bj, At, Bt) do { SETPRIO(1); _Pragma("unroll") for (int m = 0; m < 4; ++m) _Pragma("unroll") for (int n = 0; n < 2; ++n) _Pragma("unroll") for (int k = 0; k < 2; ++k) \
        acc[ai][bj][m][n] = MFMA16(Bt[n][k], At[m][k], acc[ai][bj][m][n]); SETPRIO(0); } while (0)
    Unit cur, nxt; int ui = 0;
    if (!S.next(0, cur)) return;
    f32x4 acc[2][2][4][2];
#pragma unroll
    for (int a = 0; a < 2; ++a)
#pragma unroll
        for (int b = 0; b < 2; ++b)
#pragma unroll
            for (int m = 0; m < 4; ++m)
#pragma unroll
                for (int n = 0; n < 2; ++n) acc[a][b][m][n] = (f32x4){0.f, 0.f, 0.f, 0.f};
    bf16x8 At[4][2], B0[2][2], B1[2][2];
    const char* cA = (const char*)g.A + (size_t)cur.pm * tstep; const char* cB = (const char*)g.Bt + (size_t)cur.pn * tstep;
    PG8_STAGE(PG8_SB(0, 0), cB, voffB); PG8_STAGE(PG8_SA(0, 0), cA, voffA); PG8_STAGE(PG8_SB(0, 1), cB + hstep, voffB); PG8_STAGE(PG8_SA(0, 1), cA + hstep, voffA);
    if (wr == 1) RAW_BAR();
    WAIT_V(4); RAW_BAR();
    PG8_STAGE(PG8_SB(1, 0), cB + kstep, voffB); PG8_STAGE(PG8_SA(1, 0), cA + kstep, voffA); PG8_STAGE(PG8_SB(1, 1), cB + hstep + kstep, voffB);
    WAIT_V(6); RAW_BAR();
    for (;;) {
        const bool has_next = S.next(ui + 1, nxt);
        const char* nA = has_next ? (const char*)g.A + (size_t)nxt.pm * tstep : cA; const char* nB = has_next ? (const char*)g.Bt + (size_t)nxt.pn * tstep : cB;
        for (int t = 0; t < nt; t += 2) {
            const bool last = (t == nt - 2);
            const char* a1 = cA + (size_t)(t + 1) * kstep;
            const char* a2 = last ? nA : cA + (size_t)(t + 2) * kstep; const char* b2 = last ? nB : cB + (size_t)(t + 2) * kstep;
            const char* a3 = a2 + kstep; const char* b3 = b2 + kstep;
            PG8_LDB(B0, 0, 0); SCHED_BAR(); PG8_LDA(At, 0, 0); PG8_STAGE(PG8_SA(1, 1), a1 + hstep, voffA);
            WAIT_L(8); RAW_BAR(); WAIT_L(0); PG8_MMA(0, 0, At, B0); RAW_BAR(); SCHED_BAR();
            PG8_LDB(B1, 0, 1); PG8_STAGE(PG8_SB(0, 0), b2, voffB);
            RAW_BAR(); WAIT_L(0); PG8_MMA(0, 1, At, B1); RAW_BAR();
            PG8_LDA(At, 0, 1); PG8_STAGE(PG8_SA(0, 0), a2, voffA);
            RAW_BAR(); WAIT_L(0); PG8_MMA(1, 0, At, B0); RAW_BAR(); SCHED_BAR();
            PG8_STAGE(PG8_SB(0, 1), b2 + hstep, voffB);
            WAIT_V(6); RAW_BAR(); PG8_MMA(1, 1, At, B1); RAW_BAR();
            PG8_LDB(B0, 1, 0); SCHED_BAR(); PG8_LDA(At, 1, 0); PG8_STAGE(PG8_SA(0, 1), a2 + hstep, voffA);
            WAIT_L(8); RAW_BAR(); WAIT_L(0); PG8_MMA(0, 0, At, B0); RAW_BAR(); SCHED_BAR();
            PG8_LDB(B1, 1, 1); PG8_STAGE(PG8_SB(1, 0), b3, voffB);
            RAW_BAR(); WAIT_L(0); PG8_MMA(0, 1, At, B1); RAW_BAR();
            PG8_LDA(At, 1, 1); PG8_STAGE(PG8_SA(1, 0), a3, voffA);
            RAW_BAR(); WAIT_L(0); PG8_MMA(1, 0, At, B0); RAW_BAR(); SCHED_BAR();
            PG8_STAGE(PG8_SB(1, 1), b3 + hstep, voffB);
            WAIT_V(6); RAW_BAR(); PG8_MMA(1, 1, At, B1); RAW_BAR();
        }
        E(acc, cur, wr, wc, fr, fq);
        if (!has_next) break;
#pragma unroll
        for (int a = 0; a < 2; ++a)
#pragma unroll
            for (int b = 0; b < 2; ++b)
#pragma unroll
                for (int m = 0; m < 4; ++m)
#pragma unroll
                    for (int n = 0; n < 2; ++n) acc[a][b][m][n] = (f32x4){0.f, 0.f, 0.f, 0.f};
        cur = nxt; cA = nA; cB = nB; ++ui;
    }
    WAIT_V(0);
    if (wr == 0) RAW_BAR();
    RAW_BAR();
#undef PG8_SA
#undef PG8_SB
#undef PG8_STAGE
#undef PG8_LDA
#undef PG8_LDB
#undef PG8_MMA
}
}

struct EpiP {
    static constexpr bool PERM = true;
    bf16* O;
    DEV void operator()(const f32x4 (&acc)[2][2][4][2], const pg8::Unit& u, int wr, int wc, int fr, int fq) const {
        const int row0 = u.pm * 256 + wr * 64 + fr, col0 = u.pn * 256 + wc * 32 + 8 * fq;
#pragma unroll
        for (int ai = 0; ai < 2; ++ai)
#pragma unroll
            for (int m = 0; m < 4; ++m) { bf16* rowp = O + (size_t)(row0 + ai * 128 + m * 16) * NP + col0;
#pragma unroll
                for (int bj = 0; bj < 2; ++bj) { const f32x4 v0 = acc[ai][bj][m][0], v1 = acc[ai][bj][m][1];
                    u32x4 w; w.x = cvt_pk_bf16(v0[0], v0[1]); w.y = cvt_pk_bf16(v0[2], v0[3]); w.z = cvt_pk_bf16(v1[0], v1[1]); w.w = cvt_pk_bf16(v1[2], v1[3]);
                    *(u32x4*)(rowp + bj * 128) = w; } }
    }
};
struct SchedUp {
    pg8::StaticOrder so;
    DEV bool next(int i, pg8::Unit& u) const { if (!so.next(i >> 1, u)) return false; if (i & 1) { u.pm += M / 256; u.pn += D / 256; } return true; }
};
struct EpiUp {
    static constexpr bool PERM = true;
    bf16* Y; const bf16* P;
    DEV void operator()(const f32x4 (&acc)[2][2][4][2], const pg8::Unit& u, int wr, int wc, int fr, int fq) const {
        const int br = u.pm >= M / 256 ? 1 : 0, pm = u.pm - br * (M / 256), pn = u.pn - br * (D / 256);
        const int row0 = pm * 256 + wr * 64 + fr, col0 = pn * 256 + wc * 32 + 8 * fq, gcol = (br ? C_GB : C_GA) + col0;
#pragma unroll
        for (int ai = 0; ai < 2; ++ai)
#pragma unroll
            for (int m = 0; m < 4; ++m) { const size_t row = (size_t)(row0 + ai * 128 + m * 16);
#pragma unroll
                for (int bj = 0; bj < 2; ++bj) {
                    const u32x4 g8 = *(const u32x4*)(P + row * NP + gcol + bj * 128);
                    bf16* yp = Y + row * D + col0 + bj * 128;
                    u32x4 y8 = (u32x4){0u, 0u, 0u, 0u}; if (br) y8 = *(const u32x4*)yp;
                    const f32x4 v0 = acc[ai][bj][m][0], v1 = acc[ai][bj][m][1];
                    float o[8];
#pragma unroll
                    for (int k = 0; k < 8; ++k) { const unsigned gw = g8[k >> 1], yw = y8[k >> 1]; const float gv = bf2f((k & 1) ? (gw >> 16) : (gw & 0xffffu)), yv = bf2f((k & 1) ? (yw >> 16) : (yw & 0xffffu));
                        const float a = k < 4 ? v0[k & 3] : v1[k & 3]; o[k] = yv + sigm(gv) * a; }
                    u32x4 w; w.x = cvt_pk_bf16(o[0], o[1]); w.y = cvt_pk_bf16(o[2], o[3]); w.z = cvt_pk_bf16(o[4], o[5]); w.w = cvt_pk_bf16(o[6], o[7]);
                    *(u32x4*)yp = w; } }
    }
};
struct EpiOut {
    static constexpr bool PERM = false;
    float* C; float* RSS;
    DEV void operator()(const f32x4 (&acc)[2][2][4][2], const pg8::Unit& u, int wr, int wc, int fr, int fq) const {
        const int row0 = u.pm * 256 + wr * 64 + fr, col0 = u.pn * 256 + wc * 32 + 4 * fq;
#pragma unroll
        for (int ai = 0; ai < 2; ++ai)
#pragma unroll
            for (int m = 0; m < 4; ++m) { const size_t row = (size_t)(row0 + ai * 128 + m * 16); float* rowp = C + row * D + col0; float ss = 0.f;
#pragma unroll
                for (int bj = 0; bj < 2; ++bj)
#pragma unroll
                    for (int n = 0; n < 2; ++n) { const f32x4 v = acc[ai][bj][m][n]; *(f32x4*)(rowp + bj * 128 + n * 16) = v; ss += (v[0] * v[0] + v[1] * v[1]) + (v[2] * v[2] + v[3] * v[3]); }
                ss += __shfl_xor(ss, 16); ss += __shfl_xor(ss, 32);
                if (fq == 0) RSS[row * NRS + u.pn * 4 + wc] = ss; }
    }
};

#ifndef EMU
typedef GAS unsigned gu32;
#define RLX_AGENT __ATOMIC_RELAXED, __HIP_MEMORY_SCOPE_AGENT
#define XB_TMO      128
#define XB_XCNT(j)  (256  + 64 * (j))
#define XB_XSUB(j)  (1280 + 64 * (j))
#define XB_XGEN(j)  (2304 + 64 * (j))
#define XB_TOP      3328
#define XB_TOPGEN   3392
#define XCD_BAR_WORDS 3456
#define XB_SPIN_CAP (1u << 22)
__device__ __forceinline__ unsigned xb_ld(unsigned* p)              { return __hip_atomic_load(p, __ATOMIC_RELAXED, __HIP_MEMORY_SCOPE_AGENT); }
__device__ __forceinline__ unsigned xb_add(unsigned* p, unsigned v) { return __hip_atomic_fetch_add(p, v, __ATOMIC_RELAXED, __HIP_MEMORY_SCOPE_AGENT); }
__device__ __forceinline__ unsigned xb_xcc_id() { return (unsigned)__builtin_amdgcn_s_getreg((3 << 11) | 20) & 0xFu; }
#define XB_SPIN(cond, bar) do { unsigned _sp = 0; while (cond) { __builtin_amdgcn_s_sleep(1); \
    if ((++_sp & 255u) == 0u) { if (xb_ld(&(bar)[XB_TMO])) break; if (_sp > XB_SPIN_CAP) { atomicAdd(&(bar)[XB_TMO], 1u); break; } } } } while (0)
struct XcdBarrier { unsigned* bar; unsigned x; volatile LAS unsigned* st; };
__device__ __forceinline__ XcdBarrier xcd_barrier_post(unsigned* bar, volatile LAS unsigned* st) {
    XcdBarrier b; b.bar = bar; b.x = xb_xcc_id(); b.st = st;
    if (threadIdx.x == 0) (void)xb_add(&bar[XB_XCNT(b.x)], 1u);
    return b;
}
__device__ __forceinline__ void xcd_barrier_complete(unsigned* bar, unsigned x, unsigned& nloc, unsigned& nx) {
    const unsigned G = gridDim.x * gridDim.y * gridDim.z;
    unsigned sum, cnt, mine, sp = 0u;
    for (;;) {
        sum = 0u; cnt = 0u; mine = 0u;
#pragma unroll
        for (unsigned j = 0; j < 16; ++j) { const unsigned c = xb_ld(&bar[XB_XCNT(j)]); sum += c; cnt += (c > 0u) ? 1u : 0u; mine = (j == x) ? c : mine; }
        if (sum == G) break;
        __builtin_amdgcn_s_sleep(1);
        if ((++sp & 255u) == 0u) { if (xb_ld(&bar[XB_TMO])) break; if (sp > XB_SPIN_CAP) { atomicAdd(&bar[XB_TMO], 1u); break; } }
    }
    nloc = mine > 0u ? mine : 1u; nx = cnt > 0u ? cnt : 1u;
}
__device__ __forceinline__ void xcd_barrier(const XcdBarrier& b) {
    asm volatile("s_waitcnt vmcnt(0)" ::: "memory");
    __syncthreads();
    if (threadIdx.x == 0) {
        unsigned* bar = b.bar;
        __builtin_amdgcn_s_waitcnt(0);
        unsigned nloc = b.st[0], nx = b.st[1];
        if (nloc == 0u) { xcd_barrier_complete(bar, b.x, nloc, nx); b.st[0] = nloc; b.st[1] = nx; }
        const unsigned old = xb_add(&bar[XB_XSUB(b.x)], 1u);
        const unsigned gen = old / nloc;
        if (old + 1u == (gen + 1u) * nloc) {
            __builtin_amdgcn_fence(__ATOMIC_RELEASE, "agent");
            asm volatile("s_waitcnt vmcnt(0)" ::: "memory");
            const unsigned og = xb_add(&bar[XB_TOP], 1u);
            const unsigned tg = og / nx;
            if (og + 1u == (tg + 1u) * nx) xb_add(&bar[XB_TOPGEN], 1u);
            else XB_SPIN(xb_ld(&bar[XB_TOPGEN]) == tg, bar);
            __builtin_amdgcn_fence(__ATOMIC_ACQUIRE, "agent");
            xb_add(&bar[XB_XGEN(b.x)], 1u);
            asm volatile("s_waitcnt vmcnt(0)" ::: "memory");
        } else {
            XB_SPIN(xb_ld(&bar[XB_XGEN(b.x)]) == gen, bar);
            __builtin_amdgcn_fence(__ATOMIC_ACQUIRE, "agent");
            asm volatile("s_waitcnt vmcnt(0)" ::: "memory");
        }
    }
    __syncthreads();
}
#endif

struct Args { const float* in[14]; float* out; unsigned char* ws; int ph_lo, ph_hi; };

DEV void p0_transpose_item(const float* W, int ldw, int K, bf16* WT, int k0, int c0, int r0, int nvalid, ldsp scr, int lane) {
    const int n_ = lane & 31;
#pragma unroll 8
    for (int i = 0; i < 32; ++i) { const int kk = 2 * i + (lane >> 5); const float v = (n_ < nvalid) ? W[(size_t)(k0 + kk) * ldw + c0 + n_] : 0.f; LDS_WR(float, scr + (kk * 33 + n_) * 4, v); }
    WAVE_SYNC();
    const int c = lane & 7;
#pragma unroll
    for (int j = 0; j < 4; ++j) { const int n = (lane >> 3) + 8 * j; ldsp s = scr + ((8 * c) * 33 + n) * 4;
        u32x4 o; o.x = pk2(LDS_RD(float, s + 0 * 132), LDS_RD(float, s + 1 * 132)); o.y = pk2(LDS_RD(float, s + 2 * 132), LDS_RD(float, s + 3 * 132));
        o.z = pk2(LDS_RD(float, s + 4 * 132), LDS_RD(float, s + 5 * 132)); o.w = pk2(LDS_RD(float, s + 6 * 132), LDS_RD(float, s + 7 * 132));
        if (n < nvalid) *(u32x4*)(WT + (size_t)(r0 + n) * K + k0 + 8 * c) = o; }
    WAVE_SYNC();
}

constexpr int MS = 272, MS64 = 144;
constexpr int MX_QR = 0, MX_KR = MX_QR + 64 * MS, MX_KRT = MX_KR + 64 * MS, MX_IT = MX_KRT + 128 * MS64, MX_PS = MX_IT + 256 * MS64, MX_SM = MX_PS + 64 * MS64;
constexpr int SM_TOT = MX_SM, SM_BME = SM_TOT + 4 * 128 * 4, SM_EG = SM_BME + 512, SM_EGM = SM_EG + 512, SM_SSQ = SM_EGM + 512;
constexpr int SM_A = SM_SSQ + 64 * 8 * 4, SM_MX = SM_A + 256, SM_INT = SM_MX + 256, SM_EMT = SM_INT + 256, SM_WGT = SM_EMT + 256, SM_SCAL = SM_WGT + 256;
constexpr int SM_NV = SM_SCAL + 64, SM_NACC = SM_NV + 512, SM_RSUM = SM_NACC + 4 * 512, SM_QN = SM_RSUM + 64 * 2 * 4, MX_END = SM_QN + 256;
static_assert(MX_END <= RING_BYTES, "mixer LDS");

DEV bf16x8 frag16(ldsp buf, int stride, int row0, int ks, int lane) { return LDS_RD(bf16x8, buf + (row0 + (lane & 15)) * stride + ks * 64 + (lane >> 4) * 16); }
DEV bf16x8 frag8x2(ldsp buf, int stride, int row0, int ks, int lane) {
    ldsp p = buf + (row0 + (lane & 15)) * stride + ks * 64 + (lane >> 4) * 8;
    const bf16x4 lo = LDS_RD(bf16x4, p), hi = LDS_RD(bf16x4, p + 32);
    return (bf16x8){lo[0], lo[1], lo[2], lo[3], hi[0], hi[1], hi[2], hi[3]};
}
DEV bf16x8 pack_state(const f32x4 a, const f32x4 b) {
    u32x4 w; w.x = pk2(a[0], a[1]); w.y = pk2(a[2], a[3]); w.z = pk2(b[0], b[1]); w.w = pk2(b[2], b[3]);
    return __builtin_bit_cast(bf16x8, w);
}

DEV void mixer_a_job(const Args& args, ldsp lds, int b, int h, int tid) {
    const int lane = tid & 63, wave = RFL(tid >> 6), q4 = lane >> 4, l15 = lane & 15;
    const int seg = wave >> 1, d = (wave & 1) * 64 + lane;
    const rsrc_t RP = make_rsrc(args.ws + WS_P, (unsigned)((size_t)M * NP * 2)), RO = make_rsrc(args.ws + WS_OAB, (unsigned)((size_t)2 * M * DA * 2));
    const unsigned vo_d = (unsigned)(h * 128 + d) * 2u, vo_g = (unsigned)((4 * q4) * NP + h * 128 + 16 * wave + l15) * 2u, vo_o = (unsigned)((4 * q4) * DA + h * 128 + 16 * wave + l15) * 2u;
    const float* lbl = args.in[3];
    const float lbv = frcp(1.0f + fexp(lbl[DA + h * 128 + d] - lbl[h * 128 + d]));
    const float gn = args.in[8][h * 128 + 16 * wave + l15];
    f32x4 st[8];
#pragma unroll
    for (int t = 0; t < 8; ++t) st[t] = (f32x4){0.f, 0.f, 0.f, 0.f};
    unsigned short rq[16], rf[16], ri[16];
    for (int j = 0; j < NCH; ++j) {
        int tidj = tid; OPAQUE(tidj);
        const int lane = tidj & 63, q4 = lane >> 4, l15 = lane & 15, d = (wave & 1) * 64 + lane;
        const unsigned vo_d = (unsigned)(h * 128 + d) * 2u, vo_g = (unsigned)((4 * q4) * NP + h * 128 + 16 * wave + l15) * 2u, vo_o = (unsigned)((4 * q4) * DA + h * 128 + 16 * wave + l15) * 2u;
        const unsigned tk0 = (unsigned)(b * SEQ + 64 * j);
#pragma unroll
        for (int c = 0; c < 16; ++c) { const unsigned so = (tk0 + 16 * seg + c) * (unsigned)(NP * 2); rq[c] = bload16(RP, vo_d, so + C_QA * 2); rf[c] = bload16(RP, vo_d, so + C_FA * 2); ri[c] = bload16(RP, vo_d, so + C_IA * 2); }
        float lf[16], qv[16], kv[16]; unsigned short iv[16];
#pragma unroll
        for (int c = 0; c < 16; ++c) { const float f = lbv + (1.0f - lbv) * sigm(bf2f(rf[c])); lf[c] = flog(f); kv[c] = 1.0f - f; qv[c] = bf2f(rq[c]); iv[c] = ri[c]; }
#pragma unroll
        for (int c = 1; c < 16; ++c) lf[c] += lf[c - 1];
        LDS_WR(float, lds + SM_TOT + (seg * 128 + d) * 4, lf[15]);
        BLOCK_BAR();
        {
            const float t0 = LDS_RD(float, lds + SM_TOT + (0 * 128 + d) * 4), t1 = LDS_RD(float, lds + SM_TOT + (1 * 128 + d) * 4), t2 = LDS_RD(float, lds + SM_TOT + (2 * 128 + d) * 4), t3 = LDS_RD(float, lds + SM_TOT + (3 * 128 + d) * 4);
            const float off = seg == 0 ? 0.f : (seg == 1 ? t0 : (seg == 2 ? t0 + t1 : t0 + t1 + t2));
            const float bmid = t0 + t1, g = (t0 + t1) + (t2 + t3);
            unsigned kr[16];
#pragma unroll
            for (int c = 0; c < 16; ++c) { const float bb = lf[c] + off; const float e1 = fexp(bb - bmid), e2 = fexp(bmid - bb);
                LDS_WR(unsigned short, lds + MX_QR + (16 * seg + c) * MS + d * 2, (unsigned short)f2bf(qv[c] * e1));
                kr[c] = f2bf(kv[c] * e2);
                LDS_WR(unsigned short, lds + MX_KR + (16 * seg + c) * MS + d * 2, (unsigned short)kr[c]); }
            u32x4 w0, w1; w0.x = kr[0] | (kr[1] << 16); w0.y = kr[2] | (kr[3] << 16); w0.z = kr[4] | (kr[5] << 16); w0.w = kr[6] | (kr[7] << 16);
            w1.x = kr[8] | (kr[9] << 16); w1.y = kr[10] | (kr[11] << 16); w1.z = kr[12] | (kr[13] << 16); w1.w = kr[14] | (kr[15] << 16);
            LDS_WR(u32x4, lds + MX_KRT + d * MS64 + seg * 32, w0); LDS_WR(u32x4, lds + MX_KRT + d * MS64 + seg * 32 + 16, w1);
            u32x4 i0, i1; i0.x = iv[0] | ((unsigned)iv[1] << 16); i0.y = iv[2] | ((unsigned)iv[3] << 16); i0.z = iv[4] | ((unsigned)iv[5] << 16); i0.w = iv[6] | ((unsigned)iv[7] << 16);
            i1.x = iv[8] | ((unsigned)iv[9] << 16); i1.y = iv[10] | ((unsigned)iv[11] << 16); i1.z = iv[12] | ((unsigned)iv[13] << 16); i1.w = iv[14] | ((unsigned)iv[15] << 16);
            LDS_WR(u32x4, lds + MX_IT + d * MS64 + seg * 32, i0); LDS_WR(u32x4, lds + MX_IT + d * MS64 + seg * 32 + 16, i1);
            if (seg == 0) { LDS_WR(float, lds + SM_BME + d * 4, fexp(bmid)); LDS_WR(float, lds + SM_EG + d * 4, fexp(g)); LDS_WR(float, lds + SM_EGM + d * 4, fexp(g - bmid)); }
        }
        BLOCK_BAR();
        {
            const int ct = wave >> 1, st0 = 2 * (wave & 1);
            f32x4 sc[2] = {(f32x4){0.f, 0.f, 0.f, 0.f}, (f32x4){0.f, 0.f, 0.f, 0.f}};
#pragma unroll
            for (int ks = 0; ks < 4; ++ks) { const bf16x8 a = frag16(lds + MX_QR, MS, 16 * ct, ks, lane);
#pragma unroll
                for (int n = 0; n < 2; ++n) { const bf16x8 bb = frag16(lds + MX_KR, MS, 16 * (st0 + n), ks, lane); sc[n] = MFMA16(a, bb, sc[n]); } }
#pragma unroll
            for (int n = 0; n < 2; ++n)
#pragma unroll
                for (int r = 0; r < 4; ++r) { const int c = 16 * ct + 4 * q4 + r, s = 16 * (st0 + n) + l15; const float v = (s <= c) ? sc[n][r] : 0.f;
                    LDS_WR(unsigned short, lds + MX_PS + c * MS64 + s * 2, (unsigned short)f2bf(v)); }
        }
        BLOCK_BAR();
        f32x4 o[4];
#pragma unroll
        for (int ct = 0; ct < 4; ++ct) o[ct] = (f32x4){0.f, 0.f, 0.f, 0.f};
#pragma unroll
        for (int ks = 0; ks < 2; ++ks) { const bf16x8 bb = frag16(lds + MX_IT, MS64, 16 * wave, ks, lane);
#pragma unroll
            for (int ct = 0; ct < 4; ++ct) { const bf16x8 a = frag16(lds + MX_PS, MS64, 16 * ct, ks, lane); o[ct] = MFMA16(a, bb, o[ct]); } }
#pragma unroll
        for (int ks = 0; ks < 4; ++ks) {
            const f32x4 e0 = LDS_RD(f32x4, lds + SM_BME + (32 * ks + 4 * q4) * 4), e1 = LDS_RD(f32x4, lds + SM_BME + (32 * ks + 16 + 4 * q4) * 4);
            const bf16x8 bb = pack_state(st[2 * ks] * e0, st[2 * ks + 1] * e1);
#pragma unroll
            for (int ct = 0; ct < 4; ++ct) { const bf16x8 a = frag8x2(lds + MX_QR, MS, 16 * ct, ks, lane); o[ct] = MFMA16(a, bb, o[ct]); } }
        {
            f32x4 u[8];
#pragma unroll
            for (int t = 0; t < 8; ++t) u[t] = (f32x4){0.f, 0.f, 0.f, 0.f};
#pragma unroll
            for (int ks = 0; ks < 2; ++ks) { const bf16x8 bb = frag16(lds + MX_IT, MS64, 16 * wave, ks, lane);
#pragma unroll
                for (int t = 0; t < 8; ++t) { const bf16x8 a = frag16(lds + MX_KRT, MS64, 16 * t, ks, lane); u[t] = MFMA16(a, bb, u[t]); } }
#pragma unroll
            for (int t = 0; t < 8; ++t) { const f32x4 eg = LDS_RD(f32x4, lds + SM_EG + (16 * t + 4 * q4) * 4), egm = LDS_RD(f32x4, lds + SM_EGM + (16 * t + 4 * q4) * 4); st[t] = eg * st[t] + egm * u[t]; }
        }
#pragma unroll
        for (int ct = 0; ct < 4; ++ct)
#pragma unroll
            for (int r = 0; r < 4; ++r) { float s = o[ct][r] * o[ct][r]; s += __shfl_xor(s, 1); s += __shfl_xor(s, 2); s += __shfl_xor(s, 4); s += __shfl_xor(s, 8);
                LDS_WR(float, lds + SM_SSQ + ((16 * ct + 4 * q4 + r) * 8 + wave) * 4, s); }
        BLOCK_BAR();
        unsigned short rog[4][4], rz[4][4];
#pragma unroll
        for (int ct = 0; ct < 4; ++ct)
#pragma unroll
            for (int r = 0; r < 4; ++r) { const unsigned so = (tk0 + 16 * ct + r) * (unsigned)(NP * 2); rog[ct][r] = bload16(RP, vo_g, so + C_OGA * 2); rz[ct][r] = bload16(RP, vo_g, so + C_ZA * 2); }
#pragma unroll
        for (int ct = 0; ct < 4; ++ct)
#pragma unroll
            for (int r = 0; r < 4; ++r) { const int c = 16 * ct + 4 * q4 + r;
                const f32x4 s0 = LDS_RD(f32x4, lds + SM_SSQ + (c * 8) * 4), s1 = LDS_RD(f32x4, lds + SM_SSQ + (c * 8 + 4) * 4);
                const float tot = ((s0[0] + s0[1]) + (s0[2] + s0[3])) + ((s1[0] + s1[1]) + (s1[2] + s1[3]));
                const float rstd = frsq(tot * (1.0f / 128.0f) + EPS);
                const float og = bf2f(rog[ct][r]), z = bf2f(rz[ct][r]);
                const float val = o[ct][r] * rstd * gn * sigm(og) * (z * sigm(z));
                bstore16(RO, vo_o, (tk0 + 16 * ct + r) * (unsigned)(DA * 2), (unsigned short)f2bf(val)); }
    }
}

DEV float scan_add(float v, int lane) {
#pragma unroll
    for (int o = 1; o < 64; o <<= 1) { const float t = __shfl_up(v, o); if (lane >= o) v += t; }
    return v;
}
DEV float scan_max(float v, int lane) {
#pragma unroll
    for (int o = 1; o < 64; o <<= 1) { const float t = __shfl_up(v, o); if (lane >= o) v = fmaxf(v, t); }
    return v;
}

DEV void mixer_b_job(const Args& args, ldsp lds, int b, int h, int half, int tid_) {
    const int tid = tid_;
    const int lane = tid & 63, wave = RFL(tid >> 6), q4 = lane >> 4, l15 = lane & 15;
    const int seg = wave >> 1, d = (wave & 1) * 64 + lane;
    const int vbase = h * 256 + 128 * half;
    const rsrc_t RP = make_rsrc(args.ws + WS_P, (unsigned)((size_t)M * NP * 2)), RO = make_rsrc(args.ws + WS_OAB, (unsigned)((size_t)2 * M * DA * 2));
    const unsigned vo_d = (unsigned)(h * 128 + d) * 2u, vo_v = (unsigned)(vbase + d) * 2u, vo_g = (unsigned)((4 * q4) * NP + vbase + 16 * wave + l15) * 2u, vo_o = (unsigned)((4 * q4) * DB + vbase + 16 * wave + l15) * 2u;
    const float* SG = (const float*)(args.ws + WS_SG);
    float* SSB = (float*)(args.ws + WS_SSB);
    const float* cw = args.in[4]; const float* cb = args.in[5];
    float wq[4], wk[4];
#pragma unroll
    for (int k = 0; k < 4; ++k) { wq[k] = cw[k * (2 * DQK) + h * 128 + d]; wk[k] = cw[k * (2 * DQK) + DQK + h * 128 + d]; }
    const float bq = cb[h * 128 + d], bk = cb[DQK + h * 128 + d];
    const float big = args.in[6][h], bfg = args.in[7][h];
    const float gn = args.in[9][vbase + 16 * wave + l15];
    f32x4 st[8];
#pragma unroll
    for (int t = 0; t < 8; ++t) st[t] = (f32x4){0.f, 0.f, 0.f, 0.f};
    float mcar = 0.f;
    if (wave < 2) LDS_WR(float, lds + SM_NV + tid * 4, 0.f);
    for (int j = 0; j < NCH; ++j) {
        const unsigned tk0 = (unsigned)(b * SEQ + 64 * j);
        int tidj = tid_; OPAQUE(tidj);
        const int tid = tidj, lane = tidj & 63, q4 = lane >> 4, l15 = lane & 15, d = (wave & 1) * 64 + lane;
        const unsigned vo_d = (unsigned)(h * 128 + d) * 2u, vo_v = (unsigned)(vbase + d) * 2u, vo_g = (unsigned)((4 * q4) * NP + vbase + 16 * wave + l15) * 2u, vo_o = (unsigned)((4 * q4) * DB + vbase + 16 * wave + l15) * 2u;
        float kf[16];
        {
            unsigned short ruq[19], ruk[19];
            const int t0 = 64 * j + 16 * seg - 3;
#pragma unroll
            for (int i = 0; i < 19; ++i) { const int tt = t0 + i; const unsigned so = (unsigned)(b * SEQ + (tt < 0 ? 0 : tt)) * (unsigned)(NP * 2);
                const unsigned short uq = bload16(RP, vo_d, so + C_QB * 2), uk = bload16(RP, vo_d, so + C_KB * 2); ruq[i] = tt < 0 ? (unsigned short)0 : uq; ruk[i] = tt < 0 ? (unsigned short)0 : uk; }
#pragma unroll
            for (int c = 0; c < 16; ++c) {
                float yq = bq, yk = bk;
#pragma unroll
                for (int k = 0; k < 4; ++k) { yq += wq[k] * bf2f(ruq[c + k]); yk += wk[k] * bf2f(ruk[c + k]); }
                const float qq = yq * sigm(yq); kf[c] = yk * sigm(yk) * 0.08838834764831845f;
                LDS_WR(unsigned short, lds + MX_QR + (16 * seg + c) * MS + d * 2, (unsigned short)f2bf(qq));
                LDS_WR(unsigned short, lds + MX_KR + (16 * seg + c) * MS + d * 2, (unsigned short)f2bf(kf[c]));
            }
        }
        {
            unsigned short rv[16];
#pragma unroll
            for (int c = 0; c < 16; ++c) rv[c] = bload16(RP, vo_v, (tk0 + 16 * seg + c) * (unsigned)(NP * 2) + C_VB * 2);
            u32x4 i0, i1; i0.x = rv[0] | ((unsigned)rv[1] << 16); i0.y = rv[2] | ((unsigned)rv[3] << 16); i0.z = rv[4] | ((unsigned)rv[5] << 16); i0.w = rv[6] | ((unsigned)rv[7] << 16);
            i1.x = rv[8] | ((unsigned)rv[9] << 16); i1.y = rv[10] | ((unsigned)rv[11] << 16); i1.z = rv[12] | ((unsigned)rv[13] << 16); i1.w = rv[14] | ((unsigned)rv[15] << 16);
            LDS_WR(u32x4, lds + MX_IT + d * MS64 + seg * 32, i0); LDS_WR(u32x4, lds + MX_IT + d * MS64 + seg * 32 + 16, i1);
        }
        if (wave == 0) {
            const float fp = SG[(size_t)(tk0 + lane) * 16 + HB + h] + bfg, ig = SG[(size_t)(tk0 + lane) * 16 + h] + big;
            const float bc = scan_add(logsig(fp), lane), a = ig - bc, mx = fmaxf(mcar, scan_max(a, lane));
            const float g = __shfl(bc, 63), m63 = __shfl(mx, 63);
            LDS_WR(float, lds + SM_A + lane * 4, a); LDS_WR(float, lds + SM_MX + lane * 4, mx); LDS_WR(float, lds + SM_INT + lane * 4, fexp(mcar - mx));
            LDS_WR(float, lds + SM_EMT + lane * 4, fexp(-(bc + mx))); LDS_WR(float, lds + SM_WGT + lane * 4, fexp(a - m63));
            if (lane == 0) { LDS_WR(float, lds + SM_SCAL, fexp(mcar - m63)); LDS_WR(float, lds + SM_SCAL + 4, g + m63); }
        }
        BLOCK_BAR();
        const float decay = LDS_RD(float, lds + SM_SCAL);
        mcar = LDS_RD(float, lds + SM_SCAL + 4);
        {
            unsigned kr[16]; float na = 0.f;
#pragma unroll
            for (int c = 0; c < 16; ++c) { const float wk_ = LDS_RD(float, lds + SM_WGT + (16 * seg + c) * 4) * kf[c]; na += wk_; kr[c] = f2bf(wk_); }
            u32x4 w0, w1; w0.x = kr[0] | (kr[1] << 16); w0.y = kr[2] | (kr[3] << 16); w0.z = kr[4] | (kr[5] << 16); w0.w = kr[6] | (kr[7] << 16);
            w1.x = kr[8] | (kr[9] << 16); w1.y = kr[10] | (kr[11] << 16); w1.z = kr[12] | (kr[13] << 16); w1.w = kr[14] | (kr[15] << 16);
            LDS_WR(u32x4, lds + MX_KRT + d * MS64 + seg * 32, w0); LDS_WR(u32x4, lds + MX_KRT + d * MS64 + seg * 32 + 16, w1);
            LDS_WR(float, lds + SM_NACC + (seg * 128 + d) * 4, na);
            const int c = tid >> 3, part = tid & 7; float s = 0.f;
#pragma unroll
            for (int e = 0; e < 16; ++e) s += bf2f(LDS_RD(unsigned short, lds + MX_QR + c * MS + (16 * part + e) * 2)) * LDS_RD(float, lds + SM_NV + (16 * part + e) * 4);
            s += __shfl_xor(s, 1); s += __shfl_xor(s, 2); s += __shfl_xor(s, 4);
            LDS_WR(float, lds + SM_QN + c * 4, s);
        }
        BLOCK_BAR();
        {
            const int ct = wave >> 1, st0 = 2 * (wave & 1);
            f32x4 sc[2] = {(f32x4){0.f, 0.f, 0.f, 0.f}, (f32x4){0.f, 0.f, 0.f, 0.f}};
#pragma unroll
            for (int ks = 0; ks < 4; ++ks) { const bf16x8 a = frag16(lds + MX_QR, MS, 16 * ct, ks, lane);
#pragma unroll
                for (int n = 0; n < 2; ++n) { const bf16x8 bb = frag16(lds + MX_KR, MS, 16 * (st0 + n), ks, lane); sc[n] = MFMA16(a, bb, sc[n]); } }
            float rs[4] = {0.f, 0.f, 0.f, 0.f};
#pragma unroll
            for (int n = 0; n < 2; ++n) { const int s = 16 * (st0 + n) + l15; const float as = LDS_RD(float, lds + SM_A + s * 4);
#pragma unroll
                for (int r = 0; r < 4; ++r) { const int c = 16 * ct + 4 * q4 + r; const float mxc = LDS_RD(float, lds + SM_MX + c * 4);
                    float v = fexp(as - mxc) * sc[n][r]; v = (s <= c) ? v : 0.f; rs[r] += v;
                    LDS_WR(unsigned short, lds + MX_PS + c * MS64 + s * 2, (unsigned short)f2bf(v)); } }
#pragma unroll
            for (int r = 0; r < 4; ++r) { float s = rs[r]; s += __shfl_xor(s, 1); s += __shfl_xor(s, 2); s += __shfl_xor(s, 4); s += __shfl_xor(s, 8);
                LDS_WR(float, lds + SM_RSUM + ((16 * ct + 4 * q4 + r) * 2 + (wave & 1)) * 4, s); }
        }
        BLOCK_BAR();
        f32x4 hv[4];
        {
            bf16x8 bv[2], bs[4];
#pragma unroll
            for (int ks = 0; ks < 2; ++ks) bv[ks] = frag16(lds + MX_IT, MS64, 16 * wave, ks, lane);
#pragma unroll
            for (int ks = 0; ks < 4; ++ks) bs[ks] = pack_state(st[2 * ks], st[2 * ks + 1]);
#pragma unroll
            for (int ct = 0; ct < 4; ++ct) {
                f32x4 a1 = (f32x4){0.f, 0.f, 0.f, 0.f}, a2 = (f32x4){0.f, 0.f, 0.f, 0.f};
#pragma unroll
                for (int ks = 0; ks < 2; ++ks) { const bf16x8 a = frag16(lds + MX_PS, MS64, 16 * ct, ks, lane); a2 = MFMA16(a, bv[ks], a2); }
#pragma unroll
                for (int ks = 0; ks < 4; ++ks) { const bf16x8 a = frag8x2(lds + MX_QR, MS, 16 * ct, ks, lane); a1 = MFMA16(a, bs[ks], a1); }
#pragma unroll
                for (int r = 0; r < 4; ++r) { const int c = 16 * ct + 4 * q4 + r; const float inter = LDS_RD(float, lds + SM_INT + c * 4);
                    const float den = inter * LDS_RD(float, lds + SM_QN + c * 4) + (LDS_RD(float, lds + SM_RSUM + (c * 2) * 4) + LDS_RD(float, lds + SM_RSUM + (c * 2 + 1) * 4));
                    const float num = inter * a1[r] + a2[r];
                    hv[ct][r] = num / fmaxf(fabsf(den), LDS_RD(float, lds + SM_EMT + c * 4)); }
            }
#pragma unroll
            for (int t = 0; t < 8; ++t) {
                f32x4 u = (f32x4){0.f, 0.f, 0.f, 0.f};
#pragma unroll
                for (int ks = 0; ks < 2; ++ks) { const bf16x8 a = frag16(lds + MX_KRT, MS64, 16 * t, ks, lane); u = MFMA16(a, bv[ks], u); }
                st[t] = decay * st[t] + u;
            }
        }
        if (wave < 2) { const float nn = decay * LDS_RD(float, lds + SM_NV + tid * 4) + ((LDS_RD(float, lds + SM_NACC + tid * 4) + LDS_RD(float, lds + SM_NACC + (128 + tid) * 4)) + (LDS_RD(float, lds + SM_NACC + (256 + tid) * 4) + LDS_RD(float, lds + SM_NACC + (384 + tid) * 4)));
            LDS_WR(float, lds + SM_NV + tid * 4, nn); }
#pragma unroll
        for (int ct = 0; ct < 4; ++ct)
#pragma unroll
            for (int r = 0; r < 4; ++r) { float s = hv[ct][r] * hv[ct][r]; s += __shfl_xor(s, 1); s += __shfl_xor(s, 2); s += __shfl_xor(s, 4); s += __shfl_xor(s, 8);
                LDS_WR(float, lds + SM_SSQ + ((16 * ct + 4 * q4 + r) * 8 + wave) * 4, s); }
        BLOCK_BAR();
        if (wave == 0) { const f32x4 s0 = LDS_RD(f32x4, lds + SM_SSQ + (lane * 8) * 4), s1 = LDS_RD(f32x4, lds + SM_SSQ + (lane * 8 + 4) * 4);
            SSB[(size_t)(tk0 + lane) * (2 * HB) + 2 * h + half] = ((s0[0] + s0[1]) + (s0[2] + s0[3])) + ((s1[0] + s1[1]) + (s1[2] + s1[3])); }
        unsigned short rog[4][4], rz[4][4];
#pragma unroll
        for (int ct = 0; ct < 4; ++ct)
#pragma unroll
            for (int r = 0; r < 4; ++r) { const unsigned so = (tk0 + 16 * ct + r) * (unsigned)(NP * 2); rog[ct][r] = bload16(RP, vo_g, so + C_OGB * 2); rz[ct][r] = bload16(RP, vo_g, so + C_ZB * 2); }
#pragma unroll
        for (int ct = 0; ct < 4; ++ct)
#pragma unroll
            for (int r = 0; r < 4; ++r) { const float og = bf2f(rog[ct][r]), z = bf2f(rz[ct][r]);
                const float val = hv[ct][r] * gn * sigm(og) * (z * sigm(z));
                bstore16(RO, vo_o, ((unsigned)M + tk0 + 16 * ct + r) * (unsigned)(DB * 2), (unsigned short)f2bf(val)); }
    }
}

__global__ void __launch_bounds__(NTHREADS, 2) fwd_kernel(Args args) {
#ifndef EMU
    extern __shared__ __attribute__((aligned(16))) unsigned char lds_raw[];
    ldsp lds = (ldsp)lds_raw;
#else
    ldsp lds = emu_lds;
#endif
    const int tid = threadIdx.x, lane = tid & 63, wave = RFL(tid >> 6);
    const int G = gridDim.x, bx = blockIdx.x;
    const int vcu = (G % 8 == 0) ? (bx % 8) * (G / 8) + bx / 8 : bx;
    unsigned char* ws = args.ws;
#ifndef EMU
    for (int u = tid; u < (LDS_BYTES - LDSCTL_OFF) / 4; u += NTHREADS) ((LAS unsigned*)(lds + LDSCTL_OFF))[u] = 0u;
    __syncthreads();
    XcdBarrier bar = xcd_barrier_post((unsigned*)(ws + WS_CTL) + CW_BAR, (volatile LAS unsigned*)(lds + MISC_OFF) + 8);
#define GRID_BAR() xcd_barrier(bar)
#else
#define GRID_BAR()
#endif
    const int lo = args.ph_lo, hi = args.ph_hi;
#ifndef PHASE_MASK
#define PHASE_MASK 127
#endif
#define IN(k) (((PHASE_MASK >> (k)) & 1) && lo <= (k) && (k) < hi)
#define BOTH(k) (IN(k) && IN((k) + 1))
    const float* x = args.in[0];
    bf16* W1T = (bf16*)(ws + WS_W1T); bf16* WUT = (bf16*)(ws + WS_WUT); bf16* WOT = (bf16*)(ws + WS_WOT);
    bf16* HBUF = (bf16*)(ws + WS_HB); bf16* PB = (bf16*)(ws + WS_P); float* SG = (float*)(ws + WS_SG); bf16* OAB = (bf16*)(ws + WS_OAB); float* RSS = (float*)(ws + WS_RSS);

    if (IN(0)) {
        ldsp scr = lds + wave * 16384;
        const int gw = vcu * NWAVES + wave, NGW = G * NWAVES;
        constexpr int RB1 = (NP + NSG + 31) / 32, I_1 = (D / 64) * RB1, I_U = (DA / 64) * (D / 32), I_O = (D / 64) * (D / 32);
        constexpr int NITEMS = I_1 + 2 * I_U + I_O;
        for (int it = gw; it < NITEMS; it += NGW) {
            int r = it;
            if (r < I_1) { const int kb = r / RB1, rb = r % RB1, r0 = 32 * rb; int c0, nv;
                if (r0 < NPM) { c0 = r0; nv = 32; } else if (r0 < NP) { c0 = r0 + NSG; nv = 32; } else { c0 = NPM + (r0 - NP); nv = NSG - (r0 - NP) < 32 ? NSG - (r0 - NP) : 32; }
                p0_transpose_item(args.in[2], D_IN, D, W1T, 64 * kb, c0, r0, nv, scr, lane); continue; }
            r -= I_1;
            if (r < I_U) { const int kb = r / (D / 32), rb = r % (D / 32); p0_transpose_item(args.in[10], D, DA, WUT, 64 * kb, 32 * rb, 32 * rb, 32, scr, lane); continue; }
            r -= I_U;
            if (r < I_U) { const int kb = r / (D / 32), rb = r % (D / 32); p0_transpose_item(args.in[11], D, DB, WUT + (size_t)D * DA, 64 * kb, 32 * rb, 32 * rb, 32, scr, lane); continue; }
            r -= I_U;
            { const int kb = r / (D / 32), rb = r % (D / 32); p0_transpose_item(args.in[12], D, D, WOT, 64 * kb, 32 * rb, 32 * rb, 32, scr, lane); }
        }
        const float* gpre = args.in[1];
        for (int m = gw; m < M; m += NGW) {
            const f32x4* xr = (const f32x4*)(x + (size_t)m * D) + lane;
            f32x4 v[D / 256]; float s = 0.f;
#pragma unroll
            for (int jj = 0; jj < D / 256; ++jj) { v[jj] = xr[64 * jj]; s += (v[jj][0] * v[jj][0] + v[jj][1] * v[jj][1]) + (v[jj][2] * v[jj][2] + v[jj][3] * v[jj][3]); }
            const float rstd = frsq(wave_sum(s) * (1.0f / D) + EPS) ;
            u32x2* o8 = (u32x2*)(HBUF + (size_t)m * D) + lane;
#pragma unroll
            for (int jj = 0; jj < D / 256; ++jj) { const f32x4 gg = ((const f32x4*)gpre)[lane + 64 * jj]; u32x2 w; w.x = pk2(v[jj][0] * rstd * gg[0], v[jj][1] * rstd * gg[1]); w.y = pk2(v[jj][2] * rstd * gg[2], v[jj][3] * rstd * gg[3]); o8[64 * jj] = w; }
        }
        if (BOTH(0)) GRID_BAR();
    }

    if (IN(1)) {
        {
            const int gw = vcu * NWAVES + wave, NGW = G * NWAVES, l15 = lane & 15, q4 = lane >> 4;
            const int wrow = NP + (l15 < NSG ? l15 : NSG - 1);
            for (int t = gw; t < M / 16; t += NGW) {
                f32x4 acc = (f32x4){0.f, 0.f, 0.f, 0.f};
                const bf16* ap = HBUF + (size_t)(16 * t + l15) * D + 8 * q4; const bf16* bp = W1T + (size_t)wrow * D + 8 * q4;
#pragma unroll 8
                for (int ks = 0; ks < D / 32; ++ks) { const bf16x8 a = *(const bf16x8*)(ap + 32 * ks), bb = *(const bf16x8*)(bp + 32 * ks); acc = MFMA16(a, bb, acc); }
#pragma unroll
                for (int r = 0; r < 4; ++r) SG[(size_t)(16 * t + 4 * q4 + r) * 16 + l15] = acc[r];
            }
        }
        pg8::Gemm g{HBUF, W1T, M, NP, D}; pg8::StaticOrder S; S.init(M, NP, G, bx);
        EpiP E{PB};
        pg8::gemm_phase<EpiP, pg8::StaticOrder>(lds, g, S, E);
        if (BOTH(1)) GRID_BAR();
    }

    if (IN(2)) {
        constexpr int NJA = NB * HA, NJB = NB * HB * 2;
        for (int job = bx; job < NJA + NJB; job += G) {
#ifndef NO_MIX_A
            if (job < NJA) mixer_a_job(args, lds, job / HA, job % HA, tid);
#endif
#ifndef NO_MIX_B
            if (job >= NJA) { const int jb = job - NJA; mixer_b_job(args, lds, jb / (2 * HB), (jb >> 1) % HB, jb & 1, tid); }
#endif
            BLOCK_BAR();
        }
        if (BOTH(2)) GRID_BAR();
    }

    if (IN(3)) {
        {
            const int gw = vcu * NWAVES + wave, NGW = G * NWAVES;
            const float* SSB = (const float*)(ws + WS_SSB);
            constexpr int PER = DB / 64;
            static_assert(PER % 8 == 0 && 256 % PER == 0, "P2b tiling");
            for (int m = gw; m < M; m += NGW) {
                const int hh = (lane * PER) / 256;
                const float rstd = frsq((SSB[(size_t)m * (2 * HB) + 2 * hh] + SSB[(size_t)m * (2 * HB) + 2 * hh + 1]) * (1.0f / 256.0f) + EPS);
                u32x4* p = (u32x4*)(OAB + (size_t)(M + m) * DB + lane * PER);
#pragma unroll
                for (int i = 0; i < PER / 8; ++i) { u32x4 w = p[i];
#pragma unroll
                    for (int e = 0; e < 4; ++e) w[e] = pk2(bf2f(w[e] & 0xffffu) * rstd, bf2f(w[e] >> 16) * rstd);
                    p[i] = w; }
            }
        }
        if (BOTH(3)) GRID_BAR();
    }
    if (IN(4)) {
        pg8::Gemm g{OAB, WUT, 2 * M, 2 * D, DA}; SchedUp S; S.so.init(M, D, G, bx);
        EpiUp E{HBUF, PB};
        pg8::gemm_phase<EpiUp, SchedUp>(lds, g, S, E);
        if (BOTH(4)) GRID_BAR();
    }

    if (IN(5)) {
        pg8::Gemm g{HBUF, WOT, M, D, D}; pg8::StaticOrder S; S.init(M, D, G, bx);
        EpiOut E{args.out, RSS};
        pg8::gemm_phase<EpiOut, pg8::StaticOrder>(lds, g, S, E);
        if (BOTH(5)) GRID_BAR();
    }

    if (IN(6)) {
        const int gw = vcu * NWAVES + wave, NGW = G * NWAVES;
        const float* gpost = args.in[13];
        for (int m = gw; m < M; m += NGW) {
            const float ss = wave_sum(lane < NRS ? RSS[(size_t)m * NRS + lane] : 0.f);
            const float rstd = frsq(ss * (1.0f / D) + EPS);
            const f32x4* xr = (const f32x4*)(x + (size_t)m * D) + lane; f32x4* orow = (f32x4*)(args.out + (size_t)m * D) + lane;
#pragma unroll
            for (int jj = 0; jj < D / 256; ++jj) { const f32x4 xv = xr[64 * jj], ov = orow[64 * jj], gg = ((const f32x4*)gpost)[lane + 64 * jj]; orow[64 * jj] = xv + ov * rstd * gg; }
        }
    }
#undef IN
#undef BOTH
}

#ifndef EMU
extern "C" void kernel_launch(void* const* d_in, const int* in_sizes, int n_in, void* d_out, int out_size, void* d_ws, size_t ws_size, hipStream_t stream) {
    static int grid = 0;
    if (grid == 0) {
        if (n_in != 14 || out_size != M * D || ws_size < WS_END) { fprintf(stderr, "kernel_launch: unexpected shapes (n_in %d, out %d, ws %zu < %zu)\n", n_in, out_size, ws_size, (size_t)WS_END); grid = -1; return; }
        int dev = 0, cus = 0, per_cu = 0;
        if (hipGetDevice(&dev) != hipSuccess || hipDeviceGetAttribute(&cus, hipDeviceAttributeMultiprocessorCount, dev) != hipSuccess) { grid = -1; return; }
        if (hipFuncSetAttribute((const void*)fwd_kernel, hipFuncAttributeMaxDynamicSharedMemorySize, LDS_BYTES) != hipSuccess) { fprintf(stderr, "kernel_launch: hipFuncSetAttribute failed\n"); grid = -1; return; }
        if (hipOccupancyMaxActiveBlocksPerMultiprocessor(&per_cu, (const void*)fwd_kernel, NTHREADS, LDS_BYTES) != hipSuccess || per_cu < 1) { fprintf(stderr, "kernel_launch: occupancy query says %d\n", per_cu); }
        (void)hipGetLastError();
        grid = cus;
    }
    if (grid < 0) return;
    (void)hipMemsetAsync((char*)d_ws + WS_CTL, 0, CTL_ZERO_BYTES, stream);
    Args a{};
    for (int i = 0; i < 14; ++i) a.in[i] = (const float*)d_in[i];
    a.out = (float*)d_out; a.ws = (unsigned char*)d_ws; a.ph_lo = 0; a.ph_hi = 7;
    hipLaunchKernelGGL(fwd_kernel, dim3(grid), dim3(NTHREADS), LDS_BYTES, stream, a);
}
#endif
```

```cpp
#ifndef EMU
#include <hip/hip_runtime.h>
#include <cstdio>
#include <cstdint>
#define LAS __attribute__((address_space(3)))
#define GAS __attribute__((address_space(1)))
typedef short bf16x8 __attribute__((ext_vector_type(8)));
typedef short bf16x4 __attribute__((ext_vector_type(4)));
typedef float f32x4 __attribute__((ext_vector_type(4)));
#define DEV __device__ __forceinline__
#define LDS_RD(T, p) (*(const LAS T*)(p))
#define LDS_WR(T, p, v) (*(LAS T*)(p) = (v))
#define WAVE_SYNC() asm volatile("s_waitcnt lgkmcnt(0)" ::: "memory")
#define BLOCK_BAR() __syncthreads()
#define RAW_BAR() __builtin_amdgcn_s_barrier()
#define WAIT_V(n) asm volatile("s_waitcnt vmcnt(" #n ")" ::: "memory")
#define WAIT_L(n) asm volatile("s_waitcnt lgkmcnt(" #n ")" ::: "memory")
#define SCHED_BAR() __builtin_amdgcn_sched_barrier(0)
#define SETPRIO(n) __builtin_amdgcn_s_setprio(n)
#define GLDS16(g, l) __builtin_amdgcn_global_load_lds((const unsigned*)(g), (LAS unsigned*)(l), 16, 0, 0)
#define MFMA16(a, b, c) __builtin_amdgcn_mfma_f32_16x16x32_bf16(a, b, c, 0, 0, 0)
#define RFL(x) __builtin_amdgcn_readfirstlane(x)
#define COMPILER_FENCE() asm volatile("" ::: "memory")
#define OPAQUE(x) asm volatile("" : "+v"(x))
DEV float fexp2(float x) { return __builtin_amdgcn_exp2f(x); }
DEV float flog2(float x) { return __builtin_amdgcn_logf(x); }
DEV float frcp(float x) { return __builtin_amdgcn_rcpf(x); }
DEV float frsq(float x) { return __builtin_amdgcn_rsqf(x); }
DEV unsigned cvt_pk_bf16(float lo, float hi) { unsigned r; asm volatile("v_cvt_pk_bf16_f32 %0, %1, %2" : "=v"(r) : "v"(lo), "v"(hi)); return r; }
typedef short v4i16_t __attribute__((ext_vector_type(4)));
DEV bf16x4 lds_tr16(LAS unsigned char* p) { return __builtin_bit_cast(bf16x4, __builtin_amdgcn_ds_read_tr16_b64_v4i16((LAS v4i16_t*)p)); }
#define MIX_BAR() do { asm volatile("s_waitcnt lgkmcnt(0)" ::: "memory"); __builtin_amdgcn_s_barrier(); asm volatile("" ::: "memory"); } while (0)
typedef __amdgpu_buffer_rsrc_t rsrc_t;
DEV rsrc_t make_rsrc(const void* p, unsigned bytes) { return __builtin_amdgcn_make_buffer_rsrc((void*)p, (short)0, (int)bytes, 0x00020000); }
DEV unsigned short bload16(rsrc_t r, unsigned voff, unsigned soff) { return (unsigned short)__builtin_amdgcn_raw_buffer_load_b16(r, (int)voff, (int)soff, 0); }
DEV void bstore16(rsrc_t r, unsigned voff, unsigned soff, unsigned short v) { __builtin_amdgcn_raw_buffer_store_b16(v, r, (int)voff, (int)soff, 0); }
#else
#define LAS
#define GAS
#define DEV inline
#define LDS_RD(T, p) emu_lds_rd<T>((const void*)(p), #p)
#define LDS_WR(T, p, v) emu_lds_wr<T>((void*)(p), (T)(v), #p)
#define WAVE_SYNC() emu_wavesync()
#define BLOCK_BAR() emu_syncthreads()
#define RAW_BAR() emu_syncthreads()
#define WAIT_V(n)
#define WAIT_L(n)
#define SCHED_BAR()
#define SETPRIO(n)
#define GLDS16(g, l) emu_glds16((const void*)(g), (unsigned char*)(l))
#define MFMA16(a, b, c) emu_mfma16(a, b, c)
#define RFL(x) (x)
#define COMPILER_FENCE()
#define OPAQUE(x)
DEV float fexp2(float x) { return exp2f(x); }
DEV float flog2(float x) { return log2f(x); }
DEV float frcp(float x) { return 1.0f / x; }
DEV float frsq(float x) { return 1.0f / sqrtf(x); }
DEV unsigned cvt_pk_bf16(float lo, float hi) { return (unsigned)emu_f2bf(lo) | ((unsigned)emu_f2bf(hi) << 16); }
#define lds_tr16(p) emu_lds_tr16((const unsigned char*)(p))
#define MIX_BAR() emu_syncthreads()
typedef unsigned char* rsrc_t;
DEV rsrc_t make_rsrc(const void* p, unsigned) { return (unsigned char*)p; }
DEV unsigned short bload16(rsrc_t r, unsigned voff, unsigned soff) { unsigned short v; memcpy(&v, r + (size_t)voff + soff, 2); return v; }
DEV void bstore16(rsrc_t r, unsigned voff, unsigned soff, unsigned short v) { memcpy(r + (size_t)voff + soff, &v, 2); }
#endif

typedef unsigned short bf16;
typedef unsigned u32x4 __attribute__((ext_vector_type(4)));
typedef unsigned u32x2 __attribute__((ext_vector_type(2)));
typedef float f32x2 __attribute__((ext_vector_type(2)));
typedef LAS unsigned char* ldsp;

#ifndef CFG_D
#define CFG_D 4096
#define CFG_B 4
#define CFG_S 4096
#define CFG_HB 8
#endif
constexpr int D = CFG_D, NB = CFG_B, SEQ = CFG_S, M = NB * SEQ;
constexpr int DA = D / 2, HA = DA / 128, DB = D / 2, HB = CFG_HB, DVB = DB / HB, DKB = 128, DQK = HB * DKB;
constexpr int NSG = 2 * HB;
constexpr int NCH = SEQ / 64;
static_assert(DVB == 256 && NSG <= 16 && SEQ % 64 == 0 && M % 256 == 0 && D % 256 == 0, "shape");
constexpr int C_QA = 0, C_FA = DA, C_IA = 2 * DA, C_OGA = 3 * DA, C_ZA = 4 * DA, C_QB = 5 * DA, C_KB = C_QB + DQK, C_VB = C_KB + DQK, C_OGB = C_VB + DB, C_ZB = C_OGB + DB;
constexpr int NPM = C_ZB + DB, C_GA = NPM, C_GB = NPM + D, NP = NPM + 2 * D, D_IN = NP + NSG;
static_assert(NPM % 256 == 0 && NP % 256 == 0, "column map");
constexpr float EPS = 1e-6f;
constexpr float LOG2E = 1.4426950408889634f, LN2 = 0.6931471805599453f;
constexpr int NRS = D / 64;

constexpr size_t al256(size_t x) { return (x + 255) & ~(size_t)255; }
constexpr size_t WS_CTL = 0, CTL_ZERO_BYTES = 65536;
constexpr size_t WS_W1T = 1u << 20;
constexpr size_t WS_WUT = al256(WS_W1T + (size_t)(NP + 16) * D * 2);
constexpr size_t WS_WOT = al256(WS_WUT + (size_t)2 * D * DA * 2);
constexpr size_t WS_HB = al256(WS_WOT + (size_t)D * D * 2);
constexpr size_t WS_P = al256(WS_HB + (size_t)M * D * 2);
constexpr size_t WS_SG = al256(WS_P + (size_t)M * NP * 2);
constexpr size_t WS_OAB = al256(WS_SG + (size_t)M * 16 * 4);
constexpr size_t WS_RSS = al256(WS_OAB + (size_t)2 * M * DA * 2);
constexpr size_t WS_SSB = al256(WS_RSS + (size_t)M * NRS * 4);
constexpr size_t WS_SSA = al256(WS_SSB + (size_t)M * HB * 2 * 4);
constexpr size_t WS_END = al256(WS_SSA + (size_t)M * HA * 4);
constexpr int CW_BAR = 1024;

constexpr int RING_BYTES = 154624, LDSCTL_OFF = RING_BYTES, MISC_OFF = LDSCTL_OFF + 320, LDS_BYTES = 155648;
constexpr int NWAVES = 8, NTHREADS = 512;

DEV unsigned f2bf(float f) { unsigned u = __builtin_bit_cast(unsigned, f); return (u + 0x7fffu + ((u >> 16) & 1u)) >> 16; }
DEV float bf2f(unsigned b) { return __builtin_bit_cast(float, b << 16); }
DEV unsigned pk2(float lo, float hi) { return f2bf(lo) | (f2bf(hi) << 16); }
DEV float fexp(float x) { return fexp2(x * LOG2E); }
DEV float flog(float x) { return flog2(x) * LN2; }
DEV float sigm(float x) { return frcp(1.0f + fexp(-x)); }
DEV float logsig(float x) { return fminf(x, 0.f) - flog(1.0f + fexp(-fabsf(x))); }
DEV float wave_sum(float v) {
#pragma unroll
    for (int o = 1; o < 64; o <<= 1) v += __shfl_xor(v, o);
    return v;
}

namespace pg8 {
constexpr int BM = 256, BK = 64, HALF = 128, HTB = HALF * BK * 2, STAGE_BYTES = 8 * HTB, NXCD = 8, WGM = 8;
DEV int lds_byte(int r, int c) { const int st = (r >> 4) * 2 + (c >> 5), rr = r & 15, cc = c & 31, ob = rr * 64 + cc * 2; return st * 1024 + (ob ^ (((ob >> 9) & 1) << 5)); }
DEV void stage_rc(int b, int& R, int& C) { const int st = b / 1024, sb = b % 1024, swz = sb ^ (((sb >> 9) & 1) << 5); R = (st >> 1) * 16 + swz / 64; C = (st & 1) * 32 + (swz % 64) / 2; }
DEV int perm32(int rho) { const int n = rho >> 4, i = rho & 15; return 8 * (i >> 2) + 4 * n + (i & 3); }
struct Unit { int pm, pn; };
struct Gemm { const bf16* A; const bf16* Bt; int M, N, K; };
struct StaticOrder {
    int nM, nN, nwg, G, c;
    DEV void init(int M_, int N_, int G_, int c_) { nM = M_ / BM; nN = N_ / BM; nwg = nM * nN; G = G_; c = c_; }
    DEV bool next(int i, Unit& u) const {
        const long L = (long)i * G + c; if (L >= nwg) return false;
        int wgid = (int)L; { const int q = nwg / NXCD, r = nwg % NXCD, xcd = wgid % NXCD, off = wgid / NXCD; wgid = (xcd < r ? xcd * (q + 1) : r * (q + 1) + (xcd - r) * q) + off; }
        const int nig = WGM * nN, gid = wgid / nig, fm = gid * WGM, gsz = (nM - fm) < WGM ? (nM - fm) : WGM;
        u.pm = fm + ((wgid % nig) % gsz); u.pn = (wgid % nig) / gsz; return true;
    }
};
template <class Epi, class Sched>
DEV void gemm_phase(ldsp lds, const Gemm g, const Sched& S, const Epi& E) {
    const int tid = threadIdx.x, wid = RFL(tid >> 6), lane = tid & 63, wr = wid >> 2, wc = wid & 3, fr = lane & 15, fq = lane >> 4;
    const int K = g.K, nt = K / BK;
    unsigned voffA[2], voffB[2];
#pragma unroll
    for (int i = 0; i < 2; ++i) { int R, C; stage_rc(tid * 16 + i * 8192, R, C); const int Rb = Epi::PERM ? ((R & ~31) + perm32(R & 31)) : R;
        voffA[i] = (unsigned)(R * K + C) * 2u; voffB[i] = (unsigned)(Rb * K + C) * 2u; }
    const size_t kstep = (size_t)(BK * 2);
    const size_t hstep = (size_t)HALF * K * 2;
    const size_t tstep = 2 * hstep;
    const unsigned ldsw = (unsigned)wid * 1024u;
    const int aoff = lds_byte(wr * 64 + fr, fq * 8), boff = lds_byte(wc * 32 + fr, fq * 8);
#define PG8_SA(b, h) (((b) * 2 + (h)) * HTB)
#define PG8_SB(b, h) ((4 + (b) * 2 + (h)) * HTB)
#define PG8_STAGE(bufoff, gbase, voff) do { _Pragma("unroll") for (int _i = 0; _i < 2; ++_i) \
        GLDS16((const char*)(gbase) + (voff)[_i], lds + (bufoff) + ldsw + _i * 8192); } while (0)
#define PG8_LDA(dst, b, h) do { _Pragma("unroll") for (int m = 0; m < 4; ++m) _Pragma("unroll") for (int k = 0; k < 2; ++k) dst[m][k] = *(const LAS bf16x8*)(lds + PG8_SA(b, h) + aoff + m * 2048 + k * 1024); } while (0)
#define PG8_LDB(dst, b, h) do { _Pragma("unroll") for (int n = 0; n < 2; ++n) _Pragma("unroll") for (int k = 0; k < 2; ++k) dst[n][k] = *(const LAS bf16x8*)(lds + PG8_SB(b, h) + boff + n * 2048 + k * 1024); } while (0)
#define PG8_MMA(ai, bj, At, Bt) do { SETPRIO(1); _Pragma("unroll") for (int m = 0; m < 4; ++m) _Pragma("unroll") for (int n = 0; n < 2; ++n) _Pragma("unroll") for (int k = 0; k < 2; ++k) \
        acc[ai][bj][m][n] = MFMA16(Bt[n][k], At[m][k], acc[ai][bj][m][n]); SETPRIO(0); } while (0)
    Unit cur, nxt; int ui = 0;
    if (!S.next(0, cur)) return;
    f32x4 acc[2][2][4][2];
#pragma unroll
    for (int a = 0; a < 2; ++a)
#pragma unroll
        for (int b = 0; b < 2; ++b)
#pragma unroll
            for (int m = 0; m < 4; ++m)
#pragma unroll
                for (int n = 0; n < 2; ++n) acc[a][b][m][n] = (f32x4){0.f, 0.f, 0.f, 0.f};
    bf16x8 At[4][2], B0[2][2], B1[2][2];
    const char* cA = (const char*)g.A + (size_t)cur.pm * tstep; const char* cB = (const char*)g.Bt + (size_t)cur.pn * tstep;
    PG8_STAGE(PG8_SB(0, 0), cB, voffB); PG8_STAGE(PG8_SA(0, 0), cA, voffA); PG8_STAGE(PG8_SB(0, 1), cB + hstep, voffB); PG8_STAGE(PG8_SA(0, 1), cA + hstep, voffA);
    if (wr == 1) RAW_BAR();
    WAIT_V(4); RAW_BAR();
    PG8_STAGE(PG8_SB(1, 0), cB + kstep, voffB); PG8_STAGE(PG8_SA(1, 0), cA + kstep, voffA); PG8_STAGE(PG8_SB(1, 1), cB + hstep + kstep, voffB);
    WAIT_V(6); RAW_BAR();
    for (;;) {
        const bool has_next = S.next(ui + 1, nxt);
        const char* nA = has_next ? (const char*)g.A + (size_t)nxt.pm * tstep : cA; const char* nB = has_next ? (const char*)g.Bt + (size_t)nxt.pn * tstep : cB;
        for (int t = 0; t < nt; t += 2) {
            const bool last = (t == nt - 2);
            const char* a1 = cA + (size_t)(t + 1) * kstep;
            const char* a2 = last ? nA : cA + (size_t)(t + 2) * kstep; const char* b2 = last ? nB : cB + (size_t)(t + 2) * kstep;
            const char* a3 = a2 + kstep; const char* b3 = b2 + kstep;
            PG8_LDB(B0, 0, 0); SCHED_BAR(); PG8_LDA(At, 0, 0); PG8_STAGE(PG8_SA(1, 1), a1 + hstep, voffA);
            WAIT_L(8); RAW_BAR(); WAIT_L(0); PG8_MMA(0, 0, At, B0); RAW_BAR(); SCHED_BAR();
            PG8_LDB(B1, 0, 1); PG8_STAGE(PG8_SB(0, 0), b2, voffB);
            RAW_BAR(); WAIT_L(0); PG8_MMA(0, 1, At, B1); RAW_BAR();
            PG8_LDA(At, 0, 1); PG8_STAGE(PG8_SA(0, 0), a2, voffA);
            RAW_BAR(); WAIT_L(0); PG8_MMA(1, 0, At, B0); RAW_BAR(); SCHED_BAR();
            PG8_STAGE(PG8_SB(0, 1), b2 + hstep, voffB);
            WAIT_V(6); RAW_BAR(); PG8_MMA(1, 1, At, B1); RAW_BAR();
            PG8_LDB(B0, 1, 0); SCHED_BAR(); PG8_LDA(At, 1, 0); PG8_STAGE(PG8_SA(0, 1), a2 + hstep, voffA);
            WAIT_L(8); RAW_BAR(); WAIT_L(0); PG8_MMA(0, 0, At, B0); RAW_BAR(); SCHED_BAR();
            PG8_LDB(B1, 1, 1); PG8_STAGE(PG8_SB(1, 0), b3, voffB);
            RAW_BAR(); WAIT_L(0); PG8_MMA(0, 1, At, B1); RAW_BAR();
            PG8_LDA(At, 1, 1); PG8_STAGE(PG8_SA(1, 0), a3, voffA);
            RAW_BAR(); WAIT_L(0); PG8_MMA(1, 0, At, B0); RAW_BAR(); SCHED_BAR();
            PG8_STAGE(PG8_SB(1, 1), b3 + hstep, voffB);
            WAIT_V(6); RAW_BAR(); PG8_MMA(1, 1, At, B1); RAW_BAR();
        }
        E(acc, cur, wr, wc, fr, fq);
        if (!has_next) break;
#pragma unroll
        for (int a = 0; a < 2; ++a)
#pragma unroll
            for (int b = 0; b < 2; ++b)
#pragma unroll
                for (int m = 0; m < 4; ++m)
#pragma unroll
                    for (int n = 0; n < 2; ++n) acc[a][b][m][n] = (f32x4){0.f, 0.f, 0.f, 0.f};
        cur = nxt; cA = nA; cB = nB; ++ui;
    }
    WAIT_V(0);
    if (wr == 0) RAW_BAR();
    RAW_BAR();
#undef PG8_SA
#undef PG8_SB
#undef PG8_STAGE
#undef PG8_LDA
#undef PG8_LDB
#undef PG8_MMA
}
}

struct EpiP {
    static constexpr bool PERM = true;
    bf16* O;
    DEV void operator()(const f32x4 (&acc)[2][2][4][2], const pg8::Unit& u, int wr, int wc, int fr, int fq) const {
        const int row0 = u.pm * 256 + wr * 64 + fr, col0 = u.pn * 256 + wc * 32 + 8 * fq;
#pragma unroll
        for (int ai = 0; ai < 2; ++ai)
#pragma unroll
            for (int m = 0; m < 4; ++m) { bf16* rowp = O + (size_t)(row0 + ai * 128 + m * 16) * NP + col0;
#pragma unroll
                for (int bj = 0; bj < 2; ++bj) { const f32x4 v0 = acc[ai][bj][m][0], v1 = acc[ai][bj][m][1];
                    u32x4 w; w.x = cvt_pk_bf16(v0[0], v0[1]); w.y = cvt_pk_bf16(v0[2], v0[3]); w.z = cvt_pk_bf16(v1[0], v1[1]); w.w = cvt_pk_bf16(v1[2], v1[3]);
                    *(u32x4*)(rowp + bj * 128) = w; } }
    }
};
struct SchedUp {
    pg8::StaticOrder so;
    DEV bool next(int i, pg8::Unit& u) const { if (!so.next(i >> 1, u)) return false; if (i & 1) { u.pm += M / 256; u.pn += D / 256; } return true; }
};
struct EpiUp {
    static constexpr bool PERM = true;
    bf16* Y; const bf16* P;
    DEV void operator()(const f32x4 (&acc)[2][2][4][2], const pg8::Unit& u, int wr, int wc, int fr, int fq) const {
        const int br = u.pm >= M / 256 ? 1 : 0, pm = u.pm - br * (M / 256), pn = u.pn - br * (D / 256);
        const int row0 = pm * 256 + wr * 64 + fr, col0 = pn * 256 + wc * 32 + 8 * fq, gcol = (br ? C_GB : C_GA) + col0;
#pragma unroll
        for (int ai = 0; ai < 2; ++ai)
#pragma unroll
            for (int m = 0; m < 4; ++m) { const size_t row = (size_t)(row0 + ai * 128 + m * 16);
#pragma unroll
                for (int bj = 0; bj < 2; ++bj) {
                    const u32x4 g8 = *(const u32x4*)(P + row * NP + gcol + bj * 128);
                    bf16* yp = Y + row * D + col0 + bj * 128;
                    u32x4 y8 = (u32x4){0u, 0u, 0u, 0u}; if (br) y8 = *(const u32x4*)yp;
                    const f32x4 v0 = acc[ai][bj][m][0], v1 = acc[ai][bj][m][1];
                    float o[8];
#pragma unroll
                    for (int k = 0; k < 8; ++k) { const unsigned gw = g8[k >> 1], yw = y8[k >> 1]; const float gv = bf2f((k & 1) ? (gw >> 16) : (gw & 0xffffu)), yv = bf2f((k & 1) ? (yw >> 16) : (yw & 0xffffu));
                        const float a = k < 4 ? v0[k & 3] : v1[k & 3]; o[k] = yv + sigm(gv) * a; }
                    u32x4 w; w.x = cvt_pk_bf16(o[0], o[1]); w.y = cvt_pk_bf16(o[2], o[3]); w.z = cvt_pk_bf16(o[4], o[5]); w.w = cvt_pk_bf16(o[6], o[7]);
                    *(u32x4*)yp = w; } }
    }
};
struct EpiOut {
    static constexpr bool PERM = false;
    float* C; float* RSS;
    DEV void operator()(const f32x4 (&acc)[2][2][4][2], const pg8::Unit& u, int wr, int wc, int fr, int fq) const {
        const int row0 = u.pm * 256 + wr * 64 + fr, col0 = u.pn * 256 + wc * 32 + 4 * fq;
#pragma unroll
        for (int ai = 0; ai < 2; ++ai)
#pragma unroll
            for (int m = 0; m < 4; ++m) { const size_t row = (size_t)(row0 + ai * 128 + m * 16); float* rowp = C + row * D + col0; float ss = 0.f;
#pragma unroll
                for (int bj = 0; bj < 2; ++bj)
#pragma unroll
                    for (int n = 0; n < 2; ++n) { const f32x4 v = acc[ai][bj][m][n]; *(f32x4*)(rowp + bj * 128 + n * 16) = v; ss += (v[0] * v[0] + v[1] * v[1]) + (v[2] * v[2] + v[3] * v[3]); }
                ss += __shfl_xor(ss, 16); ss += __shfl_xor(ss, 32);
                if (fq == 0) RSS[row * NRS + u.pn * 4 + wc] = ss; }
    }
};

#ifndef EMU
typedef GAS unsigned gu32;
#define RLX_AGENT __ATOMIC_RELAXED, __HIP_MEMORY_SCOPE_AGENT
#define XB_TMO      128
#define XB_XCNT(j)  (256  + 64 * (j))
#define XB_XSUB(j)  (1280 + 64 * (j))
#define XB_XGEN(j)  (2304 + 64 * (j))
#define XB_TOP      3328
#define XB_TOPGEN   3392
#define XCD_BAR_WORDS 3456
#define XB_SPIN_CAP (1u << 22)
__device__ __forceinline__ unsigned xb_ld(unsigned* p)              { return __hip_atomic_load(p, __ATOMIC_RELAXED, __HIP_MEMORY_SCOPE_AGENT); }
__device__ __forceinline__ unsigned xb_add(unsigned* p, unsigned v) { return __hip_atomic_fetch_add(p, v, __ATOMIC_RELAXED, __HIP_MEMORY_SCOPE_AGENT); }
__device__ __forceinline__ unsigned xb_xcc_id() { return (unsigned)__builtin_amdgcn_s_getreg((3 << 11) | 20) & 0xFu; }
#define XB_SPIN(cond, bar) do { unsigned _sp = 0; while (cond) { __builtin_amdgcn_s_sleep(1); \
    if ((++_sp & 255u) == 0u) { if (xb_ld(&(bar)[XB_TMO])) break; if (_sp > XB_SPIN_CAP) { atomicAdd(&(bar)[XB_TMO], 1u); break; } } } } while (0)
struct XcdBarrier { unsigned* bar; unsigned x; volatile LAS unsigned* st; };
__device__ __forceinline__ XcdBarrier xcd_barrier_post(unsigned* bar, volatile LAS unsigned* st) {
    XcdBarrier b; b.bar = bar; b.x = xb_xcc_id(); b.st = st;
    if (threadIdx.x == 0) (void)xb_add(&bar[XB_XCNT(b.x)], 1u);
    return b;
}
__device__ __forceinline__ void xcd_barrier_complete(unsigned* bar, unsigned x, unsigned& nloc, unsigned& nx) {
    const unsigned G = gridDim.x * gridDim.y * gridDim.z;
    unsigned sum, cnt, mine, sp = 0u;
    for (;;) {
        sum = 0u; cnt = 0u; mine = 0u;
#pragma unroll
        for (unsigned j = 0; j < 16; ++j) { const unsigned c = xb_ld(&bar[XB_XCNT(j)]); sum += c; cnt += (c > 0u) ? 1u : 0u; mine = (j == x) ? c : mine; }
        if (sum == G) break;
        __builtin_amdgcn_s_sleep(1);
        if ((++sp & 255u) == 0u) { if (xb_ld(&bar[XB_TMO])) break; if (sp > XB_SPIN_CAP) { atomicAdd(&bar[XB_TMO], 1u); break; } }
    }
    nloc = mine > 0u ? mine : 1u; nx = cnt > 0u ? cnt : 1u;
}
__device__ __forceinline__ void xcd_barrier(const XcdBarrier& b) {
    asm volatile("s_waitcnt vmcnt(0)" ::: "memory");
    __syncthreads();
    if (threadIdx.x == 0) {
        unsigned* bar = b.bar;
        __builtin_amdgcn_s_waitcnt(0);
        unsigned nloc = b.st[0], nx = b.st[1];
        if (nloc == 0u) { xcd_barrier_complete(bar, b.x, nloc, nx); b.st[0] = nloc; b.st[1] = nx; }
        const unsigned old = xb_add(&bar[XB_XSUB(b.x)], 1u);
        const unsigned gen = old / nloc;
        if (old + 1u == (gen + 1u) * nloc) {
            __builtin_amdgcn_fence(__ATOMIC_RELEASE, "agent");
            asm volatile("s_waitcnt vmcnt(0)" ::: "memory");
            const unsigned og = xb_add(&bar[XB_TOP], 1u);
            const unsigned tg = og / nx;
            if (og + 1u == (tg + 1u) * nx) xb_add(&bar[XB_TOPGEN], 1u);
            else XB_SPIN(xb_ld(&bar[XB_TOPGEN]) == tg, bar);
            __builtin_amdgcn_fence(__ATOMIC_ACQUIRE, "agent");
            xb_add(&bar[XB_XGEN(b.x)], 1u);
            asm volatile("s_waitcnt vmcnt(0)" ::: "memory");
        } else {
            XB_SPIN(xb_ld(&bar[XB_XGEN(b.x)]) == gen, bar);
            __builtin_amdgcn_fence(__ATOMIC_ACQUIRE, "agent");
            asm volatile("s_waitcnt vmcnt(0)" ::: "memory");
        }
    }
    __syncthreads();
}
#endif

struct Args { const float* in[14]; float* out; unsigned char* ws; int ph_lo, ph_hi; };

DEV void p0_transpose_item(const float* W, int ldw, int K, bf16* WT, int k0, int c0, int r0, int nvalid, ldsp scr, int lane) {
    const int n_ = lane & 31;
#pragma unroll 8
    for (int i = 0; i < 32; ++i) { const int kk = 2 * i + (lane >> 5); const float v = (n_ < nvalid) ? W[(size_t)(k0 + kk) * ldw + c0 + n_] : 0.f; LDS_WR(float, scr + (kk * 33 + n_) * 4, v); }
    WAVE_SYNC();
    const int c = lane & 7;
#pragma unroll
    for (int j = 0; j < 4; ++j) { const int n = (lane >> 3) + 8 * j; ldsp s = scr + ((8 * c) * 33 + n) * 4;
        u32x4 o; o.x = pk2(LDS_RD(float, s + 0 * 132), LDS_RD(float, s + 1 * 132)); o.y = pk2(LDS_RD(float, s + 2 * 132), LDS_RD(float, s + 3 * 132));
        o.z = pk2(LDS_RD(float, s + 4 * 132), LDS_RD(float, s + 5 * 132)); o.w = pk2(LDS_RD(float, s + 6 * 132), LDS_RD(float, s + 7 * 132));
        if (n < nvalid) *(u32x4*)(WT + (size_t)(r0 + n) * K + k0 + 8 * c) = o; }
    WAVE_SYNC();
}

constexpr int MS = 272, MS64 = 144;
constexpr int RAW_A = 0, RAW_B = RAW_A + 68 * 256, RAW_I = RAW_B + 68 * 256;
constexpr int MX_QR = RAW_I + 2 * 64 * 256, MX_KR = MX_QR + 64 * MS, MX_KW = MX_KR + 64 * MS, MX_PS = MX_KW + 64 * MS, MX_SM = MX_PS + 64 * MS64;
constexpr int SM_TOT = MX_SM, SM_BME = SM_TOT + 8 * 128 * 4, SM_EG = SM_BME + 512, SM_EGM = SM_EG + 512, SM_SSQ = SM_EGM + 512;
constexpr int SM_A = SM_SSQ + 2 * 64 * 8 * 4, SM_MX = SM_A + 256, SM_INT = SM_MX + 256, SM_EMT = SM_INT + 256, SM_WGT = SM_EMT + 256, SM_SCAL = SM_WGT + 256;
constexpr int SM_NV = SM_SCAL + 64, SM_NACC = SM_NV + 512, SM_RSUM = SM_NACC + 8 * 512, SM_QN = SM_RSUM + 64 * 2 * 4, SM_CW = SM_QN + 256, MX_END = SM_CW + 10 * 512;
static_assert(MX_END <= RING_BYTES, "mixer LDS");

DEV bf16x8 frag16(ldsp buf, int stride, int row0, int ks, int lane) { return LDS_RD(bf16x8, buf + (row0 + (lane & 15)) * stride + ks * 64 + (lane >> 4) * 16); }
DEV bf16x8 frag8x2(ldsp buf, int stride, int row0, int ks, int lane) {
    ldsp p = buf + (row0 + (lane & 15)) * stride + ks * 64 + (lane >> 4) * 8;
    const bf16x4 lo = LDS_RD(bf16x4, p), hi = LDS_RD(bf16x4, p + 32);
    return (bf16x8){lo[0], lo[1], lo[2], lo[3], hi[0], hi[1], hi[2], hi[3]};
}
DEV bf16x8 frag_tr(ldsp img, int n0, int ks, int lane, int stride = 256) {
    ldsp p = img + (32 * ks + 8 * (lane >> 4) + ((lane & 15) >> 2)) * stride + (n0 + 4 * (lane & 3)) * 2;
    const bf16x4 lo = lds_tr16(p), hi = lds_tr16(p + 4 * stride);
    return (bf16x8){lo[0], lo[1], lo[2], lo[3], hi[0], hi[1], hi[2], hi[3]};
}
DEV bf16x8 pack_state(const f32x4 a, const f32x4 b) {
    u32x4 w; w.x = pk2(a[0], a[1]); w.y = pk2(a[2], a[3]); w.z = pk2(b[0], b[1]); w.w = pk2(b[2], b[3]);
    return __builtin_bit_cast(bf16x8, w);
}
DEV void dma_tile(const bf16* P, long row0, int col0, int ninst, ldsp dst, int wave, int lane) {
    for (int i = wave; i < ninst; i += NWAVES) {
        long r = row0 + 4 * i + (lane >> 4); r = r < 0 ? 0 : (r > (long)M - 1 ? (long)M - 1 : r);
        GLDS16((const char*)(P + (size_t)r * NP + col0) + 16 * (lane & 15), dst + i * 1024);
    }
}

DEV float sigm2(float x) { return frcp(1.0f + fexp2(-LOG2E * x)); }
DEV u32x2 pack4(const f32x4 v) { u32x2 w; w.x = cvt_pk_bf16(v[0], v[1]); w.y = cvt_pk_bf16(v[2], v[3]); return w; }

DEV void mixer_a_job(const Args& args, ldsp lds, int b, int h, int tid_) {
    const int wave = RFL(tid_ >> 6);
    const bf16* P = (const bf16*)(args.ws + WS_P);
    bf16* OA = (bf16*)(args.ws + WS_OAB);
    float* SSA = (float*)(args.ws + WS_SSA);
    const float* lbl = args.in[3];
    float lbv[2];
#pragma unroll
    for (int e = 0; e < 2; ++e) { const int col = h * 128 + 2 * (tid_ & 63) + e; lbv[e] = frcp(1.0f + fexp(lbl[DA + col] - lbl[col])); }
    f32x4 st[8], o[4];
#pragma unroll
    for (int t = 0; t < 8; ++t) st[t] = (f32x4){0.f, 0.f, 0.f, 0.f};
#pragma unroll
    for (int ct = 0; ct < 4; ++ct) o[ct] = (f32x4){0.f, 0.f, 0.f, 0.f};
    {
        const long tk = (long)b * SEQ;
        dma_tile(P, tk, C_QA + h * 128, 16, lds + RAW_A, wave, tid_ & 63); dma_tile(P, tk, C_FA + h * 128, 16, lds + RAW_B, wave, tid_ & 63); dma_tile(P, tk, C_IA + h * 128, 16, lds + RAW_I, wave, tid_ & 63);
    }
    for (int j = 0; j <= NCH; ++j) {
        int tidj = tid_; OPAQUE(tidj);
        const int lane = tidj & 63, q4 = lane >> 4, l15 = lane & 15;
        const size_t tk0 = (size_t)b * SEQ + 64 * j;
        WAIT_V(0); MIX_BAR();
        if (j > 0 && wave == 0) { ldsp ssq = lds + SM_SSQ + ((j - 1) & 1) * 2048; const f32x4 s0 = LDS_RD(f32x4, ssq + (lane * 8) * 4), s1 = LDS_RD(f32x4, ssq + (lane * 8 + 4) * 4);
            SSA[(tk0 - 64 + lane) * HA + h] = ((s0[0] + s0[1]) + (s0[2] + s0[3])) + ((s1[0] + s1[1]) + (s1[2] + s1[3])); }
        if (j < NCH) {
            float lf[8][2], qv[8][2], kv[8][2];
#pragma unroll
            for (int c = 0; c < 8; ++c) { const unsigned fw = LDS_RD(unsigned, lds + RAW_B + (8 * wave + c) * 256 + lane * 4), qw = LDS_RD(unsigned, lds + RAW_A + (8 * wave + c) * 256 + lane * 4);
#pragma unroll
                for (int e = 0; e < 2; ++e) { const float f = lbv[e] + (1.0f - lbv[e]) * sigm2(__builtin_bit_cast(float, e ? (fw & 0xffff0000u) : (fw << 16))); lf[c][e] = flog2(f); kv[c][e] = 1.0f - f; qv[c][e] = __builtin_bit_cast(float, e ? (qw & 0xffff0000u) : (qw << 16)); } }
#pragma unroll
            for (int c = 1; c < 8; ++c) { lf[c][0] += lf[c - 1][0]; lf[c][1] += lf[c - 1][1]; }
            LDS_WR(f32x2, lds + SM_TOT + (wave * 128 + 2 * lane) * 4, ((f32x2){lf[7][0], lf[7][1]}));
            MIX_BAR();
            {
                f32x2 off = (f32x2){0.f, 0.f}, bmid = (f32x2){0.f, 0.f}, g = (f32x2){0.f, 0.f};
#pragma unroll
                for (int w = 0; w < 8; ++w) { const f32x2 t = LDS_RD(f32x2, lds + SM_TOT + (w * 128 + 2 * lane) * 4); if (w < wave) off += t; if (w < 4) bmid += t; g += t; }
                unsigned kr[8];
#pragma unroll
                for (int c = 0; c < 8; ++c) { float qr[2], kk[2];
#pragma unroll
                    for (int e = 0; e < 2; ++e) { const float t1 = lf[c][e] + off[e] - bmid[e]; qr[e] = qv[c][e] * fexp2(t1); kk[e] = kv[c][e] * fexp2(-t1); }
                    LDS_WR(unsigned, lds + MX_QR + (8 * wave + c) * MS + lane * 4, cvt_pk_bf16(qr[0], qr[1]));
                    kr[c] = cvt_pk_bf16(kk[0], kk[1]);
                    LDS_WR(unsigned, lds + MX_KR + (8 * wave + c) * MS + lane * 4, kr[c]); }
                if (wave == 0) { LDS_WR(f32x2, lds + SM_BME + lane * 8, ((f32x2){fexp2(bmid[0]), fexp2(bmid[1])})); LDS_WR(f32x2, lds + SM_EG + lane * 8, ((f32x2){fexp2(g[0]), fexp2(g[1])}));
                    LDS_WR(f32x2, lds + SM_EGM + lane * 8, ((f32x2){fexp2(g[0] - bmid[0]), fexp2(g[1] - bmid[1])})); }
            }
        }
        MIX_BAR();
        if (j > 0) {
#pragma unroll
            for (int ct = 0; ct < 4; ++ct) *(u32x2*)(OA + (tk0 - 64 + 16 * ct + l15) * DA + h * 128 + 16 * wave + 4 * q4) = pack4(o[ct]);
        }
        if (j == NCH) break;
        if (j + 1 < NCH) { const long tk = (long)tk0 + 64;
            dma_tile(P, tk, C_QA + h * 128, 16, lds + RAW_A, wave, lane); dma_tile(P, tk, C_FA + h * 128, 16, lds + RAW_B, wave, lane); dma_tile(P, tk, C_IA + h * 128, 16, lds + RAW_I + ((j + 1) & 1) * 16384, wave, lane); }
        {
            const int ct = wave >> 1, st0 = 2 * (wave & 1);
            f32x4 sc[2] = {(f32x4){0.f, 0.f, 0.f, 0.f}, (f32x4){0.f, 0.f, 0.f, 0.f}};
#pragma unroll
            for (int ks = 0; ks < 4; ++ks) { const bf16x8 qf = frag16(lds + MX_QR, MS, 16 * ct, ks, lane);
#pragma unroll
                for (int n = 0; n < 2; ++n) { const bf16x8 kf_ = frag16(lds + MX_KR, MS, 16 * (st0 + n), ks, lane); sc[n] = MFMA16(kf_, qf, sc[n]); } }
#pragma unroll
            for (int n = 0; n < 2; ++n) { const int c = 16 * ct + l15, s0_ = 16 * (st0 + n) + 4 * q4; f32x4 v = sc[n];
#pragma unroll
                for (int r = 0; r < 4; ++r) v[r] = (s0_ + r <= c) ? v[r] : 0.f;
                LDS_WR(u32x2, lds + MX_PS + c * MS64 + s0_ * 2, pack4(v)); }
        }
        MIX_BAR();
        {
            ldsp rawi = lds + RAW_I + (j & 1) * 16384;
            bf16x8 bv[2];
#pragma unroll
            for (int ks = 0; ks < 2; ++ks) bv[ks] = frag_tr(rawi, 16 * wave, ks, lane);
#pragma unroll
            for (int ct = 0; ct < 4; ++ct) o[ct] = (f32x4){0.f, 0.f, 0.f, 0.f};
#pragma unroll
            for (int ks = 0; ks < 2; ++ks)
#pragma unroll
                for (int ct = 0; ct < 4; ++ct) { const bf16x8 pf = frag16(lds + MX_PS, MS64, 16 * ct, ks, lane); o[ct] = MFMA16(bv[ks], pf, o[ct]); }
#pragma unroll
            for (int ks = 0; ks < 4; ++ks) {
                const f32x4 e0 = LDS_RD(f32x4, lds + SM_BME + (32 * ks + 4 * q4) * 4), e1 = LDS_RD(f32x4, lds + SM_BME + (32 * ks + 16 + 4 * q4) * 4);
                u32x4 w; const f32x4 a0 = st[2 * ks] * e0, a1 = st[2 * ks + 1] * e1; w.x = cvt_pk_bf16(a0[0], a0[1]); w.y = cvt_pk_bf16(a0[2], a0[3]); w.z = cvt_pk_bf16(a1[0], a1[1]); w.w = cvt_pk_bf16(a1[2], a1[3]);
                const bf16x8 sf = __builtin_bit_cast(bf16x8, w);
#pragma unroll
                for (int ct = 0; ct < 4; ++ct) { const bf16x8 qf = frag8x2(lds + MX_QR, MS, 16 * ct, ks, lane); o[ct] = MFMA16(sf, qf, o[ct]); } }
#pragma unroll
            for (int t = 0; t < 8; ++t) {
                f32x4 u = (f32x4){0.f, 0.f, 0.f, 0.f};
#pragma unroll
                for (int ks = 0; ks < 2; ++ks) { const bf16x8 a = frag_tr(lds + MX_KR, 16 * t, ks, lane, MS); u = MFMA16(a, bv[ks], u); }
                const f32x4 eg = LDS_RD(f32x4, lds + SM_EG + (16 * t + 4 * q4) * 4), egm = LDS_RD(f32x4, lds + SM_EGM + (16 * t + 4 * q4) * 4); st[t] = eg * st[t] + egm * u; }
            ldsp ssq = lds + SM_SSQ + (j & 1) * 2048;
#pragma unroll
            for (int ct = 0; ct < 4; ++ct) { float s = (o[ct][0] * o[ct][0] + o[ct][1] * o[ct][1]) + (o[ct][2] * o[ct][2] + o[ct][3] * o[ct][3]); s += __shfl_xor(s, 16); s += __shfl_xor(s, 32);
                LDS_WR(float, ssq + ((16 * ct + l15) * 8 + wave) * 4, s); }
        }
    }
}

DEV float scan_add(float v, int lane) {
#pragma unroll
    for (int o = 1; o < 64; o <<= 1) { const float t = __shfl_up(v, o); if (lane >= o) v += t; }
    return v;
}
DEV float scan_max(float v, int lane) {
#pragma unroll
    for (int o = 1; o < 64; o <<= 1) { const float t = __shfl_up(v, o); if (lane >= o) v = fmaxf(v, t); }
    return v;
}

DEV void mixer_b_job(const Args& args, ldsp lds, int b, int h, int half, int tid_) {
    const int wave = RFL(tid_ >> 6);
    const int vbase = h * 256 + 128 * half;
    const bf16* P = (const bf16*)(args.ws + WS_P);
    bf16* OB = (bf16*)(args.ws + WS_OAB) + (size_t)M * DA;
    const float* SG = (const float*)(args.ws + WS_SG);
    float* SSB = (float*)(args.ws + WS_SSB);
    const float* cw = args.in[4]; const float* cb = args.in[5];
    if (tid_ < 128) { const int col = h * 128 + tid_;
#pragma unroll
        for (int k = 0; k < 4; ++k) { LDS_WR(float, lds + SM_CW + (k * 128 + tid_) * 4, cw[k * (2 * DQK) + col]); LDS_WR(float, lds + SM_CW + ((4 + k) * 128 + tid_) * 4, cw[k * (2 * DQK) + DQK + col]); }
        LDS_WR(float, lds + SM_CW + (8 * 128 + tid_) * 4, cb[col]); LDS_WR(float, lds + SM_CW + (9 * 128 + tid_) * 4, cb[DQK + col]); }
    const float big = args.in[6][h], bfg = args.in[7][h];
    f32x4 st[8], hv[4];
#pragma unroll
    for (int t = 0; t < 8; ++t) st[t] = (f32x4){0.f, 0.f, 0.f, 0.f};
#pragma unroll
    for (int ct = 0; ct < 4; ++ct) hv[ct] = (f32x4){0.f, 0.f, 0.f, 0.f};
    float mcar = 0.f;
    if (wave < 2) LDS_WR(float, lds + SM_NV + tid_ * 4, 0.f);
    {
        const long tk = (long)b * SEQ;
        dma_tile(P, tk - 3, C_QB + h * 128, 17, lds + RAW_A, wave, tid_ & 63); dma_tile(P, tk - 3, C_KB + h * 128, 17, lds + RAW_B, wave, tid_ & 63); dma_tile(P, tk, C_VB + vbase, 16, lds + RAW_I, wave, tid_ & 63);
    }
    for (int j = 0; j <= NCH; ++j) {
        const size_t tk0 = (size_t)b * SEQ + 64 * j;
        int tidj = tid_; OPAQUE(tidj);
        const int tid = tidj, lane = tidj & 63, q4 = lane >> 4, l15 = lane & 15;
        WAIT_V(0); MIX_BAR();
        if (j > 0 && wave == 0) { ldsp ssq = lds + SM_SSQ + ((j - 1) & 1) * 2048; const f32x4 s0 = LDS_RD(f32x4, ssq + (lane * 8) * 4), s1 = LDS_RD(f32x4, ssq + (lane * 8 + 4) * 4);
            SSB[(tk0 - 64 + lane) * (2 * HB) + 2 * h + half] = ((s0[0] + s0[1]) + (s0[2] + s0[3])) + ((s1[0] + s1[1]) + (s1[2] + s1[3])); }
        float kf[8][2], decay = 0.f;
        if (j < NCH) {
            f32x2 wq[4], wk[4];
#pragma unroll
            for (int k = 0; k < 4; ++k) { wq[k] = LDS_RD(f32x2, lds + SM_CW + (k * 128 + 2 * lane) * 4); wk[k] = LDS_RD(f32x2, lds + SM_CW + ((4 + k) * 128 + 2 * lane) * 4); }
            const f32x2 bq = LDS_RD(f32x2, lds + SM_CW + (8 * 128 + 2 * lane) * 4), bk = LDS_RD(f32x2, lds + SM_CW + (9 * 128 + 2 * lane) * 4);
            unsigned uq[11], uk[11];
#pragma unroll
            for (int i = 0; i < 11; ++i) { const bool neg = (64 * j + 8 * wave + i - 3) < 0;
                const unsigned a = LDS_RD(unsigned, lds + RAW_A + (8 * wave + i) * 256 + lane * 4), bb = LDS_RD(unsigned, lds + RAW_B + (8 * wave + i) * 256 + lane * 4); uq[i] = neg ? 0u : a; uk[i] = neg ? 0u : bb; }
#pragma unroll
            for (int c = 0; c < 8; ++c) { float qq[2];
#pragma unroll
                for (int e = 0; e < 2; ++e) { float yq = bq[e], yk = bk[e];
#pragma unroll
                    for (int k = 0; k < 4; ++k) { yq += wq[k][e] * __builtin_bit_cast(float, e ? (uq[c + k] & 0xffff0000u) : (uq[c + k] << 16)); yk += wk[k][e] * __builtin_bit_cast(float, e ? (uk[c + k] & 0xffff0000u) : (uk[c + k] << 16)); }
                    qq[e] = yq * sigm2(yq); kf[c][e] = yk * sigm2(yk) * 0.08838834764831845f; }
                LDS_WR(unsigned, lds + MX_QR + (8 * wave + c) * MS + lane * 4, cvt_pk_bf16(qq[0], qq[1]));
                LDS_WR(unsigned, lds + MX_KR + (8 * wave + c) * MS + lane * 4, cvt_pk_bf16(kf[c][0], kf[c][1])); }
            if (wave == 0) {
                const float fp = SG[(tk0 + lane) * 16 + HB + h] + bfg, ig = SG[(tk0 + lane) * 16 + h] + big;
                const float bc = scan_add(logsig(fp), lane), a = ig - bc, mx = fmaxf(mcar, scan_max(a, lane));
                const float g = __shfl(bc, 63), m63 = __shfl(mx, 63);
                LDS_WR(float, lds + SM_A + lane * 4, a * LOG2E); LDS_WR(float, lds + SM_MX + lane * 4, mx * LOG2E); LDS_WR(float, lds + SM_INT + lane * 4, fexp(mcar - mx));
                LDS_WR(float, lds + SM_EMT + lane * 4, fexp(-(bc + mx))); LDS_WR(float, lds + SM_WGT + lane * 4, fexp(a - m63));
                if (lane == 0) { LDS_WR(float, lds + SM_SCAL, fexp(mcar - m63)); LDS_WR(float, lds + SM_SCAL + 4, g + m63); }
            }
            MIX_BAR();
            decay = LDS_RD(float, lds + SM_SCAL);
            mcar = LDS_RD(float, lds + SM_SCAL + 4);
            {
                float na[2] = {0.f, 0.f};
#pragma unroll
                for (int c = 0; c < 8; ++c) { const float w_ = LDS_RD(float, lds + SM_WGT + (8 * wave + c) * 4); const float k0 = w_ * kf[c][0], k1 = w_ * kf[c][1]; na[0] += k0; na[1] += k1;
                    LDS_WR(unsigned, lds + MX_KW + (8 * wave + c) * MS + lane * 4, cvt_pk_bf16(k0, k1)); }
                LDS_WR(f32x2, lds + SM_NACC + (wave * 128 + 2 * lane) * 4, ((f32x2){na[0], na[1]}));
                const int c = tid >> 3, part = tid & 7; float s = 0.f;
#pragma unroll
                for (int e = 0; e < 8; ++e) { const unsigned qw = LDS_RD(unsigned, lds + MX_QR + c * MS + (16 * part + 2 * e) * 2); const f32x2 nv = LDS_RD(f32x2, lds + SM_NV + (16 * part + 2 * e) * 4);
                    s += __builtin_bit_cast(float, qw << 16) * nv[0] + __builtin_bit_cast(float, qw & 0xffff0000u) * nv[1]; }
                s += __shfl_xor(s, 1); s += __shfl_xor(s, 2); s += __shfl_xor(s, 4);
                LDS_WR(float, lds + SM_QN + c * 4, s);
            }
        }
        MIX_BAR();
        if (j > 0) {
#pragma unroll
            for (int ct = 0; ct < 4; ++ct) *(u32x2*)(OB + (tk0 - 64 + 16 * ct + l15) * DB + vbase + 16 * wave + 4 * q4) = pack4(hv[ct]);
        }
        if (j == NCH) break;
        if (j + 1 < NCH) { const long tk = (long)tk0 + 64;
            dma_tile(P, tk - 3, C_QB + h * 128, 17, lds + RAW_A, wave, lane); dma_tile(P, tk - 3, C_KB + h * 128, 17, lds + RAW_B, wave, lane); dma_tile(P, tk, C_VB + vbase, 16, lds + RAW_I + ((j + 1) & 1) * 16384, wave, lane); }
        {
            const int ct = wave >> 1, st0 = 2 * (wave & 1), c = 16 * ct + l15;
            f32x4 sc[2] = {(f32x4){0.f, 0.f, 0.f, 0.f}, (f32x4){0.f, 0.f, 0.f, 0.f}};
#pragma unroll
            for (int ks = 0; ks < 4; ++ks) { const bf16x8 qf = frag16(lds + MX_QR, MS, 16 * ct, ks, lane);
#pragma unroll
                for (int n = 0; n < 2; ++n) { const bf16x8 kf_ = frag16(lds + MX_KR, MS, 16 * (st0 + n), ks, lane); sc[n] = MFMA16(kf_, qf, sc[n]); } }
            const float mxc = LDS_RD(float, lds + SM_MX + c * 4); float rs = 0.f;
#pragma unroll
            for (int n = 0; n < 2; ++n) { const int s0_ = 16 * (st0 + n) + 4 * q4; const f32x4 as = LDS_RD(f32x4, lds + SM_A + s0_ * 4); f32x4 v;
#pragma unroll
                for (int r = 0; r < 4; ++r) { const float t = fexp2(as[r] - mxc) * sc[n][r]; v[r] = (s0_ + r <= c) ? t : 0.f; rs += v[r]; }
                LDS_WR(u32x2, lds + MX_PS + c * MS64 + s0_ * 2, pack4(v)); }
            rs += __shfl_xor(rs, 16); rs += __shfl_xor(rs, 32);
            LDS_WR(float, lds + SM_RSUM + (c * 2 + (wave & 1)) * 4, rs);
        }
        MIX_BAR();
        {
            ldsp rawv = lds + RAW_I + (j & 1) * 16384;
            bf16x8 bv[2], bs[4];
#pragma unroll
            for (int ks = 0; ks < 2; ++ks) bv[ks] = frag_tr(rawv, 16 * wave, ks, lane);
#pragma unroll
            for (int ks = 0; ks < 4; ++ks) { u32x4 w; const f32x4 a0 = st[2 * ks], a1 = st[2 * ks + 1]; w.x = cvt_pk_bf16(a0[0], a0[1]); w.y = cvt_pk_bf16(a0[2], a0[3]); w.z = cvt_pk_bf16(a1[0], a1[1]); w.w = cvt_pk_bf16(a1[2], a1[3]); bs[ks] = __builtin_bit_cast(bf16x8, w); }
#pragma unroll
            for (int ct = 0; ct < 4; ++ct) {
                f32x4 a1 = (f32x4){0.f, 0.f, 0.f, 0.f}, a2 = (f32x4){0.f, 0.f, 0.f, 0.f};
#pragma unroll
                for (int ks = 0; ks < 2; ++ks) { const bf16x8 pf = frag16(lds + MX_PS, MS64, 16 * ct, ks, lane); a2 = MFMA16(bv[ks], pf, a2); }
#pragma unroll
                for (int ks = 0; ks < 4; ++ks) { const bf16x8 qf = frag8x2(lds + MX_QR, MS, 16 * ct, ks, lane); a1 = MFMA16(bs[ks], qf, a1); }
                const int c = 16 * ct + l15; const float inter = LDS_RD(float, lds + SM_INT + c * 4); const f32x2 rsm = LDS_RD(f32x2, lds + SM_RSUM + (c * 2) * 4);
                const float den = inter * LDS_RD(float, lds + SM_QN + c * 4) + (rsm[0] + rsm[1]);
                const float rden = frcp(fmaxf(fabsf(den), LDS_RD(float, lds + SM_EMT + c * 4)));
                hv[ct] = (inter * a1 + a2) * rden;
            }
#pragma unroll
            for (int t = 0; t < 8; ++t) {
                f32x4 u = (f32x4){0.f, 0.f, 0.f, 0.f};
#pragma unroll
                for (int ks = 0; ks < 2; ++ks) { const bf16x8 a = frag_tr(lds + MX_KW, 16 * t, ks, lane, MS); u = MFMA16(a, bv[ks], u); }
                st[t] = decay * st[t] + u;
            }
            if (wave < 2) { float nn = decay * LDS_RD(float, lds + SM_NV + tid * 4);
#pragma unroll
                for (int w = 0; w < 8; ++w) nn += LDS_RD(float, lds + SM_NACC + (w * 128 + tid) * 4);
                LDS_WR(float, lds + SM_NV + tid * 4, nn); }
            ldsp ssq = lds + SM_SSQ + (j & 1) * 2048;
#pragma unroll
            for (int ct = 0; ct < 4; ++ct) { float s = (hv[ct][0] * hv[ct][0] + hv[ct][1] * hv[ct][1]) + (hv[ct][2] * hv[ct][2] + hv[ct][3] * hv[ct][3]); s += __shfl_xor(s, 16); s += __shfl_xor(s, 32);
                LDS_WR(float, ssq + ((16 * ct + l15) * 8 + wave) * 4, s); }
        }
    }
}

__global__ void __launch_bounds__(NTHREADS, 2) fwd_kernel(Args args) {
#ifndef EMU
    extern __shared__ __attribute__((aligned(16))) unsigned char lds_raw[];
    ldsp lds = (ldsp)lds_raw;
#else
    ldsp lds = emu_lds;
#endif
    const int tid = threadIdx.x, lane = tid & 63, wave = RFL(tid >> 6);
    const int G = gridDim.x, bx = blockIdx.x;
    const int vcu = (G % 8 == 0) ? (bx % 8) * (G / 8) + bx / 8 : bx;
    unsigned char* ws = args.ws;
#ifndef EMU
    for (int u = tid; u < (LDS_BYTES - LDSCTL_OFF) / 4; u += NTHREADS) ((LAS unsigned*)(lds + LDSCTL_OFF))[u] = 0u;
    __syncthreads();
    XcdBarrier bar = xcd_barrier_post((unsigned*)(ws + WS_CTL) + CW_BAR, (volatile LAS unsigned*)(lds + MISC_OFF) + 8);
#define GRID_BAR() xcd_barrier(bar)
#else
#define GRID_BAR()
#endif
    const int lo = args.ph_lo, hi = args.ph_hi;
#ifndef PROBE_REP_P1
#define PROBE_REP_P1 1
#endif
#ifndef PROBE_REP_P2
#define PROBE_REP_P2 1
#endif
#ifndef PHASE_MASK
#define PHASE_MASK 127
#endif
#define IN(k) (((PHASE_MASK >> (k)) & 1) && lo <= (k) && (k) < hi)
#define BOTH(k) (IN(k) && IN((k) + 1))
    const float* x = args.in[0];
    bf16* W1T = (bf16*)(ws + WS_W1T); bf16* WUT = (bf16*)(ws + WS_WUT); bf16* WOT = (bf16*)(ws + WS_WOT);
    bf16* HBUF = (bf16*)(ws + WS_HB); bf16* PB = (bf16*)(ws + WS_P); float* SG = (float*)(ws + WS_SG); bf16* OAB = (bf16*)(ws + WS_OAB); float* RSS = (float*)(ws + WS_RSS);

    if (IN(0)) {
        ldsp scr = lds + wave * 16384;
        const int gw = vcu * NWAVES + wave, NGW = G * NWAVES;
        constexpr int RB1 = (NP + NSG + 31) / 32, I_1 = (D / 64) * RB1, I_U = (DA / 64) * (D / 32), I_O = (D / 64) * (D / 32);
        constexpr int NITEMS = I_1 + 2 * I_U + I_O;
        for (int it = gw; it < NITEMS; it += NGW) {
            int r = it;
            if (r < I_1) { const int kb = r / RB1, rb = r % RB1, r0 = 32 * rb; int c0, nv;
                if (r0 < NPM) { c0 = r0; nv = 32; } else if (r0 < NP) { c0 = r0 + NSG; nv = 32; } else { c0 = NPM + (r0 - NP); nv = NSG - (r0 - NP) < 32 ? NSG - (r0 - NP) : 32; }
                p0_transpose_item(args.in[2], D_IN, D, W1T, 64 * kb, c0, r0, nv, scr, lane); continue; }
            r -= I_1;
            if (r < I_U) { const int kb = r / (D / 32), rb = r % (D / 32); p0_transpose_item(args.in[10], D, DA, WUT, 64 * kb, 32 * rb, 32 * rb, 32, scr, lane); continue; }
            r -= I_U;
            if (r < I_U) { const int kb = r / (D / 32), rb = r % (D / 32); p0_transpose_item(args.in[11], D, DB, WUT + (size_t)D * DA, 64 * kb, 32 * rb, 32 * rb, 32, scr, lane); continue; }
            r -= I_U;
            { const int kb = r / (D / 32), rb = r % (D / 32); p0_transpose_item(args.in[12], D, D, WOT, 64 * kb, 32 * rb, 32 * rb, 32, scr, lane); }
        }
        const float* gpre = args.in[1];
        for (int m = gw; m < M; m += NGW) {
            const f32x4* xr = (const f32x4*)(x + (size_t)m * D) + lane;
            f32x4 v[D / 256]; float s = 0.f;
#pragma unroll
            for (int jj = 0; jj < D / 256; ++jj) { v[jj] = xr[64 * jj]; s += (v[jj][0] * v[jj][0] + v[jj][1] * v[jj][1]) + (v[jj][2] * v[jj][2] + v[jj][3] * v[jj][3]); }
            const float rstd = frsq(wave_sum(s) * (1.0f / D) + EPS) ;
            u32x2* o8 = (u32x2*)(HBUF + (size_t)m * D) + lane;
#pragma unroll
            for (int jj = 0; jj < D / 256; ++jj) { const f32x4 gg = ((const f32x4*)gpre)[lane + 64 * jj]; u32x2 w; w.x = pk2(v[jj][0] * rstd * gg[0], v[jj][1] * rstd * gg[1]); w.y = pk2(v[jj][2] * rstd * gg[2], v[jj][3] * rstd * gg[3]); o8[64 * jj] = w; }
        }
        if (BOTH(0)) GRID_BAR();
    }

    if (IN(1)) {
        {
            const int gw = vcu * NWAVES + wave, NGW = G * NWAVES, l15 = lane & 15, q4 = lane >> 4;
            const int wrow = NP + (l15 < NSG ? l15 : NSG - 1);
            for (int t = gw; t < M / 16; t += NGW) {
                f32x4 acc = (f32x4){0.f, 0.f, 0.f, 0.f};
                const bf16* ap = HBUF + (size_t)(16 * t + l15) * D + 8 * q4; const bf16* bp = W1T + (size_t)wrow * D + 8 * q4;
#pragma unroll 8
                for (int ks = 0; ks < D / 32; ++ks) { const bf16x8 a = *(const bf16x8*)(ap + 32 * ks), bb = *(const bf16x8*)(bp + 32 * ks); acc = MFMA16(a, bb, acc); }
#pragma unroll
                for (int r = 0; r < 4; ++r) SG[(size_t)(16 * t + 4 * q4 + r) * 16 + l15] = acc[r];
            }
        }
        pg8::Gemm g{HBUF, W1T, M, NP, D}; pg8::StaticOrder S; S.init(M, NP, G, bx);
        EpiP E{PB};
        for (int rep = 0; rep < PROBE_REP_P1; ++rep) pg8::gemm_phase<EpiP, pg8::StaticOrder>(lds, g, S, E);
        if (BOTH(1)) GRID_BAR();
    }

    if (IN(2)) {
        constexpr int NJA = NB * HA, NJB = NB * HB * 2;
        for (int rep = 0; rep < PROBE_REP_P2; ++rep)
        for (int job = bx; job < NJA + NJB; job += G) {
#ifndef NO_MIX_A
            if (job < NJA) mixer_a_job(args, lds, job / HA, job % HA, tid);
#endif
#ifndef NO_MIX_B
            if (job >= NJA) { const int jb = job - NJA; mixer_b_job(args, lds, jb / (2 * HB), (jb >> 1) % HB, jb & 1, tid); }
#endif
            BLOCK_BAR();
        }
        if (BOTH(2)) GRID_BAR();
    }

    if (IN(3)) {
        const int gw = vcu * NWAVES + wave, NGW = G * NWAVES;
        const float* SSA = (const float*)(ws + WS_SSA); const float* SSB = (const float*)(ws + WS_SSB);
        static_assert(DA % 512 == 0 && DA == DB, "P3 tiling");
        for (int m = gw; m < M; m += NGW) {
#pragma unroll
            for (int br = 0; br < 2; ++br) {
#pragma unroll
                for (int i = 0; i < DA / 512; ++i) {
                    const int col0 = i * 512 + lane * 8;
                    float rstd;
                    if (br == 0) rstd = frsq(SSA[(size_t)m * HA + col0 / 128] * (1.0f / 128.0f) + EPS);
                    else { const int hh = col0 / 256; rstd = frsq((SSB[(size_t)m * (2 * HB) + 2 * hh] + SSB[(size_t)m * (2 * HB) + 2 * hh + 1]) * (1.0f / 256.0f) + EPS); }
                    u32x4* po = (u32x4*)(OAB + (size_t)(br * M + m) * DA + col0);
                    u32x4 w = *po; const u32x4 g8 = *(const u32x4*)(PB + (size_t)m * NP + (br ? C_OGB : C_OGA) + col0), z8 = *(const u32x4*)(PB + (size_t)m * NP + (br ? C_ZB : C_ZA) + col0);
                    const f32x4 gn0 = *(const f32x4*)(args.in[br ? 9 : 8] + col0), gn1 = *(const f32x4*)(args.in[br ? 9 : 8] + col0 + 4);
#pragma unroll
                    for (int e = 0; e < 4; ++e) { float v[2];
#pragma unroll
                        for (int k = 0; k < 2; ++k) { const float ov = __builtin_bit_cast(float, k ? (w[e] & 0xffff0000u) : (w[e] << 16)), og = __builtin_bit_cast(float, k ? (g8[e] & 0xffff0000u) : (g8[e] << 16)), z = __builtin_bit_cast(float, k ? (z8[e] & 0xffff0000u) : (z8[e] << 16));
                            const float gnv = (e < 2 ? gn0 : gn1)[(2 * e + k) & 3];
                            v[k] = ov * rstd * gnv * sigm2(og) * (z * sigm2(z)); }
                        w[e] = cvt_pk_bf16(v[0], v[1]); }
                    *po = w;
                }
            }
        }
        if (BOTH(3)) GRID_BAR();
    }
    if (IN(4)) {
        pg8::Gemm g{OAB, WUT, 2 * M, 2 * D, DA}; SchedUp S; S.so.init(M, D, G, bx);
        EpiUp E{HBUF, PB};
        pg8::gemm_phase<EpiUp, SchedUp>(lds, g, S, E);
        if (BOTH(4)) GRID_BAR();
    }

    if (IN(5)) {
        pg8::Gemm g{HBUF, WOT, M, D, D}; pg8::StaticOrder S; S.init(M, D, G, bx);
        EpiOut E{args.out, RSS};
        pg8::gemm_phase<EpiOut, pg8::StaticOrder>(lds, g, S, E);
        if (BOTH(5)) GRID_BAR();
    }

    if (IN(6)) {
        const int gw = vcu * NWAVES + wave, NGW = G * NWAVES;
        const float* gpost = args.in[13];
        for (int m = gw; m < M; m += NGW) {
            const float ss = wave_sum(lane < NRS ? RSS[(size_t)m * NRS + lane] : 0.f);
            const float rstd = frsq(ss * (1.0f / D) + EPS);
            const f32x4* xr = (const f32x4*)(x + (size_t)m * D) + lane; f32x4* orow = (f32x4*)(args.out + (size_t)m * D) + lane;
#pragma unroll
            for (int jj = 0; jj < D / 256; ++jj) { const f32x4 xv = xr[64 * jj], ov = orow[64 * jj], gg = ((const f32x4*)gpost)[lane + 64 * jj]; orow[64 * jj] = xv + ov * rstd * gg; }
        }
    }
#undef IN
#undef BOTH
}

#ifndef EMU
extern "C" void kernel_launch(void* const* d_in, const int* in_sizes, int n_in, void* d_out, int out_size, void* d_ws, size_t ws_size, hipStream_t stream) {
    static int grid = 0;
    if (grid == 0) {
        if (n_in != 14 || out_size != M * D || ws_size < WS_END) { fprintf(stderr, "kernel_launch: unexpected shapes (n_in %d, out %d, ws %zu < %zu)\n", n_in, out_size, ws_size, (size_t)WS_END); grid = -1; return; }
        int dev = 0, cus = 0, per_cu = 0;
        if (hipGetDevice(&dev) != hipSuccess || hipDeviceGetAttribute(&cus, hipDeviceAttributeMultiprocessorCount, dev) != hipSuccess) { grid = -1; return; }
        if (hipFuncSetAttribute((const void*)fwd_kernel, hipFuncAttributeMaxDynamicSharedMemorySize, LDS_BYTES) != hipSuccess) { fprintf(stderr, "kernel_launch: hipFuncSetAttribute failed\n"); grid = -1; return; }
        if (hipOccupancyMaxActiveBlocksPerMultiprocessor(&per_cu, (const void*)fwd_kernel, NTHREADS, LDS_BYTES) != hipSuccess || per_cu < 1) { fprintf(stderr, "kernel_launch: occupancy query says %d\n", per_cu); }
        (void)hipGetLastError();
        grid = cus;
    }
    if (grid < 0) return;
    (void)hipMemsetAsync((char*)d_ws + WS_CTL, 0, CTL_ZERO_BYTES, stream);
    Args a{};
    for (int i = 0; i < 14; ++i) a.in[i] = (const float*)d_in[i];
    a.out = (float*)d_out; a.ws = (unsigned char*)d_ws; a.ph_lo = 0; a.ph_hi = 7;
    hipLaunchKernelGGL(fwd_kernel, dim3(grid), dim3(NTHREADS), LDS_BYTES, stream, a);
}
#endif
```

```cpp
#ifndef EMU
#include <hip/hip_runtime.h>
#include <cstdio>
#include <cstdint>
#define LAS __attribute__((address_space(3)))
#define GAS __attribute__((address_space(1)))
typedef short bf16x8 __attribute__((ext_vector_type(8)));
typedef short bf16x4 __attribute__((ext_vector_type(4)));
typedef float f32x4 __attribute__((ext_vector_type(4)));
#define DEV __device__ __forceinline__
#define LDS_RD(T, p) (*(const LAS T*)(p))
#define LDS_WR(T, p, v) (*(LAS T*)(p) = (v))
#define WAVE_SYNC() asm volatile("s_waitcnt lgkmcnt(0)" ::: "memory")
#define BLOCK_BAR() __syncthreads()
#define RAW_BAR() __builtin_amdgcn_s_barrier()
#define WAIT_V(n) asm volatile("s_waitcnt vmcnt(" #n ")" ::: "memory")
#define WAIT_L(n) asm volatile("s_waitcnt lgkmcnt(" #n ")" ::: "memory")
#define SCHED_BAR() __builtin_amdgcn_sched_barrier(0)
#define SETPRIO(n) __builtin_amdgcn_s_setprio(n)
#define GLDS16(g, l) __builtin_amdgcn_global_load_lds((const unsigned*)(g), (LAS unsigned*)(l), 16, 0, 0)
#define MFMA16(a, b, c) __builtin_amdgcn_mfma_f32_16x16x32_bf16(a, b, c, 0, 0, 0)
#define RFL(x) __builtin_amdgcn_readfirstlane(x)
#define COMPILER_FENCE() asm volatile("" ::: "memory")
#define OPAQUE(x) asm volatile("" : "+v"(x))
DEV float fexp2(float x) { return __builtin_amdgcn_exp2f(x); }
DEV float flog2(float x) { return __builtin_amdgcn_logf(x); }
DEV float frcp(float x) { return __builtin_amdgcn_rcpf(x); }
DEV float frsq(float x) { return __builtin_amdgcn_rsqf(x); }
DEV unsigned cvt_pk_bf16(float lo, float hi) { unsigned r; asm volatile("v_cvt_pk_bf16_f32 %0, %1, %2" : "=v"(r) : "v"(lo), "v"(hi)); return r; }
typedef short v4i16_t __attribute__((ext_vector_type(4)));
DEV bf16x4 lds_tr16(LAS unsigned char* p) { return __builtin_bit_cast(bf16x4, __builtin_amdgcn_ds_read_tr16_b64_v4i16((LAS v4i16_t*)p)); }
#define MIX_BAR() do { asm volatile("s_waitcnt lgkmcnt(0)" ::: "memory"); __builtin_amdgcn_s_barrier(); asm volatile("" ::: "memory"); } while (0)
DEV void glds16_asm(const void* gsrc, unsigned lds_dst) { unsigned keep;
    asm volatile("s_mov_b32 %0, m0\n\ts_mov_b32 m0, %2\n\ts_nop 0\n\tglobal_load_lds_dwordx4 %1, off\n\ts_mov_b32 m0, %0" : "=&s"(keep) : "v"(gsrc), "s"(lds_dst) : "memory"); }
#define GLDS16X(g, l) glds16_asm((const void*)(g), (unsigned)RFL((int)(unsigned)(__UINTPTR_TYPE__)(l)))
typedef __amdgpu_buffer_rsrc_t rsrc_t;
DEV rsrc_t make_rsrc(const void* p, unsigned bytes) { return __builtin_amdgcn_make_buffer_rsrc((void*)p, (short)0, (int)bytes, 0x00020000); }
DEV unsigned short bload16(rsrc_t r, unsigned voff, unsigned soff) { return (unsigned short)__builtin_amdgcn_raw_buffer_load_b16(r, (int)voff, (int)soff, 0); }
DEV void bstore16(rsrc_t r, unsigned voff, unsigned soff, unsigned short v) { __builtin_amdgcn_raw_buffer_store_b16(v, r, (int)voff, (int)soff, 0); }
#else
#define LAS
#define GAS
#define DEV inline
#define LDS_RD(T, p) emu_lds_rd<T>((const void*)(p), #p)
#define LDS_WR(T, p, v) emu_lds_wr<T>((void*)(p), (T)(v), #p)
#define WAVE_SYNC() emu_wavesync()
#define BLOCK_BAR() emu_syncthreads()
#define RAW_BAR() emu_syncthreads()
#define WAIT_V(n)
#define WAIT_L(n)
#define SCHED_BAR()
#define SETPRIO(n)
#define GLDS16(g, l) emu_glds16((const void*)(g), (unsigned char*)(l))
#define GLDS16X(g, l) emu_glds16((const void*)(g), (unsigned char*)(l))
#define MFMA16(a, b, c) emu_mfma16(a, b, c)
#define RFL(x) (x)
#define COMPILER_FENCE()
#define OPAQUE(x)
DEV float fexp2(float x) { return exp2f(x); }
DEV float flog2(float x) { return log2f(x); }
DEV float frcp(float x) { return 1.0f / x; }
DEV float frsq(float x) { return 1.0f / sqrtf(x); }
DEV unsigned cvt_pk_bf16(float lo, float hi) { return (unsigned)emu_f2bf(lo) | ((unsigned)emu_f2bf(hi) << 16); }
#define lds_tr16(p) emu_lds_tr16((const unsigned char*)(p))
#define MIX_BAR() emu_syncthreads()
typedef unsigned char* rsrc_t;
DEV rsrc_t make_rsrc(const void* p, unsigned) { return (unsigned char*)p; }
DEV unsigned short bload16(rsrc_t r, unsigned voff, unsigned soff) { unsigned short v; memcpy(&v, r + (size_t)voff + soff, 2); return v; }
DEV void bstore16(rsrc_t r, unsigned voff, unsigned soff, unsigned short v) { memcpy(r + (size_t)voff + soff, &v, 2); }
#endif

typedef unsigned short bf16;
typedef unsigned u32x4 __attribute__((ext_vector_type(4)));
typedef unsigned u32x2 __attribute__((ext_vector_type(2)));
typedef float f32x2 __attribute__((ext_vector_type(2)));
typedef LAS unsigned char* ldsp;

#ifndef CFG_D
#define CFG_D 4096
#define CFG_B 4
#define CFG_S 4096
#define CFG_HB 8
#endif
constexpr int D = CFG_D, NB = CFG_B, SEQ = CFG_S, M = NB * SEQ;
constexpr int DA = D / 2, HA = DA / 128, DB = D / 2, HB = CFG_HB, DVB = DB / HB, DKB = 128, DQK = HB * DKB;
constexpr int NSG = 2 * HB;
constexpr int NCH = SEQ / 64;
static_assert(DVB == 256 && NSG <= 16 && SEQ % 64 == 0 && M % 256 == 0 && D % 256 == 0, "shape");
constexpr int C_QA = 0, C_FA = DA, C_IA = 2 * DA, C_OGA = 3 * DA, C_ZA = 4 * DA, C_QB = 5 * DA, C_KB = C_QB + DQK, C_VB = C_KB + DQK, C_OGB = C_VB + DB, C_ZB = C_OGB + DB;
constexpr int NPM = C_ZB + DB, C_GA = NPM, C_GB = NPM + D, NP = NPM + 2 * D, D_IN = NP + NSG;
static_assert(NPM % 256 == 0 && NP % 256 == 0, "column map");
constexpr float EPS = 1e-6f;
constexpr float LOG2E = 1.4426950408889634f, LN2 = 0.6931471805599453f;
constexpr int NRS = D / 64;
constexpr int PT_PITCH = M / 64 + 1;
DEV size_t p_off(size_t row, int col) { return ((size_t)(col >> 7) * (size_t)PT_PITCH + (row >> 6)) * 8192 + (row & 63) * 128 + (size_t)(col & 127); }

constexpr size_t al256(size_t x) { return (x + 255) & ~(size_t)255; }
constexpr size_t WS_CTL = 0, CTL_ZERO_BYTES = 65536;
constexpr size_t WS_W1T = 1u << 20;
constexpr size_t WS_WUT = al256(WS_W1T + (size_t)(NP + 16) * D * 2);
constexpr size_t WS_WOT = al256(WS_WUT + (size_t)2 * D * DA * 2);
constexpr size_t WS_HB = al256(WS_WOT + (size_t)D * D * 2);
constexpr size_t WS_P = al256(WS_HB + (size_t)M * D * 2);
constexpr size_t WS_SG = al256(WS_P + (size_t)(NP / 128) * (M / 64 + 1) * 16384 + 4096);
constexpr size_t WS_OAB = al256(WS_SG + (size_t)M * 16 * 4);
constexpr size_t WS_RSS = al256(WS_OAB + (size_t)2 * M * DA * 2);
constexpr size_t WS_SSB = al256(WS_RSS + (size_t)M * NRS * 4);
constexpr size_t WS_SSA = al256(WS_SSB + (size_t)M * HB * 2 * 4);
constexpr size_t WS_END = al256(WS_SSA + (size_t)M * HA * 4);
constexpr int CW_BAR = 1024;

constexpr int RING_BYTES = 154624, LDSCTL_OFF = RING_BYTES, MISC_OFF = LDSCTL_OFF + 320, LDS_BYTES = 155648;
constexpr int NWAVES = 8, NTHREADS = 512;

DEV unsigned f2bf(float f) { unsigned u = __builtin_bit_cast(unsigned, f); return (u + 0x7fffu + ((u >> 16) & 1u)) >> 16; }
DEV float bf2f(unsigned b) { return __builtin_bit_cast(float, b << 16); }
DEV unsigned pk2(float lo, float hi) { return f2bf(lo) | (f2bf(hi) << 16); }
DEV float fexp(float x) { return fexp2(x * LOG2E); }
DEV float flog(float x) { return flog2(x) * LN2; }
DEV float sigm(float x) { return frcp(1.0f + fexp(-x)); }
DEV float logsig(float x) { return fminf(x, 0.f) - flog(1.0f + fexp(-fabsf(x))); }
DEV float wave_sum(float v) {
#pragma unroll
    for (int o = 1; o < 64; o <<= 1) v += __shfl_xor(v, o);
    return v;
}

namespace pg8 {
constexpr int BM = 256, BK = 64, HALF = 128, HTB = HALF * BK * 2, STAGE_BYTES = 8 * HTB, NXCD = 8, WGM = 8;
DEV int lds_byte(int r, int c) { const int st = (r >> 4) * 2 + (c >> 5), rr = r & 15, cc = c & 31, ob = rr * 64 + cc * 2; return st * 1024 + (ob ^ (((ob >> 9) & 1) << 5)); }
DEV void stage_rc(int b, int& R, int& C) { const int st = b / 1024, sb = b % 1024, swz = sb ^ (((sb >> 9) & 1) << 5); R = (st >> 1) * 16 + swz / 64; C = (st & 1) * 32 + (swz % 64) / 2; }
DEV int perm32(int rho) { const int n = rho >> 4, i = rho & 15; return 8 * (i >> 2) + 4 * n + (i & 3); }
struct Unit { int pm, pn; };
struct Gemm { const bf16* A; const bf16* Bt; int M, N, K; };
struct StaticOrder {
    int nM, nN, nwg, G, c;
    DEV void init(int M_, int N_, int G_, int c_) { nM = M_ / BM; nN = N_ / BM; nwg = nM * nN; G = G_; c = c_; }
    DEV bool next(int i, Unit& u) const {
        const long L = (long)i * G + c; if (L >= nwg) return false;
        int wgid = (int)L; { const int q = nwg / NXCD, r = nwg % NXCD, xcd = wgid % NXCD, off = wgid / NXCD; wgid = (xcd < r ? xcd * (q + 1) : r * (q + 1) + (xcd - r) * q) + off; }
        const int nig = WGM * nN, gid = wgid / nig, fm = gid * WGM, gsz = (nM - fm) < WGM ? (nM - fm) : WGM;
        u.pm = fm + ((wgid % nig) % gsz); u.pn = (wgid % nig) / gsz; return true;
    }
};
template <class Epi, class Sched, bool ALIGN_EPI = false, bool SP2 = false>
DEV void gemm_phase(ldsp lds, const Gemm g, const Sched& S, const Epi& E) {
    const int tid = threadIdx.x, wid = RFL(tid >> 6), lane = tid & 63, wr = wid >> 2, wc = wid & 3, fr = lane & 15, fq = lane >> 4;
    const int K = g.K, nt = K / BK;
    unsigned voffA[2], voffB[2];
#pragma unroll
    for (int i = 0; i < 2; ++i) { int R, C; stage_rc(tid * 16 + i * 8192, R, C); const int Rb = Epi::PERM ? ((R & ~31) + perm32(R & 31)) : R;
        voffA[i] = (unsigned)(R * K + C) * 2u; voffB[i] = (unsigned)(Rb * K + C) * 2u; }
    const size_t kstep = (size_t)(BK * 2);
    const size_t hstep = (size_t)HALF * K * 2;
    const size_t tstep = 2 * hstep;
    const unsigned ldsw = (unsigned)wid * 1024u;
    const int aoff = lds_byte(wr * 64 + fr, fq * 8), boff = lds_byte(wc * 32 + fr, fq * 8);
#define PG8_SA(b, h) (((b) * 2 + (h)) * HTB)
#define PG8_SB(b, h) ((4 + (b) * 2 + (h)) * HTB)
#define PG8_STAGE(bufoff, gbase, voff) do { _Pragma("unroll") for (int _i = 0; _i < 2; ++_i) \
        GLDS16((const char*)(gbase) + (voff)[_i], lds + (bufoff) + ldsw + _i * 8192); } while (0)
#define PG8_LDA(dst, b, h) do { _Pragma("unroll") for (int m = 0; m < 4; ++m) _Pragma("unroll") for (int k = 0; k < 2; ++k) dst[m][k] = *(const LAS bf16x8*)(lds + PG8_SA(b, h) + aoff + m * 2048 + k * 1024); } while (0)
#define PG8_LDB(dst, b, h) do { _Pragma("unroll") for (int n = 0; n < 2; ++n) _Pragma("unroll") for (int k = 0; k < 2; ++k) dst[n][k] = *(const LAS bf16x8*)(lds + PG8_SB(b, h) + boff + n * 2048 + k * 1024); } while (0)
#define PG8_MMA(ai, bj, At, Bt) do { SETPRIO(1); _Pragma("unroll") for (int m = 0; m < 4; ++m) _Pragma("unroll") for (int n = 0; n < 2; ++n) _Pragma("unroll") for (int k = 0; k < 2; ++k) \
        acc[ai][bj][m][n] = MFMA16(Bt[n][k], At[m][k], acc[ai][bj][m][n]); SETPRIO(0); } while (0)
    Unit cur, nxt; int ui = 0;
    if (!S.next(0, cur)) return;
    f32x4 acc[2][2][4][2];
#pragma unroll
    for (int a = 0; a < 2; ++a)
#pragma unroll
        for (int b = 0; b < 2; ++b)
#pragma unroll
            for (int m = 0; m < 4; ++m)
#pragma unroll
                for (int n = 0; n < 2; ++n) acc[a][b][m][n] = (f32x4){0.f, 0.f, 0.f, 0.f};
    bf16x8 At[4][2], B0[2][2], B1[2][2];
    const char* cA = (const char*)g.A + (size_t)cur.pm * tstep; const char* cB = (const char*)g.Bt + (size_t)cur.pn * tstep;
    if constexpr (SP2) {
        PG8_STAGE(PG8_SB(0, 0), cB, voffB); PG8_STAGE(PG8_SB(0, 1), cB + hstep, voffB); PG8_STAGE(PG8_SA(0, 0), cA, voffA); PG8_STAGE(PG8_SA(0, 1), cA + hstep, voffA);
        if (wr == 1) RAW_BAR();
        WAIT_V(2); RAW_BAR();
        PG8_STAGE(PG8_SB(1, 0), cB + kstep, voffB); PG8_STAGE(PG8_SA(1, 0), cA + kstep, voffA); PG8_STAGE(PG8_SB(1, 1), cB + hstep + kstep, voffB);
        WAIT_V(6); RAW_BAR();
    } else {
        PG8_STAGE(PG8_SB(0, 0), cB, voffB); PG8_STAGE(PG8_SA(0, 0), cA, voffA); PG8_STAGE(PG8_SB(0, 1), cB + hstep, voffB); PG8_STAGE(PG8_SA(0, 1), cA + hstep, voffA);
        if (wr == 1) RAW_BAR();
        WAIT_V(4); RAW_BAR();
        PG8_STAGE(PG8_SB(1, 0), cB + kstep, voffB); PG8_STAGE(PG8_SA(1, 0), cA + kstep, voffA); PG8_STAGE(PG8_SB(1, 1), cB + hstep + kstep, voffB);
        WAIT_V(6); RAW_BAR();
    }
    for (;;) {
        const bool has_next = S.next(ui + 1, nxt);
        const char* nA = has_next ? (const char*)g.A + (size_t)nxt.pm * tstep : cA; const char* nB = has_next ? (const char*)g.Bt + (size_t)nxt.pn * tstep : cB;
        for (int t = 0; t < nt; t += 2) {
            const bool last = (t == nt - 2);
            const char* a1 = cA + (size_t)(t + 1) * kstep;
            const char* a2 = last ? nA : cA + (size_t)(t + 2) * kstep; const char* b2 = last ? nB : cB + (size_t)(t + 2) * kstep;
            const char* a3 = a2 + kstep; const char* b3 = b2 + kstep;
            if constexpr (SP2) {
            PG8_LDB(B0, 0, 0); PG8_LDB(B1, 0, 1); SCHED_BAR(); PG8_LDA(At, 0, 0); PG8_STAGE(PG8_SA(1, 1), a1 + hstep, voffA);
            WAIT_V(8); WAIT_L(0); RAW_BAR(); PG8_MMA(0, 0, At, B0); PG8_MMA(0, 1, At, B1); RAW_BAR(); SCHED_BAR();
            PG8_LDA(At, 0, 1); PG8_STAGE(PG8_SB(0, 0), b2, voffB); PG8_STAGE(PG8_SB(0, 1), b2 + hstep, voffB); PG8_STAGE(PG8_SA(0, 0), a2, voffA);
            WAIT_V(8); WAIT_L(0); RAW_BAR(); PG8_MMA(1, 0, At, B0); PG8_MMA(1, 1, At, B1); RAW_BAR(); SCHED_BAR();
            PG8_LDB(B0, 1, 0); PG8_LDB(B1, 1, 1); SCHED_BAR(); PG8_LDA(At, 1, 0); PG8_STAGE(PG8_SA(0, 1), a2 + hstep, voffA);
            WAIT_V(8); WAIT_L(0); RAW_BAR(); PG8_MMA(0, 0, At, B0); PG8_MMA(0, 1, At, B1); RAW_BAR(); SCHED_BAR();
            PG8_LDA(At, 1, 1); PG8_STAGE(PG8_SB(1, 0), b3, voffB); PG8_STAGE(PG8_SB(1, 1), b3 + hstep, voffB); PG8_STAGE(PG8_SA(1, 0), a3, voffA);
            WAIT_V(8); WAIT_L(0); RAW_BAR(); PG8_MMA(1, 0, At, B0); PG8_MMA(1, 1, At, B1); RAW_BAR(); SCHED_BAR();
            } else {
            PG8_LDB(B0, 0, 0); SCHED_BAR(); PG8_LDA(At, 0, 0); PG8_STAGE(PG8_SA(1, 1), a1 + hstep, voffA);
            WAIT_L(8); RAW_BAR(); WAIT_L(0); PG8_MMA(0, 0, At, B0); RAW_BAR(); SCHED_BAR();
            PG8_LDB(B1, 0, 1); PG8_STAGE(PG8_SB(0, 0), b2, voffB);
            RAW_BAR(); WAIT_L(0); PG8_MMA(0, 1, At, B1); RAW_BAR();
            PG8_LDA(At, 0, 1); PG8_STAGE(PG8_SA(0, 0), a2, voffA);
            RAW_BAR(); WAIT_L(0); PG8_MMA(1, 0, At, B0); RAW_BAR(); SCHED_BAR();
            PG8_STAGE(PG8_SB(0, 1), b2 + hstep, voffB);
            WAIT_V(6); RAW_BAR(); PG8_MMA(1, 1, At, B1); RAW_BAR();
            PG8_LDB(B0, 1, 0); SCHED_BAR(); PG8_LDA(At, 1, 0); PG8_STAGE(PG8_SA(0, 1), a2 + hstep, voffA);
            WAIT_L(8); RAW_BAR(); WAIT_L(0); PG8_MMA(0, 0, At, B0); RAW_BAR(); SCHED_BAR();
            PG8_LDB(B1, 1, 1); PG8_STAGE(PG8_SB(1, 0), b3, voffB);
            RAW_BAR(); WAIT_L(0); PG8_MMA(0, 1, At, B1); RAW_BAR();
            PG8_LDA(At, 1, 1); PG8_STAGE(PG8_SA(1, 0), a3, voffA);
            RAW_BAR(); WAIT_L(0); PG8_MMA(1, 0, At, B0); RAW_BAR(); SCHED_BAR();
            PG8_STAGE(PG8_SB(1, 1), b3 + hstep, voffB);
            WAIT_V(6); RAW_BAR(); PG8_MMA(1, 1, At, B1); RAW_BAR();
            }
        }
        if constexpr (ALIGN_EPI) { if (wr == 0) RAW_BAR(); }
        E(acc, cur, wr, wc, fr, fq);
        if (!has_next) break;
#pragma unroll
        for (int a = 0; a < 2; ++a)
#pragma unroll
            for (int b = 0; b < 2; ++b)
#pragma unroll
                for (int m = 0; m < 4; ++m)
#pragma unroll
                    for (int n = 0; n < 2; ++n) acc[a][b][m][n] = (f32x4){0.f, 0.f, 0.f, 0.f};
        cur = nxt; cA = nA; cB = nB; ++ui;
        if constexpr (ALIGN_EPI) { if (wr == 1) RAW_BAR(); }
    }
    WAIT_V(0);
    if constexpr (!ALIGN_EPI) { if (wr == 0) RAW_BAR(); }
    RAW_BAR();
#undef PG8_SA
#undef PG8_SB
#undef PG8_STAGE
#undef PG8_LDA
#undef PG8_LDB
#undef PG8_MMA
}
}

struct EpiP {
    static constexpr bool PERM = true;
    bf16* O;
    DEV void operator()(const f32x4 (&acc)[2][2][4][2], const pg8::Unit& u, int wr, int wc, int fr, int fq) const {
        const int row0 = u.pm * 256 + wr * 64 + fr, col0 = u.pn * 256 + wc * 32 + 8 * fq;
#pragma unroll
        for (int ai = 0; ai < 2; ++ai)
#pragma unroll
            for (int m = 0; m < 4; ++m) { const size_t row = (size_t)(row0 + ai * 128 + m * 16);
#pragma unroll
                for (int bj = 0; bj < 2; ++bj) { const f32x4 v0 = acc[ai][bj][m][0], v1 = acc[ai][bj][m][1];
                    u32x4 w; w.x = cvt_pk_bf16(v0[0], v0[1]); w.y = cvt_pk_bf16(v0[2], v0[3]); w.z = cvt_pk_bf16(v1[0], v1[1]); w.w = cvt_pk_bf16(v1[2], v1[3]);
                    *(u32x4*)(O + p_off(row, col0 + bj * 128)) = w; } }
    }
};
struct SchedUp {
    pg8::StaticOrder so;
    DEV bool next(int i, pg8::Unit& u) const { if (!so.next(i >> 1, u)) return false; if (i & 1) { u.pm += M / 256; u.pn += D / 256; } return true; }
};
struct EpiUp {
    static constexpr bool PERM = true;
    bf16* Y; const bf16* P;
    DEV void operator()(const f32x4 (&acc)[2][2][4][2], const pg8::Unit& u, int wr, int wc, int fr, int fq) const {
        const int br = u.pm >= M / 256 ? 1 : 0, pm = u.pm - br * (M / 256), pn = u.pn - br * (D / 256);
        const int row0 = pm * 256 + wr * 64 + fr, col0 = pn * 256 + wc * 32 + 8 * fq, gcol = (br ? C_GB : C_GA) + col0;
#pragma unroll
        for (int ai = 0; ai < 2; ++ai)
#pragma unroll
            for (int m = 0; m < 4; ++m) { const size_t row = (size_t)(row0 + ai * 128 + m * 16);
#pragma unroll
                for (int bj = 0; bj < 2; ++bj) {
                    const u32x4 g8 = *(const u32x4*)(P + p_off(row, gcol + bj * 128));
                    bf16* yp = Y + row * D + col0 + bj * 128;
                    u32x4 y8 = (u32x4){0u, 0u, 0u, 0u}; if (br) y8 = *(const u32x4*)yp;
                    const f32x4 v0 = acc[ai][bj][m][0], v1 = acc[ai][bj][m][1];
                    float o[8];
#pragma unroll
                    for (int k = 0; k < 8; ++k) { const unsigned gw = g8[k >> 1], yw = y8[k >> 1]; const float gv = bf2f((k & 1) ? (gw >> 16) : (gw & 0xffffu)), yv = bf2f((k & 1) ? (yw >> 16) : (yw & 0xffffu));
                        const float a = k < 4 ? v0[k & 3] : v1[k & 3]; o[k] = yv + sigm(gv) * a; }
                    u32x4 w; w.x = cvt_pk_bf16(o[0], o[1]); w.y = cvt_pk_bf16(o[2], o[3]); w.z = cvt_pk_bf16(o[4], o[5]); w.w = cvt_pk_bf16(o[6], o[7]);
                    *(u32x4*)yp = w; } }
    }
};
struct EpiOut {
    static constexpr bool PERM = false;
    float* C; float* RSS;
    DEV void operator()(const f32x4 (&acc)[2][2][4][2], const pg8::Unit& u, int wr, int wc, int fr, int fq) const {
        const int row0 = u.pm * 256 + wr * 64 + fr, col0 = u.pn * 256 + wc * 32 + 4 * fq;
#pragma unroll
        for (int ai = 0; ai < 2; ++ai)
#pragma unroll
            for (int m = 0; m < 4; ++m) { const size_t row = (size_t)(row0 + ai * 128 + m * 16); float* rowp = C + row * D + col0; float ss = 0.f;
#pragma unroll
                for (int bj = 0; bj < 2; ++bj)
#pragma unroll
                    for (int n = 0; n < 2; ++n) { const f32x4 v = acc[ai][bj][m][n]; *(f32x4*)(rowp + bj * 128 + n * 16) = v; ss += (v[0] * v[0] + v[1] * v[1]) + (v[2] * v[2] + v[3] * v[3]); }
                ss += __shfl_xor(ss, 16); ss += __shfl_xor(ss, 32);
                if (fq == 0) RSS[row * NRS + u.pn * 4 + wc] = ss; }
    }
};

#ifndef EMU
typedef GAS unsigned gu32;
#define RLX_AGENT __ATOMIC_RELAXED, __HIP_MEMORY_SCOPE_AGENT
#define XB_TMO      128
#define XB_XCNT(j)  (256  + 64 * (j))
#define XB_XSUB(j)  (1280 + 64 * (j))
#define XB_XGEN(j)  (2304 + 64 * (j))
#define XB_TOP      3328
#define XB_TOPGEN   3392
#define XCD_BAR_WORDS 3456
#define XB_SPIN_CAP (1u << 22)
__device__ __forceinline__ unsigned xb_ld(unsigned* p)              { return __hip_atomic_load(p, __ATOMIC_RELAXED, __HIP_MEMORY_SCOPE_AGENT); }
__device__ __forceinline__ unsigned xb_add(unsigned* p, unsigned v) { return __hip_atomic_fetch_add(p, v, __ATOMIC_RELAXED, __HIP_MEMORY_SCOPE_AGENT); }
__device__ __forceinline__ unsigned xb_xcc_id() { return (unsigned)__builtin_amdgcn_s_getreg((3 << 11) | 20) & 0xFu; }
#define XB_SPIN(cond, bar) do { unsigned _sp = 0; while (cond) { __builtin_amdgcn_s_sleep(1); \
    if ((++_sp & 255u) == 0u) { if (xb_ld(&(bar)[XB_TMO])) break; if (_sp > XB_SPIN_CAP) { atomicAdd(&(bar)[XB_TMO], 1u); break; } } } } while (0)
struct XcdBarrier { unsigned* bar; unsigned x; volatile LAS unsigned* st; };
__device__ __forceinline__ XcdBarrier xcd_barrier_post(unsigned* bar, volatile LAS unsigned* st) {
    XcdBarrier b; b.bar = bar; b.x = xb_xcc_id(); b.st = st;
    if (threadIdx.x == 0) (void)xb_add(&bar[XB_XCNT(b.x)], 1u);
    return b;
}
__device__ __forceinline__ void xcd_barrier_complete(unsigned* bar, unsigned x, unsigned& nloc, unsigned& nx) {
    const unsigned G = gridDim.x * gridDim.y * gridDim.z;
    unsigned sum, cnt, mine, sp = 0u;
    for (;;) {
        sum = 0u; cnt = 0u; mine = 0u;
#pragma unroll
        for (unsigned j = 0; j < 16; ++j) { const unsigned c = xb_ld(&bar[XB_XCNT(j)]); sum += c; cnt += (c > 0u) ? 1u : 0u; mine = (j == x) ? c : mine; }
        if (sum == G) break;
        __builtin_amdgcn_s_sleep(1);
        if ((++sp & 255u) == 0u) { if (xb_ld(&bar[XB_TMO])) break; if (sp > XB_SPIN_CAP) { atomicAdd(&bar[XB_TMO], 1u); break; } }
    }
    nloc = mine > 0u ? mine : 1u; nx = cnt > 0u ? cnt : 1u;
}
__device__ __forceinline__ void xcd_barrier(const XcdBarrier& b) {
    asm volatile("s_waitcnt vmcnt(0)" ::: "memory");
    __syncthreads();
    if (threadIdx.x == 0) {
        unsigned* bar = b.bar;
        __builtin_amdgcn_s_waitcnt(0);
        unsigned nloc = b.st[0], nx = b.st[1];
        if (nloc == 0u) { xcd_barrier_complete(bar, b.x, nloc, nx); b.st[0] = nloc; b.st[1] = nx; }
        const unsigned old = xb_add(&bar[XB_XSUB(b.x)], 1u);
        const unsigned gen = old / nloc;
        if (old + 1u == (gen + 1u) * nloc) {
            __builtin_amdgcn_fence(__ATOMIC_RELEASE, "agent");
            asm volatile("s_waitcnt vmcnt(0)" ::: "memory");
            const unsigned og = xb_add(&bar[XB_TOP], 1u);
            const unsigned tg = og / nx;
            if (og + 1u == (tg + 1u) * nx) xb_add(&bar[XB_TOPGEN], 1u);
            else XB_SPIN(xb_ld(&bar[XB_TOPGEN]) == tg, bar);
            __builtin_amdgcn_fence(__ATOMIC_ACQUIRE, "agent");
            xb_add(&bar[XB_XGEN(b.x)], 1u);
            asm volatile("s_waitcnt vmcnt(0)" ::: "memory");
        } else {
            XB_SPIN(xb_ld(&bar[XB_XGEN(b.x)]) == gen, bar);
            __builtin_amdgcn_fence(__ATOMIC_ACQUIRE, "agent");
            asm volatile("s_waitcnt vmcnt(0)" ::: "memory");
        }
    }
    __syncthreads();
}
#endif

struct Args { const float* in[14]; float* out; unsigned char* ws; int ph_lo, ph_hi; };

DEV void p0_transpose_item(const float* W, int ldw, int K, bf16* WT, int k0, int c0, int r0, int nvalid, ldsp scr, int lane) {
    const int kr = lane >> 4, n4 = 4 * (lane & 15);
    f32x4 v[16];
#pragma unroll
    for (int i = 0; i < 16; ++i) v[i] = (n4 < nvalid) ? *(const f32x4*)(W + (size_t)(k0 + 4 * i + kr) * ldw + c0 + n4) : (f32x4){0.f, 0.f, 0.f, 0.f};
#pragma unroll
    for (int i = 0; i < 16; ++i) LDS_WR(f32x4, scr + ((4 * i + kr) * 68 + n4) * 4, v[i]);
    WAVE_SYNC();
    const int c = lane & 7;
#pragma unroll
    for (int j = 0; j < 8; ++j) { const int n = (lane >> 3) + 8 * j; ldsp sp = scr + ((8 * c) * 68 + n) * 4;
        u32x4 o; o.x = pk2(LDS_RD(float, sp + 0 * 272), LDS_RD(float, sp + 1 * 272)); o.y = pk2(LDS_RD(float, sp + 2 * 272), LDS_RD(float, sp + 3 * 272));
        o.z = pk2(LDS_RD(float, sp + 4 * 272), LDS_RD(float, sp + 5 * 272)); o.w = pk2(LDS_RD(float, sp + 6 * 272), LDS_RD(float, sp + 7 * 272));
        if (n < nvalid) *(u32x4*)(WT + (size_t)(r0 + n) * K + k0 + 8 * c) = o; }
    WAVE_SYNC();
}

constexpr int MS = 272, MS64 = 144;
constexpr int RAW_A = 0, RAW_B = RAW_A + 68 * 256, RAW_I = RAW_B + 68 * 256;
constexpr int MX_QR = RAW_I + 2 * 64 * 256, MX_KR = MX_QR + 64 * MS, MX_KW = MX_KR + 64 * MS, MX_PS = MX_KW + 64 * MS, MX_SM = MX_PS + 64 * MS64;
constexpr int SM_TOT = MX_SM, SM_BME = SM_TOT + 8 * 128 * 4, SM_EG = SM_BME + 512, SM_EGM = SM_EG + 512, SM_SSQ = SM_EGM + 512;
constexpr int SM_A = SM_SSQ + 2 * 64 * 8 * 4, SM_MX = SM_A + 256, SM_INT = SM_MX + 256, SM_EMT = SM_INT + 256, SM_WGT = SM_EMT + 256, SM_SCAL = SM_WGT + 256;
constexpr int SM_NV = SM_SCAL + 64, SM_NACC = SM_NV + 512, SM_RSUM = SM_NACC + 8 * 512, SM_QN = SM_RSUM + 64 * 2 * 4, SM_CW = SM_QN + 256, MX_END = SM_CW + 10 * 512;
static_assert(MX_END <= RING_BYTES, "mixer LDS");

DEV bf16x8 frag16(ldsp buf, int stride, int row0, int ks, int lane) { return LDS_RD(bf16x8, buf + (row0 + (lane & 15)) * stride + ks * 64 + (lane >> 4) * 16); }
DEV bf16x8 frag8x2(ldsp buf, int stride, int row0, int ks, int lane) {
    ldsp p = buf + (row0 + (lane & 15)) * stride + ks * 64 + (lane >> 4) * 8;
    const bf16x4 lo = LDS_RD(bf16x4, p), hi = LDS_RD(bf16x4, p + 32);
    return (bf16x8){lo[0], lo[1], lo[2], lo[3], hi[0], hi[1], hi[2], hi[3]};
}
DEV bf16x8 frag_tr(ldsp img, int n0, int ks, int lane, int stride = 256) {
    ldsp p = img + (32 * ks + 8 * (lane >> 4) + ((lane & 15) >> 2)) * stride + (n0 + 4 * (lane & 3)) * 2;
    const bf16x4 lo = lds_tr16(p), hi = lds_tr16(p + 4 * stride);
    return (bf16x8){lo[0], lo[1], lo[2], lo[3], hi[0], hi[1], hi[2], hi[3]};
}
DEV bf16x8 pack_state(const f32x4 a, const f32x4 b) {
    u32x4 w; w.x = pk2(a[0], a[1]); w.y = pk2(a[2], a[3]); w.z = pk2(b[0], b[1]); w.w = pk2(b[2], b[3]);
    return __builtin_bit_cast(bf16x8, w);
}
DEV void dma_tile(const bf16* P, size_t tok0, int rowoff, int col0, int ninst, ldsp dst, int wave, int lane) {
    const bf16* src = P + p_off(tok0, col0) + (long)(rowoff + (lane >> 4)) * 128 + 8 * (lane & 15);
    for (int i = wave; i < ninst; i += NWAVES) GLDS16X(src + i * 512, dst + i * 1024);
}

DEV float sigm2(float x) { return frcp(1.0f + fexp2(-LOG2E * x)); }
DEV u32x2 pack4(const f32x4 v) { u32x2 w; w.x = cvt_pk_bf16(v[0], v[1]); w.y = cvt_pk_bf16(v[2], v[3]); return w; }

DEV void mixer_a_job(const Args& args, ldsp lds, int b, int h, int tid_) {
    const int wave = RFL(tid_ >> 6);
    const bf16* P = (const bf16*)(args.ws + WS_P);
    bf16* OA = (bf16*)(args.ws + WS_OAB);
    float* SSA = (float*)(args.ws + WS_SSA);
    const float* lbl = args.in[3];
    float lbv[2];
#pragma unroll
    for (int e = 0; e < 2; ++e) { const int col = h * 128 + 2 * (tid_ & 63) + e; lbv[e] = frcp(1.0f + fexp(lbl[DA + col] - lbl[col])); }
    f32x4 st[8], o[4];
#pragma unroll
    for (int t = 0; t < 8; ++t) st[t] = (f32x4){0.f, 0.f, 0.f, 0.f};
#pragma unroll
    for (int ct = 0; ct < 4; ++ct) o[ct] = (f32x4){0.f, 0.f, 0.f, 0.f};
    {
        const size_t tk = (size_t)b * SEQ;
        dma_tile(P, tk, 0, C_QA + h * 128, 16, lds + RAW_A, wave, tid_ & 63); dma_tile(P, tk, 0, C_FA + h * 128, 16, lds + RAW_B, wave, tid_ & 63); dma_tile(P, tk, 0, C_IA + h * 128, 16, lds + RAW_I, wave, tid_ & 63);
    }
    for (int j = 0; j <= NCH; ++j) {
        int tidj = tid_; OPAQUE(tidj);
        const int lane = tidj & 63, q4 = lane >> 4, l15 = lane & 15;
        const size_t tk0 = (size_t)b * SEQ + 64 * j;
        if (j <= 1) WAIT_V(0); else WAIT_V(4);
        MIX_BAR();
        if (j > 0 && wave == 0) { ldsp ssq = lds + SM_SSQ + ((j - 1) & 1) * 2048; const f32x4 s0 = LDS_RD(f32x4, ssq + (lane * 8) * 4), s1 = LDS_RD(f32x4, ssq + (lane * 8 + 4) * 4);
            SSA[(tk0 - 64 + lane) * HA + h] = ((s0[0] + s0[1]) + (s0[2] + s0[3])) + ((s1[0] + s1[1]) + (s1[2] + s1[3])); }
        if (j < NCH) {
            float lf[8][2], qv[8][2], kv[8][2];
#pragma unroll
            for (int c = 0; c < 8; ++c) { const unsigned fw = LDS_RD(unsigned, lds + RAW_B + (8 * wave + c) * 256 + lane * 4), qw = LDS_RD(unsigned, lds + RAW_A + (8 * wave + c) * 256 + lane * 4);
#pragma unroll
                for (int e = 0; e < 2; ++e) { const float f = lbv[e] + (1.0f - lbv[e]) * sigm2(__builtin_bit_cast(float, e ? (fw & 0xffff0000u) : (fw << 16))); lf[c][e] = flog2(f); kv[c][e] = 1.0f - f; qv[c][e] = __builtin_bit_cast(float, e ? (qw & 0xffff0000u) : (qw << 16)); } }
#pragma unroll
            for (int c = 1; c < 8; ++c) { lf[c][0] += lf[c - 1][0]; lf[c][1] += lf[c - 1][1]; }
            LDS_WR(f32x2, lds + SM_TOT + (wave * 128 + 2 * lane) * 4, ((f32x2){lf[7][0], lf[7][1]}));
            MIX_BAR();
            if (j + 1 < NCH) { const size_t tk = tk0 + 64;
                dma_tile(P, tk, 0, C_QA + h * 128, 16, lds + RAW_A, wave, lane); dma_tile(P, tk, 0, C_FA + h * 128, 16, lds + RAW_B, wave, lane); dma_tile(P, tk, 0, C_IA + h * 128, 16, lds + RAW_I + ((j + 1) & 1) * 16384, wave, lane); }
            {
                f32x2 off = (f32x2){0.f, 0.f}, bmid = (f32x2){0.f, 0.f}, g = (f32x2){0.f, 0.f};
#pragma unroll
                for (int w = 0; w < 8; ++w) { const f32x2 t = LDS_RD(f32x2, lds + SM_TOT + (w * 128 + 2 * lane) * 4); if (w < wave) off += t; if (w < 4) bmid += t; g += t; }
                unsigned kr[8];
#pragma unroll
                for (int c = 0; c < 8; ++c) { float qr[2], kk[2];
#pragma unroll
                    for (int e = 0; e < 2; ++e) { const float t1 = lf[c][e] + off[e] - bmid[e]; qr[e] = qv[c][e] * fexp2(t1); kk[e] = kv[c][e] * fexp2(-t1); }
                    LDS_WR(unsigned, lds + MX_QR + (8 * wave + c) * MS + lane * 4, cvt_pk_bf16(qr[0], qr[1]));
                    kr[c] = cvt_pk_bf16(kk[0], kk[1]);
                    LDS_WR(unsigned, lds + MX_KR + (8 * wave + c) * MS + lane * 4, kr[c]); }
                if (wave == 0) { LDS_WR(f32x2, lds + SM_BME + lane * 8, ((f32x2){fexp2(bmid[0]), fexp2(bmid[1])})); LDS_WR(f32x2, lds + SM_EG + lane * 8, ((f32x2){fexp2(g[0]), fexp2(g[1])}));
                    LDS_WR(f32x2, lds + SM_EGM + lane * 8, ((f32x2){fexp2(g[0] - bmid[0]), fexp2(g[1] - bmid[1])})); }
            }
        }
        MIX_BAR();
        if (j > 0) {
#pragma unroll
            for (int ct = 0; ct < 4; ++ct) *(u32x2*)(OA + (tk0 - 64 + 16 * ct + l15) * DA + h * 128 + 16 * wave + 4 * q4) = pack4(o[ct]);
        }
        if (j == NCH) break;
        {
            const int ct = wave >> 1, st0 = 2 * (wave & 1);
            f32x4 sc[2] = {(f32x4){0.f, 0.f, 0.f, 0.f}, (f32x4){0.f, 0.f, 0.f, 0.f}};
#pragma unroll
            for (int ks = 0; ks < 4; ++ks) { const bf16x8 qf = frag16(lds + MX_QR, MS, 16 * ct, ks, lane);
#pragma unroll
                for (int n = 0; n < 2; ++n) { const bf16x8 kf_ = frag16(lds + MX_KR, MS, 16 * (st0 + n), ks, lane); sc[n] = MFMA16(kf_, qf, sc[n]); } }
#pragma unroll
            for (int n = 0; n < 2; ++n) { const int c = 16 * ct + l15, s0_ = 16 * (st0 + n) + 4 * q4; f32x4 v = sc[n];
#pragma unroll
                for (int r = 0; r < 4; ++r) v[r] = (s0_ + r <= c) ? v[r] : 0.f;
                LDS_WR(u32x2, lds + MX_PS + c * MS64 + s0_ * 2, pack4(v)); }
        }
        MIX_BAR();
        {
            ldsp rawi = lds + RAW_I + (j & 1) * 16384;
            bf16x8 bv[2];
#pragma unroll
            for (int ks = 0; ks < 2; ++ks) bv[ks] = frag_tr(rawi, 16 * wave, ks, lane);
#pragma unroll
            for (int ct = 0; ct < 4; ++ct) o[ct] = (f32x4){0.f, 0.f, 0.f, 0.f};
#pragma unroll
            for (int ks = 0; ks < 2; ++ks)
#pragma unroll
                for (int ct = 0; ct < 4; ++ct) { const bf16x8 pf = frag16(lds + MX_PS, MS64, 16 * ct, ks, lane); o[ct] = MFMA16(bv[ks], pf, o[ct]); }
#pragma unroll
            for (int ks = 0; ks < 4; ++ks) {
                const f32x4 e0 = LDS_RD(f32x4, lds + SM_BME + (32 * ks + 4 * q4) * 4), e1 = LDS_RD(f32x4, lds + SM_BME + (32 * ks + 16 + 4 * q4) * 4);
                u32x4 w; const f32x4 a0 = st[2 * ks] * e0, a1 = st[2 * ks + 1] * e1; w.x = cvt_pk_bf16(a0[0], a0[1]); w.y = cvt_pk_bf16(a0[2], a0[3]); w.z = cvt_pk_bf16(a1[0], a1[1]); w.w = cvt_pk_bf16(a1[2], a1[3]);
                const bf16x8 sf = __builtin_bit_cast(bf16x8, w);
#pragma unroll
                for (int ct = 0; ct < 4; ++ct) { const bf16x8 qf = frag8x2(lds + MX_QR, MS, 16 * ct, ks, lane); o[ct] = MFMA16(sf, qf, o[ct]); } }
#pragma unroll
            for (int t = 0; t < 8; ++t) {
                f32x4 u = (f32x4){0.f, 0.f, 0.f, 0.f};
#pragma unroll
                for (int ks = 0; ks < 2; ++ks) { const bf16x8 a = frag_tr(lds + MX_KR, 16 * t, ks, lane, MS); u = MFMA16(a, bv[ks], u); }
                const f32x4 eg = LDS_RD(f32x4, lds + SM_EG + (16 * t + 4 * q4) * 4), egm = LDS_RD(f32x4, lds + SM_EGM + (16 * t + 4 * q4) * 4); st[t] = eg * st[t] + egm * u; }
            ldsp ssq = lds + SM_SSQ + (j & 1) * 2048;
#pragma unroll
            for (int ct = 0; ct < 4; ++ct) { float s = (o[ct][0] * o[ct][0] + o[ct][1] * o[ct][1]) + (o[ct][2] * o[ct][2] + o[ct][3] * o[ct][3]); s += __shfl_xor(s, 16); s += __shfl_xor(s, 32);
                LDS_WR(float, ssq + ((16 * ct + l15) * 8 + wave) * 4, s); }
        }
    }
}

DEV float scan_add(float v, int lane) {
#pragma unroll
    for (int o = 1; o < 64; o <<= 1) { const float t = __shfl_up(v, o); if (lane >= o) v += t; }
    return v;
}
DEV float scan_max(float v, int lane) {
#pragma unroll
    for (int o = 1; o < 64; o <<= 1) { const float t = __shfl_up(v, o); if (lane >= o) v = fmaxf(v, t); }
    return v;
}

DEV void mixer_b_job(const Args& args, ldsp lds, int b, int h, int half, int tid_) {
    const int wave = RFL(tid_ >> 6);
    const int vbase = h * 256 + 128 * half;
    const bf16* P = (const bf16*)(args.ws + WS_P);
    bf16* OB = (bf16*)(args.ws + WS_OAB) + (size_t)M * DA;
    const float* SG = (const float*)(args.ws + WS_SG);
    float* SSB = (float*)(args.ws + WS_SSB);
    const float* cw = args.in[4]; const float* cb = args.in[5];
    if (tid_ < 128) { const int col = h * 128 + tid_;
#pragma unroll
        for (int k = 0; k < 4; ++k) { LDS_WR(float, lds + SM_CW + (k * 128 + tid_) * 4, cw[k * (2 * DQK) + col]); LDS_WR(float, lds + SM_CW + ((4 + k) * 128 + tid_) * 4, cw[k * (2 * DQK) + DQK + col]); }
        LDS_WR(float, lds + SM_CW + (8 * 128 + tid_) * 4, cb[col]); LDS_WR(float, lds + SM_CW + (9 * 128 + tid_) * 4, cb[DQK + col]); }
    const float big = args.in[6][h], bfg = args.in[7][h];
    f32x4 st[8], hv[4];
#pragma unroll
    for (int t = 0; t < 8; ++t) st[t] = (f32x4){0.f, 0.f, 0.f, 0.f};
#pragma unroll
    for (int ct = 0; ct < 4; ++ct) hv[ct] = (f32x4){0.f, 0.f, 0.f, 0.f};
    float mcar = 0.f;
    if (wave < 2) LDS_WR(float, lds + SM_NV + tid_ * 4, 0.f);
    float sg_f = 0.f, sg_i = 0.f;
    if (wave == 0) { const size_t t = (size_t)b * SEQ + (tid_ & 63); sg_f = SG[t * 16 + HB + h]; sg_i = SG[t * 16 + h]; }
    {
        const size_t tk = (size_t)b * SEQ;
        dma_tile(P, tk, -3, C_QB + h * 128, 17, lds + RAW_A, wave, tid_ & 63); dma_tile(P, tk, -3, C_KB + h * 128, 17, lds + RAW_B, wave, tid_ & 63); dma_tile(P, tk, 0, C_VB + vbase, 16, lds + RAW_I, wave, tid_ & 63);
    }
    for (int j = 0; j <= NCH; ++j) {
        const size_t tk0 = (size_t)b * SEQ + 64 * j;
        int tidj = tid_; OPAQUE(tidj);
        const int tid = tidj, lane = tidj & 63, q4 = lane >> 4, l15 = lane & 15;
        if (j <= 1) WAIT_V(0); else WAIT_V(4);
        MIX_BAR();
        if (j > 0 && wave == 0) { ldsp ssq = lds + SM_SSQ + ((j - 1) & 1) * 2048; const f32x4 s0 = LDS_RD(f32x4, ssq + (lane * 8) * 4), s1 = LDS_RD(f32x4, ssq + (lane * 8 + 4) * 4);
            SSB[(tk0 - 64 + lane) * (2 * HB) + 2 * h + half] = ((s0[0] + s0[1]) + (s0[2] + s0[3])) + ((s1[0] + s1[1]) + (s1[2] + s1[3])); }
        float kf[8][2], decay = 0.f;
        if (j < NCH) {
            f32x2 wq[4], wk[4];
#pragma unroll
            for (int k = 0; k < 4; ++k) { wq[k] = LDS_RD(f32x2, lds + SM_CW + (k * 128 + 2 * lane) * 4); wk[k] = LDS_RD(f32x2, lds + SM_CW + ((4 + k) * 128 + 2 * lane) * 4); }
            const f32x2 bq = LDS_RD(f32x2, lds + SM_CW + (8 * 128 + 2 * lane) * 4), bk = LDS_RD(f32x2, lds + SM_CW + (9 * 128 + 2 * lane) * 4);
            unsigned uq[11], uk[11];
#pragma unroll
            for (int i = 0; i < 11; ++i) { const bool neg = (64 * j + 8 * wave + i - 3) < 0;
                const unsigned a = LDS_RD(unsigned, lds + RAW_A + (8 * wave + i) * 256 + lane * 4), bb = LDS_RD(unsigned, lds + RAW_B + (8 * wave + i) * 256 + lane * 4); uq[i] = neg ? 0u : a; uk[i] = neg ? 0u : bb; }
#pragma unroll
            for (int c = 0; c < 8; ++c) { float qq[2];
#pragma unroll
                for (int e = 0; e < 2; ++e) { float yq = bq[e], yk = bk[e];
#pragma unroll
                    for (int k = 0; k < 4; ++k) { yq += wq[k][e] * __builtin_bit_cast(float, e ? (uq[c + k] & 0xffff0000u) : (uq[c + k] << 16)); yk += wk[k][e] * __builtin_bit_cast(float, e ? (uk[c + k] & 0xffff0000u) : (uk[c + k] << 16)); }
                    qq[e] = yq * sigm2(yq); kf[c][e] = yk * sigm2(yk) * 0.08838834764831845f; }
                LDS_WR(unsigned, lds + MX_QR + (8 * wave + c) * MS + lane * 4, cvt_pk_bf16(qq[0], qq[1]));
                LDS_WR(unsigned, lds + MX_KR + (8 * wave + c) * MS + lane * 4, cvt_pk_bf16(kf[c][0], kf[c][1])); }
            if (wave == 0) {
                const float fp = sg_f + bfg, ig = sg_i + big;
                if (j + 1 < NCH) { sg_f = SG[(tk0 + 64 + lane) * 16 + HB + h]; sg_i = SG[(tk0 + 64 + lane) * 16 + h]; }
                const float bc = scan_add(logsig(fp), lane), a = ig - bc, mx = fmaxf(mcar, scan_max(a, lane));
                const float g = __shfl(bc, 63), m63 = __shfl(mx, 63);
                LDS_WR(float, lds + SM_A + lane * 4, a * LOG2E); LDS_WR(float, lds + SM_MX + lane * 4, mx * LOG2E); LDS_WR(float, lds + SM_INT + lane * 4, fexp(mcar - mx));
                LDS_WR(float, lds + SM_EMT + lane * 4, fexp(-(bc + mx))); LDS_WR(float, lds + SM_WGT + lane * 4, fexp(a - m63));
                if (lane == 0) { LDS_WR(float, lds + SM_SCAL, fexp(mcar - m63)); LDS_WR(float, lds + SM_SCAL + 4, g + m63); }
            }
            MIX_BAR();
            if (j + 1 < NCH) { const size_t tk = tk0 + 64;
                dma_tile(P, tk, -3, C_QB + h * 128, 17, lds + RAW_A, wave, lane); dma_tile(P, tk, -3, C_KB + h * 128, 17, lds + RAW_B, wave, lane); dma_tile(P, tk, 0, C_VB + vbase, 16, lds + RAW_I + ((j + 1) & 1) * 16384, wave, lane); }
            decay = LDS_RD(float, lds + SM_SCAL);
            mcar = LDS_RD(float, lds + SM_SCAL + 4);
            {
                float na[2] = {0.f, 0.f};
#pragma unroll
                for (int c = 0; c < 8; ++c) { const float w_ = LDS_RD(float, lds + SM_WGT + (8 * wave + c) * 4); const float k0 = w_ * kf[c][0], k1 = w_ * kf[c][1]; na[0] += k0; na[1] += k1;
                    LDS_WR(unsigned, lds + MX_KW + (8 * wave + c) * MS + lane * 4, cvt_pk_bf16(k0, k1)); }
                LDS_WR(f32x2, lds + SM_NACC + (wave * 128 + 2 * lane) * 4, ((f32x2){na[0], na[1]}));
                const int c = tid >> 3, part = tid & 7; float s = 0.f;
#pragma unroll
                for (int e = 0; e < 8; ++e) { const unsigned qw = LDS_RD(unsigned, lds + MX_QR + c * MS + (16 * part + 2 * e) * 2); const f32x2 nv = LDS_RD(f32x2, lds + SM_NV + (16 * part + 2 * e) * 4);
                    s += __builtin_bit_cast(float, qw << 16) * nv[0] + __builtin_bit_cast(float, qw & 0xffff0000u) * nv[1]; }
                s += __shfl_xor(s, 1); s += __shfl_xor(s, 2); s += __shfl_xor(s, 4);
                LDS_WR(float, lds + SM_QN + c * 4, s);
            }
        }
        MIX_BAR();
        if (j > 0) {
#pragma unroll
            for (int ct = 0; ct < 4; ++ct) *(u32x2*)(OB + (tk0 - 64 + 16 * ct + l15) * DB + vbase + 16 * wave + 4 * q4) = pack4(hv[ct]);
        }
        if (j == NCH) break;
        {
            const int ct = wave >> 1, st0 = 2 * (wave & 1), c = 16 * ct + l15;
            f32x4 sc[2] = {(f32x4){0.f, 0.f, 0.f, 0.f}, (f32x4){0.f, 0.f, 0.f, 0.f}};
#pragma unroll
            for (int ks = 0; ks < 4; ++ks) { const bf16x8 qf = frag16(lds + MX_QR, MS, 16 * ct, ks, lane);
#pragma unroll
                for (int n = 0; n < 2; ++n) { const bf16x8 kf_ = frag16(lds + MX_KR, MS, 16 * (st0 + n), ks, lane); sc[n] = MFMA16(kf_, qf, sc[n]); } }
            const float mxc = LDS_RD(float, lds + SM_MX + c * 4); float rs = 0.f;
#pragma unroll
            for (int n = 0; n < 2; ++n) { const int s0_ = 16 * (st0 + n) + 4 * q4; const f32x4 as = LDS_RD(f32x4, lds + SM_A + s0_ * 4); f32x4 v;
#pragma unroll
                for (int r = 0; r < 4; ++r) { const float t = fexp2(as[r] - mxc) * sc[n][r]; v[r] = (s0_ + r <= c) ? t : 0.f; rs += v[r]; }
                LDS_WR(u32x2, lds + MX_PS + c * MS64 + s0_ * 2, pack4(v)); }
            rs += __shfl_xor(rs, 16); rs += __shfl_xor(rs, 32);
            LDS_WR(float, lds + SM_RSUM + (c * 2 + (wave & 1)) * 4, rs);
        }
        MIX_BAR();
        {
            ldsp rawv = lds + RAW_I + (j & 1) * 16384;
            bf16x8 bv[2], bs[4];
#pragma unroll
            for (int ks = 0; ks < 2; ++ks) bv[ks] = frag_tr(rawv, 16 * wave, ks, lane);
#pragma unroll
            for (int ks = 0; ks < 4; ++ks) { u32x4 w; const f32x4 a0 = st[2 * ks], a1 = st[2 * ks + 1]; w.x = cvt_pk_bf16(a0[0], a0[1]); w.y = cvt_pk_bf16(a0[2], a0[3]); w.z = cvt_pk_bf16(a1[0], a1[1]); w.w = cvt_pk_bf16(a1[2], a1[3]); bs[ks] = __builtin_bit_cast(bf16x8, w); }
#pragma unroll
            for (int ct = 0; ct < 4; ++ct) {
                f32x4 a1 = (f32x4){0.f, 0.f, 0.f, 0.f}, a2 = (f32x4){0.f, 0.f, 0.f, 0.f};
#pragma unroll
                for (int ks = 0; ks < 2; ++ks) { const bf16x8 pf = frag16(lds + MX_PS, MS64, 16 * ct, ks, lane); a2 = MFMA16(bv[ks], pf, a2); }
#pragma unroll
                for (int ks = 0; ks < 4; ++ks) { const bf16x8 qf = frag8x2(lds + MX_QR, MS, 16 * ct, ks, lane); a1 = MFMA16(bs[ks], qf, a1); }
                const int c = 16 * ct + l15; const float inter = LDS_RD(float, lds + SM_INT + c * 4); const f32x2 rsm = LDS_RD(f32x2, lds + SM_RSUM + (c * 2) * 4);
                const float den = inter * LDS_RD(float, lds + SM_QN + c * 4) + (rsm[0] + rsm[1]);
                const float rden = frcp(fmaxf(fabsf(den), LDS_RD(float, lds + SM_EMT + c * 4)));
                hv[ct] = (inter * a1 + a2) * rden;
            }
#pragma unroll
            for (int t = 0; t < 8; ++t) {
                f32x4 u = (f32x4){0.f, 0.f, 0.f, 0.f};
#pragma unroll
                for (int ks = 0; ks < 2; ++ks) { const bf16x8 a = frag_tr(lds + MX_KW, 16 * t, ks, lane, MS); u = MFMA16(a, bv[ks], u); }
                st[t] = decay * st[t] + u;
            }
            if (wave < 2) { float nn = decay * LDS_RD(float, lds + SM_NV + tid * 4);
#pragma unroll
                for (int w = 0; w < 8; ++w) nn += LDS_RD(float, lds + SM_NACC + (w * 128 + tid) * 4);
                LDS_WR(float, lds + SM_NV + tid * 4, nn); }
            ldsp ssq = lds + SM_SSQ + (j & 1) * 2048;
#pragma unroll
            for (int ct = 0; ct < 4; ++ct) { float s = (hv[ct][0] * hv[ct][0] + hv[ct][1] * hv[ct][1]) + (hv[ct][2] * hv[ct][2] + hv[ct][3] * hv[ct][3]); s += __shfl_xor(s, 16); s += __shfl_xor(s, 32);
                LDS_WR(float, ssq + ((16 * ct + l15) * 8 + wave) * 4, s); }
        }
    }
}

__global__ void __launch_bounds__(NTHREADS, 2) fwd_kernel(Args args) {
#ifndef EMU
    extern __shared__ __attribute__((aligned(16))) unsigned char lds_raw[];
    ldsp lds = (ldsp)lds_raw;
#else
    ldsp lds = emu_lds;
#endif
    const int tid = threadIdx.x, lane = tid & 63, wave = RFL(tid >> 6);
    const int G = gridDim.x, bx = blockIdx.x;
    const int vcu = (G % 8 == 0) ? (bx % 8) * (G / 8) + bx / 8 : bx;
    unsigned char* ws = args.ws;
#ifndef EMU
    for (int u = tid; u < (LDS_BYTES - LDSCTL_OFF) / 4; u += NTHREADS) ((LAS unsigned*)(lds + LDSCTL_OFF))[u] = 0u;
    __syncthreads();
    XcdBarrier bar = xcd_barrier_post((unsigned*)(ws + WS_CTL) + CW_BAR, (volatile LAS unsigned*)(lds + MISC_OFF) + 8);
#define GRID_BAR() xcd_barrier(bar)
#else
#define GRID_BAR()
#endif
    const int lo = args.ph_lo, hi = args.ph_hi;
#ifndef GEMM_SP2
#define GEMM_SP2 true
#endif
#ifndef GEMM_ALIGN
#define GEMM_ALIGN true
#endif
#ifndef PROBE_REP_P1
#define PROBE_REP_P1 1
#endif
#ifndef PROBE_REP_P2
#define PROBE_REP_P2 1
#endif
#ifndef PHASE_MASK
#define PHASE_MASK 127
#endif
#define IN(k) (((PHASE_MASK >> (k)) & 1) && lo <= (k) && (k) < hi)
#define BOTH(k) (IN(k) && IN((k) + 1))
    const float* x = args.in[0];
    bf16* W1T = (bf16*)(ws + WS_W1T); bf16* WUT = (bf16*)(ws + WS_WUT); bf16* WOT = (bf16*)(ws + WS_WOT);
    bf16* HBUF = (bf16*)(ws + WS_HB); bf16* PB = (bf16*)(ws + WS_P); float* SG = (float*)(ws + WS_SG); bf16* OAB = (bf16*)(ws + WS_OAB); float* RSS = (float*)(ws + WS_RSS);

    if (IN(0)) {
        ldsp scr = lds + wave * 17408;
        const int gw = vcu * NWAVES + wave, NGW = G * NWAVES;
        constexpr int RB1 = (NP + NSG + 63) / 64, I_1 = (D / 64) * RB1, I_U = (DA / 64) * (D / 64), I_O = (D / 64) * (D / 64);
        constexpr int NITEMS = I_1 + 2 * I_U + I_O;
        static_assert(NPM % 64 == 0 && NP % 64 == 0 && NSG % 4 == 0, "P0 item tiling");
        for (int it = gw; it < NITEMS; it += NGW) {
            int r = it;
            if (r < I_1) { const int kb = r / RB1, rb = r % RB1, r0 = 64 * rb; int c0, nv;
                if (r0 < NPM) { c0 = r0; nv = 64; } else if (r0 < NP) { c0 = r0 + NSG; nv = 64; } else { c0 = NPM + (r0 - NP); nv = NSG - (r0 - NP) < 64 ? NSG - (r0 - NP) : 64; }
                p0_transpose_item(args.in[2], D_IN, D, W1T, 64 * kb, c0, r0, nv, scr, lane); continue; }
            r -= I_1;
            if (r < I_U) { const int kb = r / (D / 64), rb = r % (D / 64); p0_transpose_item(args.in[10], D, DA, WUT, 64 * kb, 64 * rb, 64 * rb, 64, scr, lane); continue; }
            r -= I_U;
            if (r < I_U) { const int kb = r / (D / 64), rb = r % (D / 64); p0_transpose_item(args.in[11], D, DB, WUT + (size_t)D * DA, 64 * kb, 64 * rb, 64 * rb, 64, scr, lane); continue; }
            r -= I_U;
            { const int kb = r / (D / 64), rb = r % (D / 64); p0_transpose_item(args.in[12], D, D, WOT, 64 * kb, 64 * rb, 64 * rb, 64, scr, lane); }
        }
        const float* gpre = args.in[1];
        for (int m = gw; m < M; m += NGW) {
            const f32x4* xr = (const f32x4*)(x + (size_t)m * D) + lane;
            f32x4 v[D / 256]; float s = 0.f;
#pragma unroll
            for (int jj = 0; jj < D / 256; ++jj) { v[jj] = xr[64 * jj]; s += (v[jj][0] * v[jj][0] + v[jj][1] * v[jj][1]) + (v[jj][2] * v[jj][2] + v[jj][3] * v[jj][3]); }
            const float rstd = frsq(wave_sum(s) * (1.0f / D) + EPS) ;
            u32x2* o8 = (u32x2*)(HBUF + (size_t)m * D) + lane;
#pragma unroll
            for (int jj = 0; jj < D / 256; ++jj) { const f32x4 gg = ((const f32x4*)gpre)[lane + 64 * jj]; u32x2 w; w.x = pk2(v[jj][0] * rstd * gg[0], v[jj][1] * rstd * gg[1]); w.y = pk2(v[jj][2] * rstd * gg[2], v[jj][3] * rstd * gg[3]); o8[64 * jj] = w; }
        }
        if (BOTH(0)) GRID_BAR();
    }

    if (IN(1)) {
        {
            const int gw = vcu * NWAVES + wave, NGW = G * NWAVES, l15 = lane & 15, q4 = lane >> 4;
            const int wrow = NP + (l15 < NSG ? l15 : NSG - 1);
            for (int t = gw; t < M / 16; t += NGW) {
                f32x4 acc = (f32x4){0.f, 0.f, 0.f, 0.f};
                const bf16* ap = HBUF + (size_t)(16 * t + l15) * D + 8 * q4; const bf16* bp = W1T + (size_t)wrow * D + 8 * q4;
#pragma unroll 8
                for (int ks = 0; ks < D / 32; ++ks) { const bf16x8 a = *(const bf16x8*)(ap + 32 * ks), bb = *(const bf16x8*)(bp + 32 * ks); acc = MFMA16(a, bb, acc); }
#pragma unroll
                for (int r = 0; r < 4; ++r) SG[(size_t)(16 * t + 4 * q4 + r) * 16 + l15] = acc[r];
            }
        }
        pg8::Gemm g{HBUF, W1T, M, NP, D}; pg8::StaticOrder S; S.init(M, NP, G, bx);
        EpiP E{PB};
        for (int rep = 0; rep < PROBE_REP_P1; ++rep) pg8::gemm_phase<EpiP, pg8::StaticOrder, GEMM_ALIGN, GEMM_SP2>(lds, g, S, E);
        if (BOTH(1)) GRID_BAR();
    }

    if (IN(2)) {
        constexpr int NJA = NB * HA, NJB = NB * HB * 2;
        for (int rep = 0; rep < PROBE_REP_P2; ++rep)
        for (int job = bx; job < NJA + NJB; job += G) {
#ifndef NO_MIX_A
            if (job < NJA) mixer_a_job(args, lds, job / HA, job % HA, tid);
#endif
#ifndef NO_MIX_B
            if (job >= NJA) { const int jb = job - NJA; mixer_b_job(args, lds, jb / (2 * HB), (jb >> 1) % HB, jb & 1, tid); }
#endif
            BLOCK_BAR();
        }
        if (BOTH(2)) GRID_BAR();
    }

    if (IN(3)) {
        const int gw = vcu * NWAVES + wave, NGW = G * NWAVES;
        const float* SSA = (const float*)(ws + WS_SSA); const float* SSB = (const float*)(ws + WS_SSB);
        static_assert(DA % 512 == 0 && DA == DB, "P3 tiling");
        for (int m = gw; m < M; m += NGW) {
#pragma unroll
            for (int br = 0; br < 2; ++br) {
#pragma unroll
                for (int i = 0; i < DA / 512; ++i) {
                    const int col0 = i * 512 + lane * 8;
                    float rstd;
                    if (br == 0) rstd = frsq(SSA[(size_t)m * HA + col0 / 128] * (1.0f / 128.0f) + EPS);
                    else { const int hh = col0 / 256; rstd = frsq((SSB[(size_t)m * (2 * HB) + 2 * hh] + SSB[(size_t)m * (2 * HB) + 2 * hh + 1]) * (1.0f / 256.0f) + EPS); }
                    u32x4* po = (u32x4*)(OAB + (size_t)(br * M + m) * DA + col0);
                    u32x4 w = *po; const u32x4 g8 = *(const u32x4*)(PB + p_off((size_t)m, (br ? C_OGB : C_OGA) + col0)), z8 = *(const u32x4*)(PB + p_off((size_t)m, (br ? C_ZB : C_ZA) + col0));
                    const f32x4 gn0 = *(const f32x4*)(args.in[br ? 9 : 8] + col0), gn1 = *(const f32x4*)(args.in[br ? 9 : 8] + col0 + 4);
#pragma unroll
                    for (int e = 0; e < 4; ++e) { float v[2];
#pragma unroll
                        for (int k = 0; k < 2; ++k) { const float ov = __builtin_bit_cast(float, k ? (w[e] & 0xffff0000u) : (w[e] << 16)), og = __builtin_bit_cast(float, k ? (g8[e] & 0xffff0000u) : (g8[e] << 16)), z = __builtin_bit_cast(float, k ? (z8[e] & 0xffff0000u) : (z8[e] << 16));
                            const float gnv = (e < 2 ? gn0 : gn1)[(2 * e + k) & 3];
                            v[k] = ov * rstd * gnv * sigm2(og) * (z * sigm2(z)); }
                        w[e] = cvt_pk_bf16(v[0], v[1]); }
                    *po = w;
                }
            }
        }
        if (BOTH(3)) GRID_BAR();
    }
    if (IN(4)) {
        pg8::Gemm g{OAB, WUT, 2 * M, 2 * D, DA}; SchedUp S; S.so.init(M, D, G, bx);
        EpiUp E{HBUF, PB};
        pg8::gemm_phase<EpiUp, SchedUp, GEMM_ALIGN, GEMM_SP2>(lds, g, S, E);
        if (BOTH(4)) GRID_BAR();
    }

    if (IN(5)) {
        pg8::Gemm g{HBUF, WOT, M, D, D}; pg8::StaticOrder S; S.init(M, D, G, bx);
        EpiOut E{args.out, RSS};
        pg8::gemm_phase<EpiOut, pg8::StaticOrder, GEMM_ALIGN, GEMM_SP2>(lds, g, S, E);
        if (BOTH(5)) GRID_BAR();
    }

    if (IN(6)) {
        const int gw = vcu * NWAVES + wave, NGW = G * NWAVES;
        const float* gpost = args.in[13];
        for (int m = gw; m < M; m += NGW) {
            const float ss = wave_sum(lane < NRS ? RSS[(size_t)m * NRS + lane] : 0.f);
            const float rstd = frsq(ss * (1.0f / D) + EPS);
            const f32x4* xr = (const f32x4*)(x + (size_t)m * D) + lane; f32x4* orow = (f32x4*)(args.out + (size_t)m * D) + lane;
#pragma unroll
            for (int jj = 0; jj < D / 256; ++jj) { const f32x4 xv = xr[64 * jj], ov = orow[64 * jj], gg = ((const f32x4*)gpost)[lane + 64 * jj]; orow[64 * jj] = xv + ov * rstd * gg; }
        }
    }
#undef IN
#undef BOTH
}

#ifndef EMU
extern "C" void kernel_launch(void* const* d_in, const int* in_sizes, int n_in, void* d_out, int out_size, void* d_ws, size_t ws_size, hipStream_t stream) {
    static int grid = 0;
    if (grid == 0) {
        if (n_in != 14 || out_size != M * D || ws_size < WS_END) { fprintf(stderr, "kernel_launch: unexpected shapes (n_in %d, out %d, ws %zu < %zu)\n", n_in, out_size, ws_size, (size_t)WS_END); grid = -1; return; }
        int dev = 0, cus = 0, per_cu = 0;
        if (hipGetDevice(&dev) != hipSuccess || hipDeviceGetAttribute(&cus, hipDeviceAttributeMultiprocessorCount, dev) != hipSuccess) { grid = -1; return; }
        if (hipFuncSetAttribute((const void*)fwd_kernel, hipFuncAttributeMaxDynamicSharedMemorySize, LDS_BYTES) != hipSuccess) { fprintf(stderr, "kernel_launch: hipFuncSetAttribute failed\n"); grid = -1; return; }
        if (hipOccupancyMaxActiveBlocksPerMultiprocessor(&per_cu, (const void*)fwd_kernel, NTHREADS, LDS_BYTES) != hipSuccess || per_cu < 1) { fprintf(stderr, "kernel_launch: occupancy query says %d\n", per_cu); }
        (void)hipGetLastError();
        grid = cus;
    }
    if (grid < 0) return;
    (void)hipMemsetAsync((char*)d_ws + WS_CTL, 0, CTL_ZERO_BYTES, stream);
    Args a{};
    for (int i = 0; i < 14; ++i) a.in[i] = (const float*)d_in[i];
    a.out = (float*)d_out; a.ws = (unsigned char*)d_ws; a.ph_lo = 0; a.ph_hi = 7;
    hipLaunchKernelGGL(fwd_kernel, dim3(grid), dim3(NTHREADS), LDS_BYTES, stream, a);
}
#endif
```

```cpp
typedef int v8i_t __attribute__((ext_vector_type(8)));
typedef int v4i_t __attribute__((ext_vector_type(4)));
#ifndef EMU
#include <hip/hip_runtime.h>
#include <cstdio>
#include <cstdint>
#define LAS __attribute__((address_space(3)))
#define GAS __attribute__((address_space(1)))
typedef short bf16x8 __attribute__((ext_vector_type(8)));
typedef short bf16x4 __attribute__((ext_vector_type(4)));
typedef float f32x4 __attribute__((ext_vector_type(4)));
#define DEV __device__ __forceinline__
#define LDS_RD(T, p) (*(const LAS T*)(p))
#define LDS_WR(T, p, v) (*(LAS T*)(p) = (v))
#define WAVE_SYNC() asm volatile("s_waitcnt lgkmcnt(0)" ::: "memory")
#define BLOCK_BAR() __syncthreads()
#define RAW_BAR() __builtin_amdgcn_s_barrier()
#define WAIT_V(n) asm volatile("s_waitcnt vmcnt(" #n ")" ::: "memory")
#define WAIT_L(n) asm volatile("s_waitcnt lgkmcnt(" #n ")" ::: "memory")
#define SCHED_BAR() __builtin_amdgcn_sched_barrier(0)
#define SETPRIO(n) __builtin_amdgcn_s_setprio(n)
#define GLDS16(g, l) __builtin_amdgcn_global_load_lds((const unsigned*)(g), (LAS unsigned*)(l), 16, 0, 0)
#define MFMA16(a, b, c) __builtin_amdgcn_mfma_f32_16x16x32_bf16(a, b, c, 0, 0, 0)
#define RFL(x) __builtin_amdgcn_readfirstlane(x)
#define COMPILER_FENCE() asm volatile("" ::: "memory")
#define OPAQUE(x) asm volatile("" : "+v"(x))
DEV float fexp2(float x) { return __builtin_amdgcn_exp2f(x); }
DEV float flog2(float x) { return __builtin_amdgcn_logf(x); }
DEV float frcp(float x) { return __builtin_amdgcn_rcpf(x); }
DEV float frsq(float x) { return __builtin_amdgcn_rsqf(x); }
DEV unsigned cvt_pk_bf16(float lo, float hi) { unsigned r; asm volatile("v_cvt_pk_bf16_f32 %0, %1, %2" : "=v"(r) : "v"(lo), "v"(hi)); return r; }
DEV f32x4 mfma8(v8i_t a, v8i_t b, f32x4 c, int sc) { asm volatile("v_mfma_scale_f32_16x16x128_f8f6f4 %0, %1, %2, %0, %3, %3 op_sel_hi:[0,0,0]" : "+v"(c) : "v"(a), "v"(b), "v"(sc)); return c; }
#define MFMA_DRAIN() asm volatile("s_nop 15\n\ts_nop 7" ::: "memory")
DEV unsigned pk_fp8x4(float a, float b, float c, float d) { int r = __builtin_amdgcn_cvt_pk_fp8_f32(a, b, 0, false); r = __builtin_amdgcn_cvt_pk_fp8_f32(c, d, r, true); return (unsigned)r; }
typedef short v4i16_t __attribute__((ext_vector_type(4)));
DEV bf16x4 lds_tr16(LAS unsigned char* p) { return __builtin_bit_cast(bf16x4, __builtin_amdgcn_ds_read_tr16_b64_v4i16((LAS v4i16_t*)p)); }
#define MIX_BAR() do { asm volatile("s_waitcnt lgkmcnt(0)" ::: "memory"); __builtin_amdgcn_s_barrier(); asm volatile("" ::: "memory"); } while (0)
DEV void glds16_asm(const void* gsrc, unsigned lds_dst) { unsigned keep;
    asm volatile("s_mov_b32 %0, m0\n\ts_mov_b32 m0, %2\n\ts_nop 0\n\tglobal_load_lds_dwordx4 %1, off\n\ts_mov_b32 m0, %0" : "=&s"(keep) : "v"(gsrc), "s"(lds_dst) : "memory"); }
#define GLDS16X(g, l) glds16_asm((const void*)(g), (unsigned)RFL((int)(unsigned)(__UINTPTR_TYPE__)(l)))
typedef __amdgpu_buffer_rsrc_t rsrc_t;
DEV rsrc_t make_rsrc(const void* p, unsigned bytes) { return __builtin_amdgcn_make_buffer_rsrc((void*)p, (short)0, (int)bytes, 0x00020000); }
DEV unsigned short bload16(rsrc_t r, unsigned voff, unsigned soff) { return (unsigned short)__builtin_amdgcn_raw_buffer_load_b16(r, (int)voff, (int)soff, 0); }
DEV void bstore16(rsrc_t r, unsigned voff, unsigned soff, unsigned short v) { __builtin_amdgcn_raw_buffer_store_b16(v, r, (int)voff, (int)soff, 0); }
#else
#define LAS
#define GAS
#define DEV inline
#define LDS_RD(T, p) emu_lds_rd<T>((const void*)(p), #p)
#define LDS_WR(T, p, v) emu_lds_wr<T>((void*)(p), (T)(v), #p)
#define WAVE_SYNC() emu_wavesync()
#define BLOCK_BAR() emu_syncthreads()
#define RAW_BAR() emu_syncthreads()
#define WAIT_V(n)
#define WAIT_L(n)
#define SCHED_BAR()
#define SETPRIO(n)
#define GLDS16(g, l) emu_glds16((const void*)(g), (unsigned char*)(l))
#define GLDS16X(g, l) emu_glds16((const void*)(g), (unsigned char*)(l))
#define MFMA16(a, b, c) emu_mfma16(a, b, c)
#define RFL(x) (x)
#define COMPILER_FENCE()
#define OPAQUE(x)
DEV float fexp2(float x) { return exp2f(x); }
DEV float flog2(float x) { return log2f(x); }
DEV float frcp(float x) { return 1.0f / x; }
DEV float frsq(float x) { return 1.0f / sqrtf(x); }
DEV unsigned cvt_pk_bf16(float lo, float hi) { return (unsigned)emu_f2bf(lo) | ((unsigned)emu_f2bf(hi) << 16); }
#define mfma8(a, b, c, sc) emu_mfma8(a, b, c)
#define MFMA_DRAIN()
DEV unsigned pk_fp8x4(float a, float b, float c, float d) { return (unsigned)emu_f2fp8(a) | ((unsigned)emu_f2fp8(b) << 8) | ((unsigned)emu_f2fp8(c) << 16) | ((unsigned)emu_f2fp8(d) << 24); }
#define lds_tr16(p) emu_lds_tr16((const unsigned char*)(p))
#define MIX_BAR() emu_syncthreads()
typedef unsigned char* rsrc_t;
DEV rsrc_t make_rsrc(const void* p, unsigned) { return (unsigned char*)p; }
DEV unsigned short bload16(rsrc_t r, unsigned voff, unsigned soff) { unsigned short v; memcpy(&v, r + (size_t)voff + soff, 2); return v; }
DEV void bstore16(rsrc_t r, unsigned voff, unsigned soff, unsigned short v) { memcpy(r + (size_t)voff + soff, &v, 2); }
#endif

typedef unsigned short bf16;
typedef unsigned u32x4 __attribute__((ext_vector_type(4)));
typedef unsigned u32x2 __attribute__((ext_vector_type(2)));
typedef float f32x2 __attribute__((ext_vector_type(2)));
typedef LAS unsigned char* ldsp;

#ifndef CFG_D
#define CFG_D 4096
#define CFG_B 4
#define CFG_S 4096
#define CFG_HB 8
#endif
constexpr int D = CFG_D, NB = CFG_B, SEQ = CFG_S, M = NB * SEQ;
constexpr int DA = D / 2, HA = DA / 128, DB = D / 2, HB = CFG_HB, DVB = DB / HB, DKB = 128, DQK = HB * DKB;
constexpr int NSG = 2 * HB;
constexpr int NCH = SEQ / 64;
static_assert(DVB == 256 && NSG <= 16 && SEQ % 64 == 0 && M % 256 == 0 && D % 256 == 0, "shape");
constexpr int C_QA = 0, C_FA = DA, C_IA = 2 * DA, C_OGA = 3 * DA, C_ZA = 4 * DA, C_QB = 5 * DA, C_KB = C_QB + DQK, C_VB = C_KB + DQK, C_OGB = C_VB + DB, C_ZB = C_OGB + DB;
constexpr int NPM = C_ZB + DB, C_GA = NPM, C_GB = NPM + D, NP = NPM + 2 * D, D_IN = NP + NSG;
static_assert(NPM % 256 == 0 && NP % 256 == 0, "column map");
constexpr float EPS = 1e-6f;
constexpr float H8_SCALE = 64.0f, W8_SCALE = 1024.0f, G8_DESCALE = 1.0f / (64.0f * 1024.0f);
constexpr float LOG2E = 1.4426950408889634f, LN2 = 0.6931471805599453f;
constexpr int NRS = D / 64;
constexpr int PT_PITCH = M / 64 + 1;
DEV size_t p_off(size_t row, int col) { return ((size_t)(col >> 7) * (size_t)PT_PITCH + (row >> 6)) * 8192 + (row & 63) * 128 + (size_t)(col & 127); }

constexpr size_t al256(size_t x) { return (x + 255) & ~(size_t)255; }
constexpr size_t WS_CTL = 0, CTL_ZERO_BYTES = 65536;
constexpr size_t WS_W1T = 1u << 20;
constexpr size_t WS_WUT = al256(WS_W1T + (size_t)(NP + 16) * D * 2);
constexpr size_t WS_WOT = al256(WS_WUT + (size_t)2 * D * DA * 2);
constexpr size_t WS_HB = al256(WS_WOT + (size_t)D * D * 2);
constexpr size_t WS_P = al256(WS_HB + (size_t)M * D * 2);
constexpr size_t WS_SG = al256(WS_P + (size_t)(NP / 128) * (M / 64 + 1) * 16384 + 4096);
constexpr size_t WS_OAB = al256(WS_SG + (size_t)M * 16 * 4);
constexpr size_t WS_RSS = al256(WS_OAB + (size_t)2 * M * DA * 2);
constexpr size_t WS_SSB = al256(WS_RSS + (size_t)M * NRS * 4);
constexpr size_t WS_SSA = al256(WS_SSB + (size_t)M * HB * 2 * 4);
constexpr size_t WS_H8 = al256(WS_SSA + (size_t)M * HA * 4);
constexpr size_t WS_W8 = al256(WS_H8 + (size_t)M * D);
constexpr size_t WS_END = al256(WS_W8 + (size_t)2 * D * D);
constexpr int CW_BAR = 1024;

constexpr int RING_BYTES = 154624, LDSCTL_OFF = RING_BYTES, MISC_OFF = LDSCTL_OFF + 320, LDS_BYTES = 155648;
constexpr int NWAVES = 8, NTHREADS = 512;

DEV unsigned f2bf(float f) { unsigned u = __builtin_bit_cast(unsigned, f); return (u + 0x7fffu + ((u >> 16) & 1u)) >> 16; }
DEV float bf2f(unsigned b) { return __builtin_bit_cast(float, b << 16); }
DEV unsigned pk2(float lo, float hi) { return f2bf(lo) | (f2bf(hi) << 16); }
DEV float fexp(float x) { return fexp2(x * LOG2E); }
DEV float flog(float x) { return flog2(x) * LN2; }
DEV float sigm(float x) { return frcp(1.0f + fexp(-x)); }
DEV float logsig(float x) { return fminf(x, 0.f) - flog(1.0f + fexp(-fabsf(x))); }
DEV float wave_sum(float v) {
#pragma unroll
    for (int o = 1; o < 64; o <<= 1) v += __shfl_xor(v, o);
    return v;
}

namespace pg8 {
constexpr int BM = 256, BK = 64, HALF = 128, HTB = HALF * BK * 2, STAGE_BYTES = 8 * HTB, NXCD = 8, WGM = 8;
DEV int lds_byte(int r, int c) { const int st = (r >> 4) * 2 + (c >> 5), rr = r & 15, cc = c & 31, ob = rr * 64 + cc * 2; return st * 1024 + (ob ^ (((ob >> 9) & 1) << 5)); }
DEV void stage_rc(int b, int& R, int& C) { const int st = b / 1024, sb = b % 1024, swz = sb ^ (((sb >> 9) & 1) << 5); R = (st >> 1) * 16 + swz / 64; C = (st & 1) * 32 + (swz % 64) / 2; }
DEV int perm32(int rho) { const int n = rho >> 4, i = rho & 15; return 8 * (i >> 2) + 4 * n + (i & 3); }
struct Unit { int pm, pn; };
struct Gemm { const bf16* A; const bf16* Bt; int M, N, K; };
struct StaticOrder {
    int nM, nN, nwg, G, c;
    DEV void init(int M_, int N_, int G_, int c_) { nM = M_ / BM; nN = N_ / BM; nwg = nM * nN; G = G_; c = c_; }
    DEV bool next(int i, Unit& u) const {
        const long L = (long)i * G + c; if (L >= nwg) return false;
        int wgid = (int)L; { const int q = nwg / NXCD, r = nwg % NXCD, xcd = wgid % NXCD, off = wgid / NXCD; wgid = (xcd < r ? xcd * (q + 1) : r * (q + 1) + (xcd - r) * q) + off; }
        const int nig = WGM * nN, gid = wgid / nig, fm = gid * WGM, gsz = (nM - fm) < WGM ? (nM - fm) : WGM;
        u.pm = fm + ((wgid % nig) % gsz); u.pn = (wgid % nig) / gsz; return true;
    }
};
template <class Epi, class Sched, bool ALIGN_EPI = false, bool SP2 = false, int ESZ = 2>
DEV void gemm_phase(ldsp lds, const Gemm g, const Sched& S, const Epi& E) {
    const int tid = threadIdx.x, wid = RFL(tid >> 6), lane = tid & 63, wr = wid >> 2, wc = wid & 3, fr = lane & 15, fq = lane >> 4;
    const int K = g.K * ESZ / 2, nt = K / BK;
    unsigned voffA[2], voffB[2];
#pragma unroll
    for (int i = 0; i < 2; ++i) { int R, C; stage_rc(tid * 16 + i * 8192, R, C); const int Rb = Epi::PERM ? ((R & ~31) + perm32(R & 31)) : R;
        voffA[i] = (unsigned)(R * K + C) * 2u; voffB[i] = (unsigned)(Rb * K + C) * 2u; }
    const size_t kstep = (size_t)(BK * 2);
    const size_t hstep = (size_t)HALF * K * 2;
    const size_t tstep = 2 * hstep;
    const unsigned ldsw = (unsigned)wid * 1024u;
    int aoffk[2], boffk[2];
#pragma unroll
    for (int k = 0; k < 2; ++k) { const int ch = ESZ == 2 ? fq + 4 * k : 2 * fq + k;
        aoffk[k] = lds_byte(wr * 64 + fr, (ch & 3) * 8) + (ch >> 2) * 1024; boffk[k] = lds_byte(wc * 32 + fr, (ch & 3) * 8) + (ch >> 2) * 1024; }
#define PG8_SA(b, h) (((b) * 2 + (h)) * HTB)
#define PG8_SB(b, h) ((4 + (b) * 2 + (h)) * HTB)
#define PG8_STAGE(bufoff, gbase, voff) do { _Pragma("unroll") for (int _i = 0; _i < 2; ++_i) \
        GLDS16((const char*)(gbase) + (voff)[_i], lds + (bufoff) + ldsw + _i * 8192); } while (0)
#define PG8_LDA(dst, b, h) do { _Pragma("unroll") for (int m = 0; m < 4; ++m) { if constexpr (ESZ == 2) { _Pragma("unroll") for (int k = 0; k < 2; ++k) dst[m][k] = *(const LAS bf16x8*)(lds + PG8_SA(b, h) + aoffk[k] + m * 2048); } \
        else dst##8[m] = __builtin_shufflevector(*(const LAS v4i_t*)(lds + PG8_SA(b, h) + aoffk[0] + m * 2048), *(const LAS v4i_t*)(lds + PG8_SA(b, h) + aoffk[1] + m * 2048), 0, 1, 2, 3, 4, 5, 6, 7); } } while (0)
#define PG8_LDB(dst, b, h) do { _Pragma("unroll") for (int n = 0; n < 2; ++n) { if constexpr (ESZ == 2) { _Pragma("unroll") for (int k = 0; k < 2; ++k) dst[n][k] = *(const LAS bf16x8*)(lds + PG8_SB(b, h) + boffk[k] + n * 2048); } \
        else dst##8[n] = __builtin_shufflevector(*(const LAS v4i_t*)(lds + PG8_SB(b, h) + boffk[0] + n * 2048), *(const LAS v4i_t*)(lds + PG8_SB(b, h) + boffk[1] + n * 2048), 0, 1, 2, 3, 4, 5, 6, 7); } } while (0)
#define PG8_MMA(ai, bj, At, Bt) do { SETPRIO(1); _Pragma("unroll") for (int m = 0; m < 4; ++m) _Pragma("unroll") for (int n = 0; n < 2; ++n) { \
        if constexpr (ESZ == 2) { _Pragma("unroll") for (int k = 0; k < 2; ++k) acc[ai][bj][m][n] = MFMA16(Bt[n][k], At[m][k], acc[ai][bj][m][n]); } \
        else acc[ai][bj][m][n] = mfma8(Bt##8[n], At##8[m], acc[ai][bj][m][n], sc8); } SETPRIO(0); } while (0)
    int sc8 = 0x7f7f7f7f; OPAQUE(sc8);
    Unit cur, nxt; int ui = 0;
    if (!S.next(0, cur)) return;
    f32x4 acc[2][2][4][2];
#pragma unroll
    for (int a = 0; a < 2; ++a)
#pragma unroll
        for (int b = 0; b < 2; ++b)
#pragma unroll
            for (int m = 0; m < 4; ++m)
#pragma unroll
                for (int n = 0; n < 2; ++n) acc[a][b][m][n] = (f32x4){0.f, 0.f, 0.f, 0.f};
    bf16x8 At[ESZ == 2 ? 4 : 1][2], B0[ESZ == 2 ? 2 : 1][2], B1[ESZ == 2 ? 2 : 1][2];
    v8i_t At8[ESZ == 1 ? 4 : 1], B08[ESZ == 1 ? 2 : 1], B18[ESZ == 1 ? 2 : 1];
    const char* cA = (const char*)g.A + (size_t)cur.pm * tstep; const char* cB = (const char*)g.Bt + (size_t)cur.pn * tstep;
    if constexpr (SP2) {
        PG8_STAGE(PG8_SB(0, 0), cB, voffB); PG8_STAGE(PG8_SB(0, 1), cB + hstep, voffB); PG8_STAGE(PG8_SA(0, 0), cA, voffA); PG8_STAGE(PG8_SA(0, 1), cA + hstep, voffA);
        if (wr == 1) RAW_BAR();
        WAIT_V(2); RAW_BAR();
        PG8_STAGE(PG8_SB(1, 0), cB + kstep, voffB); PG8_STAGE(PG8_SA(1, 0), cA + kstep, voffA); PG8_STAGE(PG8_SB(1, 1), cB + hstep + kstep, voffB);
        WAIT_V(6); RAW_BAR();
    } else {
        PG8_STAGE(PG8_SB(0, 0), cB, voffB); PG8_STAGE(PG8_SA(0, 0), cA, voffA); PG8_STAGE(PG8_SB(0, 1), cB + hstep, voffB); PG8_STAGE(PG8_SA(0, 1), cA + hstep, voffA);
        if (wr == 1) RAW_BAR();
        WAIT_V(4); RAW_BAR();
        PG8_STAGE(PG8_SB(1, 0), cB + kstep, voffB); PG8_STAGE(PG8_SA(1, 0), cA + kstep, voffA); PG8_STAGE(PG8_SB(1, 1), cB + hstep + kstep, voffB);
        WAIT_V(6); RAW_BAR();
    }
    for (;;) {
        const bool has_next = S.next(ui + 1, nxt);
        const char* nA = has_next ? (const char*)g.A + (size_t)nxt.pm * tstep : cA; const char* nB = has_next ? (const char*)g.Bt + (size_t)nxt.pn * tstep : cB;
        for (int t = 0; t < nt; t += 2) {
            const bool last = (t == nt - 2);
            const char* a1 = cA + (size_t)(t + 1) * kstep;
            const char* a2 = last ? nA : cA + (size_t)(t + 2) * kstep; const char* b2 = last ? nB : cB + (size_t)(t + 2) * kstep;
            const char* a3 = a2 + kstep; const char* b3 = b2 + kstep;
            if constexpr (SP2) {
            PG8_LDB(B0, 0, 0); PG8_LDB(B1, 0, 1); SCHED_BAR(); PG8_LDA(At, 0, 0); PG8_STAGE(PG8_SA(1, 1), a1 + hstep, voffA);
            WAIT_V(8); WAIT_L(0); RAW_BAR(); PG8_MMA(0, 0, At, B0); PG8_MMA(0, 1, At, B1); RAW_BAR(); SCHED_BAR();
            PG8_LDA(At, 0, 1); PG8_STAGE(PG8_SB(0, 0), b2, voffB); PG8_STAGE(PG8_SB(0, 1), b2 + hstep, voffB); PG8_STAGE(PG8_SA(0, 0), a2, voffA);
            WAIT_V(8); WAIT_L(0); RAW_BAR(); PG8_MMA(1, 0, At, B0); PG8_MMA(1, 1, At, B1); RAW_BAR(); SCHED_BAR();
            PG8_LDB(B0, 1, 0); PG8_LDB(B1, 1, 1); SCHED_BAR(); PG8_LDA(At, 1, 0); PG8_STAGE(PG8_SA(0, 1), a2 + hstep, voffA);
            WAIT_V(8); WAIT_L(0); RAW_BAR(); PG8_MMA(0, 0, At, B0); PG8_MMA(0, 1, At, B1); RAW_BAR(); SCHED_BAR();
            PG8_LDA(At, 1, 1); PG8_STAGE(PG8_SB(1, 0), b3, voffB); PG8_STAGE(PG8_SB(1, 1), b3 + hstep, voffB); PG8_STAGE(PG8_SA(1, 0), a3, voffA);
            WAIT_V(8); WAIT_L(0); RAW_BAR(); PG8_MMA(1, 0, At, B0); PG8_MMA(1, 1, At, B1); RAW_BAR(); SCHED_BAR();
            } else {
            PG8_LDB(B0, 0, 0); SCHED_BAR(); PG8_LDA(At, 0, 0); PG8_STAGE(PG8_SA(1, 1), a1 + hstep, voffA);
            WAIT_L(8); RAW_BAR(); WAIT_L(0); PG8_MMA(0, 0, At, B0); RAW_BAR(); SCHED_BAR();
            PG8_LDB(B1, 0, 1); PG8_STAGE(PG8_SB(0, 0), b2, voffB);
            RAW_BAR(); WAIT_L(0); PG8_MMA(0, 1, At, B1); RAW_BAR();
            PG8_LDA(At, 0, 1); PG8_STAGE(PG8_SA(0, 0), a2, voffA);
            RAW_BAR(); WAIT_L(0); PG8_MMA(1, 0, At, B0); RAW_BAR(); SCHED_BAR();
            PG8_STAGE(PG8_SB(0, 1), b2 + hstep, voffB);
            WAIT_V(6); RAW_BAR(); PG8_MMA(1, 1, At, B1); RAW_BAR();
            PG8_LDB(B0, 1, 0); SCHED_BAR(); PG8_LDA(At, 1, 0); PG8_STAGE(PG8_SA(0, 1), a2 + hstep, voffA);
            WAIT_L(8); RAW_BAR(); WAIT_L(0); PG8_MMA(0, 0, At, B0); RAW_BAR(); SCHED_BAR();
            PG8_LDB(B1, 1, 1); PG8_STAGE(PG8_SB(1, 0), b3, voffB);
            RAW_BAR(); WAIT_L(0); PG8_MMA(0, 1, At, B1); RAW_BAR();
            PG8_LDA(At, 1, 1); PG8_STAGE(PG8_SA(1, 0), a3, voffA);
            RAW_BAR(); WAIT_L(0); PG8_MMA(1, 0, At, B0); RAW_BAR(); SCHED_BAR();
            PG8_STAGE(PG8_SB(1, 1), b3 + hstep, voffB);
            WAIT_V(6); RAW_BAR(); PG8_MMA(1, 1, At, B1); RAW_BAR();
            }
        }
        if constexpr (ALIGN_EPI) { if (wr == 0) RAW_BAR(); }
        if constexpr (ESZ == 1) { MFMA_DRAIN();
#pragma unroll
            for (int a = 0; a < 2; ++a)
#pragma unroll
                for (int b = 0; b < 2; ++b) asm volatile("" : "+v"(acc[a][b][0][0]), "+v"(acc[a][b][0][1]), "+v"(acc[a][b][1][0]), "+v"(acc[a][b][1][1]), "+v"(acc[a][b][2][0]), "+v"(acc[a][b][2][1]), "+v"(acc[a][b][3][0]), "+v"(acc[a][b][3][1])); }
        E(acc, cur, wr, wc, fr, fq);
        if (!has_next) break;
#pragma unroll
        for (int a = 0; a < 2; ++a)
#pragma unroll
            for (int b = 0; b < 2; ++b)
#pragma unroll
                for (int m = 0; m < 4; ++m)
#pragma unroll
                    for (int n = 0; n < 2; ++n) acc[a][b][m][n] = (f32x4){0.f, 0.f, 0.f, 0.f};
        cur = nxt; cA = nA; cB = nB; ++ui;
        if constexpr (ALIGN_EPI) { if (wr == 1) RAW_BAR(); }
    }
    WAIT_V(0);
    if constexpr (!ALIGN_EPI) { if (wr == 0) RAW_BAR(); }
    RAW_BAR();
#undef PG8_SA
#undef PG8_SB
#undef PG8_STAGE
#undef PG8_LDA
#undef PG8_LDB
#undef PG8_MMA
}
}

struct EpiP {
    static constexpr bool PERM = true;
    bf16* O;
    DEV void operator()(const f32x4 (&acc)[2][2][4][2], const pg8::Unit& u, int wr, int wc, int fr, int fq) const {
        const int row0 = u.pm * 256 + wr * 64 + fr, col0 = u.pn * 256 + wc * 32 + 8 * fq;
#pragma unroll
        for (int ai = 0; ai < 2; ++ai)
#pragma unroll
            for (int m = 0; m < 4; ++m) { const size_t row = (size_t)(row0 + ai * 128 + m * 16);
#pragma unroll
                for (int bj = 0; bj < 2; ++bj) { const f32x4 v0 = acc[ai][bj][m][0], v1 = acc[ai][bj][m][1];
                    u32x4 w; w.x = cvt_pk_bf16(v0[0], v0[1]); w.y = cvt_pk_bf16(v0[2], v0[3]); w.z = cvt_pk_bf16(v1[0], v1[1]); w.w = cvt_pk_bf16(v1[2], v1[3]);
                    *(u32x4*)(O + p_off(row, col0 + bj * 128)) = w; } }
    }
};
struct EpiP8 {
    static constexpr bool PERM = true;
    bf16* O;
    DEV void operator()(const f32x4 (&acc)[2][2][4][2], const pg8::Unit& u, int wr, int wc, int fr, int fq) const {
        const int row0 = u.pm * 256 + wr * 64 + fr, col0 = NPM + u.pn * 256 + wc * 32 + 8 * fq;
#pragma unroll
        for (int ai = 0; ai < 2; ++ai)
#pragma unroll
            for (int m = 0; m < 4; ++m) { const size_t row = (size_t)(row0 + ai * 128 + m * 16);
#pragma unroll
                for (int bj = 0; bj < 2; ++bj) { const f32x4 v0 = acc[ai][bj][m][0] * G8_DESCALE, v1 = acc[ai][bj][m][1] * G8_DESCALE;
                    u32x4 w; w.x = cvt_pk_bf16(v0[0], v0[1]); w.y = cvt_pk_bf16(v0[2], v0[3]); w.z = cvt_pk_bf16(v1[0], v1[1]); w.w = cvt_pk_bf16(v1[2], v1[3]);
                    *(u32x4*)(O + p_off(row, col0 + bj * 128)) = w; } }
    }
};
struct SchedUp {
    pg8::StaticOrder so;
    DEV bool next(int i, pg8::Unit& u) const { if (!so.next(i >> 1, u)) return false; if (i & 1) { u.pm += M / 256; u.pn += D / 256; } return true; }
};
struct EpiUp {
    static constexpr bool PERM = true;
    bf16* Y; const bf16* P;
    DEV void operator()(const f32x4 (&acc)[2][2][4][2], const pg8::Unit& u, int wr, int wc, int fr, int fq) const {
        const int br = u.pm >= M / 256 ? 1 : 0, pm = u.pm - br * (M / 256), pn = u.pn - br * (D / 256);
        const int row0 = pm * 256 + wr * 64 + fr, col0 = pn * 256 + wc * 32 + 8 * fq, gcol = (br ? C_GB : C_GA) + col0;
#pragma unroll
        for (int ai = 0; ai < 2; ++ai)
#pragma unroll
            for (int m = 0; m < 4; ++m) { const size_t row = (size_t)(row0 + ai * 128 + m * 16);
#pragma unroll
                for (int bj = 0; bj < 2; ++bj) {
                    const u32x4 g8 = *(const u32x4*)(P + p_off(row, gcol + bj * 128));
                    bf16* yp = Y + row * D + col0 + bj * 128;
                    u32x4 y8 = (u32x4){0u, 0u, 0u, 0u}; if (br) y8 = *(const u32x4*)yp;
                    const f32x4 v0 = acc[ai][bj][m][0], v1 = acc[ai][bj][m][1];
                    float o[8];
#pragma unroll
                    for (int k = 0; k < 8; ++k) { const unsigned gw = g8[k >> 1], yw = y8[k >> 1]; const float gv = bf2f((k & 1) ? (gw >> 16) : (gw & 0xffffu)), yv = bf2f((k & 1) ? (yw >> 16) : (yw & 0xffffu));
                        const float a = k < 4 ? v0[k & 3] : v1[k & 3]; o[k] = yv + sigm(gv) * a; }
                    u32x4 w; w.x = cvt_pk_bf16(o[0], o[1]); w.y = cvt_pk_bf16(o[2], o[3]); w.z = cvt_pk_bf16(o[4], o[5]); w.w = cvt_pk_bf16(o[6], o[7]);
                    *(u32x4*)yp = w; } }
    }
};
struct EpiOut {
    static constexpr bool PERM = false;
    float* C; float* RSS;
    DEV void operator()(const f32x4 (&acc)[2][2][4][2], const pg8::Unit& u, int wr, int wc, int fr, int fq) const {
        const int row0 = u.pm * 256 + wr * 64 + fr, col0 = u.pn * 256 + wc * 32 + 4 * fq;
#pragma unroll
        for (int ai = 0; ai < 2; ++ai)
#pragma unroll
            for (int m = 0; m < 4; ++m) { const size_t row = (size_t)(row0 + ai * 128 + m * 16); float* rowp = C + row * D + col0; float ss = 0.f;
#pragma unroll
                for (int bj = 0; bj < 2; ++bj)
#pragma unroll
                    for (int n = 0; n < 2; ++n) { const f32x4 v = acc[ai][bj][m][n]; *(f32x4*)(rowp + bj * 128 + n * 16) = v; ss += (v[0] * v[0] + v[1] * v[1]) + (v[2] * v[2] + v[3] * v[3]); }
                ss += __shfl_xor(ss, 16); ss += __shfl_xor(ss, 32);
                if (fq == 0) RSS[row * NRS + u.pn * 4 + wc] = ss; }
    }
};

#ifndef EMU
typedef GAS unsigned gu32;
#define RLX_AGENT __ATOMIC_RELAXED, __HIP_MEMORY_SCOPE_AGENT
#define XB_TMO      128
#define XB_XCNT(j)  (256  + 64 * (j))
#define XB_XSUB(j)  (1280 + 64 * (j))
#define XB_XGEN(j)  (2304 + 64 * (j))
#define XB_TOP      3328
#define XB_TOPGEN   3392
#define XCD_BAR_WORDS 3456
#define XB_SPIN_CAP (1u << 22)
__device__ __forceinline__ unsigned xb_ld(unsigned* p)              { return __hip_atomic_load(p, __ATOMIC_RELAXED, __HIP_MEMORY_SCOPE_AGENT); }
__device__ __forceinline__ unsigned xb_add(unsigned* p, unsigned v) { return __hip_atomic_fetch_add(p, v, __ATOMIC_RELAXED, __HIP_MEMORY_SCOPE_AGENT); }
__device__ __forceinline__ unsigned xb_xcc_id() { return (unsigned)__builtin_amdgcn_s_getreg((3 << 11) | 20) & 0xFu; }
#define XB_SPIN(cond, bar) do { unsigned _sp = 0; while (cond) { __builtin_amdgcn_s_sleep(1); \
    if ((++_sp & 255u) == 0u) { if (xb_ld(&(bar)[XB_TMO])) break; if (_sp > XB_SPIN_CAP) { atomicAdd(&(bar)[XB_TMO], 1u); break; } } } } while (0)
struct XcdBarrier { unsigned* bar; unsigned x; volatile LAS unsigned* st; };
__device__ __forceinline__ XcdBarrier xcd_barrier_post(unsigned* bar, volatile LAS unsigned* st) {
    XcdBarrier b; b.bar = bar; b.x = xb_xcc_id(); b.st = st;
    if (threadIdx.x == 0) (void)xb_add(&bar[XB_XCNT(b.x)], 1u);
    return b;
}
__device__ __forceinline__ void xcd_barrier_complete(unsigned* bar, unsigned x, unsigned& nloc, unsigned& nx) {
    const unsigned G = gridDim.x * gridDim.y * gridDim.z;
    unsigned sum, cnt, mine, sp = 0u;
    for (;;) {
        sum = 0u; cnt = 0u; mine = 0u;
#pragma unroll
        for (unsigned j = 0; j < 16; ++j) { const unsigned c = xb_ld(&bar[XB_XCNT(j)]); sum += c; cnt += (c > 0u) ? 1u : 0u; mine = (j == x) ? c : mine; }
        if (sum == G) break;
        __builtin_amdgcn_s_sleep(1);
        if ((++sp & 255u) == 0u) { if (xb_ld(&bar[XB_TMO])) break; if (sp > XB_SPIN_CAP) { atomicAdd(&bar[XB_TMO], 1u); break; } }
    }
    nloc = mine > 0u ? mine : 1u; nx = cnt > 0u ? cnt : 1u;
}
__device__ __forceinline__ void xcd_barrier(const XcdBarrier& b) {
    asm volatile("s_waitcnt vmcnt(0)" ::: "memory");
    __syncthreads();
    if (threadIdx.x == 0) {
        unsigned* bar = b.bar;
        __builtin_amdgcn_s_waitcnt(0);
        unsigned nloc = b.st[0], nx = b.st[1];
        if (nloc == 0u) { xcd_barrier_complete(bar, b.x, nloc, nx); b.st[0] = nloc; b.st[1] = nx; }
        const unsigned old = xb_add(&bar[XB_XSUB(b.x)], 1u);
        const unsigned gen = old / nloc;
        if (old + 1u == (gen + 1u) * nloc) {
            __builtin_amdgcn_fence(__ATOMIC_RELEASE, "agent");
            asm volatile("s_waitcnt vmcnt(0)" ::: "memory");
            const unsigned og = xb_add(&bar[XB_TOP], 1u);
            const unsigned tg = og / nx;
            if (og + 1u == (tg + 1u) * nx) xb_add(&bar[XB_TOPGEN], 1u);
            else XB_SPIN(xb_ld(&bar[XB_TOPGEN]) == tg, bar);
            __builtin_amdgcn_fence(__ATOMIC_ACQUIRE, "agent");
            xb_add(&bar[XB_XGEN(b.x)], 1u);
            asm volatile("s_waitcnt vmcnt(0)" ::: "memory");
        } else {
            XB_SPIN(xb_ld(&bar[XB_XGEN(b.x)]) == gen, bar);
            __builtin_amdgcn_fence(__ATOMIC_ACQUIRE, "agent");
            asm volatile("s_waitcnt vmcnt(0)" ::: "memory");
        }
    }
    __syncthreads();
}
#endif

struct Args { const float* in[14]; float* out; unsigned char* ws; int ph_lo, ph_hi; };

DEV float clamp8(float x) { return fminf(fmaxf(x, -448.0f), 448.0f); }
template <bool FP8>
DEV void p0_transpose_item(const float* W, int ldw, int K, void* WT_, int k0, int c0, int r0, int nvalid, ldsp scr, int lane) {
    const int kr = lane >> 4, n4 = 4 * (lane & 15);
    f32x4 v[16];
#pragma unroll
    for (int i = 0; i < 16; ++i) v[i] = (n4 < nvalid) ? *(const f32x4*)(W + (size_t)(k0 + 4 * i + kr) * ldw + c0 + n4) : (f32x4){0.f, 0.f, 0.f, 0.f};
#pragma unroll
    for (int i = 0; i < 16; ++i) LDS_WR(f32x4, scr + ((4 * i + kr) * 68 + n4) * 4, v[i]);
    WAVE_SYNC();
    if constexpr (!FP8) {
        bf16* WT = (bf16*)WT_;
        const int c = lane & 7;
#pragma unroll
        for (int j = 0; j < 8; ++j) { const int n = (lane >> 3) + 8 * j; ldsp sp = scr + ((8 * c) * 68 + n) * 4;
            u32x4 o; o.x = pk2(LDS_RD(float, sp + 0 * 272), LDS_RD(float, sp + 1 * 272)); o.y = pk2(LDS_RD(float, sp + 2 * 272), LDS_RD(float, sp + 3 * 272));
            o.z = pk2(LDS_RD(float, sp + 4 * 272), LDS_RD(float, sp + 5 * 272)); o.w = pk2(LDS_RD(float, sp + 6 * 272), LDS_RD(float, sp + 7 * 272));
            if (n < nvalid) *(u32x4*)(WT + (size_t)(r0 + n) * K + k0 + 8 * c) = o; }
    } else {
        unsigned char* WT = (unsigned char*)WT_;
        const int c = lane & 3;
#pragma unroll
        for (int j = 0; j < 4; ++j) { const int n = (lane >> 2) + 16 * j; ldsp sp = scr + ((16 * c) * 68 + n) * 4; float f[16];
#pragma unroll
            for (int i = 0; i < 16; ++i) f[i] = clamp8(LDS_RD(float, sp + i * 272) * W8_SCALE);
            u32x4 o; o.x = pk_fp8x4(f[0], f[1], f[2], f[3]); o.y = pk_fp8x4(f[4], f[5], f[6], f[7]); o.z = pk_fp8x4(f[8], f[9], f[10], f[11]); o.w = pk_fp8x4(f[12], f[13], f[14], f[15]);
            if (n < nvalid) *(u32x4*)(WT + (size_t)(r0 + n) * K + k0 + 16 * c) = o; }
    }
    WAVE_SYNC();
}

constexpr int MS = 272, MS64 = 144;
constexpr int RAW_A = 0, RAW_B = RAW_A + 68 * 256, RAW_I = RAW_B + 68 * 256;
constexpr int MX_QR = RAW_I + 2 * 64 * 256, MX_KR = MX_QR + 64 * MS, MX_KW = MX_KR + 64 * MS, MX_PS = MX_KW + 64 * MS, MX_SM = MX_PS + 64 * MS64;
constexpr int SM_TOT = MX_SM, SM_BME = SM_TOT + 8 * 128 * 4, SM_EG = SM_BME + 512, SM_EGM = SM_EG + 512, SM_SSQ = SM_EGM + 512;
constexpr int SM_A = SM_SSQ + 2 * 64 * 8 * 4, SM_MX = SM_A + 256, SM_INT = SM_MX + 256, SM_EMT = SM_INT + 256, SM_WGT = SM_EMT + 256, SM_SCAL = SM_WGT + 256;
constexpr int SM_NV = SM_SCAL + 64, SM_NACC = SM_NV + 512, SM_RSUM = SM_NACC + 8 * 512, SM_QN = SM_RSUM + 64 * 2 * 4, SM_CW = SM_QN + 256, MX_END = SM_CW + 10 * 512;
static_assert(MX_END <= RING_BYTES, "mixer LDS");

DEV bf16x8 frag16(ldsp buf, int stride, int row0, int ks, int lane) { return LDS_RD(bf16x8, buf + (row0 + (lane & 15)) * stride + ks * 64 + (lane >> 4) * 16); }
DEV bf16x8 frag8x2(ldsp buf, int stride, int row0, int ks, int lane) {
    ldsp p = buf + (row0 + (lane & 15)) * stride + ks * 64 + (lane >> 4) * 8;
    const bf16x4 lo = LDS_RD(bf16x4, p), hi = LDS_RD(bf16x4, p + 32);
    return (bf16x8){lo[0], lo[1], lo[2], lo[3], hi[0], hi[1], hi[2], hi[3]};
}
DEV bf16x8 frag_tr(ldsp img, int n0, int ks, int lane, int stride = 256) {
    ldsp p = img + (32 * ks + 8 * (lane >> 4) + ((lane & 15) >> 2)) * stride + (n0 + 4 * (lane & 3)) * 2;
    const bf16x4 lo = lds_tr16(p), hi = lds_tr16(p + 4 * stride);
    return (bf16x8){lo[0], lo[1], lo[2], lo[3], hi[0], hi[1], hi[2], hi[3]};
}
DEV bf16x8 pack_state(const f32x4 a, const f32x4 b) {
    u32x4 w; w.x = pk2(a[0], a[1]); w.y = pk2(a[2], a[3]); w.z = pk2(b[0], b[1]); w.w = pk2(b[2], b[3]);
    return __builtin_bit_cast(bf16x8, w);
}
DEV void dma_tile(const bf16* P, size_t tok0, int rowoff, int col0, int ninst, ldsp dst, int wave, int lane) {
    const bf16* src = P + p_off(tok0, col0) + (long)(rowoff + (lane >> 4)) * 128 + 8 * (lane & 15);
    for (int i = wave; i < ninst; i += NWAVES) GLDS16X(src + i * 512, dst + i * 1024);
}

DEV float sigm2(float x) { return frcp(1.0f + fexp2(-LOG2E * x)); }
DEV u32x2 pack4(const f32x4 v) { u32x2 w; w.x = cvt_pk_bf16(v[0], v[1]); w.y = cvt_pk_bf16(v[2], v[3]); return w; }

DEV void mixer_a_job(const Args& args, ldsp lds, int b, int h, int tid_) {
    const int wave = RFL(tid_ >> 6);
    const bf16* P = (const bf16*)(args.ws + WS_P);
    bf16* OA = (bf16*)(args.ws + WS_OAB);
    float* SSA = (float*)(args.ws + WS_SSA);
    const float* lbl = args.in[3];
    float lbv[2];
#pragma unroll
    for (int e = 0; e < 2; ++e) { const int col = h * 128 + 2 * (tid_ & 63) + e; lbv[e] = frcp(1.0f + fexp(lbl[DA + col] - lbl[col])); }
    f32x4 st[8], o[4];
#pragma unroll
    for (int t = 0; t < 8; ++t) st[t] = (f32x4){0.f, 0.f, 0.f, 0.f};
#pragma unroll
    for (int ct = 0; ct < 4; ++ct) o[ct] = (f32x4){0.f, 0.f, 0.f, 0.f};
    {
        const size_t tk = (size_t)b * SEQ;
        dma_tile(P, tk, 0, C_QA + h * 128, 16, lds + RAW_A, wave, tid_ & 63); dma_tile(P, tk, 0, C_FA + h * 128, 16, lds + RAW_B, wave, tid_ & 63); dma_tile(P, tk, 0, C_IA + h * 128, 16, lds + RAW_I, wave, tid_ & 63);
    }
    for (int j = 0; j <= NCH; ++j) {
        int tidj = tid_; OPAQUE(tidj);
        const int lane = tidj & 63, q4 = lane >> 4, l15 = lane & 15;
        const size_t tk0 = (size_t)b * SEQ + 64 * j;
        if (j <= 1) WAIT_V(0); else WAIT_V(4);
        MIX_BAR();
        if (j > 0 && wave == 0) { ldsp ssq = lds + SM_SSQ + ((j - 1) & 1) * 2048; const f32x4 s0 = LDS_RD(f32x4, ssq + (lane * 8) * 4), s1 = LDS_RD(f32x4, ssq + (lane * 8 + 4) * 4);
            SSA[(tk0 - 64 + lane) * HA + h] = ((s0[0] + s0[1]) + (s0[2] + s0[3])) + ((s1[0] + s1[1]) + (s1[2] + s1[3])); }
        if (j < NCH) {
            float lf[8][2], qv[8][2], kv[8][2];
#pragma unroll
            for (int c = 0; c < 8; ++c) { const unsigned fw = LDS_RD(unsigned, lds + RAW_B + (8 * wave + c) * 256 + lane * 4), qw = LDS_RD(unsigned, lds + RAW_A + (8 * wave + c) * 256 + lane * 4);
#pragma unroll
                for (int e = 0; e < 2; ++e) { const float f = lbv[e] + (1.0f - lbv[e]) * sigm2(__builtin_bit_cast(float, e ? (fw & 0xffff0000u) : (fw << 16))); lf[c][e] = flog2(f); kv[c][e] = 1.0f - f; qv[c][e] = __builtin_bit_cast(float, e ? (qw & 0xffff0000u) : (qw << 16)); } }
#pragma unroll
            for (int c = 1; c < 8; ++c) { lf[c][0] += lf[c - 1][0]; lf[c][1] += lf[c - 1][1]; }
            LDS_WR(f32x2, lds + SM_TOT + (wave * 128 + 2 * lane) * 4, ((f32x2){lf[7][0], lf[7][1]}));
            MIX_BAR();
            if (j + 1 < NCH) { const size_t tk = tk0 + 64;
                dma_tile(P, tk, 0, C_QA + h * 128, 16, lds + RAW_A, wave, lane); dma_tile(P, tk, 0, C_FA + h * 128, 16, lds + RAW_B, wave, lane); dma_tile(P, tk, 0, C_IA + h * 128, 16, lds + RAW_I + ((j + 1) & 1) * 16384, wave, lane); }
            {
                f32x2 off = (f32x2){0.f, 0.f}, bmid = (f32x2){0.f, 0.f}, g = (f32x2){0.f, 0.f};
#pragma unroll
                for (int w = 0; w < 8; ++w) { const f32x2 t = LDS_RD(f32x2, lds + SM_TOT + (w * 128 + 2 * lane) * 4); if (w < wave) off += t; if (w < 4) bmid += t; g += t; }
                unsigned kr[8];
#pragma unroll
                for (int c = 0; c < 8; ++c) { float qr[2], kk[2];
#pragma unroll
                    for (int e = 0; e < 2; ++e) { const float t1 = lf[c][e] + off[e] - bmid[e]; qr[e] = qv[c][e] * fexp2(t1); kk[e] = kv[c][e] * fexp2(-t1); }
                    LDS_WR(unsigned, lds + MX_QR + (8 * wave + c) * MS + lane * 4, cvt_pk_bf16(qr[0], qr[1]));
                    kr[c] = cvt_pk_bf16(kk[0], kk[1]);
                    LDS_WR(unsigned, lds + MX_KR + (8 * wave + c) * MS + lane * 4, kr[c]); }
                if (wave == 0) { LDS_WR(f32x2, lds + SM_BME + lane * 8, ((f32x2){fexp2(bmid[0]), fexp2(bmid[1])})); LDS_WR(f32x2, lds + SM_EG + lane * 8, ((f32x2){fexp2(g[0]), fexp2(g[1])}));
                    LDS_WR(f32x2, lds + SM_EGM + lane * 8, ((f32x2){fexp2(g[0] - bmid[0]), fexp2(g[1] - bmid[1])})); }
            }
        }
        MIX_BAR();
        if (j > 0) {
#pragma unroll
            for (int ct = 0; ct < 4; ++ct) *(u32x2*)(OA + (tk0 - 64 + 16 * ct + l15) * DA + h * 128 + 16 * wave + 4 * q4) = pack4(o[ct]);
        }
        if (j == NCH) break;
        {
            const int ct = wave >> 1, st0 = 2 * (wave & 1);
            f32x4 sc[2] = {(f32x4){0.f, 0.f, 0.f, 0.f}, (f32x4){0.f, 0.f, 0.f, 0.f}};
#pragma unroll
            for (int ks = 0; ks < 4; ++ks) { const bf16x8 qf = frag16(lds + MX_QR, MS, 16 * ct, ks, lane);
#pragma unroll
                for (int n = 0; n < 2; ++n) { const bf16x8 kf_ = frag16(lds + MX_KR, MS, 16 * (st0 + n), ks, lane); sc[n] = MFMA16(kf_, qf, sc[n]); } }
#pragma unroll
            for (int n = 0; n < 2; ++n) { const int c = 16 * ct + l15, s0_ = 16 * (st0 + n) + 4 * q4; f32x4 v = sc[n];
#pragma unroll
                for (int r = 0; r < 4; ++r) v[r] = (s0_ + r <= c) ? v[r] : 0.f;
                LDS_WR(u32x2, lds + MX_PS + c * MS64 + s0_ * 2, pack4(v)); }
        }
        MIX_BAR();
        {
            ldsp rawi = lds + RAW_I + (j & 1) * 16384;
            bf16x8 bv[2];
#pragma unroll
            for (int ks = 0; ks < 2; ++ks) bv[ks] = frag_tr(rawi, 16 * wave, ks, lane);
#pragma unroll
            for (int ct = 0; ct < 4; ++ct) o[ct] = (f32x4){0.f, 0.f, 0.f, 0.f};
#pragma unroll
            for (int ks = 0; ks < 2; ++ks)
#pragma unroll
                for (int ct = 0; ct < 4; ++ct) { const bf16x8 pf = frag16(lds + MX_PS, MS64, 16 * ct, ks, lane); o[ct] = MFMA16(bv[ks], pf, o[ct]); }
#pragma unroll
            for (int ks = 0; ks < 4; ++ks) {
                const f32x4 e0 = LDS_RD(f32x4, lds + SM_BME + (32 * ks + 4 * q4) * 4), e1 = LDS_RD(f32x4, lds + SM_BME + (32 * ks + 16 + 4 * q4) * 4);
                u32x4 w; const f32x4 a0 = st[2 * ks] * e0, a1 = st[2 * ks + 1] * e1; w.x = cvt_pk_bf16(a0[0], a0[1]); w.y = cvt_pk_bf16(a0[2], a0[3]); w.z = cvt_pk_bf16(a1[0], a1[1]); w.w = cvt_pk_bf16(a1[2], a1[3]);
                const bf16x8 sf = __builtin_bit_cast(bf16x8, w);
#pragma unroll
                for (int ct = 0; ct < 4; ++ct) { const bf16x8 qf = frag8x2(lds + MX_QR, MS, 16 * ct, ks, lane); o[ct] = MFMA16(sf, qf, o[ct]); } }
#pragma unroll
            for (int t = 0; t < 8; ++t) {
                f32x4 u = (f32x4){0.f, 0.f, 0.f, 0.f};
#pragma unroll
                for (int ks = 0; ks < 2; ++ks) { const bf16x8 a = frag_tr(lds + MX_KR, 16 * t, ks, lane, MS); u = MFMA16(a, bv[ks], u); }
                const f32x4 eg = LDS_RD(f32x4, lds + SM_EG + (16 * t + 4 * q4) * 4), egm = LDS_RD(f32x4, lds + SM_EGM + (16 * t + 4 * q4) * 4); st[t] = eg * st[t] + egm * u; }
            ldsp ssq = lds + SM_SSQ + (j & 1) * 2048;
#pragma unroll
            for (int ct = 0; ct < 4; ++ct) { float s = (o[ct][0] * o[ct][0] + o[ct][1] * o[ct][1]) + (o[ct][2] * o[ct][2] + o[ct][3] * o[ct][3]); s += __shfl_xor(s, 16); s += __shfl_xor(s, 32);
                LDS_WR(float, ssq + ((16 * ct + l15) * 8 + wave) * 4, s); }
        }
    }
}

DEV float scan_add(float v, int lane) {
#pragma unroll
    for (int o = 1; o < 64; o <<= 1) { const float t = __shfl_up(v, o); if (lane >= o) v += t; }
    return v;
}
DEV float scan_max(float v, int lane) {
#pragma unroll
    for (int o = 1; o < 64; o <<= 1) { const float t = __shfl_up(v, o); if (lane >= o) v = fmaxf(v, t); }
    return v;
}

DEV void mixer_b_job(const Args& args, ldsp lds, int b, int h, int half, int tid_) {
    const int wave = RFL(tid_ >> 6);
    const int vbase = h * 256 + 128 * half;
    const bf16* P = (const bf16*)(args.ws + WS_P);
    bf16* OB = (bf16*)(args.ws + WS_OAB) + (size_t)M * DA;
    const float* SG = (const float*)(args.ws + WS_SG);
    float* SSB = (float*)(args.ws + WS_SSB);
    const float* cw = args.in[4]; const float* cb = args.in[5];
    if (tid_ < 128) { const int col = h * 128 + tid_;
#pragma unroll
        for (int k = 0; k < 4; ++k) { LDS_WR(float, lds + SM_CW + (k * 128 + tid_) * 4, cw[k * (2 * DQK) + col]); LDS_WR(float, lds + SM_CW + ((4 + k) * 128 + tid_) * 4, cw[k * (2 * DQK) + DQK + col]); }
        LDS_WR(float, lds + SM_CW + (8 * 128 + tid_) * 4, cb[col]); LDS_WR(float, lds + SM_CW + (9 * 128 + tid_) * 4, cb[DQK + col]); }
    const float big = args.in[6][h], bfg = args.in[7][h];
    f32x4 st[8], hv[4];
#pragma unroll
    for (int t = 0; t < 8; ++t) st[t] = (f32x4){0.f, 0.f, 0.f, 0.f};
#pragma unroll
    for (int ct = 0; ct < 4; ++ct) hv[ct] = (f32x4){0.f, 0.f, 0.f, 0.f};
    float mcar = 0.f;
    if (wave < 2) LDS_WR(float, lds + SM_NV + tid_ * 4, 0.f);
    float sg_f = 0.f, sg_i = 0.f;
    if (wave == 0) { const size_t t = (size_t)b * SEQ + (tid_ & 63); sg_f = SG[t * 16 + HB + h]; sg_i = SG[t * 16 + h]; }
    {
        const size_t tk = (size_t)b * SEQ;
        dma_tile(P, tk, -3, C_QB + h * 128, 17, lds + RAW_A, wave, tid_ & 63); dma_tile(P, tk, -3, C_KB + h * 128, 17, lds + RAW_B, wave, tid_ & 63); dma_tile(P, tk, 0, C_VB + vbase, 16, lds + RAW_I, wave, tid_ & 63);
    }
    for (int j = 0; j <= NCH; ++j) {
        const size_t tk0 = (size_t)b * SEQ + 64 * j;
        int tidj = tid_; OPAQUE(tidj);
        const int tid = tidj, lane = tidj & 63, q4 = lane >> 4, l15 = lane & 15;
        if (j <= 1) WAIT_V(0); else WAIT_V(4);
        MIX_BAR();
        if (j > 0 && wave == 0) { ldsp ssq = lds + SM_SSQ + ((j - 1) & 1) * 2048; const f32x4 s0 = LDS_RD(f32x4, ssq + (lane * 8) * 4), s1 = LDS_RD(f32x4, ssq + (lane * 8 + 4) * 4);
            SSB[(tk0 - 64 + lane) * (2 * HB) + 2 * h + half] = ((s0[0] + s0[1]) + (s0[2] + s0[3])) + ((s1[0] + s1[1]) + (s1[2] + s1[3])); }
        float kf[8][2], decay = 0.f;
        if (j < NCH) {
            f32x2 wq[4], wk[4];
#pragma unroll
            for (int k = 0; k < 4; ++k) { wq[k] = LDS_RD(f32x2, lds + SM_CW + (k * 128 + 2 * lane) * 4); wk[k] = LDS_RD(f32x2, lds + SM_CW + ((4 + k) * 128 + 2 * lane) * 4); }
            const f32x2 bq = LDS_RD(f32x2, lds + SM_CW + (8 * 128 + 2 * lane) * 4), bk = LDS_RD(f32x2, lds + SM_CW + (9 * 128 + 2 * lane) * 4);
            unsigned uq[11], uk[11];
#pragma unroll
            for (int i = 0; i < 11; ++i) { const bool neg = (64 * j + 8 * wave + i - 3) < 0;
                const unsigned a = LDS_RD(unsigned, lds + RAW_A + (8 * wave + i) * 256 + lane * 4), bb = LDS_RD(unsigned, lds + RAW_B + (8 * wave + i) * 256 + lane * 4); uq[i] = neg ? 0u : a; uk[i] = neg ? 0u : bb; }
#pragma unroll
            for (int c = 0; c < 8; ++c) { float qq[2];
#pragma unroll
                for (int e = 0; e < 2; ++e) { float yq = bq[e], yk = bk[e];
#pragma unroll
                    for (int k = 0; k < 4; ++k) { yq += wq[k][e] * __builtin_bit_cast(float, e ? (uq[c + k] & 0xffff0000u) : (uq[c + k] << 16)); yk += wk[k][e] * __builtin_bit_cast(float, e ? (uk[c + k] & 0xffff0000u) : (uk[c + k] << 16)); }
                    qq[e] = yq * sigm2(yq); kf[c][e] = yk * sigm2(yk) * 0.08838834764831845f; }
                LDS_WR(unsigned, lds + MX_QR + (8 * wave + c) * MS + lane * 4, cvt_pk_bf16(qq[0], qq[1]));
                LDS_WR(unsigned, lds + MX_KR + (8 * wave + c) * MS + lane * 4, cvt_pk_bf16(kf[c][0], kf[c][1])); }
            if (wave == 0) {
                const float fp = sg_f + bfg, ig = sg_i + big;
                if (j + 1 < NCH) { sg_f = SG[(tk0 + 64 + lane) * 16 + HB + h]; sg_i = SG[(tk0 + 64 + lane) * 16 + h]; }
                const float bc = scan_add(logsig(fp), lane), a = ig - bc, mx = fmaxf(mcar, scan_max(a, lane));
                const float g = __shfl(bc, 63), m63 = __shfl(mx, 63);
                LDS_WR(float, lds + SM_A + lane * 4, a * LOG2E); LDS_WR(float, lds + SM_MX + lane * 4, mx * LOG2E); LDS_WR(float, lds + SM_INT + lane * 4, fexp(mcar - mx));
                LDS_WR(float, lds + SM_EMT + lane * 4, fexp(-(bc + mx))); LDS_WR(float, lds + SM_WGT + lane * 4, fexp(a - m63));
                if (lane == 0) { LDS_WR(float, lds + SM_SCAL, fexp(mcar - m63)); LDS_WR(float, lds + SM_SCAL + 4, g + m63); }
            }
            MIX_BAR();
            if (j + 1 < NCH) { const size_t tk = tk0 + 64;
                dma_tile(P, tk, -3, C_QB + h * 128, 17, lds + RAW_A, wave, lane); dma_tile(P, tk, -3, C_KB + h * 128, 17, lds + RAW_B, wave, lane); dma_tile(P, tk, 0, C_VB + vbase, 16, lds + RAW_I + ((j + 1) & 1) * 16384, wave, lane); }
            decay = LDS_RD(float, lds + SM_SCAL);
            mcar = LDS_RD(float, lds + SM_SCAL + 4);
            {
                float na[2] = {0.f, 0.f};
#pragma unroll
                for (int c = 0; c < 8; ++c) { const float w_ = LDS_RD(float, lds + SM_WGT + (8 * wave + c) * 4); const float k0 = w_ * kf[c][0], k1 = w_ * kf[c][1]; na[0] += k0; na[1] += k1;
                    LDS_WR(unsigned, lds + MX_KW + (8 * wave + c) * MS + lane * 4, cvt_pk_bf16(k0, k1)); }
                LDS_WR(f32x2, lds + SM_NACC + (wave * 128 + 2 * lane) * 4, ((f32x2){na[0], na[1]}));
                const int c = tid >> 3, part = tid & 7; float s = 0.f;
#pragma unroll
                for (int e = 0; e < 8; ++e) { const unsigned qw = LDS_RD(unsigned, lds + MX_QR + c * MS + (16 * part + 2 * e) * 2); const f32x2 nv = LDS_RD(f32x2, lds + SM_NV + (16 * part + 2 * e) * 4);
                    s += __builtin_bit_cast(float, qw << 16) * nv[0] + __builtin_bit_cast(float, qw & 0xffff0000u) * nv[1]; }
                s += __shfl_xor(s, 1); s += __shfl_xor(s, 2); s += __shfl_xor(s, 4);
                LDS_WR(float, lds + SM_QN + c * 4, s);
            }
        }
        MIX_BAR();
        if (j > 0) {
#pragma unroll
            for (int ct = 0; ct < 4; ++ct) *(u32x2*)(OB + (tk0 - 64 + 16 * ct + l15) * DB + vbase + 16 * wave + 4 * q4) = pack4(hv[ct]);
        }
        if (j == NCH) break;
        {
            const int ct = wave >> 1, st0 = 2 * (wave & 1), c = 16 * ct + l15;
            f32x4 sc[2] = {(f32x4){0.f, 0.f, 0.f, 0.f}, (f32x4){0.f, 0.f, 0.f, 0.f}};
#pragma unroll
            for (int ks = 0; ks < 4; ++ks) { const bf16x8 qf = frag16(lds + MX_QR, MS, 16 * ct, ks, lane);
#pragma unroll
                for (int n = 0; n < 2; ++n) { const bf16x8 kf_ = frag16(lds + MX_KR, MS, 16 * (st0 + n), ks, lane); sc[n] = MFMA16(kf_, qf, sc[n]); } }
            const float mxc = LDS_RD(float, lds + SM_MX + c * 4); float rs = 0.f;
#pragma unroll
            for (int n = 0; n < 2; ++n) { const int s0_ = 16 * (st0 + n) + 4 * q4; const f32x4 as = LDS_RD(f32x4, lds + SM_A + s0_ * 4); f32x4 v;
#pragma unroll
                for (int r = 0; r < 4; ++r) { const float t = fexp2(as[r] - mxc) * sc[n][r]; v[r] = (s0_ + r <= c) ? t : 0.f; rs += v[r]; }
                LDS_WR(u32x2, lds + MX_PS + c * MS64 + s0_ * 2, pack4(v)); }
            rs += __shfl_xor(rs, 16); rs += __shfl_xor(rs, 32);
            LDS_WR(float, lds + SM_RSUM + (c * 2 + (wave & 1)) * 4, rs);
        }
        MIX_BAR();
        {
            ldsp rawv = lds + RAW_I + (j & 1) * 16384;
            bf16x8 bv[2], bs[4];
#pragma unroll
            for (int ks = 0; ks < 2; ++ks) bv[ks] = frag_tr(rawv, 16 * wave, ks, lane);
#pragma unroll
            for (int ks = 0; ks < 4; ++ks) { u32x4 w; const f32x4 a0 = st[2 * ks], a1 = st[2 * ks + 1]; w.x = cvt_pk_bf16(a0[0], a0[1]); w.y = cvt_pk_bf16(a0[2], a0[3]); w.z = cvt_pk_bf16(a1[0], a1[1]); w.w = cvt_pk_bf16(a1[2], a1[3]); bs[ks] = __builtin_bit_cast(bf16x8, w); }
#pragma unroll
            for (int ct = 0; ct < 4; ++ct) {
                f32x4 a1 = (f32x4){0.f, 0.f, 0.f, 0.f}, a2 = (f32x4){0.f, 0.f, 0.f, 0.f};
#pragma unroll
                for (int ks = 0; ks < 2; ++ks) { const bf16x8 pf = frag16(lds + MX_PS, MS64, 16 * ct, ks, lane); a2 = MFMA16(bv[ks], pf, a2); }
#pragma unroll
                for (int ks = 0; ks < 4; ++ks) { const bf16x8 qf = frag8x2(lds + MX_QR, MS, 16 * ct, ks, lane); a1 = MFMA16(bs[ks], qf, a1); }
                const int c = 16 * ct + l15; const float inter = LDS_RD(float, lds + SM_INT + c * 4); const f32x2 rsm = LDS_RD(f32x2, lds + SM_RSUM + (c * 2) * 4);
                const float den = inter * LDS_RD(float, lds + SM_QN + c * 4) + (rsm[0] + rsm[1]);
                const float rden = frcp(fmaxf(fabsf(den), LDS_RD(float, lds + SM_EMT + c * 4)));
                hv[ct] = (inter * a1 + a2) * rden;
            }
#pragma unroll
            for (int t = 0; t < 8; ++t) {
                f32x4 u = (f32x4){0.f, 0.f, 0.f, 0.f};
#pragma unroll
                for (int ks = 0; ks < 2; ++ks) { const bf16x8 a = frag_tr(lds + MX_KW, 16 * t, ks, lane, MS); u = MFMA16(a, bv[ks], u); }
                st[t] = decay * st[t] + u;
            }
            if (wave < 2) { float nn = decay * LDS_RD(float, lds + SM_NV + tid * 4);
#pragma unroll
                for (int w = 0; w < 8; ++w) nn += LDS_RD(float, lds + SM_NACC + (w * 128 + tid) * 4);
                LDS_WR(float, lds + SM_NV + tid * 4, nn); }
            ldsp ssq = lds + SM_SSQ + (j & 1) * 2048;
#pragma unroll
            for (int ct = 0; ct < 4; ++ct) { float s = (hv[ct][0] * hv[ct][0] + hv[ct][1] * hv[ct][1]) + (hv[ct][2] * hv[ct][2] + hv[ct][3] * hv[ct][3]); s += __shfl_xor(s, 16); s += __shfl_xor(s, 32);
                LDS_WR(float, ssq + ((16 * ct + l15) * 8 + wave) * 4, s); }
        }
    }
}

__global__ void __launch_bounds__(NTHREADS, 2) fwd_kernel(Args args) {
#ifndef EMU
    extern __shared__ __attribute__((aligned(16))) unsigned char lds_raw[];
    ldsp lds = (ldsp)lds_raw;
#else
    ldsp lds = emu_lds;
#endif
    const int tid = threadIdx.x, lane = tid & 63, wave = RFL(tid >> 6);
    const int G = gridDim.x, bx = blockIdx.x;
    const int vcu = (G % 8 == 0) ? (bx % 8) * (G / 8) + bx / 8 : bx;
    unsigned char* ws = args.ws;
#ifndef EMU
    for (int u = tid; u < (LDS_BYTES - LDSCTL_OFF) / 4; u += NTHREADS) ((LAS unsigned*)(lds + LDSCTL_OFF))[u] = 0u;
    __syncthreads();
    XcdBarrier bar = xcd_barrier_post((unsigned*)(ws + WS_CTL) + CW_BAR, (volatile LAS unsigned*)(lds + MISC_OFF) + 8);
#define GRID_BAR() xcd_barrier(bar)
#else
#define GRID_BAR()
#endif
    const int lo = args.ph_lo, hi = args.ph_hi;
#ifndef GEMM_SP2
#define GEMM_SP2 true
#endif
#ifndef GEMM_ALIGN
#define GEMM_ALIGN true
#endif
#ifndef PROBE_REP_P4
#define PROBE_REP_P4 1
#endif
#ifndef PROBE_REP_P5
#define PROBE_REP_P5 1
#endif
#ifndef PROBE_REP_P1
#define PROBE_REP_P1 2
#endif
#ifndef PROBE_REP_P2
#define PROBE_REP_P2 1
#endif
#ifndef PHASE_MASK
#define PHASE_MASK 127
#endif
#define IN(k) (((PHASE_MASK >> (k)) & 1) && lo <= (k) && (k) < hi)
#define BOTH(k) (IN(k) && IN((k) + 1))
    const float* x = args.in[0];
    bf16* W1T = (bf16*)(ws + WS_W1T); bf16* WUT = (bf16*)(ws + WS_WUT); bf16* WOT = (bf16*)(ws + WS_WOT);
    bf16* HBUF = (bf16*)(ws + WS_HB); bf16* PB = (bf16*)(ws + WS_P); float* SG = (float*)(ws + WS_SG); bf16* OAB = (bf16*)(ws + WS_OAB); float* RSS = (float*)(ws + WS_RSS);

    if (IN(0)) {
        ldsp scr = lds + wave * 17408;
        const int gw = vcu * NWAVES + wave, NGW = G * NWAVES;
        constexpr int RB1 = (NP + NSG + 63) / 64, I_1 = (D / 64) * RB1, I_U = (DA / 64) * (D / 64), I_O = (D / 64) * (D / 64);
        constexpr int NITEMS = I_1 + 2 * I_U + I_O;
        static_assert(NPM % 64 == 0 && NP % 64 == 0 && NSG % 4 == 0, "P0 item tiling");
        for (int it = gw; it < NITEMS; it += NGW) {
            int r = it;
            if (r < I_1) { const int kb = r / RB1, rb = r % RB1, r0 = 64 * rb; int c0, nv;
                if (r0 >= NPM && r0 < NP) { p0_transpose_item<true>(args.in[2], D_IN, D, ws + WS_W8, 64 * kb, r0 + NSG, r0 - NPM, 64, scr, lane); continue; }
                if (r0 < NPM) { c0 = r0; nv = 64; } else { c0 = NPM + (r0 - NP); nv = NSG - (r0 - NP) < 64 ? NSG - (r0 - NP) : 64; }
                p0_transpose_item<false>(args.in[2], D_IN, D, W1T, 64 * kb, c0, r0, nv, scr, lane); continue; }
            r -= I_1;
            if (r < I_U) { const int kb = r / (D / 64), rb = r % (D / 64); p0_transpose_item<false>(args.in[10], D, DA, WUT, 64 * kb, 64 * rb, 64 * rb, 64, scr, lane); continue; }
            r -= I_U;
            if (r < I_U) { const int kb = r / (D / 64), rb = r % (D / 64); p0_transpose_item<false>(args.in[11], D, DB, WUT + (size_t)D * DA, 64 * kb, 64 * rb, 64 * rb, 64, scr, lane); continue; }
            r -= I_U;
            { const int kb = r / (D / 64), rb = r % (D / 64); p0_transpose_item<false>(args.in[12], D, D, WOT, 64 * kb, 64 * rb, 64 * rb, 64, scr, lane); }
        }
        const float* gpre = args.in[1];
        for (int m = gw; m < M; m += NGW) {
            const f32x4* xr = (const f32x4*)(x + (size_t)m * D) + lane;
            f32x4 v[D / 256]; float s = 0.f;
#pragma unroll
            for (int jj = 0; jj < D / 256; ++jj) { v[jj] = xr[64 * jj]; s += (v[jj][0] * v[jj][0] + v[jj][1] * v[jj][1]) + (v[jj][2] * v[jj][2] + v[jj][3] * v[jj][3]); }
            const float rstd = frsq(wave_sum(s) * (1.0f / D) + EPS) ;
            u32x2* o8 = (u32x2*)(HBUF + (size_t)m * D) + lane; unsigned* o4 = (unsigned*)(ws + WS_H8 + (size_t)m * D) + lane;
#pragma unroll
            for (int jj = 0; jj < D / 256; ++jj) { const f32x4 gg = ((const f32x4*)gpre)[lane + 64 * jj]; const f32x4 hh = v[jj] * rstd * gg; u32x2 w; w.x = pk2(hh[0], hh[1]); w.y = pk2(hh[2], hh[3]); o8[64 * jj] = w;
                o4[64 * jj] = pk_fp8x4(clamp8(hh[0] * H8_SCALE), clamp8(hh[1] * H8_SCALE), clamp8(hh[2] * H8_SCALE), clamp8(hh[3] * H8_SCALE)); }
        }
        if (BOTH(0)) GRID_BAR();
    }

    if (IN(1)) {
        {
            const int gw = vcu * NWAVES + wave, NGW = G * NWAVES, l15 = lane & 15, q4 = lane >> 4;
            const int wrow = NP + (l15 < NSG ? l15 : NSG - 1);
            for (int t = gw; t < M / 16; t += NGW) {
                f32x4 acc = (f32x4){0.f, 0.f, 0.f, 0.f};
                const bf16* ap = HBUF + (size_t)(16 * t + l15) * D + 8 * q4; const bf16* bp = W1T + (size_t)wrow * D + 8 * q4;
#pragma unroll 8
                for (int ks = 0; ks < D / 32; ++ks) { const bf16x8 a = *(const bf16x8*)(ap + 32 * ks), bb = *(const bf16x8*)(bp + 32 * ks); acc = MFMA16(a, bb, acc); }
#pragma unroll
                for (int r = 0; r < 4; ++r) SG[(size_t)(16 * t + 4 * q4 + r) * 16 + l15] = acc[r];
            }
        }
        { pg8::Gemm g{HBUF, W1T, M, NPM, D}; pg8::StaticOrder S; S.init(M, NPM, G, bx);
          EpiP E{PB};
          pg8::gemm_phase<EpiP, pg8::StaticOrder, GEMM_ALIGN, GEMM_SP2>(lds, g, S, E); }
        { pg8::Gemm g{(const bf16*)(ws + WS_H8), (const bf16*)(ws + WS_W8), M, 2 * D, D}; pg8::StaticOrder S; S.init(M, 2 * D, G, bx);
          EpiP8 E{PB};
          pg8::gemm_phase<EpiP8, pg8::StaticOrder, GEMM_ALIGN, GEMM_SP2, 1>(lds, g, S, E); }
        if (BOTH(1)) GRID_BAR();
    }

    if (IN(2)) {
        constexpr int NJA = NB * HA, NJB = NB * HB * 2;
        for (int rep = 0; rep < PROBE_REP_P2; ++rep)
        for (int job = bx; job < NJA + NJB; job += G) {
#ifndef NO_MIX_A
            if (job < NJA) mixer_a_job(args, lds, job / HA, job % HA, tid);
#endif
#ifndef NO_MIX_B
            if (job >= NJA) { const int jb = job - NJA; mixer_b_job(args, lds, jb / (2 * HB), (jb >> 1) % HB, jb & 1, tid); }
#endif
            BLOCK_BAR();
        }
        if (BOTH(2)) GRID_BAR();
    }

    if (IN(3)) {
        const int gw = vcu * NWAVES + wave, NGW = G * NWAVES;
        const float* SSA = (const float*)(ws + WS_SSA); const float* SSB = (const float*)(ws + WS_SSB);
        static_assert(DA % 512 == 0 && DA == DB, "P3 tiling");
        for (int m = gw; m < M; m += NGW) {
#pragma unroll
            for (int br = 0; br < 2; ++br) {
#pragma unroll
                for (int i = 0; i < DA / 512; ++i) {
                    const int col0 = i * 512 + lane * 8;
                    float rstd;
                    if (br == 0) rstd = frsq(SSA[(size_t)m * HA + col0 / 128] * (1.0f / 128.0f) + EPS);
                    else { const int hh = col0 / 256; rstd = frsq((SSB[(size_t)m * (2 * HB) + 2 * hh] + SSB[(size_t)m * (2 * HB) + 2 * hh + 1]) * (1.0f / 256.0f) + EPS); }
                    u32x4* po = (u32x4*)(OAB + (size_t)(br * M + m) * DA + col0);
                    u32x4 w = *po; const u32x4 g8 = *(const u32x4*)(PB + p_off((size_t)m, (br ? C_OGB : C_OGA) + col0)), z8 = *(const u32x4*)(PB + p_off((size_t)m, (br ? C_ZB : C_ZA) + col0));
                    const f32x4 gn0 = *(const f32x4*)(args.in[br ? 9 : 8] + col0), gn1 = *(const f32x4*)(args.in[br ? 9 : 8] + col0 + 4);
#pragma unroll
                    for (int e = 0; e < 4; ++e) { float v[2];
#pragma unroll
                        for (int k = 0; k < 2; ++k) { const float ov = __builtin_bit_cast(float, k ? (w[e] & 0xffff0000u) : (w[e] << 16)), og = __builtin_bit_cast(float, k ? (g8[e] & 0xffff0000u) : (g8[e] << 16)), z = __builtin_bit_cast(float, k ? (z8[e] & 0xffff0000u) : (z8[e] << 16));
                            const float gnv = (e < 2 ? gn0 : gn1)[(2 * e + k) & 3];
                            v[k] = ov * rstd * gnv * sigm2(og) * (z * sigm2(z)); }
                        w[e] = cvt_pk_bf16(v[0], v[1]); }
                    *po = w;
                }
            }
        }
        if (BOTH(3)) GRID_BAR();
    }
    if (IN(4)) {
        pg8::Gemm g{OAB, WUT, 2 * M, 2 * D, DA}; SchedUp S; S.so.init(M, D, G, bx);
        EpiUp E{HBUF, PB};
        for (int rep = 0; rep < PROBE_REP_P4; ++rep) pg8::gemm_phase<EpiUp, SchedUp, GEMM_ALIGN, GEMM_SP2>(lds, g, S, E);
        if (BOTH(4)) GRID_BAR();
    }

    if (IN(5)) {
        pg8::Gemm g{HBUF, WOT, M, D, D}; pg8::StaticOrder S; S.init(M, D, G, bx);
        EpiOut E{args.out, RSS};
        for (int rep = 0; rep < PROBE_REP_P5; ++rep) pg8::gemm_phase<EpiOut, pg8::StaticOrder, GEMM_ALIGN, GEMM_SP2>(lds, g, S, E);
        if (BOTH(5)) GRID_BAR();
    }

    if (IN(6)) {
        const int gw = vcu * NWAVES + wave, NGW = G * NWAVES;
        const float* gpost = args.in[13];
        for (int m = gw; m < M; m += NGW) {
            const float ss = wave_sum(lane < NRS ? RSS[(size_t)m * NRS + lane] : 0.f);
            const float rstd = frsq(ss * (1.0f / D) + EPS);
            const f32x4* xr = (const f32x4*)(x + (size_t)m * D) + lane; f32x4* orow = (f32x4*)(args.out + (size_t)m * D) + lane;
#pragma unroll
            for (int jj = 0; jj < D / 256; ++jj) { const f32x4 xv = xr[64 * jj], ov = orow[64 * jj], gg = ((const f32x4*)gpost)[lane + 64 * jj]; orow[64 * jj] = xv + ov * rstd * gg; }
        }
    }
#undef IN
#undef BOTH
}

#ifndef EMU
extern "C" void kernel_launch(void* const* d_in, const int* in_sizes, int n_in, void* d_out, int out_size, void* d_ws, size_t ws_size, hipStream_t stream) {
    static int grid = 0;
    if (grid == 0) {
        if (n_in != 14 || out_size != M * D || ws_size < WS_END) { fprintf(stderr, "kernel_launch: unexpected shapes (n_in %d, out %d, ws %zu < %zu)\n", n_in, out_size, ws_size, (size_t)WS_END); grid = -1; return; }
        int dev = 0, cus = 0, per_cu = 0;
        if (hipGetDevice(&dev) != hipSuccess || hipDeviceGetAttribute(&cus, hipDeviceAttributeMultiprocessorCount, dev) != hipSuccess) { grid = -1; return; }
        if (hipFuncSetAttribute((const void*)fwd_kernel, hipFuncAttributeMaxDynamicSharedMemorySize, LDS_BYTES) != hipSuccess) { fprintf(stderr, "kernel_launch: hipFuncSetAttribute failed\n"); grid = -1; return; }
        if (hipOccupancyMaxActiveBlocksPerMultiprocessor(&per_cu, (const void*)fwd_kernel, NTHREADS, LDS_BYTES) != hipSuccess || per_cu < 1) { fprintf(stderr, "kernel_launch: occupancy query says %d\n", per_cu); }
        (void)hipGetLastError();
        grid = cus;
    }
    if (grid < 0) return;
    (void)hipMemsetAsync((char*)d_ws + WS_CTL, 0, CTL_ZERO_BYTES, stream);
    Args a{};
    for (int i = 0; i < 14; ++i) a.in[i] = (const float*)d_in[i];
    a.out = (float*)d_out; a.ws = (unsigned char*)d_ws; a.ph_lo = 0; a.ph_hi = 7;
    hipLaunchKernelGGL(fwd_kernel, dim3(grid), dim3(NTHREADS), LDS_BYTES, stream, a);
}
#endif
```

```cpp
typedef unsigned u32x2_t __attribute__((ext_vector_type(2)));
typedef int v8i_t __attribute__((ext_vector_type(8)));
typedef int v4i_t __attribute__((ext_vector_type(4)));
#ifndef EMU
#include <hip/hip_runtime.h>
#include <cstdio>
#include <cstdint>
#define LAS __attribute__((address_space(3)))
#define GAS __attribute__((address_space(1)))
typedef short bf16x8 __attribute__((ext_vector_type(8)));
typedef short bf16x4 __attribute__((ext_vector_type(4)));
typedef float f32x4 __attribute__((ext_vector_type(4)));
#define DEV __device__ __forceinline__
#define LDS_RD(T, p) (*(const LAS T*)(p))
#define LDS_WR(T, p, v) (*(LAS T*)(p) = (v))
#define WAVE_SYNC() asm volatile("s_waitcnt lgkmcnt(0)" ::: "memory")
#define BLOCK_BAR() __syncthreads()
#define RAW_BAR() __builtin_amdgcn_s_barrier()
#define WAIT_V(n) asm volatile("s_waitcnt vmcnt(" #n ")" ::: "memory")
#define WAIT_L(n) asm volatile("s_waitcnt lgkmcnt(" #n ")" ::: "memory")
#define SCHED_BAR() __builtin_amdgcn_sched_barrier(0)
#define SETPRIO(n) __builtin_amdgcn_s_setprio(n)
#define GLDS16(g, l) __builtin_amdgcn_global_load_lds((const unsigned*)(g), (LAS unsigned*)(l), 16, 0, 0)
#define MFMA16(a, b, c) __builtin_amdgcn_mfma_f32_16x16x32_bf16(a, b, c, 0, 0, 0)
#define RFL(x) __builtin_amdgcn_readfirstlane(x)
#define COMPILER_FENCE() asm volatile("" ::: "memory")
#define OPAQUE(x) asm volatile("" : "+v"(x))
DEV float fexp2(float x) { return __builtin_amdgcn_exp2f(x); }
DEV float flog2(float x) { return __builtin_amdgcn_logf(x); }
DEV float frcp(float x) { return __builtin_amdgcn_rcpf(x); }
DEV float frsq(float x) { return __builtin_amdgcn_rsqf(x); }
DEV unsigned cvt_pk_bf16(float lo, float hi) { unsigned r; asm volatile("v_cvt_pk_bf16_f32 %0, %1, %2" : "=v"(r) : "v"(lo), "v"(hi)); return r; }
DEV f32x4 mfma8(v8i_t a, v8i_t b, f32x4 c, int sc) { asm volatile("v_mfma_scale_f32_16x16x128_f8f6f4 %0, %1, %2, %0, %3, %3 op_sel_hi:[0,0,0]" : "+v"(c) : "v"(a), "v"(b), "v"(sc)); return c; }
#define MFMA_DRAIN() asm volatile("s_nop 15\n\ts_nop 7" ::: "memory")
DEV unsigned pk_fp8x4(float a, float b, float c, float d) { int r = __builtin_amdgcn_cvt_pk_fp8_f32(a, b, 0, false); r = __builtin_amdgcn_cvt_pk_fp8_f32(c, d, r, true); return (unsigned)r; }
typedef short v4i16_t __attribute__((ext_vector_type(4)));
DEV bf16x4 lds_tr16(LAS unsigned char* p) { return __builtin_bit_cast(bf16x4, __builtin_amdgcn_ds_read_tr16_b64_v4i16((LAS v4i16_t*)p)); }
#define MIX_BAR() do { asm volatile("s_waitcnt lgkmcnt(0)" ::: "memory"); __builtin_amdgcn_s_barrier(); asm volatile("" ::: "memory"); } while (0)
DEV void glds16_asm(const void* gsrc, unsigned lds_dst) { unsigned keep;
    asm volatile("s_mov_b32 %0, m0\n\ts_mov_b32 m0, %2\n\ts_nop 0\n\tglobal_load_lds_dwordx4 %1, off\n\ts_mov_b32 m0, %0" : "=&s"(keep) : "v"(gsrc), "s"(lds_dst) : "memory"); }
#define GLDS16X(g, l) glds16_asm((const void*)(g), (unsigned)RFL((int)(unsigned)(__UINTPTR_TYPE__)(l)))
typedef __amdgpu_buffer_rsrc_t rsrc_t;
DEV rsrc_t make_rsrc(const void* p, unsigned bytes) { return __builtin_amdgcn_make_buffer_rsrc((void*)p, (short)0, (int)bytes, 0x00020000); }
DEV unsigned short bload16(rsrc_t r, unsigned voff, unsigned soff) { return (unsigned short)__builtin_amdgcn_raw_buffer_load_b16(r, (int)voff, (int)soff, 0); }
DEV void bstore16(rsrc_t r, unsigned voff, unsigned soff, unsigned short v) { __builtin_amdgcn_raw_buffer_store_b16(v, r, (int)voff, (int)soff, 0); }
DEV void bstore64(rsrc_t r, unsigned voff, unsigned soff, u32x2_t v) { __builtin_amdgcn_raw_buffer_store_b64(v, r, (int)voff, (int)soff, 0); }
#else
#define LAS
#define GAS
#define DEV inline
#define LDS_RD(T, p) emu_lds_rd<T>((const void*)(p), #p)
#define LDS_WR(T, p, v) emu_lds_wr<T>((void*)(p), (T)(v), #p)
#define WAVE_SYNC() emu_wavesync()
#define BLOCK_BAR() emu_syncthreads()
#define RAW_BAR() emu_syncthreads()
#define WAIT_V(n)
#define WAIT_L(n)
#define SCHED_BAR()
#define SETPRIO(n)
#define GLDS16(g, l) emu_glds16((const void*)(g), (unsigned char*)(l))
#define GLDS16X(g, l) emu_glds16((const void*)(g), (unsigned char*)(l))
#define MFMA16(a, b, c) emu_mfma16(a, b, c)
#define RFL(x) (x)
#define COMPILER_FENCE()
#define OPAQUE(x)
DEV float fexp2(float x) { return exp2f(x); }
DEV float flog2(float x) { return log2f(x); }
DEV float frcp(float x) { return 1.0f / x; }
DEV float frsq(float x) { return 1.0f / sqrtf(x); }
DEV unsigned cvt_pk_bf16(float lo, float hi) { return (unsigned)emu_f2bf(lo) | ((unsigned)emu_f2bf(hi) << 16); }
#define mfma8(a, b, c, sc) emu_mfma8(a, b, c)
#define MFMA_DRAIN()
DEV unsigned pk_fp8x4(float a, float b, float c, float d) { return (unsigned)emu_f2fp8(a) | ((unsigned)emu_f2fp8(b) << 8) | ((unsigned)emu_f2fp8(c) << 16) | ((unsigned)emu_f2fp8(d) << 24); }
#define lds_tr16(p) emu_lds_tr16((const unsigned char*)(p))
#define MIX_BAR() emu_syncthreads()
typedef unsigned char* rsrc_t;
DEV rsrc_t make_rsrc(const void* p, unsigned) { return (unsigned char*)p; }
DEV unsigned short bload16(rsrc_t r, unsigned voff, unsigned soff) { unsigned short v; memcpy(&v, r + (size_t)voff + soff, 2); return v; }
DEV void bstore16(rsrc_t r, unsigned voff, unsigned soff, unsigned short v) { memcpy(r + (size_t)voff + soff, &v, 2); }
DEV void bstore64(rsrc_t r, unsigned voff, unsigned soff, u32x2_t v) { memcpy(r + (size_t)voff + soff, &v, 8); }
#endif

typedef unsigned short bf16;
typedef unsigned u32x4 __attribute__((ext_vector_type(4)));
typedef unsigned u32x2 __attribute__((ext_vector_type(2)));
typedef float f32x2 __attribute__((ext_vector_type(2)));
typedef LAS unsigned char* ldsp;

#ifndef CFG_D
#define CFG_D 4096
#define CFG_B 4
#define CFG_S 4096
#define CFG_HB 8
#endif
constexpr int D = CFG_D, NB = CFG_B, SEQ = CFG_S, M = NB * SEQ;
constexpr int DA = D / 2, HA = DA / 128, DB = D / 2, HB = CFG_HB, DVB = DB / HB, DKB = 128, DQK = HB * DKB;
constexpr int NSG = 2 * HB;
constexpr int NCH = SEQ / 64;
static_assert(DVB == 256 && NSG <= 16 && SEQ % 64 == 0 && M % 256 == 0 && D % 256 == 0, "shape");
constexpr int C_QA = 0, C_FA = DA, C_IA = 2 * DA, C_OGA = 3 * DA, C_ZA = 4 * DA, C_QB = 5 * DA, C_KB = C_QB + DQK, C_VB = C_KB + DQK, C_OGB = C_VB + DB, C_ZB = C_OGB + DB;
constexpr int NPM = C_ZB + DB, C_GA = NPM, C_GB = NPM + D, NP = NPM + 2 * D, D_IN = NP + NSG;
static_assert(NPM % 256 == 0 && NP % 256 == 0, "column map");
constexpr float EPS = 1e-6f;
constexpr float H8_SCALE = 64.0f, W8_SCALE = 1024.0f, G8_DESCALE = 1.0f / (64.0f * 1024.0f);
constexpr float LOG2E = 1.4426950408889634f, LN2 = 0.6931471805599453f;
constexpr int NRS = D / 64;
constexpr int PT_PITCH = M / 64 + 1;
DEV size_t p_off(size_t row, int col) { return ((size_t)(col >> 7) * (size_t)PT_PITCH + (row >> 6)) * 8192 + (row & 63) * 128 + (size_t)(col & 127); }

constexpr size_t al256(size_t x) { return (x + 255) & ~(size_t)255; }
constexpr size_t WS_CTL = 0, CTL_ZERO_BYTES = 65536;
constexpr size_t WS_W1T = 1u << 20;
constexpr size_t WS_WUT = al256(WS_W1T + (size_t)(NP + 16) * D * 2);
constexpr size_t WS_WOT = al256(WS_WUT + (size_t)2 * D * DA * 2);
constexpr size_t WS_HB = al256(WS_WOT + (size_t)D * D * 2);
constexpr size_t WS_P = al256(WS_HB + (size_t)M * D * 2);
constexpr size_t WS_SG = al256(WS_P + (size_t)(NP / 128) * (M / 64 + 1) * 16384 + 4096);
constexpr size_t WS_OAB = al256(WS_SG + (size_t)M * 16 * 4);
constexpr size_t WS_RSS = al256(WS_OAB + (size_t)2 * M * DA * 2);
constexpr size_t WS_SSB = al256(WS_RSS + (size_t)M * NRS * 4);
constexpr size_t WS_SSA = al256(WS_SSB + (size_t)M * HB * 2 * 4);
constexpr size_t WS_H8 = al256(WS_SSA + (size_t)M * HA * 4);
constexpr size_t WS_W8 = al256(WS_H8 + (size_t)M * D);
constexpr size_t WS_END = al256(WS_W8 + (size_t)2 * D * D);
constexpr int CW_BAR = 1024;

constexpr int RING_BYTES = 154624, LDSCTL_OFF = RING_BYTES, MISC_OFF = LDSCTL_OFF + 320, LDS_BYTES = 155648;
constexpr int NWAVES = 8, NTHREADS = 512;

DEV unsigned f2bf(float f) { unsigned u = __builtin_bit_cast(unsigned, f); return (u + 0x7fffu + ((u >> 16) & 1u)) >> 16; }
DEV float bf2f(unsigned b) { return __builtin_bit_cast(float, b << 16); }
DEV unsigned pk2(float lo, float hi) { return f2bf(lo) | (f2bf(hi) << 16); }
DEV float fexp(float x) { return fexp2(x * LOG2E); }
DEV float flog(float x) { return flog2(x) * LN2; }
DEV float sigm(float x) { return frcp(1.0f + fexp(-x)); }
DEV float logsig(float x) { return fminf(x, 0.f) - flog(1.0f + fexp(-fabsf(x))); }
DEV float wave_sum(float v) {
#pragma unroll
    for (int o = 1; o < 64; o <<= 1) v += __shfl_xor(v, o);
    return v;
}

namespace pg8 {
constexpr int BM = 256, BK = 64, HALF = 128, HTB = HALF * BK * 2, STAGE_BYTES = 8 * HTB, NXCD = 8, WGM = 8;
DEV int lds_byte(int r, int c) { const int st = (r >> 4) * 2 + (c >> 5), rr = r & 15, cc = c & 31, ob = rr * 64 + cc * 2; return st * 1024 + (ob ^ (((ob >> 9) & 1) << 5)); }
DEV void stage_rc(int b, int& R, int& C) { const int st = b / 1024, sb = b % 1024, swz = sb ^ (((sb >> 9) & 1) << 5); R = (st >> 1) * 16 + swz / 64; C = (st & 1) * 32 + (swz % 64) / 2; }
DEV int perm32(int rho) { const int n = rho >> 4, i = rho & 15; return 8 * (i >> 2) + 4 * n + (i & 3); }
struct Unit { int pm, pn; };
struct Gemm { const bf16* A; const bf16* Bt; int M, N, K; };
struct StaticOrder {
    int nM, nN, nwg, G, c;
    DEV void init(int M_, int N_, int G_, int c_) { nM = M_ / BM; nN = N_ / BM; nwg = nM * nN; G = G_; c = c_; }
    DEV bool next(int i, Unit& u) const {
        const long L = (long)i * G + c; if (L >= nwg) return false;
        int wgid = (int)L; { const int q = nwg / NXCD, r = nwg % NXCD, xcd = wgid % NXCD, off = wgid / NXCD; wgid = (xcd < r ? xcd * (q + 1) : r * (q + 1) + (xcd - r) * q) + off; }
        const int nig = WGM * nN, gid = wgid / nig, fm = gid * WGM, gsz = (nM - fm) < WGM ? (nM - fm) : WGM;
        u.pm = fm + ((wgid % nig) % gsz); u.pn = (wgid % nig) / gsz; return true;
    }
};
template <class Epi, class Sched, bool ALIGN_EPI = false, bool SP2 = false, int ESZ = 2>
DEV void gemm_phase(ldsp lds, const Gemm g, const Sched& S, const Epi& E) {
    const int tid = threadIdx.x, wid = RFL(tid >> 6), lane = tid & 63, wr = wid >> 2, wc = wid & 3, fr = lane & 15, fq = lane >> 4;
    const int K = g.K * ESZ / 2, nt = K / BK;
    unsigned voffA[2], voffB[2];
#pragma unroll
    for (int i = 0; i < 2; ++i) { int R, C; stage_rc(tid * 16 + i * 8192, R, C); const int Rb = Epi::PERM ? ((R & ~31) + perm32(R & 31)) : R;
        voffA[i] = (unsigned)(R * K + C) * 2u; voffB[i] = (unsigned)(Rb * K + C) * 2u; }
    const size_t kstep = (size_t)(BK * 2);
    const size_t hstep = (size_t)HALF * K * 2;
    const size_t tstep = 2 * hstep;
    const unsigned ldsw = (unsigned)wid * 1024u;
    int aoffk[2], boffk[2];
#pragma unroll
    for (int k = 0; k < 2; ++k) { const int ch = ESZ == 2 ? fq + 4 * k : 2 * fq + k;
        aoffk[k] = lds_byte(wr * 64 + fr, (ch & 3) * 8) + (ch >> 2) * 1024; boffk[k] = lds_byte(wc * 32 + fr, (ch & 3) * 8) + (ch >> 2) * 1024; }
#define PG8_SA(b, h) (((b) * 2 + (h)) * HTB)
#define PG8_SB(b, h) ((4 + (b) * 2 + (h)) * HTB)
#define PG8_STAGE(bufoff, gbase, voff) do { _Pragma("unroll") for (int _i = 0; _i < 2; ++_i) \
        GLDS16((const char*)(gbase) + (voff)[_i], lds + (bufoff) + ldsw + _i * 8192); } while (0)
#define PG8_LDA(dst, b, h) do { _Pragma("unroll") for (int m = 0; m < 4; ++m) { if constexpr (ESZ == 2) { _Pragma("unroll") for (int k = 0; k < 2; ++k) dst[m][k] = *(const LAS bf16x8*)(lds + PG8_SA(b, h) + aoffk[k] + m * 2048); } \
        else dst##8[m] = __builtin_shufflevector(*(const LAS v4i_t*)(lds + PG8_SA(b, h) + aoffk[0] + m * 2048), *(const LAS v4i_t*)(lds + PG8_SA(b, h) + aoffk[1] + m * 2048), 0, 1, 2, 3, 4, 5, 6, 7); } } while (0)
#define PG8_LDB(dst, b, h) do { _Pragma("unroll") for (int n = 0; n < 2; ++n) { if constexpr (ESZ == 2) { _Pragma("unroll") for (int k = 0; k < 2; ++k) dst[n][k] = *(const LAS bf16x8*)(lds + PG8_SB(b, h) + boffk[k] + n * 2048); } \
        else dst##8[n] = __builtin_shufflevector(*(const LAS v4i_t*)(lds + PG8_SB(b, h) + boffk[0] + n * 2048), *(const LAS v4i_t*)(lds + PG8_SB(b, h) + boffk[1] + n * 2048), 0, 1, 2, 3, 4, 5, 6, 7); } } while (0)
#define PG8_MMA(ai, bj, At, Bt) do { SETPRIO(1); _Pragma("unroll") for (int m = 0; m < 4; ++m) _Pragma("unroll") for (int n = 0; n < 2; ++n) { \
        if constexpr (ESZ == 2) { _Pragma("unroll") for (int k = 0; k < 2; ++k) acc[ai][bj][m][n] = MFMA16(Bt[n][k], At[m][k], acc[ai][bj][m][n]); } \
        else acc[ai][bj][m][n] = mfma8(Bt##8[n], At##8[m], acc[ai][bj][m][n], sc8); } SETPRIO(0); } while (0)
    int sc8 = 0x7f7f7f7f; OPAQUE(sc8);
    Unit cur, nxt; int ui = 0;
    if (!S.next(0, cur)) return;
    f32x4 acc[2][2][4][2];
#pragma unroll
    for (int a = 0; a < 2; ++a)
#pragma unroll
        for (int b = 0; b < 2; ++b)
#pragma unroll
            for (int m = 0; m < 4; ++m)
#pragma unroll
                for (int n = 0; n < 2; ++n) acc[a][b][m][n] = (f32x4){0.f, 0.f, 0.f, 0.f};
    bf16x8 At[ESZ == 2 ? 4 : 1][2], B0[ESZ == 2 ? 2 : 1][2], B1[ESZ == 2 ? 2 : 1][2];
    v8i_t At8[ESZ == 1 ? 4 : 1], B08[ESZ == 1 ? 2 : 1], B18[ESZ == 1 ? 2 : 1];
    const char* cA = (const char*)g.A + (size_t)cur.pm * tstep; const char* cB = (const char*)g.Bt + (size_t)cur.pn * tstep;
    if constexpr (SP2) {
        PG8_STAGE(PG8_SB(0, 0), cB, voffB); PG8_STAGE(PG8_SB(0, 1), cB + hstep, voffB); PG8_STAGE(PG8_SA(0, 0), cA, voffA); PG8_STAGE(PG8_SA(0, 1), cA + hstep, voffA);
        if (wr == 1) RAW_BAR();
        WAIT_V(2); RAW_BAR();
        PG8_STAGE(PG8_SB(1, 0), cB + kstep, voffB); PG8_STAGE(PG8_SA(1, 0), cA + kstep, voffA); PG8_STAGE(PG8_SB(1, 1), cB + hstep + kstep, voffB);
        WAIT_V(6); RAW_BAR();
    } else {
        PG8_STAGE(PG8_SB(0, 0), cB, voffB); PG8_STAGE(PG8_SA(0, 0), cA, voffA); PG8_STAGE(PG8_SB(0, 1), cB + hstep, voffB); PG8_STAGE(PG8_SA(0, 1), cA + hstep, voffA);
        if (wr == 1) RAW_BAR();
        WAIT_V(4); RAW_BAR();
        PG8_STAGE(PG8_SB(1, 0), cB + kstep, voffB); PG8_STAGE(PG8_SA(1, 0), cA + kstep, voffA); PG8_STAGE(PG8_SB(1, 1), cB + hstep + kstep, voffB);
        WAIT_V(6); RAW_BAR();
    }
    for (;;) {
        const bool has_next = S.next(ui + 1, nxt);
        const char* nA = has_next ? (const char*)g.A + (size_t)nxt.pm * tstep : cA; const char* nB = has_next ? (const char*)g.Bt + (size_t)nxt.pn * tstep : cB;
        for (int t = 0; t < nt; t += 2) {
            const bool last = (t == nt - 2);
            const char* a1 = cA + (size_t)(t + 1) * kstep;
            const char* a2 = last ? nA : cA + (size_t)(t + 2) * kstep; const char* b2 = last ? nB : cB + (size_t)(t + 2) * kstep;
            const char* a3 = a2 + kstep; const char* b3 = b2 + kstep;
            if constexpr (SP2) {
            PG8_LDB(B0, 0, 0); PG8_LDB(B1, 0, 1); SCHED_BAR(); PG8_LDA(At, 0, 0); PG8_STAGE(PG8_SA(1, 1), a1 + hstep, voffA);
            WAIT_V(8); WAIT_L(0); RAW_BAR(); PG8_MMA(0, 0, At, B0); PG8_MMA(0, 1, At, B1); RAW_BAR(); SCHED_BAR();
            PG8_LDA(At, 0, 1); PG8_STAGE(PG8_SB(0, 0), b2, voffB); PG8_STAGE(PG8_SB(0, 1), b2 + hstep, voffB); PG8_STAGE(PG8_SA(0, 0), a2, voffA);
            WAIT_V(8); WAIT_L(0); RAW_BAR(); PG8_MMA(1, 0, At, B0); PG8_MMA(1, 1, At, B1); RAW_BAR(); SCHED_BAR();
            PG8_LDB(B0, 1, 0); PG8_LDB(B1, 1, 1); SCHED_BAR(); PG8_LDA(At, 1, 0); PG8_STAGE(PG8_SA(0, 1), a2 + hstep, voffA);
            WAIT_V(8); WAIT_L(0); RAW_BAR(); PG8_MMA(0, 0, At, B0); PG8_MMA(0, 1, At, B1); RAW_BAR(); SCHED_BAR();
            PG8_LDA(At, 1, 1); PG8_STAGE(PG8_SB(1, 0), b3, voffB); PG8_STAGE(PG8_SB(1, 1), b3 + hstep, voffB); PG8_STAGE(PG8_SA(1, 0), a3, voffA);
            WAIT_V(8); WAIT_L(0); RAW_BAR(); PG8_MMA(1, 0, At, B0); PG8_MMA(1, 1, At, B1); RAW_BAR(); SCHED_BAR();
            } else {
            PG8_LDB(B0, 0, 0); SCHED_BAR(); PG8_LDA(At, 0, 0); PG8_STAGE(PG8_SA(1, 1), a1 + hstep, voffA);
            WAIT_L(8); RAW_BAR(); WAIT_L(0); PG8_MMA(0, 0, At, B0); RAW_BAR(); SCHED_BAR();
            PG8_LDB(B1, 0, 1); PG8_STAGE(PG8_SB(0, 0), b2, voffB);
            RAW_BAR(); WAIT_L(0); PG8_MMA(0, 1, At, B1); RAW_BAR();
            PG8_LDA(At, 0, 1); PG8_STAGE(PG8_SA(0, 0), a2, voffA);
            RAW_BAR(); WAIT_L(0); PG8_MMA(1, 0, At, B0); RAW_BAR(); SCHED_BAR();
            PG8_STAGE(PG8_SB(0, 1), b2 + hstep, voffB);
            WAIT_V(6); RAW_BAR(); PG8_MMA(1, 1, At, B1); RAW_BAR();
            PG8_LDB(B0, 1, 0); SCHED_BAR(); PG8_LDA(At, 1, 0); PG8_STAGE(PG8_SA(0, 1), a2 + hstep, voffA);
            WAIT_L(8); RAW_BAR(); WAIT_L(0); PG8_MMA(0, 0, At, B0); RAW_BAR(); SCHED_BAR();
            PG8_LDB(B1, 1, 1); PG8_STAGE(PG8_SB(1, 0), b3, voffB);
            RAW_BAR(); WAIT_L(0); PG8_MMA(0, 1, At, B1); RAW_BAR();
            PG8_LDA(At, 1, 1); PG8_STAGE(PG8_SA(1, 0), a3, voffA);
            RAW_BAR(); WAIT_L(0); PG8_MMA(1, 0, At, B0); RAW_BAR(); SCHED_BAR();
            PG8_STAGE(PG8_SB(1, 1), b3 + hstep, voffB);
            WAIT_V(6); RAW_BAR(); PG8_MMA(1, 1, At, B1); RAW_BAR();
            }
        }
        if constexpr (ALIGN_EPI) { if (wr == 0) RAW_BAR(); }
        if constexpr (ESZ == 1) { MFMA_DRAIN();
#pragma unroll
            for (int a = 0; a < 2; ++a)
#pragma unroll
                for (int b = 0; b < 2; ++b) asm volatile("" : "+v"(acc[a][b][0][0]), "+v"(acc[a][b][0][1]), "+v"(acc[a][b][1][0]), "+v"(acc[a][b][1][1]), "+v"(acc[a][b][2][0]), "+v"(acc[a][b][2][1]), "+v"(acc[a][b][3][0]), "+v"(acc[a][b][3][1])); }
        E(acc, cur, wr, wc, fr, fq);
        if (!has_next) break;
#pragma unroll
        for (int a = 0; a < 2; ++a)
#pragma unroll
            for (int b = 0; b < 2; ++b)
#pragma unroll
                for (int m = 0; m < 4; ++m)
#pragma unroll
                    for (int n = 0; n < 2; ++n) acc[a][b][m][n] = (f32x4){0.f, 0.f, 0.f, 0.f};
        cur = nxt; cA = nA; cB = nB; ++ui;
        if constexpr (ALIGN_EPI) { if (wr == 1) RAW_BAR(); }
    }
    WAIT_V(0);
    if constexpr (!ALIGN_EPI) { if (wr == 0) RAW_BAR(); }
    RAW_BAR();
#undef PG8_SA
#undef PG8_SB
#undef PG8_STAGE
#undef PG8_LDA
#undef PG8_LDB
#undef PG8_MMA
}
}

struct EpiP {
    static constexpr bool PERM = true;
    bf16* O;
    DEV void operator()(const f32x4 (&acc)[2][2][4][2], const pg8::Unit& u, int wr, int wc, int fr, int fq) const {
        const int row0 = u.pm * 256 + wr * 64 + fr, col0 = u.pn * 256 + wc * 32 + 8 * fq;
#pragma unroll
        for (int ai = 0; ai < 2; ++ai)
#pragma unroll
            for (int m = 0; m < 4; ++m) { const size_t row = (size_t)(row0 + ai * 128 + m * 16);
#pragma unroll
                for (int bj = 0; bj < 2; ++bj) { const f32x4 v0 = acc[ai][bj][m][0], v1 = acc[ai][bj][m][1];
                    u32x4 w; w.x = cvt_pk_bf16(v0[0], v0[1]); w.y = cvt_pk_bf16(v0[2], v0[3]); w.z = cvt_pk_bf16(v1[0], v1[1]); w.w = cvt_pk_bf16(v1[2], v1[3]);
                    *(u32x4*)(O + p_off(row, col0 + bj * 128)) = w; } }
    }
};
struct EpiP8 {
    static constexpr bool PERM = true;
    bf16* O;
    DEV void operator()(const f32x4 (&acc)[2][2][4][2], const pg8::Unit& u, int wr, int wc, int fr, int fq) const {
        const int row0 = u.pm * 256 + wr * 64 + fr, col0 = NPM + u.pn * 256 + wc * 32 + 8 * fq;
#pragma unroll
        for (int ai = 0; ai < 2; ++ai)
#pragma unroll
            for (int m = 0; m < 4; ++m) { const size_t row = (size_t)(row0 + ai * 128 + m * 16);
#pragma unroll
                for (int bj = 0; bj < 2; ++bj) { const f32x4 v0 = acc[ai][bj][m][0] * G8_DESCALE, v1 = acc[ai][bj][m][1] * G8_DESCALE;
                    u32x4 w; w.x = cvt_pk_bf16(v0[0], v0[1]); w.y = cvt_pk_bf16(v0[2], v0[3]); w.z = cvt_pk_bf16(v1[0], v1[1]); w.w = cvt_pk_bf16(v1[2], v1[3]);
                    *(u32x4*)(O + p_off(row, col0 + bj * 128)) = w; } }
    }
};
struct SchedUp {
    pg8::StaticOrder so;
    DEV bool next(int i, pg8::Unit& u) const { if (!so.next(i >> 1, u)) return false; if (i & 1) { u.pm += M / 256; u.pn += D / 256; } return true; }
};
struct EpiUp {
    static constexpr bool PERM = true;
    bf16* Y; const bf16* P;
    DEV void operator()(const f32x4 (&acc)[2][2][4][2], const pg8::Unit& u, int wr, int wc, int fr, int fq) const {
        const int br = u.pm >= M / 256 ? 1 : 0, pm = u.pm - br * (M / 256), pn = u.pn - br * (D / 256);
        const int row0 = pm * 256 + wr * 64 + fr, col0 = pn * 256 + wc * 32 + 8 * fq, gcol = (br ? C_GB : C_GA) + col0;
#pragma unroll
        for (int ai = 0; ai < 2; ++ai)
#pragma unroll
            for (int m = 0; m < 4; ++m) { const size_t row = (size_t)(row0 + ai * 128 + m * 16);
#pragma unroll
                for (int bj = 0; bj < 2; ++bj) {
                    const u32x4 g8 = *(const u32x4*)(P + p_off(row, gcol + bj * 128));
                    bf16* yp = Y + row * D + col0 + bj * 128;
                    u32x4 y8 = (u32x4){0u, 0u, 0u, 0u}; if (br) y8 = *(const u32x4*)yp;
                    const f32x4 v0 = acc[ai][bj][m][0], v1 = acc[ai][bj][m][1];
                    float o[8];
#pragma unroll
                    for (int k = 0; k < 8; ++k) { const unsigned gw = g8[k >> 1], yw = y8[k >> 1]; const float gv = bf2f((k & 1) ? (gw >> 16) : (gw & 0xffffu)), yv = bf2f((k & 1) ? (yw >> 16) : (yw & 0xffffu));
                        const float a = k < 4 ? v0[k & 3] : v1[k & 3]; o[k] = yv + sigm(gv) * a; }
                    u32x4 w; w.x = cvt_pk_bf16(o[0], o[1]); w.y = cvt_pk_bf16(o[2], o[3]); w.z = cvt_pk_bf16(o[4], o[5]); w.w = cvt_pk_bf16(o[6], o[7]);
                    *(u32x4*)yp = w; } }
    }
};
struct EpiOut {
    static constexpr bool PERM = true;
    bf16* C; float* RSS;
    DEV void operator()(const f32x4 (&acc)[2][2][4][2], const pg8::Unit& u, int wr, int wc, int fr, int fq) const {
        const int row0 = u.pm * 256 + wr * 64 + fr, col0 = u.pn * 256 + wc * 32 + 8 * fq;
#pragma unroll
        for (int ai = 0; ai < 2; ++ai)
#pragma unroll
            for (int m = 0; m < 4; ++m) { const size_t row = (size_t)(row0 + ai * 128 + m * 16); bf16* rowp = C + row * D + col0; float ss = 0.f;
#pragma unroll
                for (int bj = 0; bj < 2; ++bj) { const f32x4 v0 = acc[ai][bj][m][0], v1 = acc[ai][bj][m][1];
                    ss += ((v0[0] * v0[0] + v0[1] * v0[1]) + (v0[2] * v0[2] + v0[3] * v0[3])) + ((v1[0] * v1[0] + v1[1] * v1[1]) + (v1[2] * v1[2] + v1[3] * v1[3]));
                    u32x4 w; w.x = cvt_pk_bf16(v0[0], v0[1]); w.y = cvt_pk_bf16(v0[2], v0[3]); w.z = cvt_pk_bf16(v1[0], v1[1]); w.w = cvt_pk_bf16(v1[2], v1[3]);
                    *(u32x4*)(rowp + bj * 128) = w; }
                ss += __shfl_xor(ss, 16); ss += __shfl_xor(ss, 32);
                if (fq == 0) RSS[row * NRS + u.pn * 4 + wc] = ss; }
    }
};

#ifndef EMU
typedef GAS unsigned gu32;
#define RLX_AGENT __ATOMIC_RELAXED, __HIP_MEMORY_SCOPE_AGENT
#define XB_TMO      128
#define XB_XCNT(j)  (256  + 64 * (j))
#define XB_XSUB(j)  (1280 + 64 * (j))
#define XB_XGEN(j)  (2304 + 64 * (j))
#define XB_TOP      3328
#define XB_TOPGEN   3392
#define XCD_BAR_WORDS 3456
#define XB_SPIN_CAP (1u << 22)
__device__ __forceinline__ unsigned xb_ld(unsigned* p)              { return __hip_atomic_load(p, __ATOMIC_RELAXED, __HIP_MEMORY_SCOPE_AGENT); }
__device__ __forceinline__ unsigned xb_add(unsigned* p, unsigned v) { return __hip_atomic_fetch_add(p, v, __ATOMIC_RELAXED, __HIP_MEMORY_SCOPE_AGENT); }
__device__ __forceinline__ unsigned xb_xcc_id() { return (unsigned)__builtin_amdgcn_s_getreg((3 << 11) | 20) & 0xFu; }
#define XB_SPIN(cond, bar) do { unsigned _sp = 0; while (cond) { __builtin_amdgcn_s_sleep(1); \
    if ((++_sp & 255u) == 0u) { if (xb_ld(&(bar)[XB_TMO])) break; if (_sp > XB_SPIN_CAP) { atomicAdd(&(bar)[XB_TMO], 1u); break; } } } } while (0)
struct XcdBarrier { unsigned* bar; unsigned x; volatile LAS unsigned* st; };
__device__ __forceinline__ XcdBarrier xcd_barrier_post(unsigned* bar, volatile LAS unsigned* st) {
    XcdBarrier b; b.bar = bar; b.x = xb_xcc_id(); b.st = st;
    if (threadIdx.x == 0) (void)xb_add(&bar[XB_XCNT(b.x)], 1u);
    return b;
}
__device__ __forceinline__ void xcd_barrier_complete(unsigned* bar, unsigned x, unsigned& nloc, unsigned& nx) {
    const unsigned G = gridDim.x * gridDim.y * gridDim.z;
    unsigned sum, cnt, mine, sp = 0u;
    for (;;) {
        sum = 0u; cnt = 0u; mine = 0u;
#pragma unroll
        for (unsigned j = 0; j < 16; ++j) { const unsigned c = xb_ld(&bar[XB_XCNT(j)]); sum += c; cnt += (c > 0u) ? 1u : 0u; mine = (j == x) ? c : mine; }
        if (sum == G) break;
        __builtin_amdgcn_s_sleep(1);
        if ((++sp & 255u) == 0u) { if (xb_ld(&bar[XB_TMO])) break; if (sp > XB_SPIN_CAP) { atomicAdd(&bar[XB_TMO], 1u); break; } }
    }
    nloc = mine > 0u ? mine : 1u; nx = cnt > 0u ? cnt : 1u;
}
__device__ __forceinline__ void xcd_barrier(const XcdBarrier& b) {
    asm volatile("s_waitcnt vmcnt(0)" ::: "memory");
    __syncthreads();
    if (threadIdx.x == 0) {
        unsigned* bar = b.bar;
        __builtin_amdgcn_s_waitcnt(0);
        unsigned nloc = b.st[0], nx = b.st[1];
        if (nloc == 0u) { xcd_barrier_complete(bar, b.x, nloc, nx); b.st[0] = nloc; b.st[1] = nx; }
        const unsigned old = xb_add(&bar[XB_XSUB(b.x)], 1u);
        const unsigned gen = old / nloc;
        if (old + 1u == (gen + 1u) * nloc) {
            __builtin_amdgcn_fence(__ATOMIC_RELEASE, "agent");
            asm volatile("s_waitcnt vmcnt(0)" ::: "memory");
            const unsigned og = xb_add(&bar[XB_TOP], 1u);
            const unsigned tg = og / nx;
            if (og + 1u == (tg + 1u) * nx) xb_add(&bar[XB_TOPGEN], 1u);
            else XB_SPIN(xb_ld(&bar[XB_TOPGEN]) == tg, bar);
            __builtin_amdgcn_fence(__ATOMIC_ACQUIRE, "agent");
            xb_add(&bar[XB_XGEN(b.x)], 1u);
            asm volatile("s_waitcnt vmcnt(0)" ::: "memory");
        } else {
            XB_SPIN(xb_ld(&bar[XB_XGEN(b.x)]) == gen, bar);
            __builtin_amdgcn_fence(__ATOMIC_ACQUIRE, "agent");
            asm volatile("s_waitcnt vmcnt(0)" ::: "memory");
        }
    }
    __syncthreads();
}
#endif

struct Args { const float* in[14]; float* out; unsigned char* ws; int ph_lo, ph_hi; };

DEV float clamp8(float x) { return fminf(fmaxf(x, -448.0f), 448.0f); }
template <bool FP8>
DEV void p0_transpose_item(const float* W, int ldw, int K, void* WT_, int k0, int c0, int r0, int nvalid, ldsp scr, int lane) {
    const int kr = lane >> 4, n4 = 4 * (lane & 15);
    f32x4 v[16];
#pragma unroll
    for (int i = 0; i < 16; ++i) v[i] = (n4 < nvalid) ? *(const f32x4*)(W + (size_t)(k0 + 4 * i + kr) * ldw + c0 + n4) : (f32x4){0.f, 0.f, 0.f, 0.f};
#pragma unroll
    for (int i = 0; i < 16; ++i) LDS_WR(f32x4, scr + ((4 * i + kr) * 68 + n4) * 4, v[i]);
    WAVE_SYNC();
    if constexpr (!FP8) {
        bf16* WT = (bf16*)WT_;
        const int c = lane & 7;
#pragma unroll
        for (int j = 0; j < 8; ++j) { const int n = (lane >> 3) + 8 * j; ldsp sp = scr + ((8 * c) * 68 + n) * 4;
            u32x4 o; o.x = pk2(LDS_RD(float, sp + 0 * 272), LDS_RD(float, sp + 1 * 272)); o.y = pk2(LDS_RD(float, sp + 2 * 272), LDS_RD(float, sp + 3 * 272));
            o.z = pk2(LDS_RD(float, sp + 4 * 272), LDS_RD(float, sp + 5 * 272)); o.w = pk2(LDS_RD(float, sp + 6 * 272), LDS_RD(float, sp + 7 * 272));
            if (n < nvalid) *(u32x4*)(WT + (size_t)(r0 + n) * K + k0 + 8 * c) = o; }
    } else {
        unsigned char* WT = (unsigned char*)WT_;
        const int c = lane & 3;
#pragma unroll
        for (int j = 0; j < 4; ++j) { const int n = (lane >> 2) + 16 * j; ldsp sp = scr + ((16 * c) * 68 + n) * 4; float f[16];
#pragma unroll
            for (int i = 0; i < 16; ++i) f[i] = clamp8(LDS_RD(float, sp + i * 272) * W8_SCALE);
            u32x4 o; o.x = pk_fp8x4(f[0], f[1], f[2], f[3]); o.y = pk_fp8x4(f[4], f[5], f[6], f[7]); o.z = pk_fp8x4(f[8], f[9], f[10], f[11]); o.w = pk_fp8x4(f[12], f[13], f[14], f[15]);
            if (n < nvalid) *(u32x4*)(WT + (size_t)(r0 + n) * K + k0 + 16 * c) = o; }
    }
    WAVE_SYNC();
}

constexpr int MS = 272, MS64 = 144;
constexpr int NUA = NB * HA * NCH, NUB = NB * HB * NCH;
constexpr size_t TW_QA = 0, TW_KA = TW_QA + (size_t)NUA * 16384, TW_VA = TW_KA + (size_t)NUA * 16384, TW_QB = TW_VA + (size_t)NUA * 2048, TW_KB = TW_QB + (size_t)NUB * 16384, TW_SB = TW_KB + (size_t)NUB * 16384, TW_END = TW_SB + (size_t)NUB * 1024;
static_assert(TW_END <= (size_t)(NP + 16) * D * 2, "operand tiles must fit the dead W1T region");
DEV int swz(int row, int chunk) { return row * 256 + ((chunk ^ (row & 15)) << 4); }

DEV bf16x8 frag16(ldsp buf, int stride, int row0, int ks, int lane) { return LDS_RD(bf16x8, buf + (row0 + (lane & 15)) * stride + ks * 64 + (lane >> 4) * 16); }
DEV bf16x8 frag16s(ldsp img, int row0, int ks, int lane) { return LDS_RD(bf16x8, img + swz(row0 + (lane & 15), 4 * ks + (lane >> 4))); }
DEV bf16x8 frag8x2s(ldsp img, int row0, int ks, int lane) {
    const int row = row0 + (lane & 15), q = lane >> 4;
    const bf16x4 lo = LDS_RD(bf16x4, img + swz(row, 4 * ks + (q >> 1)) + (q & 1) * 8), hi = LDS_RD(bf16x4, img + swz(row, 4 * ks + 2 + (q >> 1)) + (q & 1) * 8);
    return (bf16x8){lo[0], lo[1], lo[2], lo[3], hi[0], hi[1], hi[2], hi[3]};
}
DEV bf16x8 frag_tr(ldsp img, int n0, int ks, int lane, int stride = 256) {
    ldsp p = img + (32 * ks + 8 * (lane >> 4) + ((lane & 15) >> 2)) * stride + (n0 + 4 * (lane & 3)) * 2;
    const bf16x4 lo = lds_tr16(p), hi = lds_tr16(p + 4 * stride);
    return (bf16x8){lo[0], lo[1], lo[2], lo[3], hi[0], hi[1], hi[2], hi[3]};
}
DEV bf16x8 frag_trs(ldsp img, int n0, int ks, int lane) {
    const int row = 32 * ks + 8 * (lane >> 4) + ((lane & 15) >> 2), p = lane & 3, ch = (n0 >> 3) + (p >> 1);
    const bf16x4 lo = lds_tr16(img + swz(row, ch) + (p & 1) * 8), hi = lds_tr16(img + swz(row + 4, ch) + (p & 1) * 8);
    return (bf16x8){lo[0], lo[1], lo[2], lo[3], hi[0], hi[1], hi[2], hi[3]};
}
DEV void dma_lin(const void* src, int ninst, ldsp dst, int wave, int lane) {
    for (int i = wave; i < ninst; i += NWAVES) GLDS16X((const char*)src + i * 1024 + 16 * lane, dst + i * 1024);
}
DEV float sigm2(float x) { return frcp(1.0f + fexp2(-LOG2E * x)); }
DEV u32x2 pack4(const f32x4 v) { u32x2 w; w.x = cvt_pk_bf16(v[0], v[1]); w.y = cvt_pk_bf16(v[2], v[3]); return w; }

DEV float scan_add(float v, int lane) {
#pragma unroll
    for (int o = 1; o < 64; o <<= 1) { const float t = __shfl_up(v, o); if (lane >= o) v += t; }
    return v;
}
DEV float scan_max(float v, int lane) {
#pragma unroll
    for (int o = 1; o < 64; o <<= 1) { const float t = __shfl_up(v, o); if (lane >= o) v = fmaxf(v, t); }
    return v;
}

constexpr int PA_RAW = 0, PA_RAWSZ = 2 * 68 * 256, PA_TOT = 2 * PA_RAWSZ, PA_END = PA_TOT + 8 * 128 * 4;
static_assert(PA_END <= RING_BYTES, "P2 LDS");
DEV void p2_issue(const Args& args, int u, ldsp raw, int wave, int lane) {
    const bf16* P = (const bf16*)(args.ws + WS_P);
    if (u < NUA) { const int bh = u / NCH, j = u % NCH, b = bh / HA, h = bh % HA; const size_t tok0 = (size_t)b * SEQ + 64 * j;
        dma_lin(P + p_off(tok0, C_QA + h * 128), 16, raw, wave, lane); dma_lin(P + p_off(tok0, C_FA + h * 128), 16, raw + 68 * 256, wave, lane); }
    else { const int ub = u - NUA, bh = ub / NCH, j = ub % NCH, b = bh / HB, h = bh % HB; const size_t tok0 = (size_t)b * SEQ + 64 * j;
        dma_lin(P + p_off(tok0, C_QB + h * 128) - 3 * 128, 17, raw, wave, lane); dma_lin(P + p_off(tok0, C_KB + h * 128) - 3 * 128, 17, raw + 68 * 256, wave, lane); }
}
DEV void p2_unit(const Args& args, ldsp lds, int u, ldsp raw, int wave, int lane) {
    unsigned char* TW = args.ws + WS_W1T;
    if (u < NUA) {
        const int bh = u / NCH, h = bh % HA;
        const float* lbl = args.in[3];
        float lbv[2];
#pragma unroll
        for (int e = 0; e < 2; ++e) { const int col = h * 128 + 2 * lane + e; lbv[e] = frcp(1.0f + fexp(lbl[DA + col] - lbl[col])); }
        float lf[8][2], qv[8][2], kv[8][2];
#pragma unroll
        for (int c = 0; c < 8; ++c) { const unsigned qw = LDS_RD(unsigned, raw + (8 * wave + c) * 256 + lane * 4), fw = LDS_RD(unsigned, raw + 68 * 256 + (8 * wave + c) * 256 + lane * 4);
#pragma unroll
            for (int e = 0; e < 2; ++e) { const float f = lbv[e] + (1.0f - lbv[e]) * sigm2(__builtin_bit_cast(float, e ? (fw & 0xffff0000u) : (fw << 16))); lf[c][e] = flog2(f); kv[c][e] = 1.0f - f; qv[c][e] = __builtin_bit_cast(float, e ? (qw & 0xffff0000u) : (qw << 16)); } }
#pragma unroll
        for (int c = 1; c < 8; ++c) { lf[c][0] += lf[c - 1][0]; lf[c][1] += lf[c - 1][1]; }
        LDS_WR(f32x2, lds + PA_TOT + (wave * 128 + 2 * lane) * 4, ((f32x2){lf[7][0], lf[7][1]}));
        MIX_BAR();
        f32x2 off = (f32x2){0.f, 0.f}, bmid = (f32x2){0.f, 0.f}, g = (f32x2){0.f, 0.f};
#pragma unroll
        for (int w = 0; w < 8; ++w) { const f32x2 t = LDS_RD(f32x2, lds + PA_TOT + (w * 128 + 2 * lane) * 4); if (w < wave) off += t; if (w < 4) bmid += t; g += t; }
        if (wave == 0) { float* vec = (float*)(TW + TW_VA + (size_t)u * 2048) + 2 * lane;
            *(f32x2*)vec = (f32x2){fexp2(bmid[0]), fexp2(bmid[1])}; *(f32x2*)(vec + 128) = (f32x2){fexp2(g[0]), fexp2(g[1])}; *(f32x2*)(vec + 256) = (f32x2){fexp2(g[0] - bmid[0]), fexp2(g[1] - bmid[1])}; }
        unsigned char* tq = TW + TW_QA + (size_t)u * 16384; unsigned char* tk = TW + TW_KA + (size_t)u * 16384;
#pragma unroll
        for (int c = 0; c < 8; ++c) { float qr[2], kk[2]; const int r = 8 * wave + c;
#pragma unroll
            for (int e = 0; e < 2; ++e) { const float t1 = lf[c][e] + off[e] - bmid[e]; qr[e] = qv[c][e] * fexp2(t1); kk[e] = kv[c][e] * fexp2(-t1); }
            *(unsigned*)(tq + swz(r, lane >> 2) + (lane & 3) * 4) = cvt_pk_bf16(qr[0], qr[1]);
            *(unsigned*)(tk + swz(r, lane >> 2) + (lane & 3) * 4) = cvt_pk_bf16(kk[0], kk[1]); }
    } else {
        const int ub = u - NUA, bh = ub / NCH, j = ub % NCH, h = bh % HB;
        const float* cw = args.in[4]; const float* cb = args.in[5];
        f32x2 wq[4], wk[4];
#pragma unroll
        for (int k = 0; k < 4; ++k) { wq[k] = *(const f32x2*)(cw + k * (2 * DQK) + h * 128 + 2 * lane); wk[k] = *(const f32x2*)(cw + k * (2 * DQK) + DQK + h * 128 + 2 * lane); }
        const f32x2 bq = *(const f32x2*)(cb + h * 128 + 2 * lane), bk = *(const f32x2*)(cb + DQK + h * 128 + 2 * lane);
        unsigned uq[11], uk[11];
#pragma unroll
        for (int i = 0; i < 11; ++i) { const bool neg = (64 * j + 8 * wave + i - 3) < 0;
            const unsigned a = LDS_RD(unsigned, raw + (8 * wave + i) * 256 + lane * 4), bb = LDS_RD(unsigned, raw + 68 * 256 + (8 * wave + i) * 256 + lane * 4); uq[i] = neg ? 0u : a; uk[i] = neg ? 0u : bb; }
        if (wave == 0) {
            const int b = bh / HB; const size_t tok = (size_t)b * SEQ + 64 * j + lane; const float* SG = (const float*)(args.ws + WS_SG);
            const float fp = SG[tok * 16 + HB + h] + args.in[7][h], ig = SG[tok * 16 + h] + args.in[6][h];
            const float bc = scan_add(logsig(fp), lane), a = ig - bc, pm = scan_max(a, lane);
            float* sb = (float*)(TW + TW_SB + (size_t)ub * 1024) + lane; sb[0] = a; sb[64] = pm; sb[128] = bc;
        }
        unsigned char* tq = TW + TW_QB + (size_t)ub * 16384; unsigned char* tk = TW + TW_KB + (size_t)ub * 16384;
#pragma unroll
        for (int c = 0; c < 8; ++c) { float qq[2], kk[2]; const int r = 8 * wave + c;
#pragma unroll
            for (int e = 0; e < 2; ++e) { float yq = bq[e], yk = bk[e];
#pragma unroll
                for (int k = 0; k < 4; ++k) { yq += wq[k][e] * __builtin_bit_cast(float, e ? (uq[c + k] & 0xffff0000u) : (uq[c + k] << 16)); yk += wk[k][e] * __builtin_bit_cast(float, e ? (uk[c + k] & 0xffff0000u) : (uk[c + k] << 16)); }
                qq[e] = yq * sigm2(yq); kk[e] = yk * sigm2(yk) * 0.08838834764831845f; }
            *(unsigned*)(tq + swz(r, lane >> 2) + (lane & 3) * 4) = cvt_pk_bf16(qq[0], qq[1]);
            *(unsigned*)(tk + swz(r, lane >> 2) + (lane & 3) * 4) = cvt_pk_bf16(kk[0], kk[1]); }
    }
}

constexpr int PB_BUFSZ = 51200, PB_Q = 0, PB_K = 16384, PB_V = 32768, PB_VEC = 49152;
constexpr int PB_KW = 2 * PB_BUFSZ, PB_PS = PB_KW + 64 * MS, PB_SM = PB_PS + 64 * MS64;
constexpr int SM_SSQ = PB_SM;
constexpr int SM_A = SM_SSQ + 2 * 64 * 8 * 4, SM_MX = SM_A + 256, SM_INT = SM_MX + 256, SM_EMT = SM_INT + 256, SM_WGT = SM_EMT + 256, SM_SCAL = SM_WGT + 256;
constexpr int SM_NV = SM_SCAL + 64, SM_NACC = SM_NV + 512, SM_RSUM = SM_NACC + 8 * 512, SM_QN = SM_RSUM + 64 * 2 * 4, MX_END = SM_QN + 256;
static_assert(MX_END <= RING_BYTES, "mixer LDS");

DEV void mixer_a_job(const Args& args, ldsp lds, int b, int h, int tid_) {
    const int wave = RFL(tid_ >> 6);
    const bf16* P = (const bf16*)(args.ws + WS_P);
    const unsigned char* TW = args.ws + WS_W1T;
    const rsrc_t RO = make_rsrc(args.ws + WS_OAB, (unsigned)((size_t)2 * M * DA * 2));
    float* SSA = (float*)(args.ws + WS_SSA);
    const int u0 = (b * HA + h) * NCH;
    f32x4 st[8], o[4];
#pragma unroll
    for (int t = 0; t < 8; ++t) st[t] = (f32x4){0.f, 0.f, 0.f, 0.f};
#pragma unroll
    for (int ct = 0; ct < 4; ++ct) o[ct] = (f32x4){0.f, 0.f, 0.f, 0.f};
#define MA_DMA(jj) do { ldsp bf_ = lds + ((jj) & 1) * PB_BUFSZ; const size_t uu_ = (size_t)(u0 + (jj)); \
        dma_lin(TW + TW_QA + uu_ * 16384, 16, bf_ + PB_Q, wave, lane); dma_lin(TW + TW_KA + uu_ * 16384, 16, bf_ + PB_K, wave, lane); \
        dma_lin(P + p_off((size_t)b * SEQ + 64 * (jj), C_IA + h * 128), 16, bf_ + PB_V, wave, lane); dma_lin(TW + TW_VA + uu_ * 2048, 2, bf_ + PB_VEC, wave, lane); } while (0)
    { const int lane = tid_ & 63; MA_DMA(0); }
    for (int j = 0; j <= NCH; ++j) {
        int tidj = tid_; OPAQUE(tidj);
        const int lane = tidj & 63, q4 = lane >> 4, l15 = lane & 15;
        const size_t tk0 = (size_t)b * SEQ + 64 * j;
        if (j <= 1) WAIT_V(0); else WAIT_V(4);
        MIX_BAR();
        if (j + 1 < NCH) MA_DMA(j + 1);
        if (j > 0) {
            if (wave == 0) { ldsp ssq = lds + SM_SSQ + ((j - 1) & 1) * 2048; const f32x4 s0 = LDS_RD(f32x4, ssq + (lane * 8) * 4), s1 = LDS_RD(f32x4, ssq + (lane * 8 + 4) * 4);
                SSA[(tk0 - 64 + lane) * HA + h] = ((s0[0] + s0[1]) + (s0[2] + s0[3])) + ((s1[0] + s1[1]) + (s1[2] + s1[3])); }
#pragma unroll
            for (int ct = 0; ct < 4; ++ct) bstore64(RO, (unsigned)(l15 * DA + h * 128 + 16 * wave + 4 * q4) * 2u, (unsigned)(tk0 - 64 + 16 * ct) * (unsigned)(DA * 2), pack4(o[ct]));
        }
        if (j == NCH) break;
        ldsp bf = lds + (j & 1) * PB_BUFSZ;
        {
            const int ct = wave >> 1, st0 = 2 * (wave & 1);
            f32x4 sc[2] = {(f32x4){0.f, 0.f, 0.f, 0.f}, (f32x4){0.f, 0.f, 0.f, 0.f}};
#pragma unroll
            for (int ks = 0; ks < 4; ++ks) { const bf16x8 qf = frag16s(bf + PB_Q, 16 * ct, ks, lane);
#pragma unroll
                for (int n = 0; n < 2; ++n) { const bf16x8 kf_ = frag16s(bf + PB_K, 16 * (st0 + n), ks, lane); sc[n] = MFMA16(kf_, qf, sc[n]); } }
#pragma unroll
            for (int n = 0; n < 2; ++n) { const int c = 16 * ct + l15, s0_ = 16 * (st0 + n) + 4 * q4; f32x4 v = sc[n];
#pragma unroll
                for (int r = 0; r < 4; ++r) v[r] = (s0_ + r <= c) ? v[r] : 0.f;
                LDS_WR(u32x2, lds + PB_PS + c * MS64 + s0_ * 2, pack4(v)); }
        }
        MIX_BAR();
        {
            bf16x8 bv[2];
#pragma unroll
            for (int ks = 0; ks < 2; ++ks) bv[ks] = frag_tr(bf + PB_V, 16 * wave, ks, lane);
#pragma unroll
            for (int ct = 0; ct < 4; ++ct) o[ct] = (f32x4){0.f, 0.f, 0.f, 0.f};
#pragma unroll
            for (int ks = 0; ks < 2; ++ks)
#pragma unroll
                for (int ct = 0; ct < 4; ++ct) { const bf16x8 pf = frag16(lds + PB_PS, MS64, 16 * ct, ks, lane); o[ct] = MFMA16(bv[ks], pf, o[ct]); }
#pragma unroll
            for (int ks = 0; ks < 4; ++ks) {
                const f32x4 e0 = LDS_RD(f32x4, bf + PB_VEC + (32 * ks + 4 * q4) * 4), e1 = LDS_RD(f32x4, bf + PB_VEC + (32 * ks + 16 + 4 * q4) * 4);
                u32x4 w; const f32x4 a0 = st[2 * ks] * e0, a1 = st[2 * ks + 1] * e1; w.x = cvt_pk_bf16(a0[0], a0[1]); w.y = cvt_pk_bf16(a0[2], a0[3]); w.z = cvt_pk_bf16(a1[0], a1[1]); w.w = cvt_pk_bf16(a1[2], a1[3]);
                const bf16x8 sf = __builtin_bit_cast(bf16x8, w);
#pragma unroll
                for (int ct = 0; ct < 4; ++ct) { const bf16x8 qf = frag8x2s(bf + PB_Q, 16 * ct, ks, lane); o[ct] = MFMA16(sf, qf, o[ct]); } }
#pragma unroll
            for (int t = 0; t < 8; ++t) {
                f32x4 u = (f32x4){0.f, 0.f, 0.f, 0.f};
#pragma unroll
                for (int ks = 0; ks < 2; ++ks) { const bf16x8 a = frag_trs(bf + PB_K, 16 * t, ks, lane); u = MFMA16(a, bv[ks], u); }
                const f32x4 eg = LDS_RD(f32x4, bf + PB_VEC + 512 + (16 * t + 4 * q4) * 4), egm = LDS_RD(f32x4, bf + PB_VEC + 1024 + (16 * t + 4 * q4) * 4); st[t] = eg * st[t] + egm * u; }
            ldsp ssq = lds + SM_SSQ + (j & 1) * 2048;
#pragma unroll
            for (int ct = 0; ct < 4; ++ct) { float s = (o[ct][0] * o[ct][0] + o[ct][1] * o[ct][1]) + (o[ct][2] * o[ct][2] + o[ct][3] * o[ct][3]); s += __shfl_xor(s, 16); s += __shfl_xor(s, 32);
                LDS_WR(float, ssq + ((16 * ct + l15) * 8 + wave) * 4, s); }
        }
    }
#undef MA_DMA
}

DEV void mixer_b_job(const Args& args, ldsp lds, int b, int h, int half, int tid_) {
    const int wave = RFL(tid_ >> 6);
    const int vbase = h * 256 + 128 * half;
    const bf16* P = (const bf16*)(args.ws + WS_P);
    const unsigned char* TW = args.ws + WS_W1T;
    const rsrc_t RO = make_rsrc(args.ws + WS_OAB, (unsigned)((size_t)2 * M * DA * 2));
    float* SSB = (float*)(args.ws + WS_SSB);
    const int u0 = (b * HB + h) * NCH;
    f32x4 st[8], hv[4];
#pragma unroll
    for (int t = 0; t < 8; ++t) st[t] = (f32x4){0.f, 0.f, 0.f, 0.f};
#pragma unroll
    for (int ct = 0; ct < 4; ++ct) hv[ct] = (f32x4){0.f, 0.f, 0.f, 0.f};
    float mcar = 0.f;
    if (wave < 2) LDS_WR(float, lds + SM_NV + tid_ * 4, 0.f);
#define MB_DMA(jj) do { ldsp bf_ = lds + ((jj) & 1) * PB_BUFSZ; const size_t uu_ = (size_t)(u0 + (jj)); \
        dma_lin(TW + TW_QB + uu_ * 16384, 16, bf_ + PB_Q, wave, lane); dma_lin(TW + TW_KB + uu_ * 16384, 16, bf_ + PB_K, wave, lane); \
        dma_lin(P + p_off((size_t)b * SEQ + 64 * (jj), C_VB + vbase), 16, bf_ + PB_V, wave, lane); dma_lin(TW + TW_SB + uu_ * 1024, 1, bf_ + PB_VEC, wave, lane); } while (0)
    { const int lane = tid_ & 63; MB_DMA(0); }
    for (int j = 0; j <= NCH; ++j) {
        const size_t tk0 = (size_t)b * SEQ + 64 * j;
        int tidj = tid_; OPAQUE(tidj);
        const int tid = tidj, lane = tidj & 63, q4 = lane >> 4, l15 = lane & 15;
        if (j <= 1) WAIT_V(0); else WAIT_V(4);
        MIX_BAR();
        if (j + 1 < NCH) MB_DMA(j + 1);
        if (j > 0) {
            if (wave == 0) { ldsp ssq = lds + SM_SSQ + ((j - 1) & 1) * 2048; const f32x4 s0 = LDS_RD(f32x4, ssq + (lane * 8) * 4), s1 = LDS_RD(f32x4, ssq + (lane * 8 + 4) * 4);
                SSB[(tk0 - 64 + lane) * (2 * HB) + 2 * h + half] = ((s0[0] + s0[1]) + (s0[2] + s0[3])) + ((s1[0] + s1[1]) + (s1[2] + s1[3])); }
#pragma unroll
            for (int ct = 0; ct < 4; ++ct) bstore64(RO, (unsigned)(l15 * DB + vbase + 16 * wave + 4 * q4) * 2u, (unsigned)(M + tk0 - 64 + 16 * ct) * (unsigned)(DB * 2), pack4(hv[ct]));
        }
        if (j == NCH) break;
        ldsp bf = lds + (j & 1) * PB_BUFSZ;
        if (wave == 0) {
            const float a = LDS_RD(float, bf + PB_VEC + lane * 4), bc = LDS_RD(float, bf + PB_VEC + 512 + lane * 4), mx = fmaxf(mcar, LDS_RD(float, bf + PB_VEC + 256 + lane * 4));
            const float g = __shfl(bc, 63), m63 = __shfl(mx, 63);
            LDS_WR(float, lds + SM_A + lane * 4, a * LOG2E); LDS_WR(float, lds + SM_MX + lane * 4, mx * LOG2E); LDS_WR(float, lds + SM_INT + lane * 4, fexp(mcar - mx));
            LDS_WR(float, lds + SM_EMT + lane * 4, fexp(-(bc + mx))); LDS_WR(float, lds + SM_WGT + lane * 4, fexp(a - m63));
            if (lane == 0) { LDS_WR(float, lds + SM_SCAL, fexp(mcar - m63)); LDS_WR(float, lds + SM_SCAL + 4, g + m63); }
        }
        MIX_BAR();
        const float decay = LDS_RD(float, lds + SM_SCAL);
        mcar = LDS_RD(float, lds + SM_SCAL + 4);
        {
            float na[2] = {0.f, 0.f};
            const f32x4 w0 = LDS_RD(f32x4, lds + SM_WGT + (8 * wave) * 4), w1 = LDS_RD(f32x4, lds + SM_WGT + (8 * wave + 4) * 4);
#pragma unroll
            for (int c = 0; c < 8; ++c) { const int r = 8 * wave + c; const float w_ = c < 4 ? w0[c & 3] : w1[c & 3]; const unsigned kw_ = LDS_RD(unsigned, bf + PB_K + swz(r, lane >> 2) + (lane & 3) * 4);
                na[0] += w_ * __builtin_bit_cast(float, kw_ << 16); na[1] += w_ * __builtin_bit_cast(float, kw_ & 0xffff0000u); }
            LDS_WR(f32x2, lds + SM_NACC + (wave * 128 + 2 * lane) * 4, ((f32x2){na[0], na[1]}));
            const int c = tid >> 3, part = tid & 7; float s = 0.f;
#pragma unroll
            for (int hh = 0; hh < 2; ++hh) { const u32x4 qw = LDS_RD(u32x4, bf + PB_Q + swz(c, 2 * part + hh));
#pragma unroll
                for (int e = 0; e < 4; ++e) { const f32x2 nv = LDS_RD(f32x2, lds + SM_NV + (16 * part + 8 * hh + 2 * e) * 4); s += __builtin_bit_cast(float, qw[e] << 16) * nv[0] + __builtin_bit_cast(float, qw[e] & 0xffff0000u) * nv[1]; } }
            s += __shfl_xor(s, 1); s += __shfl_xor(s, 2); s += __shfl_xor(s, 4);
            LDS_WR(float, lds + SM_QN + c * 4, s);
        }
        MIX_BAR();
        {
            const int ct = wave >> 1, st0 = 2 * (wave & 1), c = 16 * ct + l15;
            f32x4 sc[2] = {(f32x4){0.f, 0.f, 0.f, 0.f}, (f32x4){0.f, 0.f, 0.f, 0.f}};
#pragma unroll
            for (int ks = 0; ks < 4; ++ks) { const bf16x8 qf = frag16s(bf + PB_Q, 16 * ct, ks, lane);
#pragma unroll
                for (int n = 0; n < 2; ++n) { const bf16x8 kf_ = frag16s(bf + PB_K, 16 * (st0 + n), ks, lane); sc[n] = MFMA16(kf_, qf, sc[n]); } }
            const float mxc = LDS_RD(float, lds + SM_MX + c * 4); float rs = 0.f;
#pragma unroll
            for (int n = 0; n < 2; ++n) { const int s0_ = 16 * (st0 + n) + 4 * q4; const f32x4 as = LDS_RD(f32x4, lds + SM_A + s0_ * 4); f32x4 v;
#pragma unroll
                for (int r = 0; r < 4; ++r) { const float t = fexp2(as[r] - mxc) * sc[n][r]; v[r] = (s0_ + r <= c) ? t : 0.f; rs += v[r]; }
                LDS_WR(u32x2, lds + PB_PS + c * MS64 + s0_ * 2, pack4(v)); }
            rs += __shfl_xor(rs, 16); rs += __shfl_xor(rs, 32);
            LDS_WR(float, lds + SM_RSUM + (c * 2 + (wave & 1)) * 4, rs);
        }
        MIX_BAR();
        {
            bf16x8 bv[2], bvw[2], bs[4];
#pragma unroll
            for (int ks = 0; ks < 2; ++ks) { bv[ks] = frag_tr(bf + PB_V, 16 * wave, ks, lane);
                const f32x4 wa = LDS_RD(f32x4, lds + SM_WGT + (32 * ks + 8 * q4) * 4), wb = LDS_RD(f32x4, lds + SM_WGT + (32 * ks + 8 * q4 + 4) * 4);
                const u32x4 vw = __builtin_bit_cast(u32x4, bv[ks]); u32x4 ow;
#pragma unroll
                for (int e = 0; e < 4; ++e) { const f32x4 ww = e < 2 ? wa : wb; ow[e] = cvt_pk_bf16(__builtin_bit_cast(float, vw[e] << 16) * ww[(2 * e) & 3], __builtin_bit_cast(float, vw[e] & 0xffff0000u) * ww[(2 * e + 1) & 3]); }
                bvw[ks] = __builtin_bit_cast(bf16x8, ow); }
#pragma unroll
            for (int ks = 0; ks < 4; ++ks) { u32x4 w; const f32x4 a0 = st[2 * ks], a1 = st[2 * ks + 1]; w.x = cvt_pk_bf16(a0[0], a0[1]); w.y = cvt_pk_bf16(a0[2], a0[3]); w.z = cvt_pk_bf16(a1[0], a1[1]); w.w = cvt_pk_bf16(a1[2], a1[3]); bs[ks] = __builtin_bit_cast(bf16x8, w); }
#pragma unroll
            for (int ct = 0; ct < 4; ++ct) {
                f32x4 a1 = (f32x4){0.f, 0.f, 0.f, 0.f}, a2 = (f32x4){0.f, 0.f, 0.f, 0.f};
#pragma unroll
                for (int ks = 0; ks < 2; ++ks) { const bf16x8 pf = frag16(lds + PB_PS, MS64, 16 * ct, ks, lane); a2 = MFMA16(bv[ks], pf, a2); }
#pragma unroll
                for (int ks = 0; ks < 4; ++ks) { const bf16x8 qf = frag8x2s(bf + PB_Q, 16 * ct, ks, lane); a1 = MFMA16(bs[ks], qf, a1); }
                const int c = 16 * ct + l15; const float inter = LDS_RD(float, lds + SM_INT + c * 4); const f32x2 rsm = LDS_RD(f32x2, lds + SM_RSUM + (c * 2) * 4);
                const float den = inter * LDS_RD(float, lds + SM_QN + c * 4) + (rsm[0] + rsm[1]);
                const float rden = frcp(fmaxf(fabsf(den), LDS_RD(float, lds + SM_EMT + c * 4)));
                hv[ct] = (inter * a1 + a2) * rden;
            }
#pragma unroll
            for (int t = 0; t < 8; ++t) {
                f32x4 u = (f32x4){0.f, 0.f, 0.f, 0.f};
#pragma unroll
                for (int ks = 0; ks < 2; ++ks) { const bf16x8 a = frag_trs(bf + PB_K, 16 * t, ks, lane); u = MFMA16(a, bvw[ks], u); }
                st[t] = decay * st[t] + u;
            }
            if (wave < 2) { float nn = decay * LDS_RD(float, lds + SM_NV + tid * 4);
#pragma unroll
                for (int w = 0; w < 8; ++w) nn += LDS_RD(float, lds + SM_NACC + (w * 128 + tid) * 4);
                LDS_WR(float, lds + SM_NV + tid * 4, nn); }
            ldsp ssq = lds + SM_SSQ + (j & 1) * 2048;
#pragma unroll
            for (int ct = 0; ct < 4; ++ct) { float s = (hv[ct][0] * hv[ct][0] + hv[ct][1] * hv[ct][1]) + (hv[ct][2] * hv[ct][2] + hv[ct][3] * hv[ct][3]); s += __shfl_xor(s, 16); s += __shfl_xor(s, 32);
                LDS_WR(float, ssq + ((16 * ct + l15) * 8 + wave) * 4, s); }
        }
    }
#undef MB_DMA
}

constexpr int P0_RB1 = (NP + NSG + 63) / 64, P0_I1 = (D / 64) * P0_RB1, P0_IU = (DA / 64) * (D / 64), P0_IO = (D / 64) * (D / 64), P0_NITEMS = P0_I1 + 2 * P0_IU + P0_IO;
DEV void p0_item(const Args& args, int it, ldsp scr, int lane) {
    unsigned char* ws = args.ws; bf16* W1T = (bf16*)(ws + WS_W1T); bf16* WUT = (bf16*)(ws + WS_WUT); bf16* WOT = (bf16*)(ws + WS_WOT);
    int r = it;
    if (r < P0_I1) { const int kb = r / P0_RB1, rb = r % P0_RB1, r0 = 64 * rb; int c0, nv;
        if (r0 >= NPM && r0 < NP) { p0_transpose_item<true>(args.in[2], D_IN, D, ws + WS_W8, 64 * kb, r0 + NSG, r0 - NPM, 64, scr, lane); return; }
        if (r0 < NPM) { c0 = r0; nv = 64; } else { c0 = NPM + (r0 - NP); nv = NSG - (r0 - NP) < 64 ? NSG - (r0 - NP) : 64; }
        p0_transpose_item<false>(args.in[2], D_IN, D, W1T, 64 * kb, c0, r0, nv, scr, lane); return; }
    r -= P0_I1;
    if (r < P0_IU) { const int kb = r / (D / 64), rb = r % (D / 64); p0_transpose_item<false>(args.in[10], D, DA, WUT, 64 * kb, 64 * rb, 64 * rb, 64, scr, lane); return; }
    r -= P0_IU;
    if (r < P0_IU) { const int kb = r / (D / 64), rb = r % (D / 64); p0_transpose_item<false>(args.in[11], D, DB, WUT + (size_t)D * DA, 64 * kb, 64 * rb, 64 * rb, 64, scr, lane); return; }
    r -= P0_IU;
    { const int kb = r / (D / 64), rb = r % (D / 64); p0_transpose_item<false>(args.in[12], D, D, WOT, 64 * kb, 64 * rb, 64 * rb, 64, scr, lane); }
}

__global__ void __launch_bounds__(NTHREADS, 2) fwd_kernel(Args args) {
#ifndef EMU
    extern __shared__ __attribute__((aligned(16))) unsigned char lds_raw[];
    ldsp lds = (ldsp)lds_raw;
#else
    ldsp lds = emu_lds;
#endif
    const int tid = threadIdx.x, lane = tid & 63, wave = RFL(tid >> 6);
    const int G = gridDim.x, bx = blockIdx.x;
    const int vcu = (G % 8 == 0) ? (bx % 8) * (G / 8) + bx / 8 : bx;
    unsigned char* ws = args.ws;
#ifndef EMU
    for (int u = tid; u < (LDS_BYTES - LDSCTL_OFF) / 4; u += NTHREADS) ((LAS unsigned*)(lds + LDSCTL_OFF))[u] = 0u;
    __syncthreads();
    XcdBarrier bar = xcd_barrier_post((unsigned*)(ws + WS_CTL) + CW_BAR, (volatile LAS unsigned*)(lds + MISC_OFF) + 8);
#define GRID_BAR() xcd_barrier(bar)
#else
#define GRID_BAR()
#endif
    const int lo = args.ph_lo, hi = args.ph_hi;
#ifndef GEMM_SP2
#define GEMM_SP2 true
#endif
#ifndef GEMM_ALIGN
#define GEMM_ALIGN true
#endif
#ifndef PROBE_REP_P4
#define PROBE_REP_P4 1
#endif
#ifndef PROBE_REP_P5
#define PROBE_REP_P5 1
#endif
#ifndef PROBE_REP_P1
#define PROBE_REP_P1 2
#endif
#ifndef PROBE_REP_P2
#define PROBE_REP_P2 1
#endif
#ifndef PHASE_MASK
#define PHASE_MASK 255
#endif
#define IN(k) (((PHASE_MASK >> (k)) & 1) && lo <= (k) && (k) < hi)
#define BOTH(k) (IN(k) && IN((k) + 1))
    const float* x = args.in[0];
    bf16* W1T = (bf16*)(ws + WS_W1T); bf16* WUT = (bf16*)(ws + WS_WUT); bf16* WOT = (bf16*)(ws + WS_WOT);
    bf16* HBUF = (bf16*)(ws + WS_HB); bf16* PB = (bf16*)(ws + WS_P); float* SG = (float*)(ws + WS_SG); bf16* OAB = (bf16*)(ws + WS_OAB); float* RSS = (float*)(ws + WS_RSS);

    if (IN(0)) {
        ldsp scr = lds + wave * 17408;
        const int gw = vcu * NWAVES + wave, NGW = G * NWAVES;
        constexpr int I_1 = P0_I1, NITEMS = P0_NITEMS;
        static_assert(NPM % 64 == 0 && NP % 64 == 0 && NSG % 4 == 0, "P0 item tiling");
        constexpr int NJOBS3 = NB * HA + NB * HB * 2;
        const int nit0 = (G > NJOBS3) ? I_1 : NITEMS;
        for (int it = gw; it < nit0; it += NGW) p0_item(args, it, scr, lane);
        const float* gpre = args.in[1];
        for (int m = gw; m < M; m += NGW) {
            const f32x4* xr = (const f32x4*)(x + (size_t)m * D) + lane;
            f32x4 v[D / 256]; float s = 0.f;
#pragma unroll
            for (int jj = 0; jj < D / 256; ++jj) { v[jj] = xr[64 * jj]; s += (v[jj][0] * v[jj][0] + v[jj][1] * v[jj][1]) + (v[jj][2] * v[jj][2] + v[jj][3] * v[jj][3]); }
            const float rstd = frsq(wave_sum(s) * (1.0f / D) + EPS) ;
            u32x2* o8 = (u32x2*)(HBUF + (size_t)m * D) + lane; unsigned* o4 = (unsigned*)(ws + WS_H8 + (size_t)m * D) + lane;
#pragma unroll
            for (int jj = 0; jj < D / 256; ++jj) { const f32x4 gg = ((const f32x4*)gpre)[lane + 64 * jj]; const f32x4 hh = v[jj] * rstd * gg; u32x2 w; w.x = pk2(hh[0], hh[1]); w.y = pk2(hh[2], hh[3]); o8[64 * jj] = w;
                o4[64 * jj] = pk_fp8x4(clamp8(hh[0] * H8_SCALE), clamp8(hh[1] * H8_SCALE), clamp8(hh[2] * H8_SCALE), clamp8(hh[3] * H8_SCALE)); }
        }
        if (BOTH(0)) GRID_BAR();
    }

    if (IN(1)) {
        {
            const int gw = vcu * NWAVES + wave, NGW = G * NWAVES, l15 = lane & 15, q4 = lane >> 4;
            const int wrow = NP + (l15 < NSG ? l15 : NSG - 1);
            for (int t = gw; t < M / 16; t += NGW) {
                f32x4 acc = (f32x4){0.f, 0.f, 0.f, 0.f};
                const bf16* ap = HBUF + (size_t)(16 * t + l15) * D + 8 * q4; const bf16* bp = W1T + (size_t)wrow * D + 8 * q4;
#pragma unroll 8
                for (int ks = 0; ks < D / 32; ++ks) { const bf16x8 a = *(const bf16x8*)(ap + 32 * ks), bb = *(const bf16x8*)(bp + 32 * ks); acc = MFMA16(a, bb, acc); }
#pragma unroll
                for (int r = 0; r < 4; ++r) SG[(size_t)(16 * t + 4 * q4 + r) * 16 + l15] = acc[r];
            }
        }
        { pg8::Gemm g{HBUF, W1T, M, NPM, D}; pg8::StaticOrder S; S.init(M, NPM, G, bx);
          EpiP E{PB};
          pg8::gemm_phase<EpiP, pg8::StaticOrder, GEMM_ALIGN, GEMM_SP2>(lds, g, S, E); }
        { pg8::Gemm g{(const bf16*)(ws + WS_H8), (const bf16*)(ws + WS_W8), M, 2 * D, D}; pg8::StaticOrder S; S.init(M, 2 * D, G, bx);
          EpiP8 E{PB};
          pg8::gemm_phase<EpiP8, pg8::StaticOrder, GEMM_ALIGN, GEMM_SP2, 1>(lds, g, S, E); }
        if (BOTH(1)) GRID_BAR();
    }

    if (IN(2)) {
        int buf = 0;
        if (bx < NUA + NUB) p2_issue(args, bx, lds + PA_RAW, wave, lane);
        for (int u = bx, it = 0; u < NUA + NUB; u += G, ++it) {
            int tidj = tid; OPAQUE(tidj); const int lane_ = tidj & 63;
            if (it == 0) WAIT_V(0); else WAIT_V(16);
            MIX_BAR();
            if (u + G < NUA + NUB) p2_issue(args, u + G, lds + PA_RAW + (buf ^ 1) * PA_RAWSZ, wave, lane_);
            p2_unit(args, lds, u, lds + PA_RAW + buf * PA_RAWSZ, wave, lane_);
            buf ^= 1;
        }
        if (BOTH(2)) GRID_BAR();
    }

    if (IN(3)) {
        constexpr int NJA = NB * HA, NJB = NB * HB * 2;
        if (G > NJA + NJB && bx >= NJA + NJB) {
            ldsp scr = lds + wave * 17408;
            for (int it = P0_I1 + (bx - (NJA + NJB)) * NWAVES + wave; it < P0_NITEMS; it += (G - (NJA + NJB)) * NWAVES) p0_item(args, it, scr, lane);
        }
        for (int job = bx; job < NJA + NJB; job += G) {
            if (job < NJA) mixer_a_job(args, lds, job / HA, job % HA, tid);
            else { const int jb = job - NJA; mixer_b_job(args, lds, jb / (2 * HB), (jb >> 1) % HB, jb & 1, tid); }
            BLOCK_BAR();
        }
        if (BOTH(3)) GRID_BAR();
    }

    if (IN(4)) {
        const int gw = vcu * NWAVES + wave, NGW = G * NWAVES;
        const float* SSA = (const float*)(ws + WS_SSA); const float* SSB = (const float*)(ws + WS_SSB);
        static_assert(DA % 512 == 0 && DA == DB, "P3 tiling");
        for (int m = gw; m < M; m += NGW) {
#pragma unroll
            for (int br = 0; br < 2; ++br) {
#pragma unroll
                for (int i = 0; i < DA / 512; ++i) {
                    const int col0 = i * 512 + lane * 8;
                    float rstd;
                    if (br == 0) rstd = frsq(SSA[(size_t)m * HA + col0 / 128] * (1.0f / 128.0f) + EPS);
                    else { const int hh = col0 / 256; rstd = frsq((SSB[(size_t)m * (2 * HB) + 2 * hh] + SSB[(size_t)m * (2 * HB) + 2 * hh + 1]) * (1.0f / 256.0f) + EPS); }
                    u32x4* po = (u32x4*)(OAB + (size_t)(br * M + m) * DA + col0);
                    u32x4 w = *po; const u32x4 g8 = *(const u32x4*)(PB + p_off((size_t)m, (br ? C_OGB : C_OGA) + col0)), z8 = *(const u32x4*)(PB + p_off((size_t)m, (br ? C_ZB : C_ZA) + col0));
                    const f32x4 gn0 = *(const f32x4*)(args.in[br ? 9 : 8] + col0), gn1 = *(const f32x4*)(args.in[br ? 9 : 8] + col0 + 4);
#pragma unroll
                    for (int e = 0; e < 4; ++e) { float v[2];
#pragma unroll
                        for (int k = 0; k < 2; ++k) { const float ov = __builtin_bit_cast(float, k ? (w[e] & 0xffff0000u) : (w[e] << 16)), og = __builtin_bit_cast(float, k ? (g8[e] & 0xffff0000u) : (g8[e] << 16)), z = __builtin_bit_cast(float, k ? (z8[e] & 0xffff0000u) : (z8[e] << 16));
                            const float gnv = (e < 2 ? gn0 : gn1)[(2 * e + k) & 3];
                            v[k] = ov * rstd * gnv * sigm2(og) * (z * sigm2(z)); }
                        w[e] = cvt_pk_bf16(v[0], v[1]); }
                    *po = w;
                }
            }
        }
        if (BOTH(4)) GRID_BAR();
    }
    if (IN(5)) {
        pg8::Gemm g{OAB, WUT, 2 * M, 2 * D, DA}; SchedUp S; S.so.init(M, D, G, bx);
        EpiUp E{HBUF, PB};
        for (int rep = 0; rep < PROBE_REP_P4; ++rep) pg8::gemm_phase<EpiUp, SchedUp, GEMM_ALIGN, GEMM_SP2>(lds, g, S, E);
        if (BOTH(5)) GRID_BAR();
    }

    if (IN(6)) {
        pg8::Gemm g{HBUF, WOT, M, D, D}; pg8::StaticOrder S; S.init(M, D, G, bx);
        EpiOut E{PB, RSS};
        for (int rep = 0; rep < PROBE_REP_P5; ++rep) pg8::gemm_phase<EpiOut, pg8::StaticOrder, GEMM_ALIGN, GEMM_SP2>(lds, g, S, E);
        if (BOTH(6)) GRID_BAR();
    }

    if (IN(7)) {
        const int gw = vcu * NWAVES + wave, NGW = G * NWAVES;
        const float* gpost = args.in[13];
        for (int m = gw; m < M; m += NGW) {
            const float ss = wave_sum(lane < NRS ? RSS[(size_t)m * NRS + lane] : 0.f);
            const float rstd = frsq(ss * (1.0f / D) + EPS);
            const f32x4* xr = (const f32x4*)(x + (size_t)m * D) + lane; f32x4* orow = (f32x4*)(args.out + (size_t)m * D) + lane; const u32x2* ob = (const u32x2*)(PB + (size_t)m * D) + lane;
#pragma unroll
            for (int jj = 0; jj < D / 256; ++jj) { const f32x4 xv = xr[64 * jj], gg = ((const f32x4*)gpost)[lane + 64 * jj]; const u32x2 w = ob[64 * jj];
                const f32x4 ov = (f32x4){__builtin_bit_cast(float, w.x << 16), __builtin_bit_cast(float, w.x & 0xffff0000u), __builtin_bit_cast(float, w.y << 16), __builtin_bit_cast(float, w.y & 0xffff0000u)};
                orow[64 * jj] = xv + ov * rstd * gg; }
        }
    }
#undef IN
#undef BOTH
}

#ifndef EMU
extern "C" void kernel_launch(void* const* d_in, const int* in_sizes, int n_in, void* d_out, int out_size, void* d_ws, size_t ws_size, hipStream_t stream) {
    static int grid = 0;
    if (grid == 0) {
        if (n_in != 14 || out_size != M * D || ws_size < WS_END) { fprintf(stderr, "kernel_launch: unexpected shapes (n_in %d, out %d, ws %zu < %zu)\n", n_in, out_size, ws_size, (size_t)WS_END); grid = -1; return; }
        int dev = 0, cus = 0, per_cu = 0;
        if (hipGetDevice(&dev) != hipSuccess || hipDeviceGetAttribute(&cus, hipDeviceAttributeMultiprocessorCount, dev) != hipSuccess) { grid = -1; return; }
        if (hipFuncSetAttribute((const void*)fwd_kernel, hipFuncAttributeMaxDynamicSharedMemorySize, LDS_BYTES) != hipSuccess) { fprintf(stderr, "kernel_launch: hipFuncSetAttribute failed\n"); grid = -1; return; }
        if (hipOccupancyMaxActiveBlocksPerMultiprocessor(&per_cu, (const void*)fwd_kernel, NTHREADS, LDS_BYTES) != hipSuccess || per_cu < 1) { fprintf(stderr, "kernel_launch: occupancy query says %d\n", per_cu); }
        (void)hipGetLastError();
        grid = cus;
    }
    if (grid < 0) return;
    (void)hipMemsetAsync((char*)d_ws + WS_CTL, 0, CTL_ZERO_BYTES, stream);
    Args a{};
    for (int i = 0; i < 14; ++i) a.in[i] = (const float*)d_in[i];
    a.out = (float*)d_out; a.ws = (unsigned char*)d_ws; a.ph_lo = 0; a.ph_hi = 8;
    hipLaunchKernelGGL(fwd_kernel, dim3(grid), dim3(NTHREADS), LDS_BYTES, stream, a);
}
#endif
```

```cpp
typedef unsigned u32x2_t __attribute__((ext_vector_type(2)));
typedef int v8i_t __attribute__((ext_vector_type(8)));
typedef int v4i_t __attribute__((ext_vector_type(4)));
#ifndef EMU
#include <hip/hip_runtime.h>
#include <cstdio>
#include <cstdint>
#define LAS __attribute__((address_space(3)))
#define GAS __attribute__((address_space(1)))
typedef short bf16x8 __attribute__((ext_vector_type(8)));
typedef short bf16x4 __attribute__((ext_vector_type(4)));
typedef float f32x4 __attribute__((ext_vector_type(4)));
#define DEV __device__ __forceinline__
#define LDS_RD(T, p) (*(const LAS T*)(p))
#define LDS_WR(T, p, v) (*(LAS T*)(p) = (v))
#define WAVE_SYNC() asm volatile("s_waitcnt lgkmcnt(0)" ::: "memory")
#define BLOCK_BAR() __syncthreads()
#define RAW_BAR() __builtin_amdgcn_s_barrier()
#define WAIT_V(n) asm volatile("s_waitcnt vmcnt(" #n ")" ::: "memory")
#define WAIT_L(n) asm volatile("s_waitcnt lgkmcnt(" #n ")" ::: "memory")
#define SCHED_BAR() __builtin_amdgcn_sched_barrier(0)
#define SETPRIO(n) __builtin_amdgcn_s_setprio(n)
#define GLDS16(g, l) __builtin_amdgcn_global_load_lds((const unsigned*)(g), (LAS unsigned*)(l), 16, 0, 0)
#define MFMA16(a, b, c) __builtin_amdgcn_mfma_f32_16x16x32_bf16(a, b, c, 0, 0, 0)
#define RFL(x) __builtin_amdgcn_readfirstlane(x)
#define COMPILER_FENCE() asm volatile("" ::: "memory")
#define OPAQUE(x) asm volatile("" : "+v"(x))
DEV float fexp2(float x) { return __builtin_amdgcn_exp2f(x); }
DEV float flog2(float x) { return __builtin_amdgcn_logf(x); }
DEV float frcp(float x) { return __builtin_amdgcn_rcpf(x); }
DEV float frsq(float x) { return __builtin_amdgcn_rsqf(x); }
DEV unsigned cvt_pk_bf16(float lo, float hi) { unsigned r; asm volatile("v_cvt_pk_bf16_f32 %0, %1, %2" : "=v"(r) : "v"(lo), "v"(hi)); return r; }
DEV f32x4 mfma8(v8i_t a, v8i_t b, f32x4 c, int sc) { asm volatile("v_mfma_scale_f32_16x16x128_f8f6f4 %0, %1, %2, %0, %3, %3 op_sel_hi:[0,0,0]" : "+v"(c) : "v"(a), "v"(b), "v"(sc)); return c; }
#define MFMA_DRAIN() asm volatile("s_nop 15\n\ts_nop 7" ::: "memory")
DEV unsigned pk_fp8x4(float a, float b, float c, float d) { int r = __builtin_amdgcn_cvt_pk_fp8_f32(a, b, 0, false); r = __builtin_amdgcn_cvt_pk_fp8_f32(c, d, r, true); return (unsigned)r; }
typedef short v4i16_t __attribute__((ext_vector_type(4)));
DEV bf16x4 lds_tr16(LAS unsigned char* p) { return __builtin_bit_cast(bf16x4, __builtin_amdgcn_ds_read_tr16_b64_v4i16((LAS v4i16_t*)p)); }
#define MIX_BAR() do { asm volatile("s_waitcnt lgkmcnt(0)" ::: "memory"); __builtin_amdgcn_s_barrier(); asm volatile("" ::: "memory"); } while (0)
DEV void glds16_asm(const void* gsrc, unsigned lds_dst) { unsigned keep;
    asm volatile("s_mov_b32 %0, m0\n\ts_mov_b32 m0, %2\n\ts_nop 0\n\tglobal_load_lds_dwordx4 %1, off\n\ts_mov_b32 m0, %0" : "=&s"(keep) : "v"(gsrc), "s"(lds_dst) : "memory"); }
#define GLDS16X(g, l) glds16_asm((const void*)(g), (unsigned)RFL((int)(unsigned)(__UINTPTR_TYPE__)(l)))
DEV void glds16_sbase(const void* sbase, unsigned voff, unsigned lds_dst) { unsigned keep;
    asm volatile("s_mov_b32 %0, m0\n\ts_mov_b32 m0, %3\n\ts_nop 0\n\tglobal_load_lds_dwordx4 %1, %2\n\ts_mov_b32 m0, %0" : "=&s"(keep) : "v"(voff), "s"(sbase), "s"(lds_dst) : "memory"); }
#define GLDS16S(sb, vo, l) glds16_sbase((const void*)(sb), (unsigned)(vo), (unsigned)RFL((int)(unsigned)(__UINTPTR_TYPE__)(l)))
typedef __amdgpu_buffer_rsrc_t rsrc_t;
DEV rsrc_t make_rsrc(const void* p, unsigned bytes) { return __builtin_amdgcn_make_buffer_rsrc((void*)p, (short)0, (int)bytes, 0x00020000); }
DEV unsigned short bload16(rsrc_t r, unsigned voff, unsigned soff) { return (unsigned short)__builtin_amdgcn_raw_buffer_load_b16(r, (int)voff, (int)soff, 0); }
DEV void bstore16(rsrc_t r, unsigned voff, unsigned soff, unsigned short v) { __builtin_amdgcn_raw_buffer_store_b16(v, r, (int)voff, (int)soff, 0); }
DEV void bstore64(rsrc_t r, unsigned voff, unsigned soff, u32x2_t v) { __builtin_amdgcn_raw_buffer_store_b64(v, r, (int)voff, (int)soff, 0); }
#else
#define LAS
#define GAS
#define DEV inline
#define LDS_RD(T, p) emu_lds_rd<T>((const void*)(p), #p)
#define LDS_WR(T, p, v) emu_lds_wr<T>((void*)(p), (T)(v), #p)
#define WAVE_SYNC() emu_wavesync()
#define BLOCK_BAR() emu_syncthreads()
#define RAW_BAR() emu_syncthreads()
#define WAIT_V(n)
#define WAIT_L(n)
#define SCHED_BAR()
#define SETPRIO(n)
#define GLDS16(g, l) emu_glds16((const void*)(g), (unsigned char*)(l))
#define GLDS16X(g, l) emu_glds16((const void*)(g), (unsigned char*)(l))
#define GLDS16S(sb, vo, l) emu_glds16((const void*)((const char*)(sb) + (vo)), (unsigned char*)(l))
#define MFMA16(a, b, c) emu_mfma16(a, b, c)
#define RFL(x) (x)
#define COMPILER_FENCE()
#define OPAQUE(x)
DEV float fexp2(float x) { return exp2f(x); }
DEV float flog2(float x) { return log2f(x); }
DEV float frcp(float x) { return 1.0f / x; }
DEV float frsq(float x) { return 1.0f / sqrtf(x); }
DEV unsigned cvt_pk_bf16(float lo, float hi) { return (unsigned)emu_f2bf(lo) | ((unsigned)emu_f2bf(hi) << 16); }
#define mfma8(a, b, c, sc) emu_mfma8(a, b, c)
#define MFMA_DRAIN()
DEV unsigned pk_fp8x4(float a, float b, float c, float d) { return (unsigned)emu_f2fp8(a) | ((unsigned)emu_f2fp8(b) << 8) | ((unsigned)emu_f2fp8(c) << 16) | ((unsigned)emu_f2fp8(d) << 24); }
#define lds_tr16(p) emu_lds_tr16((const unsigned char*)(p))
#define MIX_BAR() emu_syncthreads()
typedef unsigned char* rsrc_t;
DEV rsrc_t make_rsrc(const void* p, unsigned) { return (unsigned char*)p; }
DEV unsigned short bload16(rsrc_t r, unsigned voff, unsigned soff) { unsigned short v; memcpy(&v, r + (size_t)voff + soff, 2); return v; }
DEV void bstore16(rsrc_t r, unsigned voff, unsigned soff, unsigned short v) { memcpy(r + (size_t)voff + soff, &v, 2); }
DEV void bstore64(rsrc_t r, unsigned voff, unsigned soff, u32x2_t v) { memcpy(r + (size_t)voff + soff, &v, 8); }
#endif

typedef unsigned short bf16;
typedef unsigned u32x4 __attribute__((ext_vector_type(4)));
typedef unsigned u32x2 __attribute__((ext_vector_type(2)));
typedef float f32x2 __attribute__((ext_vector_type(2)));
typedef LAS unsigned char* ldsp;

#ifndef CFG_D
#define CFG_D 4096
#define CFG_B 4
#define CFG_S 4096
#define CFG_HB 8
#endif
constexpr int D = CFG_D, NB = CFG_B, SEQ = CFG_S, M = NB * SEQ;
constexpr int DA = D / 2, HA = DA / 128, DB = D / 2, HB = CFG_HB, DVB = DB / HB, DKB = 128, DQK = HB * DKB;
constexpr int NSG = 2 * HB;
constexpr int NCH = SEQ / 64;
static_assert(DVB == 256 && NSG <= 16 && SEQ % 64 == 0 && M % 256 == 0 && D % 256 == 0, "shape");
constexpr int C_QA = 0, C_FA = DA, C_IA = 2 * DA, C_OGA = 3 * DA, C_ZA = 4 * DA, C_QB = 5 * DA, C_KB = C_QB + DQK, C_VB = C_KB + DQK, C_OGB = C_VB + DB, C_ZB = C_OGB + DB;
constexpr int NPM = C_ZB + DB, C_GA = NPM, C_GB = NPM + D, NP = NPM + 2 * D, D_IN = NP + NSG;
static_assert(NPM % 256 == 0 && NP % 256 == 0, "column map");
constexpr float EPS = 1e-6f;
constexpr float H8_SCALE = 64.0f, W8_SCALE = 1024.0f, G8_DESCALE = 1.0f / (64.0f * 1024.0f);
constexpr float LOG2E = 1.4426950408889634f, LN2 = 0.6931471805599453f;
constexpr int NRS = D / 64;
constexpr int PT_PITCH = M / 64 + 1;
DEV size_t p_off(size_t row, int col) { return ((size_t)(col >> 7) * (size_t)PT_PITCH + (row >> 6)) * 8192 + (row & 63) * 128 + (size_t)(col & 127); }

constexpr size_t al256(size_t x) { return (x + 255) & ~(size_t)255; }
constexpr size_t WS_CTL = 0, CTL_ZERO_BYTES = 65536;
constexpr size_t WS_W1T = 1u << 20;
constexpr size_t WS_WUT = al256(WS_W1T + (size_t)(NP + 16) * D * 2);
constexpr size_t WS_WOT = al256(WS_WUT + (size_t)2 * D * DA * 2);
constexpr size_t WS_HB = al256(WS_WOT + (size_t)D * D * 2);
constexpr size_t WS_P = al256(WS_HB + (size_t)M * D * 2);
constexpr size_t WS_SG = al256(WS_P + (size_t)(NP / 128) * (M / 64 + 1) * 16384 + 4096);
constexpr size_t WS_OAB = al256(WS_SG + (size_t)M * 16 * 4);
constexpr size_t WS_RSS = al256(WS_OAB + (size_t)2 * M * DA * 2);
constexpr size_t WS_SSB = al256(WS_RSS + (size_t)M * NRS * 4);
constexpr size_t WS_SSA = al256(WS_SSB + (size_t)M * HB * 2 * 4);
constexpr size_t WS_H8 = al256(WS_SSA + (size_t)M * HA * 4);
constexpr size_t WS_W8 = al256(WS_H8 + (size_t)M * D);
constexpr size_t WS_END = al256(WS_W8 + (size_t)2 * D * D);
constexpr int CW_BAR = 1024;

constexpr int RING_BYTES = 154624, LDSCTL_OFF = RING_BYTES, MISC_OFF = LDSCTL_OFF + 320, LDS_BYTES = 155648;
constexpr int NWAVES = 8, NTHREADS = 512;

DEV unsigned f2bf(float f) { unsigned u = __builtin_bit_cast(unsigned, f); return (u + 0x7fffu + ((u >> 16) & 1u)) >> 16; }
DEV float bf2f(unsigned b) { return __builtin_bit_cast(float, b << 16); }
DEV unsigned pk2(float lo, float hi) { return f2bf(lo) | (f2bf(hi) << 16); }
DEV float fexp(float x) { return fexp2(x * LOG2E); }
DEV float flog(float x) { return flog2(x) * LN2; }
DEV float sigm(float x) { return frcp(1.0f + fexp(-x)); }
DEV float logsig(float x) { return fminf(x, 0.f) - flog(1.0f + fexp(-fabsf(x))); }
DEV float wave_sum(float v) {
#pragma unroll
    for (int o = 1; o < 64; o <<= 1) v += __shfl_xor(v, o);
    return v;
}

namespace pg8 {
constexpr int BM = 256, BK = 64, HALF = 128, HTB = HALF * BK * 2, STAGE_BYTES = 8 * HTB, NXCD = 8, WGM = 8;
DEV int lds_byte(int r, int c) { const int st = (r >> 4) * 2 + (c >> 5), rr = r & 15, cc = c & 31, ob = rr * 64 + cc * 2; return st * 1024 + (ob ^ (((ob >> 9) & 1) << 5)); }
DEV void stage_rc(int b, int& R, int& C) { const int st = b / 1024, sb = b % 1024, swz = sb ^ (((sb >> 9) & 1) << 5); R = (st >> 1) * 16 + swz / 64; C = (st & 1) * 32 + (swz % 64) / 2; }
DEV int perm32(int rho) { const int n = rho >> 4, i = rho & 15; return 8 * (i >> 2) + 4 * n + (i & 3); }
struct Unit { int pm, pn; };
struct Gemm { const bf16* A; const bf16* Bt; int M, N, K; };
struct StaticOrder {
    int nM, nN, nwg, G, c;
    DEV void init(int M_, int N_, int G_, int c_) { nM = M_ / BM; nN = N_ / BM; nwg = nM * nN; G = G_; c = c_; }
    DEV bool next(int i, Unit& u) const {
        const long L = (long)i * G + c; if (L >= nwg) return false;
        int wgid = (int)L; { const int q = nwg / NXCD, r = nwg % NXCD, xcd = wgid % NXCD, off = wgid / NXCD; wgid = (xcd < r ? xcd * (q + 1) : r * (q + 1) + (xcd - r) * q) + off; }
        const int nig = WGM * nN, gid = wgid / nig, fm = gid * WGM, gsz = (nM - fm) < WGM ? (nM - fm) : WGM;
        u.pm = fm + ((wgid % nig) % gsz); u.pn = (wgid % nig) / gsz; return true;
    }
};
template <class Epi, class Sched, bool ALIGN_EPI = false, bool SP2 = false, int ESZ = 2>
DEV void gemm_phase(ldsp lds, const Gemm g, const Sched& S, const Epi& E) {
    const int tid = threadIdx.x, wid = RFL(tid >> 6), lane = tid & 63, wr = wid >> 2, wc = wid & 3, fr = lane & 15, fq = lane >> 4;
    const int K = g.K * ESZ / 2, nt = K / BK;
    unsigned voffA[2], voffB[2];
#pragma unroll
    for (int i = 0; i < 2; ++i) { int R, C; stage_rc(tid * 16 + i * 8192, R, C); const int Rb = Epi::PERM ? ((R & ~31) + perm32(R & 31)) : R;
        voffA[i] = (unsigned)(R * K + C) * 2u; voffB[i] = (unsigned)(Rb * K + C) * 2u; }
    const size_t kstep = (size_t)(BK * 2);
    const size_t hstep = (size_t)HALF * K * 2;
    const size_t tstep = 2 * hstep;
    const unsigned ldsw = (unsigned)wid * 1024u;
    int aoffk[2], boffk[2];
#pragma unroll
    for (int k = 0; k < 2; ++k) { const int ch = ESZ == 2 ? fq + 4 * k : 2 * fq + k;
        aoffk[k] = lds_byte(wr * 64 + fr, (ch & 3) * 8) + (ch >> 2) * 1024; boffk[k] = lds_byte(wc * 32 + fr, (ch & 3) * 8) + (ch >> 2) * 1024; }
#define PG8_SA(b, h) (((b) * 2 + (h)) * HTB)
#define PG8_SB(b, h) ((4 + (b) * 2 + (h)) * HTB)
#define PG8_STAGE(bufoff, gbase, voff) do { _Pragma("unroll") for (int _i = 0; _i < 2; ++_i) \
        GLDS16((const char*)(gbase) + (voff)[_i], lds + (bufoff) + ldsw + _i * 8192); } while (0)
#define PG8_LDA(dst, b, h) do { _Pragma("unroll") for (int m = 0; m < 4; ++m) { if constexpr (ESZ == 2) { _Pragma("unroll") for (int k = 0; k < 2; ++k) dst[m][k] = *(const LAS bf16x8*)(lds + PG8_SA(b, h) + aoffk[k] + m * 2048); } \
        else dst##8[m] = __builtin_shufflevector(*(const LAS v4i_t*)(lds + PG8_SA(b, h) + aoffk[0] + m * 2048), *(const LAS v4i_t*)(lds + PG8_SA(b, h) + aoffk[1] + m * 2048), 0, 1, 2, 3, 4, 5, 6, 7); } } while (0)
#define PG8_LDB(dst, b, h) do { _Pragma("unroll") for (int n = 0; n < 2; ++n) { if constexpr (ESZ == 2) { _Pragma("unroll") for (int k = 0; k < 2; ++k) dst[n][k] = *(const LAS bf16x8*)(lds + PG8_SB(b, h) + boffk[k] + n * 2048); } \
        else dst##8[n] = __builtin_shufflevector(*(const LAS v4i_t*)(lds + PG8_SB(b, h) + boffk[0] + n * 2048), *(const LAS v4i_t*)(lds + PG8_SB(b, h) + boffk[1] + n * 2048), 0, 1, 2, 3, 4, 5, 6, 7); } } while (0)
#define PG8_MMA(ai, bj, At, Bt) do { SETPRIO(1); _Pragma("unroll") for (int m = 0; m < 4; ++m) _Pragma("unroll") for (int n = 0; n < 2; ++n) { \
        if constexpr (ESZ == 2) { _Pragma("unroll") for (int k = 0; k < 2; ++k) acc[ai][bj][m][n] = MFMA16(Bt[n][k], At[m][k], acc[ai][bj][m][n]); } \
        else acc[ai][bj][m][n] = mfma8(Bt##8[n], At##8[m], acc[ai][bj][m][n], sc8); } SETPRIO(0); } while (0)
    int sc8 = 0x7f7f7f7f; OPAQUE(sc8);
    Unit cur, nxt; int ui = 0;
    if (!S.next(0, cur)) return;
    f32x4 acc[2][2][4][2];
#pragma unroll
    for (int a = 0; a < 2; ++a)
#pragma unroll
        for (int b = 0; b < 2; ++b)
#pragma unroll
            for (int m = 0; m < 4; ++m)
#pragma unroll
                for (int n = 0; n < 2; ++n) acc[a][b][m][n] = (f32x4){0.f, 0.f, 0.f, 0.f};
    bf16x8 At[ESZ == 2 ? 4 : 1][2], B0[ESZ == 2 ? 2 : 1][2], B1[ESZ == 2 ? 2 : 1][2];
    v8i_t At8[ESZ == 1 ? 4 : 1], B08[ESZ == 1 ? 2 : 1], B18[ESZ == 1 ? 2 : 1];
    const char* cA = (const char*)g.A + (size_t)cur.pm * tstep; const char* cB = (const char*)g.Bt + (size_t)cur.pn * tstep;
    if constexpr (SP2) {
        PG8_STAGE(PG8_SB(0, 0), cB, voffB); PG8_STAGE(PG8_SB(0, 1), cB + hstep, voffB); PG8_STAGE(PG8_SA(0, 0), cA, voffA); PG8_STAGE(PG8_SA(0, 1), cA + hstep, voffA);
        if (wr == 1) RAW_BAR();
        WAIT_V(2); RAW_BAR();
        PG8_STAGE(PG8_SB(1, 0), cB + kstep, voffB); PG8_STAGE(PG8_SA(1, 0), cA + kstep, voffA); PG8_STAGE(PG8_SB(1, 1), cB + hstep + kstep, voffB);
        WAIT_V(6); RAW_BAR();
    } else {
        PG8_STAGE(PG8_SB(0, 0), cB, voffB); PG8_STAGE(PG8_SA(0, 0), cA, voffA); PG8_STAGE(PG8_SB(0, 1), cB + hstep, voffB); PG8_STAGE(PG8_SA(0, 1), cA + hstep, voffA);
        if (wr == 1) RAW_BAR();
        WAIT_V(4); RAW_BAR();
        PG8_STAGE(PG8_SB(1, 0), cB + kstep, voffB); PG8_STAGE(PG8_SA(1, 0), cA + kstep, voffA); PG8_STAGE(PG8_SB(1, 1), cB + hstep + kstep, voffB);
        WAIT_V(6); RAW_BAR();
    }
    for (;;) {
        const bool has_next = S.next(ui + 1, nxt);
        const char* nA = has_next ? (const char*)g.A + (size_t)nxt.pm * tstep : cA; const char* nB = has_next ? (const char*)g.Bt + (size_t)nxt.pn * tstep : cB;
        for (int t = 0; t < nt; t += 2) {
            const bool last = (t == nt - 2);
            const char* a1 = cA + (size_t)(t + 1) * kstep;
            const char* a2 = last ? nA : cA + (size_t)(t + 2) * kstep; const char* b2 = last ? nB : cB + (size_t)(t + 2) * kstep;
            const char* a3 = a2 + kstep; const char* b3 = b2 + kstep;
            if constexpr (SP2) {
            PG8_LDB(B0, 0, 0); PG8_LDB(B1, 0, 1); SCHED_BAR(); PG8_LDA(At, 0, 0); PG8_STAGE(PG8_SA(1, 1), a1 + hstep, voffA);
            WAIT_V(8); WAIT_L(0); RAW_BAR(); PG8_MMA(0, 0, At, B0); PG8_MMA(0, 1, At, B1); RAW_BAR(); SCHED_BAR();
            PG8_LDA(At, 0, 1); PG8_STAGE(PG8_SB(0, 0), b2, voffB); PG8_STAGE(PG8_SB(0, 1), b2 + hstep, voffB); PG8_STAGE(PG8_SA(0, 0), a2, voffA);
            WAIT_V(8); WAIT_L(0); RAW_BAR(); PG8_MMA(1, 0, At, B0); PG8_MMA(1, 1, At, B1); RAW_BAR(); SCHED_BAR();
            PG8_LDB(B0, 1, 0); PG8_LDB(B1, 1, 1); SCHED_BAR(); PG8_LDA(At, 1, 0); PG8_STAGE(PG8_SA(0, 1), a2 + hstep, voffA);
            WAIT_V(8); WAIT_L(0); RAW_BAR(); PG8_MMA(0, 0, At, B0); PG8_MMA(0, 1, At, B1); RAW_BAR(); SCHED_BAR();
            PG8_LDA(At, 1, 1); PG8_STAGE(PG8_SB(1, 0), b3, voffB); PG8_STAGE(PG8_SB(1, 1), b3 + hstep, voffB); PG8_STAGE(PG8_SA(1, 0), a3, voffA);
            WAIT_V(8); WAIT_L(0); RAW_BAR(); PG8_MMA(1, 0, At, B0); PG8_MMA(1, 1, At, B1); RAW_BAR(); SCHED_BAR();
            } else {
            PG8_LDB(B0, 0, 0); SCHED_BAR(); PG8_LDA(At, 0, 0); PG8_STAGE(PG8_SA(1, 1), a1 + hstep, voffA);
            WAIT_L(8); RAW_BAR(); WAIT_L(0); PG8_MMA(0, 0, At, B0); RAW_BAR(); SCHED_BAR();
            PG8_LDB(B1, 0, 1); PG8_STAGE(PG8_SB(0, 0), b2, voffB);
            RAW_BAR(); WAIT_L(0); PG8_MMA(0, 1, At, B1); RAW_BAR();
            PG8_LDA(At, 0, 1); PG8_STAGE(PG8_SA(0, 0), a2, voffA);
            RAW_BAR(); WAIT_L(0); PG8_MMA(1, 0, At, B0); RAW_BAR(); SCHED_BAR();
            PG8_STAGE(PG8_SB(0, 1), b2 + hstep, voffB);
            WAIT_V(6); RAW_BAR(); PG8_MMA(1, 1, At, B1); RAW_BAR();
            PG8_LDB(B0, 1, 0); SCHED_BAR(); PG8_LDA(At, 1, 0); PG8_STAGE(PG8_SA(0, 1), a2 + hstep, voffA);
            WAIT_L(8); RAW_BAR(); WAIT_L(0); PG8_MMA(0, 0, At, B0); RAW_BAR(); SCHED_BAR();
            PG8_LDB(B1, 1, 1); PG8_STAGE(PG8_SB(1, 0), b3, voffB);
            RAW_BAR(); WAIT_L(0); PG8_MMA(0, 1, At, B1); RAW_BAR();
            PG8_LDA(At, 1, 1); PG8_STAGE(PG8_SA(1, 0), a3, voffA);
            RAW_BAR(); WAIT_L(0); PG8_MMA(1, 0, At, B0); RAW_BAR(); SCHED_BAR();
            PG8_STAGE(PG8_SB(1, 1), b3 + hstep, voffB);
            WAIT_V(6); RAW_BAR(); PG8_MMA(1, 1, At, B1); RAW_BAR();
            }
        }
        if constexpr (ALIGN_EPI) { if (wr == 0) RAW_BAR(); }
        if constexpr (ESZ == 1) { MFMA_DRAIN();
#pragma unroll
            for (int a = 0; a < 2; ++a)
#pragma unroll
                for (int b = 0; b < 2; ++b) asm volatile("" : "+v"(acc[a][b][0][0]), "+v"(acc[a][b][0][1]), "+v"(acc[a][b][1][0]), "+v"(acc[a][b][1][1]), "+v"(acc[a][b][2][0]), "+v"(acc[a][b][2][1]), "+v"(acc[a][b][3][0]), "+v"(acc[a][b][3][1])); }
        E(acc, cur, wr, wc, fr, fq);
        if (!has_next) break;
#pragma unroll
        for (int a = 0; a < 2; ++a)
#pragma unroll
            for (int b = 0; b < 2; ++b)
#pragma unroll
                for (int m = 0; m < 4; ++m)
#pragma unroll
                    for (int n = 0; n < 2; ++n) acc[a][b][m][n] = (f32x4){0.f, 0.f, 0.f, 0.f};
        cur = nxt; cA = nA; cB = nB; ++ui;
        if constexpr (ALIGN_EPI) { if (wr == 1) RAW_BAR(); }
    }
    WAIT_V(0);
    if constexpr (!ALIGN_EPI) { if (wr == 0) RAW_BAR(); }
    RAW_BAR();
#undef PG8_SA
#undef PG8_SB
#undef PG8_STAGE
#undef PG8_LDA
#undef PG8_LDB
#undef PG8_MMA
}
}

struct EpiP {
    static constexpr bool PERM = true;
    bf16* O;
    DEV void operator()(const f32x4 (&acc)[2][2][4][2], const pg8::Unit& u, int wr, int wc, int fr, int fq) const {
        const int row0 = u.pm * 256 + wr * 64 + fr, col0 = u.pn * 256 + wc * 32 + 8 * fq;
#pragma unroll
        for (int ai = 0; ai < 2; ++ai)
#pragma unroll
            for (int m = 0; m < 4; ++m) { const size_t row = (size_t)(row0 + ai * 128 + m * 16);
#pragma unroll
                for (int bj = 0; bj < 2; ++bj) { const f32x4 v0 = acc[ai][bj][m][0], v1 = acc[ai][bj][m][1];
                    u32x4 w; w.x = cvt_pk_bf16(v0[0], v0[1]); w.y = cvt_pk_bf16(v0[2], v0[3]); w.z = cvt_pk_bf16(v1[0], v1[1]); w.w = cvt_pk_bf16(v1[2], v1[3]);
                    *(u32x4*)(O + p_off(row, col0 + bj * 128)) = w; } }
    }
};
struct EpiP8 {
    static constexpr bool PERM = true;
    bf16* O;
    DEV void operator()(const f32x4 (&acc)[2][2][4][2], const pg8::Unit& u, int wr, int wc, int fr, int fq) const {
        const int row0 = u.pm * 256 + wr * 64 + fr, col0 = NPM + u.pn * 256 + wc * 32 + 8 * fq;
#pragma unroll
        for (int ai = 0; ai < 2; ++ai)
#pragma unroll
            for (int m = 0; m < 4; ++m) { const size_t row = (size_t)(row0 + ai * 128 + m * 16);
#pragma unroll
                for (int bj = 0; bj < 2; ++bj) { const f32x4 v0 = acc[ai][bj][m][0] * G8_DESCALE, v1 = acc[ai][bj][m][1] * G8_DESCALE;
                    u32x4 w; w.x = cvt_pk_bf16(v0[0], v0[1]); w.y = cvt_pk_bf16(v0[2], v0[3]); w.z = cvt_pk_bf16(v1[0], v1[1]); w.w = cvt_pk_bf16(v1[2], v1[3]);
                    *(u32x4*)(O + p_off(row, col0 + bj * 128)) = w; } }
    }
};
struct SchedUp {
    pg8::StaticOrder so;
    DEV bool next(int i, pg8::Unit& u) const { if (!so.next(i >> 1, u)) return false; if (i & 1) { u.pm += M / 256; u.pn += D / 256; } return true; }
};
struct EpiUp {
    static constexpr bool PERM = true;
    bf16* Y; const bf16* P;
    DEV void operator()(const f32x4 (&acc)[2][2][4][2], const pg8::Unit& u, int wr, int wc, int fr, int fq) const {
        const int br = u.pm >= M / 256 ? 1 : 0, pm = u.pm - br * (M / 256), pn = u.pn - br * (D / 256);
        const int row0 = pm * 256 + wr * 64 + fr, col0 = pn * 256 + wc * 32 + 8 * fq, gcol = (br ? C_GB : C_GA) + col0;
#pragma unroll
        for (int ai = 0; ai < 2; ++ai)
#pragma unroll
            for (int m = 0; m < 4; ++m) { const size_t row = (size_t)(row0 + ai * 128 + m * 16);
#pragma unroll
                for (int bj = 0; bj < 2; ++bj) {
                    const u32x4 g8 = *(const u32x4*)(P + p_off(row, gcol + bj * 128));
                    bf16* yp = Y + row * D + col0 + bj * 128;
                    u32x4 y8 = (u32x4){0u, 0u, 0u, 0u}; if (br) y8 = *(const u32x4*)yp;
                    const f32x4 v0 = acc[ai][bj][m][0], v1 = acc[ai][bj][m][1];
                    float o[8];
#pragma unroll
                    for (int k = 0; k < 8; ++k) { const unsigned gw = g8[k >> 1], yw = y8[k >> 1]; const float gv = bf2f((k & 1) ? (gw >> 16) : (gw & 0xffffu)), yv = bf2f((k & 1) ? (yw >> 16) : (yw & 0xffffu));
                        const float a = k < 4 ? v0[k & 3] : v1[k & 3]; o[k] = yv + sigm(gv) * a; }
                    u32x4 w; w.x = cvt_pk_bf16(o[0], o[1]); w.y = cvt_pk_bf16(o[2], o[3]); w.z = cvt_pk_bf16(o[4], o[5]); w.w = cvt_pk_bf16(o[6], o[7]);
                    *(u32x4*)yp = w; } }
    }
};
struct EpiOut {
    static constexpr bool PERM = true;
    bf16* C; float* RSS;
    DEV void operator()(const f32x4 (&acc)[2][2][4][2], const pg8::Unit& u, int wr, int wc, int fr, int fq) const {
        const int row0 = u.pm * 256 + wr * 64 + fr, col0 = u.pn * 256 + wc * 32 + 8 * fq;
#pragma unroll
        for (int ai = 0; ai < 2; ++ai)
#pragma unroll
            for (int m = 0; m < 4; ++m) { const size_t row = (size_t)(row0 + ai * 128 + m * 16); bf16* rowp = C + row * D + col0; float ss = 0.f;
#pragma unroll
                for (int bj = 0; bj < 2; ++bj) { const f32x4 v0 = acc[ai][bj][m][0], v1 = acc[ai][bj][m][1];
                    ss += ((v0[0] * v0[0] + v0[1] * v0[1]) + (v0[2] * v0[2] + v0[3] * v0[3])) + ((v1[0] * v1[0] + v1[1] * v1[1]) + (v1[2] * v1[2] + v1[3] * v1[3]));
                    u32x4 w; w.x = cvt_pk_bf16(v0[0], v0[1]); w.y = cvt_pk_bf16(v0[2], v0[3]); w.z = cvt_pk_bf16(v1[0], v1[1]); w.w = cvt_pk_bf16(v1[2], v1[3]);
                    *(u32x4*)(rowp + bj * 128) = w; }
                ss += __shfl_xor(ss, 16); ss += __shfl_xor(ss, 32);
                if (fq == 0) RSS[row * NRS + u.pn * 4 + wc] = ss; }
    }
};

#ifndef EMU
typedef GAS unsigned gu32;
#define RLX_AGENT __ATOMIC_RELAXED, __HIP_MEMORY_SCOPE_AGENT
#define XB_TMO      128
#define XB_XCNT(j)  (256  + 64 * (j))
#define XB_XSUB(j)  (1280 + 64 * (j))
#define XB_XGEN(j)  (2304 + 64 * (j))
#define XB_TOP      3328
#define XB_TOPGEN   3392
#define XCD_BAR_WORDS 3456
#define XB_SPIN_CAP (1u << 22)
__device__ __forceinline__ unsigned xb_ld(unsigned* p)              { return __hip_atomic_load(p, __ATOMIC_RELAXED, __HIP_MEMORY_SCOPE_AGENT); }
__device__ __forceinline__ unsigned xb_add(unsigned* p, unsigned v) { return __hip_atomic_fetch_add(p, v, __ATOMIC_RELAXED, __HIP_MEMORY_SCOPE_AGENT); }
__device__ __forceinline__ unsigned xb_xcc_id() { return (unsigned)__builtin_amdgcn_s_getreg((3 << 11) | 20) & 0xFu; }
#define XB_SPIN(cond, bar) do { unsigned _sp = 0; while (cond) { __builtin_amdgcn_s_sleep(1); \
    if ((++_sp & 255u) == 0u) { if (xb_ld(&(bar)[XB_TMO])) break; if (_sp > XB_SPIN_CAP) { atomicAdd(&(bar)[XB_TMO], 1u); break; } } } } while (0)
struct XcdBarrier { unsigned* bar; unsigned x; volatile LAS unsigned* st; };
__device__ __forceinline__ XcdBarrier xcd_barrier_post(unsigned* bar, volatile LAS unsigned* st) {
    XcdBarrier b; b.bar = bar; b.x = xb_xcc_id(); b.st = st;
    if (threadIdx.x == 0) (void)xb_add(&bar[XB_XCNT(b.x)], 1u);
    return b;
}
__device__ __forceinline__ void xcd_barrier_complete(unsigned* bar, unsigned x, unsigned& nloc, unsigned& nx) {
    const unsigned G = gridDim.x * gridDim.y * gridDim.z;
    unsigned sum, cnt, mine, sp = 0u;
    for (;;) {
        sum = 0u; cnt = 0u; mine = 0u;
#pragma unroll
        for (unsigned j = 0; j < 16; ++j) { const unsigned c = xb_ld(&bar[XB_XCNT(j)]); sum += c; cnt += (c > 0u) ? 1u : 0u; mine = (j == x) ? c : mine; }
        if (sum == G) break;
        __builtin_amdgcn_s_sleep(1);
        if ((++sp & 255u) == 0u) { if (xb_ld(&bar[XB_TMO])) break; if (sp > XB_SPIN_CAP) { atomicAdd(&bar[XB_TMO], 1u); break; } }
    }
    nloc = mine > 0u ? mine : 1u; nx = cnt > 0u ? cnt : 1u;
}
__device__ __forceinline__ void xcd_barrier(const XcdBarrier& b) {
    asm volatile("s_waitcnt vmcnt(0)" ::: "memory");
    __syncthreads();
    if (threadIdx.x == 0) {
        unsigned* bar = b.bar;
        __builtin_amdgcn_s_waitcnt(0);
        unsigned nloc = b.st[0], nx = b.st[1];
        if (nloc == 0u) { xcd_barrier_complete(bar, b.x, nloc, nx); b.st[0] = nloc; b.st[1] = nx; }
        const unsigned old = xb_add(&bar[XB_XSUB(b.x)], 1u);
        const unsigned gen = old / nloc;
        if (old + 1u == (gen + 1u) * nloc) {
            __builtin_amdgcn_fence(__ATOMIC_RELEASE, "agent");
            asm volatile("s_waitcnt vmcnt(0)" ::: "memory");
            const unsigned og = xb_add(&bar[XB_TOP], 1u);
            const unsigned tg = og / nx;
            if (og + 1u == (tg + 1u) * nx) xb_add(&bar[XB_TOPGEN], 1u);
            else XB_SPIN(xb_ld(&bar[XB_TOPGEN]) == tg, bar);
            __builtin_amdgcn_fence(__ATOMIC_ACQUIRE, "agent");
            xb_add(&bar[XB_XGEN(b.x)], 1u);
            asm volatile("s_waitcnt vmcnt(0)" ::: "memory");
        } else {
            XB_SPIN(xb_ld(&bar[XB_XGEN(b.x)]) == gen, bar);
            __builtin_amdgcn_fence(__ATOMIC_ACQUIRE, "agent");
            asm volatile("s_waitcnt vmcnt(0)" ::: "memory");
        }
    }
    __syncthreads();
}
#endif

struct Args { const float* in[14]; float* out; unsigned char* ws; int ph_lo, ph_hi; };

DEV float clamp8(float x) { return fminf(fmaxf(x, -448.0f), 448.0f); }
template <bool FP8>
DEV void p0_transpose_item(const float* W, int ldw, int K, void* WT_, int k0, int c0, int r0, int nvalid, ldsp scr, int lane) {
    const int kr = lane >> 4, n4 = 4 * (lane & 15);
    f32x4 v[16];
#pragma unroll
    for (int i = 0; i < 16; ++i) v[i] = (n4 < nvalid) ? *(const f32x4*)(W + (size_t)(k0 + 4 * i + kr) * ldw + c0 + n4) : (f32x4){0.f, 0.f, 0.f, 0.f};
#pragma unroll
    for (int i = 0; i < 16; ++i) LDS_WR(f32x4, scr + ((4 * i + kr) * 68 + n4) * 4, v[i]);
    WAVE_SYNC();
    if constexpr (!FP8) {
        bf16* WT = (bf16*)WT_;
        const int c = lane & 7;
#pragma unroll
        for (int j = 0; j < 8; ++j) { const int n = (lane >> 3) + 8 * j; ldsp sp = scr + ((8 * c) * 68 + n) * 4;
            u32x4 o; o.x = pk2(LDS_RD(float, sp + 0 * 272), LDS_RD(float, sp + 1 * 272)); o.y = pk2(LDS_RD(float, sp + 2 * 272), LDS_RD(float, sp + 3 * 272));
            o.z = pk2(LDS_RD(float, sp + 4 * 272), LDS_RD(float, sp + 5 * 272)); o.w = pk2(LDS_RD(float, sp + 6 * 272), LDS_RD(float, sp + 7 * 272));
            if (n < nvalid) *(u32x4*)(WT + (size_t)(r0 + n) * K + k0 + 8 * c) = o; }
    } else {
        unsigned char* WT = (unsigned char*)WT_;
        const int c = lane & 3;
#pragma unroll
        for (int j = 0; j < 4; ++j) { const int n = (lane >> 2) + 16 * j; ldsp sp = scr + ((16 * c) * 68 + n) * 4; float f[16];
#pragma unroll
            for (int i = 0; i < 16; ++i) f[i] = clamp8(LDS_RD(float, sp + i * 272) * W8_SCALE);
            u32x4 o; o.x = pk_fp8x4(f[0], f[1], f[2], f[3]); o.y = pk_fp8x4(f[4], f[5], f[6], f[7]); o.z = pk_fp8x4(f[8], f[9], f[10], f[11]); o.w = pk_fp8x4(f[12], f[13], f[14], f[15]);
            if (n < nvalid) *(u32x4*)(WT + (size_t)(r0 + n) * K + k0 + 16 * c) = o; }
    }
    WAVE_SYNC();
}

constexpr int MS = 272, MS64 = 144;
constexpr int NUA = NB * HA * NCH, NUB = NB * HB * NCH;
constexpr size_t TW_QA = 0, TW_KA = TW_QA + (size_t)NUA * 16384, TW_PA = TW_KA + (size_t)NUA * 16384, TW_VA = TW_PA + (size_t)NUA * 8192, TW_ENDA = TW_VA + (size_t)NUA * 2048;
constexpr size_t TW_QB = 0, TW_KB = TW_QB + (size_t)NUB * 16384, TW_PB = TW_KB + (size_t)NUB * 16384, TW_SB = TW_PB + (size_t)NUB * 8192, TW_ENDB = TW_SB + (size_t)NUB * 2048;
static_assert(TW_ENDA <= (size_t)(NP + 16) * D * 2 && TW_ENDB <= (size_t)M * D * 2, "operand tiles must fit the dead W1T / h regions");
DEV int swz(int row, int chunk) { return row * 256 + ((chunk ^ (row & 15)) << 4); }
DEV int swz64(int row, int chunk) { return row * 128 + ((chunk ^ (row & 7)) << 4); }
DEV bf16x8 frag16p(ldsp img, int row0, int ks, int lane) { return LDS_RD(bf16x8, img + swz64(row0 + (lane & 15), 4 * ks + (lane >> 4))); }

DEV bf16x8 frag16(ldsp buf, int stride, int row0, int ks, int lane) { return LDS_RD(bf16x8, buf + (row0 + (lane & 15)) * stride + ks * 64 + (lane >> 4) * 16); }
DEV bf16x8 frag16s(ldsp img, int row0, int ks, int lane) { return LDS_RD(bf16x8, img + swz(row0 + (lane & 15), 4 * ks + (lane >> 4))); }
DEV bf16x8 frag8x2s(ldsp img, int row0, int ks, int lane) {
    const int row = row0 + (lane & 15), q = lane >> 4;
    const bf16x4 lo = LDS_RD(bf16x4, img + swz(row, 4 * ks + (q >> 1)) + (q & 1) * 8), hi = LDS_RD(bf16x4, img + swz(row, 4 * ks + 2 + (q >> 1)) + (q & 1) * 8);
    return (bf16x8){lo[0], lo[1], lo[2], lo[3], hi[0], hi[1], hi[2], hi[3]};
}
DEV bf16x8 frag_tr(ldsp img, int n0, int ks, int lane, int stride = 256) {
    ldsp p = img + (32 * ks + 8 * (lane >> 4) + ((lane & 15) >> 2)) * stride + (n0 + 4 * (lane & 3)) * 2;
    const bf16x4 lo = lds_tr16(p), hi = lds_tr16(p + 4 * stride);
    return (bf16x8){lo[0], lo[1], lo[2], lo[3], hi[0], hi[1], hi[2], hi[3]};
}
DEV bf16x8 frag_trs(ldsp img, int n0, int ks, int lane) {
    const int row = 32 * ks + 8 * (lane >> 4) + ((lane & 15) >> 2), p = lane & 3, ch = (n0 >> 3) + (p >> 1);
    const bf16x4 lo = lds_tr16(img + swz(row, ch) + (p & 1) * 8), hi = lds_tr16(img + swz(row + 4, ch) + (p & 1) * 8);
    return (bf16x8){lo[0], lo[1], lo[2], lo[3], hi[0], hi[1], hi[2], hi[3]};
}
DEV void dma_lin(const void* src, int ninst, ldsp dst, int wave, int lane) {
    for (int i = wave; i < ninst; i += NWAVES) GLDS16S((const char*)src + i * 1024, 16 * lane, dst + i * 1024);
}
DEV float sigm2(float x) { return frcp(1.0f + fexp2(-LOG2E * x)); }
DEV u32x2 pack4(const f32x4 v) { u32x2 w; w.x = cvt_pk_bf16(v[0], v[1]); w.y = cvt_pk_bf16(v[2], v[3]); return w; }

DEV float scan_add(float v, int lane) {
#pragma unroll
    for (int o = 1; o < 64; o <<= 1) { const float t = __shfl_up(v, o); if (lane >= o) v += t; }
    return v;
}
DEV float scan_max(float v, int lane) {
#pragma unroll
    for (int o = 1; o < 64; o <<= 1) { const float t = __shfl_up(v, o); if (lane >= o) v = fmaxf(v, t); }
    return v;
}

constexpr int PA_RAW = 0, PA_RAWSZ = 2 * 68 * 256, PA_TOT = 2 * PA_RAWSZ, PA_IQ = PA_TOT + 8 * 128 * 4, PA_IK = PA_IQ + 16384, PA_SC = PA_IK + 16384, PA_END = PA_SC + 1024;
static_assert(PA_END <= RING_BYTES, "P2 LDS");
DEV void p2_issue(const Args& args, int u, ldsp raw, int wave, int lane) {
    const bf16* P = (const bf16*)(args.ws + WS_P);
    if (u < NUA) { const int bh = u / NCH, j = u % NCH, b = bh / HA, h = bh % HA; const size_t tok0 = (size_t)b * SEQ + 64 * j;
        dma_lin(P + p_off(tok0, C_QA + h * 128), 16, raw, wave, lane); dma_lin(P + p_off(tok0, C_FA + h * 128), 16, raw + 68 * 256, wave, lane); }
    else { const int ub = u - NUA, bh = ub / NCH, j = ub % NCH, b = bh / HB, h = bh % HB; const size_t tok0 = (size_t)b * SEQ + 64 * j;
        dma_lin(P + p_off(tok0, C_QB + h * 128) - 3 * 128, 17, raw, wave, lane); dma_lin(P + p_off(tok0, C_KB + h * 128) - 3 * 128, 17, raw + 68 * 256, wave, lane); }
}
DEV void p2_scores(ldsp lds, f32x4 (&sc)[2], int wave, int lane) {
    const int ct = wave >> 1, st0 = 2 * (wave & 1);
    sc[0] = (f32x4){0.f, 0.f, 0.f, 0.f}; sc[1] = (f32x4){0.f, 0.f, 0.f, 0.f};
#pragma unroll
    for (int ks = 0; ks < 4; ++ks) { const bf16x8 qf = frag16s(lds + PA_IQ, 16 * ct, ks, lane);
#pragma unroll
        for (int n = 0; n < 2; ++n) { const bf16x8 kf_ = frag16s(lds + PA_IK, 16 * (st0 + n), ks, lane); sc[n] = MFMA16(kf_, qf, sc[n]); } }
}
DEV void p2_unit(const Args& args, ldsp lds, int u, ldsp raw, int wave, int lane) {
    unsigned char* TW = args.ws + WS_W1T;
    const int q4 = lane >> 4, l15 = lane & 15;
    if (u < NUA) {
        const int bh = u / NCH, h = bh % HA;
        const float* lbl = args.in[3];
        float lbv[2];
#pragma unroll
        for (int e = 0; e < 2; ++e) { const int col = h * 128 + 2 * lane + e; lbv[e] = frcp(1.0f + fexp(lbl[DA + col] - lbl[col])); }
        float lf[8][2], qv[8][2], kv[8][2];
#pragma unroll
        for (int c = 0; c < 8; ++c) { const unsigned qw = LDS_RD(unsigned, raw + (8 * wave + c) * 256 + lane * 4), fw = LDS_RD(unsigned, raw + 68 * 256 + (8 * wave + c) * 256 + lane * 4);
#pragma unroll
            for (int e = 0; e < 2; ++e) { const float f = lbv[e] + (1.0f - lbv[e]) * sigm2(__builtin_bit_cast(float, e ? (fw & 0xffff0000u) : (fw << 16))); lf[c][e] = flog2(f); kv[c][e] = 1.0f - f; qv[c][e] = __builtin_bit_cast(float, e ? (qw & 0xffff0000u) : (qw << 16)); } }
#pragma unroll
        for (int c = 1; c < 8; ++c) { lf[c][0] += lf[c - 1][0]; lf[c][1] += lf[c - 1][1]; }
        LDS_WR(f32x2, lds + PA_TOT + (wave * 128 + 2 * lane) * 4, ((f32x2){lf[7][0], lf[7][1]}));
        MIX_BAR();
        f32x2 off = (f32x2){0.f, 0.f}, bmid = (f32x2){0.f, 0.f}, g = (f32x2){0.f, 0.f};
#pragma unroll
        for (int w = 0; w < 8; ++w) { const f32x2 t = LDS_RD(f32x2, lds + PA_TOT + (w * 128 + 2 * lane) * 4); if (w < wave) off += t; if (w < 4) bmid += t; g += t; }
        if (wave == 0) { float* vec = (float*)(TW + TW_VA + (size_t)u * 2048) + 2 * lane;
            *(f32x2*)vec = (f32x2){fexp2(bmid[0]), fexp2(bmid[1])}; *(f32x2*)(vec + 128) = (f32x2){fexp2(g[0]), fexp2(g[1])}; *(f32x2*)(vec + 256) = (f32x2){fexp2(g[0] - bmid[0]), fexp2(g[1] - bmid[1])}; }
        unsigned qr8[8], kr8[8];
#pragma unroll
        for (int c = 0; c < 8; ++c) { float qr[2], kk[2]; const int r = 8 * wave + c;
#pragma unroll
            for (int e = 0; e < 2; ++e) { const float t1 = lf[c][e] + off[e] - bmid[e]; qr[e] = qv[c][e] * fexp2(t1); kk[e] = kv[c][e] * fexp2(-t1); }
            qr8[c] = cvt_pk_bf16(qr[0], qr[1]); kr8[c] = cvt_pk_bf16(kk[0], kk[1]);
            LDS_WR(unsigned, lds + PA_IQ + swz(r, lane >> 2) + (lane & 3) * 4, qr8[c]); LDS_WR(unsigned, lds + PA_IK + swz(r, lane >> 2) + (lane & 3) * 4, kr8[c]); }
        MIX_BAR();
        f32x4 sc[2]; p2_scores(lds, sc, wave, lane);
        unsigned char* tq = TW + TW_QA + (size_t)u * 16384; unsigned char* tk = TW + TW_KA + (size_t)u * 16384; unsigned char* tp = TW + TW_PA + (size_t)u * 8192;
#pragma unroll
        for (int c = 0; c < 8; ++c) { const int r = 8 * wave + c; *(unsigned*)(tq + swz(r, lane >> 2) + (lane & 3) * 4) = qr8[c]; *(unsigned*)(tk + swz(r, lane >> 2) + (lane & 3) * 4) = kr8[c]; }
#pragma unroll
        for (int n = 0; n < 2; ++n) { const int c = 16 * (wave >> 1) + l15, s0_ = 16 * (2 * (wave & 1) + n) + 4 * q4; f32x4 v = sc[n];
#pragma unroll
            for (int r = 0; r < 4; ++r) v[r] = (s0_ + r <= c) ? v[r] : 0.f;
            *(u32x2*)(tp + swz64(c, s0_ >> 3) + (q4 & 1) * 8) = pack4(v); }
    } else {
        const int ub = u - NUA, bh = ub / NCH, j = ub % NCH, b = bh / HB, h = bh % HB;
        const float* cw = args.in[4]; const float* cb = args.in[5];
        f32x2 wq[4], wk[4];
#pragma unroll
        for (int k = 0; k < 4; ++k) { wq[k] = *(const f32x2*)(cw + k * (2 * DQK) + h * 128 + 2 * lane); wk[k] = *(const f32x2*)(cw + k * (2 * DQK) + DQK + h * 128 + 2 * lane); }
        const f32x2 bq = *(const f32x2*)(cb + h * 128 + 2 * lane), bk = *(const f32x2*)(cb + DQK + h * 128 + 2 * lane);
        unsigned uq[11], uk[11];
#pragma unroll
        for (int i = 0; i < 11; ++i) { const bool neg = (64 * j + 8 * wave + i - 3) < 0;
            const unsigned a = LDS_RD(unsigned, raw + (8 * wave + i) * 256 + lane * 4), bb = LDS_RD(unsigned, raw + 68 * 256 + (8 * wave + i) * 256 + lane * 4); uq[i] = neg ? 0u : a; uk[i] = neg ? 0u : bb; }
        unsigned char* TWB = args.ws + WS_HB;
        float* sb = (float*)(TWB + TW_SB + (size_t)ub * 2048);
        if (wave == 0) {
            const size_t tok = (size_t)b * SEQ + 64 * j + lane; const float* SG = (const float*)(args.ws + WS_SG);
            const float fp = SG[tok * 16 + HB + h] + args.in[7][h], ig = SG[tok * 16 + h] + args.in[6][h];
            const float bc = scan_add(logsig(fp), lane), a = ig - bc, pm = scan_max(a, lane);
            sb[lane] = pm; sb[64 + lane] = bc;
            LDS_WR(float, lds + PA_SC + lane * 4, a * LOG2E); LDS_WR(float, lds + PA_SC + 256 + lane * 4, pm * LOG2E);
        }
        unsigned q8[8]; float kf[8][2];
#pragma unroll
        for (int c = 0; c < 8; ++c) { float qq[2]; const int r = 8 * wave + c;
#pragma unroll
            for (int e = 0; e < 2; ++e) { float yq = bq[e], yk = bk[e];
#pragma unroll
                for (int k = 0; k < 4; ++k) { yq += wq[k][e] * __builtin_bit_cast(float, e ? (uq[c + k] & 0xffff0000u) : (uq[c + k] << 16)); yk += wk[k][e] * __builtin_bit_cast(float, e ? (uk[c + k] & 0xffff0000u) : (uk[c + k] << 16)); }
                qq[e] = yq * sigm2(yq); kf[c][e] = yk * sigm2(yk) * 0.08838834764831845f; }
            q8[c] = cvt_pk_bf16(qq[0], qq[1]);
            LDS_WR(unsigned, lds + PA_IQ + swz(r, lane >> 2) + (lane & 3) * 4, q8[c]); LDS_WR(unsigned, lds + PA_IK + swz(r, lane >> 2) + (lane & 3) * 4, cvt_pk_bf16(kf[c][0], kf[c][1])); }
        MIX_BAR();
        const float pm63 = LDS_RD(float, lds + PA_SC + 256 + 63 * 4);
        unsigned kw8[8]; float na[2] = {0.f, 0.f};
#pragma unroll
        for (int c = 0; c < 8; ++c) { const float w_ = fexp2(LDS_RD(float, lds + PA_SC + (8 * wave + c) * 4) - pm63); const float k0 = w_ * kf[c][0], k1 = w_ * kf[c][1]; na[0] += k0; na[1] += k1; kw8[c] = cvt_pk_bf16(k0, k1); }
        LDS_WR(f32x2, lds + PA_TOT + (wave * 128 + 2 * lane) * 4, ((f32x2){na[0], na[1]}));
        f32x4 sc[2]; p2_scores(lds, sc, wave, lane);
        const int ct = wave >> 1, st0 = 2 * (wave & 1), c_ = 16 * ct + l15;
        const float pmc = LDS_RD(float, lds + PA_SC + 256 + c_ * 4); float rs = 0.f; u32x2 pw[2];
#pragma unroll
        for (int n = 0; n < 2; ++n) { const int s0_ = 16 * (st0 + n) + 4 * q4; const f32x4 as = LDS_RD(f32x4, lds + PA_SC + s0_ * 4); f32x4 v;
#pragma unroll
            for (int r = 0; r < 4; ++r) { const float t = fexp2(as[r] - pmc) * sc[n][r]; v[r] = (s0_ + r <= c_) ? t : 0.f; rs += v[r]; }
            pw[n] = pack4(v); }
        rs += __shfl_xor(rs, 16); rs += __shfl_xor(rs, 32);
        MIX_BAR();
        if (wave < 2) { const int dcol = wave * 64 + lane; float nl = 0.f;
#pragma unroll
            for (int w = 0; w < 8; ++w) nl += LDS_RD(float, lds + PA_TOT + (w * 128 + dcol) * 4);
            sb[256 + dcol] = nl; }
        if (q4 == 0) sb[128 + c_ * 2 + (wave & 1)] = rs;
        unsigned char* tq = TWB + TW_QB + (size_t)ub * 16384; unsigned char* tk = TWB + TW_KB + (size_t)ub * 16384; unsigned char* tp = TWB + TW_PB + (size_t)ub * 8192;
#pragma unroll
        for (int c = 0; c < 8; ++c) { const int r = 8 * wave + c; *(unsigned*)(tq + swz(r, lane >> 2) + (lane & 3) * 4) = q8[c]; *(unsigned*)(tk + swz(r, lane >> 2) + (lane & 3) * 4) = kw8[c]; }
#pragma unroll
        for (int n = 0; n < 2; ++n) { const int s0_ = 16 * (st0 + n) + 4 * q4; *(u32x2*)(tp + swz64(c_, s0_ >> 3) + (q4 & 1) * 8) = pw[n]; }
    }
}

constexpr int PB_BUFSZ = 59392, PB_Q = 0, PB_K = 16384, PB_V = 32768, PB_P = 49152, PB_VEC = 57344;
constexpr int PB_SM = 2 * PB_BUFSZ;
constexpr int SM_SSQ = PB_SM;
constexpr int SM_R = SM_SSQ + 2 * 64 * 8 * 4, SM_INT = SM_R + 256, SM_EMT = SM_INT + 256, SM_RS = SM_EMT + 256, SM_SCAL = SM_RS + 256;
constexpr int SM_NV = SM_SCAL + 64, SM_QN = SM_NV + 512, MX_END = SM_QN + 256;
static_assert(MX_END <= RING_BYTES, "mixer LDS");

DEV void mixer_a_job(const Args& args, ldsp lds, int b, int h, int tid_) {
    const int wave = RFL(tid_ >> 6);
    const bf16* P = (const bf16*)(args.ws + WS_P);
    const unsigned char* TW = args.ws + WS_W1T;
    const rsrc_t RO = make_rsrc(args.ws + WS_OAB, (unsigned)((size_t)2 * M * DA * 2));
    float* SSA = (float*)(args.ws + WS_SSA);
    const int u0 = (b * HA + h) * NCH;
    f32x4 st[8], o[4];
#pragma unroll
    for (int t = 0; t < 8; ++t) st[t] = (f32x4){0.f, 0.f, 0.f, 0.f};
#pragma unroll
    for (int ct = 0; ct < 4; ++ct) o[ct] = (f32x4){0.f, 0.f, 0.f, 0.f};
#define MA_DMA(jj) do { ldsp bf_ = lds + ((jj) & 1) * PB_BUFSZ; const size_t uu_ = (size_t)(u0 + (jj)); \
        dma_lin(TW + TW_QA + uu_ * 16384, 16, bf_ + PB_Q, wave, lane); dma_lin(TW + TW_KA + uu_ * 16384, 16, bf_ + PB_K, wave, lane); \
        dma_lin(P + p_off((size_t)b * SEQ + 64 * (jj), C_IA + h * 128), 16, bf_ + PB_V, wave, lane); dma_lin(TW + TW_PA + uu_ * 8192, 8, bf_ + PB_P, wave, lane); dma_lin(TW + TW_VA + uu_ * 2048, 2, bf_ + PB_VEC, wave, lane); } while (0)
    { const int lane = tid_ & 63; MA_DMA(0); }
    for (int j = 0; j <= NCH; ++j) {
        int tidj = tid_; OPAQUE(tidj);
        const int lane = tidj & 63, q4 = lane >> 4, l15 = lane & 15;
        const size_t tk0 = (size_t)b * SEQ + 64 * j;
        if (j <= 1) WAIT_V(0); else WAIT_V(4);
        MIX_BAR();
        if (j + 1 < NCH) MA_DMA(j + 1);
        if (j > 0) {
            if (wave == 0) { ldsp ssq = lds + SM_SSQ + ((j - 1) & 1) * 2048; const f32x4 s0 = LDS_RD(f32x4, ssq + (lane * 8) * 4), s1 = LDS_RD(f32x4, ssq + (lane * 8 + 4) * 4);
                SSA[(tk0 - 64 + lane) * HA + h] = ((s0[0] + s0[1]) + (s0[2] + s0[3])) + ((s1[0] + s1[1]) + (s1[2] + s1[3])); }
#pragma unroll
            for (int ct = 0; ct < 4; ++ct) bstore64(RO, (unsigned)(l15 * DA + h * 128 + 16 * wave + 4 * q4) * 2u, (unsigned)(tk0 - 64 + 16 * ct) * (unsigned)(DA * 2), pack4(o[ct]));
        }
        if (j == NCH) break;
        ldsp bf = lds + (j & 1) * PB_BUFSZ;
        bf16x8 bv[2], pf[2][4], qf[4][4];
#pragma unroll
        for (int ks = 0; ks < 2; ++ks) bv[ks] = frag_tr(bf + PB_V, 16 * wave, ks, lane);
#pragma unroll
        for (int ks = 0; ks < 2; ++ks)
#pragma unroll
            for (int ct = 0; ct < 4; ++ct) pf[ks][ct] = frag16p(bf + PB_P, 16 * ct, ks, lane);
#pragma unroll
        for (int ks = 0; ks < 4; ++ks)
#pragma unroll
            for (int ct = 0; ct < 4; ++ct) qf[ks][ct] = frag8x2s(bf + PB_Q, 16 * ct, ks, lane);
        f32x4 ev[8];
#pragma unroll
        for (int t = 0; t < 8; ++t) ev[t] = LDS_RD(f32x4, bf + PB_VEC + (16 * t + 4 * q4) * 4);
        SCHED_BAR();
#pragma unroll
        for (int ct = 0; ct < 4; ++ct) o[ct] = (f32x4){0.f, 0.f, 0.f, 0.f};
#pragma unroll
        for (int ks = 0; ks < 2; ++ks)
#pragma unroll
            for (int ct = 0; ct < 4; ++ct) o[ct] = MFMA16(bv[ks], pf[ks][ct], o[ct]);
#pragma unroll
        for (int ks = 0; ks < 4; ++ks) {
            u32x4 w; const f32x4 a0 = st[2 * ks] * ev[2 * ks], a1 = st[2 * ks + 1] * ev[2 * ks + 1]; w.x = cvt_pk_bf16(a0[0], a0[1]); w.y = cvt_pk_bf16(a0[2], a0[3]); w.z = cvt_pk_bf16(a1[0], a1[1]); w.w = cvt_pk_bf16(a1[2], a1[3]);
            const bf16x8 sf = __builtin_bit_cast(bf16x8, w);
#pragma unroll
            for (int ct = 0; ct < 4; ++ct) o[ct] = MFMA16(sf, qf[ks][ct], o[ct]); }
#pragma unroll
        for (int t = 0; t < 8; ++t) {
            f32x4 u = (f32x4){0.f, 0.f, 0.f, 0.f};
#pragma unroll
            for (int ks = 0; ks < 2; ++ks) { const bf16x8 a = frag_trs(bf + PB_K, 16 * t, ks, lane); u = MFMA16(a, bv[ks], u); }
            const f32x4 eg = LDS_RD(f32x4, bf + PB_VEC + 512 + (16 * t + 4 * q4) * 4), egm = LDS_RD(f32x4, bf + PB_VEC + 1024 + (16 * t + 4 * q4) * 4); st[t] = eg * st[t] + egm * u; }
        ldsp ssq = lds + SM_SSQ + (j & 1) * 2048;
#pragma unroll
        for (int ct = 0; ct < 4; ++ct) { float s = (o[ct][0] * o[ct][0] + o[ct][1] * o[ct][1]) + (o[ct][2] * o[ct][2] + o[ct][3] * o[ct][3]); s += __shfl_xor(s, 16); s += __shfl_xor(s, 32);
            LDS_WR(float, ssq + ((16 * ct + l15) * 8 + wave) * 4, s); }
    }
#undef MA_DMA
}

DEV void mixer_b_job(const Args& args, ldsp lds, int b, int h, int half, int tid_) {
    const int wave = RFL(tid_ >> 6);
    const int vbase = h * 256 + 128 * half;
    const bf16* P = (const bf16*)(args.ws + WS_P);
    const unsigned char* TW = args.ws + WS_HB;
    const rsrc_t RO = make_rsrc(args.ws + WS_OAB, (unsigned)((size_t)2 * M * DA * 2));
    float* SSB = (float*)(args.ws + WS_SSB);
    const int u0 = (b * HB + h) * NCH;
    f32x4 st[8], hv[4];
#pragma unroll
    for (int t = 0; t < 8; ++t) st[t] = (f32x4){0.f, 0.f, 0.f, 0.f};
#pragma unroll
    for (int ct = 0; ct < 4; ++ct) hv[ct] = (f32x4){0.f, 0.f, 0.f, 0.f};
    float mcar = 0.f;
    if (wave < 2) LDS_WR(float, lds + SM_NV + tid_ * 4, 0.f);
#define MB_DMA(jj) do { ldsp bf_ = lds + ((jj) & 1) * PB_BUFSZ; const size_t uu_ = (size_t)(u0 + (jj)); \
        dma_lin(TW + TW_QB + uu_ * 16384, 16, bf_ + PB_Q, wave, lane); dma_lin(TW + TW_KB + uu_ * 16384, 16, bf_ + PB_K, wave, lane); \
        dma_lin(P + p_off((size_t)b * SEQ + 64 * (jj), C_VB + vbase), 16, bf_ + PB_V, wave, lane); dma_lin(TW + TW_PB + uu_ * 8192, 8, bf_ + PB_P, wave, lane); dma_lin(TW + TW_SB + uu_ * 2048, 2, bf_ + PB_VEC, wave, lane); } while (0)
    { const int lane = tid_ & 63; MB_DMA(0); }
    for (int j = 0; j <= NCH; ++j) {
        const size_t tk0 = (size_t)b * SEQ + 64 * j;
        int tidj = tid_; OPAQUE(tidj);
        const int tid = tidj, lane = tidj & 63, q4 = lane >> 4, l15 = lane & 15;
        if (j <= 1) WAIT_V(0); else WAIT_V(4);
        MIX_BAR();
        if (j + 1 < NCH) MB_DMA(j + 1);
        if (j > 0) {
            if (wave == 0) { ldsp ssq = lds + SM_SSQ + ((j - 1) & 1) * 2048; const f32x4 s0 = LDS_RD(f32x4, ssq + (lane * 8) * 4), s1 = LDS_RD(f32x4, ssq + (lane * 8 + 4) * 4);
                SSB[(tk0 - 64 + lane) * (2 * HB) + 2 * h + half] = ((s0[0] + s0[1]) + (s0[2] + s0[3])) + ((s1[0] + s1[1]) + (s1[2] + s1[3])); }
#pragma unroll
            for (int ct = 0; ct < 4; ++ct) bstore64(RO, (unsigned)(l15 * DB + vbase + 16 * wave + 4 * q4) * 2u, (unsigned)(M + tk0 - 64 + 16 * ct) * (unsigned)(DB * 2), pack4(hv[ct]));
        }
        if (j == NCH) break;
        ldsp bf = lds + (j & 1) * PB_BUFSZ;
        if (wave == 0) {
            const float pm = LDS_RD(float, bf + PB_VEC + lane * 4), bc = LDS_RD(float, bf + PB_VEC + 256 + lane * 4); const f32x2 rsl = LDS_RD(f32x2, bf + PB_VEC + 512 + lane * 8);
            const float mx = fmaxf(mcar, pm), r = fexp(pm - mx);
            const float pm63 = __shfl(pm, 63), bc63 = __shfl(bc, 63), m63 = fmaxf(mcar, pm63);
            LDS_WR(float, lds + SM_R + lane * 4, r); LDS_WR(float, lds + SM_INT + lane * 4, fexp(mcar - mx)); LDS_WR(float, lds + SM_EMT + lane * 4, fexp(-(bc + mx))); LDS_WR(float, lds + SM_RS + lane * 4, r * (rsl[0] + rsl[1]));
            if (lane == 0) { LDS_WR(float, lds + SM_SCAL, fexp(mcar - m63)); LDS_WR(float, lds + SM_SCAL + 4, bc63 + m63); LDS_WR(float, lds + SM_SCAL + 8, fexp(pm63 - m63)); }
        }
        {
            const int c = tid >> 3, part = tid & 7; float s = 0.f;
#pragma unroll
            for (int hh = 0; hh < 2; ++hh) { const u32x4 qw = LDS_RD(u32x4, bf + PB_Q + swz(c, 2 * part + hh));
#pragma unroll
                for (int e = 0; e < 4; ++e) { const f32x2 nv = LDS_RD(f32x2, lds + SM_NV + (16 * part + 8 * hh + 2 * e) * 4); s += __builtin_bit_cast(float, qw[e] << 16) * nv[0] + __builtin_bit_cast(float, qw[e] & 0xffff0000u) * nv[1]; } }
            s += __shfl_xor(s, 1); s += __shfl_xor(s, 2); s += __shfl_xor(s, 4);
            LDS_WR(float, lds + SM_QN + c * 4, s);
        }
        MIX_BAR();
        const float decay = LDS_RD(float, lds + SM_SCAL), sj = LDS_RD(float, lds + SM_SCAL + 8);
        mcar = LDS_RD(float, lds + SM_SCAL + 4);
        {
            bf16x8 bv[2], bs[4], pf[2][4], qf[4][4];
#pragma unroll
            for (int ks = 0; ks < 2; ++ks) bv[ks] = frag_tr(bf + PB_V, 16 * wave, ks, lane);
#pragma unroll
            for (int ks = 0; ks < 2; ++ks)
#pragma unroll
                for (int ct = 0; ct < 4; ++ct) pf[ks][ct] = frag16p(bf + PB_P, 16 * ct, ks, lane);
#pragma unroll
            for (int ks = 0; ks < 4; ++ks)
#pragma unroll
                for (int ct = 0; ct < 4; ++ct) qf[ks][ct] = frag8x2s(bf + PB_Q, 16 * ct, ks, lane);
            float s_int[4], s_r[4], s_qn[4], s_rs[4], s_emt[4];
#pragma unroll
            for (int ct = 0; ct < 4; ++ct) { const int c = 16 * ct + l15; s_int[ct] = LDS_RD(float, lds + SM_INT + c * 4); s_r[ct] = LDS_RD(float, lds + SM_R + c * 4); s_qn[ct] = LDS_RD(float, lds + SM_QN + c * 4); s_rs[ct] = LDS_RD(float, lds + SM_RS + c * 4); s_emt[ct] = LDS_RD(float, lds + SM_EMT + c * 4); }
            SCHED_BAR();
#pragma unroll
            for (int ks = 0; ks < 4; ++ks) { u32x4 w; const f32x4 a0 = st[2 * ks], a1 = st[2 * ks + 1]; w.x = cvt_pk_bf16(a0[0], a0[1]); w.y = cvt_pk_bf16(a0[2], a0[3]); w.z = cvt_pk_bf16(a1[0], a1[1]); w.w = cvt_pk_bf16(a1[2], a1[3]); bs[ks] = __builtin_bit_cast(bf16x8, w); }
#pragma unroll
            for (int ct = 0; ct < 4; ++ct) {
                f32x4 a1 = (f32x4){0.f, 0.f, 0.f, 0.f}, a2 = (f32x4){0.f, 0.f, 0.f, 0.f};
#pragma unroll
                for (int ks = 0; ks < 2; ++ks) a2 = MFMA16(bv[ks], pf[ks][ct], a2);
#pragma unroll
                for (int ks = 0; ks < 4; ++ks) a1 = MFMA16(bs[ks], qf[ks][ct], a1);
                const float den = s_int[ct] * s_qn[ct] + s_rs[ct];
                const float rden = frcp(fmaxf(fabsf(den), s_emt[ct]));
                hv[ct] = (s_int[ct] * a1 + s_r[ct] * a2) * rden;
            }
#pragma unroll
            for (int t = 0; t < 8; ++t) {
                f32x4 u = (f32x4){0.f, 0.f, 0.f, 0.f};
#pragma unroll
                for (int ks = 0; ks < 2; ++ks) { const bf16x8 a = frag_trs(bf + PB_K, 16 * t, ks, lane); u = MFMA16(a, bv[ks], u); }
                st[t] = decay * st[t] + sj * u;
            }
            if (wave < 2) LDS_WR(float, lds + SM_NV + tid * 4, decay * LDS_RD(float, lds + SM_NV + tid * 4) + sj * LDS_RD(float, bf + PB_VEC + 1024 + tid * 4));
            ldsp ssq = lds + SM_SSQ + (j & 1) * 2048;
#pragma unroll
            for (int ct = 0; ct < 4; ++ct) { float s = (hv[ct][0] * hv[ct][0] + hv[ct][1] * hv[ct][1]) + (hv[ct][2] * hv[ct][2] + hv[ct][3] * hv[ct][3]); s += __shfl_xor(s, 16); s += __shfl_xor(s, 32);
                LDS_WR(float, ssq + ((16 * ct + l15) * 8 + wave) * 4, s); }
        }
    }
#undef MB_DMA
}

constexpr int P0_RB1 = (NP + NSG + 63) / 64, P0_I1 = (D / 64) * P0_RB1, P0_IU = (DA / 64) * (D / 64), P0_IO = (D / 64) * (D / 64), P0_NITEMS = P0_I1 + 2 * P0_IU + P0_IO;
DEV void p0_item(const Args& args, int it, ldsp scr, int lane) {
    unsigned char* ws = args.ws; bf16* W1T = (bf16*)(ws + WS_W1T); bf16* WUT = (bf16*)(ws + WS_WUT); bf16* WOT = (bf16*)(ws + WS_WOT);
    int r = it;
    if (r < P0_I1) { const int kb = r / P0_RB1, rb = r % P0_RB1, r0 = 64 * rb; int c0, nv;
        if (r0 >= NPM && r0 < NP) { p0_transpose_item<true>(args.in[2], D_IN, D, ws + WS_W8, 64 * kb, r0 + NSG, r0 - NPM, 64, scr, lane); return; }
        if (r0 < NPM) { c0 = r0; nv = 64; } else { c0 = NPM + (r0 - NP); nv = NSG - (r0 - NP) < 64 ? NSG - (r0 - NP) : 64; }
        p0_transpose_item<false>(args.in[2], D_IN, D, W1T, 64 * kb, c0, r0, nv, scr, lane); return; }
    r -= P0_I1;
    if (r < P0_IU) { const int kb = r / (D / 64), rb = r % (D / 64); p0_transpose_item<false>(args.in[10], D, DA, WUT, 64 * kb, 64 * rb, 64 * rb, 64, scr, lane); return; }
    r -= P0_IU;
    if (r < P0_IU) { const int kb = r / (D / 64), rb = r % (D / 64); p0_transpose_item<false>(args.in[11], D, DB, WUT + (size_t)D * DA, 64 * kb, 64 * rb, 64 * rb, 64, scr, lane); return; }
    r -= P0_IU;
    { const int kb = r / (D / 64), rb = r % (D / 64); p0_transpose_item<false>(args.in[12], D, D, WOT, 64 * kb, 64 * rb, 64 * rb, 64, scr, lane); }
}

__global__ void __launch_bounds__(NTHREADS, 2) fwd_kernel(Args args) {
#ifndef EMU
    extern __shared__ __attribute__((aligned(16))) unsigned char lds_raw[];
    ldsp lds = (ldsp)lds_raw;
#else
    ldsp lds = emu_lds;
#endif
    const int tid = threadIdx.x, lane = tid & 63, wave = RFL(tid >> 6);
    const int G = gridDim.x, bx = blockIdx.x;
    const int vcu = (G % 8 == 0) ? (bx % 8) * (G / 8) + bx / 8 : bx;
    unsigned char* ws = args.ws;
#ifndef EMU
    for (int u = tid; u < (LDS_BYTES - LDSCTL_OFF) / 4; u += NTHREADS) ((LAS unsigned*)(lds + LDSCTL_OFF))[u] = 0u;
    __syncthreads();
    XcdBarrier bar = xcd_barrier_post((unsigned*)(ws + WS_CTL) + CW_BAR, (volatile LAS unsigned*)(lds + MISC_OFF) + 8);
#define GRID_BAR() xcd_barrier(bar)
#else
#define GRID_BAR()
#endif
    const int lo = args.ph_lo, hi = args.ph_hi;
#ifndef GEMM_SP2
#define GEMM_SP2 true
#endif
#ifndef GEMM_ALIGN
#define GEMM_ALIGN true
#endif
#ifndef PROBE_REP_P4
#define PROBE_REP_P4 1
#endif
#ifndef PROBE_REP_P5
#define PROBE_REP_P5 1
#endif
#ifndef PROBE_REP_P1
#define PROBE_REP_P1 2
#endif
#ifndef PROBE_REP_P2
#define PROBE_REP_P2 1
#endif
#ifndef PHASE_MASK
#define PHASE_MASK 255
#endif
#define IN(k) (((PHASE_MASK >> (k)) & 1) && lo <= (k) && (k) < hi)
#define BOTH(k) (IN(k) && IN((k) + 1))
    const float* x = args.in[0];
    bf16* W1T = (bf16*)(ws + WS_W1T); bf16* WUT = (bf16*)(ws + WS_WUT); bf16* WOT = (bf16*)(ws + WS_WOT);
    bf16* HBUF = (bf16*)(ws + WS_HB); bf16* PB = (bf16*)(ws + WS_P); float* SG = (float*)(ws + WS_SG); bf16* OAB = (bf16*)(ws + WS_OAB); float* RSS = (float*)(ws + WS_RSS);

    if (IN(0)) {
        ldsp scr = lds + wave * 17408;
        const int gw = vcu * NWAVES + wave, NGW = G * NWAVES;
        constexpr int I_1 = P0_I1, NITEMS = P0_NITEMS;
        static_assert(NPM % 64 == 0 && NP % 64 == 0 && NSG % 4 == 0, "P0 item tiling");
        constexpr int NJOBS3 = NB * HA + NB * HB * 2;
        const int nit0 = (G > NJOBS3) ? I_1 : NITEMS;
        for (int it = gw; it < nit0; it += NGW) p0_item(args, it, scr, lane);
        const float* gpre = args.in[1];
        for (int m = gw; m < M; m += NGW) {
            const f32x4* xr = (const f32x4*)(x + (size_t)m * D) + lane;
            f32x4 v[D / 256]; float s = 0.f;
#pragma unroll
            for (int jj = 0; jj < D / 256; ++jj) { v[jj] = xr[64 * jj]; s += (v[jj][0] * v[jj][0] + v[jj][1] * v[jj][1]) + (v[jj][2] * v[jj][2] + v[jj][3] * v[jj][3]); }
            const float rstd = frsq(wave_sum(s) * (1.0f / D) + EPS) ;
            u32x2* o8 = (u32x2*)(HBUF + (size_t)m * D) + lane; unsigned* o4 = (unsigned*)(ws + WS_H8 + (size_t)m * D) + lane;
#pragma unroll
            for (int jj = 0; jj < D / 256; ++jj) { const f32x4 gg = ((const f32x4*)gpre)[lane + 64 * jj]; const f32x4 hh = v[jj] * rstd * gg; u32x2 w; w.x = pk2(hh[0], hh[1]); w.y = pk2(hh[2], hh[3]); o8[64 * jj] = w;
                o4[64 * jj] = pk_fp8x4(clamp8(hh[0] * H8_SCALE), clamp8(hh[1] * H8_SCALE), clamp8(hh[2] * H8_SCALE), clamp8(hh[3] * H8_SCALE)); }
        }
        if (BOTH(0)) GRID_BAR();
    }

    if (IN(1)) {
        {
            const int gw = vcu * NWAVES + wave, NGW = G * NWAVES, l15 = lane & 15, q4 = lane >> 4;
            const int wrow = NP + (l15 < NSG ? l15 : NSG - 1);
            for (int t = gw; t < M / 16; t += NGW) {
                f32x4 acc = (f32x4){0.f, 0.f, 0.f, 0.f};
                const bf16* ap = HBUF + (size_t)(16 * t + l15) * D + 8 * q4; const bf16* bp = W1T + (size_t)wrow * D + 8 * q4;
                for (int k0 = 0; k0 < D / 32; k0 += 16) {
                    bf16x8 af[16], bfr[16];
#pragma unroll
                    for (int i = 0; i < 16; ++i) { af[i] = *(const bf16x8*)(ap + 32 * (k0 + i)); bfr[i] = *(const bf16x8*)(bp + 32 * (k0 + i)); }
#pragma unroll
                    for (int i = 0; i < 16; ++i) acc = MFMA16(af[i], bfr[i], acc);
                }
#pragma unroll
                for (int r = 0; r < 4; ++r) SG[(size_t)(16 * t + 4 * q4 + r) * 16 + l15] = acc[r];
            }
        }
        { pg8::Gemm g{HBUF, W1T, M, NPM, D}; pg8::StaticOrder S; S.init(M, NPM, G, bx);
          EpiP E{PB};
          pg8::gemm_phase<EpiP, pg8::StaticOrder, GEMM_ALIGN, GEMM_SP2>(lds, g, S, E); }
        { pg8::Gemm g{(const bf16*)(ws + WS_H8), (const bf16*)(ws + WS_W8), M, 2 * D, D}; pg8::StaticOrder S; S.init(M, 2 * D, G, bx);
          EpiP8 E{PB};
          pg8::gemm_phase<EpiP8, pg8::StaticOrder, GEMM_ALIGN, GEMM_SP2, 1>(lds, g, S, E); }
        if (BOTH(1)) GRID_BAR();
    }

    if (IN(2)) {
        int buf = 0;
        if (bx < NUA + NUB) p2_issue(args, bx, lds + PA_RAW, wave, lane);
        for (int u = bx, it = 0; u < NUA + NUB; u += G, ++it) {
            int tidj = tid; OPAQUE(tidj); const int lane_ = tidj & 63;
            if (it == 0) WAIT_V(0); else WAIT_V(18);
            MIX_BAR();
            if (u + G < NUA + NUB) p2_issue(args, u + G, lds + PA_RAW + (buf ^ 1) * PA_RAWSZ, wave, lane_);
            p2_unit(args, lds, u, lds + PA_RAW + buf * PA_RAWSZ, wave, lane_);
            buf ^= 1;
        }
        if (BOTH(2)) GRID_BAR();
    }

    if (IN(3)) {
        constexpr int NJA = NB * HA, NJB = NB * HB * 2;
        if (G > NJA + NJB && bx >= NJA + NJB) {
            ldsp scr = lds + wave * 17408;
            for (int it = P0_I1 + (bx - (NJA + NJB)) * NWAVES + wave; it < P0_NITEMS; it += (G - (NJA + NJB)) * NWAVES) p0_item(args, it, scr, lane);
        }
        for (int job = bx; job < NJA + NJB; job += G) {
            if (job < NJA) mixer_a_job(args, lds, job / HA, job % HA, tid);
            else { const int jb = job - NJA; mixer_b_job(args, lds, jb / (2 * HB), (jb >> 1) % HB, jb & 1, tid); }
            BLOCK_BAR();
        }
        if (BOTH(3)) GRID_BAR();
    }

    if (IN(4)) {
        const int gw = vcu * NWAVES + wave, NGW = G * NWAVES;
        const float* SSA = (const float*)(ws + WS_SSA); const float* SSB = (const float*)(ws + WS_SSB);
        static_assert(DA % 512 == 0 && DA == DB, "P3 tiling");
        for (int m = gw; m < M; m += NGW) {
#pragma unroll
            for (int br = 0; br < 2; ++br) {
#pragma unroll
                for (int i = 0; i < DA / 512; ++i) {
                    const int col0 = i * 512 + lane * 8;
                    float rstd;
                    if (br == 0) rstd = frsq(SSA[(size_t)m * HA + col0 / 128] * (1.0f / 128.0f) + EPS);
                    else { const int hh = col0 / 256; rstd = frsq((SSB[(size_t)m * (2 * HB) + 2 * hh] + SSB[(size_t)m * (2 * HB) + 2 * hh + 1]) * (1.0f / 256.0f) + EPS); }
                    u32x4* po = (u32x4*)(OAB + (size_t)(br * M + m) * DA + col0);
                    u32x4 w = *po; const u32x4 g8 = *(const u32x4*)(PB + p_off((size_t)m, (br ? C_OGB : C_OGA) + col0)), z8 = *(const u32x4*)(PB + p_off((size_t)m, (br ? C_ZB : C_ZA) + col0));
                    const f32x4 gn0 = *(const f32x4*)(args.in[br ? 9 : 8] + col0), gn1 = *(const f32x4*)(args.in[br ? 9 : 8] + col0 + 4);
#pragma unroll
                    for (int e = 0; e < 4; ++e) { float v[2];
#pragma unroll
                        for (int k = 0; k < 2; ++k) { const float ov = __builtin_bit_cast(float, k ? (w[e] & 0xffff0000u) : (w[e] << 16)), og = __builtin_bit_cast(float, k ? (g8[e] & 0xffff0000u) : (g8[e] << 16)), z = __builtin_bit_cast(float, k ? (z8[e] & 0xffff0000u) : (z8[e] << 16));
                            const float gnv = (e < 2 ? gn0 : gn1)[(2 * e + k) & 3];
                            v[k] = ov * rstd * gnv * sigm2(og) * (z * sigm2(z)); }
                        w[e] = cvt_pk_bf16(v[0], v[1]); }
                    *po = w;
                }
            }
        }
        if (BOTH(4)) GRID_BAR();
    }
    if (IN(5)) {
        pg8::Gemm g{OAB, WUT, 2 * M, 2 * D, DA}; SchedUp S; S.so.init(M, D, G, bx);
        EpiUp E{HBUF, PB};
        for (int rep = 0; rep < PROBE_REP_P4; ++rep) pg8::gemm_phase<EpiUp, SchedUp, GEMM_ALIGN, GEMM_SP2>(lds, g, S, E);
        if (BOTH(5)) GRID_BAR();
    }

    if (IN(6)) {
        pg8::Gemm g{HBUF, WOT, M, D, D}; pg8::StaticOrder S; S.init(M, D, G, bx);
        EpiOut E{PB, RSS};
        for (int rep = 0; rep < PROBE_REP_P5; ++rep) pg8::gemm_phase<EpiOut, pg8::StaticOrder, GEMM_ALIGN, GEMM_SP2>(lds, g, S, E);
        if (BOTH(6)) GRID_BAR();
    }

    if (IN(7)) {
        const int gw = vcu * NWAVES + wave, NGW = G * NWAVES;
        const float* gpost = args.in[13];
        for (int m = gw; m < M; m += NGW) {
            const float ss = wave_sum(lane < NRS ? RSS[(size_t)m * NRS + lane] : 0.f);
            const float rstd = frsq(ss * (1.0f / D) + EPS);
            const f32x4* xr = (const f32x4*)(x + (size_t)m * D) + lane; f32x4* orow = (f32x4*)(args.out + (size_t)m * D) + lane; const u32x2* ob = (const u32x2*)(PB + (size_t)m * D) + lane;
#pragma unroll
            for (int jj = 0; jj < D / 256; ++jj) { const f32x4 xv = xr[64 * jj], gg = ((const f32x4*)gpost)[lane + 64 * jj]; const u32x2 w = ob[64 * jj];
                const f32x4 ov = (f32x4){__builtin_bit_cast(float, w.x << 16), __builtin_bit_cast(float, w.x & 0xffff0000u), __builtin_bit_cast(float, w.y << 16), __builtin_bit_cast(float, w.y & 0xffff0000u)};
                orow[64 * jj] = xv + ov * rstd * gg; }
        }
    }
#undef IN
#undef BOTH
}

#ifndef EMU
extern "C" void kernel_launch(void* const* d_in, const int* in_sizes, int n_in, void* d_out, int out_size, void* d_ws, size_t ws_size, hipStream_t stream) {
    static int grid = 0;
    if (grid == 0) {
        if (n_in != 14 || out_size != M * D || ws_size < WS_END) { fprintf(stderr, "kernel_launch: unexpected shapes (n_in %d, out %d, ws %zu < %zu)\n", n_in, out_size, ws_size, (size_t)WS_END); grid = -1; return; }
        int dev = 0, cus = 0, per_cu = 0;
        if (hipGetDevice(&dev) != hipSuccess || hipDeviceGetAttribute(&cus, hipDeviceAttributeMultiprocessorCount, dev) != hipSuccess) { grid = -1; return; }
        if (hipFuncSetAttribute((const void*)fwd_kernel, hipFuncAttributeMaxDynamicSharedMemorySize, LDS_BYTES) != hipSuccess) { fprintf(stderr, "kernel_launch: hipFuncSetAttribute failed\n"); grid = -1; return; }
        if (hipOccupancyMaxActiveBlocksPerMultiprocessor(&per_cu, (const void*)fwd_kernel, NTHREADS, LDS_BYTES) != hipSuccess || per_cu < 1) { fprintf(stderr, "kernel_launch: occupancy query says %d\n", per_cu); }
        (void)hipGetLastError();
        grid = cus;
    }
    if (grid < 0) return;
    (void)hipMemsetAsync((char*)d_ws + WS_CTL, 0, CTL_ZERO_BYTES, stream);
    Args a{};
    for (int i = 0; i < 14; ++i) a.in[i] = (const float*)d_in[i];
    a.out = (float*)d_out; a.ws = (unsigned char*)d_ws; a.ph_lo = 0; a.ph_hi = 8;
    hipLaunchKernelGGL(fwd_kernel, dim3(grid), dim3(NTHREADS), LDS_BYTES, stream, a);
}
#endif
```

```cpp
typedef unsigned u32x2_t __attribute__((ext_vector_type(2)));
typedef int v8i_t __attribute__((ext_vector_type(8)));
typedef int v4i_t __attribute__((ext_vector_type(4)));
#ifndef EMU
#include <hip/hip_runtime.h>
#include <cstdio>
#include <cstdint>
#define LAS __attribute__((address_space(3)))
#define GAS __attribute__((address_space(1)))
typedef short bf16x8 __attribute__((ext_vector_type(8)));
typedef short bf16x4 __attribute__((ext_vector_type(4)));
typedef float f32x4 __attribute__((ext_vector_type(4)));
#define DEV __device__ __forceinline__
#define LDS_RD(T, p) (*(const LAS T*)(p))
#define LDS_WR(T, p, v) (*(LAS T*)(p) = (v))
#define WAVE_SYNC() asm volatile("s_waitcnt lgkmcnt(0)" ::: "memory")
#define BLOCK_BAR() __syncthreads()
#define RAW_BAR() __builtin_amdgcn_s_barrier()
#define WAIT_V(n) asm volatile("s_waitcnt vmcnt(" #n ")" ::: "memory")
#define WAIT_L(n) asm volatile("s_waitcnt lgkmcnt(" #n ")" ::: "memory")
#define SCHED_BAR() __builtin_amdgcn_sched_barrier(0)
#define SETPRIO(n) __builtin_amdgcn_s_setprio(n)
#define GLDS16(g, l) __builtin_amdgcn_global_load_lds((const unsigned*)(g), (LAS unsigned*)(l), 16, 0, 0)
#define MFMA16(a, b, c) __builtin_amdgcn_mfma_f32_16x16x32_bf16(a, b, c, 0, 0, 0)
#define RFL(x) __builtin_amdgcn_readfirstlane(x)
#define COMPILER_FENCE() asm volatile("" ::: "memory")
#define OPAQUE(x) asm volatile("" : "+v"(x))
DEV float fexp2(float x) { return __builtin_amdgcn_exp2f(x); }
DEV float flog2(float x) { return __builtin_amdgcn_logf(x); }
DEV float frcp(float x) { return __builtin_amdgcn_rcpf(x); }
DEV float frsq(float x) { return __builtin_amdgcn_rsqf(x); }
DEV unsigned cvt_pk_bf16(float lo, float hi) { unsigned r; asm volatile("v_cvt_pk_bf16_f32 %0, %1, %2" : "=v"(r) : "v"(lo), "v"(hi)); return r; }
DEV f32x4 mfma8(v8i_t a, v8i_t b, f32x4 c, int sc) { asm volatile("v_mfma_scale_f32_16x16x128_f8f6f4 %0, %1, %2, %0, %3, %3 op_sel_hi:[0,0,0]" : "+v"(c) : "v"(a), "v"(b), "v"(sc)); return c; }
#define MFMA_DRAIN() asm volatile("s_nop 15\n\ts_nop 7" ::: "memory")
DEV unsigned pk_fp8x4(float a, float b, float c, float d) { int r = __builtin_amdgcn_cvt_pk_fp8_f32(a, b, 0, false); r = __builtin_amdgcn_cvt_pk_fp8_f32(c, d, r, true); return (unsigned)r; }
typedef short v4i16_t __attribute__((ext_vector_type(4)));
DEV bf16x4 lds_tr16(LAS unsigned char* p) { return __builtin_bit_cast(bf16x4, __builtin_amdgcn_ds_read_tr16_b64_v4i16((LAS v4i16_t*)p)); }
#define MIX_BAR() do { asm volatile("s_waitcnt lgkmcnt(0)" ::: "memory"); __builtin_amdgcn_s_barrier(); asm volatile("" ::: "memory"); } while (0)
DEV void glds16_asm(const void* gsrc, unsigned lds_dst) { unsigned keep;
    asm volatile("s_mov_b32 %0, m0\n\ts_mov_b32 m0, %2\n\ts_nop 0\n\tglobal_load_lds_dwordx4 %1, off\n\ts_mov_b32 m0, %0" : "=&s"(keep) : "v"(gsrc), "s"(lds_dst) : "memory"); }
#define GLDS16X(g, l) glds16_asm((const void*)(g), (unsigned)RFL((int)(unsigned)(__UINTPTR_TYPE__)(l)))
DEV void glds16_sbase(const void* sbase, unsigned voff, unsigned lds_dst) { unsigned keep;
    asm volatile("s_mov_b32 %0, m0\n\ts_mov_b32 m0, %3\n\ts_nop 0\n\tglobal_load_lds_dwordx4 %1, %2\n\ts_mov_b32 m0, %0" : "=&s"(keep) : "v"(voff), "s"(sbase), "s"(lds_dst) : "memory"); }
#define GLDS16S(sb, vo, l) glds16_sbase((const void*)(sb), (unsigned)(vo), (unsigned)RFL((int)(unsigned)(__UINTPTR_TYPE__)(l)))
typedef __amdgpu_buffer_rsrc_t rsrc_t;
DEV rsrc_t make_rsrc(const void* p, unsigned bytes) { return __builtin_amdgcn_make_buffer_rsrc((void*)p, (short)0, (int)bytes, 0x00020000); }
DEV unsigned short bload16(rsrc_t r, unsigned voff, unsigned soff) { return (unsigned short)__builtin_amdgcn_raw_buffer_load_b16(r, (int)voff, (int)soff, 0); }
DEV void bstore16(rsrc_t r, unsigned voff, unsigned soff, unsigned short v) { __builtin_amdgcn_raw_buffer_store_b16(v, r, (int)voff, (int)soff, 0); }
DEV void bstore64(rsrc_t r, unsigned voff, unsigned soff, u32x2_t v) { __builtin_amdgcn_raw_buffer_store_b64(v, r, (int)voff, (int)soff, 0); }
#else
#define LAS
#define GAS
#define DEV inline
#define LDS_RD(T, p) emu_lds_rd<T>((const void*)(p), #p)
#define LDS_WR(T, p, v) emu_lds_wr<T>((void*)(p), (T)(v), #p)
#define WAVE_SYNC() emu_wavesync()
#define BLOCK_BAR() emu_syncthreads()
#define RAW_BAR() emu_syncthreads()
#define WAIT_V(n)
#define WAIT_L(n)
#define SCHED_BAR()
#define SETPRIO(n)
#define GLDS16(g, l) emu_glds16((const void*)(g), (unsigned char*)(l))
#define GLDS16X(g, l) emu_glds16((const void*)(g), (unsigned char*)(l))
#define GLDS16S(sb, vo, l) emu_glds16((const void*)((const char*)(sb) + (vo)), (unsigned char*)(l))
#define MFMA16(a, b, c) emu_mfma16(a, b, c)
#define RFL(x) (x)
#define COMPILER_FENCE()
#define OPAQUE(x)
DEV float fexp2(float x) { return exp2f(x); }
DEV float flog2(float x) { return log2f(x); }
DEV float frcp(float x) { return 1.0f / x; }
DEV float frsq(float x) { return 1.0f / sqrtf(x); }
DEV unsigned cvt_pk_bf16(float lo, float hi) { return (unsigned)emu_f2bf(lo) | ((unsigned)emu_f2bf(hi) << 16); }
#define mfma8(a, b, c, sc) emu_mfma8(a, b, c)
#define MFMA_DRAIN()
DEV unsigned pk_fp8x4(float a, float b, float c, float d) { return (unsigned)emu_f2fp8(a) | ((unsigned)emu_f2fp8(b) << 8) | ((unsigned)emu_f2fp8(c) << 16) | ((unsigned)emu_f2fp8(d) << 24); }
#define lds_tr16(p) emu_lds_tr16((const unsigned char*)(p))
#define MIX_BAR() emu_syncthreads()
typedef unsigned char* rsrc_t;
DEV rsrc_t make_rsrc(const void* p, unsigned) { return (unsigned char*)p; }
DEV unsigned short bload16(rsrc_t r, unsigned voff, unsigned soff) { unsigned short v; memcpy(&v, r + (size_t)voff + soff, 2); return v; }
DEV void bstore16(rsrc_t r, unsigned voff, unsigned soff, unsigned short v) { memcpy(r + (size_t)voff + soff, &v, 2); }
DEV void bstore64(rsrc_t r, unsigned voff, unsigned soff, u32x2_t v) { memcpy(r + (size_t)voff + soff, &v, 8); }
#endif

typedef unsigned short bf16;
typedef unsigned u32x4 __attribute__((ext_vector_type(4)));
typedef unsigned u32x2 __attribute__((ext_vector_type(2)));
typedef float f32x2 __attribute__((ext_vector_type(2)));
typedef LAS unsigned char* ldsp;

#ifndef CFG_D
#define CFG_D 4096
#define CFG_B 4
#define CFG_S 4096
#define CFG_HB 8
#endif
constexpr int D = CFG_D, NB = CFG_B, SEQ = CFG_S, M = NB * SEQ;
constexpr int DA = D / 2, HA = DA / 128, DB = D / 2, HB = CFG_HB, DVB = DB / HB, DKB = 128, DQK = HB * DKB;
constexpr int NSG = 2 * HB;
constexpr int NCH = SEQ / 64;
static_assert(DVB == 256 && NSG <= 16 && SEQ % 64 == 0 && M % 256 == 0 && D % 256 == 0, "shape");
constexpr int C_QA = 0, C_FA = DA, C_IA = 2 * DA, C_OGA = 3 * DA, C_ZA = 4 * DA, C_QB = 5 * DA, C_KB = C_QB + DQK, C_VB = C_KB + DQK, C_OGB = C_VB + DB, C_ZB = C_OGB + DB;
constexpr int NPM = C_ZB + DB, C_GA = NPM, C_GB = NPM + D, NP = NPM + 2 * D, D_IN = NP + NSG;
static_assert(NPM % 256 == 0 && NP % 256 == 0, "column map");
constexpr float EPS = 1e-6f;
constexpr float H8_SCALE = 64.0f, W8_SCALE = 1024.0f, G8_DESCALE = 1.0f / (64.0f * 1024.0f);
constexpr float LOG2E = 1.4426950408889634f, LN2 = 0.6931471805599453f;
constexpr int NRS = D / 64;
constexpr int PT_PITCH = M / 64 + 1;
DEV size_t p_off(size_t row, int col) { return ((size_t)(col >> 7) * (size_t)PT_PITCH + (row >> 6)) * 8192 + (row & 63) * 128 + (size_t)(col & 127); }

constexpr size_t al256(size_t x) { return (x + 255) & ~(size_t)255; }
constexpr size_t WS_CTL = 0, CTL_ZERO_BYTES = 65536;
constexpr size_t WS_W1T = 1u << 20;
constexpr size_t WS_WUT = al256(WS_W1T + (size_t)(NP + 16) * D * 2);
constexpr size_t WS_WOT = al256(WS_WUT + (size_t)2 * D * DA * 2);
constexpr size_t WS_HB = al256(WS_WOT + (size_t)D * D * 2);
constexpr size_t WS_P = al256(WS_HB + (size_t)M * D * 2);
constexpr size_t WS_SG = al256(WS_P + (size_t)(NP / 128) * (M / 64 + 1) * 16384 + 4096);
constexpr size_t WS_OAB = al256(WS_SG + (size_t)M * 16 * 4);
constexpr size_t WS_RSS = al256(WS_OAB + (size_t)2 * M * DA * 2);
constexpr size_t WS_SSB = al256(WS_RSS + (size_t)M * NRS * 4);
constexpr size_t WS_SSA = al256(WS_SSB + (size_t)M * HB * 4 * 4);
constexpr size_t WS_H8 = al256(WS_SSA + (size_t)M * HA * 2 * 4);
constexpr size_t WS_W8 = al256(WS_H8 + (size_t)M * D);
constexpr size_t WS_END = al256(WS_W8 + (size_t)2 * D * D);
constexpr int CW_BAR = 1024;

constexpr int RING_BYTES = 154624, LDSCTL_OFF = RING_BYTES, MISC_OFF = LDSCTL_OFF + 320, LDS_BYTES = 155648;
constexpr int NWAVES = 8, NTHREADS = 512;

DEV unsigned f2bf(float f) { unsigned u = __builtin_bit_cast(unsigned, f); return (u + 0x7fffu + ((u >> 16) & 1u)) >> 16; }
DEV float bf2f(unsigned b) { return __builtin_bit_cast(float, b << 16); }
DEV unsigned pk2(float lo, float hi) { return f2bf(lo) | (f2bf(hi) << 16); }
DEV float fexp(float x) { return fexp2(x * LOG2E); }
DEV float flog(float x) { return flog2(x) * LN2; }
DEV float sigm(float x) { return frcp(1.0f + fexp(-x)); }
DEV float logsig(float x) { return fminf(x, 0.f) - flog(1.0f + fexp(-fabsf(x))); }
DEV float wave_sum(float v) {
#pragma unroll
    for (int o = 1; o < 64; o <<= 1) v += __shfl_xor(v, o);
    return v;
}

namespace pg8 {
constexpr int BM = 256, BK = 64, HALF = 128, HTB = HALF * BK * 2, STAGE_BYTES = 8 * HTB, NXCD = 8, WGM = 8;
DEV int lds_byte(int r, int c) { const int st = (r >> 4) * 2 + (c >> 5), rr = r & 15, cc = c & 31, ob = rr * 64 + cc * 2; return st * 1024 + (ob ^ (((ob >> 9) & 1) << 5)); }
DEV void stage_rc(int b, int& R, int& C) { const int st = b / 1024, sb = b % 1024, swz = sb ^ (((sb >> 9) & 1) << 5); R = (st >> 1) * 16 + swz / 64; C = (st & 1) * 32 + (swz % 64) / 2; }
DEV int perm32(int rho) { const int n = rho >> 4, i = rho & 15; return 8 * (i >> 2) + 4 * n + (i & 3); }
struct Unit { int pm, pn; };
struct Gemm { const bf16* A; const bf16* Bt; int M, N, K; };
struct StaticOrder {
    int nM, nN, nwg, G, c;
    DEV void init(int M_, int N_, int G_, int c_) { nM = M_ / BM; nN = N_ / BM; nwg = nM * nN; G = G_; c = c_; }
    DEV bool next(int i, Unit& u) const {
        const long L = (long)i * G + c; if (L >= nwg) return false;
        int wgid = (int)L; { const int q = nwg / NXCD, r = nwg % NXCD, xcd = wgid % NXCD, off = wgid / NXCD; wgid = (xcd < r ? xcd * (q + 1) : r * (q + 1) + (xcd - r) * q) + off; }
        const int nig = WGM * nN, gid = wgid / nig, fm = gid * WGM, gsz = (nM - fm) < WGM ? (nM - fm) : WGM;
        u.pm = fm + ((wgid % nig) % gsz); u.pn = (wgid % nig) / gsz; return true;
    }
};
template <class Epi, class Sched, bool ALIGN_EPI = false, bool SP2 = false, int ESZ = 2>
DEV void gemm_phase(ldsp lds, const Gemm g, const Sched& S, const Epi& E) {
    const int tid = threadIdx.x, wid = RFL(tid >> 6), lane = tid & 63, wr = wid >> 2, wc = wid & 3, fr = lane & 15, fq = lane >> 4;
    const int K = g.K * ESZ / 2, nt = K / BK;
    unsigned voffA[2], voffB[2];
#pragma unroll
    for (int i = 0; i < 2; ++i) { int R, C; stage_rc(tid * 16 + i * 8192, R, C); const int Rb = Epi::PERM ? ((R & ~31) + perm32(R & 31)) : R;
        voffA[i] = (unsigned)(R * K + C) * 2u; voffB[i] = (unsigned)(Rb * K + C) * 2u; }
    const size_t kstep = (size_t)(BK * 2);
    const size_t hstep = (size_t)HALF * K * 2;
    const size_t tstep = 2 * hstep;
    const unsigned ldsw = (unsigned)wid * 1024u;
    int aoffk[2], boffk[2];
#pragma unroll
    for (int k = 0; k < 2; ++k) { const int ch = ESZ == 2 ? fq + 4 * k : 2 * fq + k;
        aoffk[k] = lds_byte(wr * 64 + fr, (ch & 3) * 8) + (ch >> 2) * 1024; boffk[k] = lds_byte(wc * 32 + fr, (ch & 3) * 8) + (ch >> 2) * 1024; }
#define PG8_SA(b, h) (((b) * 2 + (h)) * HTB)
#define PG8_SB(b, h) ((4 + (b) * 2 + (h)) * HTB)
#define PG8_STAGE(bufoff, gbase, voff) do { _Pragma("unroll") for (int _i = 0; _i < 2; ++_i) \
        GLDS16((const char*)(gbase) + (voff)[_i], lds + (bufoff) + ldsw + _i * 8192); } while (0)
#define PG8_LDA(dst, b, h) do { _Pragma("unroll") for (int m = 0; m < 4; ++m) { if constexpr (ESZ == 2) { _Pragma("unroll") for (int k = 0; k < 2; ++k) dst[m][k] = *(const LAS bf16x8*)(lds + PG8_SA(b, h) + aoffk[k] + m * 2048); } \
        else dst##8[m] = __builtin_shufflevector(*(const LAS v4i_t*)(lds + PG8_SA(b, h) + aoffk[0] + m * 2048), *(const LAS v4i_t*)(lds + PG8_SA(b, h) + aoffk[1] + m * 2048), 0, 1, 2, 3, 4, 5, 6, 7); } } while (0)
#define PG8_LDB(dst, b, h) do { _Pragma("unroll") for (int n = 0; n < 2; ++n) { if constexpr (ESZ == 2) { _Pragma("unroll") for (int k = 0; k < 2; ++k) dst[n][k] = *(const LAS bf16x8*)(lds + PG8_SB(b, h) + boffk[k] + n * 2048); } \
        else dst##8[n] = __builtin_shufflevector(*(const LAS v4i_t*)(lds + PG8_SB(b, h) + boffk[0] + n * 2048), *(const LAS v4i_t*)(lds + PG8_SB(b, h) + boffk[1] + n * 2048), 0, 1, 2, 3, 4, 5, 6, 7); } } while (0)
#define PG8_MMA(ai, bj, At, Bt) do { SETPRIO(1); _Pragma("unroll") for (int m = 0; m < 4; ++m) _Pragma("unroll") for (int n = 0; n < 2; ++n) { \
        if constexpr (ESZ == 2) { _Pragma("unroll") for (int k = 0; k < 2; ++k) acc[ai][bj][m][n] = MFMA16(Bt[n][k], At[m][k], acc[ai][bj][m][n]); } \
        else acc[ai][bj][m][n] = mfma8(Bt##8[n], At##8[m], acc[ai][bj][m][n], sc8); } SETPRIO(0); } while (0)
    int sc8 = 0x7f7f7f7f; OPAQUE(sc8);
    Unit cur, nxt; int ui = 0;
    if (!S.next(0, cur)) return;
    f32x4 acc[2][2][4][2];
#pragma unroll
    for (int a = 0; a < 2; ++a)
#pragma unroll
        for (int b = 0; b < 2; ++b)
#pragma unroll
            for (int m = 0; m < 4; ++m)
#pragma unroll
                for (int n = 0; n < 2; ++n) acc[a][b][m][n] = (f32x4){0.f, 0.f, 0.f, 0.f};
    bf16x8 At[ESZ == 2 ? 4 : 1][2], B0[ESZ == 2 ? 2 : 1][2], B1[ESZ == 2 ? 2 : 1][2];
    v8i_t At8[ESZ == 1 ? 4 : 1], B08[ESZ == 1 ? 2 : 1], B18[ESZ == 1 ? 2 : 1];
    const char* cA = (const char*)g.A + (size_t)cur.pm * tstep; const char* cB = (const char*)g.Bt + (size_t)cur.pn * tstep;
    if constexpr (SP2) {
        PG8_STAGE(PG8_SB(0, 0), cB, voffB); PG8_STAGE(PG8_SB(0, 1), cB + hstep, voffB); PG8_STAGE(PG8_SA(0, 0), cA, voffA); PG8_STAGE(PG8_SA(0, 1), cA + hstep, voffA);
        if (wr == 1) RAW_BAR();
        WAIT_V(2); RAW_BAR();
        PG8_STAGE(PG8_SB(1, 0), cB + kstep, voffB); PG8_STAGE(PG8_SA(1, 0), cA + kstep, voffA); PG8_STAGE(PG8_SB(1, 1), cB + hstep + kstep, voffB);
        WAIT_V(6); RAW_BAR();
    } else {
        PG8_STAGE(PG8_SB(0, 0), cB, voffB); PG8_STAGE(PG8_SA(0, 0), cA, voffA); PG8_STAGE(PG8_SB(0, 1), cB + hstep, voffB); PG8_STAGE(PG8_SA(0, 1), cA + hstep, voffA);
        if (wr == 1) RAW_BAR();
        WAIT_V(4); RAW_BAR();
        PG8_STAGE(PG8_SB(1, 0), cB + kstep, voffB); PG8_STAGE(PG8_SA(1, 0), cA + kstep, voffA); PG8_STAGE(PG8_SB(1, 1), cB + hstep + kstep, voffB);
        WAIT_V(6); RAW_BAR();
    }
    for (;;) {
        const bool has_next = S.next(ui + 1, nxt);
        const char* nA = has_next ? (const char*)g.A + (size_t)nxt.pm * tstep : cA; const char* nB = has_next ? (const char*)g.Bt + (size_t)nxt.pn * tstep : cB;
        for (int t = 0; t < nt; t += 2) {
            const bool last = (t == nt - 2);
            const char* a1 = cA + (size_t)(t + 1) * kstep;
            const char* a2 = last ? nA : cA + (size_t)(t + 2) * kstep; const char* b2 = last ? nB : cB + (size_t)(t + 2) * kstep;
            const char* a3 = a2 + kstep; const char* b3 = b2 + kstep;
            if constexpr (SP2) {
            PG8_LDB(B0, 0, 0); PG8_LDB(B1, 0, 1); SCHED_BAR(); PG8_LDA(At, 0, 0); PG8_STAGE(PG8_SA(1, 1), a1 + hstep, voffA);
            WAIT_V(8); WAIT_L(0); RAW_BAR(); PG8_MMA(0, 0, At, B0); PG8_MMA(0, 1, At, B1); RAW_BAR(); SCHED_BAR();
            PG8_LDA(At, 0, 1); PG8_STAGE(PG8_SB(0, 0), b2, voffB); PG8_STAGE(PG8_SB(0, 1), b2 + hstep, voffB); PG8_STAGE(PG8_SA(0, 0), a2, voffA);
            WAIT_V(8); WAIT_L(0); RAW_BAR(); PG8_MMA(1, 0, At, B0); PG8_MMA(1, 1, At, B1); RAW_BAR(); SCHED_BAR();
            PG8_LDB(B0, 1, 0); PG8_LDB(B1, 1, 1); SCHED_BAR(); PG8_LDA(At, 1, 0); PG8_STAGE(PG8_SA(0, 1), a2 + hstep, voffA);
            WAIT_V(8); WAIT_L(0); RAW_BAR(); PG8_MMA(0, 0, At, B0); PG8_MMA(0, 1, At, B1); RAW_BAR(); SCHED_BAR();
            PG8_LDA(At, 1, 1); PG8_STAGE(PG8_SB(1, 0), b3, voffB); PG8_STAGE(PG8_SB(1, 1), b3 + hstep, voffB); PG8_STAGE(PG8_SA(1, 0), a3, voffA);
            WAIT_V(8); WAIT_L(0); RAW_BAR(); PG8_MMA(1, 0, At, B0); PG8_MMA(1, 1, At, B1); RAW_BAR(); SCHED_BAR();
            } else {
            PG8_LDB(B0, 0, 0); SCHED_BAR(); PG8_LDA(At, 0, 0); PG8_STAGE(PG8_SA(1, 1), a1 + hstep, voffA);
            WAIT_L(8); RAW_BAR(); WAIT_L(0); PG8_MMA(0, 0, At, B0); RAW_BAR(); SCHED_BAR();
            PG8_LDB(B1, 0, 1); PG8_STAGE(PG8_SB(0, 0), b2, voffB);
            RAW_BAR(); WAIT_L(0); PG8_MMA(0, 1, At, B1); RAW_BAR();
            PG8_LDA(At, 0, 1); PG8_STAGE(PG8_SA(0, 0), a2, voffA);
            RAW_BAR(); WAIT_L(0); PG8_MMA(1, 0, At, B0); RAW_BAR(); SCHED_BAR();
            PG8_STAGE(PG8_SB(0, 1), b2 + hstep, voffB);
            WAIT_V(6); RAW_BAR(); PG8_MMA(1, 1, At, B1); RAW_BAR();
            PG8_LDB(B0, 1, 0); SCHED_BAR(); PG8_LDA(At, 1, 0); PG8_STAGE(PG8_SA(0, 1), a2 + hstep, voffA);
            WAIT_L(8); RAW_BAR(); WAIT_L(0); PG8_MMA(0, 0, At, B0); RAW_BAR(); SCHED_BAR();
            PG8_LDB(B1, 1, 1); PG8_STAGE(PG8_SB(1, 0), b3, voffB);
            RAW_BAR(); WAIT_L(0); PG8_MMA(0, 1, At, B1); RAW_BAR();
            PG8_LDA(At, 1, 1); PG8_STAGE(PG8_SA(1, 0), a3, voffA);
            RAW_BAR(); WAIT_L(0); PG8_MMA(1, 0, At, B0); RAW_BAR(); SCHED_BAR();
            PG8_STAGE(PG8_SB(1, 1), b3 + hstep, voffB);
            WAIT_V(6); RAW_BAR(); PG8_MMA(1, 1, At, B1); RAW_BAR();
            }
        }
        if constexpr (ALIGN_EPI) { if (wr == 0) RAW_BAR(); }
        if constexpr (ESZ == 1) { MFMA_DRAIN();
#pragma unroll
            for (int a = 0; a < 2; ++a)
#pragma unroll
                for (int b = 0; b < 2; ++b) asm volatile("" : "+v"(acc[a][b][0][0]), "+v"(acc[a][b][0][1]), "+v"(acc[a][b][1][0]), "+v"(acc[a][b][1][1]), "+v"(acc[a][b][2][0]), "+v"(acc[a][b][2][1]), "+v"(acc[a][b][3][0]), "+v"(acc[a][b][3][1])); }
        E(acc, cur, wr, wc, fr, fq);
        if (!has_next) break;
#pragma unroll
        for (int a = 0; a < 2; ++a)
#pragma unroll
            for (int b = 0; b < 2; ++b)
#pragma unroll
                for (int m = 0; m < 4; ++m)
#pragma unroll
                    for (int n = 0; n < 2; ++n) acc[a][b][m][n] = (f32x4){0.f, 0.f, 0.f, 0.f};
        cur = nxt; cA = nA; cB = nB; ++ui;
        if constexpr (ALIGN_EPI) { if (wr == 1) RAW_BAR(); }
    }
    WAIT_V(0);
    if constexpr (!ALIGN_EPI) { if (wr == 0) RAW_BAR(); }
    RAW_BAR();
#undef PG8_SA
#undef PG8_SB
#undef PG8_STAGE
#undef PG8_LDA
#undef PG8_LDB
#undef PG8_MMA
}
}

struct EpiP {
    static constexpr bool PERM = true;
    bf16* O;
    DEV void operator()(const f32x4 (&acc)[2][2][4][2], const pg8::Unit& u, int wr, int wc, int fr, int fq) const {
        const int row0 = u.pm * 256 + wr * 64 + fr, col0 = u.pn * 256 + wc * 32 + 8 * fq;
#pragma unroll
        for (int ai = 0; ai < 2; ++ai)
#pragma unroll
            for (int m = 0; m < 4; ++m) { const size_t row = (size_t)(row0 + ai * 128 + m * 16);
#pragma unroll
                for (int bj = 0; bj < 2; ++bj) { const f32x4 v0 = acc[ai][bj][m][0], v1 = acc[ai][bj][m][1];
                    u32x4 w; w.x = cvt_pk_bf16(v0[0], v0[1]); w.y = cvt_pk_bf16(v0[2], v0[3]); w.z = cvt_pk_bf16(v1[0], v1[1]); w.w = cvt_pk_bf16(v1[2], v1[3]);
                    *(u32x4*)(O + p_off(row, col0 + bj * 128)) = w; } }
    }
};
struct EpiP8 {
    static constexpr bool PERM = true;
    bf16* O;
    DEV void operator()(const f32x4 (&acc)[2][2][4][2], const pg8::Unit& u, int wr, int wc, int fr, int fq) const {
        const int row0 = u.pm * 256 + wr * 64 + fr, col0 = NPM + u.pn * 256 + wc * 32 + 8 * fq;
#pragma unroll
        for (int ai = 0; ai < 2; ++ai)
#pragma unroll
            for (int m = 0; m < 4; ++m) { const size_t row = (size_t)(row0 + ai * 128 + m * 16);
#pragma unroll
                for (int bj = 0; bj < 2; ++bj) { const f32x4 v0 = acc[ai][bj][m][0] * G8_DESCALE, v1 = acc[ai][bj][m][1] * G8_DESCALE;
                    u32x4 w; w.x = cvt_pk_bf16(v0[0], v0[1]); w.y = cvt_pk_bf16(v0[2], v0[3]); w.z = cvt_pk_bf16(v1[0], v1[1]); w.w = cvt_pk_bf16(v1[2], v1[3]);
                    *(u32x4*)(O + p_off(row, col0 + bj * 128)) = w; } }
    }
};
struct SchedUp {
    pg8::StaticOrder so;
    DEV bool next(int i, pg8::Unit& u) const { if (!so.next(i >> 1, u)) return false; if (i & 1) { u.pm += M / 256; u.pn += D / 256; } return true; }
};
struct EpiUp {
    static constexpr bool PERM = true;
    bf16* Y; const bf16* P;
    DEV void operator()(const f32x4 (&acc)[2][2][4][2], const pg8::Unit& u, int wr, int wc, int fr, int fq) const {
        const int br = u.pm >= M / 256 ? 1 : 0, pm = u.pm - br * (M / 256), pn = u.pn - br * (D / 256);
        const int row0 = pm * 256 + wr * 64 + fr, col0 = pn * 256 + wc * 32 + 8 * fq, gcol = (br ? C_GB : C_GA) + col0;
#pragma unroll
        for (int ai = 0; ai < 2; ++ai)
#pragma unroll
            for (int m = 0; m < 4; ++m) { const size_t row = (size_t)(row0 + ai * 128 + m * 16);
#pragma unroll
                for (int bj = 0; bj < 2; ++bj) {
                    const u32x4 g8 = *(const u32x4*)(P + p_off(row, gcol + bj * 128));
                    bf16* yp = Y + row * D + col0 + bj * 128;
                    u32x4 y8 = (u32x4){0u, 0u, 0u, 0u}; if (br) y8 = *(const u32x4*)yp;
                    const f32x4 v0 = acc[ai][bj][m][0], v1 = acc[ai][bj][m][1];
                    float o[8];
#pragma unroll
                    for (int k = 0; k < 8; ++k) { const unsigned gw = g8[k >> 1], yw = y8[k >> 1]; const float gv = bf2f((k & 1) ? (gw >> 16) : (gw & 0xffffu)), yv = bf2f((k & 1) ? (yw >> 16) : (yw & 0xffffu));
                        const float a = k < 4 ? v0[k & 3] : v1[k & 3]; o[k] = yv + sigm(gv) * a; }
                    u32x4 w; w.x = cvt_pk_bf16(o[0], o[1]); w.y = cvt_pk_bf16(o[2], o[3]); w.z = cvt_pk_bf16(o[4], o[5]); w.w = cvt_pk_bf16(o[6], o[7]);
                    *(u32x4*)yp = w; } }
    }
};
struct EpiOut {
    static constexpr bool PERM = true;
    bf16* C; float* RSS;
    DEV void operator()(const f32x4 (&acc)[2][2][4][2], const pg8::Unit& u, int wr, int wc, int fr, int fq) const {
        const int row0 = u.pm * 256 + wr * 64 + fr, col0 = u.pn * 256 + wc * 32 + 8 * fq;
#pragma unroll
        for (int ai = 0; ai < 2; ++ai)
#pragma unroll
            for (int m = 0; m < 4; ++m) { const size_t row = (size_t)(row0 + ai * 128 + m * 16); bf16* rowp = C + row * D + col0; float ss = 0.f;
#pragma unroll
                for (int bj = 0; bj < 2; ++bj) { const f32x4 v0 = acc[ai][bj][m][0], v1 = acc[ai][bj][m][1];
                    ss += ((v0[0] * v0[0] + v0[1] * v0[1]) + (v0[2] * v0[2] + v0[3] * v0[3])) + ((v1[0] * v1[0] + v1[1] * v1[1]) + (v1[2] * v1[2] + v1[3] * v1[3]));
                    u32x4 w; w.x = cvt_pk_bf16(v0[0], v0[1]); w.y = cvt_pk_bf16(v0[2], v0[3]); w.z = cvt_pk_bf16(v1[0], v1[1]); w.w = cvt_pk_bf16(v1[2], v1[3]);
                    *(u32x4*)(rowp + bj * 128) = w; }
                ss += __shfl_xor(ss, 16); ss += __shfl_xor(ss, 32);
                if (fq == 0) RSS[row * NRS + u.pn * 4 + wc] = ss; }
    }
};

#ifndef EMU
typedef GAS unsigned gu32;
#define RLX_AGENT __ATOMIC_RELAXED, __HIP_MEMORY_SCOPE_AGENT
#define XB_TMO      128
#define XB_XCNT(j)  (256  + 64 * (j))
#define XB_XSUB(j)  (1280 + 64 * (j))
#define XB_XGEN(j)  (2304 + 64 * (j))
#define XB_TOP      3328
#define XB_TOPGEN   3392
#define XCD_BAR_WORDS 3456
#define XB_SPIN_CAP (1u << 22)
__device__ __forceinline__ unsigned xb_ld(unsigned* p)              { return __hip_atomic_load(p, __ATOMIC_RELAXED, __HIP_MEMORY_SCOPE_AGENT); }
__device__ __forceinline__ unsigned xb_add(unsigned* p, unsigned v) { return __hip_atomic_fetch_add(p, v, __ATOMIC_RELAXED, __HIP_MEMORY_SCOPE_AGENT); }
__device__ __forceinline__ unsigned xb_xcc_id() { return (unsigned)__builtin_amdgcn_s_getreg((3 << 11) | 20) & 0xFu; }
#define XB_SPIN(cond, bar) do { unsigned _sp = 0; while (cond) { __builtin_amdgcn_s_sleep(1); \
    if ((++_sp & 255u) == 0u) { if (xb_ld(&(bar)[XB_TMO])) break; if (_sp > XB_SPIN_CAP) { atomicAdd(&(bar)[XB_TMO], 1u); break; } } } } while (0)
struct XcdBarrier { unsigned* bar; unsigned x; volatile LAS unsigned* st; };
__device__ __forceinline__ XcdBarrier xcd_barrier_post(unsigned* bar, volatile LAS unsigned* st) {
    XcdBarrier b; b.bar = bar; b.x = xb_xcc_id(); b.st = st;
    if (threadIdx.x == 0) (void)xb_add(&bar[XB_XCNT(b.x)], 1u);
    return b;
}
__device__ __forceinline__ void xcd_barrier_complete(unsigned* bar, unsigned x, unsigned& nloc, unsigned& nx) {
    const unsigned G = gridDim.x * gridDim.y * gridDim.z;
    unsigned sum, cnt, mine, sp = 0u;
    for (;;) {
        sum = 0u; cnt = 0u; mine = 0u;
#pragma unroll
        for (unsigned j = 0; j < 16; ++j) { const unsigned c = xb_ld(&bar[XB_XCNT(j)]); sum += c; cnt += (c > 0u) ? 1u : 0u; mine = (j == x) ? c : mine; }
        if (sum == G) break;
        __builtin_amdgcn_s_sleep(1);
        if ((++sp & 255u) == 0u) { if (xb_ld(&bar[XB_TMO])) break; if (sp > XB_SPIN_CAP) { atomicAdd(&bar[XB_TMO], 1u); break; } }
    }
    nloc = mine > 0u ? mine : 1u; nx = cnt > 0u ? cnt : 1u;
}
__device__ __forceinline__ void xcd_barrier(const XcdBarrier& b) {
    asm volatile("s_waitcnt vmcnt(0)" ::: "memory");
    __syncthreads();
    if (threadIdx.x == 0) {
        unsigned* bar = b.bar;
        __builtin_amdgcn_s_waitcnt(0);
        unsigned nloc = b.st[0], nx = b.st[1];
        if (nloc == 0u) { xcd_barrier_complete(bar, b.x, nloc, nx); b.st[0] = nloc; b.st[1] = nx; }
        const unsigned old = xb_add(&bar[XB_XSUB(b.x)], 1u);
        const unsigned gen = old / nloc;
        if (old + 1u == (gen + 1u) * nloc) {
            __builtin_amdgcn_fence(__ATOMIC_RELEASE, "agent");
            asm volatile("s_waitcnt vmcnt(0)" ::: "memory");
            const unsigned og = xb_add(&bar[XB_TOP], 1u);
            const unsigned tg = og / nx;
            if (og + 1u == (tg + 1u) * nx) xb_add(&bar[XB_TOPGEN], 1u);
            else XB_SPIN(xb_ld(&bar[XB_TOPGEN]) == tg, bar);
            __builtin_amdgcn_fence(__ATOMIC_ACQUIRE, "agent");
            xb_add(&bar[XB_XGEN(b.x)], 1u);
            asm volatile("s_waitcnt vmcnt(0)" ::: "memory");
        } else {
            XB_SPIN(xb_ld(&bar[XB_XGEN(b.x)]) == gen, bar);
            __builtin_amdgcn_fence(__ATOMIC_ACQUIRE, "agent");
            asm volatile("s_waitcnt vmcnt(0)" ::: "memory");
        }
    }
    __syncthreads();
}
#endif

struct Args { const float* in[14]; float* out; unsigned char* ws; int ph_lo, ph_hi; };

DEV float clamp8(float x) { return fminf(fmaxf(x, -448.0f), 448.0f); }
struct P0Desc { const float* W; void* WT; int ldw, K, k0, c0, r0, nv, fp8; };
DEV void p0_load(const P0Desc& d, int lane, f32x4 (&v)[16]) {
    const int kr = lane >> 4, n4 = 4 * (lane & 15);
#pragma unroll
    for (int i = 0; i < 16; ++i) v[i] = (n4 < d.nv) ? *(const f32x4*)(d.W + (size_t)(d.k0 + 4 * i + kr) * d.ldw + d.c0 + n4) : (f32x4){0.f, 0.f, 0.f, 0.f};
}
DEV void p0_store(const P0Desc& d, const f32x4 (&v)[16], ldsp scr, int lane) {
    const int kr = lane >> 4, n4 = 4 * (lane & 15);
#pragma unroll
    for (int i = 0; i < 16; ++i) LDS_WR(f32x4, scr + ((4 * i + kr) * 68 + n4) * 4, v[i]);
    WAVE_SYNC();
    if (!d.fp8) {
        bf16* WT = (bf16*)d.WT;
        const int c = lane & 7;
#pragma unroll
        for (int j = 0; j < 8; ++j) { const int n = (lane >> 3) + 8 * j; ldsp sp = scr + ((8 * c) * 68 + n) * 4;
            u32x4 o; o.x = pk2(LDS_RD(float, sp + 0 * 272), LDS_RD(float, sp + 1 * 272)); o.y = pk2(LDS_RD(float, sp + 2 * 272), LDS_RD(float, sp + 3 * 272));
            o.z = pk2(LDS_RD(float, sp + 4 * 272), LDS_RD(float, sp + 5 * 272)); o.w = pk2(LDS_RD(float, sp + 6 * 272), LDS_RD(float, sp + 7 * 272));
            if (n < d.nv) *(u32x4*)(WT + (size_t)(d.r0 + n) * d.K + d.k0 + 8 * c) = o; }
    } else {
        unsigned char* WT = (unsigned char*)d.WT;
        const int c = lane & 3;
#pragma unroll
        for (int j = 0; j < 4; ++j) { const int n = (lane >> 2) + 16 * j; ldsp sp = scr + ((16 * c) * 68 + n) * 4; float f[16];
#pragma unroll
            for (int i = 0; i < 16; ++i) f[i] = clamp8(LDS_RD(float, sp + i * 272) * W8_SCALE);
            u32x4 o; o.x = pk_fp8x4(f[0], f[1], f[2], f[3]); o.y = pk_fp8x4(f[4], f[5], f[6], f[7]); o.z = pk_fp8x4(f[8], f[9], f[10], f[11]); o.w = pk_fp8x4(f[12], f[13], f[14], f[15]);
            if (n < d.nv) *(u32x4*)(WT + (size_t)(d.r0 + n) * d.K + d.k0 + 16 * c) = o; }
    }
    WAVE_SYNC();
}

constexpr int MS = 272, MS64 = 144;
constexpr int NUA = NB * HA * NCH, NUB = NB * HB * NCH;
constexpr size_t TW_QA = 0, TW_KA = TW_QA + (size_t)NUA * 16384, TW_PA = TW_KA + (size_t)NUA * 16384, TW_VA = TW_PA + (size_t)NUA * 8192, TW_ENDA = TW_VA + (size_t)NUA * 2048;
constexpr size_t TW_QB = 0, TW_KB = TW_QB + (size_t)NUB * 16384, TW_PB = TW_KB + (size_t)NUB * 16384, TW_SB = TW_PB + (size_t)NUB * 8192, TW_ENDB = TW_SB + (size_t)NUB * 2048;
static_assert(TW_ENDA <= (size_t)(NP + 16) * D * 2 && TW_ENDB <= (size_t)M * D * 2, "operand tiles must fit the dead W1T / h regions");
DEV int swz(int row, int chunk) { return row * 256 + ((chunk ^ (row & 15)) << 4); }
DEV int swz64(int row, int chunk) { return row * 128 + ((chunk ^ (row & 7)) << 4); }
DEV bf16x8 frag16p(ldsp img, int row0, int ks, int lane) { return LDS_RD(bf16x8, img + swz64(row0 + (lane & 15), 4 * ks + (lane >> 4))); }

DEV bf16x8 frag16(ldsp buf, int stride, int row0, int ks, int lane) { return LDS_RD(bf16x8, buf + (row0 + (lane & 15)) * stride + ks * 64 + (lane >> 4) * 16); }
DEV bf16x8 frag16s(ldsp img, int row0, int ks, int lane) { return LDS_RD(bf16x8, img + swz(row0 + (lane & 15), 4 * ks + (lane >> 4))); }
DEV bf16x8 frag8x2s(ldsp img, int row0, int ks, int lane) {
    const int row = row0 + (lane & 15), q = lane >> 4;
    const bf16x4 lo = LDS_RD(bf16x4, img + swz(row, 4 * ks + (q >> 1)) + (q & 1) * 8), hi = LDS_RD(bf16x4, img + swz(row, 4 * ks + 2 + (q >> 1)) + (q & 1) * 8);
    return (bf16x8){lo[0], lo[1], lo[2], lo[3], hi[0], hi[1], hi[2], hi[3]};
}
DEV bf16x8 frag_tr(ldsp img, int n0, int ks, int lane, int stride = 256) {
    ldsp p = img + (32 * ks + 8 * (lane >> 4) + ((lane & 15) >> 2)) * stride + (n0 + 4 * (lane & 3)) * 2;
    const bf16x4 lo = lds_tr16(p), hi = lds_tr16(p + 4 * stride);
    return (bf16x8){lo[0], lo[1], lo[2], lo[3], hi[0], hi[1], hi[2], hi[3]};
}
DEV bf16x8 frag_trs(ldsp img, int n0, int ks, int lane) {
    const int row = 32 * ks + 8 * (lane >> 4) + ((lane & 15) >> 2), p = lane & 3, ch = (n0 >> 3) + (p >> 1);
    const bf16x4 lo = lds_tr16(img + swz(row, ch) + (p & 1) * 8), hi = lds_tr16(img + swz(row + 4, ch) + (p & 1) * 8);
    return (bf16x8){lo[0], lo[1], lo[2], lo[3], hi[0], hi[1], hi[2], hi[3]};
}
DEV void dma_lin(const void* src, int ninst, ldsp dst, int wave, int lane) {
    for (int i = wave; i < ninst; i += NWAVES) GLDS16X((const char*)src + i * 1024 + 16 * lane, dst + i * 1024);
}
DEV float sigm2(float x) { return frcp(1.0f + fexp2(-LOG2E * x)); }
DEV u32x2 pack4(const f32x4 v) { u32x2 w; w.x = cvt_pk_bf16(v[0], v[1]); w.y = cvt_pk_bf16(v[2], v[3]); return w; }

DEV float scan_add(float v, int lane) {
#pragma unroll
    for (int o = 1; o < 64; o <<= 1) { const float t = __shfl_up(v, o); if (lane >= o) v += t; }
    return v;
}
DEV float scan_max(float v, int lane) {
#pragma unroll
    for (int o = 1; o < 64; o <<= 1) { const float t = __shfl_up(v, o); if (lane >= o) v = fmaxf(v, t); }
    return v;
}

constexpr int PA_RAW = 0, PA_RAWSZ = 2 * 68 * 256, PA_TOT = 2 * PA_RAWSZ, PA_IQ = PA_TOT + 8 * 128 * 4, PA_IK = PA_IQ + 16384, PA_SC = PA_IK + 16384, PA_END = PA_SC + 1024;
static_assert(PA_END <= RING_BYTES, "P2 LDS");
DEV void p2_issue(const Args& args, int u, ldsp raw, int wave, int lane) {
    const bf16* P = (const bf16*)(args.ws + WS_P);
    if (u < NUA) { const int bh = u / NCH, j = u % NCH, b = bh / HA, h = bh % HA; const size_t tok0 = (size_t)b * SEQ + 64 * j;
        dma_lin(P + p_off(tok0, C_QA + h * 128), 16, raw, wave, lane); dma_lin(P + p_off(tok0, C_FA + h * 128), 16, raw + 68 * 256, wave, lane); }
    else { const int ub = u - NUA, bh = ub / NCH, j = ub % NCH, b = bh / HB, h = bh % HB; const size_t tok0 = (size_t)b * SEQ + 64 * j;
        dma_lin(P + p_off(tok0, C_QB + h * 128) - 3 * 128, 17, raw, wave, lane); dma_lin(P + p_off(tok0, C_KB + h * 128) - 3 * 128, 17, raw + 68 * 256, wave, lane); }
}
DEV void p2_scores(ldsp lds, f32x4 (&sc)[2], int wave, int lane) {
    const int ct = wave >> 1, st0 = 2 * (wave & 1);
    sc[0] = (f32x4){0.f, 0.f, 0.f, 0.f}; sc[1] = (f32x4){0.f, 0.f, 0.f, 0.f};
#pragma unroll
    for (int ks = 0; ks < 4; ++ks) { const bf16x8 qf = frag16s(lds + PA_IQ, 16 * ct, ks, lane);
#pragma unroll
        for (int n = 0; n < 2; ++n) { const bf16x8 kf_ = frag16s(lds + PA_IK, 16 * (st0 + n), ks, lane); sc[n] = MFMA16(kf_, qf, sc[n]); } }
}
DEV void p2_unit(const Args& args, ldsp lds, int u, ldsp raw, int wave, int lane) {
    unsigned char* TW = args.ws + WS_W1T;
    const int q4 = lane >> 4, l15 = lane & 15;
    if (u < NUA) {
        const int bh = u / NCH, h = bh % HA;
        const float* lbl = args.in[3];
        float lbv[2];
#pragma unroll
        for (int e = 0; e < 2; ++e) { const int col = h * 128 + 2 * lane + e; lbv[e] = frcp(1.0f + fexp(lbl[DA + col] - lbl[col])); }
        float lf[8][2], qv[8][2], kv[8][2];
#pragma unroll
        for (int c = 0; c < 8; ++c) { const unsigned qw = LDS_RD(unsigned, raw + (8 * wave + c) * 256 + lane * 4), fw = LDS_RD(unsigned, raw + 68 * 256 + (8 * wave + c) * 256 + lane * 4);
#pragma unroll
            for (int e = 0; e < 2; ++e) { const float f = lbv[e] + (1.0f - lbv[e]) * sigm2(__builtin_bit_cast(float, e ? (fw & 0xffff0000u) : (fw << 16))); lf[c][e] = flog2(f); kv[c][e] = 1.0f - f; qv[c][e] = __builtin_bit_cast(float, e ? (qw & 0xffff0000u) : (qw << 16)); } }
#pragma unroll
        for (int c = 1; c < 8; ++c) { lf[c][0] += lf[c - 1][0]; lf[c][1] += lf[c - 1][1]; }
        LDS_WR(f32x2, lds + PA_TOT + (wave * 128 + 2 * lane) * 4, ((f32x2){lf[7][0], lf[7][1]}));
        MIX_BAR();
        f32x2 off = (f32x2){0.f, 0.f}, bmid = (f32x2){0.f, 0.f}, g = (f32x2){0.f, 0.f};
#pragma unroll
        for (int w = 0; w < 8; ++w) { const f32x2 t = LDS_RD(f32x2, lds + PA_TOT + (w * 128 + 2 * lane) * 4); if (w < wave) off += t; if (w < 4) bmid += t; g += t; }
        if (wave == 0) { float* vec = (float*)(TW + TW_VA + (size_t)u * 2048) + 2 * lane;
            *(f32x2*)vec = (f32x2){fexp2(bmid[0]), fexp2(bmid[1])}; *(f32x2*)(vec + 128) = (f32x2){fexp2(g[0]), fexp2(g[1])}; *(f32x2*)(vec + 256) = (f32x2){fexp2(g[0] - bmid[0]), fexp2(g[1] - bmid[1])}; }
        unsigned qr8[8], kr8[8];
#pragma unroll
        for (int c = 0; c < 8; ++c) { float qr[2], kk[2]; const int r = 8 * wave + c;
#pragma unroll
            for (int e = 0; e < 2; ++e) { const float t1 = lf[c][e] + off[e] - bmid[e]; qr[e] = qv[c][e] * fexp2(t1); kk[e] = kv[c][e] * fexp2(-t1); }
            qr8[c] = cvt_pk_bf16(qr[0], qr[1]); kr8[c] = cvt_pk_bf16(kk[0], kk[1]);
            LDS_WR(unsigned, lds + PA_IQ + swz(r, lane >> 2) + (lane & 3) * 4, qr8[c]); LDS_WR(unsigned, lds + PA_IK + swz(r, lane >> 2) + (lane & 3) * 4, kr8[c]); }
        MIX_BAR();
        f32x4 sc[2]; p2_scores(lds, sc, wave, lane);
        unsigned char* tq = TW + TW_QA + (size_t)u * 16384; unsigned char* tk = TW + TW_KA + (size_t)u * 16384; unsigned char* tp = TW + TW_PA + (size_t)u * 8192;
#pragma unroll
        for (int c = 0; c < 8; ++c) { const int r = 8 * wave + c; *(unsigned*)(tq + swz(r, lane >> 2) + (lane & 3) * 4) = qr8[c]; *(unsigned*)(tk + swz(r, lane >> 2) + (lane & 3) * 4) = kr8[c]; }
#pragma unroll
        for (int n = 0; n < 2; ++n) { const int c = 16 * (wave >> 1) + l15, s0_ = 16 * (2 * (wave & 1) + n) + 4 * q4; f32x4 v = sc[n];
#pragma unroll
            for (int r = 0; r < 4; ++r) v[r] = (s0_ + r <= c) ? v[r] : 0.f;
            *(u32x2*)(tp + swz64(c, s0_ >> 3) + (q4 & 1) * 8) = pack4(v); }
    } else {
        const int ub = u - NUA, bh = ub / NCH, j = ub % NCH, b = bh / HB, h = bh % HB;
        const float* cw = args.in[4]; const float* cb = args.in[5];
        f32x2 wq[4], wk[4];
#pragma unroll
        for (int k = 0; k < 4; ++k) { wq[k] = *(const f32x2*)(cw + k * (2 * DQK) + h * 128 + 2 * lane); wk[k] = *(const f32x2*)(cw + k * (2 * DQK) + DQK + h * 128 + 2 * lane); }
        const f32x2 bq = *(const f32x2*)(cb + h * 128 + 2 * lane), bk = *(const f32x2*)(cb + DQK + h * 128 + 2 * lane);
        unsigned uq[11], uk[11];
#pragma unroll
        for (int i = 0; i < 11; ++i) { const bool neg = (64 * j + 8 * wave + i - 3) < 0;
            const unsigned a = LDS_RD(unsigned, raw + (8 * wave + i) * 256 + lane * 4), bb = LDS_RD(unsigned, raw + 68 * 256 + (8 * wave + i) * 256 + lane * 4); uq[i] = neg ? 0u : a; uk[i] = neg ? 0u : bb; }
        unsigned char* TWB = args.ws + WS_HB;
        float* sb = (float*)(TWB + TW_SB + (size_t)ub * 2048);
        if (wave == 0) {
            const size_t tok = (size_t)b * SEQ + 64 * j + lane; const float* SG = (const float*)(args.ws + WS_SG);
            const float fp = SG[tok * 16 + HB + h] + args.in[7][h], ig = SG[tok * 16 + h] + args.in[6][h];
            const float bc = scan_add(logsig(fp), lane), a = ig - bc, pm = scan_max(a, lane);
            sb[lane] = pm; sb[64 + lane] = bc;
            LDS_WR(float, lds + PA_SC + lane * 4, a * LOG2E); LDS_WR(float, lds + PA_SC + 256 + lane * 4, pm * LOG2E);
        }
        unsigned q8[8]; float kf[8][2];
#pragma unroll
        for (int c = 0; c < 8; ++c) { float qq[2]; const int r = 8 * wave + c;
#pragma unroll
            for (int e = 0; e < 2; ++e) { float yq = bq[e], yk = bk[e];
#pragma unroll
                for (int k = 0; k < 4; ++k) { yq += wq[k][e] * __builtin_bit_cast(float, e ? (uq[c + k] & 0xffff0000u) : (uq[c + k] << 16)); yk += wk[k][e] * __builtin_bit_cast(float, e ? (uk[c + k] & 0xffff0000u) : (uk[c + k] << 16)); }
                qq[e] = yq * sigm2(yq); kf[c][e] = yk * sigm2(yk) * 0.08838834764831845f; }
            q8[c] = cvt_pk_bf16(qq[0], qq[1]);
            LDS_WR(unsigned, lds + PA_IQ + swz(r, lane >> 2) + (lane & 3) * 4, q8[c]); LDS_WR(unsigned, lds + PA_IK + swz(r, lane >> 2) + (lane & 3) * 4, cvt_pk_bf16(kf[c][0], kf[c][1])); }
        MIX_BAR();
        const float pm63 = LDS_RD(float, lds + PA_SC + 256 + 63 * 4);
        unsigned kw8[8]; float na[2] = {0.f, 0.f};
#pragma unroll
        for (int c = 0; c < 8; ++c) { const float w_ = fexp2(LDS_RD(float, lds + PA_SC + (8 * wave + c) * 4) - pm63); const float k0 = w_ * kf[c][0], k1 = w_ * kf[c][1]; na[0] += k0; na[1] += k1; kw8[c] = cvt_pk_bf16(k0, k1); }
        LDS_WR(f32x2, lds + PA_TOT + (wave * 128 + 2 * lane) * 4, ((f32x2){na[0], na[1]}));
        f32x4 sc[2]; p2_scores(lds, sc, wave, lane);
        const int ct = wave >> 1, st0 = 2 * (wave & 1), c_ = 16 * ct + l15;
        const float pmc = LDS_RD(float, lds + PA_SC + 256 + c_ * 4); float rs = 0.f; u32x2 pw[2];
#pragma unroll
        for (int n = 0; n < 2; ++n) { const int s0_ = 16 * (st0 + n) + 4 * q4; const f32x4 as = LDS_RD(f32x4, lds + PA_SC + s0_ * 4); f32x4 v;
#pragma unroll
            for (int r = 0; r < 4; ++r) { const float t = fexp2(as[r] - pmc) * sc[n][r]; v[r] = (s0_ + r <= c_) ? t : 0.f; rs += v[r]; }
            pw[n] = pack4(v); }
        rs += __shfl_xor(rs, 16); rs += __shfl_xor(rs, 32);
        MIX_BAR();
        if (wave < 2) { const int dcol = wave * 64 + lane; float nl = 0.f;
#pragma unroll
            for (int w = 0; w < 8; ++w) nl += LDS_RD(float, lds + PA_TOT + (w * 128 + dcol) * 4);
            sb[256 + dcol] = nl; }
        if (q4 == 0) sb[128 + c_ * 2 + (wave & 1)] = rs;
        unsigned char* tq = TWB + TW_QB + (size_t)ub * 16384; unsigned char* tk = TWB + TW_KB + (size_t)ub * 16384; unsigned char* tp = TWB + TW_PB + (size_t)ub * 8192;
#pragma unroll
        for (int c = 0; c < 8; ++c) { const int r = 8 * wave + c; *(unsigned*)(tq + swz(r, lane >> 2) + (lane & 3) * 4) = q8[c]; *(unsigned*)(tk + swz(r, lane >> 2) + (lane & 3) * 4) = kw8[c]; }
#pragma unroll
        for (int n = 0; n < 2; ++n) { const int s0_ = 16 * (st0 + n) + 4 * q4; *(u32x2*)(tp + swz64(c_, s0_ >> 3) + (q4 & 1) * 8) = pw[n]; }
    }
}

constexpr int PB_BUFSZ = 51200, PB_Q = 0, PB_K = 16384, PB_V = 32768, PB_P = 40960, PB_VEC = 49152;
constexpr int PB_XS = 2 * PB_BUFSZ, PB_SM = PB_XS + 2 * 16384;
constexpr int SM_SSQ = PB_SM;
constexpr int SM_R = SM_SSQ + 2 * 64 * 4 * 4, SM_INT = SM_R + 256, SM_EMT = SM_INT + 256, SM_RS = SM_EMT + 256, SM_SCAL = SM_RS + 256;
constexpr int SM_NV = SM_SCAL + 64, SM_QN = SM_NV + 512, MX_END = SM_QN + 256;
static_assert(MX_END <= RING_BYTES, "mixer LDS");
DEV void dma_rows64(const void* src, ldsp dst, int wave, int lane) { GLDS16S((const char*)src + wave * 2048, (lane >> 3) * 256 + (lane & 7) * 16, dst + wave * 1024); }

DEV void mixer_a_job(const Args& args, ldsp lds, int b, int h, int vh, int tid_) {
    const int wave = RFL(tid_ >> 6), vt = wave & 3, hf = wave >> 2;
    const bf16* P = (const bf16*)(args.ws + WS_P);
    const unsigned char* TW = args.ws + WS_W1T;
    const rsrc_t RO = make_rsrc(args.ws + WS_OAB, (unsigned)((size_t)2 * M * DA * 2));
    float* SSA = (float*)(args.ws + WS_SSA);
    const int u0 = (b * HA + h) * NCH, vcol = h * 128 + 64 * vh;
    f32x4 st[4], o[2];
#pragma unroll
    for (int t = 0; t < 4; ++t) st[t] = (f32x4){0.f, 0.f, 0.f, 0.f};
    o[0] = (f32x4){0.f, 0.f, 0.f, 0.f}; o[1] = (f32x4){0.f, 0.f, 0.f, 0.f};
    { const u32x4 z = (u32x4){0u, 0u, 0u, 0u}; const int lane = tid_ & 63;
        LDS_WR(u32x4, lds + PB_XS + 16384 + (vt * 2 + hf) * 2048 + lane * 16, z); LDS_WR(u32x4, lds + PB_XS + 16384 + (vt * 2 + hf) * 2048 + 1024 + lane * 16, z); }
#define MA_DMA(jj) do { ldsp bf_ = lds + ((jj) & 1) * PB_BUFSZ; const size_t uu_ = (size_t)(u0 + (jj)); \
        dma_lin(TW + TW_QA + uu_ * 16384, 16, bf_ + PB_Q, wave, lane); dma_lin(TW + TW_KA + uu_ * 16384, 16, bf_ + PB_K, wave, lane); \
        dma_rows64(P + p_off((size_t)b * SEQ + 64 * (jj), C_IA + h * 128) + 64 * vh, bf_ + PB_V, wave, lane); dma_lin(TW + TW_PA + uu_ * 8192, 8, bf_ + PB_P, wave, lane); dma_lin(TW + TW_VA + uu_ * 2048, 2, bf_ + PB_VEC, wave, lane); } while (0)
    { const int lane = tid_ & 63; MA_DMA(0); }
    for (int j = 0; j <= NCH; ++j) {
        int tidj = tid_; OPAQUE(tidj);
        const int lane = tidj & 63, q4 = lane >> 4, l15 = lane & 15;
        const size_t tk0 = (size_t)b * SEQ + 64 * j;
        if (j <= 1) WAIT_V(0); else WAIT_V(2);
        MIX_BAR();
        if (j + 1 < NCH) MA_DMA(j + 1);
        if (j > 0) {
            if (wave == 0) { const f32x4 s0 = LDS_RD(f32x4, lds + SM_SSQ + ((j - 1) & 1) * 1024 + lane * 16); SSA[((tk0 - 64 + lane) * HA + h) * 2 + vh] = (s0[0] + s0[1]) + (s0[2] + s0[3]); }
#pragma unroll
            for (int i = 0; i < 2; ++i) bstore64(RO, (unsigned)(l15 * DA + vcol + 16 * vt + 4 * q4) * 2u, (unsigned)(tk0 - 64 + 16 * (2 * hf + i)) * (unsigned)(DA * 2), pack4(o[i]));
        }
        if (j == NCH) break;
        ldsp bf = lds + (j & 1) * PB_BUFSZ;
        bf16x8 bv[2], pf[2][2], qo[2][2], qp[2][2], so[2], sp[2];
#pragma unroll
        for (int ks = 0; ks < 2; ++ks) bv[ks] = frag_tr(bf + PB_V, 16 * vt, ks, lane, 128);
#pragma unroll
        for (int ks = 0; ks < 2; ++ks)
#pragma unroll
            for (int i = 0; i < 2; ++i) pf[ks][i] = frag16p(bf + PB_P, 16 * (2 * hf + i), ks, lane);
#pragma unroll
        for (int kl = 0; kl < 2; ++kl)
#pragma unroll
            for (int i = 0; i < 2; ++i) { qo[kl][i] = frag8x2s(bf + PB_Q, 16 * (2 * hf + i), 2 * hf + kl, lane); qp[kl][i] = frag8x2s(bf + PB_Q, 16 * (2 * hf + i), 2 * (hf ^ 1) + kl, lane); }
        u32x4 xp[2];
#pragma unroll
        for (int kl = 0; kl < 2; ++kl) xp[kl] = LDS_RD(u32x4, lds + PB_XS + ((j + 1) & 1) * 16384 + (vt * 2 + (hf ^ 1)) * 2048 + kl * 1024 + lane * 16);
        f32x4 eo[4], ep[4];
#pragma unroll
        for (int t = 0; t < 4; ++t) { eo[t] = LDS_RD(f32x4, bf + PB_VEC + (16 * (4 * hf + t) + 4 * q4) * 4); ep[t] = LDS_RD(f32x4, bf + PB_VEC + (16 * (4 * (hf ^ 1) + t) + 4 * q4) * 4); }
        SCHED_BAR();
#pragma unroll
        for (int kl = 0; kl < 2; ++kl) {
            { u32x4 w; const f32x4 a0 = st[2 * kl] * eo[2 * kl], a1 = st[2 * kl + 1] * eo[2 * kl + 1]; w.x = cvt_pk_bf16(a0[0], a0[1]); w.y = cvt_pk_bf16(a0[2], a0[3]); w.z = cvt_pk_bf16(a1[0], a1[1]); w.w = cvt_pk_bf16(a1[2], a1[3]);
              so[kl] = __builtin_bit_cast(bf16x8, w); }
            { u32x4 w; const f32x4 e0 = ep[2 * kl], e1 = ep[2 * kl + 1]; const u32x4 x = xp[kl];
              w.x = cvt_pk_bf16(__builtin_bit_cast(float, x.x << 16) * e0[0], __builtin_bit_cast(float, x.x & 0xffff0000u) * e0[1]); w.y = cvt_pk_bf16(__builtin_bit_cast(float, x.y << 16) * e0[2], __builtin_bit_cast(float, x.y & 0xffff0000u) * e0[3]);
              w.z = cvt_pk_bf16(__builtin_bit_cast(float, x.z << 16) * e1[0], __builtin_bit_cast(float, x.z & 0xffff0000u) * e1[1]); w.w = cvt_pk_bf16(__builtin_bit_cast(float, x.w << 16) * e1[2], __builtin_bit_cast(float, x.w & 0xffff0000u) * e1[3]);
              sp[kl] = __builtin_bit_cast(bf16x8, w); } }
        o[0] = (f32x4){0.f, 0.f, 0.f, 0.f}; o[1] = (f32x4){0.f, 0.f, 0.f, 0.f};
#pragma unroll
        for (int ks = 0; ks < 2; ++ks)
#pragma unroll
            for (int i = 0; i < 2; ++i) o[i] = MFMA16(bv[ks], pf[ks][i], o[i]);
#pragma unroll
        for (int kl = 0; kl < 2; ++kl)
#pragma unroll
            for (int i = 0; i < 2; ++i) { o[i] = MFMA16(so[kl], qo[kl][i], o[i]); o[i] = MFMA16(sp[kl], qp[kl][i], o[i]); }
#pragma unroll
        for (int i = 0; i < 4; ++i) { const int t = 4 * hf + i;
            f32x4 u = (f32x4){0.f, 0.f, 0.f, 0.f};
#pragma unroll
            for (int ks = 0; ks < 2; ++ks) { const bf16x8 a = frag_trs(bf + PB_K, 16 * t, ks, lane); u = MFMA16(a, bv[ks], u); }
            const f32x4 eg = LDS_RD(f32x4, bf + PB_VEC + 512 + (16 * t + 4 * q4) * 4), egm = LDS_RD(f32x4, bf + PB_VEC + 1024 + (16 * t + 4 * q4) * 4); st[i] = eg * st[i] + egm * u; }
#pragma unroll
        for (int kl = 0; kl < 2; ++kl) { u32x4 w; const f32x4 a0 = st[2 * kl], a1 = st[2 * kl + 1]; w.x = cvt_pk_bf16(a0[0], a0[1]); w.y = cvt_pk_bf16(a0[2], a0[3]); w.z = cvt_pk_bf16(a1[0], a1[1]); w.w = cvt_pk_bf16(a1[2], a1[3]);
            LDS_WR(u32x4, lds + PB_XS + (j & 1) * 16384 + (vt * 2 + hf) * 2048 + kl * 1024 + lane * 16, w); }
#pragma unroll
        for (int i = 0; i < 2; ++i) { float s_ = (o[i][0] * o[i][0] + o[i][1] * o[i][1]) + (o[i][2] * o[i][2] + o[i][3] * o[i][3]); s_ += __shfl_xor(s_, 16); s_ += __shfl_xor(s_, 32);
            LDS_WR(float, lds + SM_SSQ + (j & 1) * 1024 + ((16 * (2 * hf + i) + l15) * 4 + vt) * 4, s_); }
    }
#undef MA_DMA
}

DEV void mixer_b_job(const Args& args, ldsp lds, int b, int h, int vq, int tid_) {
    const int wave = RFL(tid_ >> 6), vt = wave & 3, hf = wave >> 2;
    const int vbase = h * 256 + 64 * vq;
    const bf16* P = (const bf16*)(args.ws + WS_P);
    const unsigned char* TW = args.ws + WS_HB;
    const rsrc_t RO = make_rsrc(args.ws + WS_OAB, (unsigned)((size_t)2 * M * DA * 2));
    float* SSB = (float*)(args.ws + WS_SSB);
    const int u0 = (b * HB + h) * NCH;
    f32x4 st[4], hv[2];
#pragma unroll
    for (int t = 0; t < 4; ++t) st[t] = (f32x4){0.f, 0.f, 0.f, 0.f};
    hv[0] = (f32x4){0.f, 0.f, 0.f, 0.f}; hv[1] = (f32x4){0.f, 0.f, 0.f, 0.f};
    float mcar = 0.f;
    if (wave < 2) LDS_WR(float, lds + SM_NV + tid_ * 4, 0.f);
    { const u32x4 z = (u32x4){0u, 0u, 0u, 0u}; const int lane = tid_ & 63;
        LDS_WR(u32x4, lds + PB_XS + 16384 + (vt * 2 + hf) * 2048 + lane * 16, z); LDS_WR(u32x4, lds + PB_XS + 16384 + (vt * 2 + hf) * 2048 + 1024 + lane * 16, z); }
#define MB_DMA(jj) do { ldsp bf_ = lds + ((jj) & 1) * PB_BUFSZ; const size_t uu_ = (size_t)(u0 + (jj)); \
        dma_lin(TW + TW_QB + uu_ * 16384, 16, bf_ + PB_Q, wave, lane); dma_lin(TW + TW_KB + uu_ * 16384, 16, bf_ + PB_K, wave, lane); \
        dma_rows64(P + p_off((size_t)b * SEQ + 64 * (jj), C_VB + h * 256 + 128 * (vq >> 1)) + 64 * (vq & 1), bf_ + PB_V, wave, lane); dma_lin(TW + TW_PB + uu_ * 8192, 8, bf_ + PB_P, wave, lane); dma_lin(TW + TW_SB + uu_ * 2048, 2, bf_ + PB_VEC, wave, lane); } while (0)
    { const int lane = tid_ & 63; MB_DMA(0); }
    for (int j = 0; j <= NCH; ++j) {
        const size_t tk0 = (size_t)b * SEQ + 64 * j;
        int tidj = tid_; OPAQUE(tidj);
        const int tid = tidj, lane = tidj & 63, q4 = lane >> 4, l15 = lane & 15;
        if (j <= 1) WAIT_V(0); else WAIT_V(2);
        MIX_BAR();
        if (j + 1 < NCH) MB_DMA(j + 1);
        if (j > 0) {
            if (wave == 0) { const f32x4 s0 = LDS_RD(f32x4, lds + SM_SSQ + ((j - 1) & 1) * 1024 + lane * 16); SSB[((tk0 - 64 + lane) * HB + h) * 4 + vq] = (s0[0] + s0[1]) + (s0[2] + s0[3]); }
#pragma unroll
            for (int i = 0; i < 2; ++i) bstore64(RO, (unsigned)(l15 * DB + vbase + 16 * vt + 4 * q4) * 2u, (unsigned)(M + tk0 - 64 + 16 * (2 * hf + i)) * (unsigned)(DB * 2), pack4(hv[i]));
        }
        if (j == NCH) break;
        ldsp bf = lds + (j & 1) * PB_BUFSZ;
        if (wave == 0) {
            const float pm = LDS_RD(float, bf + PB_VEC + lane * 4), bc = LDS_RD(float, bf + PB_VEC + 256 + lane * 4); const f32x2 rsl = LDS_RD(f32x2, bf + PB_VEC + 512 + lane * 8);
            const float mx = fmaxf(mcar, pm), r = fexp(pm - mx);
            const float pm63 = __shfl(pm, 63), bc63 = __shfl(bc, 63), m63 = fmaxf(mcar, pm63);
            LDS_WR(float, lds + SM_R + lane * 4, r); LDS_WR(float, lds + SM_INT + lane * 4, fexp(mcar - mx)); LDS_WR(float, lds + SM_EMT + lane * 4, fexp(-(bc + mx))); LDS_WR(float, lds + SM_RS + lane * 4, r * (rsl[0] + rsl[1]));
            if (lane == 0) { LDS_WR(float, lds + SM_SCAL, fexp(mcar - m63)); LDS_WR(float, lds + SM_SCAL + 4, bc63 + m63); LDS_WR(float, lds + SM_SCAL + 8, fexp(pm63 - m63)); }
        }
        {
            const int c = tid >> 3, part = tid & 7; float s = 0.f;
#pragma unroll
            for (int hh = 0; hh < 2; ++hh) { const u32x4 qw = LDS_RD(u32x4, bf + PB_Q + swz(c, 2 * part + hh));
#pragma unroll
                for (int e = 0; e < 4; ++e) { const f32x2 nv = LDS_RD(f32x2, lds + SM_NV + (16 * part + 8 * hh + 2 * e) * 4); s += __builtin_bit_cast(float, qw[e] << 16) * nv[0] + __builtin_bit_cast(float, qw[e] & 0xffff0000u) * nv[1]; } }
            s += __shfl_xor(s, 1); s += __shfl_xor(s, 2); s += __shfl_xor(s, 4);
            LDS_WR(float, lds + SM_QN + c * 4, s);
        }
        MIX_BAR();
        const float decay = LDS_RD(float, lds + SM_SCAL), sj = LDS_RD(float, lds + SM_SCAL + 8);
        mcar = LDS_RD(float, lds + SM_SCAL + 4);
        {
            bf16x8 bv[2], pf[2][2], qo[2][2], qp[2][2], so[2], sp[2];
#pragma unroll
            for (int ks = 0; ks < 2; ++ks) bv[ks] = frag_tr(bf + PB_V, 16 * vt, ks, lane, 128);
#pragma unroll
            for (int ks = 0; ks < 2; ++ks)
#pragma unroll
                for (int i = 0; i < 2; ++i) pf[ks][i] = frag16p(bf + PB_P, 16 * (2 * hf + i), ks, lane);
#pragma unroll
            for (int kl = 0; kl < 2; ++kl)
#pragma unroll
                for (int i = 0; i < 2; ++i) { qo[kl][i] = frag8x2s(bf + PB_Q, 16 * (2 * hf + i), 2 * hf + kl, lane); qp[kl][i] = frag8x2s(bf + PB_Q, 16 * (2 * hf + i), 2 * (hf ^ 1) + kl, lane); }
#pragma unroll
            for (int kl = 0; kl < 2; ++kl) sp[kl] = LDS_RD(bf16x8, lds + PB_XS + ((j + 1) & 1) * 16384 + (vt * 2 + (hf ^ 1)) * 2048 + kl * 1024 + lane * 16);
            float s_int[2], s_r[2], s_qn[2], s_rs[2], s_emt[2];
#pragma unroll
            for (int i = 0; i < 2; ++i) { const int c = 16 * (2 * hf + i) + l15; s_int[i] = LDS_RD(float, lds + SM_INT + c * 4); s_r[i] = LDS_RD(float, lds + SM_R + c * 4); s_qn[i] = LDS_RD(float, lds + SM_QN + c * 4); s_rs[i] = LDS_RD(float, lds + SM_RS + c * 4); s_emt[i] = LDS_RD(float, lds + SM_EMT + c * 4); }
            SCHED_BAR();
#pragma unroll
            for (int kl = 0; kl < 2; ++kl) { u32x4 w; const f32x4 a0 = st[2 * kl], a1 = st[2 * kl + 1]; w.x = cvt_pk_bf16(a0[0], a0[1]); w.y = cvt_pk_bf16(a0[2], a0[3]); w.z = cvt_pk_bf16(a1[0], a1[1]); w.w = cvt_pk_bf16(a1[2], a1[3]); so[kl] = __builtin_bit_cast(bf16x8, w); }
#pragma unroll
            for (int i = 0; i < 2; ++i) {
                f32x4 a1 = (f32x4){0.f, 0.f, 0.f, 0.f}, a2 = (f32x4){0.f, 0.f, 0.f, 0.f};
#pragma unroll
                for (int ks = 0; ks < 2; ++ks) a2 = MFMA16(bv[ks], pf[ks][i], a2);
#pragma unroll
                for (int kl = 0; kl < 2; ++kl) { a1 = MFMA16(so[kl], qo[kl][i], a1); a1 = MFMA16(sp[kl], qp[kl][i], a1); }
                const float den = s_int[i] * s_qn[i] + s_rs[i];
                const float rden = frcp(fmaxf(fabsf(den), s_emt[i]));
                hv[i] = (s_int[i] * a1 + s_r[i] * a2) * rden;
            }
#pragma unroll
            for (int i = 0; i < 4; ++i) { const int t = 4 * hf + i;
                f32x4 u = (f32x4){0.f, 0.f, 0.f, 0.f};
#pragma unroll
                for (int ks = 0; ks < 2; ++ks) { const bf16x8 a = frag_trs(bf + PB_K, 16 * t, ks, lane); u = MFMA16(a, bv[ks], u); }
                st[i] = decay * st[i] + sj * u;
            }
#pragma unroll
            for (int kl = 0; kl < 2; ++kl) { u32x4 w; const f32x4 a0 = st[2 * kl], a1 = st[2 * kl + 1]; w.x = cvt_pk_bf16(a0[0], a0[1]); w.y = cvt_pk_bf16(a0[2], a0[3]); w.z = cvt_pk_bf16(a1[0], a1[1]); w.w = cvt_pk_bf16(a1[2], a1[3]);
                LDS_WR(u32x4, lds + PB_XS + (j & 1) * 16384 + (vt * 2 + hf) * 2048 + kl * 1024 + lane * 16, w); }
            if (wave < 2) LDS_WR(float, lds + SM_NV + tid * 4, decay * LDS_RD(float, lds + SM_NV + tid * 4) + sj * LDS_RD(float, bf + PB_VEC + 1024 + tid * 4));
#pragma unroll
            for (int i = 0; i < 2; ++i) { float s_ = (hv[i][0] * hv[i][0] + hv[i][1] * hv[i][1]) + (hv[i][2] * hv[i][2] + hv[i][3] * hv[i][3]); s_ += __shfl_xor(s_, 16); s_ += __shfl_xor(s_, 32);
                LDS_WR(float, lds + SM_SSQ + (j & 1) * 1024 + ((16 * (2 * hf + i) + l15) * 4 + vt) * 4, s_); }
        }
    }
#undef MB_DMA
}

constexpr int P0_RB1 = (NP + NSG + 63) / 64, P0_I1 = (D / 64) * P0_RB1, P0_IU = (DA / 64) * (D / 64), P0_IO = (D / 64) * (D / 64), P0_NITEMS = P0_I1 + 2 * P0_IU + P0_IO;
DEV P0Desc p0_decode(const Args& args, int it) {
    unsigned char* ws = args.ws; bf16* W1T = (bf16*)(ws + WS_W1T); bf16* WUT = (bf16*)(ws + WS_WUT); bf16* WOT = (bf16*)(ws + WS_WOT);
    P0Desc d; int r = it;
    if (r < P0_I1) { const int kb = r / P0_RB1, rb = r % P0_RB1, r0 = 64 * rb; d.W = args.in[2]; d.ldw = D_IN; d.K = D; d.k0 = 64 * kb;
        if (r0 >= NPM && r0 < NP) { d.WT = ws + WS_W8; d.c0 = r0 + NSG; d.r0 = r0 - NPM; d.nv = 64; d.fp8 = 1; return d; }
        d.WT = W1T; d.fp8 = 0; d.r0 = r0;
        if (r0 < NPM) { d.c0 = r0; d.nv = 64; } else { d.c0 = NPM + (r0 - NP); d.nv = NSG - (r0 - NP) < 64 ? NSG - (r0 - NP) : 64; }
        return d; }
    r -= P0_I1; d.fp8 = 0; d.ldw = D; d.nv = 64;
    if (r < P0_IU) { const int kb = r / (D / 64), rb = r % (D / 64); d.W = args.in[10]; d.K = DA; d.WT = WUT; d.k0 = 64 * kb; d.c0 = 64 * rb; d.r0 = 64 * rb; return d; }
    r -= P0_IU;
    if (r < P0_IU) { const int kb = r / (D / 64), rb = r % (D / 64); d.W = args.in[11]; d.K = DB; d.WT = WUT + (size_t)D * DA; d.k0 = 64 * kb; d.c0 = 64 * rb; d.r0 = 64 * rb; return d; }
    r -= P0_IU;
    { const int kb = r / (D / 64), rb = r % (D / 64); d.W = args.in[12]; d.K = D; d.WT = WOT; d.k0 = 64 * kb; d.c0 = 64 * rb; d.r0 = 64 * rb; return d; }
}
DEV void p0_items(const Args& args, int first, int last, int stride, ldsp scr, int lane) {
    if (first >= last) return;
    P0Desc d = p0_decode(args, first); f32x4 v[16]; p0_load(d, lane, v);
    for (int it = first; it < last; it += stride) {
        const int nx = it + stride; P0Desc dn = d; f32x4 vn[16];
        if (nx < last) { dn = p0_decode(args, nx); p0_load(dn, lane, vn); }
        p0_store(d, v, scr, lane);
        if (nx < last) { d = dn;
#pragma unroll
            for (int i = 0; i < 16; ++i) v[i] = vn[i]; }
    }
}

__global__ void __launch_bounds__(NTHREADS, 2) fwd_kernel(Args args) {
#ifndef EMU
    extern __shared__ __attribute__((aligned(16))) unsigned char lds_raw[];
    ldsp lds = (ldsp)lds_raw;
#else
    ldsp lds = emu_lds;
#endif
    const int tid = threadIdx.x, lane = tid & 63, wave = RFL(tid >> 6);
    const int G = gridDim.x, bx = blockIdx.x;
    const int vcu = (G % 8 == 0) ? (bx % 8) * (G / 8) + bx / 8 : bx;
    unsigned char* ws = args.ws;
#ifndef EMU
    for (int u = tid; u < (LDS_BYTES - LDSCTL_OFF) / 4; u += NTHREADS) ((LAS unsigned*)(lds + LDSCTL_OFF))[u] = 0u;
    __syncthreads();
    XcdBarrier bar = xcd_barrier_post((unsigned*)(ws + WS_CTL) + CW_BAR, (volatile LAS unsigned*)(lds + MISC_OFF) + 8);
#define GRID_BAR() xcd_barrier(bar)
#else
#define GRID_BAR()
#endif
    const int lo = args.ph_lo, hi = args.ph_hi;
#ifndef GEMM_SP2
#define GEMM_SP2 true
#endif
#ifndef GEMM_ALIGN
#define GEMM_ALIGN true
#endif
#ifndef PROBE_REP_P4
#define PROBE_REP_P4 1
#endif
#ifndef PROBE_REP_P5
#define PROBE_REP_P5 1
#endif
#ifndef PROBE_REP_P1
#define PROBE_REP_P1 2
#endif
#ifndef PROBE_REP_P2
#define PROBE_REP_P2 1
#endif
#ifndef PHASE_MASK
#define PHASE_MASK 255
#endif
#define IN(k) (((PHASE_MASK >> (k)) & 1) && lo <= (k) && (k) < hi)
#define BOTH(k) (IN(k) && IN((k) + 1))
    const float* x = args.in[0];
    bf16* W1T = (bf16*)(ws + WS_W1T); bf16* WUT = (bf16*)(ws + WS_WUT); bf16* WOT = (bf16*)(ws + WS_WOT);
    bf16* HBUF = (bf16*)(ws + WS_HB); bf16* PB = (bf16*)(ws + WS_P); float* SG = (float*)(ws + WS_SG); bf16* OAB = (bf16*)(ws + WS_OAB); float* RSS = (float*)(ws + WS_RSS);

    if (IN(0)) {
        ldsp scr = lds + wave * 17408;
        const int gw = vcu * NWAVES + wave, NGW = G * NWAVES;
        constexpr int I_1 = P0_I1, NITEMS = P0_NITEMS;
        static_assert(NPM % 64 == 0 && NP % 64 == 0 && NSG % 4 == 0, "P0 item tiling");
        constexpr int NJOBS3 = NB * HA * 2 + NB * HB * 4;
        const int nit0 = (G > NJOBS3) ? I_1 : NITEMS;
        p0_items(args, gw, nit0, NGW, scr, lane);
        const float* gpre = args.in[1];
        for (int m = gw; m < M; m += NGW) {
            const f32x4* xr = (const f32x4*)(x + (size_t)m * D) + lane;
            f32x4 v[D / 256]; float s = 0.f;
#pragma unroll
            for (int jj = 0; jj < D / 256; ++jj) { v[jj] = xr[64 * jj]; s += (v[jj][0] * v[jj][0] + v[jj][1] * v[jj][1]) + (v[jj][2] * v[jj][2] + v[jj][3] * v[jj][3]); }
            const float rstd = frsq(wave_sum(s) * (1.0f / D) + EPS) ;
            u32x2* o8 = (u32x2*)(HBUF + (size_t)m * D) + lane; unsigned* o4 = (unsigned*)(ws + WS_H8 + (size_t)m * D) + lane;
#pragma unroll
            for (int jj = 0; jj < D / 256; ++jj) { const f32x4 gg = ((const f32x4*)gpre)[lane + 64 * jj]; const f32x4 hh = v[jj] * rstd * gg; u32x2 w; w.x = pk2(hh[0], hh[1]); w.y = pk2(hh[2], hh[3]); o8[64 * jj] = w;
                o4[64 * jj] = pk_fp8x4(clamp8(hh[0] * H8_SCALE), clamp8(hh[1] * H8_SCALE), clamp8(hh[2] * H8_SCALE), clamp8(hh[3] * H8_SCALE)); }
        }
        if (BOTH(0)) GRID_BAR();
    }

    if (IN(1)) {
        {
            const int gw = vcu * NWAVES + wave, NGW = G * NWAVES, l15 = lane & 15, q4 = lane >> 4;
            const int wrow = NP + (l15 < NSG ? l15 : NSG - 1);
            for (int t = gw; t < M / 16; t += NGW) {
                f32x4 acc = (f32x4){0.f, 0.f, 0.f, 0.f};
                const bf16* ap = HBUF + (size_t)(16 * t + l15) * D + 8 * q4; const bf16* bp = W1T + (size_t)wrow * D + 8 * q4;
                for (int k0 = 0; k0 < D / 32; k0 += 16) {
                    bf16x8 af[16], bfr[16];
#pragma unroll
                    for (int i = 0; i < 16; ++i) { af[i] = *(const bf16x8*)(ap + 32 * (k0 + i)); bfr[i] = *(const bf16x8*)(bp + 32 * (k0 + i)); }
#pragma unroll
                    for (int i = 0; i < 16; ++i) acc = MFMA16(af[i], bfr[i], acc);
                }
#pragma unroll
                for (int r = 0; r < 4; ++r) SG[(size_t)(16 * t + 4 * q4 + r) * 16 + l15] = acc[r];
            }
        }
        { pg8::Gemm g{HBUF, W1T, M, NPM, D}; pg8::StaticOrder S; S.init(M, NPM, G, bx);
          EpiP E{PB};
          pg8::gemm_phase<EpiP, pg8::StaticOrder, GEMM_ALIGN, GEMM_SP2>(lds, g, S, E); }
        { pg8::Gemm g{(const bf16*)(ws + WS_H8), (const bf16*)(ws + WS_W8), M, 2 * D, D}; pg8::StaticOrder S; S.init(M, 2 * D, G, bx);
          EpiP8 E{PB};
          pg8::gemm_phase<EpiP8, pg8::StaticOrder, GEMM_ALIGN, GEMM_SP2, 1>(lds, g, S, E); }
        if (BOTH(1)) GRID_BAR();
    }

    if (IN(2)) {
        int buf = 0;
        if (bx < NUA + NUB) p2_issue(args, bx, lds + PA_RAW, wave, lane);
        for (int u = bx, it = 0; u < NUA + NUB; u += G, ++it) {
            int tidj = tid; OPAQUE(tidj); const int lane_ = tidj & 63;
            if (it == 0) WAIT_V(0); else WAIT_V(18);
            MIX_BAR();
            if (u + G < NUA + NUB) p2_issue(args, u + G, lds + PA_RAW + (buf ^ 1) * PA_RAWSZ, wave, lane_);
            p2_unit(args, lds, u, lds + PA_RAW + buf * PA_RAWSZ, wave, lane_);
            buf ^= 1;
        }
        if (BOTH(2)) GRID_BAR();
    }

    if (IN(3)) {
        constexpr int NJA = NB * HA * 2, NJB = NB * HB * 4;
        if (G > NJA + NJB && bx >= NJA + NJB) {
            ldsp scr = lds + wave * 17408;
            p0_items(args, P0_I1 + (bx - (NJA + NJB)) * NWAVES + wave, P0_NITEMS, (G - (NJA + NJB)) * NWAVES, scr, lane);
        }
        for (int job = bx; job < NJA + NJB; job += G) {
            if (job < NJA) mixer_a_job(args, lds, job / (2 * HA), (job >> 1) % HA, job & 1, tid);
            else { const int jb = job - NJA; mixer_b_job(args, lds, jb / (4 * HB), (jb >> 2) % HB, jb & 3, tid); }
            BLOCK_BAR();
        }
        if (BOTH(3)) GRID_BAR();
    }

    if (IN(4)) {
        const int gw = vcu * NWAVES + wave, NGW = G * NWAVES;
        const float* SSA = (const float*)(ws + WS_SSA); const float* SSB = (const float*)(ws + WS_SSB);
        static_assert(DA % 512 == 0 && DA == DB, "P3 tiling");
        for (int m = gw; m < M; m += NGW) {
#pragma unroll
            for (int br = 0; br < 2; ++br) {
#pragma unroll
                for (int i = 0; i < DA / 512; ++i) {
                    const int col0 = i * 512 + lane * 8;
                    float rstd;
                    if (br == 0) { const int hh = col0 / 128; rstd = frsq((SSA[((size_t)m * HA + hh) * 2] + SSA[((size_t)m * HA + hh) * 2 + 1]) * (1.0f / 128.0f) + EPS); }
                    else { const int hh = col0 / 256; const f32x4 q_ = *(const f32x4*)(SSB + ((size_t)m * HB + hh) * 4); rstd = frsq(((q_[0] + q_[1]) + (q_[2] + q_[3])) * (1.0f / 256.0f) + EPS); }
                    u32x4* po = (u32x4*)(OAB + (size_t)(br * M + m) * DA + col0);
                    u32x4 w = *po; const u32x4 g8 = *(const u32x4*)(PB + p_off((size_t)m, (br ? C_OGB : C_OGA) + col0)), z8 = *(const u32x4*)(PB + p_off((size_t)m, (br ? C_ZB : C_ZA) + col0));
                    const f32x4 gn0 = *(const f32x4*)(args.in[br ? 9 : 8] + col0), gn1 = *(const f32x4*)(args.in[br ? 9 : 8] + col0 + 4);
#pragma unroll
                    for (int e = 0; e < 4; ++e) { float v[2];
#pragma unroll
                        for (int k = 0; k < 2; ++k) { const float ov = __builtin_bit_cast(float, k ? (w[e] & 0xffff0000u) : (w[e] << 16)), og = __builtin_bit_cast(float, k ? (g8[e] & 0xffff0000u) : (g8[e] << 16)), z = __builtin_bit_cast(float, k ? (z8[e] & 0xffff0000u) : (z8[e] << 16));
                            const float gnv = (e < 2 ? gn0 : gn1)[(2 * e + k) & 3];
                            v[k] = ov * rstd * gnv * sigm2(og) * (z * sigm2(z)); }
                        w[e] = cvt_pk_bf16(v[0], v[1]); }
                    *po = w;
                }
            }
        }
        if (BOTH(4)) GRID_BAR();
    }
    if (IN(5)) {
        pg8::Gemm g{OAB, WUT, 2 * M, 2 * D, DA}; SchedUp S; S.so.init(M, D, G, bx);
        EpiUp E{HBUF, PB};
        for (int rep = 0; rep < PROBE_REP_P4; ++rep) pg8::gemm_phase<EpiUp, SchedUp, GEMM_ALIGN, GEMM_SP2>(lds, g, S, E);
        if (BOTH(5)) GRID_BAR();
    }

    if (IN(6)) {
        pg8::Gemm g{HBUF, WOT, M, D, D}; pg8::StaticOrder S; S.init(M, D, G, bx);
        EpiOut E{PB, RSS};
        for (int rep = 0; rep < PROBE_REP_P5; ++rep) pg8::gemm_phase<EpiOut, pg8::StaticOrder, GEMM_ALIGN, GEMM_SP2>(lds, g, S, E);
        if (BOTH(6)) GRID_BAR();
    }

    if (IN(7)) {
        const int gw = vcu * NWAVES + wave, NGW = G * NWAVES;
        const float* gpost = args.in[13];
        for (int m = gw; m < M; m += NGW) {
            const float ss = wave_sum(lane < NRS ? RSS[(size_t)m * NRS + lane] : 0.f);
            const float rstd = frsq(ss * (1.0f / D) + EPS);
            const f32x4* xr = (const f32x4*)(x + (size_t)m * D) + lane; f32x4* orow = (f32x4*)(args.out + (size_t)m * D) + lane; const u32x2* ob = (const u32x2*)(PB + (size_t)m * D) + lane;
#pragma unroll
            for (int jj = 0; jj < D / 256; ++jj) { const f32x4 xv = xr[64 * jj], gg = ((const f32x4*)gpost)[lane + 64 * jj]; const u32x2 w = ob[64 * jj];
                const f32x4 ov = (f32x4){__builtin_bit_cast(float, w.x << 16), __builtin_bit_cast(float, w.x & 0xffff0000u), __builtin_bit_cast(float, w.y << 16), __builtin_bit_cast(float, w.y & 0xffff0000u)};
                orow[64 * jj] = xv + ov * rstd * gg; }
        }
    }
#undef IN
#undef BOTH
}

#ifndef EMU
extern "C" void kernel_launch(void* const* d_in, const int* in_sizes, int n_in, void* d_out, int out_size, void* d_ws, size_t ws_size, hipStream_t stream) {
    static int grid = 0;
    if (grid == 0) {
        if (n_in != 14 || out_size != M * D || ws_size < WS_END) { fprintf(stderr, "kernel_launch: unexpected shapes (n_in %d, out %d, ws %zu < %zu)\n", n_in, out_size, ws_size, (size_t)WS_END); grid = -1; return; }
        int dev = 0, cus = 0, per_cu = 0;
        if (hipGetDevice(&dev) != hipSuccess || hipDeviceGetAttribute(&cus, hipDeviceAttributeMultiprocessorCount, dev) != hipSuccess) { grid = -1; return; }
        if (hipFuncSetAttribute((const void*)fwd_kernel, hipFuncAttributeMaxDynamicSharedMemorySize, LDS_BYTES) != hipSuccess) { fprintf(stderr, "kernel_launch: hipFuncSetAttribute failed\n"); grid = -1; return; }
        if (hipOccupancyMaxActiveBlocksPerMultiprocessor(&per_cu, (const void*)fwd_kernel, NTHREADS, LDS_BYTES) != hipSuccess || per_cu < 1) { fprintf(stderr, "kernel_launch: occupancy query says %d\n", per_cu); }
        (void)hipGetLastError();
        grid = cus;
    }
    if (grid < 0) return;
    (void)hipMemsetAsync((char*)d_ws + WS_CTL, 0, CTL_ZERO_BYTES, stream);
    Args a{};
    for (int i = 0; i < 14; ++i) a.in[i] = (const float*)d_in[i];
    a.out = (float*)d_out; a.ws = (unsigned char*)d_ws; a.ph_lo = 0; a.ph_hi = 8;
    hipLaunchKernelGGL(fwd_kernel, dim3(grid), dim3(NTHREADS), LDS_BYTES, stream, a);
}
#endif
```

```cpp
typedef unsigned u32x2_t __attribute__((ext_vector_type(2)));
typedef int v8i_t __attribute__((ext_vector_type(8)));
typedef int v4i_t __attribute__((ext_vector_type(4)));
#ifndef EMU
#include <hip/hip_runtime.h>
#include <cstdio>
#include <cstdint>
#define LAS __attribute__((address_space(3)))
#define GAS __attribute__((address_space(1)))
typedef short bf16x8 __attribute__((ext_vector_type(8)));
typedef short bf16x4 __attribute__((ext_vector_type(4)));
typedef float f32x4 __attribute__((ext_vector_type(4)));
#define DEV __device__ __forceinline__
#define LDS_RD(T, p) (*(const LAS T*)(p))
#define LDS_WR(T, p, v) (*(LAS T*)(p) = (v))
#define WAVE_SYNC() asm volatile("s_waitcnt lgkmcnt(0)" ::: "memory")
#define BLOCK_BAR() __syncthreads()
#define RAW_BAR() __builtin_amdgcn_s_barrier()
#define WAIT_V(n) asm volatile("s_waitcnt vmcnt(" #n ")" ::: "memory")
#define WAIT_L(n) asm volatile("s_waitcnt lgkmcnt(" #n ")" ::: "memory")
#define SCHED_BAR() __builtin_amdgcn_sched_barrier(0)
#define SETPRIO(n) __builtin_amdgcn_s_setprio(n)
#define GLDS16(g, l) __builtin_amdgcn_global_load_lds((const unsigned*)(g), (LAS unsigned*)(l), 16, 0, 0)
#define MFMA16(a, b, c) __builtin_amdgcn_mfma_f32_16x16x32_bf16(a, b, c, 0, 0, 0)
#define RFL(x) __builtin_amdgcn_readfirstlane(x)
#define COMPILER_FENCE() asm volatile("" ::: "memory")
#define OPAQUE(x) asm volatile("" : "+v"(x))
DEV float fexp2(float x) { return __builtin_amdgcn_exp2f(x); }
DEV float flog2(float x) { return __builtin_amdgcn_logf(x); }
DEV float frcp(float x) { return __builtin_amdgcn_rcpf(x); }
DEV float frsq(float x) { return __builtin_amdgcn_rsqf(x); }
DEV unsigned cvt_pk_bf16(float lo, float hi) { unsigned r; asm volatile("v_cvt_pk_bf16_f32 %0, %1, %2" : "=v"(r) : "v"(lo), "v"(hi)); return r; }
DEV f32x4 mfma8(v8i_t a, v8i_t b, f32x4 c, int sc) { asm volatile("v_mfma_scale_f32_16x16x128_f8f6f4 %0, %1, %2, %0, %3, %3 op_sel_hi:[0,0,0]" : "+v"(c) : "v"(a), "v"(b), "v"(sc)); return c; }
#define MFMA_DRAIN() asm volatile("s_nop 15\n\ts_nop 7" ::: "memory")
DEV unsigned pk_fp8x4(float a, float b, float c, float d) { int r = __builtin_amdgcn_cvt_pk_fp8_f32(a, b, 0, false); r = __builtin_amdgcn_cvt_pk_fp8_f32(c, d, r, true); return (unsigned)r; }
typedef short v4i16_t __attribute__((ext_vector_type(4)));
DEV bf16x4 lds_tr16(LAS unsigned char* p) { return __builtin_bit_cast(bf16x4, __builtin_amdgcn_ds_read_tr16_b64_v4i16((LAS v4i16_t*)p)); }
#define MIX_BAR() do { asm volatile("s_waitcnt lgkmcnt(0)" ::: "memory"); __builtin_amdgcn_s_barrier(); asm volatile("" ::: "memory"); } while (0)
DEV void glds16_asm(const void* gsrc, unsigned lds_dst) { unsigned keep;
    asm volatile("s_mov_b32 %0, m0\n\ts_mov_b32 m0, %2\n\ts_nop 0\n\tglobal_load_lds_dwordx4 %1, off\n\ts_mov_b32 m0, %0" : "=&s"(keep) : "v"(gsrc), "s"(lds_dst) : "memory"); }
#define GLDS16X(g, l) glds16_asm((const void*)(g), (unsigned)RFL((int)(unsigned)(__UINTPTR_TYPE__)(l)))
DEV void glds16_sbase(const void* sbase, unsigned voff, unsigned lds_dst) { unsigned keep;
    asm volatile("s_mov_b32 %0, m0\n\ts_mov_b32 m0, %3\n\ts_nop 0\n\tglobal_load_lds_dwordx4 %1, %2\n\ts_mov_b32 m0, %0" : "=&s"(keep) : "v"(voff), "s"(sbase), "s"(lds_dst) : "memory"); }
#define GLDS16S(sb, vo, l) glds16_sbase((const void*)(sb), (unsigned)(vo), (unsigned)RFL((int)(unsigned)(__UINTPTR_TYPE__)(l)))
typedef __amdgpu_buffer_rsrc_t rsrc_t;
DEV rsrc_t make_rsrc(const void* p, unsigned bytes) { return __builtin_amdgcn_make_buffer_rsrc((void*)p, (short)0, (int)bytes, 0x00020000); }
DEV unsigned short bload16(rsrc_t r, unsigned voff, unsigned soff) { return (unsigned short)__builtin_amdgcn_raw_buffer_load_b16(r, (int)voff, (int)soff, 0); }
DEV void bstore16(rsrc_t r, unsigned voff, unsigned soff, unsigned short v) { __builtin_amdgcn_raw_buffer_store_b16(v, r, (int)voff, (int)soff, 0); }
DEV void bstore64(rsrc_t r, unsigned voff, unsigned soff, u32x2_t v) { __builtin_amdgcn_raw_buffer_store_b64(v, r, (int)voff, (int)soff, 0); }
#else
#define LAS
#define GAS
#define DEV inline
#define LDS_RD(T, p) emu_lds_rd<T>((const void*)(p), #p)
#define LDS_WR(T, p, v) emu_lds_wr<T>((void*)(p), (T)(v), #p)
#define WAVE_SYNC() emu_wavesync()
#define BLOCK_BAR() emu_syncthreads()
#define RAW_BAR() emu_syncthreads()
#define WAIT_V(n)
#define WAIT_L(n)
#define SCHED_BAR()
#define SETPRIO(n)
#define GLDS16(g, l) emu_glds16((const void*)(g), (unsigned char*)(l))
#define GLDS16X(g, l) emu_glds16((const void*)(g), (unsigned char*)(l))
#define GLDS16S(sb, vo, l) emu_glds16((const void*)((const char*)(sb) + (vo)), (unsigned char*)(l))
#define MFMA16(a, b, c) emu_mfma16(a, b, c)
#define RFL(x) (x)
#define COMPILER_FENCE()
#define OPAQUE(x)
DEV float fexp2(float x) { return exp2f(x); }
DEV float flog2(float x) { return log2f(x); }
DEV float frcp(float x) { return 1.0f / x; }
DEV float frsq(float x) { return 1.0f / sqrtf(x); }
DEV unsigned cvt_pk_bf16(float lo, float hi) { return (unsigned)emu_f2bf(lo) | ((unsigned)emu_f2bf(hi) << 16); }
#define mfma8(a, b, c, sc) emu_mfma8(a, b, c)
#define MFMA_DRAIN()
DEV unsigned pk_fp8x4(float a, float b, float c, float d) { return (unsigned)emu_f2fp8(a) | ((unsigned)emu_f2fp8(b) << 8) | ((unsigned)emu_f2fp8(c) << 16) | ((unsigned)emu_f2fp8(d) << 24); }
#define lds_tr16(p) emu_lds_tr16((const unsigned char*)(p))
#define MIX_BAR() emu_syncthreads()
typedef unsigned char* rsrc_t;
DEV rsrc_t make_rsrc(const void* p, unsigned) { return (unsigned char*)p; }
DEV unsigned short bload16(rsrc_t r, unsigned voff, unsigned soff) { unsigned short v; memcpy(&v, r + (size_t)voff + soff, 2); return v; }
DEV void bstore16(rsrc_t r, unsigned voff, unsigned soff, unsigned short v) { memcpy(r + (size_t)voff + soff, &v, 2); }
DEV void bstore64(rsrc_t r, unsigned voff, unsigned soff, u32x2_t v) { memcpy(r + (size_t)voff + soff, &v, 8); }
#endif

typedef unsigned short bf16;
typedef unsigned u32x4 __attribute__((ext_vector_type(4)));
typedef unsigned u32x2 __attribute__((ext_vector_type(2)));
typedef float f32x2 __attribute__((ext_vector_type(2)));
typedef LAS unsigned char* ldsp;

#ifndef CFG_D
#define CFG_D 4096
#define CFG_B 4
#define CFG_S 4096
#define CFG_HB 8
#endif
constexpr int D = CFG_D, NB = CFG_B, SEQ = CFG_S, M = NB * SEQ;
constexpr int DA = D / 2, HA = DA / 128, DB = D / 2, HB = CFG_HB, DVB = DB / HB, DKB = 128, DQK = HB * DKB;
constexpr int NSG = 2 * HB;
constexpr int NCH = SEQ / 64;
static_assert(DVB == 256 && NSG <= 16 && SEQ % 64 == 0 && M % 256 == 0 && D % 256 == 0, "shape");
constexpr int C_QA = 0, C_FA = DA, C_IA = 2 * DA, C_OGA = 3 * DA, C_ZA = 4 * DA, C_QB = 5 * DA, C_KB = C_QB + DQK, C_VB = C_KB + DQK, C_OGB = C_VB + DB, C_ZB = C_OGB + DB;
constexpr int NPM = C_ZB + DB, C_GA = NPM, C_GB = NPM + D, NP = NPM + 2 * D, D_IN = NP + NSG;
static_assert(NPM % 256 == 0 && NP % 256 == 0, "column map");
constexpr float EPS = 1e-6f;
constexpr float H8_SCALE = 64.0f, W8_SCALE = 1024.0f, G8_DESCALE = 1.0f / (64.0f * 1024.0f);
constexpr float LOG2E = 1.4426950408889634f, LN2 = 0.6931471805599453f;
constexpr int NRS = D / 64;
constexpr int PT_PITCH = M / 64 + 1;
DEV size_t p_off(size_t row, int col) { return ((size_t)(col >> 7) * (size_t)PT_PITCH + (row >> 6)) * 8192 + (row & 63) * 128 + (size_t)(col & 127); }

constexpr size_t al256(size_t x) { return (x + 255) & ~(size_t)255; }
constexpr size_t WS_CTL = 0, CTL_ZERO_BYTES = 65536;
constexpr size_t WS_W1T = 1u << 20;
constexpr int LDU = DA + 64;
constexpr size_t WS_WUT = al256(WS_W1T + (size_t)(NP + 16) * D * 2);
constexpr size_t WS_WOT = al256(WS_WUT + (size_t)2 * D * LDU * 2);
constexpr size_t WS_HB = al256(WS_WOT + (size_t)D * D * 2);
constexpr size_t WS_P = al256(WS_HB + (size_t)M * D * 2);
constexpr size_t WS_SG = al256(WS_P + (size_t)(NP / 128) * (M / 64 + 1) * 16384 + 4096);
constexpr size_t WS_OAB = al256(WS_SG + (size_t)M * 16 * 4);
constexpr size_t WS_RSS = al256(WS_OAB + (size_t)2 * M * LDU * 2);
constexpr size_t WS_SSB = al256(WS_RSS + (size_t)M * NRS * 4);
constexpr size_t WS_SSA = al256(WS_SSB + (size_t)M * HB * 4 * 4);
constexpr size_t WS_H8 = al256(WS_SSA + (size_t)M * HA * 2 * 4);
constexpr size_t WS_W8 = al256(WS_H8 + (size_t)M * D);
constexpr size_t WS_END = al256(WS_W8 + (size_t)2 * D * D);
constexpr int CW_BAR = 1024;

constexpr int RING_BYTES = 154624, LDSCTL_OFF = RING_BYTES, MISC_OFF = LDSCTL_OFF + 320, LDS_BYTES = 155648;
constexpr int NWAVES = 8, NTHREADS = 512;

DEV unsigned f2bf(float f) { unsigned u = __builtin_bit_cast(unsigned, f); return (u + 0x7fffu + ((u >> 16) & 1u)) >> 16; }
DEV float bf2f(unsigned b) { return __builtin_bit_cast(float, b << 16); }
DEV unsigned pk2(float lo, float hi) { return f2bf(lo) | (f2bf(hi) << 16); }
DEV float fexp(float x) { return fexp2(x * LOG2E); }
DEV float flog(float x) { return flog2(x) * LN2; }
DEV float sigm(float x) { return frcp(1.0f + fexp(-x)); }
DEV float logsig(float x) { return fminf(x, 0.f) - flog(1.0f + fexp(-fabsf(x))); }
DEV float wave_sum(float v) {
#pragma unroll
    for (int o = 1; o < 64; o <<= 1) v += __shfl_xor(v, o);
    return v;
}

namespace pg8 {
constexpr int BM = 256, BK = 64, HALF = 128, HTB = HALF * BK * 2, STAGE_BYTES = 8 * HTB, NXCD = 8, WGM = 8;
DEV int lds_byte(int r, int c) { const int st = (r >> 4) * 2 + (c >> 5), rr = r & 15, cc = c & 31, ob = rr * 64 + cc * 2; return st * 1024 + (ob ^ (((ob >> 9) & 1) << 5)); }
DEV void stage_rc(int b, int& R, int& C) { const int st = b / 1024, sb = b % 1024, swz = sb ^ (((sb >> 9) & 1) << 5); R = (st >> 1) * 16 + swz / 64; C = (st & 1) * 32 + (swz % 64) / 2; }
DEV int perm32(int rho) { const int n = rho >> 4, i = rho & 15; return 8 * (i >> 2) + 4 * n + (i & 3); }
struct Unit { int pm, pn; };
struct Gemm { const bf16* A; const bf16* Bt; int M, N, K; int ld; size_t a2off, b2off; };
struct StaticOrder {
    int nM, nN, nwg, G, c;
    DEV void init(int M_, int N_, int G_, int c_) { nM = M_ / BM; nN = N_ / BM; nwg = nM * nN; G = G_; c = c_; }
    DEV bool next(int i, Unit& u) const {
        const long L = (long)i * G + c; if (L >= nwg) return false;
        int wgid = (int)L; { const int q = nwg / NXCD, r = nwg % NXCD, xcd = wgid % NXCD, off = wgid / NXCD; wgid = (xcd < r ? xcd * (q + 1) : r * (q + 1) + (xcd - r) * q) + off; }
        const int nig = WGM * nN, gid = wgid / nig, fm = gid * WGM, gsz = (nM - fm) < WGM ? (nM - fm) : WGM;
        u.pm = fm + ((wgid % nig) % gsz); u.pn = (wgid % nig) / gsz; return true;
    }
};
template <class Epi, class Sched, bool ALIGN_EPI = false, bool SP2 = false, int ESZ = 2, bool SPLITK = false>
DEV void gemm_phase(ldsp lds, const Gemm g, const Sched& S, const Epi& E) {
    const int tid = threadIdx.x, wid = RFL(tid >> 6), lane = tid & 63, wr = wid >> 2, wc = wid & 3, fr = lane & 15, fq = lane >> 4;
    const int nt = (g.K * ESZ / 2) / BK, K = (g.ld ? g.ld : g.K) * ESZ / 2;
    unsigned voffA[2], voffB[2];
#pragma unroll
    for (int i = 0; i < 2; ++i) { int R, C; stage_rc(tid * 16 + i * 8192, R, C); const int Rb = Epi::PERM ? ((R & ~31) + perm32(R & 31)) : R;
        voffA[i] = (unsigned)(R * K + C) * 2u; voffB[i] = (unsigned)(Rb * K + C) * 2u; }
    const size_t kstep = (size_t)(BK * 2);
    const size_t hstep = (size_t)HALF * K * 2;
    const size_t tstep = 2 * hstep;
    const unsigned ldsw = (unsigned)wid * 1024u;
    int aoffk[2], boffk[2];
#pragma unroll
    for (int k = 0; k < 2; ++k) { const int ch = ESZ == 2 ? fq + 4 * k : 2 * fq + k;
        aoffk[k] = lds_byte(wr * 64 + fr, (ch & 3) * 8) + (ch >> 2) * 1024; boffk[k] = lds_byte(wc * 32 + fr, (ch & 3) * 8) + (ch >> 2) * 1024; }
#define PG8_SA(b, h) (((b) * 2 + (h)) * HTB)
#define PG8_SB(b, h) ((4 + (b) * 2 + (h)) * HTB)
#define PG8_STAGE(bufoff, gbase, voff) do { _Pragma("unroll") for (int _i = 0; _i < 2; ++_i) \
        GLDS16((const char*)(gbase) + (voff)[_i], lds + (bufoff) + ldsw + _i * 8192); } while (0)
#define PG8_LDA(dst, b, h) do { _Pragma("unroll") for (int m = 0; m < 4; ++m) { if constexpr (ESZ == 2) { _Pragma("unroll") for (int k = 0; k < 2; ++k) dst[m][k] = *(const LAS bf16x8*)(lds + PG8_SA(b, h) + aoffk[k] + m * 2048); } \
        else dst##8[m] = __builtin_shufflevector(*(const LAS v4i_t*)(lds + PG8_SA(b, h) + aoffk[0] + m * 2048), *(const LAS v4i_t*)(lds + PG8_SA(b, h) + aoffk[1] + m * 2048), 0, 1, 2, 3, 4, 5, 6, 7); } } while (0)
#define PG8_LDB(dst, b, h) do { _Pragma("unroll") for (int n = 0; n < 2; ++n) { if constexpr (ESZ == 2) { _Pragma("unroll") for (int k = 0; k < 2; ++k) dst[n][k] = *(const LAS bf16x8*)(lds + PG8_SB(b, h) + boffk[k] + n * 2048); } \
        else dst##8[n] = __builtin_shufflevector(*(const LAS v4i_t*)(lds + PG8_SB(b, h) + boffk[0] + n * 2048), *(const LAS v4i_t*)(lds + PG8_SB(b, h) + boffk[1] + n * 2048), 0, 1, 2, 3, 4, 5, 6, 7); } } while (0)
#define PG8_MMA(ai, bj, At, Bt) do { SETPRIO(1); _Pragma("unroll") for (int m = 0; m < 4; ++m) _Pragma("unroll") for (int n = 0; n < 2; ++n) { \
        if constexpr (ESZ == 2) { _Pragma("unroll") for (int k = 0; k < 2; ++k) acc[ai][bj][m][n] = MFMA16(Bt[n][k], At[m][k], acc[ai][bj][m][n]); } \
        else acc[ai][bj][m][n] = mfma8(Bt##8[n], At##8[m], acc[ai][bj][m][n], sc8); } SETPRIO(0); } while (0)
    int sc8 = 0x7f7f7f7f; OPAQUE(sc8);
    Unit cur, nxt; int ui = 0;
    if (!S.next(0, cur)) return;
    f32x4 acc[2][2][4][2];
#pragma unroll
    for (int a = 0; a < 2; ++a)
#pragma unroll
        for (int b = 0; b < 2; ++b)
#pragma unroll
            for (int m = 0; m < 4; ++m)
#pragma unroll
                for (int n = 0; n < 2; ++n) acc[a][b][m][n] = (f32x4){0.f, 0.f, 0.f, 0.f};
    bf16x8 At[ESZ == 2 ? 4 : 1][2], B0[ESZ == 2 ? 2 : 1][2], B1[ESZ == 2 ? 2 : 1][2];
    v8i_t At8[ESZ == 1 ? 4 : 1], B08[ESZ == 1 ? 2 : 1], B18[ESZ == 1 ? 2 : 1];
    const char* cA = (const char*)g.A + (size_t)cur.pm * tstep; const char* cB = (const char*)g.Bt + (size_t)cur.pn * tstep;
    if constexpr (SP2) {
        PG8_STAGE(PG8_SB(0, 0), cB, voffB); PG8_STAGE(PG8_SB(0, 1), cB + hstep, voffB); PG8_STAGE(PG8_SA(0, 0), cA, voffA); PG8_STAGE(PG8_SA(0, 1), cA + hstep, voffA);
        if (wr == 1) RAW_BAR();
        WAIT_V(2); RAW_BAR();
        PG8_STAGE(PG8_SB(1, 0), cB + kstep, voffB); PG8_STAGE(PG8_SA(1, 0), cA + kstep, voffA); PG8_STAGE(PG8_SB(1, 1), cB + hstep + kstep, voffB);
        WAIT_V(6); RAW_BAR();
    } else {
        PG8_STAGE(PG8_SB(0, 0), cB, voffB); PG8_STAGE(PG8_SA(0, 0), cA, voffA); PG8_STAGE(PG8_SB(0, 1), cB + hstep, voffB); PG8_STAGE(PG8_SA(0, 1), cA + hstep, voffA);
        if (wr == 1) RAW_BAR();
        WAIT_V(4); RAW_BAR();
        PG8_STAGE(PG8_SB(1, 0), cB + kstep, voffB); PG8_STAGE(PG8_SA(1, 0), cA + kstep, voffA); PG8_STAGE(PG8_SB(1, 1), cB + hstep + kstep, voffB);
        WAIT_V(6); RAW_BAR();
    }
    for (;;) {
        const bool has_next = S.next(ui + 1, nxt);
        const char* nA = has_next ? (const char*)g.A + (size_t)nxt.pm * tstep : cA; const char* nB = has_next ? (const char*)g.Bt + (size_t)nxt.pn * tstep : cB;
        for (int t = 0; t < nt; t += 2) {
            const bool last = (t == nt - 2);
            const size_t h1 = (SPLITK && t >= nt / 2) ? 1 : 0, h2 = (SPLITK && t + 2 >= nt / 2) ? 1 : 0;
            const char* a1 = cA + (size_t)(t + 1) * kstep + h1 * (g.a2off - (size_t)(nt / 2) * kstep);
            const char* a2 = last ? nA : cA + (size_t)(t + 2) * kstep + h2 * (g.a2off - (size_t)(nt / 2) * kstep); const char* b2 = last ? nB : cB + (size_t)(t + 2) * kstep + h2 * (g.b2off - (size_t)(nt / 2) * kstep);
            const char* a3 = a2 + kstep; const char* b3 = b2 + kstep;
            if constexpr (SPLITK) { if (t == nt / 2) { int fr_ = fr; OPAQUE(fr_); E.mid(acc, cur, wr, wc, fr_, fq); } }
            if constexpr (SP2) {
            PG8_LDB(B0, 0, 0); PG8_LDB(B1, 0, 1); SCHED_BAR(); PG8_LDA(At, 0, 0); PG8_STAGE(PG8_SA(1, 1), a1 + hstep, voffA);
            WAIT_V(8); WAIT_L(0); RAW_BAR(); PG8_MMA(0, 0, At, B0); PG8_MMA(0, 1, At, B1); RAW_BAR(); SCHED_BAR();
            PG8_LDA(At, 0, 1); PG8_STAGE(PG8_SB(0, 0), b2, voffB); PG8_STAGE(PG8_SB(0, 1), b2 + hstep, voffB); PG8_STAGE(PG8_SA(0, 0), a2, voffA);
            WAIT_V(8); WAIT_L(0); RAW_BAR(); PG8_MMA(1, 0, At, B0); PG8_MMA(1, 1, At, B1); RAW_BAR(); SCHED_BAR();
            PG8_LDB(B0, 1, 0); PG8_LDB(B1, 1, 1); SCHED_BAR(); PG8_LDA(At, 1, 0); PG8_STAGE(PG8_SA(0, 1), a2 + hstep, voffA);
            WAIT_V(8); WAIT_L(0); RAW_BAR(); PG8_MMA(0, 0, At, B0); PG8_MMA(0, 1, At, B1); RAW_BAR(); SCHED_BAR();
            PG8_LDA(At, 1, 1); PG8_STAGE(PG8_SB(1, 0), b3, voffB); PG8_STAGE(PG8_SB(1, 1), b3 + hstep, voffB); PG8_STAGE(PG8_SA(1, 0), a3, voffA);
            WAIT_V(8); WAIT_L(0); RAW_BAR(); PG8_MMA(1, 0, At, B0); PG8_MMA(1, 1, At, B1); RAW_BAR(); SCHED_BAR();
            } else {
            PG8_LDB(B0, 0, 0); SCHED_BAR(); PG8_LDA(At, 0, 0); PG8_STAGE(PG8_SA(1, 1), a1 + hstep, voffA);
            WAIT_L(8); RAW_BAR(); WAIT_L(0); PG8_MMA(0, 0, At, B0); RAW_BAR(); SCHED_BAR();
            PG8_LDB(B1, 0, 1); PG8_STAGE(PG8_SB(0, 0), b2, voffB);
            RAW_BAR(); WAIT_L(0); PG8_MMA(0, 1, At, B1); RAW_BAR();
            PG8_LDA(At, 0, 1); PG8_STAGE(PG8_SA(0, 0), a2, voffA);
            RAW_BAR(); WAIT_L(0); PG8_MMA(1, 0, At, B0); RAW_BAR(); SCHED_BAR();
            PG8_STAGE(PG8_SB(0, 1), b2 + hstep, voffB);
            WAIT_V(6); RAW_BAR(); PG8_MMA(1, 1, At, B1); RAW_BAR();
            PG8_LDB(B0, 1, 0); SCHED_BAR(); PG8_LDA(At, 1, 0); PG8_STAGE(PG8_SA(0, 1), a2 + hstep, voffA);
            WAIT_L(8); RAW_BAR(); WAIT_L(0); PG8_MMA(0, 0, At, B0); RAW_BAR(); SCHED_BAR();
            PG8_LDB(B1, 1, 1); PG8_STAGE(PG8_SB(1, 0), b3, voffB);
            RAW_BAR(); WAIT_L(0); PG8_MMA(0, 1, At, B1); RAW_BAR();
            PG8_LDA(At, 1, 1); PG8_STAGE(PG8_SA(1, 0), a3, voffA);
            RAW_BAR(); WAIT_L(0); PG8_MMA(1, 0, At, B0); RAW_BAR(); SCHED_BAR();
            PG8_STAGE(PG8_SB(1, 1), b3 + hstep, voffB);
            WAIT_V(6); RAW_BAR(); PG8_MMA(1, 1, At, B1); RAW_BAR();
            }
        }
        if constexpr (ALIGN_EPI) { if (wr == 0) RAW_BAR(); }
        if constexpr (ESZ == 1) { MFMA_DRAIN();
#pragma unroll
            for (int a = 0; a < 2; ++a)
#pragma unroll
                for (int b = 0; b < 2; ++b) asm volatile("" : "+v"(acc[a][b][0][0]), "+v"(acc[a][b][0][1]), "+v"(acc[a][b][1][0]), "+v"(acc[a][b][1][1]), "+v"(acc[a][b][2][0]), "+v"(acc[a][b][2][1]), "+v"(acc[a][b][3][0]), "+v"(acc[a][b][3][1])); }
        E(acc, cur, wr, wc, fr, fq);
        if (!has_next) break;
#pragma unroll
        for (int a = 0; a < 2; ++a)
#pragma unroll
            for (int b = 0; b < 2; ++b)
#pragma unroll
                for (int m = 0; m < 4; ++m)
#pragma unroll
                    for (int n = 0; n < 2; ++n) acc[a][b][m][n] = (f32x4){0.f, 0.f, 0.f, 0.f};
        cur = nxt; cA = nA; cB = nB; ++ui;
        if constexpr (ALIGN_EPI) { if (wr == 1) RAW_BAR(); }
    }
    WAIT_V(0);
    if constexpr (!ALIGN_EPI) { if (wr == 0) RAW_BAR(); }
    RAW_BAR();
#undef PG8_SA
#undef PG8_SB
#undef PG8_STAGE
#undef PG8_LDA
#undef PG8_LDB
#undef PG8_MMA
}
}

struct EpiP {
    static constexpr bool PERM = true;
    bf16* O;
    DEV void operator()(const f32x4 (&acc)[2][2][4][2], const pg8::Unit& u, int wr, int wc, int fr, int fq) const {
        const int row0 = u.pm * 256 + wr * 64 + fr, col0 = u.pn * 256 + wc * 32 + 8 * fq;
#pragma unroll
        for (int ai = 0; ai < 2; ++ai)
#pragma unroll
            for (int m = 0; m < 4; ++m) { const size_t row = (size_t)(row0 + ai * 128 + m * 16);
#pragma unroll
                for (int bj = 0; bj < 2; ++bj) { const f32x4 v0 = acc[ai][bj][m][0], v1 = acc[ai][bj][m][1];
                    u32x4 w; w.x = cvt_pk_bf16(v0[0], v0[1]); w.y = cvt_pk_bf16(v0[2], v0[3]); w.z = cvt_pk_bf16(v1[0], v1[1]); w.w = cvt_pk_bf16(v1[2], v1[3]);
                    *(u32x4*)(O + p_off(row, col0 + bj * 128)) = w; } }
    }
};
struct EpiP8 {
    static constexpr bool PERM = true;
    bf16* O;
    DEV void operator()(const f32x4 (&acc)[2][2][4][2], const pg8::Unit& u, int wr, int wc, int fr, int fq) const {
        const int row0 = u.pm * 256 + wr * 64 + fr, col0 = NPM + u.pn * 256 + wc * 32 + 8 * fq;
#pragma unroll
        for (int ai = 0; ai < 2; ++ai)
#pragma unroll
            for (int m = 0; m < 4; ++m) { const size_t row = (size_t)(row0 + ai * 128 + m * 16);
#pragma unroll
                for (int bj = 0; bj < 2; ++bj) { const f32x4 v0 = acc[ai][bj][m][0] * G8_DESCALE, v1 = acc[ai][bj][m][1] * G8_DESCALE;
                    u32x4 w; w.x = cvt_pk_bf16(v0[0], v0[1]); w.y = cvt_pk_bf16(v0[2], v0[3]); w.z = cvt_pk_bf16(v1[0], v1[1]); w.w = cvt_pk_bf16(v1[2], v1[3]);
                    *(u32x4*)(O + p_off(row, col0 + bj * 128)) = w; } }
    }
};
struct SchedUp {
    pg8::StaticOrder so;
    DEV bool next(int i, pg8::Unit& u) const { if (!so.next(i >> 1, u)) return false; if (i & 1) { u.pm += M / 256; u.pn += D / 256; } return true; }
};
struct EpiUp {
    static constexpr bool PERM = true;
    bf16* Y; const bf16* P;
    DEV void operator()(const f32x4 (&acc)[2][2][4][2], const pg8::Unit& u, int wr, int wc, int fr, int fq) const {
        const int br = u.pm >= M / 256 ? 1 : 0, pm = u.pm - br * (M / 256), pn = u.pn - br * (D / 256);
        const int row0 = pm * 256 + wr * 64 + fr, col0 = pn * 256 + wc * 32 + 8 * fq, gcol = (br ? C_GB : C_GA) + col0;
#pragma unroll
        for (int ai = 0; ai < 2; ++ai)
#pragma unroll
            for (int m = 0; m < 4; ++m) { const size_t row = (size_t)(row0 + ai * 128 + m * 16);
#pragma unroll
                for (int bj = 0; bj < 2; ++bj) {
                    const u32x4 g8 = *(const u32x4*)(P + p_off(row, gcol + bj * 128));
                    bf16* yp = Y + row * D + col0 + bj * 128;
                    u32x4 y8 = (u32x4){0u, 0u, 0u, 0u}; if (br) y8 = *(const u32x4*)yp;
                    const f32x4 v0 = acc[ai][bj][m][0], v1 = acc[ai][bj][m][1];
                    float o[8];
#pragma unroll
                    for (int k = 0; k < 8; ++k) { const unsigned gw = g8[k >> 1], yw = y8[k >> 1]; const float gv = bf2f((k & 1) ? (gw >> 16) : (gw & 0xffffu)), yv = bf2f((k & 1) ? (yw >> 16) : (yw & 0xffffu));
                        const float a = k < 4 ? v0[k & 3] : v1[k & 3]; o[k] = yv + sigm(gv) * a; }
                    u32x4 w; w.x = cvt_pk_bf16(o[0], o[1]); w.y = cvt_pk_bf16(o[2], o[3]); w.z = cvt_pk_bf16(o[4], o[5]); w.w = cvt_pk_bf16(o[6], o[7]);
                    *(u32x4*)yp = w; } }
    }
};
struct SchedGate { pg8::StaticOrder so; DEV bool next(int i, pg8::Unit& u) const { if (!so.next(i >> 1, u)) return false; if (i & 1) u.pn += D / 256; return true; } };
struct SchedRev { pg8::StaticOrder so; int n; DEV void init(int M_, int N_, int G_, int c_) { so.init(M_, N_, G_, c_); n = so.nwg > c_ ? (so.nwg - c_ + G_ - 1) / G_ : 0; }
    DEV bool next(int i, pg8::Unit& u) const { return i < n && so.next(n - 1 - i, u); } };
struct EpiUp2 {
    static constexpr bool PERM = true;
    bf16* Y; const bf16* P;
    DEV void mid(f32x4 (&acc)[2][2][4][2], const pg8::Unit& u, int wr, int wc, int fr, int fq) const {
        const int row0 = u.pm * 256 + wr * 64 + fr, col0 = u.pn * 256 + wc * 32 + 8 * fq;
#pragma unroll
        for (int ai = 0; ai < 2; ++ai)
#pragma unroll
            for (int m = 0; m < 4; ++m) { const size_t row = (size_t)(row0 + ai * 128 + m * 16);
#pragma unroll
                for (int bj = 0; bj < 2; ++bj) {
                    const u32x4 ga = *(const u32x4*)(P + p_off(row, C_GA + col0 + bj * 128)), gb = *(const u32x4*)(P + p_off(row, C_GB + col0 + bj * 128));
#pragma unroll
                    for (int k = 0; k < 8; ++k) { const unsigned aw = ga[k >> 1], bw = gb[k >> 1];
                        const float av = __builtin_bit_cast(float, (k & 1) ? (aw & 0xffff0000u) : (aw << 16)), bv_ = __builtin_bit_cast(float, (k & 1) ? (bw & 0xffff0000u) : (bw << 16));
                        const float ratio = (1.0f + fexp2(-LOG2E * bv_)) * frcp(1.0f + fexp2(-LOG2E * av));
                        if (k < 4) acc[ai][bj][m][0][k & 3] *= ratio; else acc[ai][bj][m][1][k & 3] *= ratio; } } }
    }
    DEV void operator()(const f32x4 (&acc)[2][2][4][2], const pg8::Unit& u, int wr, int wc, int fr, int fq) const {
        const int row0 = u.pm * 256 + wr * 64 + fr, col0 = u.pn * 256 + wc * 32 + 8 * fq;
#pragma unroll
        for (int ai = 0; ai < 2; ++ai)
#pragma unroll
            for (int m = 0; m < 4; ++m) { const size_t row = (size_t)(row0 + ai * 128 + m * 16);
#pragma unroll
                for (int bj = 0; bj < 2; ++bj) {
                    const u32x4 gb = *(const u32x4*)(P + p_off(row, C_GB + col0 + bj * 128));
                    const f32x4 v0 = acc[ai][bj][m][0], v1 = acc[ai][bj][m][1]; float o[8];
#pragma unroll
                    for (int k = 0; k < 8; ++k) { const unsigned bw = gb[k >> 1]; const float bv_ = __builtin_bit_cast(float, (k & 1) ? (bw & 0xffff0000u) : (bw << 16));
                        o[k] = (k < 4 ? v0[k & 3] : v1[k & 3]) * frcp(1.0f + fexp2(-LOG2E * bv_)); }
                    u32x4 w; w.x = cvt_pk_bf16(o[0], o[1]); w.y = cvt_pk_bf16(o[2], o[3]); w.z = cvt_pk_bf16(o[4], o[5]); w.w = cvt_pk_bf16(o[6], o[7]);
                    *(u32x4*)(Y + row * D + col0 + bj * 128) = w; } }
    }
};
struct EpiOut {
    static constexpr bool PERM = true;
    bf16* C; float* RSS;
    DEV void operator()(const f32x4 (&acc)[2][2][4][2], const pg8::Unit& u, int wr, int wc, int fr, int fq) const {
        const int row0 = u.pm * 256 + wr * 64 + fr, col0 = u.pn * 256 + wc * 32 + 8 * fq;
#pragma unroll
        for (int ai = 0; ai < 2; ++ai)
#pragma unroll
            for (int m = 0; m < 4; ++m) { const size_t row = (size_t)(row0 + ai * 128 + m * 16); bf16* rowp = C + row * D + col0; float ss = 0.f;
#pragma unroll
                for (int bj = 0; bj < 2; ++bj) { const f32x4 v0 = acc[ai][bj][m][0], v1 = acc[ai][bj][m][1];
                    ss += ((v0[0] * v0[0] + v0[1] * v0[1]) + (v0[2] * v0[2] + v0[3] * v0[3])) + ((v1[0] * v1[0] + v1[1] * v1[1]) + (v1[2] * v1[2] + v1[3] * v1[3]));
                    u32x4 w; w.x = cvt_pk_bf16(v0[0], v0[1]); w.y = cvt_pk_bf16(v0[2], v0[3]); w.z = cvt_pk_bf16(v1[0], v1[1]); w.w = cvt_pk_bf16(v1[2], v1[3]);
                    *(u32x4*)(rowp + bj * 128) = w; }
                ss += __shfl_xor(ss, 16); ss += __shfl_xor(ss, 32);
                if (fq == 0) RSS[row * NRS + u.pn * 4 + wc] = ss; }
    }
};

#ifndef EMU
typedef GAS unsigned gu32;
#define RLX_AGENT __ATOMIC_RELAXED, __HIP_MEMORY_SCOPE_AGENT
#define XB_TMO      128
#define XB_XCNT(j)  (256  + 64 * (j))
#define XB_XSUB(j)  (1280 + 64 * (j))
#define XB_XGEN(j)  (2304 + 64 * (j))
#define XB_TOP      3328
#define XB_TOPGEN   3392
#define XCD_BAR_WORDS 3456
#define XB_SPIN_CAP (1u << 22)
__device__ __forceinline__ unsigned xb_ld(unsigned* p)              { return __hip_atomic_load(p, __ATOMIC_RELAXED, __HIP_MEMORY_SCOPE_AGENT); }
__device__ __forceinline__ unsigned xb_add(unsigned* p, unsigned v) { return __hip_atomic_fetch_add(p, v, __ATOMIC_RELAXED, __HIP_MEMORY_SCOPE_AGENT); }
__device__ __forceinline__ unsigned xb_xcc_id() { return (unsigned)__builtin_amdgcn_s_getreg((3 << 11) | 20) & 0xFu; }
#define XB_SPIN(cond, bar) do { unsigned _sp = 0; while (cond) { __builtin_amdgcn_s_sleep(1); \
    if ((++_sp & 255u) == 0u) { if (xb_ld(&(bar)[XB_TMO])) break; if (_sp > XB_SPIN_CAP) { atomicAdd(&(bar)[XB_TMO], 1u); break; } } } } while (0)
struct XcdBarrier { unsigned* bar; unsigned x; volatile LAS unsigned* st; };
__device__ __forceinline__ XcdBarrier xcd_barrier_post(unsigned* bar, volatile LAS unsigned* st) {
    XcdBarrier b; b.bar = bar; b.x = xb_xcc_id(); b.st = st;
    if (threadIdx.x == 0) (void)xb_add(&bar[XB_XCNT(b.x)], 1u);
    return b;
}
__device__ __forceinline__ void xcd_barrier_complete(unsigned* bar, unsigned x, unsigned& nloc, unsigned& nx) {
    const unsigned G = gridDim.x * gridDim.y * gridDim.z;
    unsigned sum, cnt, mine, sp = 0u;
    for (;;) {
        sum = 0u; cnt = 0u; mine = 0u;
#pragma unroll
        for (unsigned j = 0; j < 16; ++j) { const unsigned c = xb_ld(&bar[XB_XCNT(j)]); sum += c; cnt += (c > 0u) ? 1u : 0u; mine = (j == x) ? c : mine; }
        if (sum == G) break;
        __builtin_amdgcn_s_sleep(1);
        if ((++sp & 255u) == 0u) { if (xb_ld(&bar[XB_TMO])) break; if (sp > XB_SPIN_CAP) { atomicAdd(&bar[XB_TMO], 1u); break; } }
    }
    nloc = mine > 0u ? mine : 1u; nx = cnt > 0u ? cnt : 1u;
}
__device__ __forceinline__ void xcd_barrier(const XcdBarrier& b) {
    asm volatile("s_waitcnt vmcnt(0)" ::: "memory");
    __syncthreads();
    if (threadIdx.x == 0) {
        unsigned* bar = b.bar;
        __builtin_amdgcn_s_waitcnt(0);
        unsigned nloc = b.st[0], nx = b.st[1];
        if (nloc == 0u) { xcd_barrier_complete(bar, b.x, nloc, nx); b.st[0] = nloc; b.st[1] = nx; }
        const unsigned old = xb_add(&bar[XB_XSUB(b.x)], 1u);
        const unsigned gen = old / nloc;
        if (old + 1u == (gen + 1u) * nloc) {
            __builtin_amdgcn_fence(__ATOMIC_RELEASE, "agent");
            asm volatile("s_waitcnt vmcnt(0)" ::: "memory");
            const unsigned og = xb_add(&bar[XB_TOP], 1u);
            const unsigned tg = og / nx;
            if (og + 1u == (tg + 1u) * nx) xb_add(&bar[XB_TOPGEN], 1u);
            else XB_SPIN(xb_ld(&bar[XB_TOPGEN]) == tg, bar);
            __builtin_amdgcn_fence(__ATOMIC_ACQUIRE, "agent");
            xb_add(&bar[XB_XGEN(b.x)], 1u);
            asm volatile("s_waitcnt vmcnt(0)" ::: "memory");
        } else {
            XB_SPIN(xb_ld(&bar[XB_XGEN(b.x)]) == gen, bar);
            __builtin_amdgcn_fence(__ATOMIC_ACQUIRE, "agent");
            asm volatile("s_waitcnt vmcnt(0)" ::: "memory");
        }
    }
    __syncthreads();
}
#endif

struct Args { const float* in[14]; float* out; unsigned char* ws; int ph_lo, ph_hi; };

DEV float clamp8(float x) { return fminf(fmaxf(x, -448.0f), 448.0f); }
struct P0Desc { const float* W; void* WT; int ldw, K, k0, c0, r0, nv, fp8; };
DEV void p0_load(const P0Desc& d, int lane, f32x4 (&v)[16]) {
    const int kr = lane >> 4, n4 = 4 * (lane & 15);
#pragma unroll
    for (int i = 0; i < 16; ++i) v[i] = (n4 < d.nv) ? *(const f32x4*)(d.W + (size_t)(d.k0 + 4 * i + kr) * d.ldw + d.c0 + n4) : (f32x4){0.f, 0.f, 0.f, 0.f};
}
DEV void p0_store(const P0Desc& d, const f32x4 (&v)[16], ldsp scr, int lane) {
    const int kr = lane >> 4, n4 = 4 * (lane & 15);
#pragma unroll
    for (int i = 0; i < 16; ++i) LDS_WR(f32x4, scr + ((4 * i + kr) * 68 + n4) * 4, v[i]);
    WAVE_SYNC();
    if (!d.fp8) {
        bf16* WT = (bf16*)d.WT;
        const int c = lane & 7;
#pragma unroll
        for (int j = 0; j < 8; ++j) { const int n = (lane >> 3) + 8 * j; ldsp sp = scr + ((8 * c) * 68 + n) * 4;
            u32x4 o; o.x = pk2(LDS_RD(float, sp + 0 * 272), LDS_RD(float, sp + 1 * 272)); o.y = pk2(LDS_RD(float, sp + 2 * 272), LDS_RD(float, sp + 3 * 272));
            o.z = pk2(LDS_RD(float, sp + 4 * 272), LDS_RD(float, sp + 5 * 272)); o.w = pk2(LDS_RD(float, sp + 6 * 272), LDS_RD(float, sp + 7 * 272));
            if (n < d.nv) *(u32x4*)(WT + (size_t)(d.r0 + n) * d.K + d.k0 + 8 * c) = o; }
    } else {
        unsigned char* WT = (unsigned char*)d.WT;
        const int c = lane & 3;
#pragma unroll
        for (int j = 0; j < 4; ++j) { const int n = (lane >> 2) + 16 * j; ldsp sp = scr + ((16 * c) * 68 + n) * 4; float f[16];
#pragma unroll
            for (int i = 0; i < 16; ++i) f[i] = clamp8(LDS_RD(float, sp + i * 272) * W8_SCALE);
            u32x4 o; o.x = pk_fp8x4(f[0], f[1], f[2], f[3]); o.y = pk_fp8x4(f[4], f[5], f[6], f[7]); o.z = pk_fp8x4(f[8], f[9], f[10], f[11]); o.w = pk_fp8x4(f[12], f[13], f[14], f[15]);
            if (n < d.nv) *(u32x4*)(WT + (size_t)(d.r0 + n) * d.K + d.k0 + 16 * c) = o; }
    }
    WAVE_SYNC();
}

constexpr int MS = 272, MS64 = 144;
constexpr int NUA = NB * HA * NCH, NUB = NB * HB * NCH;
constexpr size_t TW_QA = 0, TW_KA = TW_QA + (size_t)NUA * 16384, TW_PA = TW_KA + (size_t)NUA * 16384, TW_VA = TW_PA + (size_t)NUA * 8192, TW_ENDA = TW_VA + (size_t)NUA * 2048;
constexpr size_t TW_QB = 0, TW_KB = TW_QB + (size_t)NUB * 16384, TW_PB = TW_KB + (size_t)NUB * 16384, TW_SB = TW_PB + (size_t)NUB * 8192, TW_ENDB = TW_SB + (size_t)NUB * 2048;
static_assert(TW_ENDA <= (size_t)(NP + 16) * D * 2 && TW_ENDB <= (size_t)M * D * 2, "operand tiles must fit the dead W1T / h regions");
DEV int swz(int row, int chunk) { return row * 256 + ((chunk ^ (row & 15)) << 4); }
DEV int swz64(int row, int chunk) { return row * 128 + ((chunk ^ (row & 7)) << 4); }
DEV bf16x8 frag16p(ldsp img, int row0, int ks, int lane) { return LDS_RD(bf16x8, img + swz64(row0 + (lane & 15), 4 * ks + (lane >> 4))); }

DEV bf16x8 frag16(ldsp buf, int stride, int row0, int ks, int lane) { return LDS_RD(bf16x8, buf + (row0 + (lane & 15)) * stride + ks * 64 + (lane >> 4) * 16); }
DEV bf16x8 frag16s(ldsp img, int row0, int ks, int lane) { return LDS_RD(bf16x8, img + swz(row0 + (lane & 15), 4 * ks + (lane >> 4))); }
DEV bf16x8 frag8x2s(ldsp img, int row0, int ks, int lane) {
    const int row = row0 + (lane & 15), q = lane >> 4;
    const bf16x4 lo = LDS_RD(bf16x4, img + swz(row, 4 * ks + (q >> 1)) + (q & 1) * 8), hi = LDS_RD(bf16x4, img + swz(row, 4 * ks + 2 + (q >> 1)) + (q & 1) * 8);
    return (bf16x8){lo[0], lo[1], lo[2], lo[3], hi[0], hi[1], hi[2], hi[3]};
}
DEV bf16x8 frag_tr(ldsp img, int n0, int ks, int lane, int stride = 256) {
    ldsp p = img + (32 * ks + 8 * (lane >> 4) + ((lane & 15) >> 2)) * stride + (n0 + 4 * (lane & 3)) * 2;
    const bf16x4 lo = lds_tr16(p), hi = lds_tr16(p + 4 * stride);
    return (bf16x8){lo[0], lo[1], lo[2], lo[3], hi[0], hi[1], hi[2], hi[3]};
}
DEV bf16x8 frag_trs(ldsp img, int n0, int ks, int lane) {
    const int row = 32 * ks + 8 * (lane >> 4) + ((lane & 15) >> 2), p = lane & 3, ch = (n0 >> 3) + (p >> 1);
    const bf16x4 lo = lds_tr16(img + swz(row, ch) + (p & 1) * 8), hi = lds_tr16(img + swz(row + 4, ch) + (p & 1) * 8);
    return (bf16x8){lo[0], lo[1], lo[2], lo[3], hi[0], hi[1], hi[2], hi[3]};
}
DEV void dma_lin(const void* src, int ninst, ldsp dst, int wave, int lane) {
    for (int i = wave; i < ninst; i += NWAVES) GLDS16X((const char*)src + i * 1024 + 16 * lane, dst + i * 1024);
}
DEV float sigm2(float x) { return frcp(1.0f + fexp2(-LOG2E * x)); }
DEV u32x2 pack4(const f32x4 v) { u32x2 w; w.x = cvt_pk_bf16(v[0], v[1]); w.y = cvt_pk_bf16(v[2], v[3]); return w; }

DEV float scan_add(float v, int lane) {
#pragma unroll
    for (int o = 1; o < 64; o <<= 1) { const float t = __shfl_up(v, o); if (lane >= o) v += t; }
    return v;
}
DEV float scan_max(float v, int lane) {
#pragma unroll
    for (int o = 1; o < 64; o <<= 1) { const float t = __shfl_up(v, o); if (lane >= o) v = fmaxf(v, t); }
    return v;
}

constexpr int PA_RAW = 0, PA_RAWSZ = 2 * 68 * 256, PA_TOT = 2 * PA_RAWSZ, PA_IQ = PA_TOT + 8 * 128 * 4, PA_IK = PA_IQ + 16384, PA_SC = PA_IK + 16384, PA_END = PA_SC + 1024;
static_assert(PA_END <= RING_BYTES, "P2 LDS");
DEV void p2_issue(const Args& args, int u, ldsp raw, int wave, int lane) {
    const bf16* P = (const bf16*)(args.ws + WS_P);
    if (u < NUA) { const int bh = u / NCH, j = u % NCH, b = bh / HA, h = bh % HA; const size_t tok0 = (size_t)b * SEQ + 64 * j;
        dma_lin(P + p_off(tok0, C_QA + h * 128), 16, raw, wave, lane); dma_lin(P + p_off(tok0, C_FA + h * 128), 16, raw + 68 * 256, wave, lane); }
    else { const int ub = u - NUA, bh = ub / NCH, j = ub % NCH, b = bh / HB, h = bh % HB; const size_t tok0 = (size_t)b * SEQ + 64 * j;
        dma_lin(P + p_off(tok0, C_QB + h * 128) - 3 * 128, 17, raw, wave, lane); dma_lin(P + p_off(tok0, C_KB + h * 128) - 3 * 128, 17, raw + 68 * 256, wave, lane); }
}
DEV void p2_scores(ldsp lds, f32x4 (&sc)[2], int wave, int lane) {
    const int ct = wave >> 1, st0 = 2 * (wave & 1);
    sc[0] = (f32x4){0.f, 0.f, 0.f, 0.f}; sc[1] = (f32x4){0.f, 0.f, 0.f, 0.f};
#pragma unroll
    for (int ks = 0; ks < 4; ++ks) { const bf16x8 qf = frag16s(lds + PA_IQ, 16 * ct, ks, lane);
#pragma unroll
        for (int n = 0; n < 2; ++n) { const bf16x8 kf_ = frag16s(lds + PA_IK, 16 * (st0 + n), ks, lane); sc[n] = MFMA16(kf_, qf, sc[n]); } }
}
DEV void p2_unit(const Args& args, ldsp lds, int u, ldsp raw, int wave, int lane) {
    unsigned char* TW = args.ws + WS_W1T;
    const int q4 = lane >> 4, l15 = lane & 15;
    if (u < NUA) {
        const int bh = u / NCH, h = bh % HA;
        const float* lbl = args.in[3];
        float lbv[2];
#pragma unroll
        for (int e = 0; e < 2; ++e) { const int col = h * 128 + 2 * lane + e; lbv[e] = frcp(1.0f + fexp(lbl[DA + col] - lbl[col])); }
        float lf[8][2], qv[8][2], kv[8][2];
#pragma unroll
        for (int c = 0; c < 8; ++c) { const unsigned qw = LDS_RD(unsigned, raw + (8 * wave + c) * 256 + lane * 4), fw = LDS_RD(unsigned, raw + 68 * 256 + (8 * wave + c) * 256 + lane * 4);
#pragma unroll
            for (int e = 0; e < 2; ++e) { const float f = lbv[e] + (1.0f - lbv[e]) * sigm2(__builtin_bit_cast(float, e ? (fw & 0xffff0000u) : (fw << 16))); lf[c][e] = flog2(f); kv[c][e] = 1.0f - f; qv[c][e] = __builtin_bit_cast(float, e ? (qw & 0xffff0000u) : (qw << 16)); } }
#pragma unroll
        for (int c = 1; c < 8; ++c) { lf[c][0] += lf[c - 1][0]; lf[c][1] += lf[c - 1][1]; }
        LDS_WR(f32x2, lds + PA_TOT + (wave * 128 + 2 * lane) * 4, ((f32x2){lf[7][0], lf[7][1]}));
        MIX_BAR();
        f32x2 off = (f32x2){0.f, 0.f}, bmid = (f32x2){0.f, 0.f}, g = (f32x2){0.f, 0.f};
#pragma unroll
        for (int w = 0; w < 8; ++w) { const f32x2 t = LDS_RD(f32x2, lds + PA_TOT + (w * 128 + 2 * lane) * 4); if (w < wave) off += t; if (w < 4) bmid += t; g += t; }
        if (wave == 0) { float* vec = (float*)(TW + TW_VA + (size_t)u * 2048) + 2 * lane;
            *(f32x2*)vec = (f32x2){fexp2(bmid[0]), fexp2(bmid[1])}; *(f32x2*)(vec + 128) = (f32x2){fexp2(g[0]), fexp2(g[1])}; *(f32x2*)(vec + 256) = (f32x2){fexp2(g[0] - bmid[0]), fexp2(g[1] - bmid[1])}; }
        unsigned qr8[8], kr8[8];
#pragma unroll
        for (int c = 0; c < 8; ++c) { float qr[2], kk[2]; const int r = 8 * wave + c;
#pragma unroll
            for (int e = 0; e < 2; ++e) { const float t1 = lf[c][e] + off[e] - bmid[e]; qr[e] = qv[c][e] * fexp2(t1); kk[e] = kv[c][e] * fexp2(-t1); }
            qr8[c] = cvt_pk_bf16(qr[0], qr[1]); kr8[c] = cvt_pk_bf16(kk[0], kk[1]);
            LDS_WR(unsigned, lds + PA_IQ + swz(r, lane >> 2) + (lane & 3) * 4, qr8[c]); LDS_WR(unsigned, lds + PA_IK + swz(r, lane >> 2) + (lane & 3) * 4, kr8[c]); }
        MIX_BAR();
        f32x4 sc[2]; p2_scores(lds, sc, wave, lane);
        unsigned char* tq = TW + TW_QA + (size_t)u * 16384; unsigned char* tk = TW + TW_KA + (size_t)u * 16384; unsigned char* tp = TW + TW_PA + (size_t)u * 8192;
#pragma unroll
        for (int c = 0; c < 8; ++c) { const int r = 8 * wave + c; *(unsigned*)(tq + swz(r, lane >> 2) + (lane & 3) * 4) = qr8[c]; *(unsigned*)(tk + swz(r, lane >> 2) + (lane & 3) * 4) = kr8[c]; }
#pragma unroll
        for (int n = 0; n < 2; ++n) { const int c = 16 * (wave >> 1) + l15, s0_ = 16 * (2 * (wave & 1) + n) + 4 * q4; f32x4 v = sc[n];
#pragma unroll
            for (int r = 0; r < 4; ++r) v[r] = (s0_ + r <= c) ? v[r] : 0.f;
            *(u32x2*)(tp + swz64(c, s0_ >> 3) + (q4 & 1) * 8) = pack4(v); }
    } else {
        const int ub = u - NUA, bh = ub / NCH, j = ub % NCH, b = bh / HB, h = bh % HB;
        const float* cw = args.in[4]; const float* cb = args.in[5];
        f32x2 wq[4], wk[4];
#pragma unroll
        for (int k = 0; k < 4; ++k) { wq[k] = *(const f32x2*)(cw + k * (2 * DQK) + h * 128 + 2 * lane); wk[k] = *(const f32x2*)(cw + k * (2 * DQK) + DQK + h * 128 + 2 * lane); }
        const f32x2 bq = *(const f32x2*)(cb + h * 128 + 2 * lane), bk = *(const f32x2*)(cb + DQK + h * 128 + 2 * lane);
        unsigned uq[11], uk[11];
#pragma unroll
        for (int i = 0; i < 11; ++i) { const bool neg = (64 * j + 8 * wave + i - 3) < 0;
            const unsigned a = LDS_RD(unsigned, raw + (8 * wave + i) * 256 + lane * 4), bb = LDS_RD(unsigned, raw + 68 * 256 + (8 * wave + i) * 256 + lane * 4); uq[i] = neg ? 0u : a; uk[i] = neg ? 0u : bb; }
        unsigned char* TWB = args.ws + WS_HB;
        float* sb = (float*)(TWB + TW_SB + (size_t)ub * 2048);
        if (wave == 0) {
            const size_t tok = (size_t)b * SEQ + 64 * j + lane; const float* SG = (const float*)(args.ws + WS_SG);
            const float fp = SG[tok * 16 + HB + h] + args.in[7][h], ig = SG[tok * 16 + h] + args.in[6][h];
            const float bc = scan_add(logsig(fp), lane), a = ig - bc, pm = scan_max(a, lane);
            sb[lane] = pm; sb[64 + lane] = bc;
            LDS_WR(float, lds + PA_SC + lane * 4, a * LOG2E); LDS_WR(float, lds + PA_SC + 256 + lane * 4, pm * LOG2E);
        }
        unsigned q8[8]; float kf[8][2];
#pragma unroll
        for (int c = 0; c < 8; ++c) { float qq[2]; const int r = 8 * wave + c;
#pragma unroll
            for (int e = 0; e < 2; ++e) { float yq = bq[e], yk = bk[e];
#pragma unroll
                for (int k = 0; k < 4; ++k) { yq += wq[k][e] * __builtin_bit_cast(float, e ? (uq[c + k] & 0xffff0000u) : (uq[c + k] << 16)); yk += wk[k][e] * __builtin_bit_cast(float, e ? (uk[c + k] & 0xffff0000u) : (uk[c + k] << 16)); }
                qq[e] = yq * sigm2(yq); kf[c][e] = yk * sigm2(yk) * 0.08838834764831845f; }
            q8[c] = cvt_pk_bf16(qq[0], qq[1]);
            LDS_WR(unsigned, lds + PA_IQ + swz(r, lane >> 2) + (lane & 3) * 4, q8[c]); LDS_WR(unsigned, lds + PA_IK + swz(r, lane >> 2) + (lane & 3) * 4, cvt_pk_bf16(kf[c][0], kf[c][1])); }
        MIX_BAR();
        const float pm63 = LDS_RD(float, lds + PA_SC + 256 + 63 * 4);
        unsigned kw8[8]; float na[2] = {0.f, 0.f};
#pragma unroll
        for (int c = 0; c < 8; ++c) { const float w_ = fexp2(LDS_RD(float, lds + PA_SC + (8 * wave + c) * 4) - pm63); const float k0 = w_ * kf[c][0], k1 = w_ * kf[c][1]; na[0] += k0; na[1] += k1; kw8[c] = cvt_pk_bf16(k0, k1); }
        LDS_WR(f32x2, lds + PA_TOT + (wave * 128 + 2 * lane) * 4, ((f32x2){na[0], na[1]}));
        f32x4 sc[2]; p2_scores(lds, sc, wave, lane);
        const int ct = wave >> 1, st0 = 2 * (wave & 1), c_ = 16 * ct + l15;
        const float pmc = LDS_RD(float, lds + PA_SC + 256 + c_ * 4); float rs = 0.f; u32x2 pw[2];
#pragma unroll
        for (int n = 0; n < 2; ++n) { const int s0_ = 16 * (st0 + n) + 4 * q4; const f32x4 as = LDS_RD(f32x4, lds + PA_SC + s0_ * 4); f32x4 v;
#pragma unroll
            for (int r = 0; r < 4; ++r) { const float t = fexp2(as[r] - pmc) * sc[n][r]; v[r] = (s0_ + r <= c_) ? t : 0.f; rs += v[r]; }
            pw[n] = pack4(v); }
        rs += __shfl_xor(rs, 16); rs += __shfl_xor(rs, 32);
        MIX_BAR();
        if (wave < 2) { const int dcol = wave * 64 + lane; float nl = 0.f;
#pragma unroll
            for (int w = 0; w < 8; ++w) nl += LDS_RD(float, lds + PA_TOT + (w * 128 + dcol) * 4);
            sb[256 + dcol] = nl; }
        if (q4 == 0) sb[128 + c_ * 2 + (wave & 1)] = rs;
        unsigned char* tq = TWB + TW_QB + (size_t)ub * 16384; unsigned char* tk = TWB + TW_KB + (size_t)ub * 16384; unsigned char* tp = TWB + TW_PB + (size_t)ub * 8192;
#pragma unroll
        for (int c = 0; c < 8; ++c) { const int r = 8 * wave + c; *(unsigned*)(tq + swz(r, lane >> 2) + (lane & 3) * 4) = q8[c]; *(unsigned*)(tk + swz(r, lane >> 2) + (lane & 3) * 4) = kw8[c]; }
#pragma unroll
        for (int n = 0; n < 2; ++n) { const int s0_ = 16 * (st0 + n) + 4 * q4; *(u32x2*)(tp + swz64(c_, s0_ >> 3) + (q4 & 1) * 8) = pw[n]; }
    }
}

constexpr int PB_BUFSZ = 51200, PB_Q = 0, PB_K = 16384, PB_V = 32768, PB_P = 40960, PB_VEC = 49152;
constexpr int PB_XS = 2 * PB_BUFSZ, PB_SM = PB_XS + 2 * 16384;
constexpr int SM_SSQ = PB_SM;
constexpr int SM_R = SM_SSQ + 2 * 64 * 4 * 4, SM_INT = SM_R + 256, SM_EMT = SM_INT + 256, SM_RS = SM_EMT + 256, SM_SCAL = SM_RS + 256;
constexpr int SM_NV = SM_SCAL + 64, SM_QN = SM_NV + 512, MX_END = SM_QN + 256;
static_assert(MX_END <= RING_BYTES, "mixer LDS");
DEV void dma_rows64(const void* src, ldsp dst, int wave, int lane) { GLDS16S((const char*)src + wave * 2048, (lane >> 3) * 256 + (lane & 7) * 16, dst + wave * 1024); }

DEV void mixer_a_job(const Args& args, ldsp lds, int b, int h, int vh, int tid_) {
    const int wave = RFL(tid_ >> 6), vt = wave & 3, hf = wave >> 2;
    const bf16* P = (const bf16*)(args.ws + WS_P);
    const unsigned char* TW = args.ws + WS_W1T;
    const rsrc_t RO = make_rsrc(args.ws + WS_OAB, (unsigned)((size_t)2 * M * LDU * 2));
    float* SSA = (float*)(args.ws + WS_SSA);
    const int u0 = (b * HA + h) * NCH, vcol = h * 128 + 64 * vh;
    f32x4 st[4], o[2];
#pragma unroll
    for (int t = 0; t < 4; ++t) st[t] = (f32x4){0.f, 0.f, 0.f, 0.f};
    o[0] = (f32x4){0.f, 0.f, 0.f, 0.f}; o[1] = (f32x4){0.f, 0.f, 0.f, 0.f};
    { const u32x4 z = (u32x4){0u, 0u, 0u, 0u}; const int lane = tid_ & 63;
        LDS_WR(u32x4, lds + PB_XS + 16384 + (vt * 2 + hf) * 2048 + lane * 16, z); LDS_WR(u32x4, lds + PB_XS + 16384 + (vt * 2 + hf) * 2048 + 1024 + lane * 16, z); }
#define MA_DMA(jj) do { ldsp bf_ = lds + ((jj) & 1) * PB_BUFSZ; const size_t uu_ = (size_t)(u0 + (jj)); \
        dma_lin(TW + TW_QA + uu_ * 16384, 16, bf_ + PB_Q, wave, lane); dma_lin(TW + TW_KA + uu_ * 16384, 16, bf_ + PB_K, wave, lane); \
        dma_rows64(P + p_off((size_t)b * SEQ + 64 * (jj), C_IA + h * 128) + 64 * vh, bf_ + PB_V, wave, lane); dma_lin(TW + TW_PA + uu_ * 8192, 8, bf_ + PB_P, wave, lane); dma_lin(TW + TW_VA + uu_ * 2048, 2, bf_ + PB_VEC, wave, lane); } while (0)
    { const int lane = tid_ & 63; MA_DMA(0); }
    for (int j = 0; j <= NCH; ++j) {
        int tidj = tid_; OPAQUE(tidj);
        const int lane = tidj & 63, q4 = lane >> 4, l15 = lane & 15;
        const size_t tk0 = (size_t)b * SEQ + 64 * j;
        if (j <= 1) WAIT_V(0); else WAIT_V(2);
        MIX_BAR();
        if (j + 1 < NCH) MA_DMA(j + 1);
        if (j > 0) {
            if (wave == 0) { const f32x4 s0 = LDS_RD(f32x4, lds + SM_SSQ + ((j - 1) & 1) * 1024 + lane * 16); SSA[((tk0 - 64 + lane) * HA + h) * 2 + vh] = (s0[0] + s0[1]) + (s0[2] + s0[3]); }
#pragma unroll
            for (int i = 0; i < 2; ++i) bstore64(RO, (unsigned)(l15 * LDU + vcol + 16 * vt + 4 * q4) * 2u, (unsigned)(tk0 - 64 + 16 * (2 * hf + i)) * (unsigned)(LDU * 2), pack4(o[i]));
        }
        if (j == NCH) break;
        ldsp bf = lds + (j & 1) * PB_BUFSZ;
        bf16x8 bv[2], pf[2][2], qo[2][2], qp[2][2], so[2], sp[2];
#pragma unroll
        for (int ks = 0; ks < 2; ++ks) bv[ks] = frag_tr(bf + PB_V, 16 * vt, ks, lane, 128);
#pragma unroll
        for (int ks = 0; ks < 2; ++ks)
#pragma unroll
            for (int i = 0; i < 2; ++i) pf[ks][i] = frag16p(bf + PB_P, 16 * (2 * hf + i), ks, lane);
#pragma unroll
        for (int kl = 0; kl < 2; ++kl)
#pragma unroll
            for (int i = 0; i < 2; ++i) { qo[kl][i] = frag8x2s(bf + PB_Q, 16 * (2 * hf + i), 2 * hf + kl, lane); qp[kl][i] = frag8x2s(bf + PB_Q, 16 * (2 * hf + i), 2 * (hf ^ 1) + kl, lane); }
        u32x4 xp[2];
#pragma unroll
        for (int kl = 0; kl < 2; ++kl) xp[kl] = LDS_RD(u32x4, lds + PB_XS + ((j + 1) & 1) * 16384 + (vt * 2 + (hf ^ 1)) * 2048 + kl * 1024 + lane * 16);
        f32x4 eo[4], ep[4];
#pragma unroll
        for (int t = 0; t < 4; ++t) { eo[t] = LDS_RD(f32x4, bf + PB_VEC + (16 * (4 * hf + t) + 4 * q4) * 4); ep[t] = LDS_RD(f32x4, bf + PB_VEC + (16 * (4 * (hf ^ 1) + t) + 4 * q4) * 4); }
        SCHED_BAR();
#pragma unroll
        for (int kl = 0; kl < 2; ++kl) {
            { u32x4 w; const f32x4 a0 = st[2 * kl] * eo[2 * kl], a1 = st[2 * kl + 1] * eo[2 * kl + 1]; w.x = cvt_pk_bf16(a0[0], a0[1]); w.y = cvt_pk_bf16(a0[2], a0[3]); w.z = cvt_pk_bf16(a1[0], a1[1]); w.w = cvt_pk_bf16(a1[2], a1[3]);
              so[kl] = __builtin_bit_cast(bf16x8, w); }
            { u32x4 w; const f32x4 e0 = ep[2 * kl], e1 = ep[2 * kl + 1]; const u32x4 x = xp[kl];
              w.x = cvt_pk_bf16(__builtin_bit_cast(float, x.x << 16) * e0[0], __builtin_bit_cast(float, x.x & 0xffff0000u) * e0[1]); w.y = cvt_pk_bf16(__builtin_bit_cast(float, x.y << 16) * e0[2], __builtin_bit_cast(float, x.y & 0xffff0000u) * e0[3]);
              w.z = cvt_pk_bf16(__builtin_bit_cast(float, x.z << 16) * e1[0], __builtin_bit_cast(float, x.z & 0xffff0000u) * e1[1]); w.w = cvt_pk_bf16(__builtin_bit_cast(float, x.w << 16) * e1[2], __builtin_bit_cast(float, x.w & 0xffff0000u) * e1[3]);
              sp[kl] = __builtin_bit_cast(bf16x8, w); } }
        o[0] = (f32x4){0.f, 0.f, 0.f, 0.f}; o[1] = (f32x4){0.f, 0.f, 0.f, 0.f};
#pragma unroll
        for (int ks = 0; ks < 2; ++ks)
#pragma unroll
            for (int i = 0; i < 2; ++i) o[i] = MFMA16(bv[ks], pf[ks][i], o[i]);
#pragma unroll
        for (int kl = 0; kl < 2; ++kl)
#pragma unroll
            for (int i = 0; i < 2; ++i) { o[i] = MFMA16(so[kl], qo[kl][i], o[i]); o[i] = MFMA16(sp[kl], qp[kl][i], o[i]); }
#pragma unroll
        for (int i = 0; i < 4; ++i) { const int t = 4 * hf + i;
            f32x4 u = (f32x4){0.f, 0.f, 0.f, 0.f};
#pragma unroll
            for (int ks = 0; ks < 2; ++ks) { const bf16x8 a = frag_trs(bf + PB_K, 16 * t, ks, lane); u = MFMA16(a, bv[ks], u); }
            const f32x4 eg = LDS_RD(f32x4, bf + PB_VEC + 512 + (16 * t + 4 * q4) * 4), egm = LDS_RD(f32x4, bf + PB_VEC + 1024 + (16 * t + 4 * q4) * 4); st[i] = eg * st[i] + egm * u; }
#pragma unroll
        for (int kl = 0; kl < 2; ++kl) { u32x4 w; const f32x4 a0 = st[2 * kl], a1 = st[2 * kl + 1]; w.x = cvt_pk_bf16(a0[0], a0[1]); w.y = cvt_pk_bf16(a0[2], a0[3]); w.z = cvt_pk_bf16(a1[0], a1[1]); w.w = cvt_pk_bf16(a1[2], a1[3]);
            LDS_WR(u32x4, lds + PB_XS + (j & 1) * 16384 + (vt * 2 + hf) * 2048 + kl * 1024 + lane * 16, w); }
#pragma unroll
        for (int i = 0; i < 2; ++i) { float s_ = (o[i][0] * o[i][0] + o[i][1] * o[i][1]) + (o[i][2] * o[i][2] + o[i][3] * o[i][3]); s_ += __shfl_xor(s_, 16); s_ += __shfl_xor(s_, 32);
            LDS_WR(float, lds + SM_SSQ + (j & 1) * 1024 + ((16 * (2 * hf + i) + l15) * 4 + vt) * 4, s_); }
    }
#undef MA_DMA
}

DEV void mixer_b_job(const Args& args, ldsp lds, int b, int h, int vq, int tid_) {
    const int wave = RFL(tid_ >> 6), vt = wave & 3, hf = wave >> 2;
    const int vbase = h * 256 + 64 * vq;
    const bf16* P = (const bf16*)(args.ws + WS_P);
    const unsigned char* TW = args.ws + WS_HB;
    const rsrc_t RO = make_rsrc(args.ws + WS_OAB, (unsigned)((size_t)2 * M * LDU * 2));
    float* SSB = (float*)(args.ws + WS_SSB);
    const int u0 = (b * HB + h) * NCH;
    f32x4 st[4], hv[2];
#pragma unroll
    for (int t = 0; t < 4; ++t) st[t] = (f32x4){0.f, 0.f, 0.f, 0.f};
    hv[0] = (f32x4){0.f, 0.f, 0.f, 0.f}; hv[1] = (f32x4){0.f, 0.f, 0.f, 0.f};
    float mcar = 0.f;
    if (wave < 2) LDS_WR(float, lds + SM_NV + tid_ * 4, 0.f);
    { const u32x4 z = (u32x4){0u, 0u, 0u, 0u}; const int lane = tid_ & 63;
        LDS_WR(u32x4, lds + PB_XS + 16384 + (vt * 2 + hf) * 2048 + lane * 16, z); LDS_WR(u32x4, lds + PB_XS + 16384 + (vt * 2 + hf) * 2048 + 1024 + lane * 16, z); }
#define MB_DMA(jj) do { ldsp bf_ = lds + ((jj) & 1) * PB_BUFSZ; const size_t uu_ = (size_t)(u0 + (jj)); \
        dma_lin(TW + TW_QB + uu_ * 16384, 16, bf_ + PB_Q, wave, lane); dma_lin(TW + TW_KB + uu_ * 16384, 16, bf_ + PB_K, wave, lane); \
        dma_rows64(P + p_off((size_t)b * SEQ + 64 * (jj), C_VB + h * 256 + 128 * (vq >> 1)) + 64 * (vq & 1), bf_ + PB_V, wave, lane); dma_lin(TW + TW_PB + uu_ * 8192, 8, bf_ + PB_P, wave, lane); dma_lin(TW + TW_SB + uu_ * 2048, 2, bf_ + PB_VEC, wave, lane); } while (0)
    { const int lane = tid_ & 63; MB_DMA(0); }
    for (int j = 0; j <= NCH; ++j) {
        const size_t tk0 = (size_t)b * SEQ + 64 * j;
        int tidj = tid_; OPAQUE(tidj);
        const int tid = tidj, lane = tidj & 63, q4 = lane >> 4, l15 = lane & 15;
        if (j <= 1) WAIT_V(0); else WAIT_V(2);
        MIX_BAR();
        if (j + 1 < NCH) MB_DMA(j + 1);
        if (j > 0) {
            if (wave == 0) { const f32x4 s0 = LDS_RD(f32x4, lds + SM_SSQ + ((j - 1) & 1) * 1024 + lane * 16); SSB[((tk0 - 64 + lane) * HB + h) * 4 + vq] = (s0[0] + s0[1]) + (s0[2] + s0[3]); }
#pragma unroll
            for (int i = 0; i < 2; ++i) bstore64(RO, (unsigned)(l15 * LDU + vbase + 16 * vt + 4 * q4) * 2u, (unsigned)(M + tk0 - 64 + 16 * (2 * hf + i)) * (unsigned)(LDU * 2), pack4(hv[i]));
        }
        if (j == NCH) break;
        ldsp bf = lds + (j & 1) * PB_BUFSZ;
        if (wave == 0) {
            const float pm = LDS_RD(float, bf + PB_VEC + lane * 4), bc = LDS_RD(float, bf + PB_VEC + 256 + lane * 4); const f32x2 rsl = LDS_RD(f32x2, bf + PB_VEC + 512 + lane * 8);
            const float mx = fmaxf(mcar, pm), r = fexp(pm - mx);
            const float pm63 = __shfl(pm, 63), bc63 = __shfl(bc, 63), m63 = fmaxf(mcar, pm63);
            LDS_WR(float, lds + SM_R + lane * 4, r); LDS_WR(float, lds + SM_INT + lane * 4, fexp(mcar - mx)); LDS_WR(float, lds + SM_EMT + lane * 4, fexp(-(bc + mx))); LDS_WR(float, lds + SM_RS + lane * 4, r * (rsl[0] + rsl[1]));
            if (lane == 0) { LDS_WR(float, lds + SM_SCAL, fexp(mcar - m63)); LDS_WR(float, lds + SM_SCAL + 4, bc63 + m63); LDS_WR(float, lds + SM_SCAL + 8, fexp(pm63 - m63)); }
        }
        {
            const int c = tid >> 3, part = tid & 7; float s = 0.f;
#pragma unroll
            for (int hh = 0; hh < 2; ++hh) { const u32x4 qw = LDS_RD(u32x4, bf + PB_Q + swz(c, 2 * part + hh));
#pragma unroll
                for (int e = 0; e < 4; ++e) { const f32x2 nv = LDS_RD(f32x2, lds + SM_NV + (16 * part + 8 * hh + 2 * e) * 4); s += __builtin_bit_cast(float, qw[e] << 16) * nv[0] + __builtin_bit_cast(float, qw[e] & 0xffff0000u) * nv[1]; } }
            s += __shfl_xor(s, 1); s += __shfl_xor(s, 2); s += __shfl_xor(s, 4);
            LDS_WR(float, lds + SM_QN + c * 4, s);
        }
        MIX_BAR();
        const float decay = LDS_RD(float, lds + SM_SCAL), sj = LDS_RD(float, lds + SM_SCAL + 8);
        mcar = LDS_RD(float, lds + SM_SCAL + 4);
        {
            bf16x8 bv[2], pf[2][2], qo[2][2], qp[2][2], so[2], sp[2];
#pragma unroll
            for (int ks = 0; ks < 2; ++ks) bv[ks] = frag_tr(bf + PB_V, 16 * vt, ks, lane, 128);
#pragma unroll
            for (int ks = 0; ks < 2; ++ks)
#pragma unroll
                for (int i = 0; i < 2; ++i) pf[ks][i] = frag16p(bf + PB_P, 16 * (2 * hf + i), ks, lane);
#pragma unroll
            for (int kl = 0; kl < 2; ++kl)
#pragma unroll
                for (int i = 0; i < 2; ++i) { qo[kl][i] = frag8x2s(bf + PB_Q, 16 * (2 * hf + i), 2 * hf + kl, lane); qp[kl][i] = frag8x2s(bf + PB_Q, 16 * (2 * hf + i), 2 * (hf ^ 1) + kl, lane); }
#pragma unroll
            for (int kl = 0; kl < 2; ++kl) sp[kl] = LDS_RD(bf16x8, lds + PB_XS + ((j + 1) & 1) * 16384 + (vt * 2 + (hf ^ 1)) * 2048 + kl * 1024 + lane * 16);
            float s_int[2], s_r[2], s_qn[2], s_rs[2], s_emt[2];
#pragma unroll
            for (int i = 0; i < 2; ++i) { const int c = 16 * (2 * hf + i) + l15; s_int[i] = LDS_RD(float, lds + SM_INT + c * 4); s_r[i] = LDS_RD(float, lds + SM_R + c * 4); s_qn[i] = LDS_RD(float, lds + SM_QN + c * 4); s_rs[i] = LDS_RD(float, lds + SM_RS + c * 4); s_emt[i] = LDS_RD(float, lds + SM_EMT + c * 4); }
            SCHED_BAR();
#pragma unroll
            for (int kl = 0; kl < 2; ++kl) { u32x4 w; const f32x4 a0 = st[2 * kl], a1 = st[2 * kl + 1]; w.x = cvt_pk_bf16(a0[0], a0[1]); w.y = cvt_pk_bf16(a0[2], a0[3]); w.z = cvt_pk_bf16(a1[0], a1[1]); w.w = cvt_pk_bf16(a1[2], a1[3]); so[kl] = __builtin_bit_cast(bf16x8, w); }
#pragma unroll
            for (int i = 0; i < 2; ++i) {
                f32x4 a1 = (f32x4){0.f, 0.f, 0.f, 0.f}, a2 = (f32x4){0.f, 0.f, 0.f, 0.f};
#pragma unroll
                for (int ks = 0; ks < 2; ++ks) a2 = MFMA16(bv[ks], pf[ks][i], a2);
#pragma unroll
                for (int kl = 0; kl < 2; ++kl) { a1 = MFMA16(so[kl], qo[kl][i], a1); a1 = MFMA16(sp[kl], qp[kl][i], a1); }
                const float den = s_int[i] * s_qn[i] + s_rs[i];
                const float rden = frcp(fmaxf(fabsf(den), s_emt[i]));
                hv[i] = (s_int[i] * a1 + s_r[i] * a2) * rden;
            }
#pragma unroll
            for (int i = 0; i < 4; ++i) { const int t = 4 * hf + i;
                f32x4 u = (f32x4){0.f, 0.f, 0.f, 0.f};
#pragma unroll
                for (int ks = 0; ks < 2; ++ks) { const bf16x8 a = frag_trs(bf + PB_K, 16 * t, ks, lane); u = MFMA16(a, bv[ks], u); }
                st[i] = decay * st[i] + sj * u;
            }
#pragma unroll
            for (int kl = 0; kl < 2; ++kl) { u32x4 w; const f32x4 a0 = st[2 * kl], a1 = st[2 * kl + 1]; w.x = cvt_pk_bf16(a0[0], a0[1]); w.y = cvt_pk_bf16(a0[2], a0[3]); w.z = cvt_pk_bf16(a1[0], a1[1]); w.w = cvt_pk_bf16(a1[2], a1[3]);
                LDS_WR(u32x4, lds + PB_XS + (j & 1) * 16384 + (vt * 2 + hf) * 2048 + kl * 1024 + lane * 16, w); }
            if (wave < 2) LDS_WR(float, lds + SM_NV + tid * 4, decay * LDS_RD(float, lds + SM_NV + tid * 4) + sj * LDS_RD(float, bf + PB_VEC + 1024 + tid * 4));
#pragma unroll
            for (int i = 0; i < 2; ++i) { float s_ = (hv[i][0] * hv[i][0] + hv[i][1] * hv[i][1]) + (hv[i][2] * hv[i][2] + hv[i][3] * hv[i][3]); s_ += __shfl_xor(s_, 16); s_ += __shfl_xor(s_, 32);
                LDS_WR(float, lds + SM_SSQ + (j & 1) * 1024 + ((16 * (2 * hf + i) + l15) * 4 + vt) * 4, s_); }
        }
    }
#undef MB_DMA
}

constexpr int P0_RB1 = (NP + NSG + 63) / 64, P0_I1 = (D / 64) * P0_RB1, P0_IU = (DA / 64) * (D / 64), P0_IO = (D / 64) * (D / 64), P0_NITEMS = P0_I1 + 2 * P0_IU + P0_IO;
DEV P0Desc p0_decode(const Args& args, int it) {
    unsigned char* ws = args.ws; bf16* W1T = (bf16*)(ws + WS_W1T); bf16* WUT = (bf16*)(ws + WS_WUT); bf16* WOT = (bf16*)(ws + WS_WOT);
    P0Desc d; int r = it;
    if (r < P0_I1) { const int kb = r / P0_RB1, rb = r % P0_RB1, r0 = 64 * rb; d.W = args.in[2]; d.ldw = D_IN; d.K = D; d.k0 = 64 * kb;
        if (r0 >= NPM && r0 < NP) { d.WT = ws + WS_W8; d.c0 = r0 + NSG; d.r0 = r0 - NPM; d.nv = 64; d.fp8 = 1; return d; }
        d.WT = W1T; d.fp8 = 0; d.r0 = r0;
        if (r0 < NPM) { d.c0 = r0; d.nv = 64; } else { d.c0 = NPM + (r0 - NP); d.nv = NSG - (r0 - NP) < 64 ? NSG - (r0 - NP) : 64; }
        return d; }
    r -= P0_I1; d.fp8 = 0; d.ldw = D; d.nv = 64;
    if (r < P0_IU) { const int kb = r / (D / 64), rb = r % (D / 64); d.W = args.in[10]; d.K = LDU; d.WT = WUT; d.k0 = 64 * kb; d.c0 = 64 * rb; d.r0 = 64 * rb; return d; }
    r -= P0_IU;
    if (r < P0_IU) { const int kb = r / (D / 64), rb = r % (D / 64); d.W = args.in[11]; d.K = LDU; d.WT = WUT + (size_t)D * LDU; d.k0 = 64 * kb; d.c0 = 64 * rb; d.r0 = 64 * rb; return d; }
    r -= P0_IU;
    { const int kb = r / (D / 64), rb = r % (D / 64); d.W = args.in[12]; d.K = D; d.WT = WOT; d.k0 = 64 * kb; d.c0 = 64 * rb; d.r0 = 64 * rb; return d; }
}
DEV void p0_items(const Args& args, int first, int last, int stride, ldsp scr, int lane) {
    if (first >= last) return;
    P0Desc d = p0_decode(args, first); f32x4 v[16]; p0_load(d, lane, v);
    for (int it = first; it < last; it += stride) {
        const int nx = it + stride; P0Desc dn = d; f32x4 vn[16];
        if (nx < last) { dn = p0_decode(args, nx); p0_load(dn, lane, vn); }
        p0_store(d, v, scr, lane);
        if (nx < last) { d = dn;
#pragma unroll
            for (int i = 0; i < 16; ++i) v[i] = vn[i]; }
    }
}

__global__ void __launch_bounds__(NTHREADS, 2) fwd_kernel(Args args) {
#ifndef EMU
    extern __shared__ __attribute__((aligned(16))) unsigned char lds_raw[];
    ldsp lds = (ldsp)lds_raw;
#else
    ldsp lds = emu_lds;
#endif
    const int tid = threadIdx.x, lane = tid & 63, wave = RFL(tid >> 6);
    const int G = gridDim.x, bx = blockIdx.x;
    const int vcu = (G % 8 == 0) ? (bx % 8) * (G / 8) + bx / 8 : bx;
    unsigned char* ws = args.ws;
#ifndef EMU
    for (int u = tid; u < (LDS_BYTES - LDSCTL_OFF) / 4; u += NTHREADS) ((LAS unsigned*)(lds + LDSCTL_OFF))[u] = 0u;
    __syncthreads();
    XcdBarrier bar = xcd_barrier_post((unsigned*)(ws + WS_CTL) + CW_BAR, (volatile LAS unsigned*)(lds + MISC_OFF) + 8);
#define GRID_BAR() xcd_barrier(bar)
#else
#define GRID_BAR()
#endif
    const int lo = args.ph_lo, hi = args.ph_hi;
#ifndef GEMM_SP2
#define GEMM_SP2 true
#endif
#ifndef GEMM_ALIGN
#define GEMM_ALIGN true
#endif
#ifndef PROBE_REP_P4
#define PROBE_REP_P4 1
#endif
#ifndef PROBE_REP_P5
#define PROBE_REP_P5 1
#endif
#ifndef PROBE_REP_P1
#define PROBE_REP_P1 2
#endif
#ifndef PROBE_REP_P2
#define PROBE_REP_P2 1
#endif
#ifndef PHASE_MASK
#define PHASE_MASK 255
#endif
#define IN(k) (((PHASE_MASK >> (k)) & 1) && lo <= (k) && (k) < hi)
#define BOTH(k) (IN(k) && IN((k) + 1))
    const float* x = args.in[0];
    bf16* W1T = (bf16*)(ws + WS_W1T); bf16* WUT = (bf16*)(ws + WS_WUT); bf16* WOT = (bf16*)(ws + WS_WOT);
    bf16* HBUF = (bf16*)(ws + WS_HB); bf16* PB = (bf16*)(ws + WS_P); float* SG = (float*)(ws + WS_SG); bf16* OAB = (bf16*)(ws + WS_OAB); float* RSS = (float*)(ws + WS_RSS);

    if (IN(0)) {
        ldsp scr = lds + wave * 17408;
        const int gw = vcu * NWAVES + wave, NGW = G * NWAVES;
        constexpr int I_1 = P0_I1, NITEMS = P0_NITEMS;
        static_assert(NPM % 64 == 0 && NP % 64 == 0 && NSG % 4 == 0, "P0 item tiling");
        constexpr int NJOBS3 = NB * HA * 2 + NB * HB * 4;
        const int nit0 = (G > NJOBS3) ? I_1 : NITEMS;
        p0_items(args, gw, nit0, NGW, scr, lane);
        const float* gpre = args.in[1];
        for (int m = gw; m < M; m += NGW) {
            const f32x4* xr = (const f32x4*)(x + (size_t)m * D) + lane;
            f32x4 v[D / 256]; float s = 0.f;
#pragma unroll
            for (int jj = 0; jj < D / 256; ++jj) { v[jj] = xr[64 * jj]; s += (v[jj][0] * v[jj][0] + v[jj][1] * v[jj][1]) + (v[jj][2] * v[jj][2] + v[jj][3] * v[jj][3]); }
            const float rstd = frsq(wave_sum(s) * (1.0f / D) + EPS) ;
            u32x2* o8 = (u32x2*)(HBUF + (size_t)m * D) + lane; unsigned* o4 = (unsigned*)(ws + WS_H8 + (size_t)m * D) + lane;
#pragma unroll
            for (int jj = 0; jj < D / 256; ++jj) { const f32x4 gg = ((const f32x4*)gpre)[lane + 64 * jj]; const f32x4 hh = v[jj] * rstd * gg; u32x2 w; w.x = pk2(hh[0], hh[1]); w.y = pk2(hh[2], hh[3]); o8[64 * jj] = w;
                o4[64 * jj] = pk_fp8x4(clamp8(hh[0] * H8_SCALE), clamp8(hh[1] * H8_SCALE), clamp8(hh[2] * H8_SCALE), clamp8(hh[3] * H8_SCALE)); }
        }
        if (BOTH(0)) GRID_BAR();
    }

    if (IN(1)) {
        {
            const int gw = vcu * NWAVES + wave, NGW = G * NWAVES, l15 = lane & 15, q4 = lane >> 4;
            const int wrow = NP + (l15 < NSG ? l15 : NSG - 1);
            for (int t = gw; t < M / 16; t += NGW) {
                f32x4 acc = (f32x4){0.f, 0.f, 0.f, 0.f};
                const bf16* ap = HBUF + (size_t)(16 * t + l15) * D + 8 * q4; const bf16* bp = W1T + (size_t)wrow * D + 8 * q4;
                for (int k0 = 0; k0 < D / 32; k0 += 16) {
                    bf16x8 af[16], bfr[16];
#pragma unroll
                    for (int i = 0; i < 16; ++i) { af[i] = *(const bf16x8*)(ap + 32 * (k0 + i)); bfr[i] = *(const bf16x8*)(bp + 32 * (k0 + i)); }
#pragma unroll
                    for (int i = 0; i < 16; ++i) acc = MFMA16(af[i], bfr[i], acc);
                }
#pragma unroll
                for (int r = 0; r < 4; ++r) SG[(size_t)(16 * t + 4 * q4 + r) * 16 + l15] = acc[r];
            }
        }
        { pg8::Gemm g{HBUF, W1T, M, NPM, D}; pg8::StaticOrder S; S.init(M, NPM, G, bx);
          EpiP E{PB};
          pg8::gemm_phase<EpiP, pg8::StaticOrder, GEMM_ALIGN, GEMM_SP2>(lds, g, S, E); }
        if (BOTH(1)) GRID_BAR();
    }

    if (IN(2)) {
        int buf = 0;
        if (bx < NUA + NUB) p2_issue(args, bx, lds + PA_RAW, wave, lane);
        for (int u = bx, it = 0; u < NUA + NUB; u += G, ++it) {
            int tidj = tid; OPAQUE(tidj); const int lane_ = tidj & 63;
            if (it == 0) WAIT_V(0); else WAIT_V(18);
            MIX_BAR();
            if (u + G < NUA + NUB) p2_issue(args, u + G, lds + PA_RAW + (buf ^ 1) * PA_RAWSZ, wave, lane_);
            p2_unit(args, lds, u, lds + PA_RAW + buf * PA_RAWSZ, wave, lane_);
            buf ^= 1;
        }
        if (BOTH(2)) GRID_BAR();
    }

    if (IN(3)) {
        constexpr int NJA = NB * HA * 2, NJB = NB * HB * 4;
        if (G > NJA + NJB && bx >= NJA + NJB) {
            ldsp scr = lds + wave * 17408;
            p0_items(args, P0_I1 + (bx - (NJA + NJB)) * NWAVES + wave, P0_NITEMS, (G - (NJA + NJB)) * NWAVES, scr, lane);
        }
        for (int job = bx; job < NJA + NJB; job += G) {
            if (job < NJA) mixer_a_job(args, lds, job / (2 * HA), (job >> 1) % HA, job & 1, tid);
            else { const int jb = job - NJA; mixer_b_job(args, lds, jb / (4 * HB), (jb >> 2) % HB, jb & 3, tid); }
            BLOCK_BAR();
        }
        if (BOTH(3)) GRID_BAR();
    }

    if (IN(4)) {
        const int gw = vcu * NWAVES + wave, NGW = G * NWAVES;
        const float* SSA = (const float*)(ws + WS_SSA); const float* SSB = (const float*)(ws + WS_SSB);
        static_assert(DA % 512 == 0 && DA == DB, "P3 tiling");
        for (int m = gw; m < M; m += NGW) {
#pragma unroll
            for (int br = 0; br < 2; ++br) {
#pragma unroll
                for (int i = 0; i < DA / 512; ++i) {
                    const int col0 = i * 512 + lane * 8;
                    float rstd;
                    if (br == 0) { const int hh = col0 / 128; rstd = frsq((SSA[((size_t)m * HA + hh) * 2] + SSA[((size_t)m * HA + hh) * 2 + 1]) * (1.0f / 128.0f) + EPS); }
                    else { const int hh = col0 / 256; const f32x4 q_ = *(const f32x4*)(SSB + ((size_t)m * HB + hh) * 4); rstd = frsq(((q_[0] + q_[1]) + (q_[2] + q_[3])) * (1.0f / 256.0f) + EPS); }
                    u32x4* po = (u32x4*)(OAB + (size_t)(br * M + m) * LDU + col0);
                    u32x4 w = *po; const u32x4 g8 = *(const u32x4*)(PB + p_off((size_t)m, (br ? C_OGB : C_OGA) + col0)), z8 = *(const u32x4*)(PB + p_off((size_t)m, (br ? C_ZB : C_ZA) + col0));
                    const f32x4 gn0 = *(const f32x4*)(args.in[br ? 9 : 8] + col0), gn1 = *(const f32x4*)(args.in[br ? 9 : 8] + col0 + 4);
#pragma unroll
                    for (int e = 0; e < 4; ++e) { float v[2];
#pragma unroll
                        for (int k = 0; k < 2; ++k) { const float ov = __builtin_bit_cast(float, k ? (w[e] & 0xffff0000u) : (w[e] << 16)), og = __builtin_bit_cast(float, k ? (g8[e] & 0xffff0000u) : (g8[e] << 16)), z = __builtin_bit_cast(float, k ? (z8[e] & 0xffff0000u) : (z8[e] << 16));
                            const float gnv = (e < 2 ? gn0 : gn1)[(2 * e + k) & 3];
                            v[k] = ov * rstd * gnv * sigm2(og) * (z * sigm2(z)); }
                        w[e] = cvt_pk_bf16(v[0], v[1]); }
                    *po = w;
                }
            }
        }
        if (BOTH(4)) GRID_BAR();
    }
    if (IN(5)) {
        { pg8::Gemm g8{(const bf16*)(ws + WS_H8), (const bf16*)(ws + WS_W8), M, 2 * D, D}; SchedGate S8; S8.so.init(M, D, G, bx);
          EpiP8 E8{PB};
          pg8::gemm_phase<EpiP8, SchedGate, GEMM_ALIGN, GEMM_SP2, 1>(lds, g8, S8, E8); }
        BLOCK_BAR();
        pg8::Gemm g{OAB, WUT, M, D, 2 * DA, LDU, (size_t)M * LDU * 2, (size_t)D * LDU * 2}; SchedRev S; S.init(M, D, G, bx);
        EpiUp2 E{HBUF, PB};
        for (int rep = 0; rep < PROBE_REP_P4; ++rep) pg8::gemm_phase<EpiUp2, SchedRev, GEMM_ALIGN, GEMM_SP2, 2, true>(lds, g, S, E);
        if (BOTH(5)) GRID_BAR();
    }

    if (IN(6)) {
        pg8::Gemm g{HBUF, WOT, M, D, D}; pg8::StaticOrder S; S.init(M, D, G, bx);
        EpiOut E{PB, RSS};
        for (int rep = 0; rep < PROBE_REP_P5; ++rep) pg8::gemm_phase<EpiOut, pg8::StaticOrder, GEMM_ALIGN, GEMM_SP2>(lds, g, S, E);
        if (BOTH(6)) GRID_BAR();
    }

    if (IN(7)) {
        const int gw = vcu * NWAVES + wave, NGW = G * NWAVES;
        const float* gpost = args.in[13];
        for (int m = gw; m < M; m += NGW) {
            const float ss = wave_sum(lane < NRS ? RSS[(size_t)m * NRS + lane] : 0.f);
            const float rstd = frsq(ss * (1.0f / D) + EPS);
            const f32x4* xr = (const f32x4*)(x + (size_t)m * D) + lane; f32x4* orow = (f32x4*)(args.out + (size_t)m * D) + lane; const u32x2* ob = (const u32x2*)(PB + (size_t)m * D) + lane;
#pragma unroll
            for (int jj = 0; jj < D / 256; ++jj) { const f32x4 xv = xr[64 * jj], gg = ((const f32x4*)gpost)[lane + 64 * jj]; const u32x2 w = ob[64 * jj];
                const f32x4 ov = (f32x4){__builtin_bit_cast(float, w.x << 16), __builtin_bit_cast(float, w.x & 0xffff0000u), __builtin_bit_cast(float, w.y << 16), __builtin_bit_cast(float, w.y & 0xffff0000u)};
                orow[64 * jj] = xv + ov * rstd * gg; }
        }
    }
#undef IN
#undef BOTH
}

#ifndef EMU
extern "C" void kernel_launch(void* const* d_in, const int* in_sizes, int n_in, void* d_out, int out_size, void* d_ws, size_t ws_size, hipStream_t stream) {
    static int grid = 0;
    if (grid == 0) {
        if (n_in != 14 || out_size != M * D || ws_size < WS_END) { fprintf(stderr, "kernel_launch: unexpected shapes (n_in %d, out %d, ws %zu < %zu)\n", n_in, out_size, ws_size, (size_t)WS_END); grid = -1; return; }
        int dev = 0, cus = 0, per_cu = 0;
        if (hipGetDevice(&dev) != hipSuccess || hipDeviceGetAttribute(&cus, hipDeviceAttributeMultiprocessorCount, dev) != hipSuccess) { grid = -1; return; }
        if (hipFuncSetAttribute((const void*)fwd_kernel, hipFuncAttributeMaxDynamicSharedMemorySize, LDS_BYTES) != hipSuccess) { fprintf(stderr, "kernel_launch: hipFuncSetAttribute failed\n"); grid = -1; return; }
        if (hipOccupancyMaxActiveBlocksPerMultiprocessor(&per_cu, (const void*)fwd_kernel, NTHREADS, LDS_BYTES) != hipSuccess || per_cu < 1) { fprintf(stderr, "kernel_launch: occupancy query says %d\n", per_cu); }
        (void)hipGetLastError();
        grid = cus;
    }
    if (grid < 0) return;
    (void)hipMemsetAsync((char*)d_ws + WS_CTL, 0, CTL_ZERO_BYTES, stream);
    Args a{};
    for (int i = 0; i < 14; ++i) a.in[i] = (const float*)d_in[i];
    a.out = (float*)d_out; a.ws = (unsigned char*)d_ws; a.ph_lo = 0; a.ph_hi = 8;
    hipLaunchKernelGGL(fwd_kernel, dim3(grid), dim3(NTHREADS), LDS_BYTES, stream, a);
}
#endif
```

```cpp
typedef unsigned u32x2_t __attribute__((ext_vector_type(2)));
typedef int v8i_t __attribute__((ext_vector_type(8)));
typedef int v4i_t __attribute__((ext_vector_type(4)));
#ifndef EMU
#include <hip/hip_runtime.h>
#include <cstdio>
#include <cstdint>
#define LAS __attribute__((address_space(3)))
#define GAS __attribute__((address_space(1)))
typedef short bf16x8 __attribute__((ext_vector_type(8)));
typedef short bf16x4 __attribute__((ext_vector_type(4)));
typedef float f32x4 __attribute__((ext_vector_type(4)));
#define DEV __device__ __forceinline__
#define LDS_RD(T, p) (*(const LAS T*)(p))
#define LDS_WR(T, p, v) (*(LAS T*)(p) = (v))
#define WAVE_SYNC() asm volatile("s_waitcnt lgkmcnt(0)" ::: "memory")
#define BLOCK_BAR() __syncthreads()
#define RAW_BAR() __builtin_amdgcn_s_barrier()
#define WAIT_V(n) asm volatile("s_waitcnt vmcnt(" #n ")" ::: "memory")
#define WAIT_L(n) asm volatile("s_waitcnt lgkmcnt(" #n ")" ::: "memory")
#define SCHED_BAR() __builtin_amdgcn_sched_barrier(0)
#define SETPRIO(n) __builtin_amdgcn_s_setprio(n)
#define GLDS16(g, l) __builtin_amdgcn_global_load_lds((const unsigned*)(g), (LAS unsigned*)(l), 16, 0, 0)
#define MFMA16(a, b, c) __builtin_amdgcn_mfma_f32_16x16x32_bf16(a, b, c, 0, 0, 0)
#define RFL(x) __builtin_amdgcn_readfirstlane(x)
#define COMPILER_FENCE() asm volatile("" ::: "memory")
#define OPAQUE(x) asm volatile("" : "+v"(x))
DEV float fexp2(float x) { return __builtin_amdgcn_exp2f(x); }
DEV float flog2(float x) { return __builtin_amdgcn_logf(x); }
DEV float frcp(float x) { return __builtin_amdgcn_rcpf(x); }
DEV float frsq(float x) { return __builtin_amdgcn_rsqf(x); }
DEV unsigned cvt_pk_bf16(float lo, float hi) { unsigned r; asm volatile("v_cvt_pk_bf16_f32 %0, %1, %2" : "=v"(r) : "v"(lo), "v"(hi)); return r; }
DEV f32x4 mfma8(v8i_t a, v8i_t b, f32x4 c, int sc) { asm volatile("v_mfma_scale_f32_16x16x128_f8f6f4 %0, %1, %2, %0, %3, %3 op_sel_hi:[0,0,0]" : "+v"(c) : "v"(a), "v"(b), "v"(sc)); return c; }
#define MFMA_DRAIN() asm volatile("s_nop 15\n\ts_nop 7" ::: "memory")
DEV unsigned pk_fp8x4(float a, float b, float c, float d) { int r = __builtin_amdgcn_cvt_pk_fp8_f32(a, b, 0, false); r = __builtin_amdgcn_cvt_pk_fp8_f32(c, d, r, true); return (unsigned)r; }
typedef short v4i16_t __attribute__((ext_vector_type(4)));
DEV bf16x4 lds_tr16(LAS unsigned char* p) { return __builtin_bit_cast(bf16x4, __builtin_amdgcn_ds_read_tr16_b64_v4i16((LAS v4i16_t*)p)); }
#define MIX_BAR() do { asm volatile("s_waitcnt lgkmcnt(0)" ::: "memory"); __builtin_amdgcn_s_barrier(); asm volatile("" ::: "memory"); } while (0)
DEV void glds16_asm(const void* gsrc, unsigned lds_dst) { unsigned keep;
    asm volatile("s_mov_b32 %0, m0\n\ts_mov_b32 m0, %2\n\ts_nop 0\n\tglobal_load_lds_dwordx4 %1, off\n\ts_mov_b32 m0, %0" : "=&s"(keep) : "v"(gsrc), "s"(lds_dst) : "memory"); }
#define GLDS16X(g, l) glds16_asm((const void*)(g), (unsigned)RFL((int)(unsigned)(__UINTPTR_TYPE__)(l)))
DEV void glds16_sbase(const void* sbase, unsigned voff, unsigned lds_dst) { unsigned keep;
    asm volatile("s_mov_b32 %0, m0\n\ts_mov_b32 m0, %3\n\ts_nop 0\n\tglobal_load_lds_dwordx4 %1, %2\n\ts_mov_b32 m0, %0" : "=&s"(keep) : "v"(voff), "s"(sbase), "s"(lds_dst) : "memory"); }
#define GLDS16S(sb, vo, l) glds16_sbase((const void*)(sb), (unsigned)(vo), (unsigned)RFL((int)(unsigned)(__UINTPTR_TYPE__)(l)))
typedef __amdgpu_buffer_rsrc_t rsrc_t;
DEV rsrc_t make_rsrc(const void* p, unsigned bytes) { return __builtin_amdgcn_make_buffer_rsrc((void*)p, (short)0, (int)bytes, 0x00020000); }
DEV unsigned short bload16(rsrc_t r, unsigned voff, unsigned soff) { return (unsigned short)__builtin_amdgcn_raw_buffer_load_b16(r, (int)voff, (int)soff, 0); }
DEV void bstore16(rsrc_t r, unsigned voff, unsigned soff, unsigned short v) { __builtin_amdgcn_raw_buffer_store_b16(v, r, (int)voff, (int)soff, 0); }
DEV void bstore64(rsrc_t r, unsigned voff, unsigned soff, u32x2_t v) { __builtin_amdgcn_raw_buffer_store_b64(v, r, (int)voff, (int)soff, 0); }
typedef unsigned u32x4_t __attribute__((ext_vector_type(4)));
DEV u32x4_t bload128(rsrc_t r, unsigned voff, unsigned soff) { return __builtin_amdgcn_raw_buffer_load_b128(r, (int)voff, (int)soff, 0); }
#else
#define LAS
#define GAS
#define DEV inline
#define LDS_RD(T, p) emu_lds_rd<T>((const void*)(p), #p)
#define LDS_WR(T, p, v) emu_lds_wr<T>((void*)(p), (T)(v), #p)
#define WAVE_SYNC() emu_wavesync()
#define BLOCK_BAR() emu_syncthreads()
#define RAW_BAR() emu_syncthreads()
#define WAIT_V(n)
#define WAIT_L(n)
#define SCHED_BAR()
#define SETPRIO(n)
#define GLDS16(g, l) emu_glds16((const void*)(g), (unsigned char*)(l))
#define GLDS16X(g, l) emu_glds16((const void*)(g), (unsigned char*)(l))
#define GLDS16S(sb, vo, l) emu_glds16((const void*)((const char*)(sb) + (vo)), (unsigned char*)(l))
#define MFMA16(a, b, c) emu_mfma16(a, b, c)
#define RFL(x) (x)
#define COMPILER_FENCE()
#define OPAQUE(x)
DEV float fexp2(float x) { return exp2f(x); }
DEV float flog2(float x) { return log2f(x); }
DEV float frcp(float x) { return 1.0f / x; }
DEV float frsq(float x) { return 1.0f / sqrtf(x); }
DEV unsigned cvt_pk_bf16(float lo, float hi) { return (unsigned)emu_f2bf(lo) | ((unsigned)emu_f2bf(hi) << 16); }
#define mfma8(a, b, c, sc) emu_mfma8(a, b, c)
#define MFMA_DRAIN()
DEV unsigned pk_fp8x4(float a, float b, float c, float d) { return (unsigned)emu_f2fp8(a) | ((unsigned)emu_f2fp8(b) << 8) | ((unsigned)emu_f2fp8(c) << 16) | ((unsigned)emu_f2fp8(d) << 24); }
#define lds_tr16(p) emu_lds_tr16((const unsigned char*)(p))
#define MIX_BAR() emu_syncthreads()
typedef unsigned char* rsrc_t;
DEV rsrc_t make_rsrc(const void* p, unsigned) { return (unsigned char*)p; }
DEV unsigned short bload16(rsrc_t r, unsigned voff, unsigned soff) { unsigned short v; memcpy(&v, r + (size_t)voff + soff, 2); return v; }
DEV void bstore16(rsrc_t r, unsigned voff, unsigned soff, unsigned short v) { memcpy(r + (size_t)voff + soff, &v, 2); }
DEV void bstore64(rsrc_t r, unsigned voff, unsigned soff, u32x2_t v) { memcpy(r + (size_t)voff + soff, &v, 8); }
typedef unsigned u32x4_t __attribute__((ext_vector_type(4)));
DEV u32x4_t bload128(rsrc_t r, unsigned voff, unsigned soff) { u32x4_t v; memcpy(&v, r + (size_t)voff + soff, 16); return v; }
#endif

typedef unsigned short bf16;
typedef unsigned u32x4 __attribute__((ext_vector_type(4)));
typedef unsigned u32x2 __attribute__((ext_vector_type(2)));
typedef float f32x2 __attribute__((ext_vector_type(2)));
typedef LAS unsigned char* ldsp;

#ifndef CFG_D
#define CFG_D 4096
#define CFG_B 4
#define CFG_S 4096
#define CFG_HB 8
#endif
constexpr int D = CFG_D, NB = CFG_B, SEQ = CFG_S, M = NB * SEQ;
constexpr int DA = D / 2, HA = DA / 128, DB = D / 2, HB = CFG_HB, DVB = DB / HB, DKB = 128, DQK = HB * DKB;
constexpr int NSG = 2 * HB;
constexpr int NCH = SEQ / 64;
static_assert(DVB == 256 && NSG <= 16 && SEQ % 64 == 0 && M % 256 == 0 && D % 256 == 0, "shape");
constexpr int C_QA = 0, C_FA = DA, C_IA = 2 * DA, C_OGA = 3 * DA, C_ZA = 4 * DA, C_QB = 5 * DA, C_KB = C_QB + DQK, C_VB = C_KB + DQK, C_OGB = C_VB + DB, C_ZB = C_OGB + DB;
constexpr int NPM = C_ZB + DB, C_GA = NPM, C_GB = NPM + D, NP = NPM + 2 * D, D_IN = NP + NSG;
static_assert(NPM % 256 == 0 && NP % 256 == 0, "column map");
constexpr float EPS = 1e-6f;
constexpr float H8_SCALE = 64.0f, W8_SCALE = 1024.0f, G8_DESCALE = 1.0f / (64.0f * 1024.0f);
constexpr float LOG2E = 1.4426950408889634f, LN2 = 0.6931471805599453f;
constexpr int NRS = D / 64;
constexpr int PT_PITCH = M / 64 + 1;
DEV size_t p_off(size_t row, int col) { return ((size_t)(col >> 7) * (size_t)PT_PITCH + (row >> 6)) * 8192 + (row & 63) * 128 + (size_t)(col & 127); }

constexpr size_t al256(size_t x) { return (x + 255) & ~(size_t)255; }
constexpr size_t WS_CTL = 0, CTL_ZERO_BYTES = 65536;
constexpr size_t WS_W1T = 1u << 20;
constexpr int LDU = DA + 64;
constexpr size_t WS_WUT = al256(WS_W1T + (size_t)(NP + 16) * D * 2);
constexpr size_t WS_WOT = al256(WS_WUT + (size_t)2 * D * LDU * 2);
constexpr size_t WS_HB = al256(WS_WOT + (size_t)D * D * 2);
constexpr size_t WS_P = al256(WS_HB + (size_t)M * D * 2);
constexpr size_t WS_SG = al256(WS_P + (size_t)(NP / 128) * (M / 64 + 1) * 16384 + 4096);
constexpr size_t WS_OAB = al256(WS_SG + (size_t)M * 16 * 4);
constexpr size_t WS_RSS = al256(WS_OAB + (size_t)2 * M * LDU * 2);
constexpr size_t WS_SSB = al256(WS_RSS + (size_t)M * NRS * 4);
constexpr size_t WS_SSA = al256(WS_SSB + (size_t)M * HB * 4 * 4);
constexpr size_t WS_H8 = al256(WS_SSA + (size_t)M * HA * 2 * 4);
constexpr size_t WS_W8 = al256(WS_H8 + (size_t)M * D);
constexpr size_t WS_END = al256(WS_W8 + (size_t)2 * D * D);
constexpr int CW_BAR = 1024;

constexpr int RING_BYTES = 154624, LDSCTL_OFF = RING_BYTES, MISC_OFF = LDSCTL_OFF + 320, LDS_BYTES = 155648;
constexpr int NWAVES = 8, NTHREADS = 512;

DEV unsigned f2bf(float f) { unsigned u = __builtin_bit_cast(unsigned, f); return (u + 0x7fffu + ((u >> 16) & 1u)) >> 16; }
DEV float bf2f(unsigned b) { return __builtin_bit_cast(float, b << 16); }
DEV unsigned pk2(float lo, float hi) { return f2bf(lo) | (f2bf(hi) << 16); }
DEV float fexp(float x) { return fexp2(x * LOG2E); }
DEV float flog(float x) { return flog2(x) * LN2; }
DEV float sigm(float x) { return frcp(1.0f + fexp(-x)); }
DEV float logsig(float x) { return fminf(x, 0.f) - flog(1.0f + fexp(-fabsf(x))); }
DEV float wave_sum(float v) {
#pragma unroll
    for (int o = 1; o < 64; o <<= 1) v += __shfl_xor(v, o);
    return v;
}

namespace pg8 {
constexpr int BM = 256, BK = 64, HALF = 128, HTB = HALF * BK * 2, STAGE_BYTES = 8 * HTB, NXCD = 8, WGM = 8;
DEV int lds_byte(int r, int c) { const int st = (r >> 4) * 2 + (c >> 5), rr = r & 15, cc = c & 31, ob = rr * 64 + cc * 2; return st * 1024 + (ob ^ (((ob >> 9) & 1) << 5)); }
DEV void stage_rc(int b, int& R, int& C) { const int st = b / 1024, sb = b % 1024, swz = sb ^ (((sb >> 9) & 1) << 5); R = (st >> 1) * 16 + swz / 64; C = (st & 1) * 32 + (swz % 64) / 2; }
DEV int perm32(int rho) { const int n = rho >> 4, i = rho & 15; return 8 * (i >> 2) + 4 * n + (i & 3); }
struct Unit { int pm, pn; };
struct Gemm { const bf16* A; const bf16* Bt; int M, N, K; int ld; size_t a2off, b2off; };
struct StaticOrder {
    int nM, nN, nwg, G, c;
    DEV void init(int M_, int N_, int G_, int c_) { nM = M_ / BM; nN = N_ / BM; nwg = nM * nN; G = G_; c = c_; }
    DEV bool next(int i, Unit& u) const {
        const long L = (long)i * G + c; if (L >= nwg) return false;
        int wgid = (int)L; { const int q = nwg / NXCD, r = nwg % NXCD, xcd = wgid % NXCD, off = wgid / NXCD; wgid = (xcd < r ? xcd * (q + 1) : r * (q + 1) + (xcd - r) * q) + off; }
        const int nig = WGM * nN, gid = wgid / nig, fm = gid * WGM, gsz = (nM - fm) < WGM ? (nM - fm) : WGM;
        u.pm = fm + ((wgid % nig) % gsz); u.pn = (wgid % nig) / gsz; return true;
    }
};
template <class Epi, class Sched, bool ALIGN_EPI = false, bool SP2 = false, int ESZ = 2, bool SPLITK = false>
DEV void gemm_phase(ldsp lds, const Gemm g, const Sched& S, const Epi& E) {
    const int tid = threadIdx.x, wid = RFL(tid >> 6), lane = tid & 63, wr = wid >> 2, wc = wid & 3, fr = lane & 15, fq = lane >> 4;
    const int nt = (g.K * ESZ / 2) / BK, K = (g.ld ? g.ld : g.K) * ESZ / 2;
    unsigned voffA[2], voffB[2];
#pragma unroll
    for (int i = 0; i < 2; ++i) { int R, C; stage_rc(tid * 16 + i * 8192, R, C); const int Rb = Epi::PERM ? ((R & ~31) + perm32(R & 31)) : R;
        voffA[i] = (unsigned)(R * K + C) * 2u; voffB[i] = (unsigned)(Rb * K + C) * 2u; }
    const size_t kstep = (size_t)(BK * 2);
    const size_t hstep = (size_t)HALF * K * 2;
    const size_t tstep = 2 * hstep;
    const unsigned ldsw = (unsigned)wid * 1024u;
    int aoffk[2], boffk[2];
#pragma unroll
    for (int k = 0; k < 2; ++k) { const int ch = ESZ == 2 ? fq + 4 * k : 2 * fq + k;
        aoffk[k] = lds_byte(wr * 64 + fr, (ch & 3) * 8) + (ch >> 2) * 1024; boffk[k] = lds_byte(wc * 32 + fr, (ch & 3) * 8) + (ch >> 2) * 1024; }
#define PG8_SA(b, h) (((b) * 2 + (h)) * HTB)
#define PG8_SB(b, h) ((4 + (b) * 2 + (h)) * HTB)
#define PG8_STAGE(bufoff, gbase, voff) do { _Pragma("unroll") for (int _i = 0; _i < 2; ++_i) \
        GLDS16((const char*)(gbase) + (voff)[_i], lds + (bufoff) + ldsw + _i * 8192); } while (0)
#define PG8_LDA(dst, b, h) do { _Pragma("unroll") for (int m = 0; m < 4; ++m) { if constexpr (ESZ == 2) { _Pragma("unroll") for (int k = 0; k < 2; ++k) dst[m][k] = *(const LAS bf16x8*)(lds + PG8_SA(b, h) + aoffk[k] + m * 2048); } \
        else dst##8[m] = __builtin_shufflevector(*(const LAS v4i_t*)(lds + PG8_SA(b, h) + aoffk[0] + m * 2048), *(const LAS v4i_t*)(lds + PG8_SA(b, h) + aoffk[1] + m * 2048), 0, 1, 2, 3, 4, 5, 6, 7); } } while (0)
#define PG8_LDB(dst, b, h) do { _Pragma("unroll") for (int n = 0; n < 2; ++n) { if constexpr (ESZ == 2) { _Pragma("unroll") for (int k = 0; k < 2; ++k) dst[n][k] = *(const LAS bf16x8*)(lds + PG8_SB(b, h) + boffk[k] + n * 2048); } \
        else dst##8[n] = __builtin_shufflevector(*(const LAS v4i_t*)(lds + PG8_SB(b, h) + boffk[0] + n * 2048), *(const LAS v4i_t*)(lds + PG8_SB(b, h) + boffk[1] + n * 2048), 0, 1, 2, 3, 4, 5, 6, 7); } } while (0)
#define PG8_MMA(ai, bj, At, Bt) do { SETPRIO(1); _Pragma("unroll") for (int m = 0; m < 4; ++m) _Pragma("unroll") for (int n = 0; n < 2; ++n) { \
        if constexpr (ESZ == 2) { _Pragma("unroll") for (int k = 0; k < 2; ++k) acc[ai][bj][m][n] = MFMA16(Bt[n][k], At[m][k], acc[ai][bj][m][n]); } \
        else acc[ai][bj][m][n] = mfma8(Bt##8[n], At##8[m], acc[ai][bj][m][n], sc8); } SETPRIO(0); } while (0)
    int sc8 = 0x7f7f7f7f; OPAQUE(sc8);
    Unit cur, nxt; int ui = 0;
    if (!S.next(0, cur)) return;
    f32x4 acc[2][2][4][2];
#pragma unroll
    for (int a = 0; a < 2; ++a)
#pragma unroll
        for (int b = 0; b < 2; ++b)
#pragma unroll
            for (int m = 0; m < 4; ++m)
#pragma unroll
                for (int n = 0; n < 2; ++n) acc[a][b][m][n] = (f32x4){0.f, 0.f, 0.f, 0.f};
    bf16x8 At[ESZ == 2 ? 4 : 1][2], B0[ESZ == 2 ? 2 : 1][2], B1[ESZ == 2 ? 2 : 1][2];
    v8i_t At8[ESZ == 1 ? 4 : 1], B08[ESZ == 1 ? 2 : 1], B18[ESZ == 1 ? 2 : 1];
    const char* cA = (const char*)g.A + (size_t)cur.pm * tstep; const char* cB = (const char*)g.Bt + (size_t)cur.pn * tstep;
    if constexpr (SP2) {
        PG8_STAGE(PG8_SB(0, 0), cB, voffB); PG8_STAGE(PG8_SB(0, 1), cB + hstep, voffB); PG8_STAGE(PG8_SA(0, 0), cA, voffA); PG8_STAGE(PG8_SA(0, 1), cA + hstep, voffA);
        if (wr == 1) RAW_BAR();
        WAIT_V(2); RAW_BAR();
        PG8_STAGE(PG8_SB(1, 0), cB + kstep, voffB); PG8_STAGE(PG8_SA(1, 0), cA + kstep, voffA); PG8_STAGE(PG8_SB(1, 1), cB + hstep + kstep, voffB);
        WAIT_V(6); RAW_BAR();
    } else {
        PG8_STAGE(PG8_SB(0, 0), cB, voffB); PG8_STAGE(PG8_SA(0, 0), cA, voffA); PG8_STAGE(PG8_SB(0, 1), cB + hstep, voffB); PG8_STAGE(PG8_SA(0, 1), cA + hstep, voffA);
        if (wr == 1) RAW_BAR();
        WAIT_V(4); RAW_BAR();
        PG8_STAGE(PG8_SB(1, 0), cB + kstep, voffB); PG8_STAGE(PG8_SA(1, 0), cA + kstep, voffA); PG8_STAGE(PG8_SB(1, 1), cB + hstep + kstep, voffB);
        WAIT_V(6); RAW_BAR();
    }
    for (;;) {
        const bool has_next = S.next(ui + 1, nxt);
        const char* nA = has_next ? (const char*)g.A + (size_t)nxt.pm * tstep : cA; const char* nB = has_next ? (const char*)g.Bt + (size_t)nxt.pn * tstep : cB;
        for (int t = 0; t < nt; t += 2) {
            const bool last = (t == nt - 2);
            const size_t h1 = (SPLITK && t >= nt / 2) ? 1 : 0, h2 = (SPLITK && t + 2 >= nt / 2) ? 1 : 0;
            const char* a1 = cA + (size_t)(t + 1) * kstep + h1 * (g.a2off - (size_t)(nt / 2) * kstep);
            const char* a2 = last ? nA : cA + (size_t)(t + 2) * kstep + h2 * (g.a2off - (size_t)(nt / 2) * kstep); const char* b2 = last ? nB : cB + (size_t)(t + 2) * kstep + h2 * (g.b2off - (size_t)(nt / 2) * kstep);
            const char* a3 = a2 + kstep; const char* b3 = b2 + kstep;
            if constexpr (SPLITK) { if (t == nt / 2) {
                if constexpr (ALIGN_EPI) { if (wr == 0) RAW_BAR(); }
                int fr_ = fr; OPAQUE(fr_); E.mid(acc, cur, wr, wc, fr_, fq);
                if constexpr (ALIGN_EPI) { if (wr == 1) RAW_BAR(); } } }
            if constexpr (SP2) {
            PG8_LDB(B0, 0, 0); PG8_LDB(B1, 0, 1); SCHED_BAR(); PG8_LDA(At, 0, 0); PG8_STAGE(PG8_SA(1, 1), a1 + hstep, voffA);
            WAIT_V(8); WAIT_L(0); RAW_BAR(); PG8_MMA(0, 0, At, B0); PG8_MMA(0, 1, At, B1); RAW_BAR(); SCHED_BAR();
            PG8_LDA(At, 0, 1); PG8_STAGE(PG8_SB(0, 0), b2, voffB); PG8_STAGE(PG8_SB(0, 1), b2 + hstep, voffB); PG8_STAGE(PG8_SA(0, 0), a2, voffA);
            WAIT_V(8); WAIT_L(0); RAW_BAR(); PG8_MMA(1, 0, At, B0); PG8_MMA(1, 1, At, B1); RAW_BAR(); SCHED_BAR();
            PG8_LDB(B0, 1, 0); PG8_LDB(B1, 1, 1); SCHED_BAR(); PG8_LDA(At, 1, 0); PG8_STAGE(PG8_SA(0, 1), a2 + hstep, voffA);
            WAIT_V(8); WAIT_L(0); RAW_BAR(); PG8_MMA(0, 0, At, B0); PG8_MMA(0, 1, At, B1); RAW_BAR(); SCHED_BAR();
            PG8_LDA(At, 1, 1); PG8_STAGE(PG8_SB(1, 0), b3, voffB); PG8_STAGE(PG8_SB(1, 1), b3 + hstep, voffB); PG8_STAGE(PG8_SA(1, 0), a3, voffA);
            WAIT_V(8); WAIT_L(0); RAW_BAR(); PG8_MMA(1, 0, At, B0); PG8_MMA(1, 1, At, B1); RAW_BAR(); SCHED_BAR();
            } else {
            PG8_LDB(B0, 0, 0); SCHED_BAR(); PG8_LDA(At, 0, 0); PG8_STAGE(PG8_SA(1, 1), a1 + hstep, voffA);
            WAIT_L(8); RAW_BAR(); WAIT_L(0); PG8_MMA(0, 0, At, B0); RAW_BAR(); SCHED_BAR();
            PG8_LDB(B1, 0, 1); PG8_STAGE(PG8_SB(0, 0), b2, voffB);
            RAW_BAR(); WAIT_L(0); PG8_MMA(0, 1, At, B1); RAW_BAR();
            PG8_LDA(At, 0, 1); PG8_STAGE(PG8_SA(0, 0), a2, voffA);
            RAW_BAR(); WAIT_L(0); PG8_MMA(1, 0, At, B0); RAW_BAR(); SCHED_BAR();
            PG8_STAGE(PG8_SB(0, 1), b2 + hstep, voffB);
            WAIT_V(6); RAW_BAR(); PG8_MMA(1, 1, At, B1); RAW_BAR();
            PG8_LDB(B0, 1, 0); SCHED_BAR(); PG8_LDA(At, 1, 0); PG8_STAGE(PG8_SA(0, 1), a2 + hstep, voffA);
            WAIT_L(8); RAW_BAR(); WAIT_L(0); PG8_MMA(0, 0, At, B0); RAW_BAR(); SCHED_BAR();
            PG8_LDB(B1, 1, 1); PG8_STAGE(PG8_SB(1, 0), b3, voffB);
            RAW_BAR(); WAIT_L(0); PG8_MMA(0, 1, At, B1); RAW_BAR();
            PG8_LDA(At, 1, 1); PG8_STAGE(PG8_SA(1, 0), a3, voffA);
            RAW_BAR(); WAIT_L(0); PG8_MMA(1, 0, At, B0); RAW_BAR(); SCHED_BAR();
            PG8_STAGE(PG8_SB(1, 1), b3 + hstep, voffB);
            WAIT_V(6); RAW_BAR(); PG8_MMA(1, 1, At, B1); RAW_BAR();
            }
        }
        if constexpr (ALIGN_EPI) { if (wr == 0) RAW_BAR(); }
        if constexpr (ESZ == 1) { MFMA_DRAIN();
#pragma unroll
            for (int a = 0; a < 2; ++a)
#pragma unroll
                for (int b = 0; b < 2; ++b) asm volatile("" : "+v"(acc[a][b][0][0]), "+v"(acc[a][b][0][1]), "+v"(acc[a][b][1][0]), "+v"(acc[a][b][1][1]), "+v"(acc[a][b][2][0]), "+v"(acc[a][b][2][1]), "+v"(acc[a][b][3][0]), "+v"(acc[a][b][3][1])); }
        E(acc, cur, wr, wc, fr, fq);
        if (!has_next) break;
#pragma unroll
        for (int a = 0; a < 2; ++a)
#pragma unroll
            for (int b = 0; b < 2; ++b)
#pragma unroll
                for (int m = 0; m < 4; ++m)
#pragma unroll
                    for (int n = 0; n < 2; ++n) acc[a][b][m][n] = (f32x4){0.f, 0.f, 0.f, 0.f};
        cur = nxt; cA = nA; cB = nB; ++ui;
        if constexpr (ALIGN_EPI) { if (wr == 1) RAW_BAR(); }
    }
    WAIT_V(0);
    if constexpr (!ALIGN_EPI) { if (wr == 0) RAW_BAR(); }
    RAW_BAR();
#undef PG8_SA
#undef PG8_SB
#undef PG8_STAGE
#undef PG8_LDA
#undef PG8_LDB
#undef PG8_MMA
}
}

struct EpiP {
    static constexpr bool PERM = true;
    bf16* O;
    DEV void operator()(const f32x4 (&acc)[2][2][4][2], const pg8::Unit& u, int wr, int wc, int fr, int fq) const {
        const int row0 = u.pm * 256 + wr * 64 + fr, col0 = u.pn * 256 + wc * 32 + 8 * fq;
#pragma unroll
        for (int ai = 0; ai < 2; ++ai)
#pragma unroll
            for (int m = 0; m < 4; ++m) { const size_t row = (size_t)(row0 + ai * 128 + m * 16);
#pragma unroll
                for (int bj = 0; bj < 2; ++bj) { const f32x4 v0 = acc[ai][bj][m][0], v1 = acc[ai][bj][m][1];
                    u32x4 w; w.x = cvt_pk_bf16(v0[0], v0[1]); w.y = cvt_pk_bf16(v0[2], v0[3]); w.z = cvt_pk_bf16(v1[0], v1[1]); w.w = cvt_pk_bf16(v1[2], v1[3]);
                    *(u32x4*)(O + p_off(row, col0 + bj * 128)) = w; } }
    }
};
struct EpiP8 {
    static constexpr bool PERM = true;
    bf16* O;
    DEV void operator()(const f32x4 (&acc)[2][2][4][2], const pg8::Unit& u, int wr, int wc, int fr, int fq) const {
        const int row0 = u.pm * 256 + wr * 64 + fr, col0 = NPM + u.pn * 256 + wc * 32 + 8 * fq;
#pragma unroll
        for (int ai = 0; ai < 2; ++ai)
#pragma unroll
            for (int m = 0; m < 4; ++m) { const size_t row = (size_t)(row0 + ai * 128 + m * 16);
#pragma unroll
                for (int bj = 0; bj < 2; ++bj) { const f32x4 v0 = acc[ai][bj][m][0] * G8_DESCALE, v1 = acc[ai][bj][m][1] * G8_DESCALE;
                    u32x4 w; w.x = cvt_pk_bf16(v0[0], v0[1]); w.y = cvt_pk_bf16(v0[2], v0[3]); w.z = cvt_pk_bf16(v1[0], v1[1]); w.w = cvt_pk_bf16(v1[2], v1[3]);
                    *(u32x4*)(O + p_off(row, col0 + bj * 128)) = w; } }
    }
};
struct SchedUp {
    pg8::StaticOrder so;
    DEV bool next(int i, pg8::Unit& u) const { if (!so.next(i >> 1, u)) return false; if (i & 1) { u.pm += M / 256; u.pn += D / 256; } return true; }
};
struct EpiUp {
    static constexpr bool PERM = true;
    bf16* Y; const bf16* P;
    DEV void operator()(const f32x4 (&acc)[2][2][4][2], const pg8::Unit& u, int wr, int wc, int fr, int fq) const {
        const int br = u.pm >= M / 256 ? 1 : 0, pm = u.pm - br * (M / 256), pn = u.pn - br * (D / 256);
        const int row0 = pm * 256 + wr * 64 + fr, col0 = pn * 256 + wc * 32 + 8 * fq, gcol = (br ? C_GB : C_GA) + col0;
#pragma unroll
        for (int ai = 0; ai < 2; ++ai)
#pragma unroll
            for (int m = 0; m < 4; ++m) { const size_t row = (size_t)(row0 + ai * 128 + m * 16);
#pragma unroll
                for (int bj = 0; bj < 2; ++bj) {
                    const u32x4 g8 = *(const u32x4*)(P + p_off(row, gcol + bj * 128));
                    bf16* yp = Y + row * D + col0 + bj * 128;
                    u32x4 y8 = (u32x4){0u, 0u, 0u, 0u}; if (br) y8 = *(const u32x4*)yp;
                    const f32x4 v0 = acc[ai][bj][m][0], v1 = acc[ai][bj][m][1];
                    float o[8];
#pragma unroll
                    for (int k = 0; k < 8; ++k) { const unsigned gw = g8[k >> 1], yw = y8[k >> 1]; const float gv = bf2f((k & 1) ? (gw >> 16) : (gw & 0xffffu)), yv = bf2f((k & 1) ? (yw >> 16) : (yw & 0xffffu));
                        const float a = k < 4 ? v0[k & 3] : v1[k & 3]; o[k] = yv + sigm(gv) * a; }
                    u32x4 w; w.x = cvt_pk_bf16(o[0], o[1]); w.y = cvt_pk_bf16(o[2], o[3]); w.z = cvt_pk_bf16(o[4], o[5]); w.w = cvt_pk_bf16(o[6], o[7]);
                    *(u32x4*)yp = w; } }
    }
};
struct SchedGate { pg8::StaticOrder so; DEV bool next(int i, pg8::Unit& u) const { if (!so.next(i >> 1, u)) return false; if (i & 1) u.pn += D / 256; return true; } };
struct SchedRev { pg8::StaticOrder so; int n; DEV void init(int M_, int N_, int G_, int c_) { so.init(M_, N_, G_, c_); n = so.nwg > c_ ? (so.nwg - c_ + G_ - 1) / G_ : 0; }
    DEV bool next(int i, pg8::Unit& u) const { return i < n && so.next(n - 1 - i, u); } };
constexpr unsigned P_BYTES = (unsigned)((size_t)(NP / 128) * PT_PITCH * 16384);
DEV unsigned p_soff(int pm, int cb, int ai, int m, int wr, int wc) { return (unsigned)((cb * PT_PITCH + 4 * pm + 2 * ai + wr) * 16384 + m * 4096 + wc * 64); }
constexpr unsigned GB_MINUS_GA = (unsigned)((D / 128) * PT_PITCH) * 16384u;
struct EpiUp2 {
    static constexpr bool PERM = true;
    bf16* Y; rsrc_t rs;
    DEV void mid(f32x4 (&acc)[2][2][4][2], const pg8::Unit& u, int wr, int wc, int fr, int fq) const {
        const unsigned voff = (unsigned)(fr * 256 + fq * 16);
#pragma unroll
        for (int ai = 0; ai < 2; ++ai) { u32x4 ga[8], gb[8];
#pragma unroll
            for (int s_ = 0; s_ < 8; ++s_) { const unsigned so = p_soff(u.pm, NPM / 128 + 2 * u.pn + (s_ & 1), ai, s_ >> 1, wr, wc); ga[s_] = bload128(rs, voff, so); gb[s_] = bload128(rs, voff, so + GB_MINUS_GA); }
            SCHED_BAR();
#pragma unroll
            for (int s_ = 0; s_ < 8; ++s_) { const int m = s_ >> 1, bj = s_ & 1;
#pragma unroll
                for (int k = 0; k < 8; ++k) { const unsigned aw = ga[s_][k >> 1], bw = gb[s_][k >> 1];
                    const float av = __builtin_bit_cast(float, (k & 1) ? (aw & 0xffff0000u) : (aw << 16)), bv_ = __builtin_bit_cast(float, (k & 1) ? (bw & 0xffff0000u) : (bw << 16));
                    const float ratio = (1.0f + fexp2(-LOG2E * bv_)) * frcp(1.0f + fexp2(-LOG2E * av));
                    if (k < 4) acc[ai][bj][m][0][k & 3] *= ratio; else acc[ai][bj][m][1][k & 3] *= ratio; } } }
    }
    DEV void operator()(const f32x4 (&acc)[2][2][4][2], const pg8::Unit& u, int wr, int wc, int fr, int fq) const {
        const int row0 = u.pm * 256 + wr * 64 + fr, col0 = u.pn * 256 + wc * 32 + 8 * fq; const unsigned voff = (unsigned)(fr * 256 + fq * 16); u32x4 gb[16];
#pragma unroll
        for (int s_ = 0; s_ < 16; ++s_) gb[s_] = bload128(rs, voff, p_soff(u.pm, NPM / 128 + 2 * u.pn + (s_ & 1), s_ >> 3, (s_ >> 1) & 3, wr, wc) + GB_MINUS_GA);
        SCHED_BAR();
#pragma unroll
        for (int s_ = 0; s_ < 16; ++s_) { const int ai = s_ >> 3, m = (s_ >> 1) & 3, bj = s_ & 1; const size_t row = (size_t)(row0 + ai * 128 + m * 16);
            const f32x4 v0 = acc[ai][bj][m][0], v1 = acc[ai][bj][m][1]; float o[8];
#pragma unroll
            for (int k = 0; k < 8; ++k) { const unsigned bw = gb[s_][k >> 1]; const float bv_ = __builtin_bit_cast(float, (k & 1) ? (bw & 0xffff0000u) : (bw << 16));
                o[k] = (k < 4 ? v0[k & 3] : v1[k & 3]) * frcp(1.0f + fexp2(-LOG2E * bv_)); }
            u32x4 w; w.x = cvt_pk_bf16(o[0], o[1]); w.y = cvt_pk_bf16(o[2], o[3]); w.z = cvt_pk_bf16(o[4], o[5]); w.w = cvt_pk_bf16(o[6], o[7]);
            *(u32x4*)(Y + row * D + col0 + bj * 128) = w; }
    }
};
struct EpiOut {
    static constexpr bool PERM = true;
    bf16* C; float* RSS;
    DEV void operator()(const f32x4 (&acc)[2][2][4][2], const pg8::Unit& u, int wr, int wc, int fr, int fq) const {
        const int row0 = u.pm * 256 + wr * 64 + fr, col0 = u.pn * 256 + wc * 32 + 8 * fq;
#pragma unroll
        for (int ai = 0; ai < 2; ++ai)
#pragma unroll
            for (int m = 0; m < 4; ++m) { const size_t row = (size_t)(row0 + ai * 128 + m * 16); bf16* rowp = C + row * D + col0; float ss = 0.f;
#pragma unroll
                for (int bj = 0; bj < 2; ++bj) { const f32x4 v0 = acc[ai][bj][m][0], v1 = acc[ai][bj][m][1];
                    ss += ((v0[0] * v0[0] + v0[1] * v0[1]) + (v0[2] * v0[2] + v0[3] * v0[3])) + ((v1[0] * v1[0] + v1[1] * v1[1]) + (v1[2] * v1[2] + v1[3] * v1[3]));
                    u32x4 w; w.x = cvt_pk_bf16(v0[0], v0[1]); w.y = cvt_pk_bf16(v0[2], v0[3]); w.z = cvt_pk_bf16(v1[0], v1[1]); w.w = cvt_pk_bf16(v1[2], v1[3]);
                    *(u32x4*)(rowp + bj * 128) = w; }
                ss += __shfl_xor(ss, 16); ss += __shfl_xor(ss, 32);
                if (fq == 0) RSS[row * NRS + u.pn * 4 + wc] = ss; }
    }
};

#ifndef EMU
typedef GAS unsigned gu32;
#define RLX_AGENT __ATOMIC_RELAXED, __HIP_MEMORY_SCOPE_AGENT
#define XB_TMO      128
#define XB_XCNT(j)  (256  + 64 * (j))
#define XB_XSUB(j)  (1280 + 64 * (j))
#define XB_XGEN(j)  (2304 + 64 * (j))
#define XB_TOP      3328
#define XB_TOPGEN   3392
#define XCD_BAR_WORDS 3456
#define XB_SPIN_CAP (1u << 22)
__device__ __forceinline__ unsigned xb_ld(unsigned* p)              { return __hip_atomic_load(p, __ATOMIC_RELAXED, __HIP_MEMORY_SCOPE_AGENT); }
__device__ __forceinline__ unsigned xb_add(unsigned* p, unsigned v) { return __hip_atomic_fetch_add(p, v, __ATOMIC_RELAXED, __HIP_MEMORY_SCOPE_AGENT); }
__device__ __forceinline__ unsigned xb_xcc_id() { return (unsigned)__builtin_amdgcn_s_getreg((3 << 11) | 20) & 0xFu; }
#define XB_SPIN(cond, bar) do { unsigned _sp = 0; while (cond) { __builtin_amdgcn_s_sleep(1); \
    if ((++_sp & 255u) == 0u) { if (xb_ld(&(bar)[XB_TMO])) break; if (_sp > XB_SPIN_CAP) { atomicAdd(&(bar)[XB_TMO], 1u); break; } } } } while (0)
struct XcdBarrier { unsigned* bar; unsigned x; volatile LAS unsigned* st; };
__device__ __forceinline__ XcdBarrier xcd_barrier_post(unsigned* bar, volatile LAS unsigned* st) {
    XcdBarrier b; b.bar = bar; b.x = xb_xcc_id(); b.st = st;
    if (threadIdx.x == 0) (void)xb_add(&bar[XB_XCNT(b.x)], 1u);
    return b;
}
__device__ __forceinline__ void xcd_barrier_complete(unsigned* bar, unsigned x, unsigned& nloc, unsigned& nx) {
    const unsigned G = gridDim.x * gridDim.y * gridDim.z;
    unsigned sum, cnt, mine, sp = 0u;
    for (;;) {
        sum = 0u; cnt = 0u; mine = 0u;
#pragma unroll
        for (unsigned j = 0; j < 16; ++j) { const unsigned c = xb_ld(&bar[XB_XCNT(j)]); sum += c; cnt += (c > 0u) ? 1u : 0u; mine = (j == x) ? c : mine; }
        if (sum == G) break;
        __builtin_amdgcn_s_sleep(1);
        if ((++sp & 255u) == 0u) { if (xb_ld(&bar[XB_TMO])) break; if (sp > XB_SPIN_CAP) { atomicAdd(&bar[XB_TMO], 1u); break; } }
    }
    nloc = mine > 0u ? mine : 1u; nx = cnt > 0u ? cnt : 1u;
}
__device__ __forceinline__ void xcd_barrier(const XcdBarrier& b) {
    asm volatile("s_waitcnt vmcnt(0)" ::: "memory");
    __syncthreads();
    if (threadIdx.x == 0) {
        unsigned* bar = b.bar;
        __builtin_amdgcn_s_waitcnt(0);
        unsigned nloc = b.st[0], nx = b.st[1];
        if (nloc == 0u) { xcd_barrier_complete(bar, b.x, nloc, nx); b.st[0] = nloc; b.st[1] = nx; }
        const unsigned old = xb_add(&bar[XB_XSUB(b.x)], 1u);
        const unsigned gen = old / nloc;
        if (old + 1u == (gen + 1u) * nloc) {
            __builtin_amdgcn_fence(__ATOMIC_RELEASE, "agent");
            asm volatile("s_waitcnt vmcnt(0)" ::: "memory");
            const unsigned og = xb_add(&bar[XB_TOP], 1u);
            const unsigned tg = og / nx;
            if (og + 1u == (tg + 1u) * nx) xb_add(&bar[XB_TOPGEN], 1u);
            else XB_SPIN(xb_ld(&bar[XB_TOPGEN]) == tg, bar);
            __builtin_amdgcn_fence(__ATOMIC_ACQUIRE, "agent");
            xb_add(&bar[XB_XGEN(b.x)], 1u);
            asm volatile("s_waitcnt vmcnt(0)" ::: "memory");
        } else {
            XB_SPIN(xb_ld(&bar[XB_XGEN(b.x)]) == gen, bar);
            __builtin_amdgcn_fence(__ATOMIC_ACQUIRE, "agent");
            asm volatile("s_waitcnt vmcnt(0)" ::: "memory");
        }
    }
    __syncthreads();
}
#endif

struct Args { const float* in[14]; float* out; unsigned char* ws; int ph_lo, ph_hi; };

DEV float clamp8(float x) { return fminf(fmaxf(x, -448.0f), 448.0f); }
struct P0Desc { const float* W; void* WT; int ldw, K, k0, c0, r0, nv, fp8; };
DEV void p0_load(const P0Desc& d, int lane, f32x4 (&v)[16]) {
    const int kr = lane >> 4, n4 = 4 * (lane & 15);
#pragma unroll
    for (int i = 0; i < 16; ++i) v[i] = (n4 < d.nv) ? *(const f32x4*)(d.W + (size_t)(d.k0 + 4 * i + kr) * d.ldw + d.c0 + n4) : (f32x4){0.f, 0.f, 0.f, 0.f};
}
DEV void p0_store(const P0Desc& d, const f32x4 (&v)[16], ldsp scr, int lane) {
    const int kr = lane >> 4, n4 = 4 * (lane & 15);
#pragma unroll
    for (int i = 0; i < 16; ++i) LDS_WR(f32x4, scr + ((4 * i + kr) * 68 + n4) * 4, v[i]);
    WAVE_SYNC();
    if (!d.fp8) {
        bf16* WT = (bf16*)d.WT;
        const int c = lane & 7;
#pragma unroll
        for (int j = 0; j < 8; ++j) { const int n = (lane >> 3) + 8 * j; ldsp sp = scr + ((8 * c) * 68 + n) * 4;
            u32x4 o; o.x = pk2(LDS_RD(float, sp + 0 * 272), LDS_RD(float, sp + 1 * 272)); o.y = pk2(LDS_RD(float, sp + 2 * 272), LDS_RD(float, sp + 3 * 272));
            o.z = pk2(LDS_RD(float, sp + 4 * 272), LDS_RD(float, sp + 5 * 272)); o.w = pk2(LDS_RD(float, sp + 6 * 272), LDS_RD(float, sp + 7 * 272));
            if (n < d.nv) *(u32x4*)(WT + (size_t)(d.r0 + n) * d.K + d.k0 + 8 * c) = o; }
    } else {
        unsigned char* WT = (unsigned char*)d.WT;
        const int c = lane & 3;
#pragma unroll
        for (int j = 0; j < 4; ++j) { const int n = (lane >> 2) + 16 * j; ldsp sp = scr + ((16 * c) * 68 + n) * 4; float f[16];
#pragma unroll
            for (int i = 0; i < 16; ++i) f[i] = clamp8(LDS_RD(float, sp + i * 272) * W8_SCALE);
            u32x4 o; o.x = pk_fp8x4(f[0], f[1], f[2], f[3]); o.y = pk_fp8x4(f[4], f[5], f[6], f[7]); o.z = pk_fp8x4(f[8], f[9], f[10], f[11]); o.w = pk_fp8x4(f[12], f[13], f[14], f[15]);
            if (n < d.nv) *(u32x4*)(WT + (size_t)(d.r0 + n) * d.K + d.k0 + 16 * c) = o; }
    }
    WAVE_SYNC();
}

constexpr int MS = 272, MS64 = 144;
constexpr int NUA = NB * HA * NCH, NUB = NB * HB * NCH;
constexpr size_t TW_QA = 0, TW_KA = TW_QA + (size_t)NUA * 16384, TW_PA = TW_KA + (size_t)NUA * 16384, TW_VA = TW_PA + (size_t)NUA * 8192, TW_ENDA = TW_VA + (size_t)NUA * 2048;
constexpr size_t TW_QB = 0, TW_KB = TW_QB + (size_t)NUB * 16384, TW_PB = TW_KB + (size_t)NUB * 16384, TW_SB = TW_PB + (size_t)NUB * 8192, TW_ENDB = TW_SB + (size_t)NUB * 2048;
static_assert(TW_ENDA <= (size_t)(NP + 16) * D * 2 && TW_ENDB <= (size_t)M * D * 2, "operand tiles must fit the dead W1T / h regions");
DEV int swz(int row, int chunk) { return row * 256 + ((chunk ^ (row & 15)) << 4); }
DEV int swz64(int row, int chunk) { return row * 128 + ((chunk ^ (row & 7)) << 4); }
DEV bf16x8 frag16p(ldsp img, int row0, int ks, int lane) { return LDS_RD(bf16x8, img + swz64(row0 + (lane & 15), 4 * ks + (lane >> 4))); }

DEV bf16x8 frag16(ldsp buf, int stride, int row0, int ks, int lane) { return LDS_RD(bf16x8, buf + (row0 + (lane & 15)) * stride + ks * 64 + (lane >> 4) * 16); }
DEV bf16x8 frag16s(ldsp img, int row0, int ks, int lane) { return LDS_RD(bf16x8, img + swz(row0 + (lane & 15), 4 * ks + (lane >> 4))); }
DEV bf16x8 frag8x2s(ldsp img, int row0, int ks, int lane) {
    const int row = row0 + (lane & 15), q = lane >> 4;
    const bf16x4 lo = LDS_RD(bf16x4, img + swz(row, 4 * ks + (q >> 1)) + (q & 1) * 8), hi = LDS_RD(bf16x4, img + swz(row, 4 * ks + 2 + (q >> 1)) + (q & 1) * 8);
    return (bf16x8){lo[0], lo[1], lo[2], lo[3], hi[0], hi[1], hi[2], hi[3]};
}
DEV bf16x8 frag_tr(ldsp img, int n0, int ks, int lane, int stride = 256) {
    ldsp p = img + (32 * ks + 8 * (lane >> 4) + ((lane & 15) >> 2)) * stride + (n0 + 4 * (lane & 3)) * 2;
    const bf16x4 lo = lds_tr16(p), hi = lds_tr16(p + 4 * stride);
    return (bf16x8){lo[0], lo[1], lo[2], lo[3], hi[0], hi[1], hi[2], hi[3]};
}
DEV bf16x8 frag_trs(ldsp img, int n0, int ks, int lane) {
    const int row = 32 * ks + 8 * (lane >> 4) + ((lane & 15) >> 2), p = lane & 3, ch = (n0 >> 3) + (p >> 1);
    const bf16x4 lo = lds_tr16(img + swz(row, ch) + (p & 1) * 8), hi = lds_tr16(img + swz(row + 4, ch) + (p & 1) * 8);
    return (bf16x8){lo[0], lo[1], lo[2], lo[3], hi[0], hi[1], hi[2], hi[3]};
}
DEV void dma_lin(const void* src, int ninst, ldsp dst, int wave, int lane) {
    for (int i = wave; i < ninst; i += NWAVES) GLDS16X((const char*)src + i * 1024 + 16 * lane, dst + i * 1024);
}
DEV float sigm2(float x) { return frcp(1.0f + fexp2(-LOG2E * x)); }
DEV u32x2 pack4(const f32x4 v) { u32x2 w; w.x = cvt_pk_bf16(v[0], v[1]); w.y = cvt_pk_bf16(v[2], v[3]); return w; }

DEV float scan_add(float v, int lane) {
#pragma unroll
    for (int o = 1; o < 64; o <<= 1) { const float t = __shfl_up(v, o); if (lane >= o) v += t; }
    return v;
}
DEV float scan_max(float v, int lane) {
#pragma unroll
    for (int o = 1; o < 64; o <<= 1) { const float t = __shfl_up(v, o); if (lane >= o) v = fmaxf(v, t); }
    return v;
}

constexpr int PA_RAW = 0, PA_RAWSZ = 2 * 68 * 256, PA_TOT = 2 * PA_RAWSZ, PA_IQ = PA_TOT + 8 * 128 * 4, PA_IK = PA_IQ + 16384, PA_SC = PA_IK + 16384, PA_END = PA_SC + 1024;
static_assert(PA_END <= RING_BYTES, "P2 LDS");
DEV void p2_issue(const Args& args, int u, ldsp raw, int wave, int lane) {
    const bf16* P = (const bf16*)(args.ws + WS_P);
    if (u < NUA) { const int bh = u / NCH, j = u % NCH, b = bh / HA, h = bh % HA; const size_t tok0 = (size_t)b * SEQ + 64 * j;
        dma_lin(P + p_off(tok0, C_QA + h * 128), 16, raw, wave, lane); dma_lin(P + p_off(tok0, C_FA + h * 128), 16, raw + 68 * 256, wave, lane); }
    else { const int ub = u - NUA, bh = ub / NCH, j = ub % NCH, b = bh / HB, h = bh % HB; const size_t tok0 = (size_t)b * SEQ + 64 * j;
        dma_lin(P + p_off(tok0, C_QB + h * 128) - 3 * 128, 17, raw, wave, lane); dma_lin(P + p_off(tok0, C_KB + h * 128) - 3 * 128, 17, raw + 68 * 256, wave, lane); }
}
DEV void p2_scores(ldsp lds, f32x4 (&sc)[2], int wave, int lane) {
    const int ct = wave >> 1, st0 = 2 * (wave & 1);
    sc[0] = (f32x4){0.f, 0.f, 0.f, 0.f}; sc[1] = (f32x4){0.f, 0.f, 0.f, 0.f};
#pragma unroll
    for (int ks = 0; ks < 4; ++ks) { const bf16x8 qf = frag16s(lds + PA_IQ, 16 * ct, ks, lane);
#pragma unroll
        for (int n = 0; n < 2; ++n) { const bf16x8 kf_ = frag16s(lds + PA_IK, 16 * (st0 + n), ks, lane); sc[n] = MFMA16(kf_, qf, sc[n]); } }
}
DEV void p2_unit(const Args& args, ldsp lds, int u, ldsp raw, int wave, int lane) {
    unsigned char* TW = args.ws + WS_W1T;
    const int q4 = lane >> 4, l15 = lane & 15;
    if (u < NUA) {
        const int bh = u / NCH, h = bh % HA;
        const float* lbl = args.in[3];
        float lbv[2];
#pragma unroll
        for (int e = 0; e < 2; ++e) { const int col = h * 128 + 2 * lane + e; lbv[e] = frcp(1.0f + fexp(lbl[DA + col] - lbl[col])); }
        float lf[8][2], qv[8][2], kv[8][2];
#pragma unroll
        for (int c = 0; c < 8; ++c) { const unsigned qw = LDS_RD(unsigned, raw + (8 * wave + c) * 256 + lane * 4), fw = LDS_RD(unsigned, raw + 68 * 256 + (8 * wave + c) * 256 + lane * 4);
#pragma unroll
            for (int e = 0; e < 2; ++e) { const float f = lbv[e] + (1.0f - lbv[e]) * sigm2(__builtin_bit_cast(float, e ? (fw & 0xffff0000u) : (fw << 16))); lf[c][e] = flog2(f); kv[c][e] = 1.0f - f; qv[c][e] = __builtin_bit_cast(float, e ? (qw & 0xffff0000u) : (qw << 16)); } }
#pragma unroll
        for (int c = 1; c < 8; ++c) { lf[c][0] += lf[c - 1][0]; lf[c][1] += lf[c - 1][1]; }
        LDS_WR(f32x2, lds + PA_TOT + (wave * 128 + 2 * lane) * 4, ((f32x2){lf[7][0], lf[7][1]}));
        MIX_BAR();
        f32x2 off = (f32x2){0.f, 0.f}, bmid = (f32x2){0.f, 0.f}, g = (f32x2){0.f, 0.f};
#pragma unroll
        for (int w = 0; w < 8; ++w) { const f32x2 t = LDS_RD(f32x2, lds + PA_TOT + (w * 128 + 2 * lane) * 4); if (w < wave) off += t; if (w < 4) bmid += t; g += t; }
        if (wave == 0) { float* vec = (float*)(TW + TW_VA + (size_t)u * 2048) + 2 * lane;
            *(f32x2*)vec = (f32x2){fexp2(bmid[0]), fexp2(bmid[1])}; *(f32x2*)(vec + 128) = (f32x2){fexp2(g[0]), fexp2(g[1])}; *(f32x2*)(vec + 256) = (f32x2){fexp2(g[0] - bmid[0]), fexp2(g[1] - bmid[1])}; }
        unsigned qr8[8], kr8[8];
#pragma unroll
        for (int c = 0; c < 8; ++c) { float qr[2], kk[2]; const int r = 8 * wave + c;
#pragma unroll
            for (int e = 0; e < 2; ++e) { const float t1 = lf[c][e] + off[e] - bmid[e]; qr[e] = qv[c][e] * fexp2(t1); kk[e] = kv[c][e] * fexp2(-t1); }
            qr8[c] = cvt_pk_bf16(qr[0], qr[1]); kr8[c] = cvt_pk_bf16(kk[0], kk[1]);
            LDS_WR(unsigned, lds + PA_IQ + swz(r, lane >> 2) + (lane & 3) * 4, qr8[c]); LDS_WR(unsigned, lds + PA_IK + swz(r, lane >> 2) + (lane & 3) * 4, kr8[c]); }
        MIX_BAR();
        f32x4 sc[2]; p2_scores(lds, sc, wave, lane);
        unsigned char* tq = TW + TW_QA + (size_t)u * 16384; unsigned char* tk = TW + TW_KA + (size_t)u * 16384; unsigned char* tp = TW + TW_PA + (size_t)u * 8192;
#pragma unroll
        for (int c = 0; c < 8; ++c) { const int r = 8 * wave + c; *(unsigned*)(tq + swz(r, lane >> 2) + (lane & 3) * 4) = qr8[c]; *(unsigned*)(tk + swz(r, lane >> 2) + (lane & 3) * 4) = kr8[c]; }
#pragma unroll
        for (int n = 0; n < 2; ++n) { const int c = 16 * (wave >> 1) + l15, s0_ = 16 * (2 * (wave & 1) + n) + 4 * q4; f32x4 v = sc[n];
#pragma unroll
            for (int r = 0; r < 4; ++r) v[r] = (s0_ + r <= c) ? v[r] : 0.f;
            *(u32x2*)(tp + swz64(c, s0_ >> 3) + (q4 & 1) * 8) = pack4(v); }
    } else {
        const int ub = u - NUA, bh = ub / NCH, j = ub % NCH, b = bh / HB, h = bh % HB;
        const float* cw = args.in[4]; const float* cb = args.in[5];
        f32x2 wq[4], wk[4];
#pragma unroll
        for (int k = 0; k < 4; ++k) { wq[k] = *(const f32x2*)(cw + k * (2 * DQK) + h * 128 + 2 * lane); wk[k] = *(const f32x2*)(cw + k * (2 * DQK) + DQK + h * 128 + 2 * lane); }
        const f32x2 bq = *(const f32x2*)(cb + h * 128 + 2 * lane), bk = *(const f32x2*)(cb + DQK + h * 128 + 2 * lane);
        unsigned uq[11], uk[11];
#pragma unroll
        for (int i = 0; i < 11; ++i) { const bool neg = (64 * j + 8 * wave + i - 3) < 0;
            const unsigned a = LDS_RD(unsigned, raw + (8 * wave + i) * 256 + lane * 4), bb = LDS_RD(unsigned, raw + 68 * 256 + (8 * wave + i) * 256 + lane * 4); uq[i] = neg ? 0u : a; uk[i] = neg ? 0u : bb; }
        unsigned char* TWB = args.ws + WS_HB;
        float* sb = (float*)(TWB + TW_SB + (size_t)ub * 2048);
        if (wave == 0) {
            const size_t tok = (size_t)b * SEQ + 64 * j + lane; const float* SG = (const float*)(args.ws + WS_SG);
            const float fp = SG[tok * 16 + HB + h] + args.in[7][h], ig = SG[tok * 16 + h] + args.in[6][h];
            const float bc = scan_add(logsig(fp), lane), a = ig - bc, pm = scan_max(a, lane);
            sb[lane] = pm; sb[64 + lane] = bc;
            LDS_WR(float, lds + PA_SC + lane * 4, a * LOG2E); LDS_WR(float, lds + PA_SC + 256 + lane * 4, pm * LOG2E);
        }
        unsigned q8[8]; float kf[8][2];
#pragma unroll
        for (int c = 0; c < 8; ++c) { float qq[2]; const int r = 8 * wave + c;
#pragma unroll
            for (int e = 0; e < 2; ++e) { float yq = bq[e], yk = bk[e];
#pragma unroll
                for (int k = 0; k < 4; ++k) { yq += wq[k][e] * __builtin_bit_cast(float, e ? (uq[c + k] & 0xffff0000u) : (uq[c + k] << 16)); yk += wk[k][e] * __builtin_bit_cast(float, e ? (uk[c + k] & 0xffff0000u) : (uk[c + k] << 16)); }
                qq[e] = yq * sigm2(yq); kf[c][e] = yk * sigm2(yk) * 0.08838834764831845f; }
            q8[c] = cvt_pk_bf16(qq[0], qq[1]);
            LDS_WR(unsigned, lds + PA_IQ + swz(r, lane >> 2) + (lane & 3) * 4, q8[c]); LDS_WR(unsigned, lds + PA_IK + swz(r, lane >> 2) + (lane & 3) * 4, cvt_pk_bf16(kf[c][0], kf[c][1])); }
        MIX_BAR();
        const float pm63 = LDS_RD(float, lds + PA_SC + 256 + 63 * 4);
        unsigned kw8[8]; float na[2] = {0.f, 0.f};
#pragma unroll
        for (int c = 0; c < 8; ++c) { const float w_ = fexp2(LDS_RD(float, lds + PA_SC + (8 * wave + c) * 4) - pm63); const float k0 = w_ * kf[c][0], k1 = w_ * kf[c][1]; na[0] += k0; na[1] += k1; kw8[c] = cvt_pk_bf16(k0, k1); }
        LDS_WR(f32x2, lds + PA_TOT + (wave * 128 + 2 * lane) * 4, ((f32x2){na[0], na[1]}));
        f32x4 sc[2]; p2_scores(lds, sc, wave, lane);
        const int ct = wave >> 1, st0 = 2 * (wave & 1), c_ = 16 * ct + l15;
        const float pmc = LDS_RD(float, lds + PA_SC + 256 + c_ * 4); float rs = 0.f; u32x2 pw[2];
#pragma unroll
        for (int n = 0; n < 2; ++n) { const int s0_ = 16 * (st0 + n) + 4 * q4; const f32x4 as = LDS_RD(f32x4, lds + PA_SC + s0_ * 4); f32x4 v;
#pragma unroll
            for (int r = 0; r < 4; ++r) { const float t = fexp2(as[r] - pmc) * sc[n][r]; v[r] = (s0_ + r <= c_) ? t : 0.f; rs += v[r]; }
            pw[n] = pack4(v); }
        rs += __shfl_xor(rs, 16); rs += __shfl_xor(rs, 32);
        MIX_BAR();
        if (wave < 2) { const int dcol = wave * 64 + lane; float nl = 0.f;
#pragma unroll
            for (int w = 0; w < 8; ++w) nl += LDS_RD(float, lds + PA_TOT + (w * 128 + dcol) * 4);
            sb[256 + dcol] = nl; }
        if (q4 == 0) sb[128 + c_ * 2 + (wave & 1)] = rs;
        unsigned char* tq = TWB + TW_QB + (size_t)ub * 16384; unsigned char* tk = TWB + TW_KB + (size_t)ub * 16384; unsigned char* tp = TWB + TW_PB + (size_t)ub * 8192;
#pragma unroll
        for (int c = 0; c < 8; ++c) { const int r = 8 * wave + c; *(unsigned*)(tq + swz(r, lane >> 2) + (lane & 3) * 4) = q8[c]; *(unsigned*)(tk + swz(r, lane >> 2) + (lane & 3) * 4) = kw8[c]; }
#pragma unroll
        for (int n = 0; n < 2; ++n) { const int s0_ = 16 * (st0 + n) + 4 * q4; *(u32x2*)(tp + swz64(c_, s0_ >> 3) + (q4 & 1) * 8) = pw[n]; }
    }
}

constexpr int PB_BUFSZ = 51200, PB_Q = 0, PB_K = 16384, PB_V = 32768, PB_P = 40960, PB_VEC = 49152;
constexpr int PB_XS = 2 * PB_BUFSZ, PB_SM = PB_XS + 2 * 16384;
constexpr int SM_SSQ = PB_SM;
constexpr int SM_R = SM_SSQ + 2 * 64 * 4 * 4, SM_INT = SM_R + 256, SM_EMT = SM_INT + 256, SM_RS = SM_EMT + 256, SM_SCAL = SM_RS + 256;
constexpr int SM_NV = SM_SCAL + 64, SM_QN = SM_NV + 512, MX_END = SM_QN + 256;
static_assert(MX_END <= RING_BYTES, "mixer LDS");
DEV void dma_rows64(const void* src, ldsp dst, int wave, int lane) { GLDS16S((const char*)src + wave * 2048, (lane >> 3) * 256 + (lane & 7) * 16, dst + wave * 1024); }

DEV void mixer_a_job(const Args& args, ldsp lds, int b, int h, int vh, int tid_) {
    const int wave = RFL(tid_ >> 6), vt = wave & 3, hf = wave >> 2;
    const bf16* P = (const bf16*)(args.ws + WS_P);
    const unsigned char* TW = args.ws + WS_W1T;
    const rsrc_t RO = make_rsrc(args.ws + WS_OAB, (unsigned)((size_t)2 * M * LDU * 2));
    float* SSA = (float*)(args.ws + WS_SSA);
    const int u0 = (b * HA + h) * NCH, vcol = h * 128 + 64 * vh;
    f32x4 st[4], o[2];
#pragma unroll
    for (int t = 0; t < 4; ++t) st[t] = (f32x4){0.f, 0.f, 0.f, 0.f};
    o[0] = (f32x4){0.f, 0.f, 0.f, 0.f}; o[1] = (f32x4){0.f, 0.f, 0.f, 0.f};
    { const u32x4 z = (u32x4){0u, 0u, 0u, 0u}; const int lane = tid_ & 63;
        LDS_WR(u32x4, lds + PB_XS + 16384 + (vt * 2 + hf) * 2048 + lane * 16, z); LDS_WR(u32x4, lds + PB_XS + 16384 + (vt * 2 + hf) * 2048 + 1024 + lane * 16, z); }
#define MA_DMA(jj) do { ldsp bf_ = lds + ((jj) & 1) * PB_BUFSZ; const size_t uu_ = (size_t)(u0 + (jj)); \
        dma_lin(TW + TW_QA + uu_ * 16384, 16, bf_ + PB_Q, wave, lane); dma_lin(TW + TW_KA + uu_ * 16384, 16, bf_ + PB_K, wave, lane); \
        dma_rows64(P + p_off((size_t)b * SEQ + 64 * (jj), C_IA + h * 128) + 64 * vh, bf_ + PB_V, wave, lane); dma_lin(TW + TW_PA + uu_ * 8192, 8, bf_ + PB_P, wave, lane); dma_lin(TW + TW_VA + uu_ * 2048, 2, bf_ + PB_VEC, wave, lane); } while (0)
    { const int lane = tid_ & 63; MA_DMA(0); }
    for (int j = 0; j <= NCH; ++j) {
        int tidj = tid_; OPAQUE(tidj);
        const int lane = tidj & 63, q4 = lane >> 4, l15 = lane & 15;
        const size_t tk0 = (size_t)b * SEQ + 64 * j;
        if (j <= 1) WAIT_V(0); else WAIT_V(2);
        MIX_BAR();
        if (j + 1 < NCH) MA_DMA(j + 1);
        if (j > 0) {
            if (wave == 0) { const f32x4 s0 = LDS_RD(f32x4, lds + SM_SSQ + ((j - 1) & 1) * 1024 + lane * 16); SSA[((tk0 - 64 + lane) * HA + h) * 2 + vh] = (s0[0] + s0[1]) + (s0[2] + s0[3]); }
#pragma unroll
            for (int i = 0; i < 2; ++i) bstore64(RO, (unsigned)(l15 * LDU + vcol + 16 * vt + 4 * q4) * 2u, (unsigned)(tk0 - 64 + 16 * (2 * hf + i)) * (unsigned)(LDU * 2), pack4(o[i]));
        }
        if (j == NCH) break;
        ldsp bf = lds + (j & 1) * PB_BUFSZ;
        bf16x8 bv[2], pf[2][2], qo[2][2], qp[2][2], so[2], sp[2];
#pragma unroll
        for (int ks = 0; ks < 2; ++ks) bv[ks] = frag_tr(bf + PB_V, 16 * vt, ks, lane, 128);
#pragma unroll
        for (int ks = 0; ks < 2; ++ks)
#pragma unroll
            for (int i = 0; i < 2; ++i) pf[ks][i] = frag16p(bf + PB_P, 16 * (2 * hf + i), ks, lane);
#pragma unroll
        for (int kl = 0; kl < 2; ++kl)
#pragma unroll
            for (int i = 0; i < 2; ++i) { qo[kl][i] = frag8x2s(bf + PB_Q, 16 * (2 * hf + i), 2 * hf + kl, lane); qp[kl][i] = frag8x2s(bf + PB_Q, 16 * (2 * hf + i), 2 * (hf ^ 1) + kl, lane); }
        u32x4 xp[2];
#pragma unroll
        for (int kl = 0; kl < 2; ++kl) xp[kl] = LDS_RD(u32x4, lds + PB_XS + ((j + 1) & 1) * 16384 + (vt * 2 + (hf ^ 1)) * 2048 + kl * 1024 + lane * 16);
        f32x4 eo[4], ep[4];
#pragma unroll
        for (int t = 0; t < 4; ++t) { eo[t] = LDS_RD(f32x4, bf + PB_VEC + (16 * (4 * hf + t) + 4 * q4) * 4); ep[t] = LDS_RD(f32x4, bf + PB_VEC + (16 * (4 * (hf ^ 1) + t) + 4 * q4) * 4); }
        SCHED_BAR();
#pragma unroll
        for (int kl = 0; kl < 2; ++kl) {
            { u32x4 w; const f32x4 a0 = st[2 * kl] * eo[2 * kl], a1 = st[2 * kl + 1] * eo[2 * kl + 1]; w.x = cvt_pk_bf16(a0[0], a0[1]); w.y = cvt_pk_bf16(a0[2], a0[3]); w.z = cvt_pk_bf16(a1[0], a1[1]); w.w = cvt_pk_bf16(a1[2], a1[3]);
              so[kl] = __builtin_bit_cast(bf16x8, w); }
            { u32x4 w; const f32x4 e0 = ep[2 * kl], e1 = ep[2 * kl + 1]; const u32x4 x = xp[kl];
              w.x = cvt_pk_bf16(__builtin_bit_cast(float, x.x << 16) * e0[0], __builtin_bit_cast(float, x.x & 0xffff0000u) * e0[1]); w.y = cvt_pk_bf16(__builtin_bit_cast(float, x.y << 16) * e0[2], __builtin_bit_cast(float, x.y & 0xffff0000u) * e0[3]);
              w.z = cvt_pk_bf16(__builtin_bit_cast(float, x.z << 16) * e1[0], __builtin_bit_cast(float, x.z & 0xffff0000u) * e1[1]); w.w = cvt_pk_bf16(__builtin_bit_cast(float, x.w << 16) * e1[2], __builtin_bit_cast(float, x.w & 0xffff0000u) * e1[3]);
              sp[kl] = __builtin_bit_cast(bf16x8, w); } }
        o[0] = (f32x4){0.f, 0.f, 0.f, 0.f}; o[1] = (f32x4){0.f, 0.f, 0.f, 0.f};
#pragma unroll
        for (int ks = 0; ks < 2; ++ks)
#pragma unroll
            for (int i = 0; i < 2; ++i) o[i] = MFMA16(bv[ks], pf[ks][i], o[i]);
#pragma unroll
        for (int kl = 0; kl < 2; ++kl)
#pragma unroll
            for (int i = 0; i < 2; ++i) { o[i] = MFMA16(so[kl], qo[kl][i], o[i]); o[i] = MFMA16(sp[kl], qp[kl][i], o[i]); }
#pragma unroll
        for (int i = 0; i < 4; ++i) { const int t = 4 * hf + i;
            f32x4 u = (f32x4){0.f, 0.f, 0.f, 0.f};
#pragma unroll
            for (int ks = 0; ks < 2; ++ks) { const bf16x8 a = frag_trs(bf + PB_K, 16 * t, ks, lane); u = MFMA16(a, bv[ks], u); }
            const f32x4 eg = LDS_RD(f32x4, bf + PB_VEC + 512 + (16 * t + 4 * q4) * 4), egm = LDS_RD(f32x4, bf + PB_VEC + 1024 + (16 * t + 4 * q4) * 4); st[i] = eg * st[i] + egm * u; }
#pragma unroll
        for (int kl = 0; kl < 2; ++kl) { u32x4 w; const f32x4 a0 = st[2 * kl], a1 = st[2 * kl + 1]; w.x = cvt_pk_bf16(a0[0], a0[1]); w.y = cvt_pk_bf16(a0[2], a0[3]); w.z = cvt_pk_bf16(a1[0], a1[1]); w.w = cvt_pk_bf16(a1[2], a1[3]);
            LDS_WR(u32x4, lds + PB_XS + (j & 1) * 16384 + (vt * 2 + hf) * 2048 + kl * 1024 + lane * 16, w); }
#pragma unroll
        for (int i = 0; i < 2; ++i) { float s_ = (o[i][0] * o[i][0] + o[i][1] * o[i][1]) + (o[i][2] * o[i][2] + o[i][3] * o[i][3]); s_ += __shfl_xor(s_, 16); s_ += __shfl_xor(s_, 32);
            LDS_WR(float, lds + SM_SSQ + (j & 1) * 1024 + ((16 * (2 * hf + i) + l15) * 4 + vt) * 4, s_); }
    }
#undef MA_DMA
}

DEV void mixer_b_job(const Args& args, ldsp lds, int b, int h, int vq, int tid_) {
    const int wave = RFL(tid_ >> 6), vt = wave & 3, hf = wave >> 2;
    const int vbase = h * 256 + 64 * vq;
    const bf16* P = (const bf16*)(args.ws + WS_P);
    const unsigned char* TW = args.ws + WS_HB;
    const rsrc_t RO = make_rsrc(args.ws + WS_OAB, (unsigned)((size_t)2 * M * LDU * 2));
    float* SSB = (float*)(args.ws + WS_SSB);
    const int u0 = (b * HB + h) * NCH;
    f32x4 st[4], hv[2];
#pragma unroll
    for (int t = 0; t < 4; ++t) st[t] = (f32x4){0.f, 0.f, 0.f, 0.f};
    hv[0] = (f32x4){0.f, 0.f, 0.f, 0.f}; hv[1] = (f32x4){0.f, 0.f, 0.f, 0.f};
    float mcar = 0.f;
    if (wave < 2) LDS_WR(float, lds + SM_NV + tid_ * 4, 0.f);
    { const u32x4 z = (u32x4){0u, 0u, 0u, 0u}; const int lane = tid_ & 63;
        LDS_WR(u32x4, lds + PB_XS + 16384 + (vt * 2 + hf) * 2048 + lane * 16, z); LDS_WR(u32x4, lds + PB_XS + 16384 + (vt * 2 + hf) * 2048 + 1024 + lane * 16, z); }
#define MB_DMA(jj) do { ldsp bf_ = lds + ((jj) & 1) * PB_BUFSZ; const size_t uu_ = (size_t)(u0 + (jj)); \
        dma_lin(TW + TW_QB + uu_ * 16384, 16, bf_ + PB_Q, wave, lane); dma_lin(TW + TW_KB + uu_ * 16384, 16, bf_ + PB_K, wave, lane); \
        dma_rows64(P + p_off((size_t)b * SEQ + 64 * (jj), C_VB + h * 256 + 128 * (vq >> 1)) + 64 * (vq & 1), bf_ + PB_V, wave, lane); dma_lin(TW + TW_PB + uu_ * 8192, 8, bf_ + PB_P, wave, lane); dma_lin(TW + TW_SB + uu_ * 2048, 2, bf_ + PB_VEC, wave, lane); } while (0)
    { const int lane = tid_ & 63; MB_DMA(0); }
    for (int j = 0; j <= NCH; ++j) {
        const size_t tk0 = (size_t)b * SEQ + 64 * j;
        int tidj = tid_; OPAQUE(tidj);
        const int tid = tidj, lane = tidj & 63, q4 = lane >> 4, l15 = lane & 15;
        if (j <= 1) WAIT_V(0); else WAIT_V(2);
        MIX_BAR();
        if (j + 1 < NCH) MB_DMA(j + 1);
        if (j > 0) {
            if (wave == 0) { const f32x4 s0 = LDS_RD(f32x4, lds + SM_SSQ + ((j - 1) & 1) * 1024 + lane * 16); SSB[((tk0 - 64 + lane) * HB + h) * 4 + vq] = (s0[0] + s0[1]) + (s0[2] + s0[3]); }
#pragma unroll
            for (int i = 0; i < 2; ++i) bstore64(RO, (unsigned)(l15 * LDU + vbase + 16 * vt + 4 * q4) * 2u, (unsigned)(M + tk0 - 64 + 16 * (2 * hf + i)) * (unsigned)(LDU * 2), pack4(hv[i]));
        }
        if (j == NCH) break;
        ldsp bf = lds + (j & 1) * PB_BUFSZ;
        if (wave == 0) {
            const float pm = LDS_RD(float, bf + PB_VEC + lane * 4), bc = LDS_RD(float, bf + PB_VEC + 256 + lane * 4); const f32x2 rsl = LDS_RD(f32x2, bf + PB_VEC + 512 + lane * 8);
            const float mx = fmaxf(mcar, pm), r = fexp(pm - mx);
            const float pm63 = __shfl(pm, 63), bc63 = __shfl(bc, 63), m63 = fmaxf(mcar, pm63);
            LDS_WR(float, lds + SM_R + lane * 4, r); LDS_WR(float, lds + SM_INT + lane * 4, fexp(mcar - mx)); LDS_WR(float, lds + SM_EMT + lane * 4, fexp(-(bc + mx))); LDS_WR(float, lds + SM_RS + lane * 4, r * (rsl[0] + rsl[1]));
            if (lane == 0) { LDS_WR(float, lds + SM_SCAL, fexp(mcar - m63)); LDS_WR(float, lds + SM_SCAL + 4, bc63 + m63); LDS_WR(float, lds + SM_SCAL + 8, fexp(pm63 - m63)); }
        }
        {
            const int c = tid >> 3, part = tid & 7; float s = 0.f;
#pragma unroll
            for (int hh = 0; hh < 2; ++hh) { const u32x4 qw = LDS_RD(u32x4, bf + PB_Q + swz(c, 2 * part + hh));
#pragma unroll
                for (int e = 0; e < 4; ++e) { const f32x2 nv = LDS_RD(f32x2, lds + SM_NV + (16 * part + 8 * hh + 2 * e) * 4); s += __builtin_bit_cast(float, qw[e] << 16) * nv[0] + __builtin_bit_cast(float, qw[e] & 0xffff0000u) * nv[1]; } }
            s += __shfl_xor(s, 1); s += __shfl_xor(s, 2); s += __shfl_xor(s, 4);
            LDS_WR(float, lds + SM_QN + c * 4, s);
        }
        MIX_BAR();
        const float decay = LDS_RD(float, lds + SM_SCAL), sj = LDS_RD(float, lds + SM_SCAL + 8);
        mcar = LDS_RD(float, lds + SM_SCAL + 4);
        {
            bf16x8 bv[2], pf[2][2], qo[2][2], qp[2][2], so[2], sp[2];
#pragma unroll
            for (int ks = 0; ks < 2; ++ks) bv[ks] = frag_tr(bf + PB_V, 16 * vt, ks, lane, 128);
#pragma unroll
            for (int ks = 0; ks < 2; ++ks)
#pragma unroll
                for (int i = 0; i < 2; ++i) pf[ks][i] = frag16p(bf + PB_P, 16 * (2 * hf + i), ks, lane);
#pragma unroll
            for (int kl = 0; kl < 2; ++kl)
#pragma unroll
                for (int i = 0; i < 2; ++i) { qo[kl][i] = frag8x2s(bf + PB_Q, 16 * (2 * hf + i), 2 * hf + kl, lane); qp[kl][i] = frag8x2s(bf + PB_Q, 16 * (2 * hf + i), 2 * (hf ^ 1) + kl, lane); }
#pragma unroll
            for (int kl = 0; kl < 2; ++kl) sp[kl] = LDS_RD(bf16x8, lds + PB_XS + ((j + 1) & 1) * 16384 + (vt * 2 + (hf ^ 1)) * 2048 + kl * 1024 + lane * 16);
            float s_int[2], s_r[2], s_qn[2], s_rs[2], s_emt[2];
#pragma unroll
            for (int i = 0; i < 2; ++i) { const int c = 16 * (2 * hf + i) + l15; s_int[i] = LDS_RD(float, lds + SM_INT + c * 4); s_r[i] = LDS_RD(float, lds + SM_R + c * 4); s_qn[i] = LDS_RD(float, lds + SM_QN + c * 4); s_rs[i] = LDS_RD(float, lds + SM_RS + c * 4); s_emt[i] = LDS_RD(float, lds + SM_EMT + c * 4); }
            SCHED_BAR();
#pragma unroll
            for (int kl = 0; kl < 2; ++kl) { u32x4 w; const f32x4 a0 = st[2 * kl], a1 = st[2 * kl + 1]; w.x = cvt_pk_bf16(a0[0], a0[1]); w.y = cvt_pk_bf16(a0[2], a0[3]); w.z = cvt_pk_bf16(a1[0], a1[1]); w.w = cvt_pk_bf16(a1[2], a1[3]); so[kl] = __builtin_bit_cast(bf16x8, w); }
#pragma unroll
            for (int i = 0; i < 2; ++i) {
                f32x4 a1 = (f32x4){0.f, 0.f, 0.f, 0.f}, a2 = (f32x4){0.f, 0.f, 0.f, 0.f};
#pragma unroll
                for (int ks = 0; ks < 2; ++ks) a2 = MFMA16(bv[ks], pf[ks][i], a2);
#pragma unroll
                for (int kl = 0; kl < 2; ++kl) { a1 = MFMA16(so[kl], qo[kl][i], a1); a1 = MFMA16(sp[kl], qp[kl][i], a1); }
                const float den = s_int[i] * s_qn[i] + s_rs[i];
                const float rden = frcp(fmaxf(fabsf(den), s_emt[i]));
                hv[i] = (s_int[i] * a1 + s_r[i] * a2) * rden;
            }
#pragma unroll
            for (int i = 0; i < 4; ++i) { const int t = 4 * hf + i;
                f32x4 u = (f32x4){0.f, 0.f, 0.f, 0.f};
#pragma unroll
                for (int ks = 0; ks < 2; ++ks) { const bf16x8 a = frag_trs(bf + PB_K, 16 * t, ks, lane); u = MFMA16(a, bv[ks], u); }
                st[i] = decay * st[i] + sj * u;
            }
#pragma unroll
            for (int kl = 0; kl < 2; ++kl) { u32x4 w; const f32x4 a0 = st[2 * kl], a1 = st[2 * kl + 1]; w.x = cvt_pk_bf16(a0[0], a0[1]); w.y = cvt_pk_bf16(a0[2], a0[3]); w.z = cvt_pk_bf16(a1[0], a1[1]); w.w = cvt_pk_bf16(a1[2], a1[3]);
                LDS_WR(u32x4, lds + PB_XS + (j & 1) * 16384 + (vt * 2 + hf) * 2048 + kl * 1024 + lane * 16, w); }
            if (wave < 2) LDS_WR(float, lds + SM_NV + tid * 4, decay * LDS_RD(float, lds + SM_NV + tid * 4) + sj * LDS_RD(float, bf + PB_VEC + 1024 + tid * 4));
#pragma unroll
            for (int i = 0; i < 2; ++i) { float s_ = (hv[i][0] * hv[i][0] + hv[i][1] * hv[i][1]) + (hv[i][2] * hv[i][2] + hv[i][3] * hv[i][3]); s_ += __shfl_xor(s_, 16); s_ += __shfl_xor(s_, 32);
                LDS_WR(float, lds + SM_SSQ + (j & 1) * 1024 + ((16 * (2 * hf + i) + l15) * 4 + vt) * 4, s_); }
        }
    }
#undef MB_DMA
}

constexpr int P0_RB1 = (NP + NSG + 63) / 64, P0_I1 = (D / 64) * P0_RB1, P0_IU = (DA / 64) * (D / 64), P0_IO = (D / 64) * (D / 64), P0_NITEMS = P0_I1 + 2 * P0_IU + P0_IO;
DEV P0Desc p0_decode(const Args& args, int it) {
    unsigned char* ws = args.ws; bf16* W1T = (bf16*)(ws + WS_W1T); bf16* WUT = (bf16*)(ws + WS_WUT); bf16* WOT = (bf16*)(ws + WS_WOT);
    P0Desc d; int r = it;
    if (r < P0_I1) { const int kb = r / P0_RB1, rb = r % P0_RB1, r0 = 64 * rb; d.W = args.in[2]; d.ldw = D_IN; d.K = D; d.k0 = 64 * kb;
        if (r0 >= NPM && r0 < NP) { d.WT = ws + WS_W8; d.c0 = r0 + NSG; d.r0 = r0 - NPM; d.nv = 64; d.fp8 = 1; return d; }
        d.WT = W1T; d.fp8 = 0; d.r0 = r0;
        if (r0 < NPM) { d.c0 = r0; d.nv = 64; } else { d.c0 = NPM + (r0 - NP); d.nv = NSG - (r0 - NP) < 64 ? NSG - (r0 - NP) : 64; }
        return d; }
    r -= P0_I1; d.fp8 = 0; d.ldw = D; d.nv = 64;
    if (r < P0_IU) { const int kb = r / (D / 64), rb = r % (D / 64); d.W = args.in[10]; d.K = LDU; d.WT = WUT; d.k0 = 64 * kb; d.c0 = 64 * rb; d.r0 = 64 * rb; return d; }
    r -= P0_IU;
    if (r < P0_IU) { const int kb = r / (D / 64), rb = r % (D / 64); d.W = args.in[11]; d.K = LDU; d.WT = WUT + (size_t)D * LDU; d.k0 = 64 * kb; d.c0 = 64 * rb; d.r0 = 64 * rb; return d; }
    r -= P0_IU;
    { const int kb = r / (D / 64), rb = r % (D / 64); d.W = args.in[12]; d.K = D; d.WT = WOT; d.k0 = 64 * kb; d.c0 = 64 * rb; d.r0 = 64 * rb; return d; }
}
DEV void p0_items(const Args& args, int first, int last, int stride, ldsp scr, int lane) {
    if (first >= last) return;
    P0Desc d = p0_decode(args, first); f32x4 v[16]; p0_load(d, lane, v);
    for (int it = first; it < last; it += stride) {
        const int nx = it + stride; P0Desc dn = d; f32x4 vn[16];
        if (nx < last) { dn = p0_decode(args, nx); p0_load(dn, lane, vn); }
        p0_store(d, v, scr, lane);
        if (nx < last) { d = dn;
#pragma unroll
            for (int i = 0; i < 16; ++i) v[i] = vn[i]; }
    }
}

__global__ void __launch_bounds__(NTHREADS, 2) fwd_kernel(Args args) {
#ifndef EMU
    extern __shared__ __attribute__((aligned(16))) unsigned char lds_raw[];
    ldsp lds = (ldsp)lds_raw;
#else
    ldsp lds = emu_lds;
#endif
    const int tid = threadIdx.x, lane = tid & 63, wave = RFL(tid >> 6);
    const int G = gridDim.x, bx = blockIdx.x;
    const int vcu = (G % 8 == 0) ? (bx % 8) * (G / 8) + bx / 8 : bx;
    unsigned char* ws = args.ws;
#ifndef EMU
    for (int u = tid; u < (LDS_BYTES - LDSCTL_OFF) / 4; u += NTHREADS) ((LAS unsigned*)(lds + LDSCTL_OFF))[u] = 0u;
    __syncthreads();
    XcdBarrier bar = xcd_barrier_post((unsigned*)(ws + WS_CTL) + CW_BAR, (volatile LAS unsigned*)(lds + MISC_OFF) + 8);
#define GRID_BAR() xcd_barrier(bar)
#else
#define GRID_BAR()
#endif
    const int lo = args.ph_lo, hi = args.ph_hi;
#ifndef GEMM_SP2
#define GEMM_SP2 true
#endif
#ifndef GEMM_ALIGN
#define GEMM_ALIGN true
#endif
#ifndef PROBE_REP_P4
#define PROBE_REP_P4 1
#endif
#ifndef PROBE_REP_P5
#define PROBE_REP_P5 1
#endif
#ifndef PROBE_REP_P1
#define PROBE_REP_P1 2
#endif
#ifndef PROBE_REP_P2
#define PROBE_REP_P2 1
#endif
#ifndef PHASE_MASK
#define PHASE_MASK 255
#endif
#define IN(k) (((PHASE_MASK >> (k)) & 1) && lo <= (k) && (k) < hi)
#define BOTH(k) (IN(k) && IN((k) + 1))
    const float* x = args.in[0];
    bf16* W1T = (bf16*)(ws + WS_W1T); bf16* WUT = (bf16*)(ws + WS_WUT); bf16* WOT = (bf16*)(ws + WS_WOT);
    bf16* HBUF = (bf16*)(ws + WS_HB); bf16* PB = (bf16*)(ws + WS_P); float* SG = (float*)(ws + WS_SG); bf16* OAB = (bf16*)(ws + WS_OAB); float* RSS = (float*)(ws + WS_RSS);

    if (IN(0)) {
        ldsp scr = lds + wave * 17408;
        const int gw = vcu * NWAVES + wave, NGW = G * NWAVES;
        constexpr int I_1 = P0_I1, NITEMS = P0_NITEMS;
        static_assert(NPM % 64 == 0 && NP % 64 == 0 && NSG % 4 == 0, "P0 item tiling");
        constexpr int NJOBS3 = NB * HA * 2 + NB * HB * 4;
        const int nit0 = (G > NJOBS3) ? I_1 : NITEMS;
        p0_items(args, gw, nit0, NGW, scr, lane);
        const float* gpre = args.in[1];
        for (int m = gw; m < M; m += NGW) {
            const f32x4* xr = (const f32x4*)(x + (size_t)m * D) + lane;
            f32x4 v[D / 256]; float s = 0.f;
#pragma unroll
            for (int jj = 0; jj < D / 256; ++jj) { v[jj] = xr[64 * jj]; s += (v[jj][0] * v[jj][0] + v[jj][1] * v[jj][1]) + (v[jj][2] * v[jj][2] + v[jj][3] * v[jj][3]); }
            const float rstd = frsq(wave_sum(s) * (1.0f / D) + EPS) ;
            u32x2* o8 = (u32x2*)(HBUF + (size_t)m * D) + lane; unsigned* o4 = (unsigned*)(ws + WS_H8 + (size_t)m * D) + lane;
#pragma unroll
            for (int jj = 0; jj < D / 256; ++jj) { const f32x4 gg = ((const f32x4*)gpre)[lane + 64 * jj]; const f32x4 hh = v[jj] * rstd * gg; u32x2 w; w.x = pk2(hh[0], hh[1]); w.y = pk2(hh[2], hh[3]); o8[64 * jj] = w;
                o4[64 * jj] = pk_fp8x4(clamp8(hh[0] * H8_SCALE), clamp8(hh[1] * H8_SCALE), clamp8(hh[2] * H8_SCALE), clamp8(hh[3] * H8_SCALE)); }
        }
        if (BOTH(0)) GRID_BAR();
    }

    if (IN(1)) {
        {
            const int gw = vcu * NWAVES + wave, NGW = G * NWAVES, l15 = lane & 15, q4 = lane >> 4;
            const int wrow = NP + (l15 < NSG ? l15 : NSG - 1);
            for (int t = gw; t < M / 16; t += NGW) {
                f32x4 acc = (f32x4){0.f, 0.f, 0.f, 0.f};
                const bf16* ap = HBUF + (size_t)(16 * t + l15) * D + 8 * q4; const bf16* bp = W1T + (size_t)wrow * D + 8 * q4;
                for (int k0 = 0; k0 < D / 32; k0 += 16) {
                    bf16x8 af[16], bfr[16];
#pragma unroll
                    for (int i = 0; i < 16; ++i) { af[i] = *(const bf16x8*)(ap + 32 * (k0 + i)); bfr[i] = *(const bf16x8*)(bp + 32 * (k0 + i)); }
#pragma unroll
                    for (int i = 0; i < 16; ++i) acc = MFMA16(af[i], bfr[i], acc);
                }
#pragma unroll
                for (int r = 0; r < 4; ++r) SG[(size_t)(16 * t + 4 * q4 + r) * 16 + l15] = acc[r];
            }
        }
        { pg8::Gemm g{HBUF, W1T, M, NPM, D}; pg8::StaticOrder S; S.init(M, NPM, G, bx);
          EpiP E{PB};
          pg8::gemm_phase<EpiP, pg8::StaticOrder, GEMM_ALIGN, GEMM_SP2>(lds, g, S, E); }
        if (BOTH(1)) GRID_BAR();
    }

    if (IN(2)) {
        int buf = 0;
        if (bx < NUA + NUB) p2_issue(args, bx, lds + PA_RAW, wave, lane);
        for (int u = bx, it = 0; u < NUA + NUB; u += G, ++it) {
            int tidj = tid; OPAQUE(tidj); const int lane_ = tidj & 63;
            if (it == 0) WAIT_V(0); else WAIT_V(18);
            MIX_BAR();
            if (u + G < NUA + NUB) p2_issue(args, u + G, lds + PA_RAW + (buf ^ 1) * PA_RAWSZ, wave, lane_);
            p2_unit(args, lds, u, lds + PA_RAW + buf * PA_RAWSZ, wave, lane_);
            buf ^= 1;
        }
        if (BOTH(2)) GRID_BAR();
    }

    if (IN(3)) {
        constexpr int NJA = NB * HA * 2, NJB = NB * HB * 4;
        if (G > NJA + NJB && bx >= NJA + NJB) {
            ldsp scr = lds + wave * 17408;
            p0_items(args, P0_I1 + (bx - (NJA + NJB)) * NWAVES + wave, P0_NITEMS, (G - (NJA + NJB)) * NWAVES, scr, lane);
        }
        for (int job = bx; job < NJA + NJB; job += G) {
            if (job < NJA) mixer_a_job(args, lds, job / (2 * HA), (job >> 1) % HA, job & 1, tid);
            else { const int jb = job - NJA; mixer_b_job(args, lds, jb / (4 * HB), (jb >> 2) % HB, jb & 3, tid); }
            BLOCK_BAR();
        }
        if (BOTH(3)) GRID_BAR();
    }

    if (IN(4)) {
        const int gw = vcu * NWAVES + wave, NGW = G * NWAVES;
        const float* SSA = (const float*)(ws + WS_SSA); const float* SSB = (const float*)(ws + WS_SSB);
        static_assert(DA % 512 == 0 && DA == DB, "P3 tiling");
        for (int m = gw; m < M; m += NGW) {
#pragma unroll
            for (int br = 0; br < 2; ++br) {
#pragma unroll
                for (int i = 0; i < DA / 512; ++i) {
                    const int col0 = i * 512 + lane * 8;
                    float rstd;
                    if (br == 0) { const int hh = col0 / 128; rstd = frsq((SSA[((size_t)m * HA + hh) * 2] + SSA[((size_t)m * HA + hh) * 2 + 1]) * (1.0f / 128.0f) + EPS); }
                    else { const int hh = col0 / 256; const f32x4 q_ = *(const f32x4*)(SSB + ((size_t)m * HB + hh) * 4); rstd = frsq(((q_[0] + q_[1]) + (q_[2] + q_[3])) * (1.0f / 256.0f) + EPS); }
                    u32x4* po = (u32x4*)(OAB + (size_t)(br * M + m) * LDU + col0);
                    u32x4 w = *po; const u32x4 g8 = *(const u32x4*)(PB + p_off((size_t)m, (br ? C_OGB : C_OGA) + col0)), z8 = *(const u32x4*)(PB + p_off((size_t)m, (br ? C_ZB : C_ZA) + col0));
                    const f32x4 gn0 = *(const f32x4*)(args.in[br ? 9 : 8] + col0), gn1 = *(const f32x4*)(args.in[br ? 9 : 8] + col0 + 4);
#pragma unroll
                    for (int e = 0; e < 4; ++e) { float v[2];
#pragma unroll
                        for (int k = 0; k < 2; ++k) { const float ov = __builtin_bit_cast(float, k ? (w[e] & 0xffff0000u) : (w[e] << 16)), og = __builtin_bit_cast(float, k ? (g8[e] & 0xffff0000u) : (g8[e] << 16)), z = __builtin_bit_cast(float, k ? (z8[e] & 0xffff0000u) : (z8[e] << 16));
                            const float gnv = (e < 2 ? gn0 : gn1)[(2 * e + k) & 3];
                            v[k] = ov * rstd * gnv * sigm2(og) * (z * sigm2(z)); }
                        w[e] = cvt_pk_bf16(v[0], v[1]); }
                    *po = w;
                }
            }
        }
        if (BOTH(4)) GRID_BAR();
    }
    if (IN(5)) {
        { pg8::Gemm g8{(const bf16*)(ws + WS_H8), (const bf16*)(ws + WS_W8), M, 2 * D, D}; SchedGate S8; S8.so.init(M, D, G, bx);
          EpiP8 E8{PB};
          pg8::gemm_phase<EpiP8, SchedGate, GEMM_ALIGN, GEMM_SP2, 1>(lds, g8, S8, E8); }
        BLOCK_BAR();
        pg8::Gemm g{OAB, WUT, M, D, 2 * DA, LDU, (size_t)M * LDU * 2, (size_t)D * LDU * 2}; SchedRev S; S.init(M, D, G, bx);
        EpiUp2 E{HBUF, make_rsrc(PB, P_BYTES)};
        for (int rep = 0; rep < PROBE_REP_P4; ++rep) pg8::gemm_phase<EpiUp2, SchedRev, GEMM_ALIGN, GEMM_SP2, 2, true>(lds, g, S, E);
        if (BOTH(5)) GRID_BAR();
    }

    if (IN(6)) {
        pg8::Gemm g{HBUF, WOT, M, D, D}; pg8::StaticOrder S; S.init(M, D, G, bx);
        EpiOut E{PB, RSS};
        for (int rep = 0; rep < PROBE_REP_P5; ++rep) pg8::gemm_phase<EpiOut, pg8::StaticOrder, GEMM_ALIGN, GEMM_SP2>(lds, g, S, E);
        if (BOTH(6)) GRID_BAR();
    }

    if (IN(7)) {
        const int gw = vcu * NWAVES + wave, NGW = G * NWAVES;
        const float* gpost = args.in[13];
        for (int m = gw; m < M; m += NGW) {
            const float ss = wave_sum(lane < NRS ? RSS[(size_t)m * NRS + lane] : 0.f);
            const float rstd = frsq(ss * (1.0f / D) + EPS);
            const f32x4* xr = (const f32x4*)(x + (size_t)m * D) + lane; f32x4* orow = (f32x4*)(args.out + (size_t)m * D) + lane; const u32x2* ob = (const u32x2*)(PB + (size_t)m * D) + lane;
#pragma unroll
            for (int jj = 0; jj < D / 256; ++jj) { const f32x4 xv = xr[64 * jj], gg = ((const f32x4*)gpost)[lane + 64 * jj]; const u32x2 w = ob[64 * jj];
                const f32x4 ov = (f32x4){__builtin_bit_cast(float, w.x << 16), __builtin_bit_cast(float, w.x & 0xffff0000u), __builtin_bit_cast(float, w.y << 16), __builtin_bit_cast(float, w.y & 0xffff0000u)};
                orow[64 * jj] = xv + ov * rstd * gg; }
        }
    }
#undef IN
#undef BOTH
}

#ifndef EMU
extern "C" void kernel_launch(void* const* d_in, const int* in_sizes, int n_in, void* d_out, int out_size, void* d_ws, size_t ws_size, hipStream_t stream) {
    static int grid = 0;
    if (grid == 0) {
        if (n_in != 14 || out_size != M * D || ws_size < WS_END) { fprintf(stderr, "kernel_launch: unexpected shapes (n_in %d, out %d, ws %zu < %zu)\n", n_in, out_size, ws_size, (size_t)WS_END); grid = -1; return; }
        int dev = 0, cus = 0, per_cu = 0;
        if (hipGetDevice(&dev) != hipSuccess || hipDeviceGetAttribute(&cus, hipDeviceAttributeMultiprocessorCount, dev) != hipSuccess) { grid = -1; return; }
        if (hipFuncSetAttribute((const void*)fwd_kernel, hipFuncAttributeMaxDynamicSharedMemorySize, LDS_BYTES) != hipSuccess) { fprintf(stderr, "kernel_launch: hipFuncSetAttribute failed\n"); grid = -1; return; }
        if (hipOccupancyMaxActiveBlocksPerMultiprocessor(&per_cu, (const void*)fwd_kernel, NTHREADS, LDS_BYTES) != hipSuccess || per_cu < 1) { fprintf(stderr, "kernel_launch: occupancy query says %d\n", per_cu); }
        (void)hipGetLastError();
        grid = cus;
    }
    if (grid < 0) return;
    (void)hipMemsetAsync((char*)d_ws + WS_CTL, 0, CTL_ZERO_BYTES, stream);
    Args a{};
    for (int i = 0; i < 14; ++i) a.in[i] = (const float*)d_in[i];
    a.out = (float*)d_out; a.ws = (unsigned char*)d_ws; a.ph_lo = 0; a.ph_hi = 8;
    hipLaunchKernelGGL(fwd_kernel, dim3(grid), dim3(NTHREADS), LDS_BYTES, stream, a);
}
#endif
```

```cpp
typedef unsigned u32x2_t __attribute__((ext_vector_type(2)));
typedef int v8i_t __attribute__((ext_vector_type(8)));
typedef int v4i_t __attribute__((ext_vector_type(4)));
#ifndef EMU
#include <hip/hip_runtime.h>
#include <cstdio>
#include <cstdint>
#define LAS __attribute__((address_space(3)))
#define GAS __attribute__((address_space(1)))
typedef short bf16x8 __attribute__((ext_vector_type(8)));
typedef short bf16x4 __attribute__((ext_vector_type(4)));
typedef float f32x4 __attribute__((ext_vector_type(4)));
#define DEV __device__ __forceinline__
#define LDS_RD(T, p) (*(const LAS T*)(p))
#define LDS_WR(T, p, v) (*(LAS T*)(p) = (v))
#define WAVE_SYNC() asm volatile("s_waitcnt lgkmcnt(0)" ::: "memory")
#define BLOCK_BAR() __syncthreads()
#define RAW_BAR() __builtin_amdgcn_s_barrier()
#define WAIT_V(n) asm volatile("s_waitcnt vmcnt(" #n ")" ::: "memory")
#define WAIT_L(n) asm volatile("s_waitcnt lgkmcnt(" #n ")" ::: "memory")
#define SCHED_BAR() __builtin_amdgcn_sched_barrier(0)
#define SETPRIO(n) __builtin_amdgcn_s_setprio(n)
#define GLDS16(g, l) __builtin_amdgcn_global_load_lds((const unsigned*)(g), (LAS unsigned*)(l), 16, 0, 0)
#define MFMA16(a, b, c) __builtin_amdgcn_mfma_f32_16x16x32_bf16(a, b, c, 0, 0, 0)
#define RFL(x) __builtin_amdgcn_readfirstlane(x)
#define COMPILER_FENCE() asm volatile("" ::: "memory")
#define OPAQUE(x) asm volatile("" : "+v"(x))
DEV float fexp2(float x) { return __builtin_amdgcn_exp2f(x); }
DEV float flog2(float x) { return __builtin_amdgcn_logf(x); }
DEV float frcp(float x) { return __builtin_amdgcn_rcpf(x); }
DEV float frsq(float x) { return __builtin_amdgcn_rsqf(x); }
DEV unsigned cvt_pk_bf16(float lo, float hi) { unsigned r; asm volatile("v_cvt_pk_bf16_f32 %0, %1, %2" : "=v"(r) : "v"(lo), "v"(hi)); return r; }
DEV f32x4 mfma8(v8i_t a, v8i_t b, f32x4 c, int sc) { asm volatile("v_mfma_scale_f32_16x16x128_f8f6f4 %0, %1, %2, %0, %3, %3 op_sel_hi:[0,0,0]" : "+v"(c) : "v"(a), "v"(b), "v"(sc)); return c; }
#define MFMA_DRAIN() asm volatile("s_nop 15\n\ts_nop 7" ::: "memory")
DEV unsigned pk_fp8x4(float a, float b, float c, float d) { int r = __builtin_amdgcn_cvt_pk_fp8_f32(a, b, 0, false); r = __builtin_amdgcn_cvt_pk_fp8_f32(c, d, r, true); return (unsigned)r; }
typedef short v4i16_t __attribute__((ext_vector_type(4)));
DEV bf16x4 lds_tr16(LAS unsigned char* p) { return __builtin_bit_cast(bf16x4, __builtin_amdgcn_ds_read_tr16_b64_v4i16((LAS v4i16_t*)p)); }
#define MIX_BAR() do { asm volatile("s_waitcnt lgkmcnt(0)" ::: "memory"); __builtin_amdgcn_s_barrier(); asm volatile("" ::: "memory"); } while (0)
DEV void glds16_asm(const void* gsrc, unsigned lds_dst) { unsigned keep;
    asm volatile("s_mov_b32 %0, m0\n\ts_mov_b32 m0, %2\n\ts_nop 0\n\tglobal_load_lds_dwordx4 %1, off\n\ts_mov_b32 m0, %0" : "=&s"(keep) : "v"(gsrc), "s"(lds_dst) : "memory"); }
#define GLDS16X(g, l) glds16_asm((const void*)(g), (unsigned)RFL((int)(unsigned)(__UINTPTR_TYPE__)(l)))
DEV void glds16_sbase(const void* sbase, unsigned voff, unsigned lds_dst) { unsigned keep;
    asm volatile("s_mov_b32 %0, m0\n\ts_mov_b32 m0, %3\n\ts_nop 0\n\tglobal_load_lds_dwordx4 %1, %2\n\ts_mov_b32 m0, %0" : "=&s"(keep) : "v"(voff), "s"(sbase), "s"(lds_dst) : "memory"); }
#define GLDS16S(sb, vo, l) glds16_sbase((const void*)(sb), (unsigned)(vo), (unsigned)RFL((int)(unsigned)(__UINTPTR_TYPE__)(l)))
typedef __amdgpu_buffer_rsrc_t rsrc_t;
DEV rsrc_t make_rsrc(const void* p, unsigned bytes) { return __builtin_amdgcn_make_buffer_rsrc((void*)p, (short)0, (int)bytes, 0x00020000); }
DEV unsigned short bload16(rsrc_t r, unsigned voff, unsigned soff) { return (unsigned short)__builtin_amdgcn_raw_buffer_load_b16(r, (int)voff, (int)soff, 0); }
DEV void bstore16(rsrc_t r, unsigned voff, unsigned soff, unsigned short v) { __builtin_amdgcn_raw_buffer_store_b16(v, r, (int)voff, (int)soff, 0); }
DEV void bstore64(rsrc_t r, unsigned voff, unsigned soff, u32x2_t v) { __builtin_amdgcn_raw_buffer_store_b64(v, r, (int)voff, (int)soff, 0); }
typedef unsigned u32x4_t __attribute__((ext_vector_type(4)));
DEV u32x4_t bload128(rsrc_t r, unsigned voff, unsigned soff) { return __builtin_amdgcn_raw_buffer_load_b128(r, (int)voff, (int)soff, 0); }
#else
#define LAS
#define GAS
#define DEV inline
#define LDS_RD(T, p) emu_lds_rd<T>((const void*)(p), #p)
#define LDS_WR(T, p, v) emu_lds_wr<T>((void*)(p), (T)(v), #p)
#define WAVE_SYNC() emu_wavesync()
#define BLOCK_BAR() emu_syncthreads()
#define RAW_BAR() emu_syncthreads()
#define WAIT_V(n)
#define WAIT_L(n)
#define SCHED_BAR()
#define SETPRIO(n)
#define GLDS16(g, l) emu_glds16((const void*)(g), (unsigned char*)(l))
#define GLDS16X(g, l) emu_glds16((const void*)(g), (unsigned char*)(l))
#define GLDS16S(sb, vo, l) emu_glds16((const void*)((const char*)(sb) + (vo)), (unsigned char*)(l))
#define MFMA16(a, b, c) emu_mfma16(a, b, c)
#define RFL(x) (x)
#define COMPILER_FENCE()
#define OPAQUE(x)
DEV float fexp2(float x) { return exp2f(x); }
DEV float flog2(float x) { return log2f(x); }
DEV float frcp(float x) { return 1.0f / x; }
DEV float frsq(float x) { return 1.0f / sqrtf(x); }
DEV unsigned cvt_pk_bf16(float lo, float hi) { return (unsigned)emu_f2bf(lo) | ((unsigned)emu_f2bf(hi) << 16); }
#define mfma8(a, b, c, sc) emu_mfma8(a, b, c)
#define MFMA_DRAIN()
DEV unsigned pk_fp8x4(float a, float b, float c, float d) { return (unsigned)emu_f2fp8(a) | ((unsigned)emu_f2fp8(b) << 8) | ((unsigned)emu_f2fp8(c) << 16) | ((unsigned)emu_f2fp8(d) << 24); }
#define lds_tr16(p) emu_lds_tr16((const unsigned char*)(p))
#define MIX_BAR() emu_syncthreads()
typedef unsigned char* rsrc_t;
DEV rsrc_t make_rsrc(const void* p, unsigned) { return (unsigned char*)p; }
DEV unsigned short bload16(rsrc_t r, unsigned voff, unsigned soff) { unsigned short v; memcpy(&v, r + (size_t)voff + soff, 2); return v; }
DEV void bstore16(rsrc_t r, unsigned voff, unsigned soff, unsigned short v) { memcpy(r + (size_t)voff + soff, &v, 2); }
DEV void bstore64(rsrc_t r, unsigned voff, unsigned soff, u32x2_t v) { memcpy(r + (size_t)voff + soff, &v, 8); }
typedef unsigned u32x4_t __attribute__((ext_vector_type(4)));
DEV u32x4_t bload128(rsrc_t r, unsigned voff, unsigned soff) { u32x4_t v; memcpy(&v, r + (size_t)voff + soff, 16); return v; }
#endif

typedef unsigned short bf16;
typedef unsigned u32x4 __attribute__((ext_vector_type(4)));
typedef unsigned u32x2 __attribute__((ext_vector_type(2)));
typedef float f32x2 __attribute__((ext_vector_type(2)));
typedef LAS unsigned char* ldsp;

#ifndef CFG_D
#define CFG_D 4096
#define CFG_B 4
#define CFG_S 4096
#define CFG_HB 8
#endif
constexpr int D = CFG_D, NB = CFG_B, SEQ = CFG_S, M = NB * SEQ;
constexpr int DA = D / 2, HA = DA / 128, DB = D / 2, HB = CFG_HB, DVB = DB / HB, DKB = 128, DQK = HB * DKB;
constexpr int NSG = 2 * HB;
constexpr int NCH = SEQ / 64;
static_assert(DVB == 256 && NSG <= 16 && SEQ % 64 == 0 && M % 256 == 0 && D % 256 == 0, "shape");
constexpr int C_QA = 0, C_FA = DA, C_IA = 2 * DA, C_OGA = 3 * DA, C_ZA = 4 * DA, C_QB = 5 * DA, C_KB = C_QB + DQK, C_VB = C_KB + DQK, C_OGB = C_VB + DB, C_ZB = C_OGB + DB;
constexpr int NPM = C_ZB + DB, C_GA = NPM, C_GB = NPM + D, NP = NPM + 2 * D, D_IN = NP + NSG;
static_assert(NPM % 256 == 0 && NP % 256 == 0, "column map");
constexpr float EPS = 1e-6f;
constexpr float H8_SCALE = 64.0f, W8_SCALE = 1024.0f, G8_DESCALE = 1.0f / (64.0f * 1024.0f);
constexpr float LOG2E = 1.4426950408889634f, LN2 = 0.6931471805599453f;
constexpr int NRS = D / 64;
constexpr int PT_PITCH = M / 64 + 1;
DEV size_t p_off(size_t row, int col) { return ((size_t)(col >> 7) * (size_t)PT_PITCH + (row >> 6)) * 8192 + (row & 63) * 128 + (size_t)(col & 127); }

constexpr size_t al256(size_t x) { return (x + 255) & ~(size_t)255; }
constexpr size_t WS_CTL = 0, CTL_ZERO_BYTES = 65536;
constexpr size_t WS_W1T = 1u << 20;
constexpr int LDU = DA + 64;
constexpr size_t WS_WUT = al256(WS_W1T + (size_t)(NP + 16) * D * 2);
constexpr size_t WS_WOT = al256(WS_WUT + (size_t)2 * D * LDU * 2);
constexpr size_t WS_HB = al256(WS_WOT + (size_t)D * D * 2);
constexpr size_t WS_P = al256(WS_HB + (size_t)M * D * 2);
constexpr size_t WS_SG = al256(WS_P + (size_t)(NP / 128) * (M / 64 + 1) * 16384 + 4096);
constexpr size_t WS_OAB = al256(WS_SG + (size_t)M * 16 * 4);
constexpr size_t WS_RSS = al256(WS_OAB + (size_t)2 * M * LDU * 2);
constexpr size_t WS_SSB = al256(WS_RSS + (size_t)M * NRS * 4);
constexpr size_t WS_SSA = al256(WS_SSB + (size_t)M * HB * 4 * 4);
constexpr size_t WS_H8 = al256(WS_SSA + (size_t)M * HA * 2 * 4);
constexpr size_t WS_W8 = al256(WS_H8 + (size_t)M * D);
constexpr size_t WS_END = al256(WS_W8 + (size_t)2 * D * D);
constexpr size_t WS_W8OG = WS_P + (size_t)(NPM / 128) * (M / 64 + 1) * 16384;
static_assert((size_t)(DA + DB) * D <= (size_t)(2 * D / 128) * (M / 64 + 1) * 16384, "out-gate weight copy fits the merge-gate tiles");
constexpr int CW_BAR = 1024;

constexpr int RING_BYTES = 154624, LDSCTL_OFF = RING_BYTES, MISC_OFF = LDSCTL_OFF + 320, LDS_BYTES = 155648;
constexpr int NWAVES = 8, NTHREADS = 512;

DEV unsigned f2bf(float f) { unsigned u = __builtin_bit_cast(unsigned, f); return (u + 0x7fffu + ((u >> 16) & 1u)) >> 16; }
DEV float bf2f(unsigned b) { return __builtin_bit_cast(float, b << 16); }
DEV unsigned pk2(float lo, float hi) { return f2bf(lo) | (f2bf(hi) << 16); }
DEV float fexp(float x) { return fexp2(x * LOG2E); }
DEV float flog(float x) { return flog2(x) * LN2; }
DEV float sigm(float x) { return frcp(1.0f + fexp(-x)); }
DEV float logsig(float x) { return fminf(x, 0.f) - flog(1.0f + fexp(-fabsf(x))); }
DEV float wave_sum(float v) {
#pragma unroll
    for (int o = 1; o < 64; o <<= 1) v += __shfl_xor(v, o);
    return v;
}

namespace pg8 {
constexpr int BM = 256, BK = 64, HALF = 128, HTB = HALF * BK * 2, STAGE_BYTES = 8 * HTB, NXCD = 8, WGM = 8;
DEV int lds_byte(int r, int c) { const int st = (r >> 4) * 2 + (c >> 5), rr = r & 15, cc = c & 31, ob = rr * 64 + cc * 2; return st * 1024 + (ob ^ (((ob >> 9) & 1) << 5)); }
DEV void stage_rc(int b, int& R, int& C) { const int st = b / 1024, sb = b % 1024, swz = sb ^ (((sb >> 9) & 1) << 5); R = (st >> 1) * 16 + swz / 64; C = (st & 1) * 32 + (swz % 64) / 2; }
DEV int perm32(int rho) { const int n = rho >> 4, i = rho & 15; return 8 * (i >> 2) + 4 * n + (i & 3); }
struct Unit { int pm, pn; };
struct Gemm { const bf16* A; const bf16* Bt; int M, N, K; int ld; size_t a2off, b2off; };
struct StaticOrder {
    int nM, nN, nwg, G, c;
    DEV void init(int M_, int N_, int G_, int c_) { nM = M_ / BM; nN = N_ / BM; nwg = nM * nN; G = G_; c = c_; }
    DEV bool next(int i, Unit& u) const {
        const long L = (long)i * G + c; if (L >= nwg) return false;
        int wgid = (int)L; { const int q = nwg / NXCD, r = nwg % NXCD, xcd = wgid % NXCD, off = wgid / NXCD; wgid = (xcd < r ? xcd * (q + 1) : r * (q + 1) + (xcd - r) * q) + off; }
        const int nig = WGM * nN, gid = wgid / nig, fm = gid * WGM, gsz = (nM - fm) < WGM ? (nM - fm) : WGM;
        u.pm = fm + ((wgid % nig) % gsz); u.pn = (wgid % nig) / gsz; return true;
    }
};
template <class Epi, class Sched, bool ALIGN_EPI = false, bool SP2 = false, int ESZ = 2, bool SPLITK = false>
DEV void gemm_phase(ldsp lds, const Gemm g, const Sched& S, const Epi& E) {
    const int tid = threadIdx.x, wid = RFL(tid >> 6), lane = tid & 63, wr = wid >> 2, wc = wid & 3, fr = lane & 15, fq = lane >> 4;
    const int nt = (g.K * ESZ / 2) / BK, K = (g.ld ? g.ld : g.K) * ESZ / 2;
    unsigned voffA[2], voffB[2];
#pragma unroll
    for (int i = 0; i < 2; ++i) { int R, C; stage_rc(tid * 16 + i * 8192, R, C); const int Rb = Epi::PERM ? ((R & ~31) + perm32(R & 31)) : R;
        voffA[i] = (unsigned)(R * K + C) * 2u; voffB[i] = (unsigned)(Rb * K + C) * 2u; }
    const size_t kstep = (size_t)(BK * 2);
    const size_t hstep = (size_t)HALF * K * 2;
    const size_t tstep = 2 * hstep;
    const unsigned ldsw = (unsigned)wid * 1024u;
    int aoffk[2], boffk[2];
#pragma unroll
    for (int k = 0; k < 2; ++k) { const int ch = ESZ == 2 ? fq + 4 * k : 2 * fq + k;
        aoffk[k] = lds_byte(wr * 64 + fr, (ch & 3) * 8) + (ch >> 2) * 1024; boffk[k] = lds_byte(wc * 32 + fr, (ch & 3) * 8) + (ch >> 2) * 1024; }
#define PG8_SA(b, h) (((b) * 2 + (h)) * HTB)
#define PG8_SB(b, h) ((4 + (b) * 2 + (h)) * HTB)
#define PG8_STAGE(bufoff, gbase, voff) do { _Pragma("unroll") for (int _i = 0; _i < 2; ++_i) \
        GLDS16((const char*)(gbase) + (voff)[_i], lds + (bufoff) + ldsw + _i * 8192); } while (0)
#define PG8_LDA(dst, b, h) do { _Pragma("unroll") for (int m = 0; m < 4; ++m) { if constexpr (ESZ == 2) { _Pragma("unroll") for (int k = 0; k < 2; ++k) dst[m][k] = *(const LAS bf16x8*)(lds + PG8_SA(b, h) + aoffk[k] + m * 2048); } \
        else dst##8[m] = __builtin_shufflevector(*(const LAS v4i_t*)(lds + PG8_SA(b, h) + aoffk[0] + m * 2048), *(const LAS v4i_t*)(lds + PG8_SA(b, h) + aoffk[1] + m * 2048), 0, 1, 2, 3, 4, 5, 6, 7); } } while (0)
#define PG8_LDB(dst, b, h) do { _Pragma("unroll") for (int n = 0; n < 2; ++n) { if constexpr (ESZ == 2) { _Pragma("unroll") for (int k = 0; k < 2; ++k) dst[n][k] = *(const LAS bf16x8*)(lds + PG8_SB(b, h) + boffk[k] + n * 2048); } \
        else dst##8[n] = __builtin_shufflevector(*(const LAS v4i_t*)(lds + PG8_SB(b, h) + boffk[0] + n * 2048), *(const LAS v4i_t*)(lds + PG8_SB(b, h) + boffk[1] + n * 2048), 0, 1, 2, 3, 4, 5, 6, 7); } } while (0)
#define PG8_MMA(ai, bj, At, Bt) do { SETPRIO(1); _Pragma("unroll") for (int m = 0; m < 4; ++m) _Pragma("unroll") for (int n = 0; n < 2; ++n) { \
        if constexpr (ESZ == 2) { _Pragma("unroll") for (int k = 0; k < 2; ++k) acc[ai][bj][m][n] = MFMA16(Bt[n][k], At[m][k], acc[ai][bj][m][n]); } \
        else acc[ai][bj][m][n] = mfma8(Bt##8[n], At##8[m], acc[ai][bj][m][n], sc8); } SETPRIO(0); } while (0)
    int sc8 = 0x7f7f7f7f; OPAQUE(sc8);
    Unit cur, nxt; int ui = 0;
    if (!S.next(0, cur)) return;
    f32x4 acc[2][2][4][2];
#pragma unroll
    for (int a = 0; a < 2; ++a)
#pragma unroll
        for (int b = 0; b < 2; ++b)
#pragma unroll
            for (int m = 0; m < 4; ++m)
#pragma unroll
                for (int n = 0; n < 2; ++n) acc[a][b][m][n] = (f32x4){0.f, 0.f, 0.f, 0.f};
    bf16x8 At[ESZ == 2 ? 4 : 1][2], B0[ESZ == 2 ? 2 : 1][2], B1[ESZ == 2 ? 2 : 1][2];
    v8i_t At8[ESZ == 1 ? 4 : 1], B08[ESZ == 1 ? 2 : 1], B18[ESZ == 1 ? 2 : 1];
    const char* cA = (const char*)g.A + (size_t)cur.pm * tstep; const char* cB = (const char*)g.Bt + (size_t)cur.pn * tstep;
    if constexpr (SP2) {
        PG8_STAGE(PG8_SB(0, 0), cB, voffB); PG8_STAGE(PG8_SB(0, 1), cB + hstep, voffB); PG8_STAGE(PG8_SA(0, 0), cA, voffA); PG8_STAGE(PG8_SA(0, 1), cA + hstep, voffA);
        if (wr == 1) RAW_BAR();
        WAIT_V(2); RAW_BAR();
        PG8_STAGE(PG8_SB(1, 0), cB + kstep, voffB); PG8_STAGE(PG8_SA(1, 0), cA + kstep, voffA); PG8_STAGE(PG8_SB(1, 1), cB + hstep + kstep, voffB);
        WAIT_V(6); RAW_BAR();
    } else {
        PG8_STAGE(PG8_SB(0, 0), cB, voffB); PG8_STAGE(PG8_SA(0, 0), cA, voffA); PG8_STAGE(PG8_SB(0, 1), cB + hstep, voffB); PG8_STAGE(PG8_SA(0, 1), cA + hstep, voffA);
        if (wr == 1) RAW_BAR();
        WAIT_V(4); RAW_BAR();
        PG8_STAGE(PG8_SB(1, 0), cB + kstep, voffB); PG8_STAGE(PG8_SA(1, 0), cA + kstep, voffA); PG8_STAGE(PG8_SB(1, 1), cB + hstep + kstep, voffB);
        WAIT_V(6); RAW_BAR();
    }
    for (;;) {
        const bool has_next = S.next(ui + 1, nxt);
        const char* nA = has_next ? (const char*)g.A + (size_t)nxt.pm * tstep : cA; const char* nB = has_next ? (const char*)g.Bt + (size_t)nxt.pn * tstep : cB;
        for (int t = 0; t < nt; t += 2) {
            const bool last = (t == nt - 2);
            const size_t h1 = (SPLITK && t >= nt / 2) ? 1 : 0, h2 = (SPLITK && t + 2 >= nt / 2) ? 1 : 0;
            const char* a1 = cA + (size_t)(t + 1) * kstep + h1 * (g.a2off - (size_t)(nt / 2) * kstep);
            const char* a2 = last ? nA : cA + (size_t)(t + 2) * kstep + h2 * (g.a2off - (size_t)(nt / 2) * kstep); const char* b2 = last ? nB : cB + (size_t)(t + 2) * kstep + h2 * (g.b2off - (size_t)(nt / 2) * kstep);
            const char* a3 = a2 + kstep; const char* b3 = b2 + kstep;
            if constexpr (SPLITK) { if (t == nt / 2) {
                if constexpr (ALIGN_EPI) { if (wr == 0) RAW_BAR(); }
                int fr_ = fr; OPAQUE(fr_); E.mid(acc, cur, wr, wc, fr_, fq);
                if constexpr (ALIGN_EPI) { if (wr == 1) RAW_BAR(); } } }
            if constexpr (SP2) {
            PG8_LDB(B0, 0, 0); PG8_LDB(B1, 0, 1); SCHED_BAR(); PG8_LDA(At, 0, 0); PG8_STAGE(PG8_SA(1, 1), a1 + hstep, voffA);
            WAIT_V(8); WAIT_L(0); RAW_BAR(); PG8_MMA(0, 0, At, B0); PG8_MMA(0, 1, At, B1); RAW_BAR(); SCHED_BAR();
            PG8_LDA(At, 0, 1); PG8_STAGE(PG8_SB(0, 0), b2, voffB); PG8_STAGE(PG8_SB(0, 1), b2 + hstep, voffB); PG8_STAGE(PG8_SA(0, 0), a2, voffA);
            WAIT_V(8); WAIT_L(0); RAW_BAR(); PG8_MMA(1, 0, At, B0); PG8_MMA(1, 1, At, B1); RAW_BAR(); SCHED_BAR();
            PG8_LDB(B0, 1, 0); PG8_LDB(B1, 1, 1); SCHED_BAR(); PG8_LDA(At, 1, 0); PG8_STAGE(PG8_SA(0, 1), a2 + hstep, voffA);
            WAIT_V(8); WAIT_L(0); RAW_BAR(); PG8_MMA(0, 0, At, B0); PG8_MMA(0, 1, At, B1); RAW_BAR(); SCHED_BAR();
            PG8_LDA(At, 1, 1); PG8_STAGE(PG8_SB(1, 0), b3, voffB); PG8_STAGE(PG8_SB(1, 1), b3 + hstep, voffB); PG8_STAGE(PG8_SA(1, 0), a3, voffA);
            WAIT_V(8); WAIT_L(0); RAW_BAR(); PG8_MMA(1, 0, At, B0); PG8_MMA(1, 1, At, B1); RAW_BAR(); SCHED_BAR();
            } else {
            PG8_LDB(B0, 0, 0); SCHED_BAR(); PG8_LDA(At, 0, 0); PG8_STAGE(PG8_SA(1, 1), a1 + hstep, voffA);
            WAIT_L(8); RAW_BAR(); WAIT_L(0); PG8_MMA(0, 0, At, B0); RAW_BAR(); SCHED_BAR();
            PG8_LDB(B1, 0, 1); PG8_STAGE(PG8_SB(0, 0), b2, voffB);
            RAW_BAR(); WAIT_L(0); PG8_MMA(0, 1, At, B1); RAW_BAR();
            PG8_LDA(At, 0, 1); PG8_STAGE(PG8_SA(0, 0), a2, voffA);
            RAW_BAR(); WAIT_L(0); PG8_MMA(1, 0, At, B0); RAW_BAR(); SCHED_BAR();
            PG8_STAGE(PG8_SB(0, 1), b2 + hstep, voffB);
            WAIT_V(6); RAW_BAR(); PG8_MMA(1, 1, At, B1); RAW_BAR();
            PG8_LDB(B0, 1, 0); SCHED_BAR(); PG8_LDA(At, 1, 0); PG8_STAGE(PG8_SA(0, 1), a2 + hstep, voffA);
            WAIT_L(8); RAW_BAR(); WAIT_L(0); PG8_MMA(0, 0, At, B0); RAW_BAR(); SCHED_BAR();
            PG8_LDB(B1, 1, 1); PG8_STAGE(PG8_SB(1, 0), b3, voffB);
            RAW_BAR(); WAIT_L(0); PG8_MMA(0, 1, At, B1); RAW_BAR();
            PG8_LDA(At, 1, 1); PG8_STAGE(PG8_SA(1, 0), a3, voffA);
            RAW_BAR(); WAIT_L(0); PG8_MMA(1, 0, At, B0); RAW_BAR(); SCHED_BAR();
            PG8_STAGE(PG8_SB(1, 1), b3 + hstep, voffB);
            WAIT_V(6); RAW_BAR(); PG8_MMA(1, 1, At, B1); RAW_BAR();
            }
        }
        if constexpr (ALIGN_EPI) { if (wr == 0) RAW_BAR(); }
        if constexpr (ESZ == 1) { MFMA_DRAIN();
#pragma unroll
            for (int a = 0; a < 2; ++a)
#pragma unroll
                for (int b = 0; b < 2; ++b) asm volatile("" : "+v"(acc[a][b][0][0]), "+v"(acc[a][b][0][1]), "+v"(acc[a][b][1][0]), "+v"(acc[a][b][1][1]), "+v"(acc[a][b][2][0]), "+v"(acc[a][b][2][1]), "+v"(acc[a][b][3][0]), "+v"(acc[a][b][3][1])); }
        E(acc, cur, wr, wc, fr, fq);
        if (!has_next) break;
#pragma unroll
        for (int a = 0; a < 2; ++a)
#pragma unroll
            for (int b = 0; b < 2; ++b)
#pragma unroll
                for (int m = 0; m < 4; ++m)
#pragma unroll
                    for (int n = 0; n < 2; ++n) acc[a][b][m][n] = (f32x4){0.f, 0.f, 0.f, 0.f};
        cur = nxt; cA = nA; cB = nB; ++ui;
        if constexpr (ALIGN_EPI) { if (wr == 1) RAW_BAR(); }
    }
    WAIT_V(0);
    if constexpr (!ALIGN_EPI) { if (wr == 0) RAW_BAR(); }
    RAW_BAR();
#undef PG8_SA
#undef PG8_SB
#undef PG8_STAGE
#undef PG8_LDA
#undef PG8_LDB
#undef PG8_MMA
}
}

struct EpiP {
    static constexpr bool PERM = true;
    bf16* O;
    DEV void operator()(const f32x4 (&acc)[2][2][4][2], const pg8::Unit& u, int wr, int wc, int fr, int fq) const {
        const int row0 = u.pm * 256 + wr * 64 + fr, col0 = u.pn * 256 + wc * 32 + 8 * fq;
#pragma unroll
        for (int ai = 0; ai < 2; ++ai)
#pragma unroll
            for (int m = 0; m < 4; ++m) { const size_t row = (size_t)(row0 + ai * 128 + m * 16);
#pragma unroll
                for (int bj = 0; bj < 2; ++bj) { const f32x4 v0 = acc[ai][bj][m][0], v1 = acc[ai][bj][m][1];
                    u32x4 w; w.x = cvt_pk_bf16(v0[0], v0[1]); w.y = cvt_pk_bf16(v0[2], v0[3]); w.z = cvt_pk_bf16(v1[0], v1[1]); w.w = cvt_pk_bf16(v1[2], v1[3]);
                    *(u32x4*)(O + p_off(row, col0 + bj * 128)) = w; } }
    }
};
struct EpiP8 {
    static constexpr bool PERM = true;
    bf16* O;
    DEV void operator()(const f32x4 (&acc)[2][2][4][2], const pg8::Unit& u, int wr, int wc, int fr, int fq) const {
        const int row0 = u.pm * 256 + wr * 64 + fr, col0 = NPM + u.pn * 256 + wc * 32 + 8 * fq;
#pragma unroll
        for (int ai = 0; ai < 2; ++ai)
#pragma unroll
            for (int m = 0; m < 4; ++m) { const size_t row = (size_t)(row0 + ai * 128 + m * 16);
#pragma unroll
                for (int bj = 0; bj < 2; ++bj) { const f32x4 v0 = acc[ai][bj][m][0] * G8_DESCALE, v1 = acc[ai][bj][m][1] * G8_DESCALE;
                    u32x4 w; w.x = cvt_pk_bf16(v0[0], v0[1]); w.y = cvt_pk_bf16(v0[2], v0[3]); w.z = cvt_pk_bf16(v1[0], v1[1]); w.w = cvt_pk_bf16(v1[2], v1[3]);
                    *(u32x4*)(O + p_off(row, col0 + bj * 128)) = w; } }
    }
};
struct SchedUp {
    pg8::StaticOrder so;
    DEV bool next(int i, pg8::Unit& u) const { if (!so.next(i >> 1, u)) return false; if (i & 1) { u.pm += M / 256; u.pn += D / 256; } return true; }
};
struct EpiUp {
    static constexpr bool PERM = true;
    bf16* Y; const bf16* P;
    DEV void operator()(const f32x4 (&acc)[2][2][4][2], const pg8::Unit& u, int wr, int wc, int fr, int fq) const {
        const int br = u.pm >= M / 256 ? 1 : 0, pm = u.pm - br * (M / 256), pn = u.pn - br * (D / 256);
        const int row0 = pm * 256 + wr * 64 + fr, col0 = pn * 256 + wc * 32 + 8 * fq, gcol = (br ? C_GB : C_GA) + col0;
#pragma unroll
        for (int ai = 0; ai < 2; ++ai)
#pragma unroll
            for (int m = 0; m < 4; ++m) { const size_t row = (size_t)(row0 + ai * 128 + m * 16);
#pragma unroll
                for (int bj = 0; bj < 2; ++bj) {
                    const u32x4 g8 = *(const u32x4*)(P + p_off(row, gcol + bj * 128));
                    bf16* yp = Y + row * D + col0 + bj * 128;
                    u32x4 y8 = (u32x4){0u, 0u, 0u, 0u}; if (br) y8 = *(const u32x4*)yp;
                    const f32x4 v0 = acc[ai][bj][m][0], v1 = acc[ai][bj][m][1];
                    float o[8];
#pragma unroll
                    for (int k = 0; k < 8; ++k) { const unsigned gw = g8[k >> 1], yw = y8[k >> 1]; const float gv = bf2f((k & 1) ? (gw >> 16) : (gw & 0xffffu)), yv = bf2f((k & 1) ? (yw >> 16) : (yw & 0xffffu));
                        const float a = k < 4 ? v0[k & 3] : v1[k & 3]; o[k] = yv + sigm(gv) * a; }
                    u32x4 w; w.x = cvt_pk_bf16(o[0], o[1]); w.y = cvt_pk_bf16(o[2], o[3]); w.z = cvt_pk_bf16(o[4], o[5]); w.w = cvt_pk_bf16(o[6], o[7]);
                    *(u32x4*)yp = w; } }
    }
};
struct SchedSkipOg { pg8::StaticOrder so; DEV bool next(int i, pg8::Unit& u) const { if (!so.next(i, u)) return false; if (u.pn >= C_OGA / 256) u.pn += DA / 256; if (u.pn >= C_OGB / 256) u.pn += DB / 256; return true; } };
static_assert(C_OGA % 256 == 0 && C_OGB % 256 == 0 && DA % 256 == 0 && DB % 256 == 0 && C_OGA < C_OGB, "out-gate column tiles");
struct EpiOg {
    static constexpr bool PERM = true;
    bf16* O;
    DEV void operator()(const f32x4 (&acc)[2][2][4][2], const pg8::Unit& u, int wr, int wc, int fr, int fq) const {
        const int cb = u.pn < DA / 256 ? C_OGA + u.pn * 256 : C_OGB + (u.pn - DA / 256) * 256;
        const int row0 = u.pm * 256 + wr * 64 + fr, col0 = cb + wc * 32 + 8 * fq;
#pragma unroll
        for (int ai = 0; ai < 2; ++ai)
#pragma unroll
            for (int m = 0; m < 4; ++m) { const size_t row = (size_t)(row0 + ai * 128 + m * 16);
#pragma unroll
                for (int bj = 0; bj < 2; ++bj) { const f32x4 v0 = acc[ai][bj][m][0] * G8_DESCALE, v1 = acc[ai][bj][m][1] * G8_DESCALE;
                    u32x4 w; w.x = cvt_pk_bf16(v0[0], v0[1]); w.y = cvt_pk_bf16(v0[2], v0[3]); w.z = cvt_pk_bf16(v1[0], v1[1]); w.w = cvt_pk_bf16(v1[2], v1[3]);
                    *(u32x4*)(O + p_off(row, col0 + bj * 128)) = w; } }
    }
};
struct SchedGate { pg8::StaticOrder so; DEV bool next(int i, pg8::Unit& u) const { if (!so.next(i >> 1, u)) return false; if (i & 1) u.pn += D / 256; return true; } };
struct SchedRev { pg8::StaticOrder so; int n; DEV void init(int M_, int N_, int G_, int c_) { so.init(M_, N_, G_, c_); n = so.nwg > c_ ? (so.nwg - c_ + G_ - 1) / G_ : 0; }
    DEV bool next(int i, pg8::Unit& u) const { return i < n && so.next(n - 1 - i, u); } };
constexpr unsigned P_BYTES = (unsigned)((size_t)(NP / 128) * PT_PITCH * 16384);
DEV unsigned p_soff(int pm, int cb, int ai, int m, int wr, int wc) { return (unsigned)((cb * PT_PITCH + 4 * pm + 2 * ai + wr) * 16384 + m * 4096 + wc * 64); }
constexpr unsigned GB_MINUS_GA = (unsigned)((D / 128) * PT_PITCH) * 16384u;
struct EpiUp2 {
    static constexpr bool PERM = true;
    bf16* Y; rsrc_t rs;
    DEV void mid(f32x4 (&acc)[2][2][4][2], const pg8::Unit& u, int wr, int wc, int fr, int fq) const {
        const unsigned voff = (unsigned)(fr * 256 + fq * 16);
#pragma unroll
        for (int ai = 0; ai < 2; ++ai) { u32x4 ga[8], gb[8];
#pragma unroll
            for (int s_ = 0; s_ < 8; ++s_) { const unsigned so = p_soff(u.pm, NPM / 128 + 2 * u.pn + (s_ & 1), ai, s_ >> 1, wr, wc); ga[s_] = bload128(rs, voff, so); gb[s_] = bload128(rs, voff, so + GB_MINUS_GA); }
            SCHED_BAR();
#pragma unroll
            for (int s_ = 0; s_ < 8; ++s_) { const int m = s_ >> 1, bj = s_ & 1;
#pragma unroll
                for (int k = 0; k < 8; ++k) { const unsigned aw = ga[s_][k >> 1], bw = gb[s_][k >> 1];
                    const float av = __builtin_bit_cast(float, (k & 1) ? (aw & 0xffff0000u) : (aw << 16)), bv_ = __builtin_bit_cast(float, (k & 1) ? (bw & 0xffff0000u) : (bw << 16));
                    const float ratio = (1.0f + fexp2(-LOG2E * bv_)) * frcp(1.0f + fexp2(-LOG2E * av));
                    if (k < 4) acc[ai][bj][m][0][k & 3] *= ratio; else acc[ai][bj][m][1][k & 3] *= ratio; } } }
    }
    DEV void operator()(const f32x4 (&acc)[2][2][4][2], const pg8::Unit& u, int wr, int wc, int fr, int fq) const {
        const int row0 = u.pm * 256 + wr * 64 + fr, col0 = u.pn * 256 + wc * 32 + 8 * fq; const unsigned voff = (unsigned)(fr * 256 + fq * 16); u32x4 gb[16];
#pragma unroll
        for (int s_ = 0; s_ < 16; ++s_) gb[s_] = bload128(rs, voff, p_soff(u.pm, NPM / 128 + 2 * u.pn + (s_ & 1), s_ >> 3, (s_ >> 1) & 3, wr, wc) + GB_MINUS_GA);
        SCHED_BAR();
#pragma unroll
        for (int s_ = 0; s_ < 16; ++s_) { const int ai = s_ >> 3, m = (s_ >> 1) & 3, bj = s_ & 1; const size_t row = (size_t)(row0 + ai * 128 + m * 16);
            const f32x4 v0 = acc[ai][bj][m][0], v1 = acc[ai][bj][m][1]; float o[8];
#pragma unroll
            for (int k = 0; k < 8; ++k) { const unsigned bw = gb[s_][k >> 1]; const float bv_ = __builtin_bit_cast(float, (k & 1) ? (bw & 0xffff0000u) : (bw << 16));
                o[k] = (k < 4 ? v0[k & 3] : v1[k & 3]) * frcp(1.0f + fexp2(-LOG2E * bv_)); }
            u32x4 w; w.x = cvt_pk_bf16(o[0], o[1]); w.y = cvt_pk_bf16(o[2], o[3]); w.z = cvt_pk_bf16(o[4], o[5]); w.w = cvt_pk_bf16(o[6], o[7]);
            *(u32x4*)(Y + row * D + col0 + bj * 128) = w; }
    }
};
struct EpiOut {
    static constexpr bool PERM = true;
    bf16* C; float* RSS;
    DEV void operator()(const f32x4 (&acc)[2][2][4][2], const pg8::Unit& u, int wr, int wc, int fr, int fq) const {
        const int row0 = u.pm * 256 + wr * 64 + fr, col0 = u.pn * 256 + wc * 32 + 8 * fq;
#pragma unroll
        for (int ai = 0; ai < 2; ++ai)
#pragma unroll
            for (int m = 0; m < 4; ++m) { const size_t row = (size_t)(row0 + ai * 128 + m * 16); bf16* rowp = C + row * D + col0; float ss = 0.f;
#pragma unroll
                for (int bj = 0; bj < 2; ++bj) { const f32x4 v0 = acc[ai][bj][m][0], v1 = acc[ai][bj][m][1];
                    ss += ((v0[0] * v0[0] + v0[1] * v0[1]) + (v0[2] * v0[2] + v0[3] * v0[3])) + ((v1[0] * v1[0] + v1[1] * v1[1]) + (v1[2] * v1[2] + v1[3] * v1[3]));
                    u32x4 w; w.x = cvt_pk_bf16(v0[0], v0[1]); w.y = cvt_pk_bf16(v0[2], v0[3]); w.z = cvt_pk_bf16(v1[0], v1[1]); w.w = cvt_pk_bf16(v1[2], v1[3]);
                    *(u32x4*)(rowp + bj * 128) = w; }
                ss += __shfl_xor(ss, 16); ss += __shfl_xor(ss, 32);
                if (fq == 0) RSS[row * NRS + u.pn * 4 + wc] = ss; }
    }
};

#ifndef EMU
typedef GAS unsigned gu32;
#define RLX_AGENT __ATOMIC_RELAXED, __HIP_MEMORY_SCOPE_AGENT
#define XB_TMO      128
#define XB_XCNT(j)  (256  + 64 * (j))
#define XB_XSUB(j)  (1280 + 64 * (j))
#define XB_XGEN(j)  (2304 + 64 * (j))
#define XB_TOP      3328
#define XB_TOPGEN   3392
#define XCD_BAR_WORDS 3456
#define XB_SPIN_CAP (1u << 22)
__device__ __forceinline__ unsigned xb_ld(unsigned* p)              { return __hip_atomic_load(p, __ATOMIC_RELAXED, __HIP_MEMORY_SCOPE_AGENT); }
__device__ __forceinline__ unsigned xb_add(unsigned* p, unsigned v) { return __hip_atomic_fetch_add(p, v, __ATOMIC_RELAXED, __HIP_MEMORY_SCOPE_AGENT); }
__device__ __forceinline__ unsigned xb_xcc_id() { return (unsigned)__builtin_amdgcn_s_getreg((3 << 11) | 20) & 0xFu; }
#define XB_SPIN(cond, bar) do { unsigned _sp = 0; while (cond) { __builtin_amdgcn_s_sleep(1); \
    if ((++_sp & 255u) == 0u) { if (xb_ld(&(bar)[XB_TMO])) break; if (_sp > XB_SPIN_CAP) { atomicAdd(&(bar)[XB_TMO], 1u); break; } } } } while (0)
struct XcdBarrier { unsigned* bar; unsigned x; volatile LAS unsigned* st; };
__device__ __forceinline__ XcdBarrier xcd_barrier_post(unsigned* bar, volatile LAS unsigned* st) {
    XcdBarrier b; b.bar = bar; b.x = xb_xcc_id(); b.st = st;
    if (threadIdx.x == 0) (void)xb_add(&bar[XB_XCNT(b.x)], 1u);
    return b;
}
__device__ __forceinline__ void xcd_barrier_complete(unsigned* bar, unsigned x, unsigned& nloc, unsigned& nx) {
    const unsigned G = gridDim.x * gridDim.y * gridDim.z;
    unsigned sum, cnt, mine, sp = 0u;
    for (;;) {
        sum = 0u; cnt = 0u; mine = 0u;
#pragma unroll
        for (unsigned j = 0; j < 16; ++j) { const unsigned c = xb_ld(&bar[XB_XCNT(j)]); sum += c; cnt += (c > 0u) ? 1u : 0u; mine = (j == x) ? c : mine; }
        if (sum == G) break;
        __builtin_amdgcn_s_sleep(1);
        if ((++sp & 255u) == 0u) { if (xb_ld(&bar[XB_TMO])) break; if (sp > XB_SPIN_CAP) { atomicAdd(&bar[XB_TMO], 1u); break; } }
    }
    nloc = mine > 0u ? mine : 1u; nx = cnt > 0u ? cnt : 1u;
}
__device__ __forceinline__ void xcd_barrier(const XcdBarrier& b) {
    asm volatile("s_waitcnt vmcnt(0)" ::: "memory");
    __syncthreads();
    if (threadIdx.x == 0) {
        unsigned* bar = b.bar;
        __builtin_amdgcn_s_waitcnt(0);
        unsigned nloc = b.st[0], nx = b.st[1];
        if (nloc == 0u) { xcd_barrier_complete(bar, b.x, nloc, nx); b.st[0] = nloc; b.st[1] = nx; }
        const unsigned old = xb_add(&bar[XB_XSUB(b.x)], 1u);
        const unsigned gen = old / nloc;
        if (old + 1u == (gen + 1u) * nloc) {
            __builtin_amdgcn_fence(__ATOMIC_RELEASE, "agent");
            asm volatile("s_waitcnt vmcnt(0)" ::: "memory");
            const unsigned og = xb_add(&bar[XB_TOP], 1u);
            const unsigned tg = og / nx;
            if (og + 1u == (tg + 1u) * nx) xb_add(&bar[XB_TOPGEN], 1u);
            else XB_SPIN(xb_ld(&bar[XB_TOPGEN]) == tg, bar);
            __builtin_amdgcn_fence(__ATOMIC_ACQUIRE, "agent");
            xb_add(&bar[XB_XGEN(b.x)], 1u);
            asm volatile("s_waitcnt vmcnt(0)" ::: "memory");
        } else {
            XB_SPIN(xb_ld(&bar[XB_XGEN(b.x)]) == gen, bar);
            __builtin_amdgcn_fence(__ATOMIC_ACQUIRE, "agent");
            asm volatile("s_waitcnt vmcnt(0)" ::: "memory");
        }
    }
    __syncthreads();
}
#endif

struct Args { const float* in[14]; float* out; unsigned char* ws; int ph_lo, ph_hi; };

DEV float clamp8(float x) { return fminf(fmaxf(x, -448.0f), 448.0f); }
struct P0Desc { const float* W; void* WT; int ldw, K, k0, c0, r0, nv, fp8; };
DEV void p0_load(const P0Desc& d, int lane, f32x4 (&v)[16]) {
    const int kr = lane >> 4, n4 = 4 * (lane & 15);
#pragma unroll
    for (int i = 0; i < 16; ++i) v[i] = (n4 < d.nv) ? *(const f32x4*)(d.W + (size_t)(d.k0 + 4 * i + kr) * d.ldw + d.c0 + n4) : (f32x4){0.f, 0.f, 0.f, 0.f};
}
DEV void p0_store(const P0Desc& d, const f32x4 (&v)[16], ldsp scr, int lane) {
    const int kr = lane >> 4, n4 = 4 * (lane & 15);
#pragma unroll
    for (int i = 0; i < 16; ++i) LDS_WR(f32x4, scr + ((4 * i + kr) * 68 + n4) * 4, v[i]);
    WAVE_SYNC();
    if (!d.fp8) {
        bf16* WT = (bf16*)d.WT;
        const int c = lane & 7;
#pragma unroll
        for (int j = 0; j < 8; ++j) { const int n = (lane >> 3) + 8 * j; ldsp sp = scr + ((8 * c) * 68 + n) * 4;
            u32x4 o; o.x = pk2(LDS_RD(float, sp + 0 * 272), LDS_RD(float, sp + 1 * 272)); o.y = pk2(LDS_RD(float, sp + 2 * 272), LDS_RD(float, sp + 3 * 272));
            o.z = pk2(LDS_RD(float, sp + 4 * 272), LDS_RD(float, sp + 5 * 272)); o.w = pk2(LDS_RD(float, sp + 6 * 272), LDS_RD(float, sp + 7 * 272));
            if (n < d.nv) *(u32x4*)(WT + (size_t)(d.r0 + n) * d.K + d.k0 + 8 * c) = o; }
    } else {
        unsigned char* WT = (unsigned char*)d.WT;
        const int c = lane & 3;
#pragma unroll
        for (int j = 0; j < 4; ++j) { const int n = (lane >> 2) + 16 * j; ldsp sp = scr + ((16 * c) * 68 + n) * 4; float f[16];
#pragma unroll
            for (int i = 0; i < 16; ++i) f[i] = clamp8(LDS_RD(float, sp + i * 272) * W8_SCALE);
            u32x4 o; o.x = pk_fp8x4(f[0], f[1], f[2], f[3]); o.y = pk_fp8x4(f[4], f[5], f[6], f[7]); o.z = pk_fp8x4(f[8], f[9], f[10], f[11]); o.w = pk_fp8x4(f[12], f[13], f[14], f[15]);
            if (n < d.nv) *(u32x4*)(WT + (size_t)(d.r0 + n) * d.K + d.k0 + 16 * c) = o; }
    }
    WAVE_SYNC();
}

constexpr int MS = 272, MS64 = 144;
constexpr int NUA = NB * HA * NCH, NUB = NB * HB * NCH;
constexpr size_t TW_QA = 0, TW_KA = TW_QA + (size_t)NUA * 16384, TW_PA = TW_KA + (size_t)NUA * 16384, TW_VA = TW_PA + (size_t)NUA * 8192, TW_ENDA = TW_VA + (size_t)NUA * 2048;
constexpr size_t TW_QB = 0, TW_KB = TW_QB + (size_t)NUB * 16384, TW_PB = TW_KB + (size_t)NUB * 16384, TW_SB = TW_PB + (size_t)NUB * 8192, TW_ENDB = TW_SB + (size_t)NUB * 2048;
static_assert(TW_ENDA <= (size_t)(NP + 16) * D * 2 && TW_ENDB <= (size_t)M * D * 2, "operand tiles must fit the dead W1T / h regions");
DEV int swz(int row, int chunk) { return row * 256 + ((chunk ^ (row & 15)) << 4); }
DEV int swz64(int row, int chunk) { return row * 128 + ((chunk ^ (row & 7)) << 4); }
DEV bf16x8 frag16p(ldsp img, int row0, int ks, int lane) { return LDS_RD(bf16x8, img + swz64(row0 + (lane & 15), 4 * ks + (lane >> 4))); }

DEV bf16x8 frag16(ldsp buf, int stride, int row0, int ks, int lane) { return LDS_RD(bf16x8, buf + (row0 + (lane & 15)) * stride + ks * 64 + (lane >> 4) * 16); }
DEV bf16x8 frag16s(ldsp img, int row0, int ks, int lane) { return LDS_RD(bf16x8, img + swz(row0 + (lane & 15), 4 * ks + (lane >> 4))); }
DEV bf16x8 frag8x2s(ldsp img, int row0, int ks, int lane) {
    const int row = row0 + (lane & 15), q = lane >> 4;
    const bf16x4 lo = LDS_RD(bf16x4, img + swz(row, 4 * ks + (q >> 1)) + (q & 1) * 8), hi = LDS_RD(bf16x4, img + swz(row, 4 * ks + 2 + (q >> 1)) + (q & 1) * 8);
    return (bf16x8){lo[0], lo[1], lo[2], lo[3], hi[0], hi[1], hi[2], hi[3]};
}
DEV bf16x8 frag_tr(ldsp img, int n0, int ks, int lane, int stride = 256) {
    ldsp p = img + (32 * ks + 8 * (lane >> 4) + ((lane & 15) >> 2)) * stride + (n0 + 4 * (lane & 3)) * 2;
    const bf16x4 lo = lds_tr16(p), hi = lds_tr16(p + 4 * stride);
    return (bf16x8){lo[0], lo[1], lo[2], lo[3], hi[0], hi[1], hi[2], hi[3]};
}
DEV bf16x8 frag_trs(ldsp img, int n0, int ks, int lane) {
    const int row = 32 * ks + 8 * (lane >> 4) + ((lane & 15) >> 2), p = lane & 3, ch = (n0 >> 3) + (p >> 1);
    const bf16x4 lo = lds_tr16(img + swz(row, ch) + (p & 1) * 8), hi = lds_tr16(img + swz(row + 4, ch) + (p & 1) * 8);
    return (bf16x8){lo[0], lo[1], lo[2], lo[3], hi[0], hi[1], hi[2], hi[3]};
}
DEV void dma_lin(const void* src, int ninst, ldsp dst, int wave, int lane) {
    for (int i = wave; i < ninst; i += NWAVES) GLDS16X((const char*)src + i * 1024 + 16 * lane, dst + i * 1024);
}
DEV float sigm2(float x) { return frcp(1.0f + fexp2(-LOG2E * x)); }
DEV u32x2 pack4(const f32x4 v) { u32x2 w; w.x = cvt_pk_bf16(v[0], v[1]); w.y = cvt_pk_bf16(v[2], v[3]); return w; }

DEV float scan_add(float v, int lane) {
#pragma unroll
    for (int o = 1; o < 64; o <<= 1) { const float t = __shfl_up(v, o); if (lane >= o) v += t; }
    return v;
}
DEV float scan_max(float v, int lane) {
#pragma unroll
    for (int o = 1; o < 64; o <<= 1) { const float t = __shfl_up(v, o); if (lane >= o) v = fmaxf(v, t); }
    return v;
}

constexpr int PA_RAW = 0, PA_RAWSZ = 2 * 68 * 256, PA_TOT = 2 * PA_RAWSZ, PA_IQ = PA_TOT + 8 * 128 * 4, PA_IK = PA_IQ + 16384, PA_SC = PA_IK + 16384, PA_END = PA_SC + 1024;
static_assert(PA_END <= RING_BYTES, "P2 LDS");
DEV void p2_issue(const Args& args, int u, ldsp raw, int wave, int lane) {
    const bf16* P = (const bf16*)(args.ws + WS_P);
    if (u < NUA) { const int bh = u / NCH, j = u % NCH, b = bh / HA, h = bh % HA; const size_t tok0 = (size_t)b * SEQ + 64 * j;
        dma_lin(P + p_off(tok0, C_QA + h * 128), 16, raw, wave, lane); dma_lin(P + p_off(tok0, C_FA + h * 128), 16, raw + 68 * 256, wave, lane); }
    else { const int ub = u - NUA, bh = ub / NCH, j = ub % NCH, b = bh / HB, h = bh % HB; const size_t tok0 = (size_t)b * SEQ + 64 * j;
        dma_lin(P + p_off(tok0, C_QB + h * 128) - 3 * 128, 17, raw, wave, lane); dma_lin(P + p_off(tok0, C_KB + h * 128) - 3 * 128, 17, raw + 68 * 256, wave, lane); }
}
DEV void p2_scores(ldsp lds, f32x4 (&sc)[2], int wave, int lane) {
    const int ct = wave >> 1, st0 = 2 * (wave & 1);
    sc[0] = (f32x4){0.f, 0.f, 0.f, 0.f}; sc[1] = (f32x4){0.f, 0.f, 0.f, 0.f};
#pragma unroll
    for (int ks = 0; ks < 4; ++ks) { const bf16x8 qf = frag16s(lds + PA_IQ, 16 * ct, ks, lane);
#pragma unroll
        for (int n = 0; n < 2; ++n) { const bf16x8 kf_ = frag16s(lds + PA_IK, 16 * (st0 + n), ks, lane); sc[n] = MFMA16(kf_, qf, sc[n]); } }
}
DEV void p2_unit(const Args& args, ldsp lds, int u, ldsp raw, int wave, int lane) {
    unsigned char* TW = args.ws + WS_W1T;
    const int q4 = lane >> 4, l15 = lane & 15;
    if (u < NUA) {
        const int bh = u / NCH, h = bh % HA;
        const float* lbl = args.in[3];
        float lbv[2];
#pragma unroll
        for (int e = 0; e < 2; ++e) { const int col = h * 128 + 2 * lane + e; lbv[e] = frcp(1.0f + fexp(lbl[DA + col] - lbl[col])); }
        float lf[8][2], qv[8][2], kv[8][2];
#pragma unroll
        for (int c = 0; c < 8; ++c) { const unsigned qw = LDS_RD(unsigned, raw + (8 * wave + c) * 256 + lane * 4), fw = LDS_RD(unsigned, raw + 68 * 256 + (8 * wave + c) * 256 + lane * 4);
#pragma unroll
            for (int e = 0; e < 2; ++e) { const float f = lbv[e] + (1.0f - lbv[e]) * sigm2(__builtin_bit_cast(float, e ? (fw & 0xffff0000u) : (fw << 16))); lf[c][e] = flog2(f); kv[c][e] = 1.0f - f; qv[c][e] = __builtin_bit_cast(float, e ? (qw & 0xffff0000u) : (qw << 16)); } }
#pragma unroll
        for (int c = 1; c < 8; ++c) { lf[c][0] += lf[c - 1][0]; lf[c][1] += lf[c - 1][1]; }
        LDS_WR(f32x2, lds + PA_TOT + (wave * 128 + 2 * lane) * 4, ((f32x2){lf[7][0], lf[7][1]}));
        MIX_BAR();
        f32x2 off = (f32x2){0.f, 0.f}, bmid = (f32x2){0.f, 0.f}, g = (f32x2){0.f, 0.f};
#pragma unroll
        for (int w = 0; w < 8; ++w) { const f32x2 t = LDS_RD(f32x2, lds + PA_TOT + (w * 128 + 2 * lane) * 4); if (w < wave) off += t; if (w < 4) bmid += t; g += t; }
        if (wave == 0) { float* vec = (float*)(TW + TW_VA + (size_t)u * 2048) + 2 * lane;
            *(f32x2*)vec = (f32x2){fexp2(bmid[0]), fexp2(bmid[1])}; *(f32x2*)(vec + 128) = (f32x2){fexp2(g[0]), fexp2(g[1])}; *(f32x2*)(vec + 256) = (f32x2){fexp2(g[0] - bmid[0]), fexp2(g[1] - bmid[1])}; }
        unsigned qr8[8], kr8[8];
#pragma unroll
        for (int c = 0; c < 8; ++c) { float qr[2], kk[2]; const int r = 8 * wave + c;
#pragma unroll
            for (int e = 0; e < 2; ++e) { const float t1 = lf[c][e] + off[e] - bmid[e]; qr[e] = qv[c][e] * fexp2(t1); kk[e] = kv[c][e] * fexp2(-t1); }
            qr8[c] = cvt_pk_bf16(qr[0], qr[1]); kr8[c] = cvt_pk_bf16(kk[0], kk[1]);
            LDS_WR(unsigned, lds + PA_IQ + swz(r, lane >> 2) + (lane & 3) * 4, qr8[c]); LDS_WR(unsigned, lds + PA_IK + swz(r, lane >> 2) + (lane & 3) * 4, kr8[c]); }
        MIX_BAR();
        f32x4 sc[2]; p2_scores(lds, sc, wave, lane);
        unsigned char* tq = TW + TW_QA + (size_t)u * 16384; unsigned char* tk = TW + TW_KA + (size_t)u * 16384; unsigned char* tp = TW + TW_PA + (size_t)u * 8192;
#pragma unroll
        for (int c = 0; c < 8; ++c) { const int r = 8 * wave + c; *(unsigned*)(tq + swz(r, lane >> 2) + (lane & 3) * 4) = qr8[c]; *(unsigned*)(tk + swz(r, lane >> 2) + (lane & 3) * 4) = kr8[c]; }
#pragma unroll
        for (int n = 0; n < 2; ++n) { const int c = 16 * (wave >> 1) + l15, s0_ = 16 * (2 * (wave & 1) + n) + 4 * q4; f32x4 v = sc[n];
#pragma unroll
            for (int r = 0; r < 4; ++r) v[r] = (s0_ + r <= c) ? v[r] : 0.f;
            *(u32x2*)(tp + swz64(c, s0_ >> 3) + (q4 & 1) * 8) = pack4(v); }
    } else {
        const int ub = u - NUA, bh = ub / NCH, j = ub % NCH, b = bh / HB, h = bh % HB;
        const float* cw = args.in[4]; const float* cb = args.in[5];
        f32x2 wq[4], wk[4];
#pragma unroll
        for (int k = 0; k < 4; ++k) { wq[k] = *(const f32x2*)(cw + k * (2 * DQK) + h * 128 + 2 * lane); wk[k] = *(const f32x2*)(cw + k * (2 * DQK) + DQK + h * 128 + 2 * lane); }
        const f32x2 bq = *(const f32x2*)(cb + h * 128 + 2 * lane), bk = *(const f32x2*)(cb + DQK + h * 128 + 2 * lane);
        unsigned uq[11], uk[11];
#pragma unroll
        for (int i = 0; i < 11; ++i) { const bool neg = (64 * j + 8 * wave + i - 3) < 0;
            const unsigned a = LDS_RD(unsigned, raw + (8 * wave + i) * 256 + lane * 4), bb = LDS_RD(unsigned, raw + 68 * 256 + (8 * wave + i) * 256 + lane * 4); uq[i] = neg ? 0u : a; uk[i] = neg ? 0u : bb; }
        unsigned char* TWB = args.ws + WS_HB;
        float* sb = (float*)(TWB + TW_SB + (size_t)ub * 2048);
        if (wave == 0) {
            const size_t tok = (size_t)b * SEQ + 64 * j + lane; const float* SG = (const float*)(args.ws + WS_SG);
            const float fp = SG[tok * 16 + HB + h] + args.in[7][h], ig = SG[tok * 16 + h] + args.in[6][h];
            const float bc = scan_add(logsig(fp), lane), a = ig - bc, pm = scan_max(a, lane);
            sb[lane] = pm; sb[64 + lane] = bc;
            LDS_WR(float, lds + PA_SC + lane * 4, a * LOG2E); LDS_WR(float, lds + PA_SC + 256 + lane * 4, pm * LOG2E);
        }
        unsigned q8[8]; float kf[8][2];
#pragma unroll
        for (int c = 0; c < 8; ++c) { float qq[2]; const int r = 8 * wave + c;
#pragma unroll
            for (int e = 0; e < 2; ++e) { float yq = bq[e], yk = bk[e];
#pragma unroll
                for (int k = 0; k < 4; ++k) { yq += wq[k][e] * __builtin_bit_cast(float, e ? (uq[c + k] & 0xffff0000u) : (uq[c + k] << 16)); yk += wk[k][e] * __builtin_bit_cast(float, e ? (uk[c + k] & 0xffff0000u) : (uk[c + k] << 16)); }
                qq[e] = yq * sigm2(yq); kf[c][e] = yk * sigm2(yk) * 0.08838834764831845f; }
            q8[c] = cvt_pk_bf16(qq[0], qq[1]);
            LDS_WR(unsigned, lds + PA_IQ + swz(r, lane >> 2) + (lane & 3) * 4, q8[c]); LDS_WR(unsigned, lds + PA_IK + swz(r, lane >> 2) + (lane & 3) * 4, cvt_pk_bf16(kf[c][0], kf[c][1])); }
        MIX_BAR();
        const float pm63 = LDS_RD(float, lds + PA_SC + 256 + 63 * 4);
        unsigned kw8[8]; float na[2] = {0.f, 0.f};
#pragma unroll
        for (int c = 0; c < 8; ++c) { const float w_ = fexp2(LDS_RD(float, lds + PA_SC + (8 * wave + c) * 4) - pm63); const float k0 = w_ * kf[c][0], k1 = w_ * kf[c][1]; na[0] += k0; na[1] += k1; kw8[c] = cvt_pk_bf16(k0, k1); }
        LDS_WR(f32x2, lds + PA_TOT + (wave * 128 + 2 * lane) * 4, ((f32x2){na[0], na[1]}));
        f32x4 sc[2]; p2_scores(lds, sc, wave, lane);
        const int ct = wave >> 1, st0 = 2 * (wave & 1), c_ = 16 * ct + l15;
        const float pmc = LDS_RD(float, lds + PA_SC + 256 + c_ * 4); float rs = 0.f; u32x2 pw[2];
#pragma unroll
        for (int n = 0; n < 2; ++n) { const int s0_ = 16 * (st0 + n) + 4 * q4; const f32x4 as = LDS_RD(f32x4, lds + PA_SC + s0_ * 4); f32x4 v;
#pragma unroll
            for (int r = 0; r < 4; ++r) { const float t = fexp2(as[r] - pmc) * sc[n][r]; v[r] = (s0_ + r <= c_) ? t : 0.f; rs += v[r]; }
            pw[n] = pack4(v); }
        rs += __shfl_xor(rs, 16); rs += __shfl_xor(rs, 32);
        MIX_BAR();
        if (wave < 2) { const int dcol = wave * 64 + lane; float nl = 0.f;
#pragma unroll
            for (int w = 0; w < 8; ++w) nl += LDS_RD(float, lds + PA_TOT + (w * 128 + dcol) * 4);
            sb[256 + dcol] = nl; }
        if (q4 == 0) sb[128 + c_ * 2 + (wave & 1)] = rs;
        unsigned char* tq = TWB + TW_QB + (size_t)ub * 16384; unsigned char* tk = TWB + TW_KB + (size_t)ub * 16384; unsigned char* tp = TWB + TW_PB + (size_t)ub * 8192;
#pragma unroll
        for (int c = 0; c < 8; ++c) { const int r = 8 * wave + c; *(unsigned*)(tq + swz(r, lane >> 2) + (lane & 3) * 4) = q8[c]; *(unsigned*)(tk + swz(r, lane >> 2) + (lane & 3) * 4) = kw8[c]; }
#pragma unroll
        for (int n = 0; n < 2; ++n) { const int s0_ = 16 * (st0 + n) + 4 * q4; *(u32x2*)(tp + swz64(c_, s0_ >> 3) + (q4 & 1) * 8) = pw[n]; }
    }
}

constexpr int PB_BUFSZ = 51200, PB_Q = 0, PB_K = 16384, PB_V = 32768, PB_P = 40960, PB_VEC = 49152;
constexpr int PB_XS = 2 * PB_BUFSZ, PB_SM = PB_XS + 2 * 16384;
constexpr int SM_SSQ = PB_SM;
constexpr int SM_R = SM_SSQ + 2 * 64 * 4 * 4, SM_INT = SM_R + 256, SM_EMT = SM_INT + 256, SM_RS = SM_EMT + 256, SM_SCAL = SM_RS + 256;
constexpr int SM_NV = SM_SCAL + 64, SM_QN = SM_NV + 512, MX_END = SM_QN + 256;
static_assert(MX_END <= RING_BYTES, "mixer LDS");
DEV void dma_rows64(const void* src, ldsp dst, int wave, int lane) { GLDS16S((const char*)src + wave * 2048, (lane >> 3) * 256 + (lane & 7) * 16, dst + wave * 1024); }

DEV void mixer_a_job(const Args& args, ldsp lds, int b, int h, int vh, int tid_) {
    const int wave = RFL(tid_ >> 6), vt = wave & 3, hf = wave >> 2;
    const bf16* P = (const bf16*)(args.ws + WS_P);
    const unsigned char* TW = args.ws + WS_W1T;
    const rsrc_t RO = make_rsrc(args.ws + WS_OAB, (unsigned)((size_t)2 * M * LDU * 2));
    float* SSA = (float*)(args.ws + WS_SSA);
    const int u0 = (b * HA + h) * NCH, vcol = h * 128 + 64 * vh;
    f32x4 st[4], o[2];
#pragma unroll
    for (int t = 0; t < 4; ++t) st[t] = (f32x4){0.f, 0.f, 0.f, 0.f};
    o[0] = (f32x4){0.f, 0.f, 0.f, 0.f}; o[1] = (f32x4){0.f, 0.f, 0.f, 0.f};
    { const u32x4 z = (u32x4){0u, 0u, 0u, 0u}; const int lane = tid_ & 63;
        LDS_WR(u32x4, lds + PB_XS + 16384 + (vt * 2 + hf) * 2048 + lane * 16, z); LDS_WR(u32x4, lds + PB_XS + 16384 + (vt * 2 + hf) * 2048 + 1024 + lane * 16, z); }
#define MA_DMA(jj) do { ldsp bf_ = lds + ((jj) & 1) * PB_BUFSZ; const size_t uu_ = (size_t)(u0 + (jj)); \
        dma_lin(TW + TW_QA + uu_ * 16384, 16, bf_ + PB_Q, wave, lane); dma_lin(TW + TW_KA + uu_ * 16384, 16, bf_ + PB_K, wave, lane); \
        dma_rows64(P + p_off((size_t)b * SEQ + 64 * (jj), C_IA + h * 128) + 64 * vh, bf_ + PB_V, wave, lane); dma_lin(TW + TW_PA + uu_ * 8192, 8, bf_ + PB_P, wave, lane); dma_lin(TW + TW_VA + uu_ * 2048, 2, bf_ + PB_VEC, wave, lane); } while (0)
    { const int lane = tid_ & 63; MA_DMA(0); }
    for (int j = 0; j <= NCH; ++j) {
        int tidj = tid_; OPAQUE(tidj);
        const int lane = tidj & 63, q4 = lane >> 4, l15 = lane & 15;
        const size_t tk0 = (size_t)b * SEQ + 64 * j;
        if (j <= 1) WAIT_V(0); else WAIT_V(2);
        MIX_BAR();
        if (j + 1 < NCH) MA_DMA(j + 1);
        if (j > 0) {
            if (wave == 0) { const f32x4 s0 = LDS_RD(f32x4, lds + SM_SSQ + ((j - 1) & 1) * 1024 + lane * 16); SSA[((tk0 - 64 + lane) * HA + h) * 2 + vh] = (s0[0] + s0[1]) + (s0[2] + s0[3]); }
#pragma unroll
            for (int i = 0; i < 2; ++i) bstore64(RO, (unsigned)(l15 * LDU + vcol + 16 * vt + 4 * q4) * 2u, (unsigned)(tk0 - 64 + 16 * (2 * hf + i)) * (unsigned)(LDU * 2), pack4(o[i]));
        }
        if (j == NCH) break;
        ldsp bf = lds + (j & 1) * PB_BUFSZ;
        bf16x8 bv[2], pf[2][2], qo[2][2], qp[2][2], so[2], sp[2];
#pragma unroll
        for (int ks = 0; ks < 2; ++ks) bv[ks] = frag_tr(bf + PB_V, 16 * vt, ks, lane, 128);
#pragma unroll
        for (int ks = 0; ks < 2; ++ks)
#pragma unroll
            for (int i = 0; i < 2; ++i) pf[ks][i] = frag16p(bf + PB_P, 16 * (2 * hf + i), ks, lane);
#pragma unroll
        for (int kl = 0; kl < 2; ++kl)
#pragma unroll
            for (int i = 0; i < 2; ++i) { qo[kl][i] = frag8x2s(bf + PB_Q, 16 * (2 * hf + i), 2 * hf + kl, lane); qp[kl][i] = frag8x2s(bf + PB_Q, 16 * (2 * hf + i), 2 * (hf ^ 1) + kl, lane); }
        u32x4 xp[2];
#pragma unroll
        for (int kl = 0; kl < 2; ++kl) xp[kl] = LDS_RD(u32x4, lds + PB_XS + ((j + 1) & 1) * 16384 + (vt * 2 + (hf ^ 1)) * 2048 + kl * 1024 + lane * 16);
        f32x4 eo[4], ep[4];
#pragma unroll
        for (int t = 0; t < 4; ++t) { eo[t] = LDS_RD(f32x4, bf + PB_VEC + (16 * (4 * hf + t) + 4 * q4) * 4); ep[t] = LDS_RD(f32x4, bf + PB_VEC + (16 * (4 * (hf ^ 1) + t) + 4 * q4) * 4); }
        SCHED_BAR();
#pragma unroll
        for (int kl = 0; kl < 2; ++kl) {
            { u32x4 w; const f32x4 a0 = st[2 * kl] * eo[2 * kl], a1 = st[2 * kl + 1] * eo[2 * kl + 1]; w.x = cvt_pk_bf16(a0[0], a0[1]); w.y = cvt_pk_bf16(a0[2], a0[3]); w.z = cvt_pk_bf16(a1[0], a1[1]); w.w = cvt_pk_bf16(a1[2], a1[3]);
              so[kl] = __builtin_bit_cast(bf16x8, w); }
            { u32x4 w; const f32x4 e0 = ep[2 * kl], e1 = ep[2 * kl + 1]; const u32x4 x = xp[kl];
              w.x = cvt_pk_bf16(__builtin_bit_cast(float, x.x << 16) * e0[0], __builtin_bit_cast(float, x.x & 0xffff0000u) * e0[1]); w.y = cvt_pk_bf16(__builtin_bit_cast(float, x.y << 16) * e0[2], __builtin_bit_cast(float, x.y & 0xffff0000u) * e0[3]);
              w.z = cvt_pk_bf16(__builtin_bit_cast(float, x.z << 16) * e1[0], __builtin_bit_cast(float, x.z & 0xffff0000u) * e1[1]); w.w = cvt_pk_bf16(__builtin_bit_cast(float, x.w << 16) * e1[2], __builtin_bit_cast(float, x.w & 0xffff0000u) * e1[3]);
              sp[kl] = __builtin_bit_cast(bf16x8, w); } }
        o[0] = (f32x4){0.f, 0.f, 0.f, 0.f}; o[1] = (f32x4){0.f, 0.f, 0.f, 0.f};
#pragma unroll
        for (int ks = 0; ks < 2; ++ks)
#pragma unroll
            for (int i = 0; i < 2; ++i) o[i] = MFMA16(bv[ks], pf[ks][i], o[i]);
#pragma unroll
        for (int kl = 0; kl < 2; ++kl)
#pragma unroll
            for (int i = 0; i < 2; ++i) { o[i] = MFMA16(so[kl], qo[kl][i], o[i]); o[i] = MFMA16(sp[kl], qp[kl][i], o[i]); }
#pragma unroll
        for (int i = 0; i < 4; ++i) { const int t = 4 * hf + i;
            f32x4 u = (f32x4){0.f, 0.f, 0.f, 0.f};
#pragma unroll
            for (int ks = 0; ks < 2; ++ks) { const bf16x8 a = frag_trs(bf + PB_K, 16 * t, ks, lane); u = MFMA16(a, bv[ks], u); }
            const f32x4 eg = LDS_RD(f32x4, bf + PB_VEC + 512 + (16 * t + 4 * q4) * 4), egm = LDS_RD(f32x4, bf + PB_VEC + 1024 + (16 * t + 4 * q4) * 4); st[i] = eg * st[i] + egm * u; }
#pragma unroll
        for (int kl = 0; kl < 2; ++kl) { u32x4 w; const f32x4 a0 = st[2 * kl], a1 = st[2 * kl + 1]; w.x = cvt_pk_bf16(a0[0], a0[1]); w.y = cvt_pk_bf16(a0[2], a0[3]); w.z = cvt_pk_bf16(a1[0], a1[1]); w.w = cvt_pk_bf16(a1[2], a1[3]);
            LDS_WR(u32x4, lds + PB_XS + (j & 1) * 16384 + (vt * 2 + hf) * 2048 + kl * 1024 + lane * 16, w); }
#pragma unroll
        for (int i = 0; i < 2; ++i) { float s_ = (o[i][0] * o[i][0] + o[i][1] * o[i][1]) + (o[i][2] * o[i][2] + o[i][3] * o[i][3]); s_ += __shfl_xor(s_, 16); s_ += __shfl_xor(s_, 32);
            LDS_WR(float, lds + SM_SSQ + (j & 1) * 1024 + ((16 * (2 * hf + i) + l15) * 4 + vt) * 4, s_); }
    }
#undef MA_DMA
}

DEV void mixer_b_job(const Args& args, ldsp lds, int b, int h, int vq, int tid_) {
    const int wave = RFL(tid_ >> 6), vt = wave & 3, hf = wave >> 2;
    const int vbase = h * 256 + 64 * vq;
    const bf16* P = (const bf16*)(args.ws + WS_P);
    const unsigned char* TW = args.ws + WS_HB;
    const rsrc_t RO = make_rsrc(args.ws + WS_OAB, (unsigned)((size_t)2 * M * LDU * 2));
    float* SSB = (float*)(args.ws + WS_SSB);
    const int u0 = (b * HB + h) * NCH;
    f32x4 st[4], hv[2];
#pragma unroll
    for (int t = 0; t < 4; ++t) st[t] = (f32x4){0.f, 0.f, 0.f, 0.f};
    hv[0] = (f32x4){0.f, 0.f, 0.f, 0.f}; hv[1] = (f32x4){0.f, 0.f, 0.f, 0.f};
    float mcar = 0.f;
    if (wave < 2) LDS_WR(float, lds + SM_NV + tid_ * 4, 0.f);
    { const u32x4 z = (u32x4){0u, 0u, 0u, 0u}; const int lane = tid_ & 63;
        LDS_WR(u32x4, lds + PB_XS + 16384 + (vt * 2 + hf) * 2048 + lane * 16, z); LDS_WR(u32x4, lds + PB_XS + 16384 + (vt * 2 + hf) * 2048 + 1024 + lane * 16, z); }
#define MB_DMA(jj) do { ldsp bf_ = lds + ((jj) & 1) * PB_BUFSZ; const size_t uu_ = (size_t)(u0 + (jj)); \
        dma_lin(TW + TW_QB + uu_ * 16384, 16, bf_ + PB_Q, wave, lane); dma_lin(TW + TW_KB + uu_ * 16384, 16, bf_ + PB_K, wave, lane); \
        dma_rows64(P + p_off((size_t)b * SEQ + 64 * (jj), C_VB + h * 256 + 128 * (vq >> 1)) + 64 * (vq & 1), bf_ + PB_V, wave, lane); dma_lin(TW + TW_PB + uu_ * 8192, 8, bf_ + PB_P, wave, lane); dma_lin(TW + TW_SB + uu_ * 2048, 2, bf_ + PB_VEC, wave, lane); } while (0)
    { const int lane = tid_ & 63; MB_DMA(0); }
    for (int j = 0; j <= NCH; ++j) {
        const size_t tk0 = (size_t)b * SEQ + 64 * j;
        int tidj = tid_; OPAQUE(tidj);
        const int tid = tidj, lane = tidj & 63, q4 = lane >> 4, l15 = lane & 15;
        if (j <= 1) WAIT_V(0); else WAIT_V(2);
        MIX_BAR();
        if (j + 1 < NCH) MB_DMA(j + 1);
        if (j > 0) {
            if (wave == 0) { const f32x4 s0 = LDS_RD(f32x4, lds + SM_SSQ + ((j - 1) & 1) * 1024 + lane * 16); SSB[((tk0 - 64 + lane) * HB + h) * 4 + vq] = (s0[0] + s0[1]) + (s0[2] + s0[3]); }
#pragma unroll
            for (int i = 0; i < 2; ++i) bstore64(RO, (unsigned)(l15 * LDU + vbase + 16 * vt + 4 * q4) * 2u, (unsigned)(M + tk0 - 64 + 16 * (2 * hf + i)) * (unsigned)(LDU * 2), pack4(hv[i]));
        }
        if (j == NCH) break;
        ldsp bf = lds + (j & 1) * PB_BUFSZ;
        if (wave == 0) {
            const float pm = LDS_RD(float, bf + PB_VEC + lane * 4), bc = LDS_RD(float, bf + PB_VEC + 256 + lane * 4); const f32x2 rsl = LDS_RD(f32x2, bf + PB_VEC + 512 + lane * 8);
            const float mx = fmaxf(mcar, pm), r = fexp(pm - mx);
            const float pm63 = __shfl(pm, 63), bc63 = __shfl(bc, 63), m63 = fmaxf(mcar, pm63);
            LDS_WR(float, lds + SM_R + lane * 4, r); LDS_WR(float, lds + SM_INT + lane * 4, fexp(mcar - mx)); LDS_WR(float, lds + SM_EMT + lane * 4, fexp(-(bc + mx))); LDS_WR(float, lds + SM_RS + lane * 4, r * (rsl[0] + rsl[1]));
            if (lane == 0) { LDS_WR(float, lds + SM_SCAL, fexp(mcar - m63)); LDS_WR(float, lds + SM_SCAL + 4, bc63 + m63); LDS_WR(float, lds + SM_SCAL + 8, fexp(pm63 - m63)); }
        }
        {
            const int c = tid >> 3, part = tid & 7; float s = 0.f;
#pragma unroll
            for (int hh = 0; hh < 2; ++hh) { const u32x4 qw = LDS_RD(u32x4, bf + PB_Q + swz(c, 2 * part + hh));
#pragma unroll
                for (int e = 0; e < 4; ++e) { const f32x2 nv = LDS_RD(f32x2, lds + SM_NV + (16 * part + 8 * hh + 2 * e) * 4); s += __builtin_bit_cast(float, qw[e] << 16) * nv[0] + __builtin_bit_cast(float, qw[e] & 0xffff0000u) * nv[1]; } }
            s += __shfl_xor(s, 1); s += __shfl_xor(s, 2); s += __shfl_xor(s, 4);
            LDS_WR(float, lds + SM_QN + c * 4, s);
        }
        MIX_BAR();
        const float decay = LDS_RD(float, lds + SM_SCAL), sj = LDS_RD(float, lds + SM_SCAL + 8);
        mcar = LDS_RD(float, lds + SM_SCAL + 4);
        {
            bf16x8 bv[2], pf[2][2], qo[2][2], qp[2][2], so[2], sp[2];
#pragma unroll
            for (int ks = 0; ks < 2; ++ks) bv[ks] = frag_tr(bf + PB_V, 16 * vt, ks, lane, 128);
#pragma unroll
            for (int ks = 0; ks < 2; ++ks)
#pragma unroll
                for (int i = 0; i < 2; ++i) pf[ks][i] = frag16p(bf + PB_P, 16 * (2 * hf + i), ks, lane);
#pragma unroll
            for (int kl = 0; kl < 2; ++kl)
#pragma unroll
                for (int i = 0; i < 2; ++i) { qo[kl][i] = frag8x2s(bf + PB_Q, 16 * (2 * hf + i), 2 * hf + kl, lane); qp[kl][i] = frag8x2s(bf + PB_Q, 16 * (2 * hf + i), 2 * (hf ^ 1) + kl, lane); }
#pragma unroll
            for (int kl = 0; kl < 2; ++kl) sp[kl] = LDS_RD(bf16x8, lds + PB_XS + ((j + 1) & 1) * 16384 + (vt * 2 + (hf ^ 1)) * 2048 + kl * 1024 + lane * 16);
            float s_int[2], s_r[2], s_qn[2], s_rs[2], s_emt[2];
#pragma unroll
            for (int i = 0; i < 2; ++i) { const int c = 16 * (2 * hf + i) + l15; s_int[i] = LDS_RD(float, lds + SM_INT + c * 4); s_r[i] = LDS_RD(float, lds + SM_R + c * 4); s_qn[i] = LDS_RD(float, lds + SM_QN + c * 4); s_rs[i] = LDS_RD(float, lds + SM_RS + c * 4); s_emt[i] = LDS_RD(float, lds + SM_EMT + c * 4); }
            SCHED_BAR();
#pragma unroll
            for (int kl = 0; kl < 2; ++kl) { u32x4 w; const f32x4 a0 = st[2 * kl], a1 = st[2 * kl + 1]; w.x = cvt_pk_bf16(a0[0], a0[1]); w.y = cvt_pk_bf16(a0[2], a0[3]); w.z = cvt_pk_bf16(a1[0], a1[1]); w.w = cvt_pk_bf16(a1[2], a1[3]); so[kl] = __builtin_bit_cast(bf16x8, w); }
#pragma unroll
            for (int i = 0; i < 2; ++i) {
                f32x4 a1 = (f32x4){0.f, 0.f, 0.f, 0.f}, a2 = (f32x4){0.f, 0.f, 0.f, 0.f};
#pragma unroll
                for (int ks = 0; ks < 2; ++ks) a2 = MFMA16(bv[ks], pf[ks][i], a2);
#pragma unroll
                for (int kl = 0; kl < 2; ++kl) { a1 = MFMA16(so[kl], qo[kl][i], a1); a1 = MFMA16(sp[kl], qp[kl][i], a1); }
                const float den = s_int[i] * s_qn[i] + s_rs[i];
                const float rden = frcp(fmaxf(fabsf(den), s_emt[i]));
                hv[i] = (s_int[i] * a1 + s_r[i] * a2) * rden;
            }
#pragma unroll
            for (int i = 0; i < 4; ++i) { const int t = 4 * hf + i;
                f32x4 u = (f32x4){0.f, 0.f, 0.f, 0.f};
#pragma unroll
                for (int ks = 0; ks < 2; ++ks) { const bf16x8 a = frag_trs(bf + PB_K, 16 * t, ks, lane); u = MFMA16(a, bv[ks], u); }
                st[i] = decay * st[i] + sj * u;
            }
#pragma unroll
            for (int kl = 0; kl < 2; ++kl) { u32x4 w; const f32x4 a0 = st[2 * kl], a1 = st[2 * kl + 1]; w.x = cvt_pk_bf16(a0[0], a0[1]); w.y = cvt_pk_bf16(a0[2], a0[3]); w.z = cvt_pk_bf16(a1[0], a1[1]); w.w = cvt_pk_bf16(a1[2], a1[3]);
                LDS_WR(u32x4, lds + PB_XS + (j & 1) * 16384 + (vt * 2 + hf) * 2048 + kl * 1024 + lane * 16, w); }
            if (wave < 2) LDS_WR(float, lds + SM_NV + tid * 4, decay * LDS_RD(float, lds + SM_NV + tid * 4) + sj * LDS_RD(float, bf + PB_VEC + 1024 + tid * 4));
#pragma unroll
            for (int i = 0; i < 2; ++i) { float s_ = (hv[i][0] * hv[i][0] + hv[i][1] * hv[i][1]) + (hv[i][2] * hv[i][2] + hv[i][3] * hv[i][3]); s_ += __shfl_xor(s_, 16); s_ += __shfl_xor(s_, 32);
                LDS_WR(float, lds + SM_SSQ + (j & 1) * 1024 + ((16 * (2 * hf + i) + l15) * 4 + vt) * 4, s_); }
        }
    }
#undef MB_DMA
}

constexpr int P0_RB1 = (NP + NSG + 63) / 64, P0_I1 = (D / 64) * P0_RB1, P0_IU = (DA / 64) * (D / 64), P0_IO = (D / 64) * (D / 64), P0_IG = (D / 64) * ((DA + DB) / 64), P0_NITEMS = P0_I1 + 2 * P0_IU + P0_IO + P0_IG;
DEV P0Desc p0_decode(const Args& args, int it) {
    unsigned char* ws = args.ws; bf16* W1T = (bf16*)(ws + WS_W1T); bf16* WUT = (bf16*)(ws + WS_WUT); bf16* WOT = (bf16*)(ws + WS_WOT);
    P0Desc d; int r = it;
    if (r < P0_I1) { const int kb = r / P0_RB1, rb = r % P0_RB1, r0 = 64 * rb; d.W = args.in[2]; d.ldw = D_IN; d.K = D; d.k0 = 64 * kb;
        if (r0 >= NPM && r0 < NP) { d.WT = ws + WS_W8; d.c0 = r0 + NSG; d.r0 = r0 - NPM; d.nv = 64; d.fp8 = 1; return d; }
        d.WT = W1T; d.fp8 = 0; d.r0 = r0;
        if (r0 < NPM) { d.c0 = r0; d.nv = 64; } else { d.c0 = NPM + (r0 - NP); d.nv = NSG - (r0 - NP) < 64 ? NSG - (r0 - NP) : 64; }
        return d; }
    r -= P0_I1; d.fp8 = 0; d.ldw = D; d.nv = 64;
    if (r < P0_IU) { const int kb = r / (D / 64), rb = r % (D / 64); d.W = args.in[10]; d.K = LDU; d.WT = WUT; d.k0 = 64 * kb; d.c0 = 64 * rb; d.r0 = 64 * rb; return d; }
    r -= P0_IU;
    if (r < P0_IU) { const int kb = r / (D / 64), rb = r % (D / 64); d.W = args.in[11]; d.K = LDU; d.WT = WUT + (size_t)D * LDU; d.k0 = 64 * kb; d.c0 = 64 * rb; d.r0 = 64 * rb; return d; }
    r -= P0_IU;
    if (r < P0_IO) { const int kb = r / (D / 64), rb = r % (D / 64); d.W = args.in[12]; d.K = D; d.WT = WOT; d.k0 = 64 * kb; d.c0 = 64 * rb; d.r0 = 64 * rb; return d; }
    r -= P0_IO;
    { const int kb = r / ((DA + DB) / 64), rb = r % ((DA + DB) / 64), j0 = 64 * rb; d.W = args.in[2]; d.ldw = D_IN; d.K = D; d.k0 = 64 * kb; d.WT = ws + WS_W8OG; d.fp8 = 1; d.r0 = j0; d.c0 = j0 < DA ? C_OGA + j0 : C_OGB + (j0 - DA); return d; }
}
DEV void p0_items(const Args& args, int first, int last, int stride, ldsp scr, int lane) {
    if (first >= last) return;
    P0Desc d = p0_decode(args, first); f32x4 v[16]; p0_load(d, lane, v);
    for (int it = first; it < last; it += stride) {
        const int nx = it + stride; P0Desc dn = d; f32x4 vn[16];
        if (nx < last) { dn = p0_decode(args, nx); p0_load(dn, lane, vn); }
        p0_store(d, v, scr, lane);
        if (nx < last) { d = dn;
#pragma unroll
            for (int i = 0; i < 16; ++i) v[i] = vn[i]; }
    }
}

__global__ void __launch_bounds__(NTHREADS, 2) fwd_kernel(Args args) {
#ifndef EMU
    extern __shared__ __attribute__((aligned(16))) unsigned char lds_raw[];
    ldsp lds = (ldsp)lds_raw;
#else
    ldsp lds = emu_lds;
#endif
    const int tid = threadIdx.x, lane = tid & 63, wave = RFL(tid >> 6);
    const int G = gridDim.x, bx = blockIdx.x;
    const int vcu = (G % 8 == 0) ? (bx % 8) * (G / 8) + bx / 8 : bx;
    unsigned char* ws = args.ws;
#ifndef EMU
    for (int u = tid; u < (LDS_BYTES - LDSCTL_OFF) / 4; u += NTHREADS) ((LAS unsigned*)(lds + LDSCTL_OFF))[u] = 0u;
    __syncthreads();
    XcdBarrier bar = xcd_barrier_post((unsigned*)(ws + WS_CTL) + CW_BAR, (volatile LAS unsigned*)(lds + MISC_OFF) + 8);
#define GRID_BAR() xcd_barrier(bar)
#else
#define GRID_BAR()
#endif
    const int lo = args.ph_lo, hi = args.ph_hi;
#ifndef GEMM_SP2
#define GEMM_SP2 true
#endif
#ifndef GEMM_ALIGN
#define GEMM_ALIGN true
#endif
#ifndef PROBE_REP_P4
#define PROBE_REP_P4 1
#endif
#ifndef PROBE_REP_P5
#define PROBE_REP_P5 1
#endif
#ifndef PROBE_REP_P1
#define PROBE_REP_P1 2
#endif
#ifndef PROBE_REP_P2
#define PROBE_REP_P2 1
#endif
#ifndef PHASE_MASK
#define PHASE_MASK 255
#endif
#define IN(k) (((PHASE_MASK >> (k)) & 1) && lo <= (k) && (k) < hi)
#define BOTH(k) (IN(k) && IN((k) + 1))
    const float* x = args.in[0];
    bf16* W1T = (bf16*)(ws + WS_W1T); bf16* WUT = (bf16*)(ws + WS_WUT); bf16* WOT = (bf16*)(ws + WS_WOT);
    bf16* HBUF = (bf16*)(ws + WS_HB); bf16* PB = (bf16*)(ws + WS_P); float* SG = (float*)(ws + WS_SG); bf16* OAB = (bf16*)(ws + WS_OAB); float* RSS = (float*)(ws + WS_RSS);

    if (IN(0)) {
        ldsp scr = lds + wave * 17408;
        const int gw = vcu * NWAVES + wave, NGW = G * NWAVES;
        constexpr int I_1 = P0_I1, NITEMS = P0_NITEMS;
        static_assert(NPM % 64 == 0 && NP % 64 == 0 && NSG % 4 == 0, "P0 item tiling");
        constexpr int NJOBS3 = NB * HA * 2 + NB * HB * 4;
        const int nit0 = (G > NJOBS3) ? I_1 : NITEMS;
        p0_items(args, gw, nit0, NGW, scr, lane);
        const float* gpre = args.in[1];
        for (int m = gw; m < M; m += NGW) {
            const f32x4* xr = (const f32x4*)(x + (size_t)m * D) + lane;
            f32x4 v[D / 256]; float s = 0.f;
#pragma unroll
            for (int jj = 0; jj < D / 256; ++jj) { v[jj] = xr[64 * jj]; s += (v[jj][0] * v[jj][0] + v[jj][1] * v[jj][1]) + (v[jj][2] * v[jj][2] + v[jj][3] * v[jj][3]); }
            const float rstd = frsq(wave_sum(s) * (1.0f / D) + EPS) ;
            u32x2* o8 = (u32x2*)(HBUF + (size_t)m * D) + lane; unsigned* o4 = (unsigned*)(ws + WS_H8 + (size_t)m * D) + lane;
#pragma unroll
            for (int jj = 0; jj < D / 256; ++jj) { const f32x4 gg = ((const f32x4*)gpre)[lane + 64 * jj]; const f32x4 hh = v[jj] * rstd * gg; u32x2 w; w.x = pk2(hh[0], hh[1]); w.y = pk2(hh[2], hh[3]); o8[64 * jj] = w;
                o4[64 * jj] = pk_fp8x4(clamp8(hh[0] * H8_SCALE), clamp8(hh[1] * H8_SCALE), clamp8(hh[2] * H8_SCALE), clamp8(hh[3] * H8_SCALE)); }
        }
        if (BOTH(0)) GRID_BAR();
    }

    if (IN(1)) {
        {
            const int gw = vcu * NWAVES + wave, NGW = G * NWAVES, l15 = lane & 15, q4 = lane >> 4;
            const int wrow = NP + (l15 < NSG ? l15 : NSG - 1);
            for (int t = gw; t < M / 16; t += NGW) {
                f32x4 acc = (f32x4){0.f, 0.f, 0.f, 0.f};
                const bf16* ap = HBUF + (size_t)(16 * t + l15) * D + 8 * q4; const bf16* bp = W1T + (size_t)wrow * D + 8 * q4;
                for (int k0 = 0; k0 < D / 32; k0 += 16) {
                    bf16x8 af[16], bfr[16];
#pragma unroll
                    for (int i = 0; i < 16; ++i) { af[i] = *(const bf16x8*)(ap + 32 * (k0 + i)); bfr[i] = *(const bf16x8*)(bp + 32 * (k0 + i)); }
#pragma unroll
                    for (int i = 0; i < 16; ++i) acc = MFMA16(af[i], bfr[i], acc);
                }
#pragma unroll
                for (int r = 0; r < 4; ++r) SG[(size_t)(16 * t + 4 * q4 + r) * 16 + l15] = acc[r];
            }
        }
        { pg8::Gemm g{HBUF, W1T, M, NPM, D}; SchedSkipOg S; S.so.init(M, NPM - DA - DB, G, bx);
          EpiP E{PB};
          pg8::gemm_phase<EpiP, SchedSkipOg, GEMM_ALIGN, GEMM_SP2>(lds, g, S, E); }
        { pg8::Gemm g8{(const bf16*)(ws + WS_H8), (const bf16*)(ws + WS_W8OG), M, DA + DB, D}; pg8::StaticOrder S8; S8.init(M, DA + DB, G, bx);
          EpiOg E8{PB};
          pg8::gemm_phase<EpiOg, pg8::StaticOrder, GEMM_ALIGN, GEMM_SP2, 1>(lds, g8, S8, E8); }
        if (BOTH(1)) GRID_BAR();
    }

    if (IN(2)) {
        int buf = 0;
        if (bx < NUA + NUB) p2_issue(args, bx, lds + PA_RAW, wave, lane);
        for (int u = bx, it = 0; u < NUA + NUB; u += G, ++it) {
            int tidj = tid; OPAQUE(tidj); const int lane_ = tidj & 63;
            if (it == 0) WAIT_V(0); else WAIT_V(18);
            MIX_BAR();
            if (u + G < NUA + NUB) p2_issue(args, u + G, lds + PA_RAW + (buf ^ 1) * PA_RAWSZ, wave, lane_);
            p2_unit(args, lds, u, lds + PA_RAW + buf * PA_RAWSZ, wave, lane_);
            buf ^= 1;
        }
        if (BOTH(2)) GRID_BAR();
    }

    if (IN(3)) {
        constexpr int NJA = NB * HA * 2, NJB = NB * HB * 4;
        if (G > NJA + NJB && bx >= NJA + NJB) {
            ldsp scr = lds + wave * 17408;
            p0_items(args, P0_I1 + (bx - (NJA + NJB)) * NWAVES + wave, P0_NITEMS, (G - (NJA + NJB)) * NWAVES, scr, lane);
        }
        for (int job = bx; job < NJA + NJB; job += G) {
            if (job < NJA) mixer_a_job(args, lds, job / (2 * HA), (job >> 1) % HA, job & 1, tid);
            else { const int jb = job - NJA; mixer_b_job(args, lds, jb / (4 * HB), (jb >> 2) % HB, jb & 3, tid); }
            BLOCK_BAR();
        }
        if (BOTH(3)) GRID_BAR();
    }

    if (IN(4)) {
        const int gw = vcu * NWAVES + wave, NGW = G * NWAVES;
        const float* SSA = (const float*)(ws + WS_SSA); const float* SSB = (const float*)(ws + WS_SSB);
        static_assert(DA % 512 == 0 && DA == DB, "P3 tiling");
        for (int m = gw; m < M; m += NGW) {
#pragma unroll
            for (int br = 0; br < 2; ++br) {
#pragma unroll
                for (int i = 0; i < DA / 512; ++i) {
                    const int col0 = i * 512 + lane * 8;
                    float rstd;
                    if (br == 0) { const int hh = col0 / 128; rstd = frsq((SSA[((size_t)m * HA + hh) * 2] + SSA[((size_t)m * HA + hh) * 2 + 1]) * (1.0f / 128.0f) + EPS); }
                    else { const int hh = col0 / 256; const f32x4 q_ = *(const f32x4*)(SSB + ((size_t)m * HB + hh) * 4); rstd = frsq(((q_[0] + q_[1]) + (q_[2] + q_[3])) * (1.0f / 256.0f) + EPS); }
                    u32x4* po = (u32x4*)(OAB + (size_t)(br * M + m) * LDU + col0);
                    u32x4 w = *po; const u32x4 g8 = *(const u32x4*)(PB + p_off((size_t)m, (br ? C_OGB : C_OGA) + col0)), z8 = *(const u32x4*)(PB + p_off((size_t)m, (br ? C_ZB : C_ZA) + col0));
                    const f32x4 gn0 = *(const f32x4*)(args.in[br ? 9 : 8] + col0), gn1 = *(const f32x4*)(args.in[br ? 9 : 8] + col0 + 4);
#pragma unroll
                    for (int e = 0; e < 4; ++e) { float v[2];
#pragma unroll
                        for (int k = 0; k < 2; ++k) { const float ov = __builtin_bit_cast(float, k ? (w[e] & 0xffff0000u) : (w[e] << 16)), og = __builtin_bit_cast(float, k ? (g8[e] & 0xffff0000u) : (g8[e] << 16)), z = __builtin_bit_cast(float, k ? (z8[e] & 0xffff0000u) : (z8[e] << 16));
                            const float gnv = (e < 2 ? gn0 : gn1)[(2 * e + k) & 3];
                            v[k] = ov * rstd * gnv * sigm2(og) * (z * sigm2(z)); }
                        w[e] = cvt_pk_bf16(v[0], v[1]); }
                    *po = w;
                }
            }
        }
        if (BOTH(4)) GRID_BAR();
    }
    if (IN(5)) {
        { pg8::Gemm g8{(const bf16*)(ws + WS_H8), (const bf16*)(ws + WS_W8), M, 2 * D, D}; SchedGate S8; S8.so.init(M, D, G, bx);
          EpiP8 E8{PB};
          pg8::gemm_phase<EpiP8, SchedGate, GEMM_ALIGN, GEMM_SP2, 1>(lds, g8, S8, E8); }
        BLOCK_BAR();
        pg8::Gemm g{OAB, WUT, M, D, 2 * DA, LDU, (size_t)M * LDU * 2, (size_t)D * LDU * 2}; SchedRev S; S.init(M, D, G, bx);
        EpiUp2 E{HBUF, make_rsrc(PB, P_BYTES)};
        for (int rep = 0; rep < PROBE_REP_P4; ++rep) pg8::gemm_phase<EpiUp2, SchedRev, GEMM_ALIGN, GEMM_SP2, 2, true>(lds, g, S, E);
        if (BOTH(5)) GRID_BAR();
    }

    if (IN(6)) {
        pg8::Gemm g{HBUF, WOT, M, D, D}; pg8::StaticOrder S; S.init(M, D, G, bx);
        EpiOut E{PB, RSS};
        for (int rep = 0; rep < PROBE_REP_P5; ++rep) pg8::gemm_phase<EpiOut, pg8::StaticOrder, GEMM_ALIGN, GEMM_SP2>(lds, g, S, E);
        if (BOTH(6)) GRID_BAR();
    }

    if (IN(7)) {
        const int gw = vcu * NWAVES + wave, NGW = G * NWAVES;
        const float* gpost = args.in[13];
        for (int m = gw; m < M; m += NGW) {
            const float ss = wave_sum(lane < NRS ? RSS[(size_t)m * NRS + lane] : 0.f);
            const float rstd = frsq(ss * (1.0f / D) + EPS);
            const f32x4* xr = (const f32x4*)(x + (size_t)m * D) + lane; f32x4* orow = (f32x4*)(args.out + (size_t)m * D) + lane; const u32x2* ob = (const u32x2*)(PB + (size_t)m * D) + lane;
#pragma unroll
            for (int jj = 0; jj < D / 256; ++jj) { const f32x4 xv = xr[64 * jj], gg = ((const f32x4*)gpost)[lane + 64 * jj]; const u32x2 w = ob[64 * jj];
                const f32x4 ov = (f32x4){__builtin_bit_cast(float, w.x << 16), __builtin_bit_cast(float, w.x & 0xffff0000u), __builtin_bit_cast(float, w.y << 16), __builtin_bit_cast(float, w.y & 0xffff0000u)};
                orow[64 * jj] = xv + ov * rstd * gg; }
        }
    }
#undef IN
#undef BOTH
}

#ifndef EMU
extern "C" void kernel_launch(void* const* d_in, const int* in_sizes, int n_in, void* d_out, int out_size, void* d_ws, size_t ws_size, hipStream_t stream) {
    static int grid = 0;
    if (grid == 0) {
        if (n_in != 14 || out_size != M * D || ws_size < WS_END) { fprintf(stderr, "kernel_launch: unexpected shapes (n_in %d, out %d, ws %zu < %zu)\n", n_in, out_size, ws_size, (size_t)WS_END); grid = -1; return; }
        int dev = 0, cus = 0, per_cu = 0;
        if (hipGetDevice(&dev) != hipSuccess || hipDeviceGetAttribute(&cus, hipDeviceAttributeMultiprocessorCount, dev) != hipSuccess) { grid = -1; return; }
        if (hipFuncSetAttribute((const void*)fwd_kernel, hipFuncAttributeMaxDynamicSharedMemorySize, LDS_BYTES) != hipSuccess) { fprintf(stderr, "kernel_launch: hipFuncSetAttribute failed\n"); grid = -1; return; }
        if (hipOccupancyMaxActiveBlocksPerMultiprocessor(&per_cu, (const void*)fwd_kernel, NTHREADS, LDS_BYTES) != hipSuccess || per_cu < 1) { fprintf(stderr, "kernel_launch: occupancy query says %d\n", per_cu); }
        (void)hipGetLastError();
        grid = cus;
    }
    if (grid < 0) return;
    (void)hipMemsetAsync((char*)d_ws + WS_CTL, 0, CTL_ZERO_BYTES, stream);
    Args a{};
    for (int i = 0; i < 14; ++i) a.in[i] = (const float*)d_in[i];
    a.out = (float*)d_out; a.ws = (unsigned char*)d_ws; a.ph_lo = 0; a.ph_hi = 8;
    hipLaunchKernelGGL(fwd_kernel, dim3(grid), dim3(NTHREADS), LDS_BYTES, stream, a);
}
#endif
```

```cpp
typedef unsigned u32x2_t __attribute__((ext_vector_type(2)));
typedef int v8i_t __attribute__((ext_vector_type(8)));
typedef int v4i_t __attribute__((ext_vector_type(4)));
#ifndef EMU
#include <hip/hip_runtime.h>
#include <cstdio>
#include <cstdint>
#define LAS __attribute__((address_space(3)))
#define GAS __attribute__((address_space(1)))
typedef short bf16x8 __attribute__((ext_vector_type(8)));
typedef short bf16x4 __attribute__((ext_vector_type(4)));
typedef float f32x4 __attribute__((ext_vector_type(4)));
#define DEV __device__ __forceinline__
#define LDS_RD(T, p) (*(const LAS T*)(p))
#define LDS_WR(T, p, v) (*(LAS T*)(p) = (v))
#define WAVE_SYNC() asm volatile("s_waitcnt lgkmcnt(0)" ::: "memory")
#define BLOCK_BAR() __syncthreads()
#define RAW_BAR() __builtin_amdgcn_s_barrier()
#define WAIT_V(n) asm volatile("s_waitcnt vmcnt(" #n ")" ::: "memory")
#define WAIT_L(n) asm volatile("s_waitcnt lgkmcnt(" #n ")" ::: "memory")
#define SCHED_BAR() __builtin_amdgcn_sched_barrier(0)
#define SETPRIO(n) __builtin_amdgcn_s_setprio(n)
#define GLDS16(g, l) __builtin_amdgcn_global_load_lds((const unsigned*)(g), (LAS unsigned*)(l), 16, 0, 0)
#define MFMA16(a, b, c) __builtin_amdgcn_mfma_f32_16x16x32_bf16(a, b, c, 0, 0, 0)
#define RFL(x) __builtin_amdgcn_readfirstlane(x)
#define COMPILER_FENCE() asm volatile("" ::: "memory")
#define OPAQUE(x) asm volatile("" : "+v"(x))
DEV float fexp2(float x) { return __builtin_amdgcn_exp2f(x); }
DEV float flog2(float x) { return __builtin_amdgcn_logf(x); }
DEV float frcp(float x) { return __builtin_amdgcn_rcpf(x); }
DEV float frsq(float x) { return __builtin_amdgcn_rsqf(x); }
DEV unsigned cvt_pk_bf16(float lo, float hi) { unsigned r; asm volatile("v_cvt_pk_bf16_f32 %0, %1, %2" : "=v"(r) : "v"(lo), "v"(hi)); return r; }
DEV f32x4 mfma8(v8i_t a, v8i_t b, f32x4 c, int sc) { asm volatile("v_mfma_scale_f32_16x16x128_f8f6f4 %0, %1, %2, %0, %3, %3 op_sel_hi:[0,0,0]" : "+v"(c) : "v"(a), "v"(b), "v"(sc)); return c; }
#define MFMA_DRAIN() asm volatile("s_nop 15\n\ts_nop 7" ::: "memory")
DEV unsigned pk_fp8x4(float a, float b, float c, float d) { int r = __builtin_amdgcn_cvt_pk_fp8_f32(a, b, 0, false); r = __builtin_amdgcn_cvt_pk_fp8_f32(c, d, r, true); return (unsigned)r; }
typedef short v4i16_t __attribute__((ext_vector_type(4)));
DEV bf16x4 lds_tr16(LAS unsigned char* p) { return __builtin_bit_cast(bf16x4, __builtin_amdgcn_ds_read_tr16_b64_v4i16((LAS v4i16_t*)p)); }
#define MIX_BAR() do { asm volatile("s_waitcnt lgkmcnt(0)" ::: "memory"); __builtin_amdgcn_s_barrier(); asm volatile("" ::: "memory"); } while (0)
DEV void glds16_asm(const void* gsrc, unsigned lds_dst) { unsigned keep;
    asm volatile("s_mov_b32 %0, m0\n\ts_mov_b32 m0, %2\n\ts_nop 0\n\tglobal_load_lds_dwordx4 %1, off\n\ts_mov_b32 m0, %0" : "=&s"(keep) : "v"(gsrc), "s"(lds_dst) : "memory"); }
#define GLDS16X(g, l) glds16_asm((const void*)(g), (unsigned)RFL((int)(unsigned)(__UINTPTR_TYPE__)(l)))
DEV void glds16_sbase(const void* sbase, unsigned voff, unsigned lds_dst) { unsigned keep;
    asm volatile("s_mov_b32 %0, m0\n\ts_mov_b32 m0, %3\n\ts_nop 0\n\tglobal_load_lds_dwordx4 %1, %2\n\ts_mov_b32 m0, %0" : "=&s"(keep) : "v"(voff), "s"(sbase), "s"(lds_dst) : "memory"); }
#define GLDS16S(sb, vo, l) glds16_sbase((const void*)(sb), (unsigned)(vo), (unsigned)RFL((int)(unsigned)(__UINTPTR_TYPE__)(l)))
typedef __amdgpu_buffer_rsrc_t rsrc_t;
DEV rsrc_t make_rsrc(const void* p, unsigned bytes) { return __builtin_amdgcn_make_buffer_rsrc((void*)p, (short)0, (int)bytes, 0x00020000); }
DEV unsigned short bload16(rsrc_t r, unsigned voff, unsigned soff) { return (unsigned short)__builtin_amdgcn_raw_buffer_load_b16(r, (int)voff, (int)soff, 0); }
DEV void bstore16(rsrc_t r, unsigned voff, unsigned soff, unsigned short v) { __builtin_amdgcn_raw_buffer_store_b16(v, r, (int)voff, (int)soff, 0); }
DEV void bstore64(rsrc_t r, unsigned voff, unsigned soff, u32x2_t v) { __builtin_amdgcn_raw_buffer_store_b64(v, r, (int)voff, (int)soff, 0); }
typedef unsigned u32x4_t __attribute__((ext_vector_type(4)));
DEV u32x4_t bload128(rsrc_t r, unsigned voff, unsigned soff) { return __builtin_amdgcn_raw_buffer_load_b128(r, (int)voff, (int)soff, 0); }
#else
#define LAS
#define GAS
#define DEV inline
#define LDS_RD(T, p) emu_lds_rd<T>((const void*)(p), #p)
#define LDS_WR(T, p, v) emu_lds_wr<T>((void*)(p), (T)(v), #p)
#define WAVE_SYNC() emu_wavesync()
#define BLOCK_BAR() emu_syncthreads()
#define RAW_BAR() emu_syncthreads()
#define WAIT_V(n)
#define WAIT_L(n)
#define SCHED_BAR()
#define SETPRIO(n)
#define GLDS16(g, l) emu_glds16((const void*)(g), (unsigned char*)(l))
#define GLDS16X(g, l) emu_glds16((const void*)(g), (unsigned char*)(l))
#define GLDS16S(sb, vo, l) emu_glds16((const void*)((const char*)(sb) + (vo)), (unsigned char*)(l))
#define MFMA16(a, b, c) emu_mfma16(a, b, c)
#define RFL(x) (x)
#define COMPILER_FENCE()
#define OPAQUE(x)
DEV float fexp2(float x) { return exp2f(x); }
DEV float flog2(float x) { return log2f(x); }
DEV float frcp(float x) { return 1.0f / x; }
DEV float frsq(float x) { return 1.0f / sqrtf(x); }
DEV unsigned cvt_pk_bf16(float lo, float hi) { return (unsigned)emu_f2bf(lo) | ((unsigned)emu_f2bf(hi) << 16); }
#define mfma8(a, b, c, sc) emu_mfma8(a, b, c)
#define MFMA_DRAIN()
DEV unsigned pk_fp8x4(float a, float b, float c, float d) { return (unsigned)emu_f2fp8(a) | ((unsigned)emu_f2fp8(b) << 8) | ((unsigned)emu_f2fp8(c) << 16) | ((unsigned)emu_f2fp8(d) << 24); }
#define lds_tr16(p) emu_lds_tr16((const unsigned char*)(p))
#define MIX_BAR() emu_syncthreads()
typedef unsigned char* rsrc_t;
DEV rsrc_t make_rsrc(const void* p, unsigned) { return (unsigned char*)p; }
DEV unsigned short bload16(rsrc_t r, unsigned voff, unsigned soff) { unsigned short v; memcpy(&v, r + (size_t)voff + soff, 2); return v; }
DEV void bstore16(rsrc_t r, unsigned voff, unsigned soff, unsigned short v) { memcpy(r + (size_t)voff + soff, &v, 2); }
DEV void bstore64(rsrc_t r, unsigned voff, unsigned soff, u32x2_t v) { memcpy(r + (size_t)voff + soff, &v, 8); }
typedef unsigned u32x4_t __attribute__((ext_vector_type(4)));
DEV u32x4_t bload128(rsrc_t r, unsigned voff, unsigned soff) { u32x4_t v; memcpy(&v, r + (size_t)voff + soff, 16); return v; }
#endif

typedef unsigned short bf16;
typedef unsigned u32x4 __attribute__((ext_vector_type(4)));
typedef unsigned u32x2 __attribute__((ext_vector_type(2)));
typedef float f32x2 __attribute__((ext_vector_type(2)));
typedef LAS unsigned char* ldsp;

#ifndef CFG_D
#define CFG_D 4096
#define CFG_B 4
#define CFG_S 4096
#define CFG_HB 8
#endif
constexpr int D = CFG_D, NB = CFG_B, SEQ = CFG_S, M = NB * SEQ;
constexpr int DA = D / 2, HA = DA / 128, DB = D / 2, HB = CFG_HB, DVB = DB / HB, DKB = 128, DQK = HB * DKB;
constexpr int NSG = 2 * HB;
constexpr int NCH = SEQ / 64;
static_assert(DVB == 256 && NSG <= 16 && SEQ % 64 == 0 && M % 256 == 0 && D % 256 == 0, "shape");
constexpr int C_QA = 0, C_FA = DA, C_IA = 2 * DA, C_OGA = 3 * DA, C_ZA = 4 * DA, C_QB = 5 * DA, C_KB = C_QB + DQK, C_VB = C_KB + DQK, C_OGB = C_VB + DB, C_ZB = C_OGB + DB;
constexpr int NPM = C_ZB + DB, C_GA = NPM, C_GB = NPM + D, NP = NPM + 2 * D, D_IN = NP + NSG;
static_assert(NPM % 256 == 0 && NP % 256 == 0, "column map");
constexpr float EPS = 1e-6f;
constexpr float H8_SCALE = 64.0f, W8_SCALE = 1024.0f, G8_DESCALE = 1.0f / (64.0f * 1024.0f);
constexpr float LOG2E = 1.4426950408889634f, LN2 = 0.6931471805599453f;
constexpr int NRS = D / 64;
constexpr int PT_PITCH = M / 64 + 1;
DEV size_t p_off(size_t row, int col) { return ((size_t)(col >> 7) * (size_t)PT_PITCH + (row >> 6)) * 8192 + (row & 63) * 128 + (size_t)(col & 127); }

constexpr size_t al256(size_t x) { return (x + 255) & ~(size_t)255; }
constexpr size_t WS_CTL = 0, CTL_ZERO_BYTES = 65536;
constexpr size_t WS_W1T = 1u << 20;
constexpr int LDU = DA + 64;
constexpr size_t WS_WUT = al256(WS_W1T + (size_t)(NP + 16) * D * 2);
constexpr size_t WS_WOT = al256(WS_WUT + (size_t)2 * D * LDU * 2);
constexpr size_t WS_HB = al256(WS_WOT + (size_t)D * D * 2);
constexpr size_t WS_P = al256(WS_HB + (size_t)M * D * 2);
constexpr size_t WS_SG = al256(WS_P + (size_t)(NP / 128) * (M / 64 + 1) * 16384 + 4096);
constexpr size_t WS_OAB = al256(WS_SG + (size_t)M * 16 * 4);
constexpr size_t WS_RSS = al256(WS_OAB + (size_t)2 * M * LDU * 2);
constexpr size_t WS_SSB = al256(WS_RSS + (size_t)M * NRS * 4);
constexpr size_t WS_SSA = al256(WS_SSB + (size_t)M * HB * 4 * 4);
constexpr size_t WS_H8 = al256(WS_SSA + (size_t)M * HA * 2 * 4);
constexpr size_t WS_W8 = al256(WS_H8 + (size_t)M * D);
constexpr size_t WS_END = al256(WS_W8 + (size_t)2 * D * D);
constexpr size_t WS_W8OG = WS_P + (size_t)(NPM / 128) * (M / 64 + 1) * 16384;
static_assert((size_t)(DA + DB) * D <= (size_t)(2 * D / 128) * (M / 64 + 1) * 16384, "out-gate weight copy fits the merge-gate tiles");
constexpr int CW_BAR = 1024;

constexpr int RING_BYTES = 154624, LDSCTL_OFF = RING_BYTES, MISC_OFF = LDSCTL_OFF + 320, LDS_BYTES = 155648;
constexpr int NWAVES = 8, NTHREADS = 512;

DEV unsigned f2bf(float f) { unsigned u = __builtin_bit_cast(unsigned, f); return (u + 0x7fffu + ((u >> 16) & 1u)) >> 16; }
DEV float bf2f(unsigned b) { return __builtin_bit_cast(float, b << 16); }
DEV unsigned pk2(float lo, float hi) { return f2bf(lo) | (f2bf(hi) << 16); }
DEV float fexp(float x) { return fexp2(x * LOG2E); }
DEV float flog(float x) { return flog2(x) * LN2; }
DEV float sigm(float x) { return frcp(1.0f + fexp(-x)); }
DEV float logsig(float x) { return fminf(x, 0.f) - flog(1.0f + fexp(-fabsf(x))); }
DEV float wave_sum(float v) {
#pragma unroll
    for (int o = 1; o < 64; o <<= 1) v += __shfl_xor(v, o);
    return v;
}

namespace pg8 {
constexpr int BM = 256, BK = 64, HALF = 128, HTB = HALF * BK * 2, STAGE_BYTES = 8 * HTB, NXCD = 8, WGM = 8;
DEV int lds_byte(int r, int c) { const int st = (r >> 4) * 2 + (c >> 5), rr = r & 15, cc = c & 31, ob = rr * 64 + cc * 2; return st * 1024 + (ob ^ (((ob >> 9) & 1) << 5)); }
DEV void stage_rc(int b, int& R, int& C) { const int st = b / 1024, sb = b % 1024, swz = sb ^ (((sb >> 9) & 1) << 5); R = (st >> 1) * 16 + swz / 64; C = (st & 1) * 32 + (swz % 64) / 2; }
DEV int perm32(int rho) { const int n = rho >> 4, i = rho & 15; return 8 * (i >> 2) + 4 * n + (i & 3); }
struct Unit { int pm, pn; };
struct Gemm { const bf16* A; const bf16* Bt; int M, N, K; int ld; size_t a2off, b2off; };
struct StaticOrder {
    int nM, nN, nwg, G, c;
    DEV void init(int M_, int N_, int G_, int c_) { nM = M_ / BM; nN = N_ / BM; nwg = nM * nN; G = G_; c = c_; }
    DEV bool next(int i, Unit& u) const {
        const long L = (long)i * G + c; if (L >= nwg) return false;
        int wgid = (int)L; { const int q = nwg / NXCD, r = nwg % NXCD, xcd = wgid % NXCD, off = wgid / NXCD; wgid = (xcd < r ? xcd * (q + 1) : r * (q + 1) + (xcd - r) * q) + off; }
        const int nig = WGM * nN, gid = wgid / nig, fm = gid * WGM, gsz = (nM - fm) < WGM ? (nM - fm) : WGM;
        u.pm = fm + ((wgid % nig) % gsz); u.pn = (wgid % nig) / gsz; return true;
    }
};
template <class Epi, class Sched, bool ALIGN_EPI = false, bool SP2 = false, int ESZ = 2, bool SPLITK = false>
DEV void gemm_phase(ldsp lds, const Gemm g, const Sched& S, const Epi& E) {
    const int tid = threadIdx.x, wid = RFL(tid >> 6), lane = tid & 63, wr = wid >> 2, wc = wid & 3, fr = lane & 15, fq = lane >> 4;
    const int nt = (g.K * ESZ / 2) / BK, K = (g.ld ? g.ld : g.K) * ESZ / 2;
    unsigned voffA[2], voffB[2];
#pragma unroll
    for (int i = 0; i < 2; ++i) { int R, C; stage_rc(tid * 16 + i * 8192, R, C); const int Rb = Epi::PERM ? ((R & ~31) + perm32(R & 31)) : R;
        voffA[i] = (unsigned)(R * K + C) * 2u; voffB[i] = (unsigned)(Rb * K + C) * 2u; }
    const size_t kstep = (size_t)(BK * 2);
    const size_t hstep = (size_t)HALF * K * 2;
    const size_t tstep = 2 * hstep;
    const unsigned ldsw = (unsigned)wid * 1024u;
    int aoffk[2], boffk[2];
#pragma unroll
    for (int k = 0; k < 2; ++k) { const int ch = ESZ == 2 ? fq + 4 * k : 2 * fq + k;
        aoffk[k] = lds_byte(wr * 64 + fr, (ch & 3) * 8) + (ch >> 2) * 1024; boffk[k] = lds_byte(wc * 32 + fr, (ch & 3) * 8) + (ch >> 2) * 1024; }
#define PG8_SA(b, h) (((b) * 2 + (h)) * HTB)
#define PG8_SB(b, h) ((4 + (b) * 2 + (h)) * HTB)
#define PG8_STAGE(bufoff, gbase, voff) do { _Pragma("unroll") for (int _i = 0; _i < 2; ++_i) \
        GLDS16((const char*)(gbase) + (voff)[_i], lds + (bufoff) + ldsw + _i * 8192); } while (0)
#define PG8_LDA(dst, b, h) do { _Pragma("unroll") for (int m = 0; m < 4; ++m) { if constexpr (ESZ == 2) { _Pragma("unroll") for (int k = 0; k < 2; ++k) dst[m][k] = *(const LAS bf16x8*)(lds + PG8_SA(b, h) + aoffk[k] + m * 2048); } \
        else dst##8[m] = __builtin_shufflevector(*(const LAS v4i_t*)(lds + PG8_SA(b, h) + aoffk[0] + m * 2048), *(const LAS v4i_t*)(lds + PG8_SA(b, h) + aoffk[1] + m * 2048), 0, 1, 2, 3, 4, 5, 6, 7); } } while (0)
#define PG8_LDB(dst, b, h) do { _Pragma("unroll") for (int n = 0; n < 2; ++n) { if constexpr (ESZ == 2) { _Pragma("unroll") for (int k = 0; k < 2; ++k) dst[n][k] = *(const LAS bf16x8*)(lds + PG8_SB(b, h) + boffk[k] + n * 2048); } \
        else dst##8[n] = __builtin_shufflevector(*(const LAS v4i_t*)(lds + PG8_SB(b, h) + boffk[0] + n * 2048), *(const LAS v4i_t*)(lds + PG8_SB(b, h) + boffk[1] + n * 2048), 0, 1, 2, 3, 4, 5, 6, 7); } } while (0)
#define PG8_MMA(ai, bj, At, Bt) do { SETPRIO(1); _Pragma("unroll") for (int m = 0; m < 4; ++m) _Pragma("unroll") for (int n = 0; n < 2; ++n) { \
        if constexpr (ESZ == 2) { _Pragma("unroll") for (int k = 0; k < 2; ++k) acc[ai][bj][m][n] = MFMA16(Bt[n][k], At[m][k], acc[ai][bj][m][n]); } \
        else acc[ai][bj][m][n] = mfma8(Bt##8[n], At##8[m], acc[ai][bj][m][n], sc8); } SETPRIO(0); } while (0)
    int sc8 = 0x7f7f7f7f; OPAQUE(sc8);
    Unit cur, nxt; int ui = 0;
    if (!S.next(0, cur)) return;
    f32x4 acc[2][2][4][2];
#pragma unroll
    for (int a = 0; a < 2; ++a)
#pragma unroll
        for (int b = 0; b < 2; ++b)
#pragma unroll
            for (int m = 0; m < 4; ++m)
#pragma unroll
                for (int n = 0; n < 2; ++n) acc[a][b][m][n] = (f32x4){0.f, 0.f, 0.f, 0.f};
    bf16x8 At[ESZ == 2 ? 4 : 1][2], B0[ESZ == 2 ? 2 : 1][2], B1[ESZ == 2 ? 2 : 1][2];
    v8i_t At8[ESZ == 1 ? 4 : 1], B08[ESZ == 1 ? 2 : 1], B18[ESZ == 1 ? 2 : 1];
    const char* cA = (const char*)g.A + (size_t)cur.pm * tstep; const char* cB = (const char*)g.Bt + (size_t)cur.pn * tstep;
    if constexpr (SP2) {
        PG8_STAGE(PG8_SB(0, 0), cB, voffB); PG8_STAGE(PG8_SB(0, 1), cB + hstep, voffB); PG8_STAGE(PG8_SA(0, 0), cA, voffA); PG8_STAGE(PG8_SA(0, 1), cA + hstep, voffA);
        if (wr == 1) RAW_BAR();
        WAIT_V(2); RAW_BAR();
        PG8_STAGE(PG8_SB(1, 0), cB + kstep, voffB); PG8_STAGE(PG8_SA(1, 0), cA + kstep, voffA); PG8_STAGE(PG8_SB(1, 1), cB + hstep + kstep, voffB);
        WAIT_V(6); RAW_BAR();
    } else {
        PG8_STAGE(PG8_SB(0, 0), cB, voffB); PG8_STAGE(PG8_SA(0, 0), cA, voffA); PG8_STAGE(PG8_SB(0, 1), cB + hstep, voffB); PG8_STAGE(PG8_SA(0, 1), cA + hstep, voffA);
        if (wr == 1) RAW_BAR();
        WAIT_V(4); RAW_BAR();
        PG8_STAGE(PG8_SB(1, 0), cB + kstep, voffB); PG8_STAGE(PG8_SA(1, 0), cA + kstep, voffA); PG8_STAGE(PG8_SB(1, 1), cB + hstep + kstep, voffB);
        WAIT_V(6); RAW_BAR();
    }
    for (;;) {
        const bool has_next = S.next(ui + 1, nxt);
        const char* nA = has_next ? (const char*)g.A + (size_t)nxt.pm * tstep : cA; const char* nB = has_next ? (const char*)g.Bt + (size_t)nxt.pn * tstep : cB;
        for (int t = 0; t < nt; t += 2) {
            const bool last = (t == nt - 2);
            const size_t h1 = (SPLITK && t >= nt / 2) ? 1 : 0, h2 = (SPLITK && t + 2 >= nt / 2) ? 1 : 0;
            const char* a1 = cA + (size_t)(t + 1) * kstep + h1 * (g.a2off - (size_t)(nt / 2) * kstep);
            const char* a2 = last ? nA : cA + (size_t)(t + 2) * kstep + h2 * (g.a2off - (size_t)(nt / 2) * kstep); const char* b2 = last ? nB : cB + (size_t)(t + 2) * kstep + h2 * (g.b2off - (size_t)(nt / 2) * kstep);
            const char* a3 = a2 + kstep; const char* b3 = b2 + kstep;
            if constexpr (SPLITK) { if (t == nt / 2) {
                if constexpr (ALIGN_EPI) { if (wr == 0) RAW_BAR(); }
                int fr_ = fr; OPAQUE(fr_); E.mid(acc, cur, wr, wc, fr_, fq);
                if constexpr (ALIGN_EPI) { if (wr == 1) RAW_BAR(); } } }
            if constexpr (SP2) {
            PG8_LDB(B0, 0, 0); PG8_LDB(B1, 0, 1); SCHED_BAR(); PG8_LDA(At, 0, 0); PG8_STAGE(PG8_SA(1, 1), a1 + hstep, voffA);
            WAIT_V(8); WAIT_L(0); RAW_BAR(); PG8_MMA(0, 0, At, B0); PG8_MMA(0, 1, At, B1); RAW_BAR(); SCHED_BAR();
            PG8_LDA(At, 0, 1); PG8_STAGE(PG8_SB(0, 0), b2, voffB); PG8_STAGE(PG8_SB(0, 1), b2 + hstep, voffB); PG8_STAGE(PG8_SA(0, 0), a2, voffA);
            WAIT_V(8); WAIT_L(0); RAW_BAR(); PG8_MMA(1, 0, At, B0); PG8_MMA(1, 1, At, B1); RAW_BAR(); SCHED_BAR();
            PG8_LDB(B0, 1, 0); PG8_LDB(B1, 1, 1); SCHED_BAR(); PG8_LDA(At, 1, 0); PG8_STAGE(PG8_SA(0, 1), a2 + hstep, voffA);
            WAIT_V(8); WAIT_L(0); RAW_BAR(); PG8_MMA(0, 0, At, B0); PG8_MMA(0, 1, At, B1); RAW_BAR(); SCHED_BAR();
            PG8_LDA(At, 1, 1); PG8_STAGE(PG8_SB(1, 0), b3, voffB); PG8_STAGE(PG8_SB(1, 1), b3 + hstep, voffB); PG8_STAGE(PG8_SA(1, 0), a3, voffA);
            WAIT_V(8); WAIT_L(0); RAW_BAR(); PG8_MMA(1, 0, At, B0); PG8_MMA(1, 1, At, B1); RAW_BAR(); SCHED_BAR();
            } else {
            PG8_LDB(B0, 0, 0); SCHED_BAR(); PG8_LDA(At, 0, 0); PG8_STAGE(PG8_SA(1, 1), a1 + hstep, voffA);
            WAIT_L(8); RAW_BAR(); WAIT_L(0); PG8_MMA(0, 0, At, B0); RAW_BAR(); SCHED_BAR();
            PG8_LDB(B1, 0, 1); PG8_STAGE(PG8_SB(0, 0), b2, voffB);
            RAW_BAR(); WAIT_L(0); PG8_MMA(0, 1, At, B1); RAW_BAR();
            PG8_LDA(At, 0, 1); PG8_STAGE(PG8_SA(0, 0), a2, voffA);
            RAW_BAR(); WAIT_L(0); PG8_MMA(1, 0, At, B0); RAW_BAR(); SCHED_BAR();
            PG8_STAGE(PG8_SB(0, 1), b2 + hstep, voffB);
            WAIT_V(6); RAW_BAR(); PG8_MMA(1, 1, At, B1); RAW_BAR();
            PG8_LDB(B0, 1, 0); SCHED_BAR(); PG8_LDA(At, 1, 0); PG8_STAGE(PG8_SA(0, 1), a2 + hstep, voffA);
            WAIT_L(8); RAW_BAR(); WAIT_L(0); PG8_MMA(0, 0, At, B0); RAW_BAR(); SCHED_BAR();
            PG8_LDB(B1, 1, 1); PG8_STAGE(PG8_SB(1, 0), b3, voffB);
            RAW_BAR(); WAIT_L(0); PG8_MMA(0, 1, At, B1); RAW_BAR();
            PG8_LDA(At, 1, 1); PG8_STAGE(PG8_SA(1, 0), a3, voffA);
            RAW_BAR(); WAIT_L(0); PG8_MMA(1, 0, At, B0); RAW_BAR(); SCHED_BAR();
            PG8_STAGE(PG8_SB(1, 1), b3 + hstep, voffB);
            WAIT_V(6); RAW_BAR(); PG8_MMA(1, 1, At, B1); RAW_BAR();
            }
        }
        if constexpr (ALIGN_EPI) { if (wr == 0) RAW_BAR(); }
        if constexpr (ESZ == 1) { MFMA_DRAIN();
#pragma unroll
            for (int a = 0; a < 2; ++a)
#pragma unroll
                for (int b = 0; b < 2; ++b) asm volatile("" : "+v"(acc[a][b][0][0]), "+v"(acc[a][b][0][1]), "+v"(acc[a][b][1][0]), "+v"(acc[a][b][1][1]), "+v"(acc[a][b][2][0]), "+v"(acc[a][b][2][1]), "+v"(acc[a][b][3][0]), "+v"(acc[a][b][3][1])); }
        E(acc, cur, wr, wc, fr, fq);
        if (!has_next) break;
#pragma unroll
        for (int a = 0; a < 2; ++a)
#pragma unroll
            for (int b = 0; b < 2; ++b)
#pragma unroll
                for (int m = 0; m < 4; ++m)
#pragma unroll
                    for (int n = 0; n < 2; ++n) acc[a][b][m][n] = (f32x4){0.f, 0.f, 0.f, 0.f};
        cur = nxt; cA = nA; cB = nB; ++ui;
        if constexpr (ALIGN_EPI) { if (wr == 1) RAW_BAR(); }
    }
    WAIT_V(0);
    if constexpr (!ALIGN_EPI) { if (wr == 0) RAW_BAR(); }
    RAW_BAR();
#undef PG8_SA
#undef PG8_SB
#undef PG8_STAGE
#undef PG8_LDA
#undef PG8_LDB
#undef PG8_MMA
}
}

struct EpiP {
    static constexpr bool PERM = true;
    bf16* O;
    DEV void operator()(const f32x4 (&acc)[2][2][4][2], const pg8::Unit& u, int wr, int wc, int fr, int fq) const {
        const int row0 = u.pm * 256 + wr * 64 + fr, col0 = u.pn * 256 + wc * 32 + 8 * fq;
#pragma unroll
        for (int ai = 0; ai < 2; ++ai)
#pragma unroll
            for (int m = 0; m < 4; ++m) { const size_t row = (size_t)(row0 + ai * 128 + m * 16);
#pragma unroll
                for (int bj = 0; bj < 2; ++bj) { const f32x4 v0 = acc[ai][bj][m][0], v1 = acc[ai][bj][m][1];
                    u32x4 w; w.x = cvt_pk_bf16(v0[0], v0[1]); w.y = cvt_pk_bf16(v0[2], v0[3]); w.z = cvt_pk_bf16(v1[0], v1[1]); w.w = cvt_pk_bf16(v1[2], v1[3]);
                    *(u32x4*)(O + p_off(row, col0 + bj * 128)) = w; } }
    }
};
struct EpiP8 {
    static constexpr bool PERM = true;
    bf16* O;
    DEV void operator()(const f32x4 (&acc)[2][2][4][2], const pg8::Unit& u, int wr, int wc, int fr, int fq) const {
        const int row0 = u.pm * 256 + wr * 64 + fr, col0 = NPM + u.pn * 256 + wc * 32 + 8 * fq;
#pragma unroll
        for (int ai = 0; ai < 2; ++ai)
#pragma unroll
            for (int m = 0; m < 4; ++m) { const size_t row = (size_t)(row0 + ai * 128 + m * 16);
#pragma unroll
                for (int bj = 0; bj < 2; ++bj) { const f32x4 v0 = acc[ai][bj][m][0] * G8_DESCALE, v1 = acc[ai][bj][m][1] * G8_DESCALE;
                    u32x4 w; w.x = cvt_pk_bf16(v0[0], v0[1]); w.y = cvt_pk_bf16(v0[2], v0[3]); w.z = cvt_pk_bf16(v1[0], v1[1]); w.w = cvt_pk_bf16(v1[2], v1[3]);
                    *(u32x4*)(O + p_off(row, col0 + bj * 128)) = w; } }
    }
};
struct SchedUp {
    pg8::StaticOrder so;
    DEV bool next(int i, pg8::Unit& u) const { if (!so.next(i >> 1, u)) return false; if (i & 1) { u.pm += M / 256; u.pn += D / 256; } return true; }
};
struct EpiUp {
    static constexpr bool PERM = true;
    bf16* Y; const bf16* P;
    DEV void operator()(const f32x4 (&acc)[2][2][4][2], const pg8::Unit& u, int wr, int wc, int fr, int fq) const {
        const int br = u.pm >= M / 256 ? 1 : 0, pm = u.pm - br * (M / 256), pn = u.pn - br * (D / 256);
        const int row0 = pm * 256 + wr * 64 + fr, col0 = pn * 256 + wc * 32 + 8 * fq, gcol = (br ? C_GB : C_GA) + col0;
#pragma unroll
        for (int ai = 0; ai < 2; ++ai)
#pragma unroll
            for (int m = 0; m < 4; ++m) { const size_t row = (size_t)(row0 + ai * 128 + m * 16);
#pragma unroll
                for (int bj = 0; bj < 2; ++bj) {
                    const u32x4 g8 = *(const u32x4*)(P + p_off(row, gcol + bj * 128));
                    bf16* yp = Y + row * D + col0 + bj * 128;
                    u32x4 y8 = (u32x4){0u, 0u, 0u, 0u}; if (br) y8 = *(const u32x4*)yp;
                    const f32x4 v0 = acc[ai][bj][m][0], v1 = acc[ai][bj][m][1];
                    float o[8];
#pragma unroll
                    for (int k = 0; k < 8; ++k) { const unsigned gw = g8[k >> 1], yw = y8[k >> 1]; const float gv = bf2f((k & 1) ? (gw >> 16) : (gw & 0xffffu)), yv = bf2f((k & 1) ? (yw >> 16) : (yw & 0xffffu));
                        const float a = k < 4 ? v0[k & 3] : v1[k & 3]; o[k] = yv + sigm(gv) * a; }
                    u32x4 w; w.x = cvt_pk_bf16(o[0], o[1]); w.y = cvt_pk_bf16(o[2], o[3]); w.z = cvt_pk_bf16(o[4], o[5]); w.w = cvt_pk_bf16(o[6], o[7]);
                    *(u32x4*)yp = w; } }
    }
};
struct SchedSkipOg { pg8::StaticOrder so; DEV bool next(int i, pg8::Unit& u) const { if (!so.next(i, u)) return false; if (u.pn >= C_OGA / 256) u.pn += DA / 256; if (u.pn >= C_OGB / 256) u.pn += DB / 256; return true; } };
static_assert(C_OGA % 256 == 0 && C_OGB % 256 == 0 && DA % 256 == 0 && DB % 256 == 0 && C_OGA < C_OGB, "out-gate column tiles");
struct EpiOg {
    static constexpr bool PERM = true;
    bf16* O;
    DEV void operator()(const f32x4 (&acc)[2][2][4][2], const pg8::Unit& u, int wr, int wc, int fr, int fq) const {
        const int cb = u.pn < DA / 256 ? C_OGA + u.pn * 256 : C_OGB + (u.pn - DA / 256) * 256;
        const int row0 = u.pm * 256 + wr * 64 + fr, col0 = cb + wc * 32 + 8 * fq;
#pragma unroll
        for (int ai = 0; ai < 2; ++ai)
#pragma unroll
            for (int m = 0; m < 4; ++m) { const size_t row = (size_t)(row0 + ai * 128 + m * 16);
#pragma unroll
                for (int bj = 0; bj < 2; ++bj) { const f32x4 v0 = acc[ai][bj][m][0] * G8_DESCALE, v1 = acc[ai][bj][m][1] * G8_DESCALE;
                    u32x4 w; w.x = cvt_pk_bf16(v0[0], v0[1]); w.y = cvt_pk_bf16(v0[2], v0[3]); w.z = cvt_pk_bf16(v1[0], v1[1]); w.w = cvt_pk_bf16(v1[2], v1[3]);
                    *(u32x4*)(O + p_off(row, col0 + bj * 128)) = w; } }
    }
};
struct SchedGate { pg8::StaticOrder so; DEV bool next(int i, pg8::Unit& u) const { if (!so.next(i >> 1, u)) return false; if (i & 1) u.pn += D / 256; return true; } };
struct SchedRev { pg8::StaticOrder so; int n; DEV void init(int M_, int N_, int G_, int c_) { so.init(M_, N_, G_, c_); n = so.nwg > c_ ? (so.nwg - c_ + G_ - 1) / G_ : 0; }
    DEV bool next(int i, pg8::Unit& u) const { return i < n && so.next(n - 1 - i, u); } };
constexpr unsigned P_BYTES = (unsigned)((size_t)(NP / 128) * PT_PITCH * 16384);
DEV unsigned p_soff(int pm, int cb, int ai, int m, int wr, int wc) { return (unsigned)((cb * PT_PITCH + 4 * pm + 2 * ai + wr) * 16384 + m * 4096 + wc * 64); }
constexpr unsigned GB_MINUS_GA = (unsigned)((D / 128) * PT_PITCH) * 16384u;
struct EpiUp2 {
    static constexpr bool PERM = true;
    bf16* Y; rsrc_t rs;
    DEV void mid(f32x4 (&acc)[2][2][4][2], const pg8::Unit& u, int wr, int wc, int fr, int fq) const {
        const unsigned voff = (unsigned)(fr * 256 + fq * 16);
#pragma unroll
        for (int ai = 0; ai < 2; ++ai) { u32x4 ga[8], gb[8];
#pragma unroll
            for (int s_ = 0; s_ < 8; ++s_) { const unsigned so = p_soff(u.pm, NPM / 128 + 2 * u.pn + (s_ & 1), ai, s_ >> 1, wr, wc); ga[s_] = bload128(rs, voff, so); gb[s_] = bload128(rs, voff, so + GB_MINUS_GA); }
            SCHED_BAR();
#pragma unroll
            for (int s_ = 0; s_ < 8; ++s_) { const int m = s_ >> 1, bj = s_ & 1;
#pragma unroll
                for (int k = 0; k < 8; ++k) { const unsigned aw = ga[s_][k >> 1], bw = gb[s_][k >> 1];
                    const float av = __builtin_bit_cast(float, (k & 1) ? (aw & 0xffff0000u) : (aw << 16)), bv_ = __builtin_bit_cast(float, (k & 1) ? (bw & 0xffff0000u) : (bw << 16));
                    const float ratio = (1.0f + fexp2(-LOG2E * bv_)) * frcp(1.0f + fexp2(-LOG2E * av));
                    if (k < 4) acc[ai][bj][m][0][k & 3] *= ratio; else acc[ai][bj][m][1][k & 3] *= ratio; } } }
    }
    DEV void operator()(const f32x4 (&acc)[2][2][4][2], const pg8::Unit& u, int wr, int wc, int fr, int fq) const {
        const int row0 = u.pm * 256 + wr * 64 + fr, col0 = u.pn * 256 + wc * 32 + 8 * fq; const unsigned voff = (unsigned)(fr * 256 + fq * 16); u32x4 gb[16];
#pragma unroll
        for (int s_ = 0; s_ < 16; ++s_) gb[s_] = bload128(rs, voff, p_soff(u.pm, NPM / 128 + 2 * u.pn + (s_ & 1), s_ >> 3, (s_ >> 1) & 3, wr, wc) + GB_MINUS_GA);
        SCHED_BAR();
#pragma unroll
        for (int s_ = 0; s_ < 16; ++s_) { const int ai = s_ >> 3, m = (s_ >> 1) & 3, bj = s_ & 1; const size_t row = (size_t)(row0 + ai * 128 + m * 16);
            const f32x4 v0 = acc[ai][bj][m][0], v1 = acc[ai][bj][m][1]; float o[8];
#pragma unroll
            for (int k = 0; k < 8; ++k) { const unsigned bw = gb[s_][k >> 1]; const float bv_ = __builtin_bit_cast(float, (k & 1) ? (bw & 0xffff0000u) : (bw << 16));
                o[k] = (k < 4 ? v0[k & 3] : v1[k & 3]) * frcp(1.0f + fexp2(-LOG2E * bv_)); }
            u32x4 w; w.x = cvt_pk_bf16(o[0], o[1]); w.y = cvt_pk_bf16(o[2], o[3]); w.z = cvt_pk_bf16(o[4], o[5]); w.w = cvt_pk_bf16(o[6], o[7]);
            *(u32x4*)(Y + row * D + col0 + bj * 128) = w; }
    }
};
struct EpiOut {
    static constexpr bool PERM = true;
    bf16* C; float* RSS;
    DEV void operator()(const f32x4 (&acc)[2][2][4][2], const pg8::Unit& u, int wr, int wc, int fr, int fq) const {
        const int row0 = u.pm * 256 + wr * 64 + fr, col0 = u.pn * 256 + wc * 32 + 8 * fq;
#pragma unroll
        for (int ai = 0; ai < 2; ++ai)
#pragma unroll
            for (int m = 0; m < 4; ++m) { const size_t row = (size_t)(row0 + ai * 128 + m * 16); bf16* rowp = C + row * D + col0; float ss = 0.f;
#pragma unroll
                for (int bj = 0; bj < 2; ++bj) { const f32x4 v0 = acc[ai][bj][m][0], v1 = acc[ai][bj][m][1];
                    ss += ((v0[0] * v0[0] + v0[1] * v0[1]) + (v0[2] * v0[2] + v0[3] * v0[3])) + ((v1[0] * v1[0] + v1[1] * v1[1]) + (v1[2] * v1[2] + v1[3] * v1[3]));
                    u32x4 w; w.x = cvt_pk_bf16(v0[0], v0[1]); w.y = cvt_pk_bf16(v0[2], v0[3]); w.z = cvt_pk_bf16(v1[0], v1[1]); w.w = cvt_pk_bf16(v1[2], v1[3]);
                    *(u32x4*)(rowp + bj * 128) = w; }
                ss += __shfl_xor(ss, 16); ss += __shfl_xor(ss, 32);
                if (fq == 0) RSS[row * NRS + u.pn * 4 + wc] = ss; }
    }
};

#ifndef EMU
typedef GAS unsigned gu32;
#define RLX_AGENT __ATOMIC_RELAXED, __HIP_MEMORY_SCOPE_AGENT
#define XB_TMO      128
#define XB_XCNT(j)  (256  + 64 * (j))
#define XB_XSUB(j)  (1280 + 64 * (j))
#define XB_XGEN(j)  (2304 + 64 * (j))
#define XB_TOP      3328
#define XB_TOPGEN   3392
#define XCD_BAR_WORDS 3456
#define XB_SPIN_CAP (1u << 22)
__device__ __forceinline__ unsigned xb_ld(unsigned* p)              { return __hip_atomic_load(p, __ATOMIC_RELAXED, __HIP_MEMORY_SCOPE_AGENT); }
__device__ __forceinline__ unsigned xb_add(unsigned* p, unsigned v) { return __hip_atomic_fetch_add(p, v, __ATOMIC_RELAXED, __HIP_MEMORY_SCOPE_AGENT); }
__device__ __forceinline__ unsigned xb_xcc_id() { return (unsigned)__builtin_amdgcn_s_getreg((3 << 11) | 20) & 0xFu; }
#define XB_SPIN(cond, bar) do { unsigned _sp = 0; while (cond) { __builtin_amdgcn_s_sleep(1); \
    if ((++_sp & 255u) == 0u) { if (xb_ld(&(bar)[XB_TMO])) break; if (_sp > XB_SPIN_CAP) { atomicAdd(&(bar)[XB_TMO], 1u); break; } } } } while (0)
struct XcdBarrier { unsigned* bar; unsigned x; volatile LAS unsigned* st; };
__device__ __forceinline__ XcdBarrier xcd_barrier_post(unsigned* bar, volatile LAS unsigned* st) {
    XcdBarrier b; b.bar = bar; b.x = xb_xcc_id(); b.st = st;
    if (threadIdx.x == 0) (void)xb_add(&bar[XB_XCNT(b.x)], 1u);
    return b;
}
__device__ __forceinline__ void xcd_barrier_complete(unsigned* bar, unsigned x, unsigned& nloc, unsigned& nx) {
    const unsigned G = gridDim.x * gridDim.y * gridDim.z;
    unsigned sum, cnt, mine, sp = 0u;
    for (;;) {
        sum = 0u; cnt = 0u; mine = 0u;
#pragma unroll
        for (unsigned j = 0; j < 16; ++j) { const unsigned c = xb_ld(&bar[XB_XCNT(j)]); sum += c; cnt += (c > 0u) ? 1u : 0u; mine = (j == x) ? c : mine; }
        if (sum == G) break;
        __builtin_amdgcn_s_sleep(1);
        if ((++sp & 255u) == 0u) { if (xb_ld(&bar[XB_TMO])) break; if (sp > XB_SPIN_CAP) { atomicAdd(&bar[XB_TMO], 1u); break; } }
    }
    nloc = mine > 0u ? mine : 1u; nx = cnt > 0u ? cnt : 1u;
}
__device__ __forceinline__ void xcd_barrier(const XcdBarrier& b) {
    asm volatile("s_waitcnt vmcnt(0)" ::: "memory");
    __syncthreads();
    if (threadIdx.x == 0) {
        unsigned* bar = b.bar;
        __builtin_amdgcn_s_waitcnt(0);
        unsigned nloc = b.st[0], nx = b.st[1];
        if (nloc == 0u) { xcd_barrier_complete(bar, b.x, nloc, nx); b.st[0] = nloc; b.st[1] = nx; }
        const unsigned old = xb_add(&bar[XB_XSUB(b.x)], 1u);
        const unsigned gen = old / nloc;
        if (old + 1u == (gen + 1u) * nloc) {
            __builtin_amdgcn_fence(__ATOMIC_RELEASE, "agent");
            asm volatile("s_waitcnt vmcnt(0)" ::: "memory");
            const unsigned og = xb_add(&bar[XB_TOP], 1u);
            const unsigned tg = og / nx;
            if (og + 1u == (tg + 1u) * nx) xb_add(&bar[XB_TOPGEN], 1u);
            else XB_SPIN(xb_ld(&bar[XB_TOPGEN]) == tg, bar);
            __builtin_amdgcn_fence(__ATOMIC_ACQUIRE, "agent");
            xb_add(&bar[XB_XGEN(b.x)], 1u);
            asm volatile("s_waitcnt vmcnt(0)" ::: "memory");
        } else {
            XB_SPIN(xb_ld(&bar[XB_XGEN(b.x)]) == gen, bar);
            __builtin_amdgcn_fence(__ATOMIC_ACQUIRE, "agent");
            asm volatile("s_waitcnt vmcnt(0)" ::: "memory");
        }
    }
    __syncthreads();
}
#endif

struct Args { const float* in[14]; float* out; unsigned char* ws; int ph_lo, ph_hi; };

DEV float clamp8(float x) { return fminf(fmaxf(x, -448.0f), 448.0f); }
struct P0Desc { const float* W; void* WT; int ldw, K, k0, c0, r0, nv, fp8; void* WT8; int r08; };
DEV void p0_load(const P0Desc& d, int lane, f32x4 (&v)[16]) {
    const int kr = lane >> 4, n4 = 4 * (lane & 15);
#pragma unroll
    for (int i = 0; i < 16; ++i) v[i] = (n4 < d.nv) ? *(const f32x4*)(d.W + (size_t)(d.k0 + 4 * i + kr) * d.ldw + d.c0 + n4) : (f32x4){0.f, 0.f, 0.f, 0.f};
}
DEV void p0_store(const P0Desc& d, const f32x4 (&v)[16], ldsp scr, int lane) {
    const int kr = lane >> 4, n4 = 4 * (lane & 15);
#pragma unroll
    for (int i = 0; i < 16; ++i) LDS_WR(f32x4, scr + ((4 * i + kr) * 68 + n4) * 4, v[i]);
    WAVE_SYNC();
    if (d.fp8 != 1) {
        bf16* WT = (bf16*)d.WT;
        const int c = lane & 7;
#pragma unroll
        for (int j = 0; j < 8; ++j) { const int n = (lane >> 3) + 8 * j; ldsp sp = scr + ((8 * c) * 68 + n) * 4;
            u32x4 o; o.x = pk2(LDS_RD(float, sp + 0 * 272), LDS_RD(float, sp + 1 * 272)); o.y = pk2(LDS_RD(float, sp + 2 * 272), LDS_RD(float, sp + 3 * 272));
            o.z = pk2(LDS_RD(float, sp + 4 * 272), LDS_RD(float, sp + 5 * 272)); o.w = pk2(LDS_RD(float, sp + 6 * 272), LDS_RD(float, sp + 7 * 272));
            if (n < d.nv) *(u32x4*)(WT + (size_t)(d.r0 + n) * d.K + d.k0 + 8 * c) = o; }
    }
    if (d.fp8 != 0) {
        unsigned char* WT = (unsigned char*)(d.fp8 == 2 ? d.WT8 : d.WT); const int r8 = d.fp8 == 2 ? d.r08 : d.r0, K8 = d.fp8 == 2 ? D : d.K;
        const int c = lane & 3;
#pragma unroll
        for (int j = 0; j < 4; ++j) { const int n = (lane >> 2) + 16 * j; ldsp sp = scr + ((16 * c) * 68 + n) * 4; float f[16];
#pragma unroll
            for (int i = 0; i < 16; ++i) f[i] = clamp8(LDS_RD(float, sp + i * 272) * W8_SCALE);
            u32x4 o; o.x = pk_fp8x4(f[0], f[1], f[2], f[3]); o.y = pk_fp8x4(f[4], f[5], f[6], f[7]); o.z = pk_fp8x4(f[8], f[9], f[10], f[11]); o.w = pk_fp8x4(f[12], f[13], f[14], f[15]);
            if (n < d.nv) *(u32x4*)(WT + (size_t)(r8 + n) * K8 + d.k0 + 16 * c) = o; }
    }
    WAVE_SYNC();
}

constexpr int MS = 272, MS64 = 144;
constexpr int NUA = NB * HA * NCH, NUB = NB * HB * NCH;
constexpr size_t TW_QA = 0, TW_KA = TW_QA + (size_t)NUA * 16384, TW_PA = TW_KA + (size_t)NUA * 16384, TW_VA = TW_PA + (size_t)NUA * 8192, TW_ENDA = TW_VA + (size_t)NUA * 2048;
constexpr size_t TW_QB = 0, TW_KB = TW_QB + (size_t)NUB * 16384, TW_PB = TW_KB + (size_t)NUB * 16384, TW_SB = TW_PB + (size_t)NUB * 8192, TW_ENDB = TW_SB + (size_t)NUB * 2048;
static_assert(TW_ENDA <= (size_t)(NP + 16) * D * 2 && TW_ENDB <= (size_t)M * D * 2, "operand tiles must fit the dead W1T / h regions");
DEV int swz(int row, int chunk) { return row * 256 + ((chunk ^ (row & 15)) << 4); }
DEV int swz64(int row, int chunk) { return row * 128 + ((chunk ^ (row & 7)) << 4); }
DEV bf16x8 frag16p(ldsp img, int row0, int ks, int lane) { return LDS_RD(bf16x8, img + swz64(row0 + (lane & 15), 4 * ks + (lane >> 4))); }

DEV bf16x8 frag16(ldsp buf, int stride, int row0, int ks, int lane) { return LDS_RD(bf16x8, buf + (row0 + (lane & 15)) * stride + ks * 64 + (lane >> 4) * 16); }
DEV bf16x8 frag16s(ldsp img, int row0, int ks, int lane) { return LDS_RD(bf16x8, img + swz(row0 + (lane & 15), 4 * ks + (lane >> 4))); }
DEV bf16x8 frag8x2s(ldsp img, int row0, int ks, int lane) {
    const int row = row0 + (lane & 15), q = lane >> 4;
    const bf16x4 lo = LDS_RD(bf16x4, img + swz(row, 4 * ks + (q >> 1)) + (q & 1) * 8), hi = LDS_RD(bf16x4, img + swz(row, 4 * ks + 2 + (q >> 1)) + (q & 1) * 8);
    return (bf16x8){lo[0], lo[1], lo[2], lo[3], hi[0], hi[1], hi[2], hi[3]};
}
DEV bf16x8 frag_tr(ldsp img, int n0, int ks, int lane, int stride = 256) {
    ldsp p = img + (32 * ks + 8 * (lane >> 4) + ((lane & 15) >> 2)) * stride + (n0 + 4 * (lane & 3)) * 2;
    const bf16x4 lo = lds_tr16(p), hi = lds_tr16(p + 4 * stride);
    return (bf16x8){lo[0], lo[1], lo[2], lo[3], hi[0], hi[1], hi[2], hi[3]};
}
DEV bf16x8 frag_trs(ldsp img, int n0, int ks, int lane) {
    const int row = 32 * ks + 8 * (lane >> 4) + ((lane & 15) >> 2), p = lane & 3, ch = (n0 >> 3) + (p >> 1);
    const bf16x4 lo = lds_tr16(img + swz(row, ch) + (p & 1) * 8), hi = lds_tr16(img + swz(row + 4, ch) + (p & 1) * 8);
    return (bf16x8){lo[0], lo[1], lo[2], lo[3], hi[0], hi[1], hi[2], hi[3]};
}
DEV void dma_lin(const void* src, int ninst, ldsp dst, int wave, int lane) {
    for (int i = wave; i < ninst; i += NWAVES) GLDS16X((const char*)src + i * 1024 + 16 * lane, dst + i * 1024);
}
DEV float sigm2(float x) { return frcp(1.0f + fexp2(-LOG2E * x)); }
DEV u32x2 pack4(const f32x4 v) { u32x2 w; w.x = cvt_pk_bf16(v[0], v[1]); w.y = cvt_pk_bf16(v[2], v[3]); return w; }

DEV float scan_add(float v, int lane) {
#pragma unroll
    for (int o = 1; o < 64; o <<= 1) { const float t = __shfl_up(v, o); if (lane >= o) v += t; }
    return v;
}
DEV float scan_max(float v, int lane) {
#pragma unroll
    for (int o = 1; o < 64; o <<= 1) { const float t = __shfl_up(v, o); if (lane >= o) v = fmaxf(v, t); }
    return v;
}

constexpr int PA_RAW = 0, PA_RAWSZ = 2 * 68 * 256, PA_TOT = 2 * PA_RAWSZ, PA_IQ = PA_TOT + 8 * 128 * 4, PA_IK = PA_IQ + 16384, PA_SC = PA_IK + 16384, PA_END = PA_SC + 1024;
static_assert(PA_END <= RING_BYTES, "P2 LDS");
DEV void p2_issue(const Args& args, int u, ldsp raw, int wave, int lane) {
    const bf16* P = (const bf16*)(args.ws + WS_P);
    if (u < NUA) { const int bh = u / NCH, j = u % NCH, b = bh / HA, h = bh % HA; const size_t tok0 = (size_t)b * SEQ + 64 * j;
        dma_lin(P + p_off(tok0, C_QA + h * 128), 16, raw, wave, lane); dma_lin(P + p_off(tok0, C_FA + h * 128), 16, raw + 68 * 256, wave, lane); }
    else { const int ub = u - NUA, bh = ub / NCH, j = ub % NCH, b = bh / HB, h = bh % HB; const size_t tok0 = (size_t)b * SEQ + 64 * j;
        dma_lin(P + p_off(tok0, C_QB + h * 128) - 3 * 128, 17, raw, wave, lane); dma_lin(P + p_off(tok0, C_KB + h * 128) - 3 * 128, 17, raw + 68 * 256, wave, lane); }
}
DEV void p2_scores(ldsp lds, f32x4 (&sc)[2], int wave, int lane) {
    const int ct = wave >> 1, st0 = 2 * (wave & 1);
    sc[0] = (f32x4){0.f, 0.f, 0.f, 0.f}; sc[1] = (f32x4){0.f, 0.f, 0.f, 0.f};
#pragma unroll
    for (int ks = 0; ks < 4; ++ks) { const bf16x8 qf = frag16s(lds + PA_IQ, 16 * ct, ks, lane);
#pragma unroll
        for (int n = 0; n < 2; ++n) { const bf16x8 kf_ = frag16s(lds + PA_IK, 16 * (st0 + n), ks, lane); sc[n] = MFMA16(kf_, qf, sc[n]); } }
}
DEV void p2_unit(const Args& args, ldsp lds, int u, ldsp raw, int wave, int lane) {
    unsigned char* TW = args.ws + WS_W1T;
    const int q4 = lane >> 4, l15 = lane & 15;
    if (u < NUA) {
        const int bh = u / NCH, h = bh % HA;
        const float* lbl = args.in[3];
        float lbv[2];
#pragma unroll
        for (int e = 0; e < 2; ++e) { const int col = h * 128 + 2 * lane + e; lbv[e] = frcp(1.0f + fexp(lbl[DA + col] - lbl[col])); }
        float lf[8][2], qv[8][2], kv[8][2];
#pragma unroll
        for (int c = 0; c < 8; ++c) { const unsigned qw = LDS_RD(unsigned, raw + (8 * wave + c) * 256 + lane * 4), fw = LDS_RD(unsigned, raw + 68 * 256 + (8 * wave + c) * 256 + lane * 4);
#pragma unroll
            for (int e = 0; e < 2; ++e) { const float f = lbv[e] + (1.0f - lbv[e]) * sigm2(__builtin_bit_cast(float, e ? (fw & 0xffff0000u) : (fw << 16))); lf[c][e] = flog2(f); kv[c][e] = 1.0f - f; qv[c][e] = __builtin_bit_cast(float, e ? (qw & 0xffff0000u) : (qw << 16)); } }
#pragma unroll
        for (int c = 1; c < 8; ++c) { lf[c][0] += lf[c - 1][0]; lf[c][1] += lf[c - 1][1]; }
        LDS_WR(f32x2, lds + PA_TOT + (wave * 128 + 2 * lane) * 4, ((f32x2){lf[7][0], lf[7][1]}));
        MIX_BAR();
        f32x2 off = (f32x2){0.f, 0.f}, bmid = (f32x2){0.f, 0.f}, g = (f32x2){0.f, 0.f};
#pragma unroll
        for (int w = 0; w < 8; ++w) { const f32x2 t = LDS_RD(f32x2, lds + PA_TOT + (w * 128 + 2 * lane) * 4); if (w < wave) off += t; if (w < 4) bmid += t; g += t; }
        if (wave == 0) { float* vec = (float*)(TW + TW_VA + (size_t)u * 2048) + 2 * lane;
            *(f32x2*)vec = (f32x2){fexp2(bmid[0]), fexp2(bmid[1])}; *(f32x2*)(vec + 128) = (f32x2){fexp2(g[0]), fexp2(g[1])}; *(f32x2*)(vec + 256) = (f32x2){fexp2(g[0] - bmid[0]), fexp2(g[1] - bmid[1])}; }
        unsigned qr8[8], kr8[8];
#pragma unroll
        for (int c = 0; c < 8; ++c) { float qr[2], kk[2]; const int r = 8 * wave + c;
#pragma unroll
            for (int e = 0; e < 2; ++e) { const float t1 = lf[c][e] + off[e] - bmid[e]; qr[e] = qv[c][e] * fexp2(t1); kk[e] = kv[c][e] * fexp2(-t1); }
            qr8[c] = cvt_pk_bf16(qr[0], qr[1]); kr8[c] = cvt_pk_bf16(kk[0], kk[1]);
            LDS_WR(unsigned, lds + PA_IQ + swz(r, lane >> 2) + (lane & 3) * 4, qr8[c]); LDS_WR(unsigned, lds + PA_IK + swz(r, lane >> 2) + (lane & 3) * 4, kr8[c]); }
        MIX_BAR();
        f32x4 sc[2]; p2_scores(lds, sc, wave, lane);
        unsigned char* tq = TW + TW_QA + (size_t)u * 16384; unsigned char* tk = TW + TW_KA + (size_t)u * 16384; unsigned char* tp = TW + TW_PA + (size_t)u * 8192;
#pragma unroll
        for (int c = 0; c < 8; ++c) { const int r = 8 * wave + c; *(unsigned*)(tq + swz(r, lane >> 2) + (lane & 3) * 4) = qr8[c]; *(unsigned*)(tk + swz(r, lane >> 2) + (lane & 3) * 4) = kr8[c]; }
#pragma unroll
        for (int n = 0; n < 2; ++n) { const int c = 16 * (wave >> 1) + l15, s0_ = 16 * (2 * (wave & 1) + n) + 4 * q4; f32x4 v = sc[n];
#pragma unroll
            for (int r = 0; r < 4; ++r) v[r] = (s0_ + r <= c) ? v[r] : 0.f;
            *(u32x2*)(tp + swz64(c, s0_ >> 3) + (q4 & 1) * 8) = pack4(v); }
    } else {
        const int ub = u - NUA, bh = ub / NCH, j = ub % NCH, b = bh / HB, h = bh % HB;
        const float* cw = args.in[4]; const float* cb = args.in[5];
        f32x2 wq[4], wk[4];
#pragma unroll
        for (int k = 0; k < 4; ++k) { wq[k] = *(const f32x2*)(cw + k * (2 * DQK) + h * 128 + 2 * lane); wk[k] = *(const f32x2*)(cw + k * (2 * DQK) + DQK + h * 128 + 2 * lane); }
        const f32x2 bq = *(const f32x2*)(cb + h * 128 + 2 * lane), bk = *(const f32x2*)(cb + DQK + h * 128 + 2 * lane);
        unsigned uq[11], uk[11];
#pragma unroll
        for (int i = 0; i < 11; ++i) { const bool neg = (64 * j + 8 * wave + i - 3) < 0;
            const unsigned a = LDS_RD(unsigned, raw + (8 * wave + i) * 256 + lane * 4), bb = LDS_RD(unsigned, raw + 68 * 256 + (8 * wave + i) * 256 + lane * 4); uq[i] = neg ? 0u : a; uk[i] = neg ? 0u : bb; }
        unsigned char* TWB = args.ws + WS_HB;
        float* sb = (float*)(TWB + TW_SB + (size_t)ub * 2048);
        if (wave == 0) {
            const size_t tok = (size_t)b * SEQ + 64 * j + lane; const float* SG = (const float*)(args.ws + WS_SG);
            const float fp = SG[tok * 16 + HB + h] + args.in[7][h], ig = SG[tok * 16 + h] + args.in[6][h];
            const float bc = scan_add(logsig(fp), lane), a = ig - bc, pm = scan_max(a, lane);
            sb[lane] = pm; sb[64 + lane] = bc;
            LDS_WR(float, lds + PA_SC + lane * 4, a * LOG2E); LDS_WR(float, lds + PA_SC + 256 + lane * 4, pm * LOG2E);
        }
        unsigned q8[8]; float kf[8][2];
#pragma unroll
        for (int c = 0; c < 8; ++c) { float qq[2]; const int r = 8 * wave + c;
#pragma unroll
            for (int e = 0; e < 2; ++e) { float yq = bq[e], yk = bk[e];
#pragma unroll
                for (int k = 0; k < 4; ++k) { yq += wq[k][e] * __builtin_bit_cast(float, e ? (uq[c + k] & 0xffff0000u) : (uq[c + k] << 16)); yk += wk[k][e] * __builtin_bit_cast(float, e ? (uk[c + k] & 0xffff0000u) : (uk[c + k] << 16)); }
                qq[e] = yq * sigm2(yq); kf[c][e] = yk * sigm2(yk) * 0.08838834764831845f; }
            q8[c] = cvt_pk_bf16(qq[0], qq[1]);
            LDS_WR(unsigned, lds + PA_IQ + swz(r, lane >> 2) + (lane & 3) * 4, q8[c]); LDS_WR(unsigned, lds + PA_IK + swz(r, lane >> 2) + (lane & 3) * 4, cvt_pk_bf16(kf[c][0], kf[c][1])); }
        MIX_BAR();
        const float pm63 = LDS_RD(float, lds + PA_SC + 256 + 63 * 4);
        unsigned kw8[8]; float na[2] = {0.f, 0.f};
#pragma unroll
        for (int c = 0; c < 8; ++c) { const float w_ = fexp2(LDS_RD(float, lds + PA_SC + (8 * wave + c) * 4) - pm63); const float k0 = w_ * kf[c][0], k1 = w_ * kf[c][1]; na[0] += k0; na[1] += k1; kw8[c] = cvt_pk_bf16(k0, k1); }
        LDS_WR(f32x2, lds + PA_TOT + (wave * 128 + 2 * lane) * 4, ((f32x2){na[0], na[1]}));
        f32x4 sc[2]; p2_scores(lds, sc, wave, lane);
        const int ct = wave >> 1, st0 = 2 * (wave & 1), c_ = 16 * ct + l15;
        const float pmc = LDS_RD(float, lds + PA_SC + 256 + c_ * 4); float rs = 0.f; u32x2 pw[2];
#pragma unroll
        for (int n = 0; n < 2; ++n) { const int s0_ = 16 * (st0 + n) + 4 * q4; const f32x4 as = LDS_RD(f32x4, lds + PA_SC + s0_ * 4); f32x4 v;
#pragma unroll
            for (int r = 0; r < 4; ++r) { const float t = fexp2(as[r] - pmc) * sc[n][r]; v[r] = (s0_ + r <= c_) ? t : 0.f; rs += v[r]; }
            pw[n] = pack4(v); }
        rs += __shfl_xor(rs, 16); rs += __shfl_xor(rs, 32);
        MIX_BAR();
        if (wave < 2) { const int dcol = wave * 64 + lane; float nl = 0.f;
#pragma unroll
            for (int w = 0; w < 8; ++w) nl += LDS_RD(float, lds + PA_TOT + (w * 128 + dcol) * 4);
            sb[256 + dcol] = nl; }
        if (q4 == 0) sb[128 + c_ * 2 + (wave & 1)] = rs;
        unsigned char* tq = TWB + TW_QB + (size_t)ub * 16384; unsigned char* tk = TWB + TW_KB + (size_t)ub * 16384; unsigned char* tp = TWB + TW_PB + (size_t)ub * 8192;
#pragma unroll
        for (int c = 0; c < 8; ++c) { const int r = 8 * wave + c; *(unsigned*)(tq + swz(r, lane >> 2) + (lane & 3) * 4) = q8[c]; *(unsigned*)(tk + swz(r, lane >> 2) + (lane & 3) * 4) = kw8[c]; }
#pragma unroll
        for (int n = 0; n < 2; ++n) { const int s0_ = 16 * (st0 + n) + 4 * q4; *(u32x2*)(tp + swz64(c_, s0_ >> 3) + (q4 & 1) * 8) = pw[n]; }
    }
}

constexpr int PB_BUFSZ = 51200, PB_Q = 0, PB_K = 16384, PB_V = 32768, PB_P = 40960, PB_VEC = 49152;
constexpr int PB_XS = 2 * PB_BUFSZ, PB_SM = PB_XS + 2 * 16384;
constexpr int SM_SSQ = PB_SM;
constexpr int SM_R = SM_SSQ + 2 * 64 * 4 * 4, SM_INT = SM_R + 256, SM_EMT = SM_INT + 256, SM_RS = SM_EMT + 256, SM_SCAL = SM_RS + 256;
constexpr int SM_NV = SM_SCAL + 64, SM_QN = SM_NV + 512, MX_END = SM_QN + 256;
static_assert(MX_END <= RING_BYTES, "mixer LDS");
DEV void dma_rows64(const void* src, ldsp dst, int wave, int lane) { GLDS16S((const char*)src + wave * 2048, (lane >> 3) * 256 + (lane & 7) * 16, dst + wave * 1024); }

DEV void mixer_a_job(const Args& args, ldsp lds, int b, int h, int vh, int tid_) {
    const int wave = RFL(tid_ >> 6), vt = wave & 3, hf = wave >> 2;
    const bf16* P = (const bf16*)(args.ws + WS_P);
    const unsigned char* TW = args.ws + WS_W1T;
    const rsrc_t RO = make_rsrc(args.ws + WS_OAB, (unsigned)((size_t)2 * M * LDU * 2));
    float* SSA = (float*)(args.ws + WS_SSA);
    const int u0 = (b * HA + h) * NCH, vcol = h * 128 + 64 * vh;
    f32x4 st[4], o[2];
#pragma unroll
    for (int t = 0; t < 4; ++t) st[t] = (f32x4){0.f, 0.f, 0.f, 0.f};
    o[0] = (f32x4){0.f, 0.f, 0.f, 0.f}; o[1] = (f32x4){0.f, 0.f, 0.f, 0.f};
    { const u32x4 z = (u32x4){0u, 0u, 0u, 0u}; const int lane = tid_ & 63;
        LDS_WR(u32x4, lds + PB_XS + 16384 + (vt * 2 + hf) * 2048 + lane * 16, z); LDS_WR(u32x4, lds + PB_XS + 16384 + (vt * 2 + hf) * 2048 + 1024 + lane * 16, z); }
#define MA_DMA(jj) do { ldsp bf_ = lds + ((jj) & 1) * PB_BUFSZ; const size_t uu_ = (size_t)(u0 + (jj)); \
        dma_lin(TW + TW_QA + uu_ * 16384, 16, bf_ + PB_Q, wave, lane); dma_lin(TW + TW_KA + uu_ * 16384, 16, bf_ + PB_K, wave, lane); \
        dma_rows64(P + p_off((size_t)b * SEQ + 64 * (jj), C_IA + h * 128) + 64 * vh, bf_ + PB_V, wave, lane); dma_lin(TW + TW_PA + uu_ * 8192, 8, bf_ + PB_P, wave, lane); dma_lin(TW + TW_VA + uu_ * 2048, 2, bf_ + PB_VEC, wave, lane); } while (0)
    { const int lane = tid_ & 63; MA_DMA(0); }
    for (int j = 0; j <= NCH; ++j) {
        int tidj = tid_; OPAQUE(tidj);
        const int lane = tidj & 63, q4 = lane >> 4, l15 = lane & 15;
        const size_t tk0 = (size_t)b * SEQ + 64 * j;
        if (j <= 1) WAIT_V(0); else WAIT_V(2);
        MIX_BAR();
        if (j + 1 < NCH) MA_DMA(j + 1);
        if (j > 0) {
            if (wave == 0) { const f32x4 s0 = LDS_RD(f32x4, lds + SM_SSQ + ((j - 1) & 1) * 1024 + lane * 16); SSA[((tk0 - 64 + lane) * HA + h) * 2 + vh] = (s0[0] + s0[1]) + (s0[2] + s0[3]); }
#pragma unroll
            for (int i = 0; i < 2; ++i) bstore64(RO, (unsigned)(l15 * LDU + vcol + 16 * vt + 4 * q4) * 2u, (unsigned)(tk0 - 64 + 16 * (2 * hf + i)) * (unsigned)(LDU * 2), pack4(o[i]));
        }
        if (j == NCH) break;
        ldsp bf = lds + (j & 1) * PB_BUFSZ;
        bf16x8 bv[2], pf[2][2], qo[2][2], qp[2][2], so[2], sp[2];
#pragma unroll
        for (int ks = 0; ks < 2; ++ks) bv[ks] = frag_tr(bf + PB_V, 16 * vt, ks, lane, 128);
#pragma unroll
        for (int ks = 0; ks < 2; ++ks)
#pragma unroll
            for (int i = 0; i < 2; ++i) pf[ks][i] = frag16p(bf + PB_P, 16 * (2 * hf + i), ks, lane);
#pragma unroll
        for (int kl = 0; kl < 2; ++kl)
#pragma unroll
            for (int i = 0; i < 2; ++i) { qo[kl][i] = frag8x2s(bf + PB_Q, 16 * (2 * hf + i), 2 * hf + kl, lane); qp[kl][i] = frag8x2s(bf + PB_Q, 16 * (2 * hf + i), 2 * (hf ^ 1) + kl, lane); }
        u32x4 xp[2];
#pragma unroll
        for (int kl = 0; kl < 2; ++kl) xp[kl] = LDS_RD(u32x4, lds + PB_XS + ((j + 1) & 1) * 16384 + (vt * 2 + (hf ^ 1)) * 2048 + kl * 1024 + lane * 16);
        f32x4 eo[4], ep[4];
#pragma unroll
        for (int t = 0; t < 4; ++t) { eo[t] = LDS_RD(f32x4, bf + PB_VEC + (16 * (4 * hf + t) + 4 * q4) * 4); ep[t] = LDS_RD(f32x4, bf + PB_VEC + (16 * (4 * (hf ^ 1) + t) + 4 * q4) * 4); }
        SCHED_BAR();
#pragma unroll
        for (int kl = 0; kl < 2; ++kl) {
            { u32x4 w; const f32x4 a0 = st[2 * kl] * eo[2 * kl], a1 = st[2 * kl + 1] * eo[2 * kl + 1]; w.x = cvt_pk_bf16(a0[0], a0[1]); w.y = cvt_pk_bf16(a0[2], a0[3]); w.z = cvt_pk_bf16(a1[0], a1[1]); w.w = cvt_pk_bf16(a1[2], a1[3]);
              so[kl] = __builtin_bit_cast(bf16x8, w); }
            { u32x4 w; const f32x4 e0 = ep[2 * kl], e1 = ep[2 * kl + 1]; const u32x4 x = xp[kl];
              w.x = cvt_pk_bf16(__builtin_bit_cast(float, x.x << 16) * e0[0], __builtin_bit_cast(float, x.x & 0xffff0000u) * e0[1]); w.y = cvt_pk_bf16(__builtin_bit_cast(float, x.y << 16) * e0[2], __builtin_bit_cast(float, x.y & 0xffff0000u) * e0[3]);
              w.z = cvt_pk_bf16(__builtin_bit_cast(float, x.z << 16) * e1[0], __builtin_bit_cast(float, x.z & 0xffff0000u) * e1[1]); w.w = cvt_pk_bf16(__builtin_bit_cast(float, x.w << 16) * e1[2], __builtin_bit_cast(float, x.w & 0xffff0000u) * e1[3]);
              sp[kl] = __builtin_bit_cast(bf16x8, w); } }
        o[0] = (f32x4){0.f, 0.f, 0.f, 0.f}; o[1] = (f32x4){0.f, 0.f, 0.f, 0.f};
#pragma unroll
        for (int ks = 0; ks < 2; ++ks)
#pragma unroll
            for (int i = 0; i < 2; ++i) o[i] = MFMA16(bv[ks], pf[ks][i], o[i]);
#pragma unroll
        for (int kl = 0; kl < 2; ++kl)
#pragma unroll
            for (int i = 0; i < 2; ++i) { o[i] = MFMA16(so[kl], qo[kl][i], o[i]); o[i] = MFMA16(sp[kl], qp[kl][i], o[i]); }
#pragma unroll
        for (int i = 0; i < 4; ++i) { const int t = 4 * hf + i;
            f32x4 u = (f32x4){0.f, 0.f, 0.f, 0.f};
#pragma unroll
            for (int ks = 0; ks < 2; ++ks) { const bf16x8 a = frag_trs(bf + PB_K, 16 * t, ks, lane); u = MFMA16(a, bv[ks], u); }
            const f32x4 eg = LDS_RD(f32x4, bf + PB_VEC + 512 + (16 * t + 4 * q4) * 4), egm = LDS_RD(f32x4, bf + PB_VEC + 1024 + (16 * t + 4 * q4) * 4); st[i] = eg * st[i] + egm * u; }
#pragma unroll
        for (int kl = 0; kl < 2; ++kl) { u32x4 w; const f32x4 a0 = st[2 * kl], a1 = st[2 * kl + 1]; w.x = cvt_pk_bf16(a0[0], a0[1]); w.y = cvt_pk_bf16(a0[2], a0[3]); w.z = cvt_pk_bf16(a1[0], a1[1]); w.w = cvt_pk_bf16(a1[2], a1[3]);
            LDS_WR(u32x4, lds + PB_XS + (j & 1) * 16384 + (vt * 2 + hf) * 2048 + kl * 1024 + lane * 16, w); }
#pragma unroll
        for (int i = 0; i < 2; ++i) { float s_ = (o[i][0] * o[i][0] + o[i][1] * o[i][1]) + (o[i][2] * o[i][2] + o[i][3] * o[i][3]); s_ += __shfl_xor(s_, 16); s_ += __shfl_xor(s_, 32);
            LDS_WR(float, lds + SM_SSQ + (j & 1) * 1024 + ((16 * (2 * hf + i) + l15) * 4 + vt) * 4, s_); }
    }
#undef MA_DMA
}

DEV void mixer_b_job(const Args& args, ldsp lds, int b, int h, int vq, int tid_) {
    const int wave = RFL(tid_ >> 6), vt = wave & 3, hf = wave >> 2;
    const int vbase = h * 256 + 64 * vq;
    const bf16* P = (const bf16*)(args.ws + WS_P);
    const unsigned char* TW = args.ws + WS_HB;
    const rsrc_t RO = make_rsrc(args.ws + WS_OAB, (unsigned)((size_t)2 * M * LDU * 2));
    float* SSB = (float*)(args.ws + WS_SSB);
    const int u0 = (b * HB + h) * NCH;
    f32x4 st[4], hv[2];
#pragma unroll
    for (int t = 0; t < 4; ++t) st[t] = (f32x4){0.f, 0.f, 0.f, 0.f};
    hv[0] = (f32x4){0.f, 0.f, 0.f, 0.f}; hv[1] = (f32x4){0.f, 0.f, 0.f, 0.f};
    float mcar = 0.f;
    if (wave < 2) LDS_WR(float, lds + SM_NV + tid_ * 4, 0.f);
    { const u32x4 z = (u32x4){0u, 0u, 0u, 0u}; const int lane = tid_ & 63;
        LDS_WR(u32x4, lds + PB_XS + 16384 + (vt * 2 + hf) * 2048 + lane * 16, z); LDS_WR(u32x4, lds + PB_XS + 16384 + (vt * 2 + hf) * 2048 + 1024 + lane * 16, z); }
#define MB_DMA(jj) do { ldsp bf_ = lds + ((jj) & 1) * PB_BUFSZ; const size_t uu_ = (size_t)(u0 + (jj)); \
        dma_lin(TW + TW_QB + uu_ * 16384, 16, bf_ + PB_Q, wave, lane); dma_lin(TW + TW_KB + uu_ * 16384, 16, bf_ + PB_K, wave, lane); \
        dma_rows64(P + p_off((size_t)b * SEQ + 64 * (jj), C_VB + h * 256 + 128 * (vq >> 1)) + 64 * (vq & 1), bf_ + PB_V, wave, lane); dma_lin(TW + TW_PB + uu_ * 8192, 8, bf_ + PB_P, wave, lane); dma_lin(TW + TW_SB + uu_ * 2048, 2, bf_ + PB_VEC, wave, lane); } while (0)
    { const int lane = tid_ & 63; MB_DMA(0); }
    for (int j = 0; j <= NCH; ++j) {
        const size_t tk0 = (size_t)b * SEQ + 64 * j;
        int tidj = tid_; OPAQUE(tidj);
        const int tid = tidj, lane = tidj & 63, q4 = lane >> 4, l15 = lane & 15;
        if (j <= 1) WAIT_V(0); else WAIT_V(2);
        MIX_BAR();
        if (j + 1 < NCH) MB_DMA(j + 1);
        if (j > 0) {
            if (wave == 0) { const f32x4 s0 = LDS_RD(f32x4, lds + SM_SSQ + ((j - 1) & 1) * 1024 + lane * 16); SSB[((tk0 - 64 + lane) * HB + h) * 4 + vq] = (s0[0] + s0[1]) + (s0[2] + s0[3]); }
#pragma unroll
            for (int i = 0; i < 2; ++i) bstore64(RO, (unsigned)(l15 * LDU + vbase + 16 * vt + 4 * q4) * 2u, (unsigned)(M + tk0 - 64 + 16 * (2 * hf + i)) * (unsigned)(LDU * 2), pack4(hv[i]));
        }
        if (j == NCH) break;
        ldsp bf = lds + (j & 1) * PB_BUFSZ;
        if (wave == 0) {
            const float pm = LDS_RD(float, bf + PB_VEC + lane * 4), bc = LDS_RD(float, bf + PB_VEC + 256 + lane * 4); const f32x2 rsl = LDS_RD(f32x2, bf + PB_VEC + 512 + lane * 8);
            const float mx = fmaxf(mcar, pm), r = fexp(pm - mx);
            const float pm63 = __shfl(pm, 63), bc63 = __shfl(bc, 63), m63 = fmaxf(mcar, pm63);
            LDS_WR(float, lds + SM_R + lane * 4, r); LDS_WR(float, lds + SM_INT + lane * 4, fexp(mcar - mx)); LDS_WR(float, lds + SM_EMT + lane * 4, fexp(-(bc + mx))); LDS_WR(float, lds + SM_RS + lane * 4, r * (rsl[0] + rsl[1]));
            if (lane == 0) { LDS_WR(float, lds + SM_SCAL, fexp(mcar - m63)); LDS_WR(float, lds + SM_SCAL + 4, bc63 + m63); LDS_WR(float, lds + SM_SCAL + 8, fexp(pm63 - m63)); }
        }
        {
            const int c = tid >> 3, part = tid & 7; float s = 0.f;
#pragma unroll
            for (int hh = 0; hh < 2; ++hh) { const u32x4 qw = LDS_RD(u32x4, bf + PB_Q + swz(c, 2 * part + hh));
#pragma unroll
                for (int e = 0; e < 4; ++e) { const f32x2 nv = LDS_RD(f32x2, lds + SM_NV + (16 * part + 8 * hh + 2 * e) * 4); s += __builtin_bit_cast(float, qw[e] << 16) * nv[0] + __builtin_bit_cast(float, qw[e] & 0xffff0000u) * nv[1]; } }
            s += __shfl_xor(s, 1); s += __shfl_xor(s, 2); s += __shfl_xor(s, 4);
            LDS_WR(float, lds + SM_QN + c * 4, s);
        }
        MIX_BAR();
        const float decay = LDS_RD(float, lds + SM_SCAL), sj = LDS_RD(float, lds + SM_SCAL + 8);
        mcar = LDS_RD(float, lds + SM_SCAL + 4);
        {
            bf16x8 bv[2], pf[2][2], qo[2][2], qp[2][2], so[2], sp[2];
#pragma unroll
            for (int ks = 0; ks < 2; ++ks) bv[ks] = frag_tr(bf + PB_V, 16 * vt, ks, lane, 128);
#pragma unroll
            for (int ks = 0; ks < 2; ++ks)
#pragma unroll
                for (int i = 0; i < 2; ++i) pf[ks][i] = frag16p(bf + PB_P, 16 * (2 * hf + i), ks, lane);
#pragma unroll
            for (int kl = 0; kl < 2; ++kl)
#pragma unroll
                for (int i = 0; i < 2; ++i) { qo[kl][i] = frag8x2s(bf + PB_Q, 16 * (2 * hf + i), 2 * hf + kl, lane); qp[kl][i] = frag8x2s(bf + PB_Q, 16 * (2 * hf + i), 2 * (hf ^ 1) + kl, lane); }
#pragma unroll
            for (int kl = 0; kl < 2; ++kl) sp[kl] = LDS_RD(bf16x8, lds + PB_XS + ((j + 1) & 1) * 16384 + (vt * 2 + (hf ^ 1)) * 2048 + kl * 1024 + lane * 16);
            float s_int[2], s_r[2], s_qn[2], s_rs[2], s_emt[2];
#pragma unroll
            for (int i = 0; i < 2; ++i) { const int c = 16 * (2 * hf + i) + l15; s_int[i] = LDS_RD(float, lds + SM_INT + c * 4); s_r[i] = LDS_RD(float, lds + SM_R + c * 4); s_qn[i] = LDS_RD(float, lds + SM_QN + c * 4); s_rs[i] = LDS_RD(float, lds + SM_RS + c * 4); s_emt[i] = LDS_RD(float, lds + SM_EMT + c * 4); }
            SCHED_BAR();
#pragma unroll
            for (int kl = 0; kl < 2; ++kl) { u32x4 w; const f32x4 a0 = st[2 * kl], a1 = st[2 * kl + 1]; w.x = cvt_pk_bf16(a0[0], a0[1]); w.y = cvt_pk_bf16(a0[2], a0[3]); w.z = cvt_pk_bf16(a1[0], a1[1]); w.w = cvt_pk_bf16(a1[2], a1[3]); so[kl] = __builtin_bit_cast(bf16x8, w); }
#pragma unroll
            for (int i = 0; i < 2; ++i) {
                f32x4 a1 = (f32x4){0.f, 0.f, 0.f, 0.f}, a2 = (f32x4){0.f, 0.f, 0.f, 0.f};
#pragma unroll
                for (int ks = 0; ks < 2; ++ks) a2 = MFMA16(bv[ks], pf[ks][i], a2);
#pragma unroll
                for (int kl = 0; kl < 2; ++kl) { a1 = MFMA16(so[kl], qo[kl][i], a1); a1 = MFMA16(sp[kl], qp[kl][i], a1); }
                const float den = s_int[i] * s_qn[i] + s_rs[i];
                const float rden = frcp(fmaxf(fabsf(den), s_emt[i]));
                hv[i] = (s_int[i] * a1 + s_r[i] * a2) * rden;
            }
#pragma unroll
            for (int i = 0; i < 4; ++i) { const int t = 4 * hf + i;
                f32x4 u = (f32x4){0.f, 0.f, 0.f, 0.f};
#pragma unroll
                for (int ks = 0; ks < 2; ++ks) { const bf16x8 a = frag_trs(bf + PB_K, 16 * t, ks, lane); u = MFMA16(a, bv[ks], u); }
                st[i] = decay * st[i] + sj * u;
            }
#pragma unroll
            for (int kl = 0; kl < 2; ++kl) { u32x4 w; const f32x4 a0 = st[2 * kl], a1 = st[2 * kl + 1]; w.x = cvt_pk_bf16(a0[0], a0[1]); w.y = cvt_pk_bf16(a0[2], a0[3]); w.z = cvt_pk_bf16(a1[0], a1[1]); w.w = cvt_pk_bf16(a1[2], a1[3]);
                LDS_WR(u32x4, lds + PB_XS + (j & 1) * 16384 + (vt * 2 + hf) * 2048 + kl * 1024 + lane * 16, w); }
            if (wave < 2) LDS_WR(float, lds + SM_NV + tid * 4, decay * LDS_RD(float, lds + SM_NV + tid * 4) + sj * LDS_RD(float, bf + PB_VEC + 1024 + tid * 4));
#pragma unroll
            for (int i = 0; i < 2; ++i) { float s_ = (hv[i][0] * hv[i][0] + hv[i][1] * hv[i][1]) + (hv[i][2] * hv[i][2] + hv[i][3] * hv[i][3]); s_ += __shfl_xor(s_, 16); s_ += __shfl_xor(s_, 32);
                LDS_WR(float, lds + SM_SSQ + (j & 1) * 1024 + ((16 * (2 * hf + i) + l15) * 4 + vt) * 4, s_); }
        }
    }
#undef MB_DMA
}

constexpr int P0_RB1 = (NP + NSG + 63) / 64, P0_I1 = (D / 64) * P0_RB1, P0_IU = (DA / 64) * (D / 64), P0_IO = (D / 64) * (D / 64), P0_NITEMS = P0_I1 + 2 * P0_IU + P0_IO;
DEV P0Desc p0_decode(const Args& args, int it) {
    unsigned char* ws = args.ws; bf16* W1T = (bf16*)(ws + WS_W1T); bf16* WUT = (bf16*)(ws + WS_WUT); bf16* WOT = (bf16*)(ws + WS_WOT);
    P0Desc d; int r = it;
    if (r < P0_I1) { const int kb = r / P0_RB1, rb = r % P0_RB1, r0 = 64 * rb; d.W = args.in[2]; d.ldw = D_IN; d.K = D; d.k0 = 64 * kb;
        if (r0 >= NPM && r0 < NP) { d.WT = ws + WS_W8; d.c0 = r0 + NSG; d.r0 = r0 - NPM; d.nv = 64; d.fp8 = 1; return d; }
        d.WT = W1T; d.fp8 = 0; d.r0 = r0;
        if (r0 >= C_OGA && r0 < C_OGA + DA) { d.fp8 = 2; d.WT8 = ws + WS_W8OG; d.r08 = r0 - C_OGA; }
        if (r0 >= C_OGB && r0 < C_OGB + DB) { d.fp8 = 2; d.WT8 = ws + WS_W8OG; d.r08 = DA + (r0 - C_OGB); }
        if (r0 < NPM) { d.c0 = r0; d.nv = 64; } else { d.c0 = NPM + (r0 - NP); d.nv = NSG - (r0 - NP) < 64 ? NSG - (r0 - NP) : 64; }
        return d; }
    r -= P0_I1; d.fp8 = 0; d.ldw = D; d.nv = 64;
    if (r < P0_IU) { const int kb = r / (D / 64), rb = r % (D / 64); d.W = args.in[10]; d.K = LDU; d.WT = WUT; d.k0 = 64 * kb; d.c0 = 64 * rb; d.r0 = 64 * rb; return d; }
    r -= P0_IU;
    if (r < P0_IU) { const int kb = r / (D / 64), rb = r % (D / 64); d.W = args.in[11]; d.K = LDU; d.WT = WUT + (size_t)D * LDU; d.k0 = 64 * kb; d.c0 = 64 * rb; d.r0 = 64 * rb; return d; }
    r -= P0_IU;
    { const int kb = r / (D / 64), rb = r % (D / 64); d.W = args.in[12]; d.K = D; d.WT = WOT; d.k0 = 64 * kb; d.c0 = 64 * rb; d.r0 = 64 * rb; return d; }
}
DEV void p0_items(const Args& args, int first, int last, int stride, ldsp scr, int lane) {
    if (first >= last) return;
    P0Desc d = p0_decode(args, first); f32x4 v[16]; p0_load(d, lane, v);
    for (int it = first; it < last; it += stride) {
        const int nx = it + stride; P0Desc dn = d; f32x4 vn[16];
        if (nx < last) { dn = p0_decode(args, nx); p0_load(dn, lane, vn); }
        p0_store(d, v, scr, lane);
        if (nx < last) { d = dn;
#pragma unroll
            for (int i = 0; i < 16; ++i) v[i] = vn[i]; }
    }
}

__global__ void __launch_bounds__(NTHREADS, 2) fwd_kernel(Args args) {
#ifndef EMU
    extern __shared__ __attribute__((aligned(16))) unsigned char lds_raw[];
    ldsp lds = (ldsp)lds_raw;
#else
    ldsp lds = emu_lds;
#endif
    const int tid = threadIdx.x, lane = tid & 63, wave = RFL(tid >> 6);
    const int G = gridDim.x, bx = blockIdx.x;
    const int vcu = (G % 8 == 0) ? (bx % 8) * (G / 8) + bx / 8 : bx;
    unsigned char* ws = args.ws;
#ifndef EMU
    for (int u = tid; u < (LDS_BYTES - LDSCTL_OFF) / 4; u += NTHREADS) ((LAS unsigned*)(lds + LDSCTL_OFF))[u] = 0u;
    __syncthreads();
    XcdBarrier bar = xcd_barrier_post((unsigned*)(ws + WS_CTL) + CW_BAR, (volatile LAS unsigned*)(lds + MISC_OFF) + 8);
#define GRID_BAR() xcd_barrier(bar)
#else
#define GRID_BAR()
#endif
    const int lo = args.ph_lo, hi = args.ph_hi;
#ifndef GEMM_SP2
#define GEMM_SP2 true
#endif
#ifndef GEMM_ALIGN
#define GEMM_ALIGN true
#endif
#ifndef PROBE_REP_P4
#define PROBE_REP_P4 1
#endif
#ifndef PROBE_REP_P5
#define PROBE_REP_P5 1
#endif
#ifndef PROBE_REP_P1
#define PROBE_REP_P1 2
#endif
#ifndef PROBE_REP_P2
#define PROBE_REP_P2 1
#endif
#ifndef PHASE_MASK
#define PHASE_MASK 255
#endif
#define IN(k) (((PHASE_MASK >> (k)) & 1) && lo <= (k) && (k) < hi)
#define BOTH(k) (IN(k) && IN((k) + 1))
    const float* x = args.in[0];
    bf16* W1T = (bf16*)(ws + WS_W1T); bf16* WUT = (bf16*)(ws + WS_WUT); bf16* WOT = (bf16*)(ws + WS_WOT);
    bf16* HBUF = (bf16*)(ws + WS_HB); bf16* PB = (bf16*)(ws + WS_P); float* SG = (float*)(ws + WS_SG); bf16* OAB = (bf16*)(ws + WS_OAB); float* RSS = (float*)(ws + WS_RSS);

    if (IN(0)) {
        ldsp scr = lds + wave * 17408;
        const int gw = vcu * NWAVES + wave, NGW = G * NWAVES;
        constexpr int I_1 = P0_I1, NITEMS = P0_NITEMS;
        static_assert(NPM % 64 == 0 && NP % 64 == 0 && NSG % 4 == 0, "P0 item tiling");
        constexpr int NJOBS3 = NB * HA * 2 + NB * HB * 4;
        const int nit0 = (G > NJOBS3) ? I_1 : NITEMS;
        p0_items(args, gw, nit0, NGW, scr, lane);
        const float* gpre = args.in[1];
        for (int m = gw; m < M; m += NGW) {
            const f32x4* xr = (const f32x4*)(x + (size_t)m * D) + lane;
            f32x4 v[D / 256]; float s = 0.f;
#pragma unroll
            for (int jj = 0; jj < D / 256; ++jj) { v[jj] = xr[64 * jj]; s += (v[jj][0] * v[jj][0] + v[jj][1] * v[jj][1]) + (v[jj][2] * v[jj][2] + v[jj][3] * v[jj][3]); }
            const float rstd = frsq(wave_sum(s) * (1.0f / D) + EPS) ;
            u32x2* o8 = (u32x2*)(HBUF + (size_t)m * D) + lane; unsigned* o4 = (unsigned*)(ws + WS_H8 + (size_t)m * D) + lane;
#pragma unroll
            for (int jj = 0; jj < D / 256; ++jj) { const f32x4 gg = ((const f32x4*)gpre)[lane + 64 * jj]; const f32x4 hh = v[jj] * rstd * gg; u32x2 w; w.x = pk2(hh[0], hh[1]); w.y = pk2(hh[2], hh[3]); o8[64 * jj] = w;
                o4[64 * jj] = pk_fp8x4(clamp8(hh[0] * H8_SCALE), clamp8(hh[1] * H8_SCALE), clamp8(hh[2] * H8_SCALE), clamp8(hh[3] * H8_SCALE)); }
        }
        if (BOTH(0)) GRID_BAR();
    }

    if (IN(1)) {
        {
            const int gw = vcu * NWAVES + wave, NGW = G * NWAVES, l15 = lane & 15, q4 = lane >> 4;
            const int wrow = NP + (l15 < NSG ? l15 : NSG - 1);
            for (int t = gw; t < M / 16; t += NGW) {
                f32x4 acc = (f32x4){0.f, 0.f, 0.f, 0.f};
                const bf16* ap = HBUF + (size_t)(16 * t + l15) * D + 8 * q4; const bf16* bp = W1T + (size_t)wrow * D + 8 * q4;
                for (int k0 = 0; k0 < D / 32; k0 += 16) {
                    bf16x8 af[16], bfr[16];
#pragma unroll
                    for (int i = 0; i < 16; ++i) { af[i] = *(const bf16x8*)(ap + 32 * (k0 + i)); bfr[i] = *(const bf16x8*)(bp + 32 * (k0 + i)); }
#pragma unroll
                    for (int i = 0; i < 16; ++i) acc = MFMA16(af[i], bfr[i], acc);
                }
#pragma unroll
                for (int r = 0; r < 4; ++r) SG[(size_t)(16 * t + 4 * q4 + r) * 16 + l15] = acc[r];
            }
        }
        { pg8::Gemm g{HBUF, W1T, M, NPM, D}; SchedSkipOg S; S.so.init(M, NPM - DA - DB, G, bx);
          EpiP E{PB};
          pg8::gemm_phase<EpiP, SchedSkipOg, GEMM_ALIGN, GEMM_SP2>(lds, g, S, E); }
        { pg8::Gemm g8{(const bf16*)(ws + WS_H8), (const bf16*)(ws + WS_W8OG), M, DA + DB, D}; pg8::StaticOrder S8; S8.init(M, DA + DB, G, bx);
          EpiOg E8{PB};
          pg8::gemm_phase<EpiOg, pg8::StaticOrder, GEMM_ALIGN, GEMM_SP2, 1>(lds, g8, S8, E8); }
        if (BOTH(1)) GRID_BAR();
    }

    if (IN(2)) {
        int buf = 0;
        if (bx < NUA + NUB) p2_issue(args, bx, lds + PA_RAW, wave, lane);
        for (int u = bx, it = 0; u < NUA + NUB; u += G, ++it) {
            int tidj = tid; OPAQUE(tidj); const int lane_ = tidj & 63;
            if (it == 0) WAIT_V(0); else WAIT_V(18);
            MIX_BAR();
            if (u + G < NUA + NUB) p2_issue(args, u + G, lds + PA_RAW + (buf ^ 1) * PA_RAWSZ, wave, lane_);
            p2_unit(args, lds, u, lds + PA_RAW + buf * PA_RAWSZ, wave, lane_);
            buf ^= 1;
        }
        if (BOTH(2)) GRID_BAR();
    }

    if (IN(3)) {
        constexpr int NJA = NB * HA * 2, NJB = NB * HB * 4;
        if (G > NJA + NJB && bx >= NJA + NJB) {
            ldsp scr = lds + wave * 17408;
            p0_items(args, P0_I1 + (bx - (NJA + NJB)) * NWAVES + wave, P0_NITEMS, (G - (NJA + NJB)) * NWAVES, scr, lane);
        }
        for (int job = bx; job < NJA + NJB; job += G) {
            if (job < NJA) mixer_a_job(args, lds, job / (2 * HA), (job >> 1) % HA, job & 1, tid);
            else { const int jb = job - NJA; mixer_b_job(args, lds, jb / (4 * HB), (jb >> 2) % HB, jb & 3, tid); }
            BLOCK_BAR();
        }
        if (BOTH(3)) GRID_BAR();
    }

    if (IN(4)) {
        const int gw = vcu * NWAVES + wave, NGW = G * NWAVES;
        const float* SSA = (const float*)(ws + WS_SSA); const float* SSB = (const float*)(ws + WS_SSB);
        static_assert(DA % 512 == 0 && DA == DB, "P3 tiling");
        for (int m = gw; m < M; m += NGW) {
#pragma unroll
            for (int br = 0; br < 2; ++br) {
#pragma unroll
                for (int i = 0; i < DA / 512; ++i) {
                    const int col0 = i * 512 + lane * 8;
                    float rstd;
                    if (br == 0) { const int hh = col0 / 128; rstd = frsq((SSA[((size_t)m * HA + hh) * 2] + SSA[((size_t)m * HA + hh) * 2 + 1]) * (1.0f / 128.0f) + EPS); }
                    else { const int hh = col0 / 256; const f32x4 q_ = *(const f32x4*)(SSB + ((size_t)m * HB + hh) * 4); rstd = frsq(((q_[0] + q_[1]) + (q_[2] + q_[3])) * (1.0f / 256.0f) + EPS); }
                    u32x4* po = (u32x4*)(OAB + (size_t)(br * M + m) * LDU + col0);
                    u32x4 w = *po; const u32x4 g8 = *(const u32x4*)(PB + p_off((size_t)m, (br ? C_OGB : C_OGA) + col0)), z8 = *(const u32x4*)(PB + p_off((size_t)m, (br ? C_ZB : C_ZA) + col0));
                    const f32x4 gn0 = *(const f32x4*)(args.in[br ? 9 : 8] + col0), gn1 = *(const f32x4*)(args.in[br ? 9 : 8] + col0 + 4);
#pragma unroll
                    for (int e = 0; e < 4; ++e) { float v[2];
#pragma unroll
                        for (int k = 0; k < 2; ++k) { const float ov = __builtin_bit_cast(float, k ? (w[e] & 0xffff0000u) : (w[e] << 16)), og = __builtin_bit_cast(float, k ? (g8[e] & 0xffff0000u) : (g8[e] << 16)), z = __builtin_bit_cast(float, k ? (z8[e] & 0xffff0000u) : (z8[e] << 16));
                            const float gnv = (e < 2 ? gn0 : gn1)[(2 * e + k) & 3];
                            v[k] = ov * rstd * gnv * sigm2(og) * (z * sigm2(z)); }
                        w[e] = cvt_pk_bf16(v[0], v[1]); }
                    *po = w;
                }
            }
        }
        if (BOTH(4)) GRID_BAR();
    }
    if (IN(5)) {
        { pg8::Gemm g8{(const bf16*)(ws + WS_H8), (const bf16*)(ws + WS_W8), M, 2 * D, D}; SchedGate S8; S8.so.init(M, D, G, bx);
          EpiP8 E8{PB};
          pg8::gemm_phase<EpiP8, SchedGate, GEMM_ALIGN, GEMM_SP2, 1>(lds, g8, S8, E8); }
        BLOCK_BAR();
        pg8::Gemm g{OAB, WUT, M, D, 2 * DA, LDU, (size_t)M * LDU * 2, (size_t)D * LDU * 2}; SchedRev S; S.init(M, D, G, bx);
        EpiUp2 E{HBUF, make_rsrc(PB, P_BYTES)};
        for (int rep = 0; rep < PROBE_REP_P4; ++rep) pg8::gemm_phase<EpiUp2, SchedRev, GEMM_ALIGN, GEMM_SP2, 2, true>(lds, g, S, E);
        if (BOTH(5)) GRID_BAR();
    }

    if (IN(6)) {
        pg8::Gemm g{HBUF, WOT, M, D, D}; pg8::StaticOrder S; S.init(M, D, G, bx);
        EpiOut E{PB, RSS};
        for (int rep = 0; rep < PROBE_REP_P5; ++rep) pg8::gemm_phase<EpiOut, pg8::StaticOrder, GEMM_ALIGN, GEMM_SP2>(lds, g, S, E);
        if (BOTH(6)) GRID_BAR();
    }

    if (IN(7)) {
        const int gw = vcu * NWAVES + wave, NGW = G * NWAVES;
        const float* gpost = args.in[13];
        for (int m = gw; m < M; m += NGW) {
            const float ss = wave_sum(lane < NRS ? RSS[(size_t)m * NRS + lane] : 0.f);
            const float rstd = frsq(ss * (1.0f / D) + EPS);
            const f32x4* xr = (const f32x4*)(x + (size_t)m * D) + lane; f32x4* orow = (f32x4*)(args.out + (size_t)m * D) + lane; const u32x2* ob = (const u32x2*)(PB + (size_t)m * D) + lane;
#pragma unroll
            for (int jj = 0; jj < D / 256; ++jj) { const f32x4 xv = xr[64 * jj], gg = ((const f32x4*)gpost)[lane + 64 * jj]; const u32x2 w = ob[64 * jj];
                const f32x4 ov = (f32x4){__builtin_bit_cast(float, w.x << 16), __builtin_bit_cast(float, w.x & 0xffff0000u), __builtin_bit_cast(float, w.y << 16), __builtin_bit_cast(float, w.y & 0xffff0000u)};
                orow[64 * jj] = xv + ov * rstd * gg; }
        }
    }
#undef IN
#undef BOTH
}

#ifndef EMU
extern "C" void kernel_launch(void* const* d_in, const int* in_sizes, int n_in, void* d_out, int out_size, void* d_ws, size_t ws_size, hipStream_t stream) {
    static int grid = 0;
    if (grid == 0) {
        if (n_in != 14 || out_size != M * D || ws_size < WS_END) { fprintf(stderr, "kernel_launch: unexpected shapes (n_in %d, out %d, ws %zu < %zu)\n", n_in, out_size, ws_size, (size_t)WS_END); grid = -1; return; }
        int dev = 0, cus = 0, per_cu = 0;
        if (hipGetDevice(&dev) != hipSuccess || hipDeviceGetAttribute(&cus, hipDeviceAttributeMultiprocessorCount, dev) != hipSuccess) { grid = -1; return; }
        if (hipFuncSetAttribute((const void*)fwd_kernel, hipFuncAttributeMaxDynamicSharedMemorySize, LDS_BYTES) != hipSuccess) { fprintf(stderr, "kernel_launch: hipFuncSetAttribute failed\n"); grid = -1; return; }
        if (hipOccupancyMaxActiveBlocksPerMultiprocessor(&per_cu, (const void*)fwd_kernel, NTHREADS, LDS_BYTES) != hipSuccess || per_cu < 1) { fprintf(stderr, "kernel_launch: occupancy query says %d\n", per_cu); }
        (void)hipGetLastError();
        grid = cus;
    }
    if (grid < 0) return;
    (void)hipMemsetAsync((char*)d_ws + WS_CTL, 0, CTL_ZERO_BYTES, stream);
    Args a{};
    for (int i = 0; i < 14; ++i) a.in[i] = (const float*)d_in[i];
    a.out = (float*)d_out; a.ws = (unsigned char*)d_ws; a.ph_lo = 0; a.ph_hi = 8;
    hipLaunchKernelGGL(fwd_kernel, dim3(grid), dim3(NTHREADS), LDS_BYTES, stream, a);
}
#endif
```

```cpp
typedef unsigned u32x2_t __attribute__((ext_vector_type(2)));
typedef int v8i_t __attribute__((ext_vector_type(8)));
typedef int v4i_t __attribute__((ext_vector_type(4)));
typedef int v2i_t __attribute__((ext_vector_type(2)));
typedef int v6i_t __attribute__((ext_vector_type(6)));
#ifndef EMU
#include <hip/hip_runtime.h>
#include <cstdio>
#include <cstdint>
#define LAS __attribute__((address_space(3)))
#define GAS __attribute__((address_space(1)))
typedef short bf16x8 __attribute__((ext_vector_type(8)));
typedef short bf16x4 __attribute__((ext_vector_type(4)));
typedef float f32x4 __attribute__((ext_vector_type(4)));
#define DEV __device__ __forceinline__
#define LDS_RD(T, p) (*(const LAS T*)(p))
#define LDS_WR(T, p, v) (*(LAS T*)(p) = (v))
#define WAVE_SYNC() asm volatile("s_waitcnt lgkmcnt(0)" ::: "memory")
#define BLOCK_BAR() __syncthreads()
#define RAW_BAR() __builtin_amdgcn_s_barrier()
#define WAIT_V(n) asm volatile("s_waitcnt vmcnt(" #n ")" ::: "memory")
#define WAIT_L(n) asm volatile("s_waitcnt lgkmcnt(" #n ")" ::: "memory")
#define SCHED_BAR() __builtin_amdgcn_sched_barrier(0)
#define SETPRIO(n) __builtin_amdgcn_s_setprio(n)
#define GLDS16(g, l) __builtin_amdgcn_global_load_lds((const unsigned*)(g), (LAS unsigned*)(l), 16, 0, 0)
#define MFMA16(a, b, c) __builtin_amdgcn_mfma_f32_16x16x32_bf16(a, b, c, 0, 0, 0)
#define RFL(x) __builtin_amdgcn_readfirstlane(x)
#define COMPILER_FENCE() asm volatile("" ::: "memory")
#define OPAQUE(x) asm volatile("" : "+v"(x))
DEV float fexp2(float x) { return __builtin_amdgcn_exp2f(x); }
DEV float flog2(float x) { return __builtin_amdgcn_logf(x); }
DEV float frcp(float x) { return __builtin_amdgcn_rcpf(x); }
DEV float frsq(float x) { return __builtin_amdgcn_rsqf(x); }
DEV unsigned cvt_pk_bf16(float lo, float hi) { unsigned r; asm volatile("v_cvt_pk_bf16_f32 %0, %1, %2" : "=v"(r) : "v"(lo), "v"(hi)); return r; }
DEV f32x4 mfma8(v8i_t a, v8i_t b, f32x4 c, int sc) { asm volatile("v_mfma_scale_f32_16x16x128_f8f6f4 %0, %1, %2, %0, %3, %3 op_sel_hi:[0,0,0]" : "+v"(c) : "v"(a), "v"(b), "v"(sc)); return c; }
DEV f32x4 mfma6(v6i_t a, v6i_t b, f32x4 c, int sc) { asm volatile("v_mfma_scale_f32_16x16x128_f8f6f4 %0, %1, %2, %0, %3, %3 op_sel_hi:[0,0,0] cbsz:2 blgp:2" : "+v"(c) : "v"(a), "v"(b), "v"(sc)); return c; }
#define MFMA_DRAIN() asm volatile("s_nop 15\n\ts_nop 7" ::: "memory")
DEV v2i_t lds_rd64_asm(unsigned addr) { v2i_t r; asm volatile("ds_read_b64 %0, %1" : "=v"(r) : "v"(addr) : "memory"); return r; }
#define LDS_RD64A(p) lds_rd64_asm((unsigned)(__UINTPTR_TYPE__)(p))
DEV unsigned pk_fp8x4(float a, float b, float c, float d) { int r = __builtin_amdgcn_cvt_pk_fp8_f32(a, b, 0, false); r = __builtin_amdgcn_cvt_pk_fp8_f32(c, d, r, true); return (unsigned)r; }
typedef short v4i16_t __attribute__((ext_vector_type(4)));
DEV bf16x4 lds_tr16(LAS unsigned char* p) { return __builtin_bit_cast(bf16x4, __builtin_amdgcn_ds_read_tr16_b64_v4i16((LAS v4i16_t*)p)); }
#define MIX_BAR() do { asm volatile("s_waitcnt lgkmcnt(0)" ::: "memory"); __builtin_amdgcn_s_barrier(); asm volatile("" ::: "memory"); } while (0)
DEV void glds16_asm(const void* gsrc, unsigned lds_dst) { unsigned keep;
    asm volatile("s_mov_b32 %0, m0\n\ts_mov_b32 m0, %2\n\ts_nop 0\n\tglobal_load_lds_dwordx4 %1, off\n\ts_mov_b32 m0, %0" : "=&s"(keep) : "v"(gsrc), "s"(lds_dst) : "memory"); }
#define GLDS16X(g, l) glds16_asm((const void*)(g), (unsigned)RFL((int)(unsigned)(__UINTPTR_TYPE__)(l)))
DEV void glds16_sbase(const void* sbase, unsigned voff, unsigned lds_dst) { unsigned keep;
    asm volatile("s_mov_b32 %0, m0\n\ts_mov_b32 m0, %3\n\ts_nop 0\n\tglobal_load_lds_dwordx4 %1, %2\n\ts_mov_b32 m0, %0" : "=&s"(keep) : "v"(voff), "s"(sbase), "s"(lds_dst) : "memory"); }
#define GLDS16S(sb, vo, l) glds16_sbase((const void*)(sb), (unsigned)(vo), (unsigned)RFL((int)(unsigned)(__UINTPTR_TYPE__)(l)))
typedef __amdgpu_buffer_rsrc_t rsrc_t;
DEV rsrc_t make_rsrc(const void* p, unsigned bytes) { return __builtin_amdgcn_make_buffer_rsrc((void*)p, (short)0, (int)bytes, 0x00020000); }
DEV unsigned short bload16(rsrc_t r, unsigned voff, unsigned soff) { return (unsigned short)__builtin_amdgcn_raw_buffer_load_b16(r, (int)voff, (int)soff, 0); }
DEV void bstore16(rsrc_t r, unsigned voff, unsigned soff, unsigned short v) { __builtin_amdgcn_raw_buffer_store_b16(v, r, (int)voff, (int)soff, 0); }
DEV void bstore64(rsrc_t r, unsigned voff, unsigned soff, u32x2_t v) { __builtin_amdgcn_raw_buffer_store_b64(v, r, (int)voff, (int)soff, 0); }
typedef unsigned u32x4_t __attribute__((ext_vector_type(4)));
DEV u32x4_t bload128(rsrc_t r, unsigned voff, unsigned soff) { return __builtin_amdgcn_raw_buffer_load_b128(r, (int)voff, (int)soff, 0); }
#else
#define LAS
#define GAS
#define DEV inline
#define LDS_RD(T, p) emu_lds_rd<T>((const void*)(p), #p)
#define LDS_WR(T, p, v) emu_lds_wr<T>((void*)(p), (T)(v), #p)
#define WAVE_SYNC() emu_wavesync()
#define BLOCK_BAR() emu_syncthreads()
#define RAW_BAR() emu_syncthreads()
#define WAIT_V(n)
#define WAIT_L(n)
#define SCHED_BAR()
#define SETPRIO(n)
#define GLDS16(g, l) emu_glds16((const void*)(g), (unsigned char*)(l))
#define GLDS16X(g, l) emu_glds16((const void*)(g), (unsigned char*)(l))
#define GLDS16S(sb, vo, l) emu_glds16((const void*)((const char*)(sb) + (vo)), (unsigned char*)(l))
#define MFMA16(a, b, c) emu_mfma16(a, b, c)
#define RFL(x) (x)
#define COMPILER_FENCE()
#define OPAQUE(x)
DEV float fexp2(float x) { return exp2f(x); }
DEV float flog2(float x) { return log2f(x); }
DEV float frcp(float x) { return 1.0f / x; }
DEV float frsq(float x) { return 1.0f / sqrtf(x); }
DEV unsigned cvt_pk_bf16(float lo, float hi) { return (unsigned)emu_f2bf(lo) | ((unsigned)emu_f2bf(hi) << 16); }
#define mfma8(a, b, c, sc) emu_mfma8(a, b, c)
#define mfma6(a, b, c, sc) emu_mfma6(a, b, c)
#define MFMA_DRAIN()
#define LDS_RD64A(p) LDS_RD(v2i_t, p)
DEV unsigned pk_fp8x4(float a, float b, float c, float d) { return (unsigned)emu_f2fp8(a) | ((unsigned)emu_f2fp8(b) << 8) | ((unsigned)emu_f2fp8(c) << 16) | ((unsigned)emu_f2fp8(d) << 24); }
#define lds_tr16(p) emu_lds_tr16((const unsigned char*)(p))
#define MIX_BAR() emu_syncthreads()
typedef unsigned char* rsrc_t;
DEV rsrc_t make_rsrc(const void* p, unsigned) { return (unsigned char*)p; }
DEV unsigned short bload16(rsrc_t r, unsigned voff, unsigned soff) { unsigned short v; memcpy(&v, r + (size_t)voff + soff, 2); return v; }
DEV void bstore16(rsrc_t r, unsigned voff, unsigned soff, unsigned short v) { memcpy(r + (size_t)voff + soff, &v, 2); }
DEV void bstore64(rsrc_t r, unsigned voff, unsigned soff, u32x2_t v) { memcpy(r + (size_t)voff + soff, &v, 8); }
typedef unsigned u32x4_t __attribute__((ext_vector_type(4)));
DEV u32x4_t bload128(rsrc_t r, unsigned voff, unsigned soff) { u32x4_t v; memcpy(&v, r + (size_t)voff + soff, 16); return v; }
#endif

typedef unsigned short bf16;
typedef unsigned u32x4 __attribute__((ext_vector_type(4)));
typedef unsigned u32x2 __attribute__((ext_vector_type(2)));
typedef float f32x2 __attribute__((ext_vector_type(2)));
typedef LAS unsigned char* ldsp;

#ifndef CFG_D
#define CFG_D 4096
#define CFG_B 4
#define CFG_S 4096
#define CFG_HB 8
#endif
constexpr int D = CFG_D, NB = CFG_B, SEQ = CFG_S, M = NB * SEQ;
constexpr int DA = D / 2, HA = DA / 128, DB = D / 2, HB = CFG_HB, DVB = DB / HB, DKB = 128, DQK = HB * DKB;
constexpr int NSG = 2 * HB;
constexpr int NCH = SEQ / 64;
static_assert(DVB == 256 && NSG <= 16 && SEQ % 64 == 0 && M % 256 == 0 && D % 256 == 0, "shape");
constexpr int C_QA = 0, C_FA = DA, C_IA = 2 * DA, C_OGA = 3 * DA, C_ZA = 4 * DA, C_QB = 5 * DA, C_KB = C_QB + DQK, C_VB = C_KB + DQK, C_OGB = C_VB + DB, C_ZB = C_OGB + DB;
constexpr int NPM = C_ZB + DB, C_GA = NPM, C_GB = NPM + D, NP = NPM + 2 * D, D_IN = NP + NSG;
static_assert(NPM % 256 == 0 && NP % 256 == 0, "column map");
constexpr float EPS = 1e-6f;
constexpr float H8_SCALE = 2.0f, W8_SCALE = D >= 4096 ? 128.0f : 64.0f, G8_DESCALE = 1.0f / (H8_SCALE * W8_SCALE);
constexpr float LOG2E = 1.4426950408889634f, LN2 = 0.6931471805599453f;
constexpr int NRS = D / 64;
constexpr int PT_PITCH = M / 64 + 1;
DEV size_t p_off(size_t row, int col) { return ((size_t)(col >> 7) * (size_t)PT_PITCH + (row >> 6)) * 8192 + (row & 63) * 128 + (size_t)(col & 127); }

constexpr size_t al256(size_t x) { return (x + 255) & ~(size_t)255; }
constexpr size_t WS_CTL = 0, CTL_ZERO_BYTES = 65536;
constexpr size_t WS_W1T = 1u << 20;
constexpr int LDU = DA + 64;
constexpr size_t WS_WUT = al256(WS_W1T + (size_t)(NP + 16) * D * 2);
constexpr size_t WS_WOT = al256(WS_WUT + (size_t)2 * D * LDU * 2);
constexpr size_t WS_HB = al256(WS_WOT + (size_t)D * D * 2);
constexpr size_t WS_P = al256(WS_HB + (size_t)M * D * 2);
constexpr size_t WS_SG = al256(WS_P + (size_t)(NP / 128) * (M / 64 + 1) * 16384 + 4096);
constexpr size_t WS_OAB = al256(WS_SG + (size_t)M * 16 * 4);
constexpr size_t WS_RSS = al256(WS_OAB + (size_t)2 * M * LDU * 2);
constexpr size_t WS_SSB = al256(WS_RSS + (size_t)M * NRS * 4);
constexpr size_t WS_SSA = al256(WS_SSB + (size_t)M * HB * 4 * 4);
constexpr size_t WS_H8 = al256(WS_SSA + (size_t)M * HA * 2 * 4);
constexpr size_t WS_W8 = al256(WS_H8 + (size_t)M * D);
constexpr size_t WS_END = al256(WS_W8 + (size_t)2 * D * D);
constexpr size_t WS_W8OG = WS_P + (size_t)(NPM / 128) * (M / 64 + 1) * 16384;
static_assert((size_t)(DA + DB) * D <= (size_t)(2 * D / 128) * (M / 64 + 1) * 16384, "out-gate weight copy fits the merge-gate tiles");
constexpr int CW_BAR = 1024;

constexpr int RING_BYTES = 154624, LDSCTL_OFF = RING_BYTES, MISC_OFF = LDSCTL_OFF + 320, LDS_BYTES = 155648;
constexpr int NWAVES = 8, NTHREADS = 512;

DEV unsigned f2bf(float f) { unsigned u = __builtin_bit_cast(unsigned, f); return (u + 0x7fffu + ((u >> 16) & 1u)) >> 16; }
DEV float bf2f(unsigned b) { return __builtin_bit_cast(float, b << 16); }
DEV unsigned pk2(float lo, float hi) { return f2bf(lo) | (f2bf(hi) << 16); }
DEV float fexp(float x) { return fexp2(x * LOG2E); }
DEV float flog(float x) { return flog2(x) * LN2; }
DEV float sigm(float x) { return frcp(1.0f + fexp(-x)); }
DEV float logsig(float x) { return fminf(x, 0.f) - flog(1.0f + fexp(-fabsf(x))); }
DEV float wave_sum(float v) {
#pragma unroll
    for (int o = 1; o < 64; o <<= 1) v += __shfl_xor(v, o);
    return v;
}

namespace pg8 {
constexpr int BM = 256, BK = 64, HALF = 128, HTB = HALF * BK * 2, STAGE_BYTES = 8 * HTB, NXCD = 8, WGM = 8;
DEV int lds_byte(int r, int c) { const int st = (r >> 4) * 2 + (c >> 5), rr = r & 15, cc = c & 31, ob = rr * 64 + cc * 2; return st * 1024 + (ob ^ (((ob >> 9) & 1) << 5)); }
DEV void stage_rc(int b, int& R, int& C) { const int st = b / 1024, sb = b % 1024, swz = sb ^ (((sb >> 9) & 1) << 5); R = (st >> 1) * 16 + swz / 64; C = (st & 1) * 32 + (swz % 64) / 2; }
DEV int perm32(int rho) { const int n = rho >> 4, i = rho & 15; return 8 * (i >> 2) + 4 * n + (i & 3); }
struct Unit { int pm, pn; };
struct Gemm { const bf16* A; const bf16* Bt; int M, N, K; int ld; size_t a2off, b2off; };
struct StaticOrder {
    int nM, nN, nwg, G, c;
    DEV void init(int M_, int N_, int G_, int c_) { nM = M_ / BM; nN = N_ / BM; nwg = nM * nN; G = G_; c = c_; }
    DEV bool next(int i, Unit& u) const {
        const long L = (long)i * G + c; if (L >= nwg) return false;
        int wgid = (int)L; { const int q = nwg / NXCD, r = nwg % NXCD, xcd = wgid % NXCD, off = wgid / NXCD; wgid = (xcd < r ? xcd * (q + 1) : r * (q + 1) + (xcd - r) * q) + off; }
        const int nig = WGM * nN, gid = wgid / nig, fm = gid * WGM, gsz = (nM - fm) < WGM ? (nM - fm) : WGM;
        u.pm = fm + ((wgid % nig) % gsz); u.pn = (wgid % nig) / gsz; return true;
    }
};
template <class Epi, class Sched, bool ALIGN_EPI = false, bool SP2 = false, int ESZ = 2, bool SPLITK = false>
DEV void gemm_phase(ldsp lds, const Gemm g, const Sched& S, const Epi& E) {
    const int tid = threadIdx.x, wid = RFL(tid >> 6), lane = tid & 63, wr = wid >> 2, wc = wid & 3, fr = lane & 15, fq = lane >> 4;
    const int nt = (g.K * ESZ / 2) / BK, K = (g.ld ? g.ld : g.K) * ESZ / 2;
    unsigned voffA[2], voffB[2];
#pragma unroll
    for (int i = 0; i < 2; ++i) { int R, C; stage_rc(tid * 16 + i * 8192, R, C); const int Rb = Epi::PERM ? ((R & ~31) + perm32(R & 31)) : R;
        voffA[i] = (unsigned)(R * K + C) * 2u; voffB[i] = (unsigned)(Rb * K + C) * 2u; }
    const size_t kstep = (size_t)(BK * 2);
    const size_t hstep = (size_t)HALF * K * 2;
    const size_t tstep = 2 * hstep;
    const unsigned ldsw = (unsigned)wid * 1024u;
    int aoffk[2], boffk[2];
#pragma unroll
    for (int k = 0; k < 2; ++k) { const int ch = ESZ == 2 ? fq + 4 * k : 2 * fq + k;
        aoffk[k] = lds_byte(wr * 64 + fr, (ch & 3) * 8) + (ch >> 2) * 1024; boffk[k] = lds_byte(wc * 32 + fr, (ch & 3) * 8) + (ch >> 2) * 1024; }
#define PG8_SA(b, h) (((b) * 2 + (h)) * HTB)
#define PG8_SB(b, h) ((4 + (b) * 2 + (h)) * HTB)
#define PG8_STAGE(bufoff, gbase, voff) do { _Pragma("unroll") for (int _i = 0; _i < 2; ++_i) \
        GLDS16((const char*)(gbase) + (voff)[_i], lds + (bufoff) + ldsw + _i * 8192); } while (0)
#define PG8_LDA(dst, b, h) do { _Pragma("unroll") for (int m = 0; m < 4; ++m) { if constexpr (ESZ == 2) { _Pragma("unroll") for (int k = 0; k < 2; ++k) dst[m][k] = *(const LAS bf16x8*)(lds + PG8_SA(b, h) + aoffk[k] + m * 2048); } \
        else { const v4i_t p0_ = *(const LAS v4i_t*)(lds + PG8_SA(b, h) + aoffk[0] + m * 2048); const v2i_t p1_ = LDS_RD64A(lds + PG8_SA(b, h) + aoffk[1] + m * 2048); dst##8[m] = (v6i_t){p0_[0], p0_[1], p0_[2], p0_[3], p1_[0], p1_[1]}; } } } while (0)
#define PG8_LDB(dst, b, h) do { _Pragma("unroll") for (int n = 0; n < 2; ++n) { if constexpr (ESZ == 2) { _Pragma("unroll") for (int k = 0; k < 2; ++k) dst[n][k] = *(const LAS bf16x8*)(lds + PG8_SB(b, h) + boffk[k] + n * 2048); } \
        else { const v4i_t p0_ = *(const LAS v4i_t*)(lds + PG8_SB(b, h) + boffk[0] + n * 2048); const v2i_t p1_ = LDS_RD64A(lds + PG8_SB(b, h) + boffk[1] + n * 2048); dst##8[n] = (v6i_t){p0_[0], p0_[1], p0_[2], p0_[3], p1_[0], p1_[1]}; } } } while (0)
#define PG8_MMA(ai, bj, At, Bt) do { SETPRIO(1); _Pragma("unroll") for (int m = 0; m < 4; ++m) _Pragma("unroll") for (int n = 0; n < 2; ++n) { \
        if constexpr (ESZ == 2) { _Pragma("unroll") for (int k = 0; k < 2; ++k) acc[ai][bj][m][n] = MFMA16(Bt[n][k], At[m][k], acc[ai][bj][m][n]); } \
        else acc[ai][bj][m][n] = mfma6(Bt##8[n], At##8[m], acc[ai][bj][m][n], sc8); } SETPRIO(0); } while (0)
    int sc8 = 0x7f7f7f7f; OPAQUE(sc8);
    Unit cur, nxt; int ui = 0;
    if (!S.next(0, cur)) return;
    f32x4 acc[2][2][4][2];
#pragma unroll
    for (int a = 0; a < 2; ++a)
#pragma unroll
        for (int b = 0; b < 2; ++b)
#pragma unroll
            for (int m = 0; m < 4; ++m)
#pragma unroll
                for (int n = 0; n < 2; ++n) acc[a][b][m][n] = (f32x4){0.f, 0.f, 0.f, 0.f};
    bf16x8 At[ESZ == 2 ? 4 : 1][2], B0[ESZ == 2 ? 2 : 1][2], B1[ESZ == 2 ? 2 : 1][2];
    v6i_t At8[ESZ == 1 ? 4 : 1], B08[ESZ == 1 ? 2 : 1], B18[ESZ == 1 ? 2 : 1];
    const char* cA = (const char*)g.A + (size_t)cur.pm * tstep; const char* cB = (const char*)g.Bt + (size_t)cur.pn * tstep;
    if constexpr (SP2) {
        PG8_STAGE(PG8_SB(0, 0), cB, voffB); PG8_STAGE(PG8_SB(0, 1), cB + hstep, voffB); PG8_STAGE(PG8_SA(0, 0), cA, voffA); PG8_STAGE(PG8_SA(0, 1), cA + hstep, voffA);
        if (wr == 1) RAW_BAR();
        WAIT_V(2); RAW_BAR();
        PG8_STAGE(PG8_SB(1, 0), cB + kstep, voffB); PG8_STAGE(PG8_SA(1, 0), cA + kstep, voffA); PG8_STAGE(PG8_SB(1, 1), cB + hstep + kstep, voffB);
        WAIT_V(6); RAW_BAR();
    } else {
        PG8_STAGE(PG8_SB(0, 0), cB, voffB); PG8_STAGE(PG8_SA(0, 0), cA, voffA); PG8_STAGE(PG8_SB(0, 1), cB + hstep, voffB); PG8_STAGE(PG8_SA(0, 1), cA + hstep, voffA);
        if (wr == 1) RAW_BAR();
        WAIT_V(4); RAW_BAR();
        PG8_STAGE(PG8_SB(1, 0), cB + kstep, voffB); PG8_STAGE(PG8_SA(1, 0), cA + kstep, voffA); PG8_STAGE(PG8_SB(1, 1), cB + hstep + kstep, voffB);
        WAIT_V(6); RAW_BAR();
    }
    for (;;) {
        const bool has_next = S.next(ui + 1, nxt);
        const char* nA = has_next ? (const char*)g.A + (size_t)nxt.pm * tstep : cA; const char* nB = has_next ? (const char*)g.Bt + (size_t)nxt.pn * tstep : cB;
        for (int t = 0; t < nt; t += 2) {
            const bool last = (t == nt - 2);
            const size_t h1 = (SPLITK && t >= nt / 2) ? 1 : 0, h2 = (SPLITK && t + 2 >= nt / 2) ? 1 : 0;
            const char* a1 = cA + (size_t)(t + 1) * kstep + h1 * (g.a2off - (size_t)(nt / 2) * kstep);
            const char* a2 = last ? nA : cA + (size_t)(t + 2) * kstep + h2 * (g.a2off - (size_t)(nt / 2) * kstep); const char* b2 = last ? nB : cB + (size_t)(t + 2) * kstep + h2 * (g.b2off - (size_t)(nt / 2) * kstep);
            const char* a3 = a2 + kstep; const char* b3 = b2 + kstep;
            if constexpr (SPLITK) { if (t == nt / 2) {
                if constexpr (ALIGN_EPI) { if (wr == 0) RAW_BAR(); }
                int fr_ = fr; OPAQUE(fr_); E.mid(acc, cur, wr, wc, fr_, fq);
                if constexpr (ALIGN_EPI) { if (wr == 1) RAW_BAR(); } } }
            if constexpr (SP2) {
            PG8_LDB(B0, 0, 0); PG8_LDB(B1, 0, 1); SCHED_BAR(); PG8_LDA(At, 0, 0); PG8_STAGE(PG8_SA(1, 1), a1 + hstep, voffA);
            WAIT_V(8); WAIT_L(0); RAW_BAR(); PG8_MMA(0, 0, At, B0); PG8_MMA(0, 1, At, B1); RAW_BAR(); SCHED_BAR();
            PG8_LDA(At, 0, 1); PG8_STAGE(PG8_SB(0, 0), b2, voffB); PG8_STAGE(PG8_SB(0, 1), b2 + hstep, voffB); PG8_STAGE(PG8_SA(0, 0), a2, voffA);
            WAIT_V(8); WAIT_L(0); RAW_BAR(); PG8_MMA(1, 0, At, B0); PG8_MMA(1, 1, At, B1); RAW_BAR(); SCHED_BAR();
            PG8_LDB(B0, 1, 0); PG8_LDB(B1, 1, 1); SCHED_BAR(); PG8_LDA(At, 1, 0); PG8_STAGE(PG8_SA(0, 1), a2 + hstep, voffA);
            WAIT_V(8); WAIT_L(0); RAW_BAR(); PG8_MMA(0, 0, At, B0); PG8_MMA(0, 1, At, B1); RAW_BAR(); SCHED_BAR();
            PG8_LDA(At, 1, 1); PG8_STAGE(PG8_SB(1, 0), b3, voffB); PG8_STAGE(PG8_SB(1, 1), b3 + hstep, voffB); PG8_STAGE(PG8_SA(1, 0), a3, voffA);
            WAIT_V(8); WAIT_L(0); RAW_BAR(); PG8_MMA(1, 0, At, B0); PG8_MMA(1, 1, At, B1); RAW_BAR(); SCHED_BAR();
            } else {
            PG8_LDB(B0, 0, 0); SCHED_BAR(); PG8_LDA(At, 0, 0); PG8_STAGE(PG8_SA(1, 1), a1 + hstep, voffA);
            WAIT_L(8); RAW_BAR(); WAIT_L(0); PG8_MMA(0, 0, At, B0); RAW_BAR(); SCHED_BAR();
            PG8_LDB(B1, 0, 1); PG8_STAGE(PG8_SB(0, 0), b2, voffB);
            RAW_BAR(); WAIT_L(0); PG8_MMA(0, 1, At, B1); RAW_BAR();
            PG8_LDA(At, 0, 1); PG8_STAGE(PG8_SA(0, 0), a2, voffA);
            RAW_BAR(); WAIT_L(0); PG8_MMA(1, 0, At, B0); RAW_BAR(); SCHED_BAR();
            PG8_STAGE(PG8_SB(0, 1), b2 + hstep, voffB);
            WAIT_V(6); RAW_BAR(); PG8_MMA(1, 1, At, B1); RAW_BAR();
            PG8_LDB(B0, 1, 0); SCHED_BAR(); PG8_LDA(At, 1, 0); PG8_STAGE(PG8_SA(0, 1), a2 + hstep, voffA);
            WAIT_L(8); RAW_BAR(); WAIT_L(0); PG8_MMA(0, 0, At, B0); RAW_BAR(); SCHED_BAR();
            PG8_LDB(B1, 1, 1); PG8_STAGE(PG8_SB(1, 0), b3, voffB);
            RAW_BAR(); WAIT_L(0); PG8_MMA(0, 1, At, B1); RAW_BAR();
            PG8_LDA(At, 1, 1); PG8_STAGE(PG8_SA(1, 0), a3, voffA);
            RAW_BAR(); WAIT_L(0); PG8_MMA(1, 0, At, B0); RAW_BAR(); SCHED_BAR();
            PG8_STAGE(PG8_SB(1, 1), b3 + hstep, voffB);
            WAIT_V(6); RAW_BAR(); PG8_MMA(1, 1, At, B1); RAW_BAR();
            }
        }
        if constexpr (ALIGN_EPI) { if (wr == 0) RAW_BAR(); }
        if constexpr (ESZ == 1) { MFMA_DRAIN();
#pragma unroll
            for (int a = 0; a < 2; ++a)
#pragma unroll
                for (int b = 0; b < 2; ++b) asm volatile("" : "+v"(acc[a][b][0][0]), "+v"(acc[a][b][0][1]), "+v"(acc[a][b][1][0]), "+v"(acc[a][b][1][1]), "+v"(acc[a][b][2][0]), "+v"(acc[a][b][2][1]), "+v"(acc[a][b][3][0]), "+v"(acc[a][b][3][1])); }
        E(acc, cur, wr, wc, fr, fq);
        if (!has_next) break;
#pragma unroll
        for (int a = 0; a < 2; ++a)
#pragma unroll
            for (int b = 0; b < 2; ++b)
#pragma unroll
                for (int m = 0; m < 4; ++m)
#pragma unroll
                    for (int n = 0; n < 2; ++n) acc[a][b][m][n] = (f32x4){0.f, 0.f, 0.f, 0.f};
        cur = nxt; cA = nA; cB = nB; ++ui;
        if constexpr (ALIGN_EPI) { if (wr == 1) RAW_BAR(); }
    }
    WAIT_V(0);
    if constexpr (!ALIGN_EPI) { if (wr == 0) RAW_BAR(); }
    RAW_BAR();
#undef PG8_SA
#undef PG8_SB
#undef PG8_STAGE
#undef PG8_LDA
#undef PG8_LDB
#undef PG8_MMA
}
}

struct EpiP {
    static constexpr bool PERM = true;
    bf16* O;
    DEV void operator()(const f32x4 (&acc)[2][2][4][2], const pg8::Unit& u, int wr, int wc, int fr, int fq) const {
        const int row0 = u.pm * 256 + wr * 64 + fr, col0 = u.pn * 256 + wc * 32 + 8 * fq;
#pragma unroll
        for (int ai = 0; ai < 2; ++ai)
#pragma unroll
            for (int m = 0; m < 4; ++m) { const size_t row = (size_t)(row0 + ai * 128 + m * 16);
#pragma unroll
                for (int bj = 0; bj < 2; ++bj) { const f32x4 v0 = acc[ai][bj][m][0], v1 = acc[ai][bj][m][1];
                    u32x4 w; w.x = cvt_pk_bf16(v0[0], v0[1]); w.y = cvt_pk_bf16(v0[2], v0[3]); w.z = cvt_pk_bf16(v1[0], v1[1]); w.w = cvt_pk_bf16(v1[2], v1[3]);
                    *(u32x4*)(O + p_off(row, col0 + bj * 128)) = w; } }
    }
};
struct EpiP8 {
    static constexpr bool PERM = true;
    bf16* O;
    DEV void operator()(const f32x4 (&acc)[2][2][4][2], const pg8::Unit& u, int wr, int wc, int fr, int fq) const {
        const int row0 = u.pm * 256 + wr * 64 + fr, col0 = NPM + u.pn * 256 + wc * 32 + 8 * fq;
#pragma unroll
        for (int ai = 0; ai < 2; ++ai)
#pragma unroll
            for (int m = 0; m < 4; ++m) { const size_t row = (size_t)(row0 + ai * 128 + m * 16);
#pragma unroll
                for (int bj = 0; bj < 2; ++bj) { const f32x4 v0 = acc[ai][bj][m][0] * G8_DESCALE, v1 = acc[ai][bj][m][1] * G8_DESCALE;
                    u32x4 w; w.x = cvt_pk_bf16(v0[0], v0[1]); w.y = cvt_pk_bf16(v0[2], v0[3]); w.z = cvt_pk_bf16(v1[0], v1[1]); w.w = cvt_pk_bf16(v1[2], v1[3]);
                    *(u32x4*)(O + p_off(row, col0 + bj * 128)) = w; } }
    }
};
struct SchedUp {
    pg8::StaticOrder so;
    DEV bool next(int i, pg8::Unit& u) const { if (!so.next(i >> 1, u)) return false; if (i & 1) { u.pm += M / 256; u.pn += D / 256; } return true; }
};
struct EpiUp {
    static constexpr bool PERM = true;
    bf16* Y; const bf16* P;
    DEV void operator()(const f32x4 (&acc)[2][2][4][2], const pg8::Unit& u, int wr, int wc, int fr, int fq) const {
        const int br = u.pm >= M / 256 ? 1 : 0, pm = u.pm - br * (M / 256), pn = u.pn - br * (D / 256);
        const int row0 = pm * 256 + wr * 64 + fr, col0 = pn * 256 + wc * 32 + 8 * fq, gcol = (br ? C_GB : C_GA) + col0;
#pragma unroll
        for (int ai = 0; ai < 2; ++ai)
#pragma unroll
            for (int m = 0; m < 4; ++m) { const size_t row = (size_t)(row0 + ai * 128 + m * 16);
#pragma unroll
                for (int bj = 0; bj < 2; ++bj) {
                    const u32x4 g8 = *(const u32x4*)(P + p_off(row, gcol + bj * 128));
                    bf16* yp = Y + row * D + col0 + bj * 128;
                    u32x4 y8 = (u32x4){0u, 0u, 0u, 0u}; if (br) y8 = *(const u32x4*)yp;
                    const f32x4 v0 = acc[ai][bj][m][0], v1 = acc[ai][bj][m][1];
                    float o[8];
#pragma unroll
                    for (int k = 0; k < 8; ++k) { const unsigned gw = g8[k >> 1], yw = y8[k >> 1]; const float gv = bf2f((k & 1) ? (gw >> 16) : (gw & 0xffffu)), yv = bf2f((k & 1) ? (yw >> 16) : (yw & 0xffffu));
                        const float a = k < 4 ? v0[k & 3] : v1[k & 3]; o[k] = yv + sigm(gv) * a; }
                    u32x4 w; w.x = cvt_pk_bf16(o[0], o[1]); w.y = cvt_pk_bf16(o[2], o[3]); w.z = cvt_pk_bf16(o[4], o[5]); w.w = cvt_pk_bf16(o[6], o[7]);
                    *(u32x4*)yp = w; } }
    }
};
struct SchedSkipOg { pg8::StaticOrder so; DEV bool next(int i, pg8::Unit& u) const { if (!so.next(i, u)) return false; if (u.pn >= C_OGA / 256) u.pn += DA / 256; if (u.pn >= C_OGB / 256) u.pn += DB / 256; return true; } };
static_assert(C_OGA % 256 == 0 && C_OGB % 256 == 0 && DA % 256 == 0 && DB % 256 == 0 && C_OGA < C_OGB, "out-gate column tiles");
struct EpiOg {
    static constexpr bool PERM = true;
    bf16* O;
    DEV void operator()(const f32x4 (&acc)[2][2][4][2], const pg8::Unit& u, int wr, int wc, int fr, int fq) const {
        const int cb = u.pn < DA / 256 ? C_OGA + u.pn * 256 : C_OGB + (u.pn - DA / 256) * 256;
        const int row0 = u.pm * 256 + wr * 64 + fr, col0 = cb + wc * 32 + 8 * fq;
#pragma unroll
        for (int ai = 0; ai < 2; ++ai)
#pragma unroll
            for (int m = 0; m < 4; ++m) { const size_t row = (size_t)(row0 + ai * 128 + m * 16);
#pragma unroll
                for (int bj = 0; bj < 2; ++bj) { const f32x4 v0 = acc[ai][bj][m][0] * G8_DESCALE, v1 = acc[ai][bj][m][1] * G8_DESCALE;
                    u32x4 w; w.x = cvt_pk_bf16(v0[0], v0[1]); w.y = cvt_pk_bf16(v0[2], v0[3]); w.z = cvt_pk_bf16(v1[0], v1[1]); w.w = cvt_pk_bf16(v1[2], v1[3]);
                    *(u32x4*)(O + p_off(row, col0 + bj * 128)) = w; } }
    }
};
struct SchedGate { pg8::StaticOrder so; DEV bool next(int i, pg8::Unit& u) const { if (!so.next(i >> 1, u)) return false; if (i & 1) u.pn += D / 256; return true; } };
struct SchedRev { pg8::StaticOrder so; int n; DEV void init(int M_, int N_, int G_, int c_) { so.init(M_, N_, G_, c_); n = so.nwg > c_ ? (so.nwg - c_ + G_ - 1) / G_ : 0; }
    DEV bool next(int i, pg8::Unit& u) const { return i < n && so.next(n - 1 - i, u); } };
constexpr unsigned P_BYTES = (unsigned)((size_t)(NP / 128) * PT_PITCH * 16384);
DEV unsigned p_soff(int pm, int cb, int ai, int m, int wr, int wc) { return (unsigned)((cb * PT_PITCH + 4 * pm + 2 * ai + wr) * 16384 + m * 4096 + wc * 64); }
constexpr unsigned GB_MINUS_GA = (unsigned)((D / 128) * PT_PITCH) * 16384u;
struct EpiUp2 {
    static constexpr bool PERM = true;
    bf16* Y; rsrc_t rs;
    DEV void mid(f32x4 (&acc)[2][2][4][2], const pg8::Unit& u, int wr, int wc, int fr, int fq) const {
        const unsigned voff = (unsigned)(fr * 256 + fq * 16);
#pragma unroll
        for (int ai = 0; ai < 2; ++ai) { u32x4 ga[8], gb[8];
#pragma unroll
            for (int s_ = 0; s_ < 8; ++s_) { const unsigned so = p_soff(u.pm, NPM / 128 + 2 * u.pn + (s_ & 1), ai, s_ >> 1, wr, wc); ga[s_] = bload128(rs, voff, so); gb[s_] = bload128(rs, voff, so + GB_MINUS_GA); }
            SCHED_BAR();
#pragma unroll
            for (int s_ = 0; s_ < 8; ++s_) { const int m = s_ >> 1, bj = s_ & 1;
#pragma unroll
                for (int k = 0; k < 8; ++k) { const unsigned aw = ga[s_][k >> 1], bw = gb[s_][k >> 1];
                    const float av = __builtin_bit_cast(float, (k & 1) ? (aw & 0xffff0000u) : (aw << 16)), bv_ = __builtin_bit_cast(float, (k & 1) ? (bw & 0xffff0000u) : (bw << 16));
                    const float ratio = (1.0f + fexp2(-LOG2E * bv_)) * frcp(1.0f + fexp2(-LOG2E * av));
                    if (k < 4) acc[ai][bj][m][0][k & 3] *= ratio; else acc[ai][bj][m][1][k & 3] *= ratio; } } }
    }
    DEV void operator()(const f32x4 (&acc)[2][2][4][2], const pg8::Unit& u, int wr, int wc, int fr, int fq) const {
        const int row0 = u.pm * 256 + wr * 64 + fr, col0 = u.pn * 256 + wc * 32 + 8 * fq; const unsigned voff = (unsigned)(fr * 256 + fq * 16); u32x4 gb[16];
#pragma unroll
        for (int s_ = 0; s_ < 16; ++s_) gb[s_] = bload128(rs, voff, p_soff(u.pm, NPM / 128 + 2 * u.pn + (s_ & 1), s_ >> 3, (s_ >> 1) & 3, wr, wc) + GB_MINUS_GA);
        SCHED_BAR();
#pragma unroll
        for (int s_ = 0; s_ < 16; ++s_) { const int ai = s_ >> 3, m = (s_ >> 1) & 3, bj = s_ & 1; const size_t row = (size_t)(row0 + ai * 128 + m * 16);
            const f32x4 v0 = acc[ai][bj][m][0], v1 = acc[ai][bj][m][1]; float o[8];
#pragma unroll
            for (int k = 0; k < 8; ++k) { const unsigned bw = gb[s_][k >> 1]; const float bv_ = __builtin_bit_cast(float, (k & 1) ? (bw & 0xffff0000u) : (bw << 16));
                o[k] = (k < 4 ? v0[k & 3] : v1[k & 3]) * frcp(1.0f + fexp2(-LOG2E * bv_)); }
            u32x4 w; w.x = cvt_pk_bf16(o[0], o[1]); w.y = cvt_pk_bf16(o[2], o[3]); w.z = cvt_pk_bf16(o[4], o[5]); w.w = cvt_pk_bf16(o[6], o[7]);
            *(u32x4*)(Y + row * D + col0 + bj * 128) = w; }
    }
};
struct EpiOut {
    static constexpr bool PERM = true;
    bf16* C; float* RSS;
    DEV void operator()(const f32x4 (&acc)[2][2][4][2], const pg8::Unit& u, int wr, int wc, int fr, int fq) const {
        const int row0 = u.pm * 256 + wr * 64 + fr, col0 = u.pn * 256 + wc * 32 + 8 * fq;
#pragma unroll
        for (int ai = 0; ai < 2; ++ai)
#pragma unroll
            for (int m = 0; m < 4; ++m) { const size_t row = (size_t)(row0 + ai * 128 + m * 16); bf16* rowp = C + row * D + col0; float ss = 0.f;
#pragma unroll
                for (int bj = 0; bj < 2; ++bj) { const f32x4 v0 = acc[ai][bj][m][0], v1 = acc[ai][bj][m][1];
                    ss += ((v0[0] * v0[0] + v0[1] * v0[1]) + (v0[2] * v0[2] + v0[3] * v0[3])) + ((v1[0] * v1[0] + v1[1] * v1[1]) + (v1[2] * v1[2] + v1[3] * v1[3]));
                    u32x4 w; w.x = cvt_pk_bf16(v0[0], v0[1]); w.y = cvt_pk_bf16(v0[2], v0[3]); w.z = cvt_pk_bf16(v1[0], v1[1]); w.w = cvt_pk_bf16(v1[2], v1[3]);
                    *(u32x4*)(rowp + bj * 128) = w; }
                ss += __shfl_xor(ss, 16); ss += __shfl_xor(ss, 32);
                if (fq == 0) RSS[row * NRS + u.pn * 4 + wc] = ss; }
    }
};

#ifndef EMU
typedef GAS unsigned gu32;
#define RLX_AGENT __ATOMIC_RELAXED, __HIP_MEMORY_SCOPE_AGENT
#define XB_TMO      128
#define XB_XCNT(j)  (256  + 64 * (j))
#define XB_XSUB(j)  (1280 + 64 * (j))
#define XB_XGEN(j)  (2304 + 64 * (j))
#define XB_TOP      3328
#define XB_TOPGEN   3392
#define XCD_BAR_WORDS 3456
#define XB_SPIN_CAP (1u << 22)
__device__ __forceinline__ unsigned xb_ld(unsigned* p)              { return __hip_atomic_load(p, __ATOMIC_RELAXED, __HIP_MEMORY_SCOPE_AGENT); }
__device__ __forceinline__ unsigned xb_add(unsigned* p, unsigned v) { return __hip_atomic_fetch_add(p, v, __ATOMIC_RELAXED, __HIP_MEMORY_SCOPE_AGENT); }
__device__ __forceinline__ unsigned xb_xcc_id() { return (unsigned)__builtin_amdgcn_s_getreg((3 << 11) | 20) & 0xFu; }
#define XB_SPIN(cond, bar) do { unsigned _sp = 0; while (cond) { __builtin_amdgcn_s_sleep(1); \
    if ((++_sp & 255u) == 0u) { if (xb_ld(&(bar)[XB_TMO])) break; if (_sp > XB_SPIN_CAP) { atomicAdd(&(bar)[XB_TMO], 1u); break; } } } } while (0)
struct XcdBarrier { unsigned* bar; unsigned x; volatile LAS unsigned* st; };
__device__ __forceinline__ XcdBarrier xcd_barrier_post(unsigned* bar, volatile LAS unsigned* st) {
    XcdBarrier b; b.bar = bar; b.x = xb_xcc_id(); b.st = st;
    if (threadIdx.x == 0) (void)xb_add(&bar[XB_XCNT(b.x)], 1u);
    return b;
}
__device__ __forceinline__ void xcd_barrier_complete(unsigned* bar, unsigned x, unsigned& nloc, unsigned& nx) {
    const unsigned G = gridDim.x * gridDim.y * gridDim.z;
    unsigned sum, cnt, mine, sp = 0u;
    for (;;) {
        sum = 0u; cnt = 0u; mine = 0u;
#pragma unroll
        for (unsigned j = 0; j < 16; ++j) { const unsigned c = xb_ld(&bar[XB_XCNT(j)]); sum += c; cnt += (c > 0u) ? 1u : 0u; mine = (j == x) ? c : mine; }
        if (sum == G) break;
        __builtin_amdgcn_s_sleep(1);
        if ((++sp & 255u) == 0u) { if (xb_ld(&bar[XB_TMO])) break; if (sp > XB_SPIN_CAP) { atomicAdd(&bar[XB_TMO], 1u); break; } }
    }
    nloc = mine > 0u ? mine : 1u; nx = cnt > 0u ? cnt : 1u;
}
__device__ __forceinline__ void xcd_barrier(const XcdBarrier& b) {
    asm volatile("s_waitcnt vmcnt(0)" ::: "memory");
    __syncthreads();
    if (threadIdx.x == 0) {
        unsigned* bar = b.bar;
        __builtin_amdgcn_s_waitcnt(0);
        unsigned nloc = b.st[0], nx = b.st[1];
        if (nloc == 0u) { xcd_barrier_complete(bar, b.x, nloc, nx); b.st[0] = nloc; b.st[1] = nx; }
        const unsigned old = xb_add(&bar[XB_XSUB(b.x)], 1u);
        const unsigned gen = old / nloc;
        if (old + 1u == (gen + 1u) * nloc) {
            __builtin_amdgcn_fence(__ATOMIC_RELEASE, "agent");
            asm volatile("s_waitcnt vmcnt(0)" ::: "memory");
            const unsigned og = xb_add(&bar[XB_TOP], 1u);
            const unsigned tg = og / nx;
            if (og + 1u == (tg + 1u) * nx) xb_add(&bar[XB_TOPGEN], 1u);
            else XB_SPIN(xb_ld(&bar[XB_TOPGEN]) == tg, bar);
            __builtin_amdgcn_fence(__ATOMIC_ACQUIRE, "agent");
            xb_add(&bar[XB_XGEN(b.x)], 1u);
            asm volatile("s_waitcnt vmcnt(0)" ::: "memory");
        } else {
            XB_SPIN(xb_ld(&bar[XB_XGEN(b.x)]) == gen, bar);
            __builtin_amdgcn_fence(__ATOMIC_ACQUIRE, "agent");
            asm volatile("s_waitcnt vmcnt(0)" ::: "memory");
        }
    }
    __syncthreads();
}
#endif

struct Args { const float* in[14]; float* out; unsigned char* ws; int ph_lo, ph_hi; };

DEV float clamp8(float x) { return fminf(fmaxf(x, -448.0f), 448.0f); }
DEV void pk_fp6x32(const float (&f)[32], unsigned (&o)[6]) {
    unsigned c[32];
#pragma unroll
    for (int i = 0; i < 32; ++i) { const float a = fminf(fabsf(f[i]), 7.5f); const float mlt = a < 2.0f ? 8.0f : (a < 4.0f ? 4.0f : 2.0f), off = a < 2.0f ? 0.0f : (a < 4.0f ? 8.0f : 16.0f);
        c[i] = (unsigned)(int)(__builtin_rintf(a * mlt) + off) | (f[i] < 0.0f ? 32u : 0u); }
#pragma unroll
    for (int g = 0; g < 2; ++g) { const unsigned* q = c + 16 * g;
        o[3 * g + 0] = q[0] | (q[1] << 6) | (q[2] << 12) | (q[3] << 18) | (q[4] << 24) | (q[5] << 30);
        o[3 * g + 1] = (q[5] >> 2) | (q[6] << 4) | (q[7] << 10) | (q[8] << 16) | (q[9] << 22) | (q[10] << 28);
        o[3 * g + 2] = (q[10] >> 4) | (q[11] << 2) | (q[12] << 8) | (q[13] << 14) | (q[14] << 20) | (q[15] << 26); }
}
struct P0Desc { const float* W; void* WT; int ldw, K, k0, c0, r0, nv, fp8; void* WT8; int r08; };
DEV void p0_load(const P0Desc& d, int lane, f32x4 (&v)[16]) {
    const int kr = lane >> 4, n4 = 4 * (lane & 15);
#pragma unroll
    for (int i = 0; i < 16; ++i) v[i] = (n4 < d.nv) ? *(const f32x4*)(d.W + (size_t)(d.k0 + 4 * i + kr) * d.ldw + d.c0 + n4) : (f32x4){0.f, 0.f, 0.f, 0.f};
}
DEV void p0_store(const P0Desc& d, const f32x4 (&v)[16], ldsp scr, int lane) {
    const int kr = lane >> 4, n4 = 4 * (lane & 15);
#pragma unroll
    for (int i = 0; i < 16; ++i) LDS_WR(f32x4, scr + ((4 * i + kr) * 68 + n4) * 4, v[i]);
    WAVE_SYNC();
    if (d.fp8 != 1) {
        bf16* WT = (bf16*)d.WT;
        const int c = lane & 7;
#pragma unroll
        for (int j = 0; j < 8; ++j) { const int n = (lane >> 3) + 8 * j; ldsp sp = scr + ((8 * c) * 68 + n) * 4;
            u32x4 o; o.x = pk2(LDS_RD(float, sp + 0 * 272), LDS_RD(float, sp + 1 * 272)); o.y = pk2(LDS_RD(float, sp + 2 * 272), LDS_RD(float, sp + 3 * 272));
            o.z = pk2(LDS_RD(float, sp + 4 * 272), LDS_RD(float, sp + 5 * 272)); o.w = pk2(LDS_RD(float, sp + 6 * 272), LDS_RD(float, sp + 7 * 272));
            if (n < d.nv) *(u32x4*)(WT + (size_t)(d.r0 + n) * d.K + d.k0 + 8 * c) = o; }
    }
    if (d.fp8 != 0) {
        unsigned char* WT = (unsigned char*)(d.fp8 == 2 ? d.WT8 : d.WT); const int r8 = d.fp8 == 2 ? d.r08 : d.r0, K8 = d.fp8 == 2 ? D : d.K;
        const int c = lane & 1;
#pragma unroll
        for (int j = 0; j < 2; ++j) { const int n = (lane >> 1) + 32 * j; ldsp sp = scr + ((32 * c) * 68 + n) * 4; float f[32]; unsigned o[6];
#pragma unroll
            for (int i = 0; i < 32; ++i) f[i] = LDS_RD(float, sp + i * 272) * W8_SCALE;
            pk_fp6x32(f, o);
            if (n < d.nv) { unsigned char* dst = WT + (size_t)(r8 + n) * K8 + d.k0 + 32 * c; *(u32x4*)dst = (u32x4){o[0], o[1], o[2], o[3]}; *(u32x2*)(dst + 16) = (u32x2){o[4], o[5]}; } }
    }
    WAVE_SYNC();
}

constexpr int MS = 272, MS64 = 144;
constexpr int NUA = NB * HA * NCH, NUB = NB * HB * NCH;
constexpr size_t TW_QA = 0, TW_KA = TW_QA + (size_t)NUA * 16384, TW_PA = TW_KA + (size_t)NUA * 16384, TW_VA = TW_PA + (size_t)NUA * 8192, TW_ENDA = TW_VA + (size_t)NUA * 2048;
constexpr size_t TW_QB = 0, TW_KB = TW_QB + (size_t)NUB * 16384, TW_PB = TW_KB + (size_t)NUB * 16384, TW_SB = TW_PB + (size_t)NUB * 8192, TW_ENDB = TW_SB + (size_t)NUB * 2048;
static_assert(TW_ENDA <= (size_t)(NP + 16) * D * 2 && TW_ENDB <= (size_t)M * D * 2, "operand tiles must fit the dead W1T / h regions");
DEV int swz(int row, int chunk) { return row * 256 + ((chunk ^ (row & 15)) << 4); }
DEV int swz64(int row, int chunk) { return row * 128 + ((chunk ^ (row & 7)) << 4); }
DEV bf16x8 frag16p(ldsp img, int row0, int ks, int lane) { return LDS_RD(bf16x8, img + swz64(row0 + (lane & 15), 4 * ks + (lane >> 4))); }

DEV bf16x8 frag16(ldsp buf, int stride, int row0, int ks, int lane) { return LDS_RD(bf16x8, buf + (row0 + (lane & 15)) * stride + ks * 64 + (lane >> 4) * 16); }
DEV bf16x8 frag16s(ldsp img, int row0, int ks, int lane) { return LDS_RD(bf16x8, img + swz(row0 + (lane & 15), 4 * ks + (lane >> 4))); }
DEV bf16x8 frag8x2s(ldsp img, int row0, int ks, int lane) {
    const int row = row0 + (lane & 15), q = lane >> 4;
    const bf16x4 lo = LDS_RD(bf16x4, img + swz(row, 4 * ks + (q >> 1)) + (q & 1) * 8), hi = LDS_RD(bf16x4, img + swz(row, 4 * ks + 2 + (q >> 1)) + (q & 1) * 8);
    return (bf16x8){lo[0], lo[1], lo[2], lo[3], hi[0], hi[1], hi[2], hi[3]};
}
DEV bf16x8 frag_tr(ldsp img, int n0, int ks, int lane, int stride = 256) {
    ldsp p = img + (32 * ks + 8 * (lane >> 4) + ((lane & 15) >> 2)) * stride + (n0 + 4 * (lane & 3)) * 2;
    const bf16x4 lo = lds_tr16(p), hi = lds_tr16(p + 4 * stride);
    return (bf16x8){lo[0], lo[1], lo[2], lo[3], hi[0], hi[1], hi[2], hi[3]};
}
DEV bf16x8 frag_trs(ldsp img, int n0, int ks, int lane) {
    const int row = 32 * ks + 8 * (lane >> 4) + ((lane & 15) >> 2), p = lane & 3, ch = (n0 >> 3) + (p >> 1);
    const bf16x4 lo = lds_tr16(img + swz(row, ch) + (p & 1) * 8), hi = lds_tr16(img + swz(row + 4, ch) + (p & 1) * 8);
    return (bf16x8){lo[0], lo[1], lo[2], lo[3], hi[0], hi[1], hi[2], hi[3]};
}
DEV void dma_lin(const void* src, int ninst, ldsp dst, int wave, int lane) {
    for (int i = wave; i < ninst; i += NWAVES) GLDS16X((const char*)src + i * 1024 + 16 * lane, dst + i * 1024);
}
DEV float sigm2(float x) { return frcp(1.0f + fexp2(-LOG2E * x)); }
DEV u32x2 pack4(const f32x4 v) { u32x2 w; w.x = cvt_pk_bf16(v[0], v[1]); w.y = cvt_pk_bf16(v[2], v[3]); return w; }

DEV float scan_add(float v, int lane) {
#pragma unroll
    for (int o = 1; o < 64; o <<= 1) { const float t = __shfl_up(v, o); if (lane >= o) v += t; }
    return v;
}
DEV float scan_max(float v, int lane) {
#pragma unroll
    for (int o = 1; o < 64; o <<= 1) { const float t = __shfl_up(v, o); if (lane >= o) v = fmaxf(v, t); }
    return v;
}

constexpr int PA_RAW = 0, PA_RAWSZ = 2 * 68 * 256, PA_TOT = 2 * PA_RAWSZ, PA_IQ = PA_TOT + 8 * 128 * 4, PA_IK = PA_IQ + 16384, PA_SC = PA_IK + 16384, PA_END = PA_SC + 1024;
static_assert(PA_END <= RING_BYTES, "P2 LDS");
DEV void p2_issue(const Args& args, int u, ldsp raw, int wave, int lane) {
    const bf16* P = (const bf16*)(args.ws + WS_P);
    if (u < NUA) { const int bh = u / NCH, j = u % NCH, b = bh / HA, h = bh % HA; const size_t tok0 = (size_t)b * SEQ + 64 * j;
        dma_lin(P + p_off(tok0, C_QA + h * 128), 16, raw, wave, lane); dma_lin(P + p_off(tok0, C_FA + h * 128), 16, raw + 68 * 256, wave, lane); }
    else { const int ub = u - NUA, bh = ub / NCH, j = ub % NCH, b = bh / HB, h = bh % HB; const size_t tok0 = (size_t)b * SEQ + 64 * j;
        dma_lin(P + p_off(tok0, C_QB + h * 128) - 3 * 128, 17, raw, wave, lane); dma_lin(P + p_off(tok0, C_KB + h * 128) - 3 * 128, 17, raw + 68 * 256, wave, lane); }
}
DEV void p2_scores(ldsp lds, f32x4 (&sc)[2], int wave, int lane) {
    const int ct = wave >> 1, st0 = 2 * (wave & 1);
    sc[0] = (f32x4){0.f, 0.f, 0.f, 0.f}; sc[1] = (f32x4){0.f, 0.f, 0.f, 0.f};
#pragma unroll
    for (int ks = 0; ks < 4; ++ks) { const bf16x8 qf = frag16s(lds + PA_IQ, 16 * ct, ks, lane);
#pragma unroll
        for (int n = 0; n < 2; ++n) { const bf16x8 kf_ = frag16s(lds + PA_IK, 16 * (st0 + n), ks, lane); sc[n] = MFMA16(kf_, qf, sc[n]); } }
}
DEV void p2_unit(const Args& args, ldsp lds, int u, ldsp raw, int wave, int lane) {
    unsigned char* TW = args.ws + WS_W1T;
    const int q4 = lane >> 4, l15 = lane & 15;
    if (u < NUA) {
        const int bh = u / NCH, h = bh % HA;
        const float* lbl = args.in[3];
        float lbv[2];
#pragma unroll
        for (int e = 0; e < 2; ++e) { const int col = h * 128 + 2 * lane + e; lbv[e] = frcp(1.0f + fexp(lbl[DA + col] - lbl[col])); }
        float lf[8][2], qv[8][2], kv[8][2];
#pragma unroll
        for (int c = 0; c < 8; ++c) { const unsigned qw = LDS_RD(unsigned, raw + (8 * wave + c) * 256 + lane * 4), fw = LDS_RD(unsigned, raw + 68 * 256 + (8 * wave + c) * 256 + lane * 4);
#pragma unroll
            for (int e = 0; e < 2; ++e) { const float f = lbv[e] + (1.0f - lbv[e]) * sigm2(__builtin_bit_cast(float, e ? (fw & 0xffff0000u) : (fw << 16))); lf[c][e] = flog2(f); kv[c][e] = 1.0f - f; qv[c][e] = __builtin_bit_cast(float, e ? (qw & 0xffff0000u) : (qw << 16)); } }
#pragma unroll
        for (int c = 1; c < 8; ++c) { lf[c][0] += lf[c - 1][0]; lf[c][1] += lf[c - 1][1]; }
        LDS_WR(f32x2, lds + PA_TOT + (wave * 128 + 2 * lane) * 4, ((f32x2){lf[7][0], lf[7][1]}));
        MIX_BAR();
        f32x2 off = (f32x2){0.f, 0.f}, bmid = (f32x2){0.f, 0.f}, g = (f32x2){0.f, 0.f};
#pragma unroll
        for (int w = 0; w < 8; ++w) { const f32x2 t = LDS_RD(f32x2, lds + PA_TOT + (w * 128 + 2 * lane) * 4); if (w < wave) off += t; if (w < 4) bmid += t; g += t; }
        if (wave == 0) { float* vec = (float*)(TW + TW_VA + (size_t)u * 2048) + 2 * lane;
            *(f32x2*)vec = (f32x2){fexp2(bmid[0]), fexp2(bmid[1])}; *(f32x2*)(vec + 128) = (f32x2){fexp2(g[0]), fexp2(g[1])}; *(f32x2*)(vec + 256) = (f32x2){fexp2(g[0] - bmid[0]), fexp2(g[1] - bmid[1])}; }
        unsigned qr8[8], kr8[8];
#pragma unroll
        for (int c = 0; c < 8; ++c) { float qr[2], kk[2]; const int r = 8 * wave + c;
#pragma unroll
            for (int e = 0; e < 2; ++e) { const float t1 = lf[c][e] + off[e] - bmid[e]; qr[e] = qv[c][e] * fexp2(t1); kk[e] = kv[c][e] * fexp2(-t1); }
            qr8[c] = cvt_pk_bf16(qr[0], qr[1]); kr8[c] = cvt_pk_bf16(kk[0], kk[1]);
            LDS_WR(unsigned, lds + PA_IQ + swz(r, lane >> 2) + (lane & 3) * 4, qr8[c]); LDS_WR(unsigned, lds + PA_IK + swz(r, lane >> 2) + (lane & 3) * 4, kr8[c]); }
        MIX_BAR();
        f32x4 sc[2]; p2_scores(lds, sc, wave, lane);
        unsigned char* tq = TW + TW_QA + (size_t)u * 16384; unsigned char* tk = TW + TW_KA + (size_t)u * 16384; unsigned char* tp = TW + TW_PA + (size_t)u * 8192;
#pragma unroll
        for (int c = 0; c < 8; ++c) { const int r = 8 * wave + c; *(unsigned*)(tq + swz(r, lane >> 2) + (lane & 3) * 4) = qr8[c]; *(unsigned*)(tk + swz(r, lane >> 2) + (lane & 3) * 4) = kr8[c]; }
#pragma unroll
        for (int n = 0; n < 2; ++n) { const int c = 16 * (wave >> 1) + l15, s0_ = 16 * (2 * (wave & 1) + n) + 4 * q4; f32x4 v = sc[n];
#pragma unroll
            for (int r = 0; r < 4; ++r) v[r] = (s0_ + r <= c) ? v[r] : 0.f;
            *(u32x2*)(tp + swz64(c, s0_ >> 3) + (q4 & 1) * 8) = pack4(v); }
    } else {
        const int ub = u - NUA, bh = ub / NCH, j = ub % NCH, b = bh / HB, h = bh % HB;
        const float* cw = args.in[4]; const float* cb = args.in[5];
        f32x2 wq[4], wk[4];
#pragma unroll
        for (int k = 0; k < 4; ++k) { wq[k] = *(const f32x2*)(cw + k * (2 * DQK) + h * 128 + 2 * lane); wk[k] = *(const f32x2*)(cw + k * (2 * DQK) + DQK + h * 128 + 2 * lane); }
        const f32x2 bq = *(const f32x2*)(cb + h * 128 + 2 * lane), bk = *(const f32x2*)(cb + DQK + h * 128 + 2 * lane);
        unsigned uq[11], uk[11];
#pragma unroll
        for (int i = 0; i < 11; ++i) { const bool neg = (64 * j + 8 * wave + i - 3) < 0;
            const unsigned a = LDS_RD(unsigned, raw + (8 * wave + i) * 256 + lane * 4), bb = LDS_RD(unsigned, raw + 68 * 256 + (8 * wave + i) * 256 + lane * 4); uq[i] = neg ? 0u : a; uk[i] = neg ? 0u : bb; }
        unsigned char* TWB = args.ws + WS_HB;
        float* sb = (float*)(TWB + TW_SB + (size_t)ub * 2048);
        if (wave == 0) {
            const size_t tok = (size_t)b * SEQ + 64 * j + lane; const float* SG = (const float*)(args.ws + WS_SG);
            const float fp = SG[tok * 16 + HB + h] + args.in[7][h], ig = SG[tok * 16 + h] + args.in[6][h];
            const float bc = scan_add(logsig(fp), lane), a = ig - bc, pm = scan_max(a, lane);
            sb[lane] = pm; sb[64 + lane] = bc;
            LDS_WR(float, lds + PA_SC + lane * 4, a * LOG2E); LDS_WR(float, lds + PA_SC + 256 + lane * 4, pm * LOG2E);
        }
        unsigned q8[8]; float kf[8][2];
#pragma unroll
        for (int c = 0; c < 8; ++c) { float qq[2]; const int r = 8 * wave + c;
#pragma unroll
            for (int e = 0; e < 2; ++e) { float yq = bq[e], yk = bk[e];
#pragma unroll
                for (int k = 0; k < 4; ++k) { yq += wq[k][e] * __builtin_bit_cast(float, e ? (uq[c + k] & 0xffff0000u) : (uq[c + k] << 16)); yk += wk[k][e] * __builtin_bit_cast(float, e ? (uk[c + k] & 0xffff0000u) : (uk[c + k] << 16)); }
                qq[e] = yq * sigm2(yq); kf[c][e] = yk * sigm2(yk) * 0.08838834764831845f; }
            q8[c] = cvt_pk_bf16(qq[0], qq[1]);
            LDS_WR(unsigned, lds + PA_IQ + swz(r, lane >> 2) + (lane & 3) * 4, q8[c]); LDS_WR(unsigned, lds + PA_IK + swz(r, lane >> 2) + (lane & 3) * 4, cvt_pk_bf16(kf[c][0], kf[c][1])); }
        MIX_BAR();
        const float pm63 = LDS_RD(float, lds + PA_SC + 256 + 63 * 4);
        unsigned kw8[8]; float na[2] = {0.f, 0.f};
#pragma unroll
        for (int c = 0; c < 8; ++c) { const float w_ = fexp2(LDS_RD(float, lds + PA_SC + (8 * wave + c) * 4) - pm63); const float k0 = w_ * kf[c][0], k1 = w_ * kf[c][1]; na[0] += k0; na[1] += k1; kw8[c] = cvt_pk_bf16(k0, k1); }
        LDS_WR(f32x2, lds + PA_TOT + (wave * 128 + 2 * lane) * 4, ((f32x2){na[0], na[1]}));
        f32x4 sc[2]; p2_scores(lds, sc, wave, lane);
        const int ct = wave >> 1, st0 = 2 * (wave & 1), c_ = 16 * ct + l15;
        const float pmc = LDS_RD(float, lds + PA_SC + 256 + c_ * 4); float rs = 0.f; u32x2 pw[2];
#pragma unroll
        for (int n = 0; n < 2; ++n) { const int s0_ = 16 * (st0 + n) + 4 * q4; const f32x4 as = LDS_RD(f32x4, lds + PA_SC + s0_ * 4); f32x4 v;
#pragma unroll
            for (int r = 0; r < 4; ++r) { const float t = fexp2(as[r] - pmc) * sc[n][r]; v[r] = (s0_ + r <= c_) ? t : 0.f; rs += v[r]; }
            pw[n] = pack4(v); }
        rs += __shfl_xor(rs, 16); rs += __shfl_xor(rs, 32);
        MIX_BAR();
        if (wave < 2) { const int dcol = wave * 64 + lane; float nl = 0.f;
#pragma unroll
            for (int w = 0; w < 8; ++w) nl += LDS_RD(float, lds + PA_TOT + (w * 128 + dcol) * 4);
            sb[256 + dcol] = nl; }
        if (q4 == 0) sb[128 + c_ * 2 + (wave & 1)] = rs;
        unsigned char* tq = TWB + TW_QB + (size_t)ub * 16384; unsigned char* tk = TWB + TW_KB + (size_t)ub * 16384; unsigned char* tp = TWB + TW_PB + (size_t)ub * 8192;
#pragma unroll
        for (int c = 0; c < 8; ++c) { const int r = 8 * wave + c; *(unsigned*)(tq + swz(r, lane >> 2) + (lane & 3) * 4) = q8[c]; *(unsigned*)(tk + swz(r, lane >> 2) + (lane & 3) * 4) = kw8[c]; }
#pragma unroll
        for (int n = 0; n < 2; ++n) { const int s0_ = 16 * (st0 + n) + 4 * q4; *(u32x2*)(tp + swz64(c_, s0_ >> 3) + (q4 & 1) * 8) = pw[n]; }
    }
}

constexpr int PB_BUFSZ = 51200, PB_Q = 0, PB_K = 16384, PB_V = 32768, PB_P = 40960, PB_VEC = 49152;
constexpr int PB_XS = 2 * PB_BUFSZ, PB_SM = PB_XS + 2 * 16384;
constexpr int SM_SSQ = PB_SM;
constexpr int SM_R = SM_SSQ + 2 * 64 * 4 * 4, SM_INT = SM_R + 256, SM_EMT = SM_INT + 256, SM_RS = SM_EMT + 256, SM_SCAL = SM_RS + 256;
constexpr int SM_NV = SM_SCAL + 64, SM_QN = SM_NV + 512, MX_END = SM_QN + 256;
static_assert(MX_END <= RING_BYTES, "mixer LDS");
DEV void dma_rows64(const void* src, ldsp dst, int wave, int lane) { GLDS16S((const char*)src + wave * 2048, (lane >> 3) * 256 + (lane & 7) * 16, dst + wave * 1024); }

DEV void mixer_a_job(const Args& args, ldsp lds, int b, int h, int vh, int tid_) {
    const int wave = RFL(tid_ >> 6), vt = wave & 3, hf = wave >> 2;
    const bf16* P = (const bf16*)(args.ws + WS_P);
    const unsigned char* TW = args.ws + WS_W1T;
    const rsrc_t RO = make_rsrc(args.ws + WS_OAB, (unsigned)((size_t)2 * M * LDU * 2));
    float* SSA = (float*)(args.ws + WS_SSA);
    const int u0 = (b * HA + h) * NCH, vcol = h * 128 + 64 * vh;
    f32x4 st[4], o[2];
#pragma unroll
    for (int t = 0; t < 4; ++t) st[t] = (f32x4){0.f, 0.f, 0.f, 0.f};
    o[0] = (f32x4){0.f, 0.f, 0.f, 0.f}; o[1] = (f32x4){0.f, 0.f, 0.f, 0.f};
    { const u32x4 z = (u32x4){0u, 0u, 0u, 0u}; const int lane = tid_ & 63;
        LDS_WR(u32x4, lds + PB_XS + 16384 + (vt * 2 + hf) * 2048 + lane * 16, z); LDS_WR(u32x4, lds + PB_XS + 16384 + (vt * 2 + hf) * 2048 + 1024 + lane * 16, z); }
#define MA_DMA(jj) do { ldsp bf_ = lds + ((jj) & 1) * PB_BUFSZ; const size_t uu_ = (size_t)(u0 + (jj)); \
        dma_lin(TW + TW_QA + uu_ * 16384, 16, bf_ + PB_Q, wave, lane); dma_lin(TW + TW_KA + uu_ * 16384, 16, bf_ + PB_K, wave, lane); \
        dma_rows64(P + p_off((size_t)b * SEQ + 64 * (jj), C_IA + h * 128) + 64 * vh, bf_ + PB_V, wave, lane); dma_lin(TW + TW_PA + uu_ * 8192, 8, bf_ + PB_P, wave, lane); dma_lin(TW + TW_VA + uu_ * 2048, 2, bf_ + PB_VEC, wave, lane); } while (0)
    { const int lane = tid_ & 63; MA_DMA(0); }
    for (int j = 0; j <= NCH; ++j) {
        int tidj = tid_; OPAQUE(tidj);
        const int lane = tidj & 63, q4 = lane >> 4, l15 = lane & 15;
        const size_t tk0 = (size_t)b * SEQ + 64 * j;
        if (j <= 1) WAIT_V(0); else WAIT_V(2);
        MIX_BAR();
        if (j + 1 < NCH) MA_DMA(j + 1);
        if (j > 0) {
            if (wave == 0) { const f32x4 s0 = LDS_RD(f32x4, lds + SM_SSQ + ((j - 1) & 1) * 1024 + lane * 16); SSA[((tk0 - 64 + lane) * HA + h) * 2 + vh] = (s0[0] + s0[1]) + (s0[2] + s0[3]); }
#pragma unroll
            for (int i = 0; i < 2; ++i) bstore64(RO, (unsigned)(l15 * LDU + vcol + 16 * vt + 4 * q4) * 2u, (unsigned)(tk0 - 64 + 16 * (2 * hf + i)) * (unsigned)(LDU * 2), pack4(o[i]));
        }
        if (j == NCH) break;
        ldsp bf = lds + (j & 1) * PB_BUFSZ;
        bf16x8 bv[2], pf[2][2], qo[2][2], qp[2][2], so[2], sp[2];
#pragma unroll
        for (int ks = 0; ks < 2; ++ks) bv[ks] = frag_tr(bf + PB_V, 16 * vt, ks, lane, 128);
#pragma unroll
        for (int ks = 0; ks < 2; ++ks)
#pragma unroll
            for (int i = 0; i < 2; ++i) pf[ks][i] = frag16p(bf + PB_P, 16 * (2 * hf + i), ks, lane);
#pragma unroll
        for (int kl = 0; kl < 2; ++kl)
#pragma unroll
            for (int i = 0; i < 2; ++i) { qo[kl][i] = frag8x2s(bf + PB_Q, 16 * (2 * hf + i), 2 * hf + kl, lane); qp[kl][i] = frag8x2s(bf + PB_Q, 16 * (2 * hf + i), 2 * (hf ^ 1) + kl, lane); }
        u32x4 xp[2];
#pragma unroll
        for (int kl = 0; kl < 2; ++kl) xp[kl] = LDS_RD(u32x4, lds + PB_XS + ((j + 1) & 1) * 16384 + (vt * 2 + (hf ^ 1)) * 2048 + kl * 1024 + lane * 16);
        f32x4 eo[4], ep[4];
#pragma unroll
        for (int t = 0; t < 4; ++t) { eo[t] = LDS_RD(f32x4, bf + PB_VEC + (16 * (4 * hf + t) + 4 * q4) * 4); ep[t] = LDS_RD(f32x4, bf + PB_VEC + (16 * (4 * (hf ^ 1) + t) + 4 * q4) * 4); }
        SCHED_BAR();
#pragma unroll
        for (int kl = 0; kl < 2; ++kl) {
            { u32x4 w; const f32x4 a0 = st[2 * kl] * eo[2 * kl], a1 = st[2 * kl + 1] * eo[2 * kl + 1]; w.x = cvt_pk_bf16(a0[0], a0[1]); w.y = cvt_pk_bf16(a0[2], a0[3]); w.z = cvt_pk_bf16(a1[0], a1[1]); w.w = cvt_pk_bf16(a1[2], a1[3]);
              so[kl] = __builtin_bit_cast(bf16x8, w); }
            { u32x4 w; const f32x4 e0 = ep[2 * kl], e1 = ep[2 * kl + 1]; const u32x4 x = xp[kl];
              w.x = cvt_pk_bf16(__builtin_bit_cast(float, x.x << 16) * e0[0], __builtin_bit_cast(float, x.x & 0xffff0000u) * e0[1]); w.y = cvt_pk_bf16(__builtin_bit_cast(float, x.y << 16) * e0[2], __builtin_bit_cast(float, x.y & 0xffff0000u) * e0[3]);
              w.z = cvt_pk_bf16(__builtin_bit_cast(float, x.z << 16) * e1[0], __builtin_bit_cast(float, x.z & 0xffff0000u) * e1[1]); w.w = cvt_pk_bf16(__builtin_bit_cast(float, x.w << 16) * e1[2], __builtin_bit_cast(float, x.w & 0xffff0000u) * e1[3]);
              sp[kl] = __builtin_bit_cast(bf16x8, w); } }
        o[0] = (f32x4){0.f, 0.f, 0.f, 0.f}; o[1] = (f32x4){0.f, 0.f, 0.f, 0.f};
#pragma unroll
        for (int ks = 0; ks < 2; ++ks)
#pragma unroll
            for (int i = 0; i < 2; ++i) o[i] = MFMA16(bv[ks], pf[ks][i], o[i]);
#pragma unroll
        for (int kl = 0; kl < 2; ++kl)
#pragma unroll
            for (int i = 0; i < 2; ++i) { o[i] = MFMA16(so[kl], qo[kl][i], o[i]); o[i] = MFMA16(sp[kl], qp[kl][i], o[i]); }
#pragma unroll
        for (int i = 0; i < 4; ++i) { const int t = 4 * hf + i;
            f32x4 u = (f32x4){0.f, 0.f, 0.f, 0.f};
#pragma unroll
            for (int ks = 0; ks < 2; ++ks) { const bf16x8 a = frag_trs(bf + PB_K, 16 * t, ks, lane); u = MFMA16(a, bv[ks], u); }
            const f32x4 eg = LDS_RD(f32x4, bf + PB_VEC + 512 + (16 * t + 4 * q4) * 4), egm = LDS_RD(f32x4, bf + PB_VEC + 1024 + (16 * t + 4 * q4) * 4); st[i] = eg * st[i] + egm * u; }
#pragma unroll
        for (int kl = 0; kl < 2; ++kl) { u32x4 w; const f32x4 a0 = st[2 * kl], a1 = st[2 * kl + 1]; w.x = cvt_pk_bf16(a0[0], a0[1]); w.y = cvt_pk_bf16(a0[2], a0[3]); w.z = cvt_pk_bf16(a1[0], a1[1]); w.w = cvt_pk_bf16(a1[2], a1[3]);
            LDS_WR(u32x4, lds + PB_XS + (j & 1) * 16384 + (vt * 2 + hf) * 2048 + kl * 1024 + lane * 16, w); }
#pragma unroll
        for (int i = 0; i < 2; ++i) { float s_ = (o[i][0] * o[i][0] + o[i][1] * o[i][1]) + (o[i][2] * o[i][2] + o[i][3] * o[i][3]); s_ += __shfl_xor(s_, 16); s_ += __shfl_xor(s_, 32);
            LDS_WR(float, lds + SM_SSQ + (j & 1) * 1024 + ((16 * (2 * hf + i) + l15) * 4 + vt) * 4, s_); }
    }
#undef MA_DMA
}

DEV void mixer_b_job(const Args& args, ldsp lds, int b, int h, int vq, int tid_) {
    const int wave = RFL(tid_ >> 6), vt = wave & 3, hf = wave >> 2;
    const int vbase = h * 256 + 64 * vq;
    const bf16* P = (const bf16*)(args.ws + WS_P);
    const unsigned char* TW = args.ws + WS_HB;
    const rsrc_t RO = make_rsrc(args.ws + WS_OAB, (unsigned)((size_t)2 * M * LDU * 2));
    float* SSB = (float*)(args.ws + WS_SSB);
    const int u0 = (b * HB + h) * NCH;
    f32x4 st[4], hv[2];
#pragma unroll
    for (int t = 0; t < 4; ++t) st[t] = (f32x4){0.f, 0.f, 0.f, 0.f};
    hv[0] = (f32x4){0.f, 0.f, 0.f, 0.f}; hv[1] = (f32x4){0.f, 0.f, 0.f, 0.f};
    float mcar = 0.f;
    if (wave < 2) LDS_WR(float, lds + SM_NV + tid_ * 4, 0.f);
    { const u32x4 z = (u32x4){0u, 0u, 0u, 0u}; const int lane = tid_ & 63;
        LDS_WR(u32x4, lds + PB_XS + 16384 + (vt * 2 + hf) * 2048 + lane * 16, z); LDS_WR(u32x4, lds + PB_XS + 16384 + (vt * 2 + hf) * 2048 + 1024 + lane * 16, z); }
#define MB_DMA(jj) do { ldsp bf_ = lds + ((jj) & 1) * PB_BUFSZ; const size_t uu_ = (size_t)(u0 + (jj)); \
        dma_lin(TW + TW_QB + uu_ * 16384, 16, bf_ + PB_Q, wave, lane); dma_lin(TW + TW_KB + uu_ * 16384, 16, bf_ + PB_K, wave, lane); \
        dma_rows64(P + p_off((size_t)b * SEQ + 64 * (jj), C_VB + h * 256 + 128 * (vq >> 1)) + 64 * (vq & 1), bf_ + PB_V, wave, lane); dma_lin(TW + TW_PB + uu_ * 8192, 8, bf_ + PB_P, wave, lane); dma_lin(TW + TW_SB + uu_ * 2048, 2, bf_ + PB_VEC, wave, lane); } while (0)
    { const int lane = tid_ & 63; MB_DMA(0); }
    for (int j = 0; j <= NCH; ++j) {
        const size_t tk0 = (size_t)b * SEQ + 64 * j;
        int tidj = tid_; OPAQUE(tidj);
        const int tid = tidj, lane = tidj & 63, q4 = lane >> 4, l15 = lane & 15;
        if (j <= 1) WAIT_V(0); else WAIT_V(2);
        MIX_BAR();
        if (j + 1 < NCH) MB_DMA(j + 1);
        if (j > 0) {
            if (wave == 0) { const f32x4 s0 = LDS_RD(f32x4, lds + SM_SSQ + ((j - 1) & 1) * 1024 + lane * 16); SSB[((tk0 - 64 + lane) * HB + h) * 4 + vq] = (s0[0] + s0[1]) + (s0[2] + s0[3]); }
#pragma unroll
            for (int i = 0; i < 2; ++i) bstore64(RO, (unsigned)(l15 * LDU + vbase + 16 * vt + 4 * q4) * 2u, (unsigned)(M + tk0 - 64 + 16 * (2 * hf + i)) * (unsigned)(LDU * 2), pack4(hv[i]));
        }
        if (j == NCH) break;
        ldsp bf = lds + (j & 1) * PB_BUFSZ;
        if (wave == 0) {
            const float pm = LDS_RD(float, bf + PB_VEC + lane * 4), bc = LDS_RD(float, bf + PB_VEC + 256 + lane * 4); const f32x2 rsl = LDS_RD(f32x2, bf + PB_VEC + 512 + lane * 8);
            const float mx = fmaxf(mcar, pm), r = fexp(pm - mx);
            const float pm63 = __shfl(pm, 63), bc63 = __shfl(bc, 63), m63 = fmaxf(mcar, pm63);
            LDS_WR(float, lds + SM_R + lane * 4, r); LDS_WR(float, lds + SM_INT + lane * 4, fexp(mcar - mx)); LDS_WR(float, lds + SM_EMT + lane * 4, fexp(-(bc + mx))); LDS_WR(float, lds + SM_RS + lane * 4, r * (rsl[0] + rsl[1]));
            if (lane == 0) { LDS_WR(float, lds + SM_SCAL, fexp(mcar - m63)); LDS_WR(float, lds + SM_SCAL + 4, bc63 + m63); LDS_WR(float, lds + SM_SCAL + 8, fexp(pm63 - m63)); }
        }
        {
            const int c = tid >> 3, part = tid & 7; float s = 0.f;
#pragma unroll
            for (int hh = 0; hh < 2; ++hh) { const u32x4 qw = LDS_RD(u32x4, bf + PB_Q + swz(c, 2 * part + hh));
#pragma unroll
                for (int e = 0; e < 4; ++e) { const f32x2 nv = LDS_RD(f32x2, lds + SM_NV + (16 * part + 8 * hh + 2 * e) * 4); s += __builtin_bit_cast(float, qw[e] << 16) * nv[0] + __builtin_bit_cast(float, qw[e] & 0xffff0000u) * nv[1]; } }
            s += __shfl_xor(s, 1); s += __shfl_xor(s, 2); s += __shfl_xor(s, 4);
            LDS_WR(float, lds + SM_QN + c * 4, s);
        }
        MIX_BAR();
        const float decay = LDS_RD(float, lds + SM_SCAL), sj = LDS_RD(float, lds + SM_SCAL + 8);
        mcar = LDS_RD(float, lds + SM_SCAL + 4);
        {
            bf16x8 bv[2], pf[2][2], qo[2][2], qp[2][2], so[2], sp[2];
#pragma unroll
            for (int ks = 0; ks < 2; ++ks) bv[ks] = frag_tr(bf + PB_V, 16 * vt, ks, lane, 128);
#pragma unroll
            for (int ks = 0; ks < 2; ++ks)
#pragma unroll
                for (int i = 0; i < 2; ++i) pf[ks][i] = frag16p(bf + PB_P, 16 * (2 * hf + i), ks, lane);
#pragma unroll
            for (int kl = 0; kl < 2; ++kl)
#pragma unroll
                for (int i = 0; i < 2; ++i) { qo[kl][i] = frag8x2s(bf + PB_Q, 16 * (2 * hf + i), 2 * hf + kl, lane); qp[kl][i] = frag8x2s(bf + PB_Q, 16 * (2 * hf + i), 2 * (hf ^ 1) + kl, lane); }
#pragma unroll
            for (int kl = 0; kl < 2; ++kl) sp[kl] = LDS_RD(bf16x8, lds + PB_XS + ((j + 1) & 1) * 16384 + (vt * 2 + (hf ^ 1)) * 2048 + kl * 1024 + lane * 16);
            float s_int[2], s_r[2], s_qn[2], s_rs[2], s_emt[2];
#pragma unroll
            for (int i = 0; i < 2; ++i) { const int c = 16 * (2 * hf + i) + l15; s_int[i] = LDS_RD(float, lds + SM_INT + c * 4); s_r[i] = LDS_RD(float, lds + SM_R + c * 4); s_qn[i] = LDS_RD(float, lds + SM_QN + c * 4); s_rs[i] = LDS_RD(float, lds + SM_RS + c * 4); s_emt[i] = LDS_RD(float, lds + SM_EMT + c * 4); }
            SCHED_BAR();
#pragma unroll
            for (int kl = 0; kl < 2; ++kl) { u32x4 w; const f32x4 a0 = st[2 * kl], a1 = st[2 * kl + 1]; w.x = cvt_pk_bf16(a0[0], a0[1]); w.y = cvt_pk_bf16(a0[2], a0[3]); w.z = cvt_pk_bf16(a1[0], a1[1]); w.w = cvt_pk_bf16(a1[2], a1[3]); so[kl] = __builtin_bit_cast(bf16x8, w); }
#pragma unroll
            for (int i = 0; i < 2; ++i) {
                f32x4 a1 = (f32x4){0.f, 0.f, 0.f, 0.f}, a2 = (f32x4){0.f, 0.f, 0.f, 0.f};
#pragma unroll
                for (int ks = 0; ks < 2; ++ks) a2 = MFMA16(bv[ks], pf[ks][i], a2);
#pragma unroll
                for (int kl = 0; kl < 2; ++kl) { a1 = MFMA16(so[kl], qo[kl][i], a1); a1 = MFMA16(sp[kl], qp[kl][i], a1); }
                const float den = s_int[i] * s_qn[i] + s_rs[i];
                const float rden = frcp(fmaxf(fabsf(den), s_emt[i]));
                hv[i] = (s_int[i] * a1 + s_r[i] * a2) * rden;
            }
#pragma unroll
            for (int i = 0; i < 4; ++i) { const int t = 4 * hf + i;
                f32x4 u = (f32x4){0.f, 0.f, 0.f, 0.f};
#pragma unroll
                for (int ks = 0; ks < 2; ++ks) { const bf16x8 a = frag_trs(bf + PB_K, 16 * t, ks, lane); u = MFMA16(a, bv[ks], u); }
                st[i] = decay * st[i] + sj * u;
            }
#pragma unroll
            for (int kl = 0; kl < 2; ++kl) { u32x4 w; const f32x4 a0 = st[2 * kl], a1 = st[2 * kl + 1]; w.x = cvt_pk_bf16(a0[0], a0[1]); w.y = cvt_pk_bf16(a0[2], a0[3]); w.z = cvt_pk_bf16(a1[0], a1[1]); w.w = cvt_pk_bf16(a1[2], a1[3]);
                LDS_WR(u32x4, lds + PB_XS + (j & 1) * 16384 + (vt * 2 + hf) * 2048 + kl * 1024 + lane * 16, w); }
            if (wave < 2) LDS_WR(float, lds + SM_NV + tid * 4, decay * LDS_RD(float, lds + SM_NV + tid * 4) + sj * LDS_RD(float, bf + PB_VEC + 1024 + tid * 4));
#pragma unroll
            for (int i = 0; i < 2; ++i) { float s_ = (hv[i][0] * hv[i][0] + hv[i][1] * hv[i][1]) + (hv[i][2] * hv[i][2] + hv[i][3] * hv[i][3]); s_ += __shfl_xor(s_, 16); s_ += __shfl_xor(s_, 32);
                LDS_WR(float, lds + SM_SSQ + (j & 1) * 1024 + ((16 * (2 * hf + i) + l15) * 4 + vt) * 4, s_); }
        }
    }
#undef MB_DMA
}

constexpr int P0_RB1 = (NP + NSG + 63) / 64, P0_I1 = (D / 64) * P0_RB1, P0_IU = (DA / 64) * (D / 64), P0_IO = (D / 64) * (D / 64), P0_NITEMS = P0_I1 + 2 * P0_IU + P0_IO;
DEV P0Desc p0_decode(const Args& args, int it) {
    unsigned char* ws = args.ws; bf16* W1T = (bf16*)(ws + WS_W1T); bf16* WUT = (bf16*)(ws + WS_WUT); bf16* WOT = (bf16*)(ws + WS_WOT);
    P0Desc d; int r = it;
    if (r < P0_I1) { const int kb = r / P0_RB1, rb = r % P0_RB1, r0 = 64 * rb; d.W = args.in[2]; d.ldw = D_IN; d.K = D; d.k0 = 64 * kb;
        if (r0 >= NPM && r0 < NP) { d.WT = ws + WS_W8; d.c0 = r0 + NSG; d.r0 = r0 - NPM; d.nv = 64; d.fp8 = 1; return d; }
        d.WT = W1T; d.fp8 = 0; d.r0 = r0;
        if (r0 >= C_OGA && r0 < C_OGA + DA) { d.fp8 = 2; d.WT8 = ws + WS_W8OG; d.r08 = r0 - C_OGA; }
        if (r0 >= C_OGB && r0 < C_OGB + DB) { d.fp8 = 2; d.WT8 = ws + WS_W8OG; d.r08 = DA + (r0 - C_OGB); }
        if (r0 < NPM) { d.c0 = r0; d.nv = 64; } else { d.c0 = NPM + (r0 - NP); d.nv = NSG - (r0 - NP) < 64 ? NSG - (r0 - NP) : 64; }
        return d; }
    r -= P0_I1; d.fp8 = 0; d.ldw = D; d.nv = 64;
    if (r < P0_IU) { const int kb = r / (D / 64), rb = r % (D / 64); d.W = args.in[10]; d.K = LDU; d.WT = WUT; d.k0 = 64 * kb; d.c0 = 64 * rb; d.r0 = 64 * rb; return d; }
    r -= P0_IU;
    if (r < P0_IU) { const int kb = r / (D / 64), rb = r % (D / 64); d.W = args.in[11]; d.K = LDU; d.WT = WUT + (size_t)D * LDU; d.k0 = 64 * kb; d.c0 = 64 * rb; d.r0 = 64 * rb; return d; }
    r -= P0_IU;
    { const int kb = r / (D / 64), rb = r % (D / 64); d.W = args.in[12]; d.K = D; d.WT = WOT; d.k0 = 64 * kb; d.c0 = 64 * rb; d.r0 = 64 * rb; return d; }
}
DEV void p0_items(const Args& args, int first, int last, int stride, ldsp scr, int lane) {
    if (first >= last) return;
    P0Desc d = p0_decode(args, first); f32x4 v[16]; p0_load(d, lane, v);
    for (int it = first; it < last; it += stride) {
        const int nx = it + stride; P0Desc dn = d; f32x4 vn[16];
        if (nx < last) { dn = p0_decode(args, nx); p0_load(dn, lane, vn); }
        p0_store(d, v, scr, lane);
        if (nx < last) { d = dn;
#pragma unroll
            for (int i = 0; i < 16; ++i) v[i] = vn[i]; }
    }
}

__global__ void __launch_bounds__(NTHREADS, 2) fwd_kernel(Args args) {
#ifndef EMU
    extern __shared__ __attribute__((aligned(16))) unsigned char lds_raw[];
    ldsp lds = (ldsp)lds_raw;
#else
    ldsp lds = emu_lds;
#endif
    const int tid = threadIdx.x, lane = tid & 63, wave = RFL(tid >> 6);
    const int G = gridDim.x, bx = blockIdx.x;
    const int vcu = (G % 8 == 0) ? (bx % 8) * (G / 8) + bx / 8 : bx;
    unsigned char* ws = args.ws;
#ifndef EMU
    for (int u = tid; u < (LDS_BYTES - LDSCTL_OFF) / 4; u += NTHREADS) ((LAS unsigned*)(lds + LDSCTL_OFF))[u] = 0u;
    __syncthreads();
    XcdBarrier bar = xcd_barrier_post((unsigned*)(ws + WS_CTL) + CW_BAR, (volatile LAS unsigned*)(lds + MISC_OFF) + 8);
#define GRID_BAR() xcd_barrier(bar)
#else
#define GRID_BAR()
#endif
    const int lo = args.ph_lo, hi = args.ph_hi;
#ifndef GEMM_SP2
#define GEMM_SP2 true
#endif
#ifndef GEMM_ALIGN
#define GEMM_ALIGN true
#endif
#ifndef PROBE_REP_P4
#define PROBE_REP_P4 1
#endif
#ifndef PROBE_REP_P5
#define PROBE_REP_P5 1
#endif
#ifndef PROBE_REP_P1
#define PROBE_REP_P1 2
#endif
#ifndef PROBE_REP_P2
#define PROBE_REP_P2 1
#endif
#ifndef PHASE_MASK
#define PHASE_MASK 255
#endif
#define IN(k) (((PHASE_MASK >> (k)) & 1) && lo <= (k) && (k) < hi)
#define BOTH(k) (IN(k) && IN((k) + 1))
    const float* x = args.in[0];
    bf16* W1T = (bf16*)(ws + WS_W1T); bf16* WUT = (bf16*)(ws + WS_WUT); bf16* WOT = (bf16*)(ws + WS_WOT);
    bf16* HBUF = (bf16*)(ws + WS_HB); bf16* PB = (bf16*)(ws + WS_P); float* SG = (float*)(ws + WS_SG); bf16* OAB = (bf16*)(ws + WS_OAB); float* RSS = (float*)(ws + WS_RSS);

    if (IN(0)) {
        ldsp scr = lds + wave * 17408;
        const int gw = vcu * NWAVES + wave, NGW = G * NWAVES;
        constexpr int I_1 = P0_I1, NITEMS = P0_NITEMS;
        static_assert(NPM % 64 == 0 && NP % 64 == 0 && NSG % 4 == 0, "P0 item tiling");
        constexpr int NJOBS3 = NB * HA * 2 + NB * HB * 4;
        const int nit0 = (G > NJOBS3) ? I_1 : NITEMS;
        p0_items(args, gw, nit0, NGW, scr, lane);
        const float* gpre = args.in[1];
        for (int m = gw; m < M; m += NGW) {
            const f32x4* xr = (const f32x4*)(x + (size_t)m * D) + lane;
            f32x4 v[D / 256]; float s = 0.f;
#pragma unroll
            for (int jj = 0; jj < D / 256; ++jj) { v[jj] = xr[64 * jj]; s += (v[jj][0] * v[jj][0] + v[jj][1] * v[jj][1]) + (v[jj][2] * v[jj][2] + v[jj][3] * v[jj][3]); }
            const float rstd = frsq(wave_sum(s) * (1.0f / D) + EPS) ;
            u32x2* o8 = (u32x2*)(HBUF + (size_t)m * D) + lane;
            constexpr int NJ = D / 256, GJ = NJ < 8 ? NJ : 8;
#pragma unroll
            for (int g0 = 0; g0 < NJ; g0 += GJ) {
#pragma unroll
                for (int jj = g0; jj < g0 + GJ; ++jj) { const f32x4 gg = ((const f32x4*)gpre)[lane + 64 * jj]; const f32x4 hh = v[jj] * rstd * gg; u32x2 w; w.x = pk2(hh[0], hh[1]); w.y = pk2(hh[2], hh[3]); o8[64 * jj] = w;
                    LDS_WR(f32x4, scr + (8 * (jj - g0) + (lane >> 3)) * 144 + (lane & 7) * 16, hh * H8_SCALE); }
                WAVE_SYNC();
                if (lane < 8 * GJ) { float f[32]; unsigned o[6];
#pragma unroll
                    for (int i = 0; i < 8; ++i) { const f32x4 t_ = LDS_RD(f32x4, scr + lane * 144 + 16 * i); f[4 * i] = t_[0]; f[4 * i + 1] = t_[1]; f[4 * i + 2] = t_[2]; f[4 * i + 3] = t_[3]; }
                    pk_fp6x32(f, o);
                    unsigned char* dst = ws + WS_H8 + (size_t)m * D + (size_t)(8 * g0 + lane) * 32; *(u32x4*)dst = (u32x4){o[0], o[1], o[2], o[3]}; *(u32x2*)(dst + 16) = (u32x2){o[4], o[5]}; }
                WAVE_SYNC();
            }
        }
        if (BOTH(0)) GRID_BAR();
    }

    if (IN(1)) {
        {
            const int gw = vcu * NWAVES + wave, NGW = G * NWAVES, l15 = lane & 15, q4 = lane >> 4;
            const int wrow = NP + (l15 < NSG ? l15 : NSG - 1);
            for (int t = gw; t < M / 16; t += NGW) {
                f32x4 acc = (f32x4){0.f, 0.f, 0.f, 0.f};
                const bf16* ap = HBUF + (size_t)(16 * t + l15) * D + 8 * q4; const bf16* bp = W1T + (size_t)wrow * D + 8 * q4;
                for (int k0 = 0; k0 < D / 32; k0 += 16) {
                    bf16x8 af[16], bfr[16];
#pragma unroll
                    for (int i = 0; i < 16; ++i) { af[i] = *(const bf16x8*)(ap + 32 * (k0 + i)); bfr[i] = *(const bf16x8*)(bp + 32 * (k0 + i)); }
#pragma unroll
                    for (int i = 0; i < 16; ++i) acc = MFMA16(af[i], bfr[i], acc);
                }
#pragma unroll
                for (int r = 0; r < 4; ++r) SG[(size_t)(16 * t + 4 * q4 + r) * 16 + l15] = acc[r];
            }
        }
        { pg8::Gemm g{HBUF, W1T, M, NPM, D}; SchedSkipOg S; S.so.init(M, NPM - DA - DB, G, bx);
          EpiP E{PB};
          pg8::gemm_phase<EpiP, SchedSkipOg, GEMM_ALIGN, GEMM_SP2>(lds, g, S, E); }
        { pg8::Gemm g8{(const bf16*)(ws + WS_H8), (const bf16*)(ws + WS_W8OG), M, DA + DB, D}; pg8::StaticOrder S8; S8.init(M, DA + DB, G, bx);
          EpiOg E8{PB};
          pg8::gemm_phase<EpiOg, pg8::StaticOrder, GEMM_ALIGN, GEMM_SP2, 1>(lds, g8, S8, E8); }
        if (BOTH(1)) GRID_BAR();
    }

    if (IN(2)) {
        int buf = 0;
        if (bx < NUA + NUB) p2_issue(args, bx, lds + PA_RAW, wave, lane);
        for (int u = bx, it = 0; u < NUA + NUB; u += G, ++it) {
            int tidj = tid; OPAQUE(tidj); const int lane_ = tidj & 63;
            if (it == 0) WAIT_V(0); else WAIT_V(18);
            MIX_BAR();
            if (u + G < NUA + NUB) p2_issue(args, u + G, lds + PA_RAW + (buf ^ 1) * PA_RAWSZ, wave, lane_);
            p2_unit(args, lds, u, lds + PA_RAW + buf * PA_RAWSZ, wave, lane_);
            buf ^= 1;
        }
        if (BOTH(2)) GRID_BAR();
    }

    if (IN(3)) {
        constexpr int NJA = NB * HA * 2, NJB = NB * HB * 4;
        if (G > NJA + NJB && bx >= NJA + NJB) {
            ldsp scr = lds + wave * 17408;
            p0_items(args, P0_I1 + (bx - (NJA + NJB)) * NWAVES + wave, P0_NITEMS, (G - (NJA + NJB)) * NWAVES, scr, lane);
        }
        for (int job = bx; job < NJA + NJB; job += G) {
            if (job < NJA) mixer_a_job(args, lds, job / (2 * HA), (job >> 1) % HA, job & 1, tid);
            else { const int jb = job - NJA; mixer_b_job(args, lds, jb / (4 * HB), (jb >> 2) % HB, jb & 3, tid); }
            BLOCK_BAR();
        }
        if (BOTH(3)) GRID_BAR();
    }

    if (IN(4)) {
        const int gw = vcu * NWAVES + wave, NGW = G * NWAVES;
        const float* SSA = (const float*)(ws + WS_SSA); const float* SSB = (const float*)(ws + WS_SSB);
        static_assert(DA % 512 == 0 && DA == DB, "P3 tiling");
        for (int m = gw; m < M; m += NGW) {
#pragma unroll
            for (int br = 0; br < 2; ++br) {
#pragma unroll
                for (int i = 0; i < DA / 512; ++i) {
                    const int col0 = i * 512 + lane * 8;
                    float rstd;
                    if (br == 0) { const int hh = col0 / 128; rstd = frsq((SSA[((size_t)m * HA + hh) * 2] + SSA[((size_t)m * HA + hh) * 2 + 1]) * (1.0f / 128.0f) + EPS); }
                    else { const int hh = col0 / 256; const f32x4 q_ = *(const f32x4*)(SSB + ((size_t)m * HB + hh) * 4); rstd = frsq(((q_[0] + q_[1]) + (q_[2] + q_[3])) * (1.0f / 256.0f) + EPS); }
                    u32x4* po = (u32x4*)(OAB + (size_t)(br * M + m) * LDU + col0);
                    u32x4 w = *po; const u32x4 g8 = *(const u32x4*)(PB + p_off((size_t)m, (br ? C_OGB : C_OGA) + col0)), z8 = *(const u32x4*)(PB + p_off((size_t)m, (br ? C_ZB : C_ZA) + col0));
                    const f32x4 gn0 = *(const f32x4*)(args.in[br ? 9 : 8] + col0), gn1 = *(const f32x4*)(args.in[br ? 9 : 8] + col0 + 4);
#pragma unroll
                    for (int e = 0; e < 4; ++e) { float v[2];
#pragma unroll
                        for (int k = 0; k < 2; ++k) { const float ov = __builtin_bit_cast(float, k ? (w[e] & 0xffff0000u) : (w[e] << 16)), og = __builtin_bit_cast(float, k ? (g8[e] & 0xffff0000u) : (g8[e] << 16)), z = __builtin_bit_cast(float, k ? (z8[e] & 0xffff0000u) : (z8[e] << 16));
                            const float gnv = (e < 2 ? gn0 : gn1)[(2 * e + k) & 3];
                            v[k] = ov * rstd * gnv * sigm2(og) * (z * sigm2(z)); }
                        w[e] = cvt_pk_bf16(v[0], v[1]); }
                    *po = w;
                }
            }
        }
        if (BOTH(4)) GRID_BAR();
    }
    if (IN(5)) {
        { pg8::Gemm g8{(const bf16*)(ws + WS_H8), (const bf16*)(ws + WS_W8), M, 2 * D, D}; SchedGate S8; S8.so.init(M, D, G, bx);
          EpiP8 E8{PB};
          pg8::gemm_phase<EpiP8, SchedGate, GEMM_ALIGN, GEMM_SP2, 1>(lds, g8, S8, E8); }
        BLOCK_BAR();
        pg8::Gemm g{OAB, WUT, M, D, 2 * DA, LDU, (size_t)M * LDU * 2, (size_t)D * LDU * 2}; SchedRev S; S.init(M, D, G, bx);
        EpiUp2 E{HBUF, make_rsrc(PB, P_BYTES)};
        for (int rep = 0; rep < PROBE_REP_P4; ++rep) pg8::gemm_phase<EpiUp2, SchedRev, GEMM_ALIGN, GEMM_SP2, 2, true>(lds, g, S, E);
        if (BOTH(5)) GRID_BAR();
    }

    if (IN(6)) {
        pg8::Gemm g{HBUF, WOT, M, D, D}; pg8::StaticOrder S; S.init(M, D, G, bx);
        EpiOut E{PB, RSS};
        for (int rep = 0; rep < PROBE_REP_P5; ++rep) pg8::gemm_phase<EpiOut, pg8::StaticOrder, GEMM_ALIGN, GEMM_SP2>(lds, g, S, E);
        if (BOTH(6)) GRID_BAR();
    }

    if (IN(7)) {
        const int gw = vcu * NWAVES + wave, NGW = G * NWAVES;
        const float* gpost = args.in[13];
        for (int m = gw; m < M; m += NGW) {
            const float ss = wave_sum(lane < NRS ? RSS[(size_t)m * NRS + lane] : 0.f);
            const float rstd = frsq(ss * (1.0f / D) + EPS);
            const f32x4* xr = (const f32x4*)(x + (size_t)m * D) + lane; f32x4* orow = (f32x4*)(args.out + (size_t)m * D) + lane; const u32x2* ob = (const u32x2*)(PB + (size_t)m * D) + lane;
#pragma unroll
            for (int jj = 0; jj < D / 256; ++jj) { const f32x4 xv = xr[64 * jj], gg = ((const f32x4*)gpost)[lane + 64 * jj]; const u32x2 w = ob[64 * jj];
                const f32x4 ov = (f32x4){__builtin_bit_cast(float, w.x << 16), __builtin_bit_cast(float, w.x & 0xffff0000u), __builtin_bit_cast(float, w.y << 16), __builtin_bit_cast(float, w.y & 0xffff0000u)};
                orow[64 * jj] = xv + ov * rstd * gg; }
        }
    }
#undef IN
#undef BOTH
}

#ifndef EMU
extern "C" void kernel_launch(void* const* d_in, const int* in_sizes, int n_in, void* d_out, int out_size, void* d_ws, size_t ws_size, hipStream_t stream) {
    static int grid = 0;
    if (grid == 0) {
        if (n_in != 14 || out_size != M * D || ws_size < WS_END) { fprintf(stderr, "kernel_launch: unexpected shapes (n_in %d, out %d, ws %zu < %zu)\n", n_in, out_size, ws_size, (size_t)WS_END); grid = -1; return; }
        int dev = 0, cus = 0, per_cu = 0;
        if (hipGetDevice(&dev) != hipSuccess || hipDeviceGetAttribute(&cus, hipDeviceAttributeMultiprocessorCount, dev) != hipSuccess) { grid = -1; return; }
        if (hipFuncSetAttribute((const void*)fwd_kernel, hipFuncAttributeMaxDynamicSharedMemorySize, LDS_BYTES) != hipSuccess) { fprintf(stderr, "kernel_launch: hipFuncSetAttribute failed\n"); grid = -1; return; }
        if (hipOccupancyMaxActiveBlocksPerMultiprocessor(&per_cu, (const void*)fwd_kernel, NTHREADS, LDS_BYTES) != hipSuccess || per_cu < 1) { fprintf(stderr, "kernel_launch: occupancy query says %d\n", per_cu); }
        (void)hipGetLastError();
        grid = cus;
    }
    if (grid < 0) return;
    (void)hipMemsetAsync((char*)d_ws + WS_CTL, 0, CTL_ZERO_BYTES, stream);
    Args a{};
    for (int i = 0; i < 14; ++i) a.in[i] = (const float*)d_in[i];
    a.out = (float*)d_out; a.ws = (unsigned char*)d_ws; a.ph_lo = 0; a.ph_hi = 8;
    hipLaunchKernelGGL(fwd_kernel, dim3(grid), dim3(NTHREADS), LDS_BYTES, stream, a);
}
#endif
```

```cpp
typedef unsigned u32x2_t __attribute__((ext_vector_type(2)));
typedef int v8i_t __attribute__((ext_vector_type(8)));
typedef int v4i_t __attribute__((ext_vector_type(4)));
#ifndef EMU
#include <hip/hip_runtime.h>
#include <cstdio>
#include <cstdint>
#define LAS __attribute__((address_space(3)))
#define GAS __attribute__((address_space(1)))
typedef short bf16x8 __attribute__((ext_vector_type(8)));
typedef short bf16x4 __attribute__((ext_vector_type(4)));
typedef float f32x4 __attribute__((ext_vector_type(4)));
#define DEV __device__ __forceinline__
#define LDS_RD(T, p) (*(const LAS T*)(p))
#define LDS_WR(T, p, v) (*(LAS T*)(p) = (v))
#define WAVE_SYNC() asm volatile("s_waitcnt lgkmcnt(0)" ::: "memory")
#define BLOCK_BAR() __syncthreads()
#define RAW_BAR() __builtin_amdgcn_s_barrier()
#define WAIT_V(n) asm volatile("s_waitcnt vmcnt(" #n ")" ::: "memory")
#define WAIT_L(n) asm volatile("s_waitcnt lgkmcnt(" #n ")" ::: "memory")
#define SCHED_BAR() __builtin_amdgcn_sched_barrier(0)
#define SETPRIO(n) __builtin_amdgcn_s_setprio(n)
#define GLDS16(g, l) __builtin_amdgcn_global_load_lds((const unsigned*)(g), (LAS unsigned*)(l), 16, 0, 0)
#define MFMA16(a, b, c) __builtin_amdgcn_mfma_f32_16x16x32_bf16(a, b, c, 0, 0, 0)
#define RFL(x) __builtin_amdgcn_readfirstlane(x)
#define COMPILER_FENCE() asm volatile("" ::: "memory")
#define OPAQUE(x) asm volatile("" : "+v"(x))
DEV float fexp2(float x) { return __builtin_amdgcn_exp2f(x); }
DEV float flog2(float x) { return __builtin_amdgcn_logf(x); }
DEV float frcp(float x) { return __builtin_amdgcn_rcpf(x); }
DEV float frsq(float x) { return __builtin_amdgcn_rsqf(x); }
DEV unsigned cvt_pk_bf16(float lo, float hi) { unsigned r; asm volatile("v_cvt_pk_bf16_f32 %0, %1, %2" : "=v"(r) : "v"(lo), "v"(hi)); return r; }
DEV f32x4 mfma8(v8i_t a, v8i_t b, f32x4 c, int sc) { asm volatile("v_mfma_scale_f32_16x16x128_f8f6f4 %0, %1, %2, %0, %3, %3 op_sel_hi:[0,0,0]" : "+v"(c) : "v"(a), "v"(b), "v"(sc)); return c; }
#define MFMA_DRAIN() asm volatile("s_nop 15\n\ts_nop 7" ::: "memory")
DEV unsigned pk_fp8x4(float a, float b, float c, float d) { int r = __builtin_amdgcn_cvt_pk_fp8_f32(a, b, 0, false); r = __builtin_amdgcn_cvt_pk_fp8_f32(c, d, r, true); return (unsigned)r; }
typedef short v4i16_t __attribute__((ext_vector_type(4)));
DEV bf16x4 lds_tr16(LAS unsigned char* p) { return __builtin_bit_cast(bf16x4, __builtin_amdgcn_ds_read_tr16_b64_v4i16((LAS v4i16_t*)p)); }
#define MIX_BAR() do { asm volatile("s_waitcnt lgkmcnt(0)" ::: "memory"); __builtin_amdgcn_s_barrier(); asm volatile("" ::: "memory"); } while (0)
DEV void glds16_asm(const void* gsrc, unsigned lds_dst) { unsigned keep;
    asm volatile("s_mov_b32 %0, m0\n\ts_mov_b32 m0, %2\n\ts_nop 0\n\tglobal_load_lds_dwordx4 %1, off\n\ts_mov_b32 m0, %0" : "=&s"(keep) : "v"(gsrc), "s"(lds_dst) : "memory"); }
#define GLDS16X(g, l) glds16_asm((const void*)(g), (unsigned)RFL((int)(unsigned)(__UINTPTR_TYPE__)(l)))
DEV void glds16_sbase(const void* sbase, unsigned voff, unsigned lds_dst) { unsigned keep;
    asm volatile("s_mov_b32 %0, m0\n\ts_mov_b32 m0, %3\n\ts_nop 0\n\tglobal_load_lds_dwordx4 %1, %2\n\ts_mov_b32 m0, %0" : "=&s"(keep) : "v"(voff), "s"(sbase), "s"(lds_dst) : "memory"); }
#define GLDS16S(sb, vo, l) glds16_sbase((const void*)(sb), (unsigned)(vo), (unsigned)RFL((int)(unsigned)(__UINTPTR_TYPE__)(l)))
typedef __amdgpu_buffer_rsrc_t rsrc_t;
DEV rsrc_t make_rsrc(const void* p, unsigned bytes) { return __builtin_amdgcn_make_buffer_rsrc((void*)p, (short)0, (int)bytes, 0x00020000); }
DEV unsigned short bload16(rsrc_t r, unsigned voff, unsigned soff) { return (unsigned short)__builtin_amdgcn_raw_buffer_load_b16(r, (int)voff, (int)soff, 0); }
DEV void bstore16(rsrc_t r, unsigned voff, unsigned soff, unsigned short v) { __builtin_amdgcn_raw_buffer_store_b16(v, r, (int)voff, (int)soff, 0); }
DEV void bstore64(rsrc_t r, unsigned voff, unsigned soff, u32x2_t v) { __builtin_amdgcn_raw_buffer_store_b64(v, r, (int)voff, (int)soff, 0); }
typedef unsigned u32x4_t __attribute__((ext_vector_type(4)));
DEV u32x4_t bload128(rsrc_t r, unsigned voff, unsigned soff) { return __builtin_amdgcn_raw_buffer_load_b128(r, (int)voff, (int)soff, 0); }
#else
#define LAS
#define GAS
#define DEV inline
#define LDS_RD(T, p) emu_lds_rd<T>((const void*)(p), #p)
#define LDS_WR(T, p, v) emu_lds_wr<T>((void*)(p), (T)(v), #p)
#define WAVE_SYNC() emu_wavesync()
#define BLOCK_BAR() emu_syncthreads()
#define RAW_BAR() emu_syncthreads()
#define WAIT_V(n)
#define WAIT_L(n)
#define SCHED_BAR()
#define SETPRIO(n)
#define GLDS16(g, l) emu_glds16((const void*)(g), (unsigned char*)(l))
#define GLDS16X(g, l) emu_glds16((const void*)(g), (unsigned char*)(l))
#define GLDS16S(sb, vo, l) emu_glds16((const void*)((const char*)(sb) + (vo)), (unsigned char*)(l))
#define MFMA16(a, b, c) emu_mfma16(a, b, c)
#define RFL(x) (x)
#define COMPILER_FENCE()
#define OPAQUE(x)
DEV float fexp2(float x) { return exp2f(x); }
DEV float flog2(float x) { return log2f(x); }
DEV float frcp(float x) { return 1.0f / x; }
DEV float frsq(float x) { return 1.0f / sqrtf(x); }
DEV unsigned cvt_pk_bf16(float lo, float hi) { return (unsigned)emu_f2bf(lo) | ((unsigned)emu_f2bf(hi) << 16); }
#define mfma8(a, b, c, sc) emu_mfma8(a, b, c)
#define MFMA_DRAIN()
DEV unsigned pk_fp8x4(float a, float b, float c, float d) { return (unsigned)emu_f2fp8(a) | ((unsigned)emu_f2fp8(b) << 8) | ((unsigned)emu_f2fp8(c) << 16) | ((unsigned)emu_f2fp8(d) << 24); }
#define lds_tr16(p) emu_lds_tr16((const unsigned char*)(p))
#define MIX_BAR() emu_syncthreads()
typedef unsigned char* rsrc_t;
DEV rsrc_t make_rsrc(const void* p, unsigned) { return (unsigned char*)p; }
DEV unsigned short bload16(rsrc_t r, unsigned voff, unsigned soff) { unsigned short v; memcpy(&v, r + (size_t)voff + soff, 2); return v; }
DEV void bstore16(rsrc_t r, unsigned voff, unsigned soff, unsigned short v) { memcpy(r + (size_t)voff + soff, &v, 2); }
DEV void bstore64(rsrc_t r, unsigned voff, unsigned soff, u32x2_t v) { memcpy(r + (size_t)voff + soff, &v, 8); }
typedef unsigned u32x4_t __attribute__((ext_vector_type(4)));
DEV u32x4_t bload128(rsrc_t r, unsigned voff, unsigned soff) { u32x4_t v; memcpy(&v, r + (size_t)voff + soff, 16); return v; }
#endif

typedef unsigned short bf16;
typedef unsigned u32x4 __attribute__((ext_vector_type(4)));
typedef unsigned u32x2 __attribute__((ext_vector_type(2)));
typedef float f32x2 __attribute__((ext_vector_type(2)));
typedef LAS unsigned char* ldsp;

#ifndef CFG_D
#define CFG_D 4096
#define CFG_B 4
#define CFG_S 4096
#define CFG_HB 8
#endif
constexpr int D = CFG_D, NB = CFG_B, SEQ = CFG_S, M = NB * SEQ;
constexpr int DA = D / 2, HA = DA / 128, DB = D / 2, HB = CFG_HB, DVB = DB / HB, DKB = 128, DQK = HB * DKB;
constexpr int NSG = 2 * HB;
constexpr int NCH = SEQ / 64;
static_assert(DVB == 256 && NSG <= 16 && SEQ % 64 == 0 && M % 256 == 0 && D % 256 == 0, "shape");
constexpr int C_QA = 0, C_FA = DA, C_IA = 2 * DA, C_OGA = 3 * DA, C_ZA = 4 * DA, C_QB = 5 * DA, C_KB = C_QB + DQK, C_VB = C_KB + DQK, C_OGB = C_VB + DB, C_ZB = C_OGB + DB;
constexpr int NPM = C_ZB + DB, C_GA = NPM, C_GB = NPM + D, NP = NPM + 2 * D, D_IN = NP + NSG;
static_assert(NPM % 256 == 0 && NP % 256 == 0, "column map");
constexpr float EPS = 1e-6f;
constexpr float H8_SCALE = 64.0f, W8_SCALE = 1024.0f, G8_DESCALE = 1.0f / (64.0f * 1024.0f);
constexpr float LOG2E = 1.4426950408889634f, LN2 = 0.6931471805599453f;
constexpr int NRS = D / 64;
constexpr int PT_PITCH = M / 64 + 1;
DEV size_t p_off(size_t row, int col) { return ((size_t)(col >> 7) * (size_t)PT_PITCH + (row >> 6)) * 8192 + (row & 63) * 128 + (size_t)(col & 127); }

constexpr size_t al256(size_t x) { return (x + 255) & ~(size_t)255; }
constexpr size_t WS_CTL = 0, CTL_ZERO_BYTES = 65536;
constexpr size_t WS_W1T = 1u << 20;
constexpr int LDU = DA + 64;
constexpr size_t WS_WUT = al256(WS_W1T + (size_t)(NP + 16) * D * 2);
constexpr size_t WS_WOT = al256(WS_WUT + (size_t)2 * D * LDU * 2);
constexpr size_t WS_HB = al256(WS_WOT + (size_t)D * D * 2);
constexpr size_t WS_P = al256(WS_HB + (size_t)M * D * 2);
constexpr size_t WS_SG = al256(WS_P + (size_t)(NP / 128) * (M / 64 + 1) * 16384 + 4096);
constexpr size_t WS_OAB = al256(WS_SG + (size_t)M * 16 * 4);
constexpr size_t WS_RSS = al256(WS_OAB + (size_t)2 * M * LDU * 2);
constexpr size_t WS_SSB = al256(WS_RSS + (size_t)M * NRS * 4);
constexpr size_t WS_SSA = al256(WS_SSB + (size_t)M * HB * 4 * 4);
constexpr size_t WS_H8 = al256(WS_SSA + (size_t)M * HA * 2 * 4);
constexpr size_t WS_W8 = al256(WS_H8 + (size_t)M * D);
constexpr size_t WS_END = al256(WS_W8 + (size_t)2 * D * D);
constexpr size_t WS_W8OG = WS_P + (size_t)(NPM / 128) * (M / 64 + 1) * 16384;
static_assert((size_t)(DA + DB) * D <= (size_t)(2 * D / 128) * (M / 64 + 1) * 16384, "out-gate weight copy fits the merge-gate tiles");
constexpr int CW_BAR = 1024;

constexpr int RING_BYTES = 154624, LDSCTL_OFF = RING_BYTES, MISC_OFF = LDSCTL_OFF + 320, LDS_BYTES = 155648;
constexpr int NWAVES = 8, NTHREADS = 512;

DEV unsigned f2bf(float f) { unsigned u = __builtin_bit_cast(unsigned, f); return (u + 0x7fffu + ((u >> 16) & 1u)) >> 16; }
DEV float bf2f(unsigned b) { return __builtin_bit_cast(float, b << 16); }
DEV unsigned pk2(float lo, float hi) { return f2bf(lo) | (f2bf(hi) << 16); }
DEV float fexp(float x) { return fexp2(x * LOG2E); }
DEV float flog(float x) { return flog2(x) * LN2; }
DEV float sigm(float x) { return frcp(1.0f + fexp(-x)); }
DEV float logsig(float x) { return fminf(x, 0.f) - flog(1.0f + fexp(-fabsf(x))); }
DEV float wave_sum(float v) {
#pragma unroll
    for (int o = 1; o < 64; o <<= 1) v += __shfl_xor(v, o);
    return v;
}

namespace pg8 {
constexpr int BM = 256, BK = 64, HALF = 128, HTB = HALF * BK * 2, STAGE_BYTES = 8 * HTB, NXCD = 8, WGM = 8;
DEV int lds_byte(int r, int c) { const int st = (r >> 4) * 2 + (c >> 5), rr = r & 15, cc = c & 31, ob = rr * 64 + cc * 2; return st * 1024 + (ob ^ (((ob >> 9) & 1) << 5)); }
DEV void stage_rc(int b, int& R, int& C) { const int st = b / 1024, sb = b % 1024, swz = sb ^ (((sb >> 9) & 1) << 5); R = (st >> 1) * 16 + swz / 64; C = (st & 1) * 32 + (swz % 64) / 2; }
DEV int perm32(int rho) { const int n = rho >> 4, i = rho & 15; return 8 * (i >> 2) + 4 * n + (i & 3); }
struct Unit { int pm, pn; };
struct Gemm { const bf16* A; const bf16* Bt; int M, N, K; int ld; size_t a2off, b2off; };
struct StaticOrder {
    int nM, nN, nwg, G, c;
    DEV void init(int M_, int N_, int G_, int c_) { nM = M_ / BM; nN = N_ / BM; nwg = nM * nN; G = G_; c = c_; }
    DEV bool next(int i, Unit& u) const {
        const long L = (long)i * G + c; if (L >= nwg) return false;
        int wgid = (int)L; { const int q = nwg / NXCD, r = nwg % NXCD, xcd = wgid % NXCD, off = wgid / NXCD; wgid = (xcd < r ? xcd * (q + 1) : r * (q + 1) + (xcd - r) * q) + off; }
        const int nig = WGM * nN, gid = wgid / nig, fm = gid * WGM, gsz = (nM - fm) < WGM ? (nM - fm) : WGM;
        u.pm = fm + ((wgid % nig) % gsz); u.pn = (wgid % nig) / gsz; return true;
    }
};
template <class Epi, class Sched, bool ALIGN_EPI = false, bool SP2 = false, int ESZ = 2, bool SPLITK = false>
DEV void gemm_phase(ldsp lds, const Gemm g, const Sched& S, const Epi& E) {
    const int tid = threadIdx.x, wid = RFL(tid >> 6), lane = tid & 63, wr = wid >> 2, wc = wid & 3, fr = lane & 15, fq = lane >> 4;
    const int nt = (g.K * ESZ / 2) / BK, K = (g.ld ? g.ld : g.K) * ESZ / 2;
    unsigned voffA[2], voffB[2];
#pragma unroll
    for (int i = 0; i < 2; ++i) { int R, C; stage_rc(tid * 16 + i * 8192, R, C); const int Rb = Epi::PERM ? ((R & ~31) + perm32(R & 31)) : R;
        voffA[i] = (unsigned)(R * K + C) * 2u; voffB[i] = (unsigned)(Rb * K + C) * 2u; }
    const size_t kstep = (size_t)(BK * 2);
    const size_t hstep = (size_t)HALF * K * 2;
    const size_t tstep = 2 * hstep;
    const unsigned ldsw = (unsigned)wid * 1024u;
    int aoffk[2], boffk[2];
#pragma unroll
    for (int k = 0; k < 2; ++k) { const int ch = fq + 4 * k;
        aoffk[k] = lds_byte(wr * 64 + fr, (ch & 3) * 8) + (ch >> 2) * 1024; boffk[k] = lds_byte(wc * 32 + fr, (ch & 3) * 8) + (ch >> 2) * 1024; }
#define PG8_SA(b, h) (((b) * 2 + (h)) * HTB)
#define PG8_SB(b, h) ((4 + (b) * 2 + (h)) * HTB)
#define PG8_STAGE(bufoff, gbase, voff) do { _Pragma("unroll") for (int _i = 0; _i < 2; ++_i) \
        GLDS16((const char*)(gbase) + (voff)[_i], lds + (bufoff) + ldsw + _i * 8192); } while (0)
#define PG8_LDA(dst, b, h) do { _Pragma("unroll") for (int m = 0; m < 4; ++m) { if constexpr (ESZ == 2) { _Pragma("unroll") for (int k = 0; k < 2; ++k) dst[m][k] = *(const LAS bf16x8*)(lds + PG8_SA(b, h) + aoffk[k] + m * 2048); } \
        else dst##8[m] = __builtin_shufflevector(*(const LAS v4i_t*)(lds + PG8_SA(b, h) + aoffk[0] + m * 2048), *(const LAS v4i_t*)(lds + PG8_SA(b, h) + aoffk[1] + m * 2048), 0, 1, 2, 3, 4, 5, 6, 7); } } while (0)
#define PG8_LDB(dst, b, h) do { _Pragma("unroll") for (int n = 0; n < 2; ++n) { if constexpr (ESZ == 2) { _Pragma("unroll") for (int k = 0; k < 2; ++k) dst[n][k] = *(const LAS bf16x8*)(lds + PG8_SB(b, h) + boffk[k] + n * 2048); } \
        else dst##8[n] = __builtin_shufflevector(*(const LAS v4i_t*)(lds + PG8_SB(b, h) + boffk[0] + n * 2048), *(const LAS v4i_t*)(lds + PG8_SB(b, h) + boffk[1] + n * 2048), 0, 1, 2, 3, 4, 5, 6, 7); } } while (0)
#define PG8_MMA(ai, bj, At, Bt) do { SETPRIO(1); _Pragma("unroll") for (int m = 0; m < 4; ++m) _Pragma("unroll") for (int n = 0; n < 2; ++n) { \
        if constexpr (ESZ == 2) { _Pragma("unroll") for (int k = 0; k < 2; ++k) acc[ai][bj][m][n] = MFMA16(Bt[n][k], At[m][k], acc[ai][bj][m][n]); } \
        else acc[ai][bj][m][n] = mfma8(Bt##8[n], At##8[m], acc[ai][bj][m][n], sc8); } SETPRIO(0); } while (0)
    int sc8 = 0x7f7f7f7f; OPAQUE(sc8);
    Unit cur, nxt; int ui = 0;
    if (!S.next(0, cur)) return;
    f32x4 acc[2][2][4][2];
#pragma unroll
    for (int a = 0; a < 2; ++a)
#pragma unroll
        for (int b = 0; b < 2; ++b)
#pragma unroll
            for (int m = 0; m < 4; ++m)
#pragma unroll
                for (int n = 0; n < 2; ++n) acc[a][b][m][n] = (f32x4){0.f, 0.f, 0.f, 0.f};
    bf16x8 At[ESZ == 2 ? 4 : 1][2], B0[ESZ == 2 ? 2 : 1][2], B1[ESZ == 2 ? 2 : 1][2];
    v8i_t At8[ESZ == 1 ? 4 : 1], B08[ESZ == 1 ? 2 : 1], B18[ESZ == 1 ? 2 : 1];
    const char* cA = (const char*)g.A + (size_t)cur.pm * tstep; const char* cB = (const char*)g.Bt + (size_t)cur.pn * tstep;
    if constexpr (SP2) {
        PG8_STAGE(PG8_SB(0, 0), cB, voffB); PG8_STAGE(PG8_SB(0, 1), cB + hstep, voffB); PG8_STAGE(PG8_SA(0, 0), cA, voffA); PG8_STAGE(PG8_SA(0, 1), cA + hstep, voffA);
        if (wr == 1) RAW_BAR();
        WAIT_V(2); RAW_BAR();
        PG8_STAGE(PG8_SB(1, 0), cB + kstep, voffB); PG8_STAGE(PG8_SA(1, 0), cA + kstep, voffA); PG8_STAGE(PG8_SB(1, 1), cB + hstep + kstep, voffB);
        WAIT_V(6); RAW_BAR();
    } else {
        PG8_STAGE(PG8_SB(0, 0), cB, voffB); PG8_STAGE(PG8_SA(0, 0), cA, voffA); PG8_STAGE(PG8_SB(0, 1), cB + hstep, voffB); PG8_STAGE(PG8_SA(0, 1), cA + hstep, voffA);
        if (wr == 1) RAW_BAR();
        WAIT_V(4); RAW_BAR();
        PG8_STAGE(PG8_SB(1, 0), cB + kstep, voffB); PG8_STAGE(PG8_SA(1, 0), cA + kstep, voffA); PG8_STAGE(PG8_SB(1, 1), cB + hstep + kstep, voffB);
        WAIT_V(6); RAW_BAR();
    }
    for (;;) {
        const bool has_next = S.next(ui + 1, nxt);
        const char* nA = has_next ? (const char*)g.A + (size_t)nxt.pm * tstep : cA; const char* nB = has_next ? (const char*)g.Bt + (size_t)nxt.pn * tstep : cB;
        for (int t = 0; t < nt; t += 2) {
            const bool last = (t == nt - 2);
            const size_t h1 = (SPLITK && t >= nt / 2) ? 1 : 0, h2 = (SPLITK && t + 2 >= nt / 2) ? 1 : 0;
            const char* a1 = cA + (size_t)(t + 1) * kstep + h1 * (g.a2off - (size_t)(nt / 2) * kstep);
            const char* a2 = last ? nA : cA + (size_t)(t + 2) * kstep + h2 * (g.a2off - (size_t)(nt / 2) * kstep); const char* b2 = last ? nB : cB + (size_t)(t + 2) * kstep + h2 * (g.b2off - (size_t)(nt / 2) * kstep);
            const char* a3 = a2 + kstep; const char* b3 = b2 + kstep;
            if constexpr (SPLITK) { if (t == nt / 2) {
                if constexpr (ALIGN_EPI) { if (wr == 0) RAW_BAR(); }
                int fr_ = fr; OPAQUE(fr_); E.mid(acc, cur, wr, wc, fr_, fq);
                if constexpr (ALIGN_EPI) { if (wr == 1) RAW_BAR(); } } }
            if constexpr (SP2) {
            PG8_LDB(B0, 0, 0); PG8_LDB(B1, 0, 1); SCHED_BAR(); PG8_LDA(At, 0, 0); PG8_STAGE(PG8_SA(1, 1), a1 + hstep, voffA);
            WAIT_V(8); WAIT_L(0); RAW_BAR(); PG8_MMA(0, 0, At, B0); PG8_MMA(0, 1, At, B1); RAW_BAR(); SCHED_BAR();
            PG8_LDA(At, 0, 1); PG8_STAGE(PG8_SB(0, 0), b2, voffB); PG8_STAGE(PG8_SB(0, 1), b2 + hstep, voffB); PG8_STAGE(PG8_SA(0, 0), a2, voffA);
            WAIT_V(8); WAIT_L(0); RAW_BAR(); PG8_MMA(1, 0, At, B0); PG8_MMA(1, 1, At, B1); RAW_BAR(); SCHED_BAR();
            PG8_LDB(B0, 1, 0); PG8_LDB(B1, 1, 1); SCHED_BAR(); PG8_LDA(At, 1, 0); PG8_STAGE(PG8_SA(0, 1), a2 + hstep, voffA);
            WAIT_V(8); WAIT_L(0); RAW_BAR(); PG8_MMA(0, 0, At, B0); PG8_MMA(0, 1, At, B1); RAW_BAR(); SCHED_BAR();
            PG8_LDA(At, 1, 1); PG8_STAGE(PG8_SB(1, 0), b3, voffB); PG8_STAGE(PG8_SB(1, 1), b3 + hstep, voffB); PG8_STAGE(PG8_SA(1, 0), a3, voffA);
            WAIT_V(8); WAIT_L(0); RAW_BAR(); PG8_MMA(1, 0, At, B0); PG8_MMA(1, 1, At, B1); RAW_BAR(); SCHED_BAR();
            } else {
            PG8_LDB(B0, 0, 0); SCHED_BAR(); PG8_LDA(At, 0, 0); PG8_STAGE(PG8_SA(1, 1), a1 + hstep, voffA);
            WAIT_L(8); RAW_BAR(); WAIT_L(0); PG8_MMA(0, 0, At, B0); RAW_BAR(); SCHED_BAR();
            PG8_LDB(B1, 0, 1); PG8_STAGE(PG8_SB(0, 0), b2, voffB);
            RAW_BAR(); WAIT_L(0); PG8_MMA(0, 1, At, B1); RAW_BAR();
            PG8_LDA(At, 0, 1); PG8_STAGE(PG8_SA(0, 0), a2, voffA);
            RAW_BAR(); WAIT_L(0); PG8_MMA(1, 0, At, B0); RAW_BAR(); SCHED_BAR();
            PG8_STAGE(PG8_SB(0, 1), b2 + hstep, voffB);
            WAIT_V(6); RAW_BAR(); PG8_MMA(1, 1, At, B1); RAW_BAR();
            PG8_LDB(B0, 1, 0); SCHED_BAR(); PG8_LDA(At, 1, 0); PG8_STAGE(PG8_SA(0, 1), a2 + hstep, voffA);
            WAIT_L(8); RAW_BAR(); WAIT_L(0); PG8_MMA(0, 0, At, B0); RAW_BAR(); SCHED_BAR();
            PG8_LDB(B1, 1, 1); PG8_STAGE(PG8_SB(1, 0), b3, voffB);
            RAW_BAR(); WAIT_L(0); PG8_MMA(0, 1, At, B1); RAW_BAR();
            PG8_LDA(At, 1, 1); PG8_STAGE(PG8_SA(1, 0), a3, voffA);
            RAW_BAR(); WAIT_L(0); PG8_MMA(1, 0, At, B0); RAW_BAR(); SCHED_BAR();
            PG8_STAGE(PG8_SB(1, 1), b3 + hstep, voffB);
            WAIT_V(6); RAW_BAR(); PG8_MMA(1, 1, At, B1); RAW_BAR();
            }
        }
        if constexpr (ALIGN_EPI) { if (wr == 0) RAW_BAR(); }
        if constexpr (ESZ == 1) { MFMA_DRAIN();
#pragma unroll
            for (int a = 0; a < 2; ++a)
#pragma unroll
                for (int b = 0; b < 2; ++b) asm volatile("" : "+v"(acc[a][b][0][0]), "+v"(acc[a][b][0][1]), "+v"(acc[a][b][1][0]), "+v"(acc[a][b][1][1]), "+v"(acc[a][b][2][0]), "+v"(acc[a][b][2][1]), "+v"(acc[a][b][3][0]), "+v"(acc[a][b][3][1])); }
        E(acc, cur, wr, wc, fr, fq);
        if (!has_next) break;
#pragma unroll
        for (int a = 0; a < 2; ++a)
#pragma unroll
            for (int b = 0; b < 2; ++b)
#pragma unroll
                for (int m = 0; m < 4; ++m)
#pragma unroll
                    for (int n = 0; n < 2; ++n) acc[a][b][m][n] = (f32x4){0.f, 0.f, 0.f, 0.f};
        cur = nxt; cA = nA; cB = nB; ++ui;
        if constexpr (ALIGN_EPI) { if (wr == 1) RAW_BAR(); }
    }
    WAIT_V(0);
    if constexpr (!ALIGN_EPI) { if (wr == 0) RAW_BAR(); }
    RAW_BAR();
#undef PG8_SA
#undef PG8_SB
#undef PG8_STAGE
#undef PG8_LDA
#undef PG8_LDB
#undef PG8_MMA
}
}

struct EpiP {
    static constexpr bool PERM = true;
    bf16* O;
    DEV void operator()(const f32x4 (&acc)[2][2][4][2], const pg8::Unit& u, int wr, int wc, int fr, int fq) const {
        const int row0 = u.pm * 256 + wr * 64 + fr, col0 = u.pn * 256 + wc * 32 + 8 * fq;
#pragma unroll
        for (int ai = 0; ai < 2; ++ai)
#pragma unroll
            for (int m = 0; m < 4; ++m) { const size_t row = (size_t)(row0 + ai * 128 + m * 16);
#pragma unroll
                for (int bj = 0; bj < 2; ++bj) { const f32x4 v0 = acc[ai][bj][m][0], v1 = acc[ai][bj][m][1];
                    u32x4 w; w.x = cvt_pk_bf16(v0[0], v0[1]); w.y = cvt_pk_bf16(v0[2], v0[3]); w.z = cvt_pk_bf16(v1[0], v1[1]); w.w = cvt_pk_bf16(v1[2], v1[3]);
                    *(u32x4*)(O + p_off(row, col0 + bj * 128)) = w; } }
    }
};
struct EpiP8 {
    static constexpr bool PERM = true;
    bf16* O;
    DEV void operator()(const f32x4 (&acc)[2][2][4][2], const pg8::Unit& u, int wr, int wc, int fr, int fq) const {
        const int row0 = u.pm * 256 + wr * 64 + fr, col0 = NPM + u.pn * 256 + wc * 32 + 8 * fq;
#pragma unroll
        for (int ai = 0; ai < 2; ++ai)
#pragma unroll
            for (int m = 0; m < 4; ++m) { const size_t row = (size_t)(row0 + ai * 128 + m * 16);
#pragma unroll
                for (int bj = 0; bj < 2; ++bj) { const f32x4 v0 = acc[ai][bj][m][0] * G8_DESCALE, v1 = acc[ai][bj][m][1] * G8_DESCALE;
                    u32x4 w; w.x = cvt_pk_bf16(v0[0], v0[1]); w.y = cvt_pk_bf16(v0[2], v0[3]); w.z = cvt_pk_bf16(v1[0], v1[1]); w.w = cvt_pk_bf16(v1[2], v1[3]);
                    *(u32x4*)(O + p_off(row, col0 + bj * 128)) = w; } }
    }
};
struct SchedUp {
    pg8::StaticOrder so;
    DEV bool next(int i, pg8::Unit& u) const { if (!so.next(i >> 1, u)) return false; if (i & 1) { u.pm += M / 256; u.pn += D / 256; } return true; }
};
struct EpiUp {
    static constexpr bool PERM = true;
    bf16* Y; const bf16* P;
    DEV void operator()(const f32x4 (&acc)[2][2][4][2], const pg8::Unit& u, int wr, int wc, int fr, int fq) const {
        const int br = u.pm >= M / 256 ? 1 : 0, pm = u.pm - br * (M / 256), pn = u.pn - br * (D / 256);
        const int row0 = pm * 256 + wr * 64 + fr, col0 = pn * 256 + wc * 32 + 8 * fq, gcol = (br ? C_GB : C_GA) + col0;
#pragma unroll
        for (int ai = 0; ai < 2; ++ai)
#pragma unroll
            for (int m = 0; m < 4; ++m) { const size_t row = (size_t)(row0 + ai * 128 + m * 16);
#pragma unroll
                for (int bj = 0; bj < 2; ++bj) {
                    const u32x4 g8 = *(const u32x4*)(P + p_off(row, gcol + bj * 128));
                    bf16* yp = Y + row * D + col0 + bj * 128;
                    u32x4 y8 = (u32x4){0u, 0u, 0u, 0u}; if (br) y8 = *(const u32x4*)yp;
                    const f32x4 v0 = acc[ai][bj][m][0], v1 = acc[ai][bj][m][1];
                    float o[8];
#pragma unroll
                    for (int k = 0; k < 8; ++k) { const unsigned gw = g8[k >> 1], yw = y8[k >> 1]; const float gv = bf2f((k & 1) ? (gw >> 16) : (gw & 0xffffu)), yv = bf2f((k & 1) ? (yw >> 16) : (yw & 0xffffu));
                        const float a = k < 4 ? v0[k & 3] : v1[k & 3]; o[k] = yv + sigm(gv) * a; }
                    u32x4 w; w.x = cvt_pk_bf16(o[0], o[1]); w.y = cvt_pk_bf16(o[2], o[3]); w.z = cvt_pk_bf16(o[4], o[5]); w.w = cvt_pk_bf16(o[6], o[7]);
                    *(u32x4*)yp = w; } }
    }
};
struct SchedSkipOg { pg8::StaticOrder so; DEV bool next(int i, pg8::Unit& u) const { if (!so.next(i, u)) return false; if (u.pn >= C_OGA / 256) u.pn += DA / 256; if (u.pn >= C_OGB / 256) u.pn += DB / 256; return true; } };
static_assert(C_OGA % 256 == 0 && C_OGB % 256 == 0 && DA % 256 == 0 && DB % 256 == 0 && C_OGA < C_OGB, "out-gate column tiles");
struct EpiOg {
    static constexpr bool PERM = true;
    bf16* O;
    DEV void operator()(const f32x4 (&acc)[2][2][4][2], const pg8::Unit& u, int wr, int wc, int fr, int fq) const {
        const int cb = u.pn < DA / 256 ? C_OGA + u.pn * 256 : C_OGB + (u.pn - DA / 256) * 256;
        const int row0 = u.pm * 256 + wr * 64 + fr, col0 = cb + wc * 32 + 8 * fq;
#pragma unroll
        for (int ai = 0; ai < 2; ++ai)
#pragma unroll
            for (int m = 0; m < 4; ++m) { const size_t row = (size_t)(row0 + ai * 128 + m * 16);
#pragma unroll
                for (int bj = 0; bj < 2; ++bj) { const f32x4 v0 = acc[ai][bj][m][0] * G8_DESCALE, v1 = acc[ai][bj][m][1] * G8_DESCALE;
                    u32x4 w; w.x = cvt_pk_bf16(v0[0], v0[1]); w.y = cvt_pk_bf16(v0[2], v0[3]); w.z = cvt_pk_bf16(v1[0], v1[1]); w.w = cvt_pk_bf16(v1[2], v1[3]);
                    *(u32x4*)(O + p_off(row, col0 + bj * 128)) = w; } }
    }
};
struct SchedGate { pg8::StaticOrder so; DEV bool next(int i, pg8::Unit& u) const { if (!so.next(i >> 1, u)) return false; if (i & 1) u.pn += D / 256; return true; } };
struct SchedRev { pg8::StaticOrder so; int n; DEV void init(int M_, int N_, int G_, int c_) { so.init(M_, N_, G_, c_); n = so.nwg > c_ ? (so.nwg - c_ + G_ - 1) / G_ : 0; }
    DEV bool next(int i, pg8::Unit& u) const { return i < n && so.next(n - 1 - i, u); } };
constexpr unsigned P_BYTES = (unsigned)((size_t)(NP / 128) * PT_PITCH * 16384);
DEV unsigned p_soff(int pm, int cb, int ai, int m, int wr, int wc) { return (unsigned)((cb * PT_PITCH + 4 * pm + 2 * ai + wr) * 16384 + m * 4096 + wc * 64); }
constexpr unsigned GB_MINUS_GA = (unsigned)((D / 128) * PT_PITCH) * 16384u;
struct EpiUp2 {
    static constexpr bool PERM = true;
    bf16* Y; rsrc_t rs;
    DEV void mid(f32x4 (&acc)[2][2][4][2], const pg8::Unit& u, int wr, int wc, int fr, int fq) const {
        const unsigned voff = (unsigned)(fr * 256 + fq * 16);
#pragma unroll
        for (int ai = 0; ai < 2; ++ai) { u32x4 ga[8], gb[8];
#pragma unroll
            for (int s_ = 0; s_ < 8; ++s_) { const unsigned so = p_soff(u.pm, NPM / 128 + 2 * u.pn + (s_ & 1), ai, s_ >> 1, wr, wc); ga[s_] = bload128(rs, voff, so); gb[s_] = bload128(rs, voff, so + GB_MINUS_GA); }
            SCHED_BAR();
#pragma unroll
            for (int s_ = 0; s_ < 8; ++s_) { const int m = s_ >> 1, bj = s_ & 1;
#pragma unroll
                for (int k = 0; k < 8; ++k) { const unsigned aw = ga[s_][k >> 1], bw = gb[s_][k >> 1];
                    const float av = __builtin_bit_cast(float, (k & 1) ? (aw & 0xffff0000u) : (aw << 16)), bv_ = __builtin_bit_cast(float, (k & 1) ? (bw & 0xffff0000u) : (bw << 16));
                    const float ratio = (1.0f + fexp2(-LOG2E * bv_)) * frcp(1.0f + fexp2(-LOG2E * av));
                    if (k < 4) acc[ai][bj][m][0][k & 3] *= ratio; else acc[ai][bj][m][1][k & 3] *= ratio; } } }
    }
    DEV void operator()(const f32x4 (&acc)[2][2][4][2], const pg8::Unit& u, int wr, int wc, int fr, int fq) const {
        const int row0 = u.pm * 256 + wr * 64 + fr, col0 = u.pn * 256 + wc * 32 + 8 * fq; const unsigned voff = (unsigned)(fr * 256 + fq * 16); u32x4 gb[16];
#pragma unroll
        for (int s_ = 0; s_ < 16; ++s_) gb[s_] = bload128(rs, voff, p_soff(u.pm, NPM / 128 + 2 * u.pn + (s_ & 1), s_ >> 3, (s_ >> 1) & 3, wr, wc) + GB_MINUS_GA);
        SCHED_BAR();
#pragma unroll
        for (int s_ = 0; s_ < 16; ++s_) { const int ai = s_ >> 3, m = (s_ >> 1) & 3, bj = s_ & 1; const size_t row = (size_t)(row0 + ai * 128 + m * 16);
            const f32x4 v0 = acc[ai][bj][m][0], v1 = acc[ai][bj][m][1]; float o[8];
#pragma unroll
            for (int k = 0; k < 8; ++k) { const unsigned bw = gb[s_][k >> 1]; const float bv_ = __builtin_bit_cast(float, (k & 1) ? (bw & 0xffff0000u) : (bw << 16));
                o[k] = (k < 4 ? v0[k & 3] : v1[k & 3]) * frcp(1.0f + fexp2(-LOG2E * bv_)); }
            u32x4 w; w.x = cvt_pk_bf16(o[0], o[1]); w.y = cvt_pk_bf16(o[2], o[3]); w.z = cvt_pk_bf16(o[4], o[5]); w.w = cvt_pk_bf16(o[6], o[7]);
            *(u32x4*)(Y + row * D + col0 + bj * 128) = w; }
    }
};
struct EpiOut {
    static constexpr bool PERM = true;
    bf16* C; float* RSS;
    DEV void operator()(const f32x4 (&acc)[2][2][4][2], const pg8::Unit& u, int wr, int wc, int fr, int fq) const {
        const int row0 = u.pm * 256 + wr * 64 + fr, col0 = u.pn * 256 + wc * 32 + 8 * fq;
#pragma unroll
        for (int ai = 0; ai < 2; ++ai)
#pragma unroll
            for (int m = 0; m < 4; ++m) { const size_t row = (size_t)(row0 + ai * 128 + m * 16); bf16* rowp = C + row * D + col0; float ss = 0.f;
#pragma unroll
                for (int bj = 0; bj < 2; ++bj) { const f32x4 v0 = acc[ai][bj][m][0], v1 = acc[ai][bj][m][1];
                    ss += ((v0[0] * v0[0] + v0[1] * v0[1]) + (v0[2] * v0[2] + v0[3] * v0[3])) + ((v1[0] * v1[0] + v1[1] * v1[1]) + (v1[2] * v1[2] + v1[3] * v1[3]));
                    u32x4 w; w.x = cvt_pk_bf16(v0[0], v0[1]); w.y = cvt_pk_bf16(v0[2], v0[3]); w.z = cvt_pk_bf16(v1[0], v1[1]); w.w = cvt_pk_bf16(v1[2], v1[3]);
                    *(u32x4*)(rowp + bj * 128) = w; }
                ss += __shfl_xor(ss, 16); ss += __shfl_xor(ss, 32);
                if (fq == 0) RSS[row * NRS + u.pn * 4 + wc] = ss; }
    }
};

#ifndef EMU
typedef GAS unsigned gu32;
#define RLX_AGENT __ATOMIC_RELAXED, __HIP_MEMORY_SCOPE_AGENT
#define XB_TMO      128
#define XB_XCNT(j)  (256  + 64 * (j))
#define XB_XSUB(j)  (1280 + 64 * (j))
#define XB_XGEN(j)  (2304 + 64 * (j))
#define XB_TOP      3328
#define XB_TOPGEN   3392
#define XCD_BAR_WORDS 3456
#define XB_SPIN_CAP (1u << 22)
__device__ __forceinline__ unsigned xb_ld(unsigned* p)              { return __hip_atomic_load(p, __ATOMIC_RELAXED, __HIP_MEMORY_SCOPE_AGENT); }
__device__ __forceinline__ unsigned xb_add(unsigned* p, unsigned v) { return __hip_atomic_fetch_add(p, v, __ATOMIC_RELAXED, __HIP_MEMORY_SCOPE_AGENT); }
__device__ __forceinline__ unsigned xb_xcc_id() { return (unsigned)__builtin_amdgcn_s_getreg((3 << 11) | 20) & 0xFu; }
#define XB_SPIN(cond, bar) do { unsigned _sp = 0; while (cond) { __builtin_amdgcn_s_sleep(1); \
    if ((++_sp & 255u) == 0u) { if (xb_ld(&(bar)[XB_TMO])) break; if (_sp > XB_SPIN_CAP) { atomicAdd(&(bar)[XB_TMO], 1u); break; } } } } while (0)
struct XcdBarrier { unsigned* bar; unsigned x; volatile LAS unsigned* st; };
__device__ __forceinline__ XcdBarrier xcd_barrier_post(unsigned* bar, volatile LAS unsigned* st) {
    XcdBarrier b; b.bar = bar; b.x = xb_xcc_id(); b.st = st;
    if (threadIdx.x == 0) (void)xb_add(&bar[XB_XCNT(b.x)], 1u);
    return b;
}
__device__ __forceinline__ void xcd_barrier_complete(unsigned* bar, unsigned x, unsigned& nloc, unsigned& nx) {
    const unsigned G = gridDim.x * gridDim.y * gridDim.z;
    unsigned sum, cnt, mine, sp = 0u;
    for (;;) {
        sum = 0u; cnt = 0u; mine = 0u;
#pragma unroll
        for (unsigned j = 0; j < 16; ++j) { const unsigned c = xb_ld(&bar[XB_XCNT(j)]); sum += c; cnt += (c > 0u) ? 1u : 0u; mine = (j == x) ? c : mine; }
        if (sum == G) break;
        __builtin_amdgcn_s_sleep(1);
        if ((++sp & 255u) == 0u) { if (xb_ld(&bar[XB_TMO])) break; if (sp > XB_SPIN_CAP) { atomicAdd(&bar[XB_TMO], 1u); break; } }
    }
    nloc = mine > 0u ? mine : 1u; nx = cnt > 0u ? cnt : 1u;
}
__device__ __forceinline__ void xcd_barrier(const XcdBarrier& b) {
    asm volatile("s_waitcnt vmcnt(0)" ::: "memory");
    __syncthreads();
    if (threadIdx.x == 0) {
        unsigned* bar = b.bar;
        __builtin_amdgcn_s_waitcnt(0);
        unsigned nloc = b.st[0], nx = b.st[1];
        if (nloc == 0u) { xcd_barrier_complete(bar, b.x, nloc, nx); b.st[0] = nloc; b.st[1] = nx; }
        const unsigned old = xb_add(&bar[XB_XSUB(b.x)], 1u);
        const unsigned gen = old / nloc;
        if (old + 1u == (gen + 1u) * nloc) {
            __builtin_amdgcn_fence(__ATOMIC_RELEASE, "agent");
            asm volatile("s_waitcnt vmcnt(0)" ::: "memory");
            const unsigned og = xb_add(&bar[XB_TOP], 1u);
            const unsigned tg = og / nx;
            if (og + 1u == (tg + 1u) * nx) xb_add(&bar[XB_TOPGEN], 1u);
            else XB_SPIN(xb_ld(&bar[XB_TOPGEN]) == tg, bar);
            __builtin_amdgcn_fence(__ATOMIC_ACQUIRE, "agent");
            xb_add(&bar[XB_XGEN(b.x)], 1u);
            asm volatile("s_waitcnt vmcnt(0)" ::: "memory");
        } else {
            XB_SPIN(xb_ld(&bar[XB_XGEN(b.x)]) == gen, bar);
            __builtin_amdgcn_fence(__ATOMIC_ACQUIRE, "agent");
            asm volatile("s_waitcnt vmcnt(0)" ::: "memory");
        }
    }
    __syncthreads();
}
#endif

struct Args { const float* in[14]; float* out; unsigned char* ws; int ph_lo, ph_hi; };

DEV float clamp8(float x) { return fminf(fmaxf(x, -448.0f), 448.0f); }
struct P0Desc { const float* W; void* WT; int ldw, K, k0, c0, r0, nv, fp8; void* WT8; int r08; };
DEV void p0_load(const P0Desc& d, int lane, f32x4 (&v)[16]) {
    const int kr = lane >> 4, n4 = 4 * (lane & 15);
#pragma unroll
    for (int i = 0; i < 16; ++i) v[i] = (n4 < d.nv) ? *(const f32x4*)(d.W + (size_t)(d.k0 + 4 * i + kr) * d.ldw + d.c0 + n4) : (f32x4){0.f, 0.f, 0.f, 0.f};
}
DEV void p0_store(const P0Desc& d, const f32x4 (&v)[16], ldsp scr, int lane) {
    const int kr = lane >> 4, n4 = 4 * (lane & 15);
#pragma unroll
    for (int i = 0; i < 16; ++i) LDS_WR(f32x4, scr + ((4 * i + kr) * 68 + n4) * 4, v[i]);
    WAVE_SYNC();
    if (d.fp8 != 1) {
        bf16* WT = (bf16*)d.WT;
        const int c = lane & 7;
#pragma unroll
        for (int j = 0; j < 8; ++j) { const int n = (lane >> 3) + 8 * j; ldsp sp = scr + ((8 * c) * 68 + n) * 4;
            u32x4 o; o.x = pk2(LDS_RD(float, sp + 0 * 272), LDS_RD(float, sp + 1 * 272)); o.y = pk2(LDS_RD(float, sp + 2 * 272), LDS_RD(float, sp + 3 * 272));
            o.z = pk2(LDS_RD(float, sp + 4 * 272), LDS_RD(float, sp + 5 * 272)); o.w = pk2(LDS_RD(float, sp + 6 * 272), LDS_RD(float, sp + 7 * 272));
            if (n < d.nv) *(u32x4*)(WT + (size_t)(d.r0 + n) * d.K + d.k0 + 8 * c) = o; }
    }
    if (d.fp8 != 0) {
        unsigned char* WT = (unsigned char*)(d.fp8 == 2 ? d.WT8 : d.WT); const int r8 = d.fp8 == 2 ? d.r08 : d.r0, K8 = d.fp8 == 2 ? D : d.K;
        const int c = lane & 3;
#pragma unroll
        for (int j = 0; j < 4; ++j) { const int n = (lane >> 2) + 16 * j; ldsp sp = scr + ((16 * c) * 68 + n) * 4; float f[16];
#pragma unroll
            for (int i = 0; i < 16; ++i) f[i] = clamp8(LDS_RD(float, sp + i * 272) * W8_SCALE);
            u32x4 o; o.x = pk_fp8x4(f[0], f[1], f[2], f[3]); o.y = pk_fp8x4(f[4], f[5], f[6], f[7]); o.z = pk_fp8x4(f[8], f[9], f[10], f[11]); o.w = pk_fp8x4(f[12], f[13], f[14], f[15]);
            if (n < d.nv) *(u32x4*)(WT + (size_t)(r8 + n) * K8 + d.k0 + 16 * c) = o; }
    }
    WAVE_SYNC();
}

constexpr int MS = 272, MS64 = 144;
constexpr int NUA = NB * HA * NCH, NUB = NB * HB * NCH;
constexpr size_t TW_QA = 0, TW_KA = TW_QA + (size_t)NUA * 16384, TW_PA = TW_KA + (size_t)NUA * 16384, TW_VA = TW_PA + (size_t)NUA * 8192, TW_ENDA = TW_VA + (size_t)NUA * 2048;
constexpr size_t TW_QB = 0, TW_KB = TW_QB + (size_t)NUB * 16384, TW_PB = TW_KB + (size_t)NUB * 16384, TW_SB = TW_PB + (size_t)NUB * 8192, TW_ENDB = TW_SB + (size_t)NUB * 2048;
static_assert(TW_ENDA <= (size_t)(NP + 16) * D * 2 && TW_ENDB <= (size_t)M * D * 2, "operand tiles must fit the dead W1T / h regions");
DEV int swz(int row, int chunk) { return row * 256 + ((chunk ^ (row & 15)) << 4); }
DEV int swz64(int row, int chunk) { return row * 128 + ((chunk ^ (row & 7)) << 4); }
DEV bf16x8 frag16p(ldsp img, int row0, int ks, int lane) { return LDS_RD(bf16x8, img + swz64(row0 + (lane & 15), 4 * ks + (lane >> 4))); }

DEV bf16x8 frag16(ldsp buf, int stride, int row0, int ks, int lane) { return LDS_RD(bf16x8, buf + (row0 + (lane & 15)) * stride + ks * 64 + (lane >> 4) * 16); }
DEV bf16x8 frag16s(ldsp img, int row0, int ks, int lane) { return LDS_RD(bf16x8, img + swz(row0 + (lane & 15), 4 * ks + (lane >> 4))); }
DEV bf16x8 frag8x2s(ldsp img, int row0, int ks, int lane) {
    const int row = row0 + (lane & 15), q = lane >> 4;
    const bf16x4 lo = LDS_RD(bf16x4, img + swz(row, 4 * ks + (q >> 1)) + (q & 1) * 8), hi = LDS_RD(bf16x4, img + swz(row, 4 * ks + 2 + (q >> 1)) + (q & 1) * 8);
    return (bf16x8){lo[0], lo[1], lo[2], lo[3], hi[0], hi[1], hi[2], hi[3]};
}
DEV bf16x8 frag_tr(ldsp img, int n0, int ks, int lane, int stride = 256) {
    ldsp p = img + (32 * ks + 8 * (lane >> 4) + ((lane & 15) >> 2)) * stride + (n0 + 4 * (lane & 3)) * 2;
    const bf16x4 lo = lds_tr16(p), hi = lds_tr16(p + 4 * stride);
    return (bf16x8){lo[0], lo[1], lo[2], lo[3], hi[0], hi[1], hi[2], hi[3]};
}
DEV bf16x8 frag_trs(ldsp img, int n0, int ks, int lane) {
    const int row = 32 * ks + 8 * (lane >> 4) + ((lane & 15) >> 2), p = lane & 3, ch = (n0 >> 3) + (p >> 1);
    const bf16x4 lo = lds_tr16(img + swz(row, ch) + (p & 1) * 8), hi = lds_tr16(img + swz(row + 4, ch) + (p & 1) * 8);
    return (bf16x8){lo[0], lo[1], lo[2], lo[3], hi[0], hi[1], hi[2], hi[3]};
}
DEV void dma_lin(const void* src, int ninst, ldsp dst, int wave, int lane) {
    for (int i = wave; i < ninst; i += NWAVES) GLDS16X((const char*)src + i * 1024 + 16 * lane, dst + i * 1024);
}
DEV float sigm2(float x) { return frcp(1.0f + fexp2(-LOG2E * x)); }
DEV u32x2 pack4(const f32x4 v) { u32x2 w; w.x = cvt_pk_bf16(v[0], v[1]); w.y = cvt_pk_bf16(v[2], v[3]); return w; }

DEV float scan_add(float v, int lane) {
#pragma unroll
    for (int o = 1; o < 64; o <<= 1) { const float t = __shfl_up(v, o); if (lane >= o) v += t; }
    return v;
}
DEV float scan_max(float v, int lane) {
#pragma unroll
    for (int o = 1; o < 64; o <<= 1) { const float t = __shfl_up(v, o); if (lane >= o) v = fmaxf(v, t); }
    return v;
}

constexpr int PA_RAW = 0, PA_RAWSZ = 2 * 68 * 256, PA_TOT = 2 * PA_RAWSZ, PA_IQ = PA_TOT + 8 * 128 * 4, PA_IK = PA_IQ + 16384, PA_SC = PA_IK + 16384, PA_END = PA_SC + 1024;
static_assert(PA_END <= RING_BYTES, "P2 LDS");
DEV void p2_issue(const Args& args, int u, ldsp raw, int wave, int lane) {
    const bf16* P = (const bf16*)(args.ws + WS_P);
    if (u < NUA) { const int bh = u / NCH, j = u % NCH, b = bh / HA, h = bh % HA; const size_t tok0 = (size_t)b * SEQ + 64 * j;
        dma_lin(P + p_off(tok0, C_QA + h * 128), 16, raw, wave, lane); dma_lin(P + p_off(tok0, C_FA + h * 128), 16, raw + 68 * 256, wave, lane); }
    else { const int ub = u - NUA, bh = ub / NCH, j = ub % NCH, b = bh / HB, h = bh % HB; const size_t tok0 = (size_t)b * SEQ + 64 * j;
        dma_lin(P + p_off(tok0, C_QB + h * 128) - 3 * 128, 17, raw, wave, lane); dma_lin(P + p_off(tok0, C_KB + h * 128) - 3 * 128, 17, raw + 68 * 256, wave, lane); }
}
DEV void p2_scores(ldsp lds, f32x4 (&sc)[2], int wave, int lane) {
    const int ct = wave >> 1, st0 = 2 * (wave & 1);
    sc[0] = (f32x4){0.f, 0.f, 0.f, 0.f}; sc[1] = (f32x4){0.f, 0.f, 0.f, 0.f};
#pragma unroll
    for (int ks = 0; ks < 4; ++ks) { const bf16x8 qf = frag16s(lds + PA_IQ, 16 * ct, ks, lane);
#pragma unroll
        for (int n = 0; n < 2; ++n) { const bf16x8 kf_ = frag16s(lds + PA_IK, 16 * (st0 + n), ks, lane); sc[n] = MFMA16(kf_, qf, sc[n]); } }
}
DEV void p2_unit(const Args& args, ldsp lds, int u, ldsp raw, int wave, int lane) {
    unsigned char* TW = args.ws + WS_W1T;
    const int q4 = lane >> 4, l15 = lane & 15;
    if (u < NUA) {
        const int bh = u / NCH, h = bh % HA;
        const float* lbl = args.in[3];
        float lbv[2];
#pragma unroll
        for (int e = 0; e < 2; ++e) { const int col = h * 128 + 2 * lane + e; lbv[e] = frcp(1.0f + fexp(lbl[DA + col] - lbl[col])); }
        float lf[8][2], qv[8][2], kv[8][2];
#pragma unroll
        for (int c = 0; c < 8; ++c) { const unsigned qw = LDS_RD(unsigned, raw + (8 * wave + c) * 256 + lane * 4), fw = LDS_RD(unsigned, raw + 68 * 256 + (8 * wave + c) * 256 + lane * 4);
#pragma unroll
            for (int e = 0; e < 2; ++e) { const float f = lbv[e] + (1.0f - lbv[e]) * sigm2(__builtin_bit_cast(float, e ? (fw & 0xffff0000u) : (fw << 16))); lf[c][e] = flog2(f); kv[c][e] = 1.0f - f; qv[c][e] = __builtin_bit_cast(float, e ? (qw & 0xffff0000u) : (qw << 16)); } }
#pragma unroll
        for (int c = 1; c < 8; ++c) { lf[c][0] += lf[c - 1][0]; lf[c][1] += lf[c - 1][1]; }
        LDS_WR(f32x2, lds + PA_TOT + (wave * 128 + 2 * lane) * 4, ((f32x2){lf[7][0], lf[7][1]}));
        MIX_BAR();
        f32x2 off = (f32x2){0.f, 0.f}, bmid = (f32x2){0.f, 0.f}, g = (f32x2){0.f, 0.f};
#pragma unroll
        for (int w = 0; w < 8; ++w) { const f32x2 t = LDS_RD(f32x2, lds + PA_TOT + (w * 128 + 2 * lane) * 4); if (w < wave) off += t; if (w < 4) bmid += t; g += t; }
        if (wave == 0) { float* vec = (float*)(TW + TW_VA + (size_t)u * 2048) + 2 * lane;
            *(f32x2*)vec = (f32x2){fexp2(bmid[0]), fexp2(bmid[1])}; *(f32x2*)(vec + 128) = (f32x2){fexp2(g[0]), fexp2(g[1])}; *(f32x2*)(vec + 256) = (f32x2){fexp2(g[0] - bmid[0]), fexp2(g[1] - bmid[1])}; }
        unsigned qr8[8], kr8[8];
#pragma unroll
        for (int c = 0; c < 8; ++c) { float qr[2], kk[2]; const int r = 8 * wave + c;
#pragma unroll
            for (int e = 0; e < 2; ++e) { const float t1 = lf[c][e] + off[e] - bmid[e]; qr[e] = qv[c][e] * fexp2(t1); kk[e] = kv[c][e] * fexp2(-t1); }
            qr8[c] = cvt_pk_bf16(qr[0], qr[1]); kr8[c] = cvt_pk_bf16(kk[0], kk[1]);
            LDS_WR(unsigned, lds + PA_IQ + swz(r, lane >> 2) + (lane & 3) * 4, qr8[c]); LDS_WR(unsigned, lds + PA_IK + swz(r, lane >> 2) + (lane & 3) * 4, kr8[c]); }
        MIX_BAR();
        f32x4 sc[2]; p2_scores(lds, sc, wave, lane);
        unsigned char* tq = TW + TW_QA + (size_t)u * 16384; unsigned char* tk = TW + TW_KA + (size_t)u * 16384; unsigned char* tp = TW + TW_PA + (size_t)u * 8192;
#pragma unroll
        for (int c = 0; c < 8; ++c) { const int r = 8 * wave + c; *(unsigned*)(tq + swz(r, lane >> 2) + (lane & 3) * 4) = qr8[c]; *(unsigned*)(tk + swz(r, lane >> 2) + (lane & 3) * 4) = kr8[c]; }
#pragma unroll
        for (int n = 0; n < 2; ++n) { const int c = 16 * (wave >> 1) + l15, s0_ = 16 * (2 * (wave & 1) + n) + 4 * q4; f32x4 v = sc[n];
#pragma unroll
            for (int r = 0; r < 4; ++r) v[r] = (s0_ + r <= c) ? v[r] : 0.f;
            *(u32x2*)(tp + swz64(c, s0_ >> 3) + (q4 & 1) * 8) = pack4(v); }
    } else {
        const int ub = u - NUA, bh = ub / NCH, j = ub % NCH, b = bh / HB, h = bh % HB;
        const float* cw = args.in[4]; const float* cb = args.in[5];
        f32x2 wq[4], wk[4];
#pragma unroll
        for (int k = 0; k < 4; ++k) { wq[k] = *(const f32x2*)(cw + k * (2 * DQK) + h * 128 + 2 * lane); wk[k] = *(const f32x2*)(cw + k * (2 * DQK) + DQK + h * 128 + 2 * lane); }
        const f32x2 bq = *(const f32x2*)(cb + h * 128 + 2 * lane), bk = *(const f32x2*)(cb + DQK + h * 128 + 2 * lane);
        unsigned uq[11], uk[11];
#pragma unroll
        for (int i = 0; i < 11; ++i) { const bool neg = (64 * j + 8 * wave + i - 3) < 0;
            const unsigned a = LDS_RD(unsigned, raw + (8 * wave + i) * 256 + lane * 4), bb = LDS_RD(unsigned, raw + 68 * 256 + (8 * wave + i) * 256 + lane * 4); uq[i] = neg ? 0u : a; uk[i] = neg ? 0u : bb; }
        unsigned char* TWB = args.ws + WS_HB;
        float* sb = (float*)(TWB + TW_SB + (size_t)ub * 2048);
        if (wave == 0) {
            const size_t tok = (size_t)b * SEQ + 64 * j + lane; const float* SG = (const float*)(args.ws + WS_SG);
            const float fp = SG[tok * 16 + HB + h] + args.in[7][h], ig = SG[tok * 16 + h] + args.in[6][h];
            const float bc = scan_add(logsig(fp), lane), a = ig - bc, pm = scan_max(a, lane);
            sb[lane] = pm; sb[64 + lane] = bc;
            LDS_WR(float, lds + PA_SC + lane * 4, a * LOG2E); LDS_WR(float, lds + PA_SC + 256 + lane * 4, pm * LOG2E);
        }
        unsigned q8[8]; float kf[8][2];
#pragma unroll
        for (int c = 0; c < 8; ++c) { float qq[2]; const int r = 8 * wave + c;
#pragma unroll
            for (int e = 0; e < 2; ++e) { float yq = bq[e], yk = bk[e];
#pragma unroll
                for (int k = 0; k < 4; ++k) { yq += wq[k][e] * __builtin_bit_cast(float, e ? (uq[c + k] & 0xffff0000u) : (uq[c + k] << 16)); yk += wk[k][e] * __builtin_bit_cast(float, e ? (uk[c + k] & 0xffff0000u) : (uk[c + k] << 16)); }
                qq[e] = yq * sigm2(yq); kf[c][e] = yk * sigm2(yk) * 0.08838834764831845f; }
            q8[c] = cvt_pk_bf16(qq[0], qq[1]);
            LDS_WR(unsigned, lds + PA_IQ + swz(r, lane >> 2) + (lane & 3) * 4, q8[c]); LDS_WR(unsigned, lds + PA_IK + swz(r, lane >> 2) + (lane & 3) * 4, cvt_pk_bf16(kf[c][0], kf[c][1])); }
        MIX_BAR();
        const float pm63 = LDS_RD(float, lds + PA_SC + 256 + 63 * 4);
        unsigned kw8[8]; float na[2] = {0.f, 0.f};
#pragma unroll
        for (int c = 0; c < 8; ++c) { const float w_ = fexp2(LDS_RD(float, lds + PA_SC + (8 * wave + c) * 4) - pm63); const float k0 = w_ * kf[c][0], k1 = w_ * kf[c][1]; na[0] += k0; na[1] += k1; kw8[c] = cvt_pk_bf16(k0, k1); }
        LDS_WR(f32x2, lds + PA_TOT + (wave * 128 + 2 * lane) * 4, ((f32x2){na[0], na[1]}));
        f32x4 sc[2]; p2_scores(lds, sc, wave, lane);
        const int ct = wave >> 1, st0 = 2 * (wave & 1), c_ = 16 * ct + l15;
        const float pmc = LDS_RD(float, lds + PA_SC + 256 + c_ * 4); float rs = 0.f; u32x2 pw[2];
#pragma unroll
        for (int n = 0; n < 2; ++n) { const int s0_ = 16 * (st0 + n) + 4 * q4; const f32x4 as = LDS_RD(f32x4, lds + PA_SC + s0_ * 4); f32x4 v;
#pragma unroll
            for (int r = 0; r < 4; ++r) { const float t = fexp2(as[r] - pmc) * sc[n][r]; v[r] = (s0_ + r <= c_) ? t : 0.f; rs += v[r]; }
            pw[n] = pack4(v); }
        rs += __shfl_xor(rs, 16); rs += __shfl_xor(rs, 32);
        MIX_BAR();
        if (wave < 2) { const int dcol = wave * 64 + lane; float nl = 0.f;
#pragma unroll
            for (int w = 0; w < 8; ++w) nl += LDS_RD(float, lds + PA_TOT + (w * 128 + dcol) * 4);
            sb[256 + dcol] = nl; }
        if (q4 == 0) sb[128 + c_ * 2 + (wave & 1)] = rs;
        unsigned char* tq = TWB + TW_QB + (size_t)ub * 16384; unsigned char* tk = TWB + TW_KB + (size_t)ub * 16384; unsigned char* tp = TWB + TW_PB + (size_t)ub * 8192;
#pragma unroll
        for (int c = 0; c < 8; ++c) { const int r = 8 * wave + c; *(unsigned*)(tq + swz(r, lane >> 2) + (lane & 3) * 4) = q8[c]; *(unsigned*)(tk + swz(r, lane >> 2) + (lane & 3) * 4) = kw8[c]; }
#pragma unroll
        for (int n = 0; n < 2; ++n) { const int s0_ = 16 * (st0 + n) + 4 * q4; *(u32x2*)(tp + swz64(c_, s0_ >> 3) + (q4 & 1) * 8) = pw[n]; }
    }
}

constexpr int PB_BUFSZ = 51200, PB_Q = 0, PB_K = 16384, PB_V = 32768, PB_P = 40960, PB_VEC = 49152;
constexpr int PB_XS = 2 * PB_BUFSZ, PB_SM = PB_XS + 2 * 16384;
constexpr int SM_SSQ = PB_SM;
constexpr int SM_R = SM_SSQ + 2 * 64 * 4 * 4, SM_INT = SM_R + 256, SM_EMT = SM_INT + 256, SM_RS = SM_EMT + 256, SM_SCAL = SM_RS + 256;
constexpr int SM_NV = SM_SCAL + 64, SM_QN = SM_NV + 512, MX_END = SM_QN + 256;
static_assert(MX_END <= RING_BYTES, "mixer LDS");
DEV void dma_rows64(const void* src, ldsp dst, int wave, int lane) { GLDS16S((const char*)src + wave * 2048, (lane >> 3) * 256 + (lane & 7) * 16, dst + wave * 1024); }

DEV void mixer_a_job(const Args& args, ldsp lds, int b, int h, int vh, int tid_) {
    const int wave = RFL(tid_ >> 6), vt = wave & 3, hf = wave >> 2;
    const bf16* P = (const bf16*)(args.ws + WS_P);
    const unsigned char* TW = args.ws + WS_W1T;
    const rsrc_t RO = make_rsrc(args.ws + WS_OAB, (unsigned)((size_t)2 * M * LDU * 2));
    float* SSA = (float*)(args.ws + WS_SSA);
    const int u0 = (b * HA + h) * NCH, vcol = h * 128 + 64 * vh;
    f32x4 st[4], o[2];
#pragma unroll
    for (int t = 0; t < 4; ++t) st[t] = (f32x4){0.f, 0.f, 0.f, 0.f};
    o[0] = (f32x4){0.f, 0.f, 0.f, 0.f}; o[1] = (f32x4){0.f, 0.f, 0.f, 0.f};
    { const u32x4 z = (u32x4){0u, 0u, 0u, 0u}; const int lane = tid_ & 63;
        LDS_WR(u32x4, lds + PB_XS + 16384 + (vt * 2 + hf) * 2048 + lane * 16, z); LDS_WR(u32x4, lds + PB_XS + 16384 + (vt * 2 + hf) * 2048 + 1024 + lane * 16, z); }
#define MA_DMA(jj) do { ldsp bf_ = lds + ((jj) & 1) * PB_BUFSZ; const size_t uu_ = (size_t)(u0 + (jj)); \
        dma_lin(TW + TW_QA + uu_ * 16384, 16, bf_ + PB_Q, wave, lane); dma_lin(TW + TW_KA + uu_ * 16384, 16, bf_ + PB_K, wave, lane); \
        dma_rows64(P + p_off((size_t)b * SEQ + 64 * (jj), C_IA + h * 128) + 64 * vh, bf_ + PB_V, wave, lane); dma_lin(TW + TW_PA + uu_ * 8192, 8, bf_ + PB_P, wave, lane); dma_lin(TW + TW_VA + uu_ * 2048, 2, bf_ + PB_VEC, wave, lane); } while (0)
    { const int lane = tid_ & 63; MA_DMA(0); }
    for (int j = 0; j <= NCH; ++j) {
        int tidj = tid_; OPAQUE(tidj);
        const int lane = tidj & 63, q4 = lane >> 4, l15 = lane & 15;
        const size_t tk0 = (size_t)b * SEQ + 64 * j;
        if (j <= 1) WAIT_V(0); else WAIT_V(2);
        MIX_BAR();
        if (j + 1 < NCH) MA_DMA(j + 1);
        if (j > 0) {
            if (wave == 0) { const f32x4 s0 = LDS_RD(f32x4, lds + SM_SSQ + ((j - 1) & 1) * 1024 + lane * 16); SSA[((tk0 - 64 + lane) * HA + h) * 2 + vh] = (s0[0] + s0[1]) + (s0[2] + s0[3]); }
#pragma unroll
            for (int i = 0; i < 2; ++i) bstore64(RO, (unsigned)(l15 * LDU + vcol + 16 * vt + 4 * q4) * 2u, (unsigned)(tk0 - 64 + 16 * (2 * hf + i)) * (unsigned)(LDU * 2), pack4(o[i]));
        }
        if (j == NCH) break;
        ldsp bf = lds + (j & 1) * PB_BUFSZ;
        bf16x8 bv[2], pf[2][2], qo[2][2], qp[2][2], so[2], sp[2];
#pragma unroll
        for (int ks = 0; ks < 2; ++ks) bv[ks] = frag_tr(bf + PB_V, 16 * vt, ks, lane, 128);
#pragma unroll
        for (int ks = 0; ks < 2; ++ks)
#pragma unroll
            for (int i = 0; i < 2; ++i) pf[ks][i] = frag16p(bf + PB_P, 16 * (2 * hf + i), ks, lane);
#pragma unroll
        for (int kl = 0; kl < 2; ++kl)
#pragma unroll
            for (int i = 0; i < 2; ++i) { qo[kl][i] = frag8x2s(bf + PB_Q, 16 * (2 * hf + i), 2 * hf + kl, lane); qp[kl][i] = frag8x2s(bf + PB_Q, 16 * (2 * hf + i), 2 * (hf ^ 1) + kl, lane); }
        u32x4 xp[2];
#pragma unroll
        for (int kl = 0; kl < 2; ++kl) xp[kl] = LDS_RD(u32x4, lds + PB_XS + ((j + 1) & 1) * 16384 + (vt * 2 + (hf ^ 1)) * 2048 + kl * 1024 + lane * 16);
        f32x4 eo[4], ep[4];
#pragma unroll
        for (int t = 0; t < 4; ++t) { eo[t] = LDS_RD(f32x4, bf + PB_VEC + (16 * (4 * hf + t) + 4 * q4) * 4); ep[t] = LDS_RD(f32x4, bf + PB_VEC + (16 * (4 * (hf ^ 1) + t) + 4 * q4) * 4); }
        SCHED_BAR();
#pragma unroll
        for (int kl = 0; kl < 2; ++kl) {
            { u32x4 w; const f32x4 a0 = st[2 * kl] * eo[2 * kl], a1 = st[2 * kl + 1] * eo[2 * kl + 1]; w.x = cvt_pk_bf16(a0[0], a0[1]); w.y = cvt_pk_bf16(a0[2], a0[3]); w.z = cvt_pk_bf16(a1[0], a1[1]); w.w = cvt_pk_bf16(a1[2], a1[3]);
              so[kl] = __builtin_bit_cast(bf16x8, w); }
            { u32x4 w; const f32x4 e0 = ep[2 * kl], e1 = ep[2 * kl + 1]; const u32x4 x = xp[kl];
              w.x = cvt_pk_bf16(__builtin_bit_cast(float, x.x << 16) * e0[0], __builtin_bit_cast(float, x.x & 0xffff0000u) * e0[1]); w.y = cvt_pk_bf16(__builtin_bit_cast(float, x.y << 16) * e0[2], __builtin_bit_cast(float, x.y & 0xffff0000u) * e0[3]);
              w.z = cvt_pk_bf16(__builtin_bit_cast(float, x.z << 16) * e1[0], __builtin_bit_cast(float, x.z & 0xffff0000u) * e1[1]); w.w = cvt_pk_bf16(__builtin_bit_cast(float, x.w << 16) * e1[2], __builtin_bit_cast(float, x.w & 0xffff0000u) * e1[3]);
              sp[kl] = __builtin_bit_cast(bf16x8, w); } }
        o[0] = (f32x4){0.f, 0.f, 0.f, 0.f}; o[1] = (f32x4){0.f, 0.f, 0.f, 0.f};
#pragma unroll
        for (int ks = 0; ks < 2; ++ks)
#pragma unroll
            for (int i = 0; i < 2; ++i) o[i] = MFMA16(bv[ks], pf[ks][i], o[i]);
#pragma unroll
        for (int kl = 0; kl < 2; ++kl)
#pragma unroll
            for (int i = 0; i < 2; ++i) { o[i] = MFMA16(so[kl], qo[kl][i], o[i]); o[i] = MFMA16(sp[kl], qp[kl][i], o[i]); }
#pragma unroll
        for (int i = 0; i < 4; ++i) { const int t = 4 * hf + i;
            f32x4 u = (f32x4){0.f, 0.f, 0.f, 0.f};
#pragma unroll
            for (int ks = 0; ks < 2; ++ks) { const bf16x8 a = frag_trs(bf + PB_K, 16 * t, ks, lane); u = MFMA16(a, bv[ks], u); }
            const f32x4 eg = LDS_RD(f32x4, bf + PB_VEC + 512 + (16 * t + 4 * q4) * 4), egm = LDS_RD(f32x4, bf + PB_VEC + 1024 + (16 * t + 4 * q4) * 4); st[i] = eg * st[i] + egm * u; }
#pragma unroll
        for (int kl = 0; kl < 2; ++kl) { u32x4 w; const f32x4 a0 = st[2 * kl], a1 = st[2 * kl + 1]; w.x = cvt_pk_bf16(a0[0], a0[1]); w.y = cvt_pk_bf16(a0[2], a0[3]); w.z = cvt_pk_bf16(a1[0], a1[1]); w.w = cvt_pk_bf16(a1[2], a1[3]);
            LDS_WR(u32x4, lds + PB_XS + (j & 1) * 16384 + (vt * 2 + hf) * 2048 + kl * 1024 + lane * 16, w); }
#pragma unroll
        for (int i = 0; i < 2; ++i) { float s_ = (o[i][0] * o[i][0] + o[i][1] * o[i][1]) + (o[i][2] * o[i][2] + o[i][3] * o[i][3]); s_ += __shfl_xor(s_, 16); s_ += __shfl_xor(s_, 32);
            LDS_WR(float, lds + SM_SSQ + (j & 1) * 1024 + ((16 * (2 * hf + i) + l15) * 4 + vt) * 4, s_); }
    }
#undef MA_DMA
}

DEV void mixer_b_job(const Args& args, ldsp lds, int b, int h, int vq, int tid_) {
    const int wave = RFL(tid_ >> 6), vt = wave & 3, hf = wave >> 2;
    const int vbase = h * 256 + 64 * vq;
    const bf16* P = (const bf16*)(args.ws + WS_P);
    const unsigned char* TW = args.ws + WS_HB;
    const rsrc_t RO = make_rsrc(args.ws + WS_OAB, (unsigned)((size_t)2 * M * LDU * 2));
    float* SSB = (float*)(args.ws + WS_SSB);
    const int u0 = (b * HB + h) * NCH;
    f32x4 st[4], hv[2];
#pragma unroll
    for (int t = 0; t < 4; ++t) st[t] = (f32x4){0.f, 0.f, 0.f, 0.f};
    hv[0] = (f32x4){0.f, 0.f, 0.f, 0.f}; hv[1] = (f32x4){0.f, 0.f, 0.f, 0.f};
    float mcar = 0.f;
    if (wave < 2) LDS_WR(float, lds + SM_NV + tid_ * 4, 0.f);
    { const u32x4 z = (u32x4){0u, 0u, 0u, 0u}; const int lane = tid_ & 63;
        LDS_WR(u32x4, lds + PB_XS + 16384 + (vt * 2 + hf) * 2048 + lane * 16, z); LDS_WR(u32x4, lds + PB_XS + 16384 + (vt * 2 + hf) * 2048 + 1024 + lane * 16, z); }
#define MB_DMA(jj) do { ldsp bf_ = lds + ((jj) & 1) * PB_BUFSZ; const size_t uu_ = (size_t)(u0 + (jj)); \
        dma_lin(TW + TW_QB + uu_ * 16384, 16, bf_ + PB_Q, wave, lane); dma_lin(TW + TW_KB + uu_ * 16384, 16, bf_ + PB_K, wave, lane); \
        dma_rows64(P + p_off((size_t)b * SEQ + 64 * (jj), C_VB + h * 256 + 128 * (vq >> 1)) + 64 * (vq & 1), bf_ + PB_V, wave, lane); dma_lin(TW + TW_PB + uu_ * 8192, 8, bf_ + PB_P, wave, lane); dma_lin(TW + TW_SB + uu_ * 2048, 2, bf_ + PB_VEC, wave, lane); } while (0)
    { const int lane = tid_ & 63; MB_DMA(0); }
    for (int j = 0; j <= NCH; ++j) {
        const size_t tk0 = (size_t)b * SEQ + 64 * j;
        int tidj = tid_; OPAQUE(tidj);
        const int tid = tidj, lane = tidj & 63, q4 = lane >> 4, l15 = lane & 15;
        if (j <= 1) WAIT_V(0); else WAIT_V(2);
        MIX_BAR();
        if (j + 1 < NCH) MB_DMA(j + 1);
        if (j > 0) {
            if (wave == 0) { const f32x4 s0 = LDS_RD(f32x4, lds + SM_SSQ + ((j - 1) & 1) * 1024 + lane * 16); SSB[((tk0 - 64 + lane) * HB + h) * 4 + vq] = (s0[0] + s0[1]) + (s0[2] + s0[3]); }
#pragma unroll
            for (int i = 0; i < 2; ++i) bstore64(RO, (unsigned)(l15 * LDU + vbase + 16 * vt + 4 * q4) * 2u, (unsigned)(M + tk0 - 64 + 16 * (2 * hf + i)) * (unsigned)(LDU * 2), pack4(hv[i]));
        }
        if (j == NCH) break;
        ldsp bf = lds + (j & 1) * PB_BUFSZ;
        if (wave == 0) {
            const float pm = LDS_RD(float, bf + PB_VEC + lane * 4), bc = LDS_RD(float, bf + PB_VEC + 256 + lane * 4); const f32x2 rsl = LDS_RD(f32x2, bf + PB_VEC + 512 + lane * 8);
            const float mx = fmaxf(mcar, pm), r = fexp(pm - mx);
            const float pm63 = __shfl(pm, 63), bc63 = __shfl(bc, 63), m63 = fmaxf(mcar, pm63);
            LDS_WR(float, lds + SM_R + lane * 4, r); LDS_WR(float, lds + SM_INT + lane * 4, fexp(mcar - mx)); LDS_WR(float, lds + SM_EMT + lane * 4, fexp(-(bc + mx))); LDS_WR(float, lds + SM_RS + lane * 4, r * (rsl[0] + rsl[1]));
            if (lane == 0) { LDS_WR(float, lds + SM_SCAL, fexp(mcar - m63)); LDS_WR(float, lds + SM_SCAL + 4, bc63 + m63); LDS_WR(float, lds + SM_SCAL + 8, fexp(pm63 - m63)); }
        }
        {
            const int c = tid >> 3, part = tid & 7; float s = 0.f;
#pragma unroll
            for (int hh = 0; hh < 2; ++hh) { const u32x4 qw = LDS_RD(u32x4, bf + PB_Q + swz(c, 2 * part + hh));
#pragma unroll
                for (int e = 0; e < 4; ++e) { const f32x2 nv = LDS_RD(f32x2, lds + SM_NV + (16 * part + 8 * hh + 2 * e) * 4); s += __builtin_bit_cast(float, qw[e] << 16) * nv[0] + __builtin_bit_cast(float, qw[e] & 0xffff0000u) * nv[1]; } }
            s += __shfl_xor(s, 1); s += __shfl_xor(s, 2); s += __shfl_xor(s, 4);
            LDS_WR(float, lds + SM_QN + c * 4, s);
        }
        MIX_BAR();
        const float decay = LDS_RD(float, lds + SM_SCAL), sj = LDS_RD(float, lds + SM_SCAL + 8);
        mcar = LDS_RD(float, lds + SM_SCAL + 4);
        {
            bf16x8 bv[2], pf[2][2], qo[2][2], qp[2][2], so[2], sp[2];
#pragma unroll
            for (int ks = 0; ks < 2; ++ks) bv[ks] = frag_tr(bf + PB_V, 16 * vt, ks, lane, 128);
#pragma unroll
            for (int ks = 0; ks < 2; ++ks)
#pragma unroll
                for (int i = 0; i < 2; ++i) pf[ks][i] = frag16p(bf + PB_P, 16 * (2 * hf + i), ks, lane);
#pragma unroll
            for (int kl = 0; kl < 2; ++kl)
#pragma unroll
                for (int i = 0; i < 2; ++i) { qo[kl][i] = frag8x2s(bf + PB_Q, 16 * (2 * hf + i), 2 * hf + kl, lane); qp[kl][i] = frag8x2s(bf + PB_Q, 16 * (2 * hf + i), 2 * (hf ^ 1) + kl, lane); }
#pragma unroll
            for (int kl = 0; kl < 2; ++kl) sp[kl] = LDS_RD(bf16x8, lds + PB_XS + ((j + 1) & 1) * 16384 + (vt * 2 + (hf ^ 1)) * 2048 + kl * 1024 + lane * 16);
            float s_int[2], s_r[2], s_qn[2], s_rs[2], s_emt[2];
#pragma unroll
            for (int i = 0; i < 2; ++i) { const int c = 16 * (2 * hf + i) + l15; s_int[i] = LDS_RD(float, lds + SM_INT + c * 4); s_r[i] = LDS_RD(float, lds + SM_R + c * 4); s_qn[i] = LDS_RD(float, lds + SM_QN + c * 4); s_rs[i] = LDS_RD(float, lds + SM_RS + c * 4); s_emt[i] = LDS_RD(float, lds + SM_EMT + c * 4); }
            SCHED_BAR();
#pragma unroll
            for (int kl = 0; kl < 2; ++kl) { u32x4 w; const f32x4 a0 = st[2 * kl], a1 = st[2 * kl + 1]; w.x = cvt_pk_bf16(a0[0], a0[1]); w.y = cvt_pk_bf16(a0[2], a0[3]); w.z = cvt_pk_bf16(a1[0], a1[1]); w.w = cvt_pk_bf16(a1[2], a1[3]); so[kl] = __builtin_bit_cast(bf16x8, w); }
#pragma unroll
            for (int i = 0; i < 2; ++i) {
                f32x4 a1 = (f32x4){0.f, 0.f, 0.f, 0.f}, a2 = (f32x4){0.f, 0.f, 0.f, 0.f};
#pragma unroll
                for (int ks = 0; ks < 2; ++ks) a2 = MFMA16(bv[ks], pf[ks][i], a2);
#pragma unroll
                for (int kl = 0; kl < 2; ++kl) { a1 = MFMA16(so[kl], qo[kl][i], a1); a1 = MFMA16(sp[kl], qp[kl][i], a1); }
                const float den = s_int[i] * s_qn[i] + s_rs[i];
                const float rden = frcp(fmaxf(fabsf(den), s_emt[i]));
                hv[i] = (s_int[i] * a1 + s_r[i] * a2) * rden;
            }
#pragma unroll
            for (int i = 0; i < 4; ++i) { const int t = 4 * hf + i;
                f32x4 u = (f32x4){0.f, 0.f, 0.f, 0.f};
#pragma unroll
                for (int ks = 0; ks < 2; ++ks) { const bf16x8 a = frag_trs(bf + PB_K, 16 * t, ks, lane); u = MFMA16(a, bv[ks], u); }
                st[i] = decay * st[i] + sj * u;
            }
#pragma unroll
            for (int kl = 0; kl < 2; ++kl) { u32x4 w; const f32x4 a0 = st[2 * kl], a1 = st[2 * kl + 1]; w.x = cvt_pk_bf16(a0[0], a0[1]); w.y = cvt_pk_bf16(a0[2], a0[3]); w.z = cvt_pk_bf16(a1[0], a1[1]); w.w = cvt_pk_bf16(a1[2], a1[3]);
                LDS_WR(u32x4, lds + PB_XS + (j & 1) * 16384 + (vt * 2 + hf) * 2048 + kl * 1024 + lane * 16, w); }
            if (wave < 2) LDS_WR(float, lds + SM_NV + tid * 4, decay * LDS_RD(float, lds + SM_NV + tid * 4) + sj * LDS_RD(float, bf + PB_VEC + 1024 + tid * 4));
#pragma unroll
            for (int i = 0; i < 2; ++i) { float s_ = (hv[i][0] * hv[i][0] + hv[i][1] * hv[i][1]) + (hv[i][2] * hv[i][2] + hv[i][3] * hv[i][3]); s_ += __shfl_xor(s_, 16); s_ += __shfl_xor(s_, 32);
                LDS_WR(float, lds + SM_SSQ + (j & 1) * 1024 + ((16 * (2 * hf + i) + l15) * 4 + vt) * 4, s_); }
        }
    }
#undef MB_DMA
}

constexpr int P0_RB1 = (NP + NSG + 63) / 64, P0_I1 = (D / 64) * P0_RB1, P0_IU = (DA / 64) * (D / 64), P0_IO = (D / 64) * (D / 64), P0_NITEMS = P0_I1 + 2 * P0_IU + P0_IO;
DEV P0Desc p0_decode(const Args& args, int it) {
    unsigned char* ws = args.ws; bf16* W1T = (bf16*)(ws + WS_W1T); bf16* WUT = (bf16*)(ws + WS_WUT); bf16* WOT = (bf16*)(ws + WS_WOT);
    P0Desc d; int r = it;
    if (r < P0_I1) { const int kb = r / P0_RB1, rb = r % P0_RB1, r0 = 64 * rb; d.W = args.in[2]; d.ldw = D_IN; d.K = D; d.k0 = 64 * kb;
        if (r0 >= NPM && r0 < NP) { d.WT = ws + WS_W8; d.c0 = r0 + NSG; d.r0 = r0 - NPM; d.nv = 64; d.fp8 = 1; return d; }
        d.WT = W1T; d.fp8 = 0; d.r0 = r0;
        if (r0 >= C_OGA && r0 < C_OGA + DA) { d.fp8 = 2; d.WT8 = ws + WS_W8OG; d.r08 = r0 - C_OGA; }
        if (r0 >= C_OGB && r0 < C_OGB + DB) { d.fp8 = 2; d.WT8 = ws + WS_W8OG; d.r08 = DA + (r0 - C_OGB); }
        if (r0 < NPM) { d.c0 = r0; d.nv = 64; } else { d.c0 = NPM + (r0 - NP); d.nv = NSG - (r0 - NP) < 64 ? NSG - (r0 - NP) : 64; }
        return d; }
    r -= P0_I1; d.fp8 = 0; d.ldw = D; d.nv = 64;
    if (r < P0_IU) { const int kb = r / (D / 64), rb = r % (D / 64); d.W = args.in[10]; d.K = LDU; d.WT = WUT; d.k0 = 64 * kb; d.c0 = 64 * rb; d.r0 = 64 * rb; return d; }
    r -= P0_IU;
    if (r < P0_IU) { const int kb = r / (D / 64), rb = r % (D / 64); d.W = args.in[11]; d.K = LDU; d.WT = WUT + (size_t)D * LDU; d.k0 = 64 * kb; d.c0 = 64 * rb; d.r0 = 64 * rb; return d; }
    r -= P0_IU;
    { const int kb = r / (D / 64), rb = r % (D / 64); d.W = args.in[12]; d.K = D; d.WT = WOT; d.k0 = 64 * kb; d.c0 = 64 * rb; d.r0 = 64 * rb; return d; }
}
DEV void p0_items(const Args& args, int first, int last, int stride, ldsp scr, int lane) {
    if (first >= last) return;
    P0Desc d = p0_decode(args, first); f32x4 v[16]; p0_load(d, lane, v);
    for (int it = first; it < last; it += stride) {
        const int nx = it + stride; P0Desc dn = d; f32x4 vn[16];
        if (nx < last) { dn = p0_decode(args, nx); p0_load(dn, lane, vn); }
        p0_store(d, v, scr, lane);
        if (nx < last) { d = dn;
#pragma unroll
            for (int i = 0; i < 16; ++i) v[i] = vn[i]; }
    }
}

__global__ void __launch_bounds__(NTHREADS, 2) fwd_kernel(Args args) {
#ifndef EMU
    extern __shared__ __attribute__((aligned(16))) unsigned char lds_raw[];
    ldsp lds = (ldsp)lds_raw;
#else
    ldsp lds = emu_lds;
#endif
    const int tid = threadIdx.x, lane = tid & 63, wave = RFL(tid >> 6);
    const int G = gridDim.x, bx = blockIdx.x;
    const int vcu = (G % 8 == 0) ? (bx % 8) * (G / 8) + bx / 8 : bx;
    unsigned char* ws = args.ws;
#ifndef EMU
    for (int u = tid; u < (LDS_BYTES - LDSCTL_OFF) / 4; u += NTHREADS) ((LAS unsigned*)(lds + LDSCTL_OFF))[u] = 0u;
    __syncthreads();
    XcdBarrier bar = xcd_barrier_post((unsigned*)(ws + WS_CTL) + CW_BAR, (volatile LAS unsigned*)(lds + MISC_OFF) + 8);
#define GRID_BAR() xcd_barrier(bar)
#else
#define GRID_BAR()
#endif
    const int lo = args.ph_lo, hi = args.ph_hi;
#ifndef GEMM_SP2
#define GEMM_SP2 true
#endif
#ifndef GEMM_ALIGN
#define GEMM_ALIGN true
#endif
#ifndef PROBE_REP_P4
#define PROBE_REP_P4 1
#endif
#ifndef PROBE_REP_P5
#define PROBE_REP_P5 1
#endif
#ifndef PROBE_REP_P1
#define PROBE_REP_P1 2
#endif
#ifndef PROBE_REP_P2
#define PROBE_REP_P2 1
#endif
#ifndef PHASE_MASK
#define PHASE_MASK 255
#endif
#define IN(k) (((PHASE_MASK >> (k)) & 1) && lo <= (k) && (k) < hi)
#define BOTH(k) (IN(k) && IN((k) + 1))
    const float* x = args.in[0];
    bf16* W1T = (bf16*)(ws + WS_W1T); bf16* WUT = (bf16*)(ws + WS_WUT); bf16* WOT = (bf16*)(ws + WS_WOT);
    bf16* HBUF = (bf16*)(ws + WS_HB); bf16* PB = (bf16*)(ws + WS_P); float* SG = (float*)(ws + WS_SG); bf16* OAB = (bf16*)(ws + WS_OAB); float* RSS = (float*)(ws + WS_RSS);

    if (IN(0)) {
        ldsp scr = lds + wave * 17408;
        const int gw = vcu * NWAVES + wave, NGW = G * NWAVES;
        constexpr int I_1 = P0_I1, NITEMS = P0_NITEMS;
        static_assert(NPM % 64 == 0 && NP % 64 == 0 && NSG % 4 == 0, "P0 item tiling");
        constexpr int NJOBS3 = NB * HA * 2 + NB * HB * 4;
        const int nit0 = (G > NJOBS3) ? I_1 : NITEMS;
        p0_items(args, gw, nit0, NGW, scr, lane);
        const float* gpre = args.in[1];
        for (int m = gw; m < M; m += NGW) {
            const f32x4* xr = (const f32x4*)(x + (size_t)m * D) + lane;
            f32x4 v[D / 256]; float s = 0.f;
#pragma unroll
            for (int jj = 0; jj < D / 256; ++jj) { v[jj] = xr[64 * jj]; s += (v[jj][0] * v[jj][0] + v[jj][1] * v[jj][1]) + (v[jj][2] * v[jj][2] + v[jj][3] * v[jj][3]); }
            const float rstd = frsq(wave_sum(s) * (1.0f / D) + EPS) ;
            u32x2* o8 = (u32x2*)(HBUF + (size_t)m * D) + lane; unsigned* o4 = (unsigned*)(ws + WS_H8 + (size_t)m * D) + lane;
#pragma unroll
            for (int jj = 0; jj < D / 256; ++jj) { const f32x4 gg = ((const f32x4*)gpre)[lane + 64 * jj]; const f32x4 hh = v[jj] * rstd * gg; u32x2 w; w.x = pk2(hh[0], hh[1]); w.y = pk2(hh[2], hh[3]); o8[64 * jj] = w;
                o4[64 * jj] = pk_fp8x4(clamp8(hh[0] * H8_SCALE), clamp8(hh[1] * H8_SCALE), clamp8(hh[2] * H8_SCALE), clamp8(hh[3] * H8_SCALE)); }
        }
        if (BOTH(0)) GRID_BAR();
    }

    if (IN(1)) {
        {
            const int gw = vcu * NWAVES + wave, NGW = G * NWAVES, l15 = lane & 15, q4 = lane >> 4;
            const int wrow = NP + (l15 < NSG ? l15 : NSG - 1);
            for (int t = gw; t < M / 16; t += NGW) {
                f32x4 acc = (f32x4){0.f, 0.f, 0.f, 0.f};
                const bf16* ap = HBUF + (size_t)(16 * t + l15) * D + 8 * q4; const bf16* bp = W1T + (size_t)wrow * D + 8 * q4;
                for (int k0 = 0; k0 < D / 32; k0 += 16) {
                    bf16x8 af[16], bfr[16];
#pragma unroll
                    for (int i = 0; i < 16; ++i) { af[i] = *(const bf16x8*)(ap + 32 * (k0 + i)); bfr[i] = *(const bf16x8*)(bp + 32 * (k0 + i)); }
#pragma unroll
                    for (int i = 0; i < 16; ++i) acc = MFMA16(af[i], bfr[i], acc);
                }
#pragma unroll
                for (int r = 0; r < 4; ++r) SG[(size_t)(16 * t + 4 * q4 + r) * 16 + l15] = acc[r];
            }
        }
        { pg8::Gemm g{HBUF, W1T, M, NPM, D}; SchedSkipOg S; S.so.init(M, NPM - DA - DB, G, bx);
          EpiP E{PB};
          pg8::gemm_phase<EpiP, SchedSkipOg, GEMM_ALIGN, GEMM_SP2>(lds, g, S, E); }
        { pg8::Gemm g8{(const bf16*)(ws + WS_H8), (const bf16*)(ws + WS_W8OG), M, DA + DB, D}; pg8::StaticOrder S8; S8.init(M, DA + DB, G, bx);
          EpiOg E8{PB};
          pg8::gemm_phase<EpiOg, pg8::StaticOrder, GEMM_ALIGN, GEMM_SP2, 1>(lds, g8, S8, E8); }
        if (BOTH(1)) GRID_BAR();
    }

    if (IN(2)) {
        int buf = 0;
        if (bx < NUA + NUB) p2_issue(args, bx, lds + PA_RAW, wave, lane);
        for (int u = bx, it = 0; u < NUA + NUB; u += G, ++it) {
            int tidj = tid; OPAQUE(tidj); const int lane_ = tidj & 63;
            if (it == 0) WAIT_V(0); else WAIT_V(18);
            MIX_BAR();
            if (u + G < NUA + NUB) p2_issue(args, u + G, lds + PA_RAW + (buf ^ 1) * PA_RAWSZ, wave, lane_);
            p2_unit(args, lds, u, lds + PA_RAW + buf * PA_RAWSZ, wave, lane_);
            buf ^= 1;
        }
        if (BOTH(2)) GRID_BAR();
    }

    if (IN(3)) {
        constexpr int NJA = NB * HA * 2, NJB = NB * HB * 4;
        if (G > NJA + NJB && bx >= NJA + NJB) {
            ldsp scr = lds + wave * 17408;
            p0_items(args, P0_I1 + (bx - (NJA + NJB)) * NWAVES + wave, P0_NITEMS, (G - (NJA + NJB)) * NWAVES, scr, lane);
        }
        for (int job = bx; job < NJA + NJB; job += G) {
            if (job < NJA) mixer_a_job(args, lds, job / (2 * HA), (job >> 1) % HA, job & 1, tid);
            else { const int jb = job - NJA; mixer_b_job(args, lds, jb / (4 * HB), (jb >> 2) % HB, jb & 3, tid); }
            BLOCK_BAR();
        }
        if (BOTH(3)) GRID_BAR();
    }

    if (IN(4)) {
        const int gw = vcu * NWAVES + wave, NGW = G * NWAVES;
        const float* SSA = (const float*)(ws + WS_SSA); const float* SSB = (const float*)(ws + WS_SSB);
        static_assert(DA % 512 == 0 && DA == DB, "P3 tiling");
        for (int m = gw; m < M; m += NGW) {
#pragma unroll
            for (int br = 0; br < 2; ++br) {
#pragma unroll
                for (int i = 0; i < DA / 512; ++i) {
                    const int col0 = i * 512 + lane * 8;
                    float rstd;
                    if (br == 0) { const int hh = col0 / 128; rstd = frsq((SSA[((size_t)m * HA + hh) * 2] + SSA[((size_t)m * HA + hh) * 2 + 1]) * (1.0f / 128.0f) + EPS); }
                    else { const int hh = col0 / 256; const f32x4 q_ = *(const f32x4*)(SSB + ((size_t)m * HB + hh) * 4); rstd = frsq(((q_[0] + q_[1]) + (q_[2] + q_[3])) * (1.0f / 256.0f) + EPS); }
                    u32x4* po = (u32x4*)(OAB + (size_t)(br * M + m) * LDU + col0);
                    u32x4 w = *po; const u32x4 g8 = *(const u32x4*)(PB + p_off((size_t)m, (br ? C_OGB : C_OGA) + col0)), z8 = *(const u32x4*)(PB + p_off((size_t)m, (br ? C_ZB : C_ZA) + col0));
                    const f32x4 gn0 = *(const f32x4*)(args.in[br ? 9 : 8] + col0), gn1 = *(const f32x4*)(args.in[br ? 9 : 8] + col0 + 4);
#pragma unroll
                    for (int e = 0; e < 4; ++e) { float v[2];
#pragma unroll
                        for (int k = 0; k < 2; ++k) { const float ov = __builtin_bit_cast(float, k ? (w[e] & 0xffff0000u) : (w[e] << 16)), og = __builtin_bit_cast(float, k ? (g8[e] & 0xffff0000u) : (g8[e] << 16)), z = __builtin_bit_cast(float, k ? (z8[e] & 0xffff0000u) : (z8[e] << 16));
                            const float gnv = (e < 2 ? gn0 : gn1)[(2 * e + k) & 3];
                            v[k] = ov * rstd * gnv * sigm2(og) * (z * sigm2(z)); }
                        w[e] = cvt_pk_bf16(v[0], v[1]); }
                    *po = w;
                }
            }
        }
        if (BOTH(4)) GRID_BAR();
    }
    if (IN(5)) {
        { pg8::Gemm g8{(const bf16*)(ws + WS_H8), (const bf16*)(ws + WS_W8), M, 2 * D, D}; SchedGate S8; S8.so.init(M, D, G, bx);
          EpiP8 E8{PB};
          pg8::gemm_phase<EpiP8, SchedGate, GEMM_ALIGN, GEMM_SP2, 1>(lds, g8, S8, E8); }
        BLOCK_BAR();
        pg8::Gemm g{OAB, WUT, M, D, 2 * DA, LDU, (size_t)M * LDU * 2, (size_t)D * LDU * 2}; SchedRev S; S.init(M, D, G, bx);
        EpiUp2 E{HBUF, make_rsrc(PB, P_BYTES)};
        for (int rep = 0; rep < PROBE_REP_P4; ++rep) pg8::gemm_phase<EpiUp2, SchedRev, GEMM_ALIGN, GEMM_SP2, 2, true>(lds, g, S, E);
        if (BOTH(5)) GRID_BAR();
    }

    if (IN(6)) {
        pg8::Gemm g{HBUF, WOT, M, D, D}; pg8::StaticOrder S; S.init(M, D, G, bx);
        EpiOut E{PB, RSS};
        for (int rep = 0; rep < PROBE_REP_P5; ++rep) pg8::gemm_phase<EpiOut, pg8::StaticOrder, GEMM_ALIGN, GEMM_SP2>(lds, g, S, E);
        if (BOTH(6)) GRID_BAR();
    }

    if (IN(7)) {
        const int gw = vcu * NWAVES + wave, NGW = G * NWAVES;
        const float* gpost = args.in[13];
        for (int m = gw; m < M; m += NGW) {
            const float ss = wave_sum(lane < NRS ? RSS[(size_t)m * NRS + lane] : 0.f);
            const float rstd = frsq(ss * (1.0f / D) + EPS);
            const f32x4* xr = (const f32x4*)(x + (size_t)m * D) + lane; f32x4* orow = (f32x4*)(args.out + (size_t)m * D) + lane; const u32x2* ob = (const u32x2*)(PB + (size_t)m * D) + lane;
#pragma unroll
            for (int jj = 0; jj < D / 256; ++jj) { const f32x4 xv = xr[64 * jj], gg = ((const f32x4*)gpost)[lane + 64 * jj]; const u32x2 w = ob[64 * jj];
                const f32x4 ov = (f32x4){__builtin_bit_cast(float, w.x << 16), __builtin_bit_cast(float, w.x & 0xffff0000u), __builtin_bit_cast(float, w.y << 16), __builtin_bit_cast(float, w.y & 0xffff0000u)};
                orow[64 * jj] = xv + ov * rstd * gg; }
        }
    }
#undef IN
#undef BOTH
}

#ifndef EMU
extern "C" void kernel_launch(void* const* d_in, const int* in_sizes, int n_in, void* d_out, int out_size, void* d_ws, size_t ws_size, hipStream_t stream) {
    static int grid = 0;
    if (grid == 0) {
        if (n_in != 14 || out_size != M * D || ws_size < WS_END) { fprintf(stderr, "kernel_launch: unexpected shapes (n_in %d, out %d, ws %zu < %zu)\n", n_in, out_size, ws_size, (size_t)WS_END); grid = -1; return; }
        int dev = 0, cus = 0, per_cu = 0;
        if (hipGetDevice(&dev) != hipSuccess || hipDeviceGetAttribute(&cus, hipDeviceAttributeMultiprocessorCount, dev) != hipSuccess) { grid = -1; return; }
        if (hipFuncSetAttribute((const void*)fwd_kernel, hipFuncAttributeMaxDynamicSharedMemorySize, LDS_BYTES) != hipSuccess) { fprintf(stderr, "kernel_launch: hipFuncSetAttribute failed\n"); grid = -1; return; }
        if (hipOccupancyMaxActiveBlocksPerMultiprocessor(&per_cu, (const void*)fwd_kernel, NTHREADS, LDS_BYTES) != hipSuccess || per_cu < 1) { fprintf(stderr, "kernel_launch: occupancy query says %d\n", per_cu); }
        (void)hipGetLastError();
        grid = cus;
    }
    if (grid < 0) return;
    (void)hipMemsetAsync((char*)d_ws + WS_CTL, 0, CTL_ZERO_BYTES, stream);
    Args a{};
    for (int i = 0; i < 14; ++i) a.in[i] = (const float*)d_in[i];
    a.out = (float*)d_out; a.ws = (unsigned char*)d_ws; a.ph_lo = 0; a.ph_hi = 8;
    hipLaunchKernelGGL(fwd_kernel, dim3(grid), dim3(NTHREADS), LDS_BYTES, stream, a);
}
#endif
```

```cpp
typedef unsigned u32x2_t __attribute__((ext_vector_type(2)));
typedef int v8i_t __attribute__((ext_vector_type(8)));
typedef int v4i_t __attribute__((ext_vector_type(4)));
#ifndef EMU
#include <hip/hip_runtime.h>
#include <cstdio>
#include <cstdint>
#define LAS __attribute__((address_space(3)))
#define GAS __attribute__((address_space(1)))
typedef short bf16x8 __attribute__((ext_vector_type(8)));
typedef short bf16x4 __attribute__((ext_vector_type(4)));
typedef float f32x4 __attribute__((ext_vector_type(4)));
#define DEV __device__ __forceinline__
#define LDS_RD(T, p) (*(const LAS T*)(p))
#define LDS_WR(T, p, v) (*(LAS T*)(p) = (v))
#define WAVE_SYNC() asm volatile("s_waitcnt lgkmcnt(0)" ::: "memory")
#define BLOCK_BAR() __syncthreads()
#define RAW_BAR() __builtin_amdgcn_s_barrier()
#define WAIT_V(n) asm volatile("s_waitcnt vmcnt(" #n ")" ::: "memory")
#define WAIT_L(n) asm volatile("s_waitcnt lgkmcnt(" #n ")" ::: "memory")
#define SCHED_BAR() __builtin_amdgcn_sched_barrier(0)
#define SETPRIO(n) __builtin_amdgcn_s_setprio(n)
#define GLDS16(g, l) __builtin_amdgcn_global_load_lds((const unsigned*)(g), (LAS unsigned*)(l), 16, 0, 0)
#define MFMA16(a, b, c) __builtin_amdgcn_mfma_f32_16x16x32_bf16(a, b, c, 0, 0, 0)
#define RFL(x) __builtin_amdgcn_readfirstlane(x)
#define COMPILER_FENCE() asm volatile("" ::: "memory")
#define OPAQUE(x) asm volatile("" : "+v"(x))
DEV float fexp2(float x) { return __builtin_amdgcn_exp2f(x); }
DEV float flog2(float x) { return __builtin_amdgcn_logf(x); }
DEV float frcp(float x) { return __builtin_amdgcn_rcpf(x); }
DEV float frsq(float x) { return __builtin_amdgcn_rsqf(x); }
DEV unsigned cvt_pk_bf16(float lo, float hi) { unsigned r; asm volatile("v_cvt_pk_bf16_f32 %0, %1, %2" : "=v"(r) : "v"(lo), "v"(hi)); return r; }
DEV unsigned cvt_pk_bf16_tr(float lo, float hi) { unsigned r; asm volatile("s_nop 0\n\tv_cvt_pk_bf16_f32 %0, %1, %2" : "=v"(r) : "v"(lo), "v"(hi)); return r; }
DEV f32x4 mfma8(v8i_t a, v8i_t b, f32x4 c, int sc) { asm volatile("v_mfma_scale_f32_16x16x128_f8f6f4 %0, %1, %2, %0, %3, %3 op_sel_hi:[0,0,0]" : "+v"(c) : "v"(a), "v"(b), "v"(sc)); return c; }
#define MFMA_DRAIN() asm volatile("s_nop 15\n\ts_nop 7" ::: "memory")
DEV unsigned pk_fp8x4(float a, float b, float c, float d) { int r = __builtin_amdgcn_cvt_pk_fp8_f32(a, b, 0, false); r = __builtin_amdgcn_cvt_pk_fp8_f32(c, d, r, true); return (unsigned)r; }
typedef short v4i16_t __attribute__((ext_vector_type(4)));
DEV bf16x4 lds_tr16(LAS unsigned char* p) { return __builtin_bit_cast(bf16x4, __builtin_amdgcn_ds_read_tr16_b64_v4i16((LAS v4i16_t*)p)); }
#define MIX_BAR() do { asm volatile("s_waitcnt lgkmcnt(0)" ::: "memory"); __builtin_amdgcn_s_barrier(); asm volatile("" ::: "memory"); } while (0)
DEV void glds16_asm(const void* gsrc, unsigned lds_dst) { unsigned keep;
    asm volatile("s_mov_b32 %0, m0\n\ts_mov_b32 m0, %2\n\ts_nop 0\n\tglobal_load_lds_dwordx4 %1, off\n\ts_mov_b32 m0, %0" : "=&s"(keep) : "v"(gsrc), "s"(lds_dst) : "memory"); }
#define GLDS16X(g, l) glds16_asm((const void*)(g), (unsigned)RFL((int)(unsigned)(__UINTPTR_TYPE__)(l)))
DEV void glds16_sbase(const void* sbase, unsigned voff, unsigned lds_dst) { unsigned keep;
    asm volatile("s_mov_b32 %0, m0\n\ts_mov_b32 m0, %3\n\ts_nop 0\n\tglobal_load_lds_dwordx4 %1, %2\n\ts_mov_b32 m0, %0" : "=&s"(keep) : "v"(voff), "s"(sbase), "s"(lds_dst) : "memory"); }
#define GLDS16S(sb, vo, l) glds16_sbase((const void*)(sb), (unsigned)(vo), (unsigned)RFL((int)(unsigned)(__UINTPTR_TYPE__)(l)))
typedef __amdgpu_buffer_rsrc_t rsrc_t;
DEV rsrc_t make_rsrc(const void* p, unsigned bytes) { return __builtin_amdgcn_make_buffer_rsrc((void*)p, (short)0, (int)bytes, 0x00020000); }
DEV unsigned short bload16(rsrc_t r, unsigned voff, unsigned soff) { return (unsigned short)__builtin_amdgcn_raw_buffer_load_b16(r, (int)voff, (int)soff, 0); }
DEV void bstore16(rsrc_t r, unsigned voff, unsigned soff, unsigned short v) { __builtin_amdgcn_raw_buffer_store_b16(v, r, (int)voff, (int)soff, 0); }
DEV void bstore64(rsrc_t r, unsigned voff, unsigned soff, u32x2_t v) { __builtin_amdgcn_raw_buffer_store_b64(v, r, (int)voff, (int)soff, 0); }
typedef unsigned u32x4_t __attribute__((ext_vector_type(4)));
DEV u32x4_t bload128(rsrc_t r, unsigned voff, unsigned soff) { return __builtin_amdgcn_raw_buffer_load_b128(r, (int)voff, (int)soff, 0); }
#else
#define LAS
#define GAS
#define DEV inline
#define LDS_RD(T, p) emu_lds_rd<T>((const void*)(p), #p)
#define LDS_WR(T, p, v) emu_lds_wr<T>((void*)(p), (T)(v), #p)
#define WAVE_SYNC() emu_wavesync()
#define BLOCK_BAR() emu_syncthreads()
#define RAW_BAR() emu_syncthreads()
#define WAIT_V(n)
#define WAIT_L(n)
#define SCHED_BAR()
#define SETPRIO(n)
#define GLDS16(g, l) emu_glds16((const void*)(g), (unsigned char*)(l))
#define GLDS16X(g, l) emu_glds16((const void*)(g), (unsigned char*)(l))
#define GLDS16S(sb, vo, l) emu_glds16((const void*)((const char*)(sb) + (vo)), (unsigned char*)(l))
#define MFMA16(a, b, c) emu_mfma16(a, b, c)
#define RFL(x) (x)
#define COMPILER_FENCE()
#define OPAQUE(x)
DEV float fexp2(float x) { return exp2f(x); }
DEV float flog2(float x) { return log2f(x); }
DEV float frcp(float x) { return 1.0f / x; }
DEV float frsq(float x) { return 1.0f / sqrtf(x); }
DEV unsigned cvt_pk_bf16(float lo, float hi) { return (unsigned)emu_f2bf(lo) | ((unsigned)emu_f2bf(hi) << 16); }
#define cvt_pk_bf16_tr cvt_pk_bf16
#define mfma8(a, b, c, sc) emu_mfma8(a, b, c)
#define MFMA_DRAIN()
DEV unsigned pk_fp8x4(float a, float b, float c, float d) { return (unsigned)emu_f2fp8(a) | ((unsigned)emu_f2fp8(b) << 8) | ((unsigned)emu_f2fp8(c) << 16) | ((unsigned)emu_f2fp8(d) << 24); }
#define lds_tr16(p) emu_lds_tr16((const unsigned char*)(p))
#define MIX_BAR() emu_syncthreads()
typedef unsigned char* rsrc_t;
DEV rsrc_t make_rsrc(const void* p, unsigned) { return (unsigned char*)p; }
DEV unsigned short bload16(rsrc_t r, unsigned voff, unsigned soff) { unsigned short v; memcpy(&v, r + (size_t)voff + soff, 2); return v; }
DEV void bstore16(rsrc_t r, unsigned voff, unsigned soff, unsigned short v) { memcpy(r + (size_t)voff + soff, &v, 2); }
DEV void bstore64(rsrc_t r, unsigned voff, unsigned soff, u32x2_t v) { memcpy(r + (size_t)voff + soff, &v, 8); }
typedef unsigned u32x4_t __attribute__((ext_vector_type(4)));
DEV u32x4_t bload128(rsrc_t r, unsigned voff, unsigned soff) { u32x4_t v; memcpy(&v, r + (size_t)voff + soff, 16); return v; }
#endif

typedef unsigned short bf16;
typedef unsigned u32x4 __attribute__((ext_vector_type(4)));
typedef unsigned u32x2 __attribute__((ext_vector_type(2)));
typedef float f32x2 __attribute__((ext_vector_type(2)));
typedef LAS unsigned char* ldsp;

#ifndef CFG_D
#define CFG_D 4096
#define CFG_B 4
#define CFG_S 4096
#define CFG_HB 8
#endif
constexpr int D = CFG_D, NB = CFG_B, SEQ = CFG_S, M = NB * SEQ;
constexpr int DA = D / 2, HA = DA / 128, DB = D / 2, HB = CFG_HB, DVB = DB / HB, DKB = 128, DQK = HB * DKB;
constexpr int NSG = 2 * HB;
constexpr int NCH = SEQ / 64;
static_assert(DVB == 256 && NSG <= 16 && SEQ % 64 == 0 && M % 256 == 0 && D % 256 == 0, "shape");
constexpr int C_QA = 0, C_FA = DA, C_IA = 2 * DA, C_OGA = 3 * DA, C_ZA = 4 * DA, C_QB = 5 * DA, C_KB = C_QB + DQK, C_VB = C_KB + DQK, C_OGB = C_VB + DB, C_ZB = C_OGB + DB;
constexpr int NPM = C_ZB + DB, C_GA = NPM, C_GB = NPM + D, NP = NPM + 2 * D, D_IN = NP + NSG;
static_assert(NPM % 256 == 0 && NP % 256 == 0, "column map");
constexpr float EPS = 1e-6f;
constexpr float H8_SCALE = 64.0f, W8_SCALE = 1024.0f, G8_DESCALE = 1.0f / (64.0f * 1024.0f);
constexpr float LOG2E = 1.4426950408889634f, LN2 = 0.6931471805599453f;
constexpr int NRS = D / 64;
constexpr int PT_PITCH = M / 64 + 1;
DEV size_t p_off(size_t row, int col) { return ((size_t)(col >> 7) * (size_t)PT_PITCH + (row >> 6)) * 8192 + (row & 63) * 128 + (size_t)(col & 127); }

constexpr size_t al256(size_t x) { return (x + 255) & ~(size_t)255; }
constexpr size_t WS_CTL = 0, CTL_ZERO_BYTES = 65536;
constexpr size_t WS_W1T = 1u << 20;
constexpr int LDU = DA + 64;
constexpr size_t WS_WUT = al256(WS_W1T + (size_t)(NP + 16) * D * 2);
constexpr size_t WS_WOT = al256(WS_WUT + (size_t)2 * D * LDU * 2);
constexpr size_t WS_HB = al256(WS_WOT + (size_t)D * D * 2);
constexpr size_t WS_P = al256(WS_HB + (size_t)M * D * 2);
constexpr size_t WS_SG = al256(WS_P + (size_t)(NP / 128) * (M / 64 + 1) * 16384 + 4096);
constexpr size_t WS_OAB = al256(WS_SG + (size_t)M * 16 * 4);
constexpr size_t WS_RSS = al256(WS_OAB + (size_t)2 * M * LDU * 2);
constexpr size_t WS_SSB = al256(WS_RSS + (size_t)M * NRS * 4);
constexpr size_t WS_SSA = al256(WS_SSB + (size_t)M * HB * 4 * 4);
constexpr size_t WS_H8 = al256(WS_SSA + (size_t)M * HA * 2 * 4);
constexpr size_t WS_W8 = al256(WS_H8 + (size_t)M * D);
constexpr size_t WS_END = al256(WS_W8 + (size_t)2 * D * D);
constexpr size_t WS_W8OG = WS_P + (size_t)(NPM / 128) * (M / 64 + 1) * 16384;
static_assert((size_t)(DA + DB) * D <= (size_t)(2 * D / 128) * (M / 64 + 1) * 16384, "out-gate weight copy fits the merge-gate tiles");
constexpr int CW_BAR = 1024;

constexpr int RING_BYTES = 154624, LDSCTL_OFF = RING_BYTES, MISC_OFF = LDSCTL_OFF + 320, LDS_BYTES = 155648;
constexpr int NWAVES = 8, NTHREADS = 512;

DEV unsigned f2bf(float f) { unsigned u = __builtin_bit_cast(unsigned, f); return (u + 0x7fffu + ((u >> 16) & 1u)) >> 16; }
DEV float bf2f(unsigned b) { return __builtin_bit_cast(float, b << 16); }
DEV unsigned pk2(float lo, float hi) { return f2bf(lo) | (f2bf(hi) << 16); }
DEV float fexp(float x) { return fexp2(x * LOG2E); }
DEV float flog(float x) { return flog2(x) * LN2; }
DEV float sigm(float x) { return frcp(1.0f + fexp(-x)); }
DEV float logsig(float x) { return fminf(x, 0.f) - flog(1.0f + fexp(-fabsf(x))); }
DEV float wave_sum(float v) {
#pragma unroll
    for (int o = 1; o < 64; o <<= 1) v += __shfl_xor(v, o);
    return v;
}

namespace pg8 {
constexpr int BM = 256, BK = 64, HALF = 128, HTB = HALF * BK * 2, STAGE_BYTES = 8 * HTB, NXCD = 8, WGM = 8;
DEV int lds_byte(int r, int c) { const int st = (r >> 4) * 2 + (c >> 5), rr = r & 15, cc = c & 31, ob = rr * 64 + cc * 2; return st * 1024 + (ob ^ (((ob >> 9) & 1) << 5)); }
DEV void stage_rc(int b, int& R, int& C) { const int st = b / 1024, sb = b % 1024, swz = sb ^ (((sb >> 9) & 1) << 5); R = (st >> 1) * 16 + swz / 64; C = (st & 1) * 32 + (swz % 64) / 2; }
DEV int perm32(int rho) { const int n = rho >> 4, i = rho & 15; return 8 * (i >> 2) + 4 * n + (i & 3); }
struct Unit { int pm, pn; };
struct Gemm { const bf16* A; const bf16* Bt; int M, N, K; int ld; size_t a2off, b2off; size_t bhalf; };
struct StaticOrder {
    int nM, nN, nwg, G, c;
    DEV void init(int M_, int N_, int G_, int c_) { nM = M_ / BM; nN = N_ / BM; nwg = nM * nN; G = G_; c = c_; }
    DEV bool next(int i, Unit& u) const {
        const long L = (long)i * G + c; if (L >= nwg) return false;
        int wgid = (int)L; { const int q = nwg / NXCD, r = nwg % NXCD, xcd = wgid % NXCD, off = wgid / NXCD; wgid = (xcd < r ? xcd * (q + 1) : r * (q + 1) + (xcd - r) * q) + off; }
        const int nig = WGM * nN, gid = wgid / nig, fm = gid * WGM, gsz = (nM - fm) < WGM ? (nM - fm) : WGM;
        u.pm = fm + ((wgid % nig) % gsz); u.pn = (wgid % nig) / gsz; return true;
    }
};
template <class Epi, class Sched, bool ALIGN_EPI = false, bool SP2 = false, int ESZ = 2, bool SPLITK = false>
DEV void gemm_phase(ldsp lds, const Gemm g, const Sched& S, const Epi& E) {
    const int tid = threadIdx.x, wid = RFL(tid >> 6), lane = tid & 63, wr = wid >> 2, wc = wid & 3, fr = lane & 15, fq = lane >> 4;
    const int nt = (g.K * ESZ / 2) / BK, K = (g.ld ? g.ld : g.K) * ESZ / 2;
    unsigned voffA[2], voffB[2];
#pragma unroll
    for (int i = 0; i < 2; ++i) { int R, C; stage_rc(tid * 16 + i * 8192, R, C); const int Rb = Epi::PERM ? ((R & ~31) + perm32(R & 31)) : R;
        voffA[i] = (unsigned)(R * K + C) * 2u; voffB[i] = (unsigned)(Rb * K + C) * 2u; }
    const size_t kstep = (size_t)(BK * 2);
    const size_t hstep = (size_t)HALF * K * 2;
    const size_t tstep = 2 * hstep;
    const size_t bhstep = g.bhalf ? g.bhalf : hstep, btstep = g.bhalf ? hstep : tstep;
    const unsigned ldsw = (unsigned)wid * 1024u;
    int aoffk[2], boffk[2];
#pragma unroll
    for (int k = 0; k < 2; ++k) { const int ch = fq + 4 * k;
        aoffk[k] = lds_byte(wr * 64 + fr, (ch & 3) * 8) + (ch >> 2) * 1024; boffk[k] = lds_byte(wc * 32 + fr, (ch & 3) * 8) + (ch >> 2) * 1024; }
#define PG8_SA(b, h) (((b) * 2 + (h)) * HTB)
#define PG8_SB(b, h) ((4 + (b) * 2 + (h)) * HTB)
#define PG8_STAGE(bufoff, gbase, voff) do { _Pragma("unroll") for (int _i = 0; _i < 2; ++_i) \
        GLDS16((const char*)(gbase) + (voff)[_i], lds + (bufoff) + ldsw + _i * 8192); } while (0)
#define PG8_LDA(dst, b, h) do { _Pragma("unroll") for (int m = 0; m < 4; ++m) { if constexpr (ESZ == 2) { _Pragma("unroll") for (int k = 0; k < 2; ++k) dst[m][k] = *(const LAS bf16x8*)(lds + PG8_SA(b, h) + aoffk[k] + m * 2048); } \
        else dst##8[m] = __builtin_shufflevector(*(const LAS v4i_t*)(lds + PG8_SA(b, h) + aoffk[0] + m * 2048), *(const LAS v4i_t*)(lds + PG8_SA(b, h) + aoffk[1] + m * 2048), 0, 1, 2, 3, 4, 5, 6, 7); } } while (0)
#define PG8_LDB(dst, b, h) do { _Pragma("unroll") for (int n = 0; n < 2; ++n) { if constexpr (ESZ == 2) { _Pragma("unroll") for (int k = 0; k < 2; ++k) dst[n][k] = *(const LAS bf16x8*)(lds + PG8_SB(b, h) + boffk[k] + n * 2048); } \
        else dst##8[n] = __builtin_shufflevector(*(const LAS v4i_t*)(lds + PG8_SB(b, h) + boffk[0] + n * 2048), *(const LAS v4i_t*)(lds + PG8_SB(b, h) + boffk[1] + n * 2048), 0, 1, 2, 3, 4, 5, 6, 7); } } while (0)
#define PG8_MMA(ai, bj, At, Bt) do { SETPRIO(1); _Pragma("unroll") for (int m = 0; m < 4; ++m) _Pragma("unroll") for (int n = 0; n < 2; ++n) { \
        if constexpr (ESZ == 2) { _Pragma("unroll") for (int k = 0; k < 2; ++k) acc[ai][bj][m][n] = MFMA16(Bt[n][k], At[m][k], acc[ai][bj][m][n]); } \
        else acc[ai][bj][m][n] = mfma8(Bt##8[n], At##8[m], acc[ai][bj][m][n], sc8); } SETPRIO(0); } while (0)
    int sc8 = 0x7f7f7f7f; OPAQUE(sc8);
    Unit cur, nxt; int ui = 0;
    if (!S.next(0, cur)) return;
    f32x4 acc[2][2][4][2];
#pragma unroll
    for (int a = 0; a < 2; ++a)
#pragma unroll
        for (int b = 0; b < 2; ++b)
#pragma unroll
            for (int m = 0; m < 4; ++m)
#pragma unroll
                for (int n = 0; n < 2; ++n) acc[a][b][m][n] = (f32x4){0.f, 0.f, 0.f, 0.f};
    bf16x8 At[ESZ == 2 ? 4 : 1][2], B0[ESZ == 2 ? 2 : 1][2], B1[ESZ == 2 ? 2 : 1][2];
    v8i_t At8[ESZ == 1 ? 4 : 1], B08[ESZ == 1 ? 2 : 1], B18[ESZ == 1 ? 2 : 1];
    const char* cA = (const char*)g.A + (size_t)cur.pm * tstep; const char* cB = (const char*)g.Bt + (size_t)cur.pn * btstep;
    if constexpr (SP2) {
        PG8_STAGE(PG8_SB(0, 0), cB, voffB); PG8_STAGE(PG8_SB(0, 1), cB + bhstep, voffB); PG8_STAGE(PG8_SA(0, 0), cA, voffA); PG8_STAGE(PG8_SA(0, 1), cA + hstep, voffA);
        if (wr == 1) RAW_BAR();
        WAIT_V(2); RAW_BAR();
        PG8_STAGE(PG8_SB(1, 0), cB + kstep, voffB); PG8_STAGE(PG8_SA(1, 0), cA + kstep, voffA); PG8_STAGE(PG8_SB(1, 1), cB + bhstep + kstep, voffB);
        WAIT_V(6); RAW_BAR();
    } else {
        PG8_STAGE(PG8_SB(0, 0), cB, voffB); PG8_STAGE(PG8_SA(0, 0), cA, voffA); PG8_STAGE(PG8_SB(0, 1), cB + hstep, voffB); PG8_STAGE(PG8_SA(0, 1), cA + hstep, voffA);
        if (wr == 1) RAW_BAR();
        WAIT_V(4); RAW_BAR();
        PG8_STAGE(PG8_SB(1, 0), cB + kstep, voffB); PG8_STAGE(PG8_SA(1, 0), cA + kstep, voffA); PG8_STAGE(PG8_SB(1, 1), cB + hstep + kstep, voffB);
        WAIT_V(6); RAW_BAR();
    }
    for (;;) {
        const bool has_next = S.next(ui + 1, nxt);
        const char* nA = has_next ? (const char*)g.A + (size_t)nxt.pm * tstep : cA; const char* nB = has_next ? (const char*)g.Bt + (size_t)nxt.pn * btstep : cB;
        for (int t = 0; t < nt; t += 2) {
            const bool last = (t == nt - 2);
            const size_t h1 = (SPLITK && t >= nt / 2) ? 1 : 0, h2 = (SPLITK && t + 2 >= nt / 2) ? 1 : 0;
            const char* a1 = cA + (size_t)(t + 1) * kstep + h1 * (g.a2off - (size_t)(nt / 2) * kstep);
            const char* a2 = last ? nA : cA + (size_t)(t + 2) * kstep + h2 * (g.a2off - (size_t)(nt / 2) * kstep); const char* b2 = last ? nB : cB + (size_t)(t + 2) * kstep + h2 * (g.b2off - (size_t)(nt / 2) * kstep);
            const char* a3 = a2 + kstep; const char* b3 = b2 + kstep;
            if constexpr (SPLITK) { if (t == nt / 2) {
                if constexpr (ALIGN_EPI) { if (wr == 0) RAW_BAR(); }
                int fr_ = fr; OPAQUE(fr_); E.mid(acc, cur, wr, wc, fr_, fq);
                if constexpr (ALIGN_EPI) { if (wr == 1) RAW_BAR(); } } }
            if constexpr (SP2) {
            PG8_LDB(B0, 0, 0); PG8_LDB(B1, 0, 1); SCHED_BAR(); PG8_LDA(At, 0, 0); PG8_STAGE(PG8_SA(1, 1), a1 + hstep, voffA);
            WAIT_V(8); WAIT_L(0); RAW_BAR(); PG8_MMA(0, 0, At, B0); PG8_MMA(0, 1, At, B1); RAW_BAR(); SCHED_BAR();
            PG8_LDA(At, 0, 1); PG8_STAGE(PG8_SB(0, 0), b2, voffB); PG8_STAGE(PG8_SB(0, 1), b2 + bhstep, voffB); PG8_STAGE(PG8_SA(0, 0), a2, voffA);
            WAIT_V(8); WAIT_L(0); RAW_BAR(); PG8_MMA(1, 0, At, B0); PG8_MMA(1, 1, At, B1); RAW_BAR(); SCHED_BAR();
            PG8_LDB(B0, 1, 0); PG8_LDB(B1, 1, 1); SCHED_BAR(); PG8_LDA(At, 1, 0); PG8_STAGE(PG8_SA(0, 1), a2 + hstep, voffA);
            WAIT_V(8); WAIT_L(0); RAW_BAR(); PG8_MMA(0, 0, At, B0); PG8_MMA(0, 1, At, B1); RAW_BAR(); SCHED_BAR();
            PG8_LDA(At, 1, 1); PG8_STAGE(PG8_SB(1, 0), b3, voffB); PG8_STAGE(PG8_SB(1, 1), b3 + bhstep, voffB); PG8_STAGE(PG8_SA(1, 0), a3, voffA);
            WAIT_V(8); WAIT_L(0); RAW_BAR(); PG8_MMA(1, 0, At, B0); PG8_MMA(1, 1, At, B1); RAW_BAR(); SCHED_BAR();
            } else {
            PG8_LDB(B0, 0, 0); SCHED_BAR(); PG8_LDA(At, 0, 0); PG8_STAGE(PG8_SA(1, 1), a1 + hstep, voffA);
            WAIT_L(8); RAW_BAR(); WAIT_L(0); PG8_MMA(0, 0, At, B0); RAW_BAR(); SCHED_BAR();
            PG8_LDB(B1, 0, 1); PG8_STAGE(PG8_SB(0, 0), b2, voffB);
            RAW_BAR(); WAIT_L(0); PG8_MMA(0, 1, At, B1); RAW_BAR();
            PG8_LDA(At, 0, 1); PG8_STAGE(PG8_SA(0, 0), a2, voffA);
            RAW_BAR(); WAIT_L(0); PG8_MMA(1, 0, At, B0); RAW_BAR(); SCHED_BAR();
            PG8_STAGE(PG8_SB(0, 1), b2 + hstep, voffB);
            WAIT_V(6); RAW_BAR(); PG8_MMA(1, 1, At, B1); RAW_BAR();
            PG8_LDB(B0, 1, 0); SCHED_BAR(); PG8_LDA(At, 1, 0); PG8_STAGE(PG8_SA(0, 1), a2 + hstep, voffA);
            WAIT_L(8); RAW_BAR(); WAIT_L(0); PG8_MMA(0, 0, At, B0); RAW_BAR(); SCHED_BAR();
            PG8_LDB(B1, 1, 1); PG8_STAGE(PG8_SB(1, 0), b3, voffB);
            RAW_BAR(); WAIT_L(0); PG8_MMA(0, 1, At, B1); RAW_BAR();
            PG8_LDA(At, 1, 1); PG8_STAGE(PG8_SA(1, 0), a3, voffA);
            RAW_BAR(); WAIT_L(0); PG8_MMA(1, 0, At, B0); RAW_BAR(); SCHED_BAR();
            PG8_STAGE(PG8_SB(1, 1), b3 + hstep, voffB);
            WAIT_V(6); RAW_BAR(); PG8_MMA(1, 1, At, B1); RAW_BAR();
            }
        }
        if constexpr (ALIGN_EPI) { if (wr == 0) RAW_BAR(); }
        if constexpr (ESZ == 1) { MFMA_DRAIN();
#pragma unroll
            for (int a = 0; a < 2; ++a)
#pragma unroll
                for (int b = 0; b < 2; ++b) asm volatile("" : "+v"(acc[a][b][0][0]), "+v"(acc[a][b][0][1]), "+v"(acc[a][b][1][0]), "+v"(acc[a][b][1][1]), "+v"(acc[a][b][2][0]), "+v"(acc[a][b][2][1]), "+v"(acc[a][b][3][0]), "+v"(acc[a][b][3][1])); }
        E(acc, cur, wr, wc, fr, fq);
        if (!has_next) break;
#pragma unroll
        for (int a = 0; a < 2; ++a)
#pragma unroll
            for (int b = 0; b < 2; ++b)
#pragma unroll
                for (int m = 0; m < 4; ++m)
#pragma unroll
                    for (int n = 0; n < 2; ++n) acc[a][b][m][n] = (f32x4){0.f, 0.f, 0.f, 0.f};
        cur = nxt; cA = nA; cB = nB; ++ui;
        if constexpr (ALIGN_EPI) { if (wr == 1) RAW_BAR(); }
    }
    WAIT_V(0);
    if constexpr (!ALIGN_EPI) { if (wr == 0) RAW_BAR(); }
    RAW_BAR();
#undef PG8_SA
#undef PG8_SB
#undef PG8_STAGE
#undef PG8_LDA
#undef PG8_LDB
#undef PG8_MMA
}
}

struct EpiP {
    static constexpr bool PERM = true;
    bf16* O;
    DEV void operator()(const f32x4 (&acc)[2][2][4][2], const pg8::Unit& u, int wr, int wc, int fr, int fq) const {
        const int row0 = u.pm * 256 + wr * 64 + fr, col0 = u.pn * 256 + wc * 32 + 8 * fq;
#pragma unroll
        for (int ai = 0; ai < 2; ++ai)
#pragma unroll
            for (int m = 0; m < 4; ++m) { const size_t row = (size_t)(row0 + ai * 128 + m * 16);
#pragma unroll
                for (int bj = 0; bj < 2; ++bj) { const f32x4 v0 = acc[ai][bj][m][0], v1 = acc[ai][bj][m][1];
                    u32x4 w; w.x = cvt_pk_bf16(v0[0], v0[1]); w.y = cvt_pk_bf16(v0[2], v0[3]); w.z = cvt_pk_bf16(v1[0], v1[1]); w.w = cvt_pk_bf16(v1[2], v1[3]);
                    *(u32x4*)(O + p_off(row, col0 + bj * 128)) = w; } }
    }
};
constexpr float G8_EXPSCALE = -LOG2E * G8_DESCALE;
struct EpiP8 {
    static constexpr bool PERM = true;
    bf16* O;
    DEV void operator()(const f32x4 (&acc)[2][2][4][2], const pg8::Unit& u, int wr, int wc, int fr, int fq) const {
        const int row0 = u.pm * 256 + wr * 64 + fr, col0 = u.pn * 128 + wc * 32 + 8 * fq;
#pragma unroll
        for (int ai = 0; ai < 2; ++ai)
#pragma unroll
            for (int m = 0; m < 4; ++m) { const size_t row = (size_t)(row0 + ai * 128 + m * 16);
                const f32x4 a0 = acc[ai][0][m][0] * G8_EXPSCALE, a1 = acc[ai][0][m][1] * G8_EXPSCALE, b0 = acc[ai][1][m][0] * G8_EXPSCALE, b1 = acc[ai][1][m][1] * G8_EXPSCALE; float rho[8], sb[8];
#pragma unroll
                for (int k = 0; k < 8; ++k) { const float eb1 = 1.0f + fexp2(k < 4 ? b0[k & 3] : b1[k & 3]), ea1 = 1.0f + fexp2(k < 4 ? a0[k & 3] : a1[k & 3]); sb[k] = frcp(eb1); rho[k] = eb1 * frcp(ea1); }
                u32x4 w; w.x = cvt_pk_bf16(rho[0], rho[1]); w.y = cvt_pk_bf16(rho[2], rho[3]); w.z = cvt_pk_bf16(rho[4], rho[5]); w.w = cvt_pk_bf16(rho[6], rho[7]);
                *(u32x4*)(O + p_off(row, C_GA + col0)) = w;
                w.x = cvt_pk_bf16_tr(sb[0], sb[1]); w.y = cvt_pk_bf16_tr(sb[2], sb[3]); w.z = cvt_pk_bf16_tr(sb[4], sb[5]); w.w = cvt_pk_bf16_tr(sb[6], sb[7]);
                *(u32x4*)(O + p_off(row, C_GB + col0)) = w; }
    }
};
struct SchedUp {
    pg8::StaticOrder so;
    DEV bool next(int i, pg8::Unit& u) const { if (!so.next(i >> 1, u)) return false; if (i & 1) { u.pm += M / 256; u.pn += D / 256; } return true; }
};
struct EpiUp {
    static constexpr bool PERM = true;
    bf16* Y; const bf16* P;
    DEV void operator()(const f32x4 (&acc)[2][2][4][2], const pg8::Unit& u, int wr, int wc, int fr, int fq) const {
        const int br = u.pm >= M / 256 ? 1 : 0, pm = u.pm - br * (M / 256), pn = u.pn - br * (D / 256);
        const int row0 = pm * 256 + wr * 64 + fr, col0 = pn * 256 + wc * 32 + 8 * fq, gcol = (br ? C_GB : C_GA) + col0;
#pragma unroll
        for (int ai = 0; ai < 2; ++ai)
#pragma unroll
            for (int m = 0; m < 4; ++m) { const size_t row = (size_t)(row0 + ai * 128 + m * 16);
#pragma unroll
                for (int bj = 0; bj < 2; ++bj) {
                    const u32x4 g8 = *(const u32x4*)(P + p_off(row, gcol + bj * 128));
                    bf16* yp = Y + row * D + col0 + bj * 128;
                    u32x4 y8 = (u32x4){0u, 0u, 0u, 0u}; if (br) y8 = *(const u32x4*)yp;
                    const f32x4 v0 = acc[ai][bj][m][0], v1 = acc[ai][bj][m][1];
                    float o[8];
#pragma unroll
                    for (int k = 0; k < 8; ++k) { const unsigned gw = g8[k >> 1], yw = y8[k >> 1]; const float gv = bf2f((k & 1) ? (gw >> 16) : (gw & 0xffffu)), yv = bf2f((k & 1) ? (yw >> 16) : (yw & 0xffffu));
                        const float a = k < 4 ? v0[k & 3] : v1[k & 3]; o[k] = yv + sigm(gv) * a; }
                    u32x4 w; w.x = cvt_pk_bf16(o[0], o[1]); w.y = cvt_pk_bf16(o[2], o[3]); w.z = cvt_pk_bf16(o[4], o[5]); w.w = cvt_pk_bf16(o[6], o[7]);
                    *(u32x4*)yp = w; } }
    }
};
struct SchedSkipOg { pg8::StaticOrder so; DEV bool next(int i, pg8::Unit& u) const { if (!so.next(i, u)) return false; if (u.pn >= C_OGA / 256) u.pn += DA / 256; if (u.pn >= C_OGB / 256) u.pn += DB / 256; return true; } };
static_assert(C_OGA % 256 == 0 && C_OGB % 256 == 0 && DA % 256 == 0 && DB % 256 == 0 && C_OGA < C_OGB, "out-gate column tiles");
struct EpiOg {
    static constexpr bool PERM = true;
    bf16* O;
    DEV void operator()(const f32x4 (&acc)[2][2][4][2], const pg8::Unit& u, int wr, int wc, int fr, int fq) const {
        const int cb = u.pn < DA / 256 ? C_OGA + u.pn * 256 : C_OGB + (u.pn - DA / 256) * 256;
        const int row0 = u.pm * 256 + wr * 64 + fr, col0 = cb + wc * 32 + 8 * fq;
#pragma unroll
        for (int ai = 0; ai < 2; ++ai)
#pragma unroll
            for (int m = 0; m < 4; ++m) { const size_t row = (size_t)(row0 + ai * 128 + m * 16);
#pragma unroll
                for (int bj = 0; bj < 2; ++bj) { const f32x4 v0 = acc[ai][bj][m][0] * G8_DESCALE, v1 = acc[ai][bj][m][1] * G8_DESCALE;
                    u32x4 w; w.x = cvt_pk_bf16(v0[0], v0[1]); w.y = cvt_pk_bf16(v0[2], v0[3]); w.z = cvt_pk_bf16(v1[0], v1[1]); w.w = cvt_pk_bf16(v1[2], v1[3]);
                    *(u32x4*)(O + p_off(row, col0 + bj * 128)) = w; } }
    }
};
struct SchedGate { pg8::StaticOrder so; DEV bool next(int i, pg8::Unit& u) const { if (!so.next(i >> 1, u)) return false; u.pn = 2 * u.pn + (i & 1); return true; } };
struct SchedRev { pg8::StaticOrder so; int n; DEV void init(int M_, int N_, int G_, int c_) { so.init(M_, N_, G_, c_); n = so.nwg > c_ ? (so.nwg - c_ + G_ - 1) / G_ : 0; }
    DEV bool next(int i, pg8::Unit& u) const { return i < n && so.next(n - 1 - i, u); } };
constexpr unsigned P_BYTES = (unsigned)((size_t)(NP / 128) * PT_PITCH * 16384);
DEV unsigned p_soff(int pm, int cb, int ai, int m, int wr, int wc) { return (unsigned)((cb * PT_PITCH + 4 * pm + 2 * ai + wr) * 16384 + m * 4096 + wc * 64); }
constexpr unsigned GB_MINUS_GA = (unsigned)((D / 128) * PT_PITCH) * 16384u;
struct EpiUp2 {
    static constexpr bool PERM = true;
    bf16* Y; rsrc_t rs;
    DEV void mid(f32x4 (&acc)[2][2][4][2], const pg8::Unit& u, int wr, int wc, int fr, int fq) const {
        const unsigned voff = (unsigned)(fr * 256 + fq * 16); u32x4 r[16];
#pragma unroll
        for (int s_ = 0; s_ < 16; ++s_) r[s_] = bload128(rs, voff, p_soff(u.pm, NPM / 128 + 2 * u.pn + (s_ & 1), s_ >> 3, (s_ >> 1) & 3, wr, wc));
        SCHED_BAR();
#pragma unroll
        for (int s_ = 0; s_ < 16; ++s_) { const int ai = s_ >> 3, m = (s_ >> 1) & 3, bj = s_ & 1;
#pragma unroll
            for (int k = 0; k < 8; ++k) { const unsigned w = r[s_][k >> 1]; const float f = __builtin_bit_cast(float, (k & 1) ? (w & 0xffff0000u) : (w << 16));
                if (k < 4) acc[ai][bj][m][0][k & 3] *= f; else acc[ai][bj][m][1][k & 3] *= f; } }
    }
    DEV void operator()(const f32x4 (&acc)[2][2][4][2], const pg8::Unit& u, int wr, int wc, int fr, int fq) const {
        const int row0 = u.pm * 256 + wr * 64 + fr, col0 = u.pn * 256 + wc * 32 + 8 * fq; const unsigned voff = (unsigned)(fr * 256 + fq * 16); u32x4 sbv[16];
#pragma unroll
        for (int s_ = 0; s_ < 16; ++s_) sbv[s_] = bload128(rs, voff, p_soff(u.pm, NPM / 128 + 2 * u.pn + (s_ & 1), s_ >> 3, (s_ >> 1) & 3, wr, wc) + GB_MINUS_GA);
        SCHED_BAR();
#pragma unroll
        for (int s_ = 0; s_ < 16; ++s_) { const int ai = s_ >> 3, m = (s_ >> 1) & 3, bj = s_ & 1; const size_t row = (size_t)(row0 + ai * 128 + m * 16);
            const f32x4 v0 = acc[ai][bj][m][0], v1 = acc[ai][bj][m][1]; float o[8];
#pragma unroll
            for (int k = 0; k < 8; ++k) { const unsigned w = sbv[s_][k >> 1]; o[k] = (k < 4 ? v0[k & 3] : v1[k & 3]) * __builtin_bit_cast(float, (k & 1) ? (w & 0xffff0000u) : (w << 16)); }
            u32x4 w; w.x = cvt_pk_bf16(o[0], o[1]); w.y = cvt_pk_bf16(o[2], o[3]); w.z = cvt_pk_bf16(o[4], o[5]); w.w = cvt_pk_bf16(o[6], o[7]);
            *(u32x4*)(Y + row * D + col0 + bj * 128) = w; }
    }
};
struct EpiOut {
    static constexpr bool PERM = true;
    bf16* C; float* RSS;
    DEV void operator()(const f32x4 (&acc)[2][2][4][2], const pg8::Unit& u, int wr, int wc, int fr, int fq) const {
        const int row0 = u.pm * 256 + wr * 64 + fr, col0 = u.pn * 256 + wc * 32 + 8 * fq;
#pragma unroll
        for (int ai = 0; ai < 2; ++ai)
#pragma unroll
            for (int m = 0; m < 4; ++m) { const size_t row = (size_t)(row0 + ai * 128 + m * 16); bf16* rowp = C + row * D + col0; float ss = 0.f;
#pragma unroll
                for (int bj = 0; bj < 2; ++bj) { const f32x4 v0 = acc[ai][bj][m][0], v1 = acc[ai][bj][m][1];
                    ss += ((v0[0] * v0[0] + v0[1] * v0[1]) + (v0[2] * v0[2] + v0[3] * v0[3])) + ((v1[0] * v1[0] + v1[1] * v1[1]) + (v1[2] * v1[2] + v1[3] * v1[3]));
                    u32x4 w; w.x = cvt_pk_bf16(v0[0], v0[1]); w.y = cvt_pk_bf16(v0[2], v0[3]); w.z = cvt_pk_bf16(v1[0], v1[1]); w.w = cvt_pk_bf16(v1[2], v1[3]);
                    *(u32x4*)(rowp + bj * 128) = w; }
                ss += __shfl_xor(ss, 16); ss += __shfl_xor(ss, 32);
                if (fq == 0) RSS[row * NRS + u.pn * 4 + wc] = ss; }
    }
};

#ifndef EMU
typedef GAS unsigned gu32;
#define RLX_AGENT __ATOMIC_RELAXED, __HIP_MEMORY_SCOPE_AGENT
#define XB_TMO      128
#define XB_XCNT(j)  (256  + 64 * (j))
#define XB_XSUB(j)  (1280 + 64 * (j))
#define XB_XGEN(j)  (2304 + 64 * (j))
#define XB_TOP      3328
#define XB_TOPGEN   3392
#define XCD_BAR_WORDS 3456
#define XB_SPIN_CAP (1u << 22)
__device__ __forceinline__ unsigned xb_ld(unsigned* p)              { return __hip_atomic_load(p, __ATOMIC_RELAXED, __HIP_MEMORY_SCOPE_AGENT); }
__device__ __forceinline__ unsigned xb_add(unsigned* p, unsigned v) { return __hip_atomic_fetch_add(p, v, __ATOMIC_RELAXED, __HIP_MEMORY_SCOPE_AGENT); }
__device__ __forceinline__ unsigned xb_xcc_id() { return (unsigned)__builtin_amdgcn_s_getreg((3 << 11) | 20) & 0xFu; }
#define XB_SPIN(cond, bar) do { unsigned _sp = 0; while (cond) { __builtin_amdgcn_s_sleep(1); \
    if ((++_sp & 255u) == 0u) { if (xb_ld(&(bar)[XB_TMO])) break; if (_sp > XB_SPIN_CAP) { atomicAdd(&(bar)[XB_TMO], 1u); break; } } } } while (0)
struct XcdBarrier { unsigned* bar; unsigned x; volatile LAS unsigned* st; };
__device__ __forceinline__ XcdBarrier xcd_barrier_post(unsigned* bar, volatile LAS unsigned* st) {
    XcdBarrier b; b.bar = bar; b.x = xb_xcc_id(); b.st = st;
    if (threadIdx.x == 0) (void)xb_add(&bar[XB_XCNT(b.x)], 1u);
    return b;
}
__device__ __forceinline__ void xcd_barrier_complete(unsigned* bar, unsigned x, unsigned& nloc, unsigned& nx) {
    const unsigned G = gridDim.x * gridDim.y * gridDim.z;
    unsigned sum, cnt, mine, sp = 0u;
    for (;;) {
        sum = 0u; cnt = 0u; mine = 0u;
#pragma unroll
        for (unsigned j = 0; j < 16; ++j) { const unsigned c = xb_ld(&bar[XB_XCNT(j)]); sum += c; cnt += (c > 0u) ? 1u : 0u; mine = (j == x) ? c : mine; }
        if (sum == G) break;
        __builtin_amdgcn_s_sleep(1);
        if ((++sp & 255u) == 0u) { if (xb_ld(&bar[XB_TMO])) break; if (sp > XB_SPIN_CAP) { atomicAdd(&bar[XB_TMO], 1u); break; } }
    }
    nloc = mine > 0u ? mine : 1u; nx = cnt > 0u ? cnt : 1u;
}
__device__ __forceinline__ void xcd_barrier(const XcdBarrier& b) {
    asm volatile("s_waitcnt vmcnt(0)" ::: "memory");
    __syncthreads();
    if (threadIdx.x == 0) {
        unsigned* bar = b.bar;
        __builtin_amdgcn_s_waitcnt(0);
        unsigned nloc = b.st[0], nx = b.st[1];
        if (nloc == 0u) { xcd_barrier_complete(bar, b.x, nloc, nx); b.st[0] = nloc; b.st[1] = nx; }
        const unsigned old = xb_add(&bar[XB_XSUB(b.x)], 1u);
        const unsigned gen = old / nloc;
        if (old + 1u == (gen + 1u) * nloc) {
            __builtin_amdgcn_fence(__ATOMIC_RELEASE, "agent");
            asm volatile("s_waitcnt vmcnt(0)" ::: "memory");
            const unsigned og = xb_add(&bar[XB_TOP], 1u);
            const unsigned tg = og / nx;
            if (og + 1u == (tg + 1u) * nx) xb_add(&bar[XB_TOPGEN], 1u);
            else XB_SPIN(xb_ld(&bar[XB_TOPGEN]) == tg, bar);
            __builtin_amdgcn_fence(__ATOMIC_ACQUIRE, "agent");
            xb_add(&bar[XB_XGEN(b.x)], 1u);
            asm volatile("s_waitcnt vmcnt(0)" ::: "memory");
        } else {
            XB_SPIN(xb_ld(&bar[XB_XGEN(b.x)]) == gen, bar);
            __builtin_amdgcn_fence(__ATOMIC_ACQUIRE, "agent");
            asm volatile("s_waitcnt vmcnt(0)" ::: "memory");
        }
    }
    __syncthreads();
}
#endif

struct Args { const float* in[14]; float* out; unsigned char* ws; int ph_lo, ph_hi; };

DEV float clamp8(float x) { return fminf(fmaxf(x, -448.0f), 448.0f); }
struct P0Desc { const float* W; void* WT; int ldw, K, k0, c0, r0, nv, fp8; void* WT8; int r08; };
DEV void p0_load(const P0Desc& d, int lane, f32x4 (&v)[16]) {
    const int kr = lane >> 4, n4 = 4 * (lane & 15);
#pragma unroll
    for (int i = 0; i < 16; ++i) v[i] = (n4 < d.nv) ? *(const f32x4*)(d.W + (size_t)(d.k0 + 4 * i + kr) * d.ldw + d.c0 + n4) : (f32x4){0.f, 0.f, 0.f, 0.f};
}
DEV void p0_store(const P0Desc& d, const f32x4 (&v)[16], ldsp scr, int lane) {
    const int kr = lane >> 4, n4 = 4 * (lane & 15);
#pragma unroll
    for (int i = 0; i < 16; ++i) LDS_WR(f32x4, scr + ((4 * i + kr) * 68 + n4) * 4, v[i]);
    WAVE_SYNC();
    if (d.fp8 != 1) {
        bf16* WT = (bf16*)d.WT;
        const int c = lane & 7;
#pragma unroll
        for (int j = 0; j < 8; ++j) { const int n = (lane >> 3) + 8 * j; ldsp sp = scr + ((8 * c) * 68 + n) * 4;
            u32x4 o; o.x = pk2(LDS_RD(float, sp + 0 * 272), LDS_RD(float, sp + 1 * 272)); o.y = pk2(LDS_RD(float, sp + 2 * 272), LDS_RD(float, sp + 3 * 272));
            o.z = pk2(LDS_RD(float, sp + 4 * 272), LDS_RD(float, sp + 5 * 272)); o.w = pk2(LDS_RD(float, sp + 6 * 272), LDS_RD(float, sp + 7 * 272));
            if (n < d.nv) *(u32x4*)(WT + (size_t)(d.r0 + n) * d.K + d.k0 + 8 * c) = o; }
    }
    if (d.fp8 != 0) {
        unsigned char* WT = (unsigned char*)(d.fp8 == 2 ? d.WT8 : d.WT); const int r8 = d.fp8 == 2 ? d.r08 : d.r0, K8 = d.fp8 == 2 ? D : d.K;
        const int c = lane & 3;
#pragma unroll
        for (int j = 0; j < 4; ++j) { const int n = (lane >> 2) + 16 * j; ldsp sp = scr + ((16 * c) * 68 + n) * 4; float f[16];
#pragma unroll
            for (int i = 0; i < 16; ++i) f[i] = clamp8(LDS_RD(float, sp + i * 272) * W8_SCALE);
            u32x4 o; o.x = pk_fp8x4(f[0], f[1], f[2], f[3]); o.y = pk_fp8x4(f[4], f[5], f[6], f[7]); o.z = pk_fp8x4(f[8], f[9], f[10], f[11]); o.w = pk_fp8x4(f[12], f[13], f[14], f[15]);
            if (n < d.nv) *(u32x4*)(WT + (size_t)(r8 + n) * K8 + d.k0 + 16 * c) = o; }
    }
    WAVE_SYNC();
}

constexpr int MS = 272, MS64 = 144;
constexpr int NUA = NB * HA * NCH, NUB = NB * HB * NCH;
constexpr size_t TW_QA = 0, TW_KA = TW_QA + (size_t)NUA * 16384, TW_PA = TW_KA + (size_t)NUA * 16384, TW_VA = TW_PA + (size_t)NUA * 8192, TW_ENDA = TW_VA + (size_t)NUA * 2048;
constexpr size_t TW_QB = 0, TW_KB = TW_QB + (size_t)NUB * 16384, TW_PB = TW_KB + (size_t)NUB * 16384, TW_SB = TW_PB + (size_t)NUB * 8192, TW_ENDB = TW_SB + (size_t)NUB * 2048;
static_assert(TW_ENDA <= (size_t)(NP + 16) * D * 2 && TW_ENDB <= (size_t)M * D * 2, "operand tiles must fit the dead W1T / h regions");
DEV int swz(int row, int chunk) { return row * 256 + ((chunk ^ (row & 15)) << 4); }
DEV int swz64(int row, int chunk) { return row * 128 + ((chunk ^ (row & 7)) << 4); }
DEV bf16x8 frag16p(ldsp img, int row0, int ks, int lane) { return LDS_RD(bf16x8, img + swz64(row0 + (lane & 15), 4 * ks + (lane >> 4))); }

DEV bf16x8 frag16(ldsp buf, int stride, int row0, int ks, int lane) { return LDS_RD(bf16x8, buf + (row0 + (lane & 15)) * stride + ks * 64 + (lane >> 4) * 16); }
DEV bf16x8 frag16s(ldsp img, int row0, int ks, int lane) { return LDS_RD(bf16x8, img + swz(row0 + (lane & 15), 4 * ks + (lane >> 4))); }
DEV bf16x8 frag8x2s(ldsp img, int row0, int ks, int lane) {
    const int row = row0 + (lane & 15), q = lane >> 4;
    const bf16x4 lo = LDS_RD(bf16x4, img + swz(row, 4 * ks + (q >> 1)) + (q & 1) * 8), hi = LDS_RD(bf16x4, img + swz(row, 4 * ks + 2 + (q >> 1)) + (q & 1) * 8);
    return (bf16x8){lo[0], lo[1], lo[2], lo[3], hi[0], hi[1], hi[2], hi[3]};
}
DEV bf16x8 frag_tr(ldsp img, int n0, int ks, int lane, int stride = 256) {
    ldsp p = img + (32 * ks + 8 * (lane >> 4) + ((lane & 15) >> 2)) * stride + (n0 + 4 * (lane & 3)) * 2;
    const bf16x4 lo = lds_tr16(p), hi = lds_tr16(p + 4 * stride);
    return (bf16x8){lo[0], lo[1], lo[2], lo[3], hi[0], hi[1], hi[2], hi[3]};
}
DEV bf16x8 frag_trs(ldsp img, int n0, int ks, int lane) {
    const int row = 32 * ks + 8 * (lane >> 4) + ((lane & 15) >> 2), p = lane & 3, ch = (n0 >> 3) + (p >> 1);
    const bf16x4 lo = lds_tr16(img + swz(row, ch) + (p & 1) * 8), hi = lds_tr16(img + swz(row + 4, ch) + (p & 1) * 8);
    return (bf16x8){lo[0], lo[1], lo[2], lo[3], hi[0], hi[1], hi[2], hi[3]};
}
DEV void dma_lin(const void* src, int ninst, ldsp dst, int wave, int lane) {
    for (int i = wave; i < ninst; i += NWAVES) GLDS16X((const char*)src + i * 1024 + 16 * lane, dst + i * 1024);
}
DEV float sigm2(float x) { return frcp(1.0f + fexp2(-LOG2E * x)); }
DEV u32x2 pack4(const f32x4 v) { u32x2 w; w.x = cvt_pk_bf16(v[0], v[1]); w.y = cvt_pk_bf16(v[2], v[3]); return w; }

DEV float scan_add(float v, int lane) {
#pragma unroll
    for (int o = 1; o < 64; o <<= 1) { const float t = __shfl_up(v, o); if (lane >= o) v += t; }
    return v;
}
DEV float scan_max(float v, int lane) {
#pragma unroll
    for (int o = 1; o < 64; o <<= 1) { const float t = __shfl_up(v, o); if (lane >= o) v = fmaxf(v, t); }
    return v;
}

constexpr int PA_RAW = 0, PA_RAWSZ = 2 * 68 * 256, PA_TOT = 2 * PA_RAWSZ, PA_IQ = PA_TOT + 8 * 128 * 4, PA_IK = PA_IQ + 16384, PA_SC = PA_IK + 16384, PA_END = PA_SC + 1024;
static_assert(PA_END <= RING_BYTES, "P2 LDS");
DEV void p2_issue(const Args& args, int u, ldsp raw, int wave, int lane) {
    const bf16* P = (const bf16*)(args.ws + WS_P);
    if (u < NUA) { const int bh = u / NCH, j = u % NCH, b = bh / HA, h = bh % HA; const size_t tok0 = (size_t)b * SEQ + 64 * j;
        dma_lin(P + p_off(tok0, C_QA + h * 128), 16, raw, wave, lane); dma_lin(P + p_off(tok0, C_FA + h * 128), 16, raw + 68 * 256, wave, lane); }
    else { const int ub = u - NUA, bh = ub / NCH, j = ub % NCH, b = bh / HB, h = bh % HB; const size_t tok0 = (size_t)b * SEQ + 64 * j;
        dma_lin(P + p_off(tok0, C_QB + h * 128) - 3 * 128, 17, raw, wave, lane); dma_lin(P + p_off(tok0, C_KB + h * 128) - 3 * 128, 17, raw + 68 * 256, wave, lane); }
}
DEV void p2_scores(ldsp lds, f32x4 (&sc)[2], int wave, int lane) {
    const int ct = wave >> 1, st0 = 2 * (wave & 1);
    sc[0] = (f32x4){0.f, 0.f, 0.f, 0.f}; sc[1] = (f32x4){0.f, 0.f, 0.f, 0.f};
#pragma unroll
    for (int ks = 0; ks < 4; ++ks) { const bf16x8 qf = frag16s(lds + PA_IQ, 16 * ct, ks, lane);
#pragma unroll
        for (int n = 0; n < 2; ++n) { const bf16x8 kf_ = frag16s(lds + PA_IK, 16 * (st0 + n), ks, lane); sc[n] = MFMA16(kf_, qf, sc[n]); } }
}
DEV void p2_unit(const Args& args, ldsp lds, int u, ldsp raw, int wave, int lane) {
    unsigned char* TW = args.ws + WS_W1T;
    const int q4 = lane >> 4, l15 = lane & 15;
    if (u < NUA) {
        const int bh = u / NCH, h = bh % HA;
        const float* lbl = args.in[3];
        float lbv[2];
#pragma unroll
        for (int e = 0; e < 2; ++e) { const int col = h * 128 + 2 * lane + e; lbv[e] = frcp(1.0f + fexp(lbl[DA + col] - lbl[col])); }
        float lf[8][2], qv[8][2], kv[8][2];
#pragma unroll
        for (int c = 0; c < 8; ++c) { const unsigned qw = LDS_RD(unsigned, raw + (8 * wave + c) * 256 + lane * 4), fw = LDS_RD(unsigned, raw + 68 * 256 + (8 * wave + c) * 256 + lane * 4);
#pragma unroll
            for (int e = 0; e < 2; ++e) { const float f = lbv[e] + (1.0f - lbv[e]) * sigm2(__builtin_bit_cast(float, e ? (fw & 0xffff0000u) : (fw << 16))); lf[c][e] = flog2(f); kv[c][e] = 1.0f - f; qv[c][e] = __builtin_bit_cast(float, e ? (qw & 0xffff0000u) : (qw << 16)); } }
#pragma unroll
        for (int c = 1; c < 8; ++c) { lf[c][0] += lf[c - 1][0]; lf[c][1] += lf[c - 1][1]; }
        LDS_WR(f32x2, lds + PA_TOT + (wave * 128 + 2 * lane) * 4, ((f32x2){lf[7][0], lf[7][1]}));
        MIX_BAR();
        f32x2 off = (f32x2){0.f, 0.f}, bmid = (f32x2){0.f, 0.f}, g = (f32x2){0.f, 0.f};
#pragma unroll
        for (int w = 0; w < 8; ++w) { const f32x2 t = LDS_RD(f32x2, lds + PA_TOT + (w * 128 + 2 * lane) * 4); if (w < wave) off += t; if (w < 4) bmid += t; g += t; }
        if (wave == 0) { float* vec = (float*)(TW + TW_VA + (size_t)u * 2048) + 2 * lane;
            *(f32x2*)vec = (f32x2){fexp2(bmid[0]), fexp2(bmid[1])}; *(f32x2*)(vec + 128) = (f32x2){fexp2(g[0]), fexp2(g[1])}; *(f32x2*)(vec + 256) = (f32x2){fexp2(g[0] - bmid[0]), fexp2(g[1] - bmid[1])}; }
        unsigned qr8[8], kr8[8];
#pragma unroll
        for (int c = 0; c < 8; ++c) { float qr[2], kk[2]; const int r = 8 * wave + c;
#pragma unroll
            for (int e = 0; e < 2; ++e) { const float t1 = lf[c][e] + off[e] - bmid[e]; qr[e] = qv[c][e] * fexp2(t1); kk[e] = kv[c][e] * fexp2(-t1); }
            qr8[c] = cvt_pk_bf16(qr[0], qr[1]); kr8[c] = cvt_pk_bf16(kk[0], kk[1]);
            LDS_WR(unsigned, lds + PA_IQ + swz(r, lane >> 2) + (lane & 3) * 4, qr8[c]); LDS_WR(unsigned, lds + PA_IK + swz(r, lane >> 2) + (lane & 3) * 4, kr8[c]); }
        MIX_BAR();
        f32x4 sc[2]; p2_scores(lds, sc, wave, lane);
        unsigned char* tq = TW + TW_QA + (size_t)u * 16384; unsigned char* tk = TW + TW_KA + (size_t)u * 16384; unsigned char* tp = TW + TW_PA + (size_t)u * 8192;
#pragma unroll
        for (int c = 0; c < 8; ++c) { const int r = 8 * wave + c; *(unsigned*)(tq + swz(r, lane >> 2) + (lane & 3) * 4) = qr8[c]; *(unsigned*)(tk + swz(r, lane >> 2) + (lane & 3) * 4) = kr8[c]; }
#pragma unroll
        for (int n = 0; n < 2; ++n) { const int c = 16 * (wave >> 1) + l15, s0_ = 16 * (2 * (wave & 1) + n) + 4 * q4; f32x4 v = sc[n];
#pragma unroll
            for (int r = 0; r < 4; ++r) v[r] = (s0_ + r <= c) ? v[r] : 0.f;
            *(u32x2*)(tp + swz64(c, s0_ >> 3) + (q4 & 1) * 8) = pack4(v); }
    } else {
        const int ub = u - NUA, bh = ub / NCH, j = ub % NCH, b = bh / HB, h = bh % HB;
        const float* cw = args.in[4]; const float* cb = args.in[5];
        f32x2 wq[4], wk[4];
#pragma unroll
        for (int k = 0; k < 4; ++k) { wq[k] = *(const f32x2*)(cw + k * (2 * DQK) + h * 128 + 2 * lane); wk[k] = *(const f32x2*)(cw + k * (2 * DQK) + DQK + h * 128 + 2 * lane); }
        const f32x2 bq = *(const f32x2*)(cb + h * 128 + 2 * lane), bk = *(const f32x2*)(cb + DQK + h * 128 + 2 * lane);
        unsigned uq[11], uk[11];
#pragma unroll
        for (int i = 0; i < 11; ++i) { const bool neg = (64 * j + 8 * wave + i - 3) < 0;
            const unsigned a = LDS_RD(unsigned, raw + (8 * wave + i) * 256 + lane * 4), bb = LDS_RD(unsigned, raw + 68 * 256 + (8 * wave + i) * 256 + lane * 4); uq[i] = neg ? 0u : a; uk[i] = neg ? 0u : bb; }
        unsigned char* TWB = args.ws + WS_HB;
        float* sb = (float*)(TWB + TW_SB + (size_t)ub * 2048);
        if (wave == 0) {
            const size_t tok = (size_t)b * SEQ + 64 * j + lane; const float* SG = (const float*)(args.ws + WS_SG);
            const float fp = SG[tok * 16 + HB + h] + args.in[7][h], ig = SG[tok * 16 + h] + args.in[6][h];
            const float bc = scan_add(logsig(fp), lane), a = ig - bc, pm = scan_max(a, lane);
            sb[lane] = pm; sb[64 + lane] = bc;
            LDS_WR(float, lds + PA_SC + lane * 4, a * LOG2E); LDS_WR(float, lds + PA_SC + 256 + lane * 4, pm * LOG2E);
        }
        unsigned q8[8]; float kf[8][2];
#pragma unroll
        for (int c = 0; c < 8; ++c) { float qq[2]; const int r = 8 * wave + c;
#pragma unroll
            for (int e = 0; e < 2; ++e) { float yq = bq[e], yk = bk[e];
#pragma unroll
                for (int k = 0; k < 4; ++k) { yq += wq[k][e] * __builtin_bit_cast(float, e ? (uq[c + k] & 0xffff0000u) : (uq[c + k] << 16)); yk += wk[k][e] * __builtin_bit_cast(float, e ? (uk[c + k] & 0xffff0000u) : (uk[c + k] << 16)); }
                qq[e] = yq * sigm2(yq); kf[c][e] = yk * sigm2(yk) * 0.08838834764831845f; }
            q8[c] = cvt_pk_bf16(qq[0], qq[1]);
            LDS_WR(unsigned, lds + PA_IQ + swz(r, lane >> 2) + (lane & 3) * 4, q8[c]); LDS_WR(unsigned, lds + PA_IK + swz(r, lane >> 2) + (lane & 3) * 4, cvt_pk_bf16(kf[c][0], kf[c][1])); }
        MIX_BAR();
        const float pm63 = LDS_RD(float, lds + PA_SC + 256 + 63 * 4);
        unsigned kw8[8]; float na[2] = {0.f, 0.f};
#pragma unroll
        for (int c = 0; c < 8; ++c) { const float w_ = fexp2(LDS_RD(float, lds + PA_SC + (8 * wave + c) * 4) - pm63); const float k0 = w_ * kf[c][0], k1 = w_ * kf[c][1]; na[0] += k0; na[1] += k1; kw8[c] = cvt_pk_bf16(k0, k1); }
        LDS_WR(f32x2, lds + PA_TOT + (wave * 128 + 2 * lane) * 4, ((f32x2){na[0], na[1]}));
        f32x4 sc[2]; p2_scores(lds, sc, wave, lane);
        const int ct = wave >> 1, st0 = 2 * (wave & 1), c_ = 16 * ct + l15;
        const float pmc = LDS_RD(float, lds + PA_SC + 256 + c_ * 4); float rs = 0.f; u32x2 pw[2];
#pragma unroll
        for (int n = 0; n < 2; ++n) { const int s0_ = 16 * (st0 + n) + 4 * q4; const f32x4 as = LDS_RD(f32x4, lds + PA_SC + s0_ * 4); f32x4 v;
#pragma unroll
            for (int r = 0; r < 4; ++r) { const float t = fexp2(as[r] - pmc) * sc[n][r]; v[r] = (s0_ + r <= c_) ? t : 0.f; rs += v[r]; }
            pw[n] = pack4(v); }
        rs += __shfl_xor(rs, 16); rs += __shfl_xor(rs, 32);
        MIX_BAR();
        if (wave < 2) { const int dcol = wave * 64 + lane; float nl = 0.f;
#pragma unroll
            for (int w = 0; w < 8; ++w) nl += LDS_RD(float, lds + PA_TOT + (w * 128 + dcol) * 4);
            sb[256 + dcol] = nl; }
        if (q4 == 0) sb[128 + c_ * 2 + (wave & 1)] = rs;
        unsigned char* tq = TWB + TW_QB + (size_t)ub * 16384; unsigned char* tk = TWB + TW_KB + (size_t)ub * 16384; unsigned char* tp = TWB + TW_PB + (size_t)ub * 8192;
#pragma unroll
        for (int c = 0; c < 8; ++c) { const int r = 8 * wave + c; *(unsigned*)(tq + swz(r, lane >> 2) + (lane & 3) * 4) = q8[c]; *(unsigned*)(tk + swz(r, lane >> 2) + (lane & 3) * 4) = kw8[c]; }
#pragma unroll
        for (int n = 0; n < 2; ++n) { const int s0_ = 16 * (st0 + n) + 4 * q4; *(u32x2*)(tp + swz64(c_, s0_ >> 3) + (q4 & 1) * 8) = pw[n]; }
    }
}

constexpr int PB_BUFSZ = 51200, PB_Q = 0, PB_K = 16384, PB_V = 32768, PB_P = 40960, PB_VEC = 49152;
constexpr int PB_XS = 2 * PB_BUFSZ, PB_SM = PB_XS + 2 * 16384;
constexpr int SM_SSQ = PB_SM;
constexpr int SM_R = SM_SSQ + 2 * 64 * 4 * 4, SM_INT = SM_R + 256, SM_EMT = SM_INT + 256, SM_RS = SM_EMT + 256, SM_SCAL = SM_RS + 256;
constexpr int SM_NV = SM_SCAL + 64, SM_QN = SM_NV + 512, MX_END = SM_QN + 256;
static_assert(MX_END <= RING_BYTES, "mixer LDS");
DEV void dma_rows64(const void* src, ldsp dst, int wave, int lane) { GLDS16S((const char*)src + wave * 2048, (lane >> 3) * 256 + (lane & 7) * 16, dst + wave * 1024); }

DEV void mixer_a_job(const Args& args, ldsp lds, int b, int h, int vh, int tid_) {
    const int wave = RFL(tid_ >> 6), vt = wave & 3, hf = wave >> 2;
    const bf16* P = (const bf16*)(args.ws + WS_P);
    const unsigned char* TW = args.ws + WS_W1T;
    const rsrc_t RO = make_rsrc(args.ws + WS_OAB, (unsigned)((size_t)2 * M * LDU * 2));
    float* SSA = (float*)(args.ws + WS_SSA);
    const int u0 = (b * HA + h) * NCH, vcol = h * 128 + 64 * vh;
    f32x4 st[4], o[2];
#pragma unroll
    for (int t = 0; t < 4; ++t) st[t] = (f32x4){0.f, 0.f, 0.f, 0.f};
    o[0] = (f32x4){0.f, 0.f, 0.f, 0.f}; o[1] = (f32x4){0.f, 0.f, 0.f, 0.f};
    { const u32x4 z = (u32x4){0u, 0u, 0u, 0u}; const int lane = tid_ & 63;
        LDS_WR(u32x4, lds + PB_XS + 16384 + (vt * 2 + hf) * 2048 + lane * 16, z); LDS_WR(u32x4, lds + PB_XS + 16384 + (vt * 2 + hf) * 2048 + 1024 + lane * 16, z); }
#define MA_DMA(jj) do { ldsp bf_ = lds + ((jj) & 1) * PB_BUFSZ; const size_t uu_ = (size_t)(u0 + (jj)); \
        dma_lin(TW + TW_QA + uu_ * 16384, 16, bf_ + PB_Q, wave, lane); dma_lin(TW + TW_KA + uu_ * 16384, 16, bf_ + PB_K, wave, lane); \
        dma_rows64(P + p_off((size_t)b * SEQ + 64 * (jj), C_IA + h * 128) + 64 * vh, bf_ + PB_V, wave, lane); dma_lin(TW + TW_PA + uu_ * 8192, 8, bf_ + PB_P, wave, lane); dma_lin(TW + TW_VA + uu_ * 2048, 2, bf_ + PB_VEC, wave, lane); } while (0)
    { const int lane = tid_ & 63; MA_DMA(0); }
    for (int j = 0; j <= NCH; ++j) {
        int tidj = tid_; OPAQUE(tidj);
        const int lane = tidj & 63, q4 = lane >> 4, l15 = lane & 15;
        const size_t tk0 = (size_t)b * SEQ + 64 * j;
        if (j <= 1) WAIT_V(0); else WAIT_V(2);
        MIX_BAR();
        if (j + 1 < NCH) MA_DMA(j + 1);
        if (j > 0) {
            if (wave == 0) { const f32x4 s0 = LDS_RD(f32x4, lds + SM_SSQ + ((j - 1) & 1) * 1024 + lane * 16); SSA[((tk0 - 64 + lane) * HA + h) * 2 + vh] = (s0[0] + s0[1]) + (s0[2] + s0[3]); }
#pragma unroll
            for (int i = 0; i < 2; ++i) bstore64(RO, (unsigned)(l15 * LDU + vcol + 16 * vt + 4 * q4) * 2u, (unsigned)(tk0 - 64 + 16 * (2 * hf + i)) * (unsigned)(LDU * 2), pack4(o[i]));
        }
        if (j == NCH) break;
        ldsp bf = lds + (j & 1) * PB_BUFSZ;
        bf16x8 bv[2], pf[2][2], qo[2][2], qp[2][2], so[2], sp[2];
#pragma unroll
        for (int ks = 0; ks < 2; ++ks) bv[ks] = frag_tr(bf + PB_V, 16 * vt, ks, lane, 128);
#pragma unroll
        for (int ks = 0; ks < 2; ++ks)
#pragma unroll
            for (int i = 0; i < 2; ++i) pf[ks][i] = frag16p(bf + PB_P, 16 * (2 * hf + i), ks, lane);
#pragma unroll
        for (int kl = 0; kl < 2; ++kl)
#pragma unroll
            for (int i = 0; i < 2; ++i) { qo[kl][i] = frag8x2s(bf + PB_Q, 16 * (2 * hf + i), 2 * hf + kl, lane); qp[kl][i] = frag8x2s(bf + PB_Q, 16 * (2 * hf + i), 2 * (hf ^ 1) + kl, lane); }
        u32x4 xp[2];
#pragma unroll
        for (int kl = 0; kl < 2; ++kl) xp[kl] = LDS_RD(u32x4, lds + PB_XS + ((j + 1) & 1) * 16384 + (vt * 2 + (hf ^ 1)) * 2048 + kl * 1024 + lane * 16);
        f32x4 eo[4], ep[4];
#pragma unroll
        for (int t = 0; t < 4; ++t) { eo[t] = LDS_RD(f32x4, bf + PB_VEC + (16 * (4 * hf + t) + 4 * q4) * 4); ep[t] = LDS_RD(f32x4, bf + PB_VEC + (16 * (4 * (hf ^ 1) + t) + 4 * q4) * 4); }
        SCHED_BAR();
#pragma unroll
        for (int kl = 0; kl < 2; ++kl) {
            { u32x4 w; const f32x4 a0 = st[2 * kl] * eo[2 * kl], a1 = st[2 * kl + 1] * eo[2 * kl + 1]; w.x = cvt_pk_bf16(a0[0], a0[1]); w.y = cvt_pk_bf16(a0[2], a0[3]); w.z = cvt_pk_bf16(a1[0], a1[1]); w.w = cvt_pk_bf16(a1[2], a1[3]);
              so[kl] = __builtin_bit_cast(bf16x8, w); }
            { u32x4 w; const f32x4 e0 = ep[2 * kl], e1 = ep[2 * kl + 1]; const u32x4 x = xp[kl];
              w.x = cvt_pk_bf16(__builtin_bit_cast(float, x.x << 16) * e0[0], __builtin_bit_cast(float, x.x & 0xffff0000u) * e0[1]); w.y = cvt_pk_bf16(__builtin_bit_cast(float, x.y << 16) * e0[2], __builtin_bit_cast(float, x.y & 0xffff0000u) * e0[3]);
              w.z = cvt_pk_bf16(__builtin_bit_cast(float, x.z << 16) * e1[0], __builtin_bit_cast(float, x.z & 0xffff0000u) * e1[1]); w.w = cvt_pk_bf16(__builtin_bit_cast(float, x.w << 16) * e1[2], __builtin_bit_cast(float, x.w & 0xffff0000u) * e1[3]);
              sp[kl] = __builtin_bit_cast(bf16x8, w); } }
        o[0] = (f32x4){0.f, 0.f, 0.f, 0.f}; o[1] = (f32x4){0.f, 0.f, 0.f, 0.f};
#pragma unroll
        for (int ks = 0; ks < 2; ++ks)
#pragma unroll
            for (int i = 0; i < 2; ++i) o[i] = MFMA16(bv[ks], pf[ks][i], o[i]);
#pragma unroll
        for (int kl = 0; kl < 2; ++kl)
#pragma unroll
            for (int i = 0; i < 2; ++i) { o[i] = MFMA16(so[kl], qo[kl][i], o[i]); o[i] = MFMA16(sp[kl], qp[kl][i], o[i]); }
#pragma unroll
        for (int i = 0; i < 4; ++i) { const int t = 4 * hf + i;
            f32x4 u = (f32x4){0.f, 0.f, 0.f, 0.f};
#pragma unroll
            for (int ks = 0; ks < 2; ++ks) { const bf16x8 a = frag_trs(bf + PB_K, 16 * t, ks, lane); u = MFMA16(a, bv[ks], u); }
            const f32x4 eg = LDS_RD(f32x4, bf + PB_VEC + 512 + (16 * t + 4 * q4) * 4), egm = LDS_RD(f32x4, bf + PB_VEC + 1024 + (16 * t + 4 * q4) * 4); st[i] = eg * st[i] + egm * u; }
#pragma unroll
        for (int kl = 0; kl < 2; ++kl) { u32x4 w; const f32x4 a0 = st[2 * kl], a1 = st[2 * kl + 1]; w.x = cvt_pk_bf16(a0[0], a0[1]); w.y = cvt_pk_bf16(a0[2], a0[3]); w.z = cvt_pk_bf16(a1[0], a1[1]); w.w = cvt_pk_bf16(a1[2], a1[3]);
            LDS_WR(u32x4, lds + PB_XS + (j & 1) * 16384 + (vt * 2 + hf) * 2048 + kl * 1024 + lane * 16, w); }
#pragma unroll
        for (int i = 0; i < 2; ++i) { float s_ = (o[i][0] * o[i][0] + o[i][1] * o[i][1]) + (o[i][2] * o[i][2] + o[i][3] * o[i][3]); s_ += __shfl_xor(s_, 16); s_ += __shfl_xor(s_, 32);
            LDS_WR(float, lds + SM_SSQ + (j & 1) * 1024 + ((16 * (2 * hf + i) + l15) * 4 + vt) * 4, s_); }
    }
#undef MA_DMA
}

DEV void mixer_b_job(const Args& args, ldsp lds, int b, int h, int vq, int tid_) {
    const int wave = RFL(tid_ >> 6), vt = wave & 3, hf = wave >> 2;
    const int vbase = h * 256 + 64 * vq;
    const bf16* P = (const bf16*)(args.ws + WS_P);
    const unsigned char* TW = args.ws + WS_HB;
    const rsrc_t RO = make_rsrc(args.ws + WS_OAB, (unsigned)((size_t)2 * M * LDU * 2));
    float* SSB = (float*)(args.ws + WS_SSB);
    const int u0 = (b * HB + h) * NCH;
    f32x4 st[4], hv[2];
#pragma unroll
    for (int t = 0; t < 4; ++t) st[t] = (f32x4){0.f, 0.f, 0.f, 0.f};
    hv[0] = (f32x4){0.f, 0.f, 0.f, 0.f}; hv[1] = (f32x4){0.f, 0.f, 0.f, 0.f};
    float mcar = 0.f;
    if (wave < 2) LDS_WR(float, lds + SM_NV + tid_ * 4, 0.f);
    { const u32x4 z = (u32x4){0u, 0u, 0u, 0u}; const int lane = tid_ & 63;
        LDS_WR(u32x4, lds + PB_XS + 16384 + (vt * 2 + hf) * 2048 + lane * 16, z); LDS_WR(u32x4, lds + PB_XS + 16384 + (vt * 2 + hf) * 2048 + 1024 + lane * 16, z); }
#define MB_DMA(jj) do { ldsp bf_ = lds + ((jj) & 1) * PB_BUFSZ; const size_t uu_ = (size_t)(u0 + (jj)); \
        dma_lin(TW + TW_QB + uu_ * 16384, 16, bf_ + PB_Q, wave, lane); dma_lin(TW + TW_KB + uu_ * 16384, 16, bf_ + PB_K, wave, lane); \
        dma_rows64(P + p_off((size_t)b * SEQ + 64 * (jj), C_VB + h * 256 + 128 * (vq >> 1)) + 64 * (vq & 1), bf_ + PB_V, wave, lane); dma_lin(TW + TW_PB + uu_ * 8192, 8, bf_ + PB_P, wave, lane); dma_lin(TW + TW_SB + uu_ * 2048, 2, bf_ + PB_VEC, wave, lane); } while (0)
    { const int lane = tid_ & 63; MB_DMA(0); }
    for (int j = 0; j <= NCH; ++j) {
        const size_t tk0 = (size_t)b * SEQ + 64 * j;
        int tidj = tid_; OPAQUE(tidj);
        const int tid = tidj, lane = tidj & 63, q4 = lane >> 4, l15 = lane & 15;
        if (j <= 1) WAIT_V(0); else WAIT_V(2);
        MIX_BAR();
        if (j + 1 < NCH) MB_DMA(j + 1);
        if (j > 0) {
            if (wave == 0) { const f32x4 s0 = LDS_RD(f32x4, lds + SM_SSQ + ((j - 1) & 1) * 1024 + lane * 16); SSB[((tk0 - 64 + lane) * HB + h) * 4 + vq] = (s0[0] + s0[1]) + (s0[2] + s0[3]); }
#pragma unroll
            for (int i = 0; i < 2; ++i) bstore64(RO, (unsigned)(l15 * LDU + vbase + 16 * vt + 4 * q4) * 2u, (unsigned)(M + tk0 - 64 + 16 * (2 * hf + i)) * (unsigned)(LDU * 2), pack4(hv[i]));
        }
        if (j == NCH) break;
        ldsp bf = lds + (j & 1) * PB_BUFSZ;
        if (wave == 0) {
            const float pm = LDS_RD(float, bf + PB_VEC + lane * 4), bc = LDS_RD(float, bf + PB_VEC + 256 + lane * 4); const f32x2 rsl = LDS_RD(f32x2, bf + PB_VEC + 512 + lane * 8);
            const float mx = fmaxf(mcar, pm), r = fexp(pm - mx);
            const float pm63 = __shfl(pm, 63), bc63 = __shfl(bc, 63), m63 = fmaxf(mcar, pm63);
            LDS_WR(float, lds + SM_R + lane * 4, r); LDS_WR(float, lds + SM_INT + lane * 4, fexp(mcar - mx)); LDS_WR(float, lds + SM_EMT + lane * 4, fexp(-(bc + mx))); LDS_WR(float, lds + SM_RS + lane * 4, r * (rsl[0] + rsl[1]));
            if (lane == 0) { LDS_WR(float, lds + SM_SCAL, fexp(mcar - m63)); LDS_WR(float, lds + SM_SCAL + 4, bc63 + m63); LDS_WR(float, lds + SM_SCAL + 8, fexp(pm63 - m63)); }
        }
        {
            const int c = tid >> 3, part = tid & 7; float s = 0.f;
#pragma unroll
            for (int hh = 0; hh < 2; ++hh) { const u32x4 qw = LDS_RD(u32x4, bf + PB_Q + swz(c, 2 * part + hh));
#pragma unroll
                for (int e = 0; e < 4; ++e) { const f32x2 nv = LDS_RD(f32x2, lds + SM_NV + (16 * part + 8 * hh + 2 * e) * 4); s += __builtin_bit_cast(float, qw[e] << 16) * nv[0] + __builtin_bit_cast(float, qw[e] & 0xffff0000u) * nv[1]; } }
            s += __shfl_xor(s, 1); s += __shfl_xor(s, 2); s += __shfl_xor(s, 4);
            LDS_WR(float, lds + SM_QN + c * 4, s);
        }
        MIX_BAR();
        const float decay = LDS_RD(float, lds + SM_SCAL), sj = LDS_RD(float, lds + SM_SCAL + 8);
        mcar = LDS_RD(float, lds + SM_SCAL + 4);
        {
            bf16x8 bv[2], pf[2][2], qo[2][2], qp[2][2], so[2], sp[2];
#pragma unroll
            for (int ks = 0; ks < 2; ++ks) bv[ks] = frag_tr(bf + PB_V, 16 * vt, ks, lane, 128);
#pragma unroll
            for (int ks = 0; ks < 2; ++ks)
#pragma unroll
                for (int i = 0; i < 2; ++i) pf[ks][i] = frag16p(bf + PB_P, 16 * (2 * hf + i), ks, lane);
#pragma unroll
            for (int kl = 0; kl < 2; ++kl)
#pragma unroll
                for (int i = 0; i < 2; ++i) { qo[kl][i] = frag8x2s(bf + PB_Q, 16 * (2 * hf + i), 2 * hf + kl, lane); qp[kl][i] = frag8x2s(bf + PB_Q, 16 * (2 * hf + i), 2 * (hf ^ 1) + kl, lane); }
#pragma unroll
            for (int kl = 0; kl < 2; ++kl) sp[kl] = LDS_RD(bf16x8, lds + PB_XS + ((j + 1) & 1) * 16384 + (vt * 2 + (hf ^ 1)) * 2048 + kl * 1024 + lane * 16);
            float s_int[2], s_r[2], s_qn[2], s_rs[2], s_emt[2];
#pragma unroll
            for (int i = 0; i < 2; ++i) { const int c = 16 * (2 * hf + i) + l15; s_int[i] = LDS_RD(float, lds + SM_INT + c * 4); s_r[i] = LDS_RD(float, lds + SM_R + c * 4); s_qn[i] = LDS_RD(float, lds + SM_QN + c * 4); s_rs[i] = LDS_RD(float, lds + SM_RS + c * 4); s_emt[i] = LDS_RD(float, lds + SM_EMT + c * 4); }
            SCHED_BAR();
#pragma unroll
            for (int kl = 0; kl < 2; ++kl) { u32x4 w; const f32x4 a0 = st[2 * kl], a1 = st[2 * kl + 1]; w.x = cvt_pk_bf16(a0[0], a0[1]); w.y = cvt_pk_bf16(a0[2], a0[3]); w.z = cvt_pk_bf16(a1[0], a1[1]); w.w = cvt_pk_bf16(a1[2], a1[3]); so[kl] = __builtin_bit_cast(bf16x8, w); }
#pragma unroll
            for (int i = 0; i < 2; ++i) {
                f32x4 a1 = (f32x4){0.f, 0.f, 0.f, 0.f}, a2 = (f32x4){0.f, 0.f, 0.f, 0.f};
#pragma unroll
                for (int ks = 0; ks < 2; ++ks) a2 = MFMA16(bv[ks], pf[ks][i], a2);
#pragma unroll
                for (int kl = 0; kl < 2; ++kl) { a1 = MFMA16(so[kl], qo[kl][i], a1); a1 = MFMA16(sp[kl], qp[kl][i], a1); }
                const float den = s_int[i] * s_qn[i] + s_rs[i];
                const float rden = frcp(fmaxf(fabsf(den), s_emt[i]));
                hv[i] = (s_int[i] * a1 + s_r[i] * a2) * rden;
            }
#pragma unroll
            for (int i = 0; i < 4; ++i) { const int t = 4 * hf + i;
                f32x4 u = (f32x4){0.f, 0.f, 0.f, 0.f};
#pragma unroll
                for (int ks = 0; ks < 2; ++ks) { const bf16x8 a = frag_trs(bf + PB_K, 16 * t, ks, lane); u = MFMA16(a, bv[ks], u); }
                st[i] = decay * st[i] + sj * u;
            }
#pragma unroll
            for (int kl = 0; kl < 2; ++kl) { u32x4 w; const f32x4 a0 = st[2 * kl], a1 = st[2 * kl + 1]; w.x = cvt_pk_bf16(a0[0], a0[1]); w.y = cvt_pk_bf16(a0[2], a0[3]); w.z = cvt_pk_bf16(a1[0], a1[1]); w.w = cvt_pk_bf16(a1[2], a1[3]);
                LDS_WR(u32x4, lds + PB_XS + (j & 1) * 16384 + (vt * 2 + hf) * 2048 + kl * 1024 + lane * 16, w); }
            if (wave < 2) LDS_WR(float, lds + SM_NV + tid * 4, decay * LDS_RD(float, lds + SM_NV + tid * 4) + sj * LDS_RD(float, bf + PB_VEC + 1024 + tid * 4));
#pragma unroll
            for (int i = 0; i < 2; ++i) { float s_ = (hv[i][0] * hv[i][0] + hv[i][1] * hv[i][1]) + (hv[i][2] * hv[i][2] + hv[i][3] * hv[i][3]); s_ += __shfl_xor(s_, 16); s_ += __shfl_xor(s_, 32);
                LDS_WR(float, lds + SM_SSQ + (j & 1) * 1024 + ((16 * (2 * hf + i) + l15) * 4 + vt) * 4, s_); }
        }
    }
#undef MB_DMA
}

constexpr int P0_RB1 = (NP + NSG + 63) / 64, P0_I1 = (D / 64) * P0_RB1, P0_IU = (DA / 64) * (D / 64), P0_IO = (D / 64) * (D / 64), P0_NITEMS = P0_I1 + 2 * P0_IU + P0_IO;
DEV P0Desc p0_decode(const Args& args, int it) {
    unsigned char* ws = args.ws; bf16* W1T = (bf16*)(ws + WS_W1T); bf16* WUT = (bf16*)(ws + WS_WUT); bf16* WOT = (bf16*)(ws + WS_WOT);
    P0Desc d; int r = it;
    if (r < P0_I1) { const int kb = r / P0_RB1, rb = r % P0_RB1, r0 = 64 * rb; d.W = args.in[2]; d.ldw = D_IN; d.K = D; d.k0 = 64 * kb;
        if (r0 >= NPM && r0 < NP) { d.WT = ws + WS_W8; d.c0 = r0 + NSG; d.r0 = r0 - NPM; d.nv = 64; d.fp8 = 1; return d; }
        d.WT = W1T; d.fp8 = 0; d.r0 = r0;
        if (r0 >= C_OGA && r0 < C_OGA + DA) { d.fp8 = 2; d.WT8 = ws + WS_W8OG; d.r08 = r0 - C_OGA; }
        if (r0 >= C_OGB && r0 < C_OGB + DB) { d.fp8 = 2; d.WT8 = ws + WS_W8OG; d.r08 = DA + (r0 - C_OGB); }
        if (r0 < NPM) { d.c0 = r0; d.nv = 64; } else { d.c0 = NPM + (r0 - NP); d.nv = NSG - (r0 - NP) < 64 ? NSG - (r0 - NP) : 64; }
        return d; }
    r -= P0_I1; d.fp8 = 0; d.ldw = D; d.nv = 64;
    if (r < P0_IU) { const int kb = r / (D / 64), rb = r % (D / 64); d.W = args.in[10]; d.K = LDU; d.WT = WUT; d.k0 = 64 * kb; d.c0 = 64 * rb; d.r0 = 64 * rb; return d; }
    r -= P0_IU;
    if (r < P0_IU) { const int kb = r / (D / 64), rb = r % (D / 64); d.W = args.in[11]; d.K = LDU; d.WT = WUT + (size_t)D * LDU; d.k0 = 64 * kb; d.c0 = 64 * rb; d.r0 = 64 * rb; return d; }
    r -= P0_IU;
    { const int kb = r / (D / 64), rb = r % (D / 64); d.W = args.in[12]; d.K = D; d.WT = WOT; d.k0 = 64 * kb; d.c0 = 64 * rb; d.r0 = 64 * rb; return d; }
}
DEV void p0_items(const Args& args, int first, int last, int stride, ldsp scr, int lane) {
    if (first >= last) return;
    P0Desc d = p0_decode(args, first); f32x4 v[16]; p0_load(d, lane, v);
    for (int it = first; it < last; it += stride) {
        const int nx = it + stride; P0Desc dn = d; f32x4 vn[16];
        if (nx < last) { dn = p0_decode(args, nx); p0_load(dn, lane, vn); }
        p0_store(d, v, scr, lane);
        if (nx < last) { d = dn;
#pragma unroll
            for (int i = 0; i < 16; ++i) v[i] = vn[i]; }
    }
}

__global__ void __launch_bounds__(NTHREADS, 2) fwd_kernel(Args args) {
#ifndef EMU
    extern __shared__ __attribute__((aligned(16))) unsigned char lds_raw[];
    ldsp lds = (ldsp)lds_raw;
#else
    ldsp lds = emu_lds;
#endif
    const int tid = threadIdx.x, lane = tid & 63, wave = RFL(tid >> 6);
    const int G = gridDim.x, bx = blockIdx.x;
    const int vcu = (G % 8 == 0) ? (bx % 8) * (G / 8) + bx / 8 : bx;
    unsigned char* ws = args.ws;
#ifndef EMU
    for (int u = tid; u < (LDS_BYTES - LDSCTL_OFF) / 4; u += NTHREADS) ((LAS unsigned*)(lds + LDSCTL_OFF))[u] = 0u;
    __syncthreads();
    XcdBarrier bar = xcd_barrier_post((unsigned*)(ws + WS_CTL) + CW_BAR, (volatile LAS unsigned*)(lds + MISC_OFF) + 8);
#define GRID_BAR() xcd_barrier(bar)
#else
#define GRID_BAR()
#endif
    const int lo = args.ph_lo, hi = args.ph_hi;
#ifndef GEMM_SP2
#define GEMM_SP2 true
#endif
#ifndef GEMM_ALIGN
#define GEMM_ALIGN true
#endif
#ifndef PROBE_REP_P4
#define PROBE_REP_P4 1
#endif
#ifndef PROBE_REP_P5
#define PROBE_REP_P5 1
#endif
#ifndef PROBE_REP_P1
#define PROBE_REP_P1 2
#endif
#ifndef PROBE_REP_P2
#define PROBE_REP_P2 1
#endif
#ifndef PHASE_MASK
#define PHASE_MASK 255
#endif
#define IN(k) (((PHASE_MASK >> (k)) & 1) && lo <= (k) && (k) < hi)
#define BOTH(k) (IN(k) && IN((k) + 1))
    const float* x = args.in[0];
    bf16* W1T = (bf16*)(ws + WS_W1T); bf16* WUT = (bf16*)(ws + WS_WUT); bf16* WOT = (bf16*)(ws + WS_WOT);
    bf16* HBUF = (bf16*)(ws + WS_HB); bf16* PB = (bf16*)(ws + WS_P); float* SG = (float*)(ws + WS_SG); bf16* OAB = (bf16*)(ws + WS_OAB); float* RSS = (float*)(ws + WS_RSS);

    if (IN(0)) {
        ldsp scr = lds + wave * 17408;
        const int gw = vcu * NWAVES + wave, NGW = G * NWAVES;
        constexpr int I_1 = P0_I1, NITEMS = P0_NITEMS;
        static_assert(NPM % 64 == 0 && NP % 64 == 0 && NSG % 4 == 0, "P0 item tiling");
        constexpr int NJOBS3 = NB * HA * 2 + NB * HB * 4;
        const int nit0 = (G > NJOBS3) ? I_1 : NITEMS;
        p0_items(args, gw, nit0, NGW, scr, lane);
        const float* gpre = args.in[1];
        for (int m = gw; m < M; m += NGW) {
            const f32x4* xr = (const f32x4*)(x + (size_t)m * D) + lane;
            f32x4 v[D / 256]; float s = 0.f;
#pragma unroll
            for (int jj = 0; jj < D / 256; ++jj) { v[jj] = xr[64 * jj]; s += (v[jj][0] * v[jj][0] + v[jj][1] * v[jj][1]) + (v[jj][2] * v[jj][2] + v[jj][3] * v[jj][3]); }
            const float rstd = frsq(wave_sum(s) * (1.0f / D) + EPS) ;
            u32x2* o8 = (u32x2*)(HBUF + (size_t)m * D) + lane; unsigned* o4 = (unsigned*)(ws + WS_H8 + (size_t)m * D) + lane;
#pragma unroll
            for (int jj = 0; jj < D / 256; ++jj) { const f32x4 gg = ((const f32x4*)gpre)[lane + 64 * jj]; const f32x4 hh = v[jj] * rstd * gg; u32x2 w; w.x = pk2(hh[0], hh[1]); w.y = pk2(hh[2], hh[3]); o8[64 * jj] = w;
                o4[64 * jj] = pk_fp8x4(clamp8(hh[0] * H8_SCALE), clamp8(hh[1] * H8_SCALE), clamp8(hh[2] * H8_SCALE), clamp8(hh[3] * H8_SCALE)); }
        }
        if (BOTH(0)) GRID_BAR();
    }

    if (IN(1)) {
        {
            const int gw = vcu * NWAVES + wave, NGW = G * NWAVES, l15 = lane & 15, q4 = lane >> 4;
            const int wrow = NP + (l15 < NSG ? l15 : NSG - 1);
            for (int t = gw; t < M / 16; t += NGW) {
                f32x4 acc = (f32x4){0.f, 0.f, 0.f, 0.f};
                const bf16* ap = HBUF + (size_t)(16 * t + l15) * D + 8 * q4; const bf16* bp = W1T + (size_t)wrow * D + 8 * q4;
                for (int k0 = 0; k0 < D / 32; k0 += 16) {
                    bf16x8 af[16], bfr[16];
#pragma unroll
                    for (int i = 0; i < 16; ++i) { af[i] = *(const bf16x8*)(ap + 32 * (k0 + i)); bfr[i] = *(const bf16x8*)(bp + 32 * (k0 + i)); }
#pragma unroll
                    for (int i = 0; i < 16; ++i) acc = MFMA16(af[i], bfr[i], acc);
                }
#pragma unroll
                for (int r = 0; r < 4; ++r) SG[(size_t)(16 * t + 4 * q4 + r) * 16 + l15] = acc[r];
            }
        }
        { pg8::Gemm g{HBUF, W1T, M, NPM, D}; SchedSkipOg S; S.so.init(M, NPM - DA - DB, G, bx);
          EpiP E{PB};
          pg8::gemm_phase<EpiP, SchedSkipOg, GEMM_ALIGN, GEMM_SP2>(lds, g, S, E); }
        { pg8::Gemm g8{(const bf16*)(ws + WS_H8), (const bf16*)(ws + WS_W8OG), M, DA + DB, D}; pg8::StaticOrder S8; S8.init(M, DA + DB, G, bx);
          EpiOg E8{PB};
          pg8::gemm_phase<EpiOg, pg8::StaticOrder, GEMM_ALIGN, GEMM_SP2, 1>(lds, g8, S8, E8); }
        if (BOTH(1)) GRID_BAR();
    }

    if (IN(2)) {
        int buf = 0;
        if (bx < NUA + NUB) p2_issue(args, bx, lds + PA_RAW, wave, lane);
        for (int u = bx, it = 0; u < NUA + NUB; u += G, ++it) {
            int tidj = tid; OPAQUE(tidj); const int lane_ = tidj & 63;
            if (it == 0) WAIT_V(0); else WAIT_V(18);
            MIX_BAR();
            if (u + G < NUA + NUB) p2_issue(args, u + G, lds + PA_RAW + (buf ^ 1) * PA_RAWSZ, wave, lane_);
            p2_unit(args, lds, u, lds + PA_RAW + buf * PA_RAWSZ, wave, lane_);
            buf ^= 1;
        }
        if (BOTH(2)) GRID_BAR();
    }

    if (IN(3)) {
        constexpr int NJA = NB * HA * 2, NJB = NB * HB * 4;
        if (G > NJA + NJB && bx >= NJA + NJB) {
            ldsp scr = lds + wave * 17408;
            p0_items(args, P0_I1 + (bx - (NJA + NJB)) * NWAVES + wave, P0_NITEMS, (G - (NJA + NJB)) * NWAVES, scr, lane);
        }
        for (int job = bx; job < NJA + NJB; job += G) {
            if (job < NJA) mixer_a_job(args, lds, job / (2 * HA), (job >> 1) % HA, job & 1, tid);
            else { const int jb = job - NJA; mixer_b_job(args, lds, jb / (4 * HB), (jb >> 2) % HB, jb & 3, tid); }
            BLOCK_BAR();
        }
        if (BOTH(3)) GRID_BAR();
    }

    if (IN(4)) {
        const int gw = vcu * NWAVES + wave, NGW = G * NWAVES;
        const float* SSA = (const float*)(ws + WS_SSA); const float* SSB = (const float*)(ws + WS_SSB);
        static_assert(DA % 512 == 0 && DA == DB, "P3 tiling");
        for (int m = gw; m < M; m += NGW) {
#pragma unroll
            for (int br = 0; br < 2; ++br) {
#pragma unroll
                for (int i = 0; i < DA / 512; ++i) {
                    const int col0 = i * 512 + lane * 8;
                    float rstd;
                    if (br == 0) { const int hh = col0 / 128; rstd = frsq((SSA[((size_t)m * HA + hh) * 2] + SSA[((size_t)m * HA + hh) * 2 + 1]) * (1.0f / 128.0f) + EPS); }
                    else { const int hh = col0 / 256; const f32x4 q_ = *(const f32x4*)(SSB + ((size_t)m * HB + hh) * 4); rstd = frsq(((q_[0] + q_[1]) + (q_[2] + q_[3])) * (1.0f / 256.0f) + EPS); }
                    u32x4* po = (u32x4*)(OAB + (size_t)(br * M + m) * LDU + col0);
                    u32x4 w = *po; const u32x4 g8 = *(const u32x4*)(PB + p_off((size_t)m, (br ? C_OGB : C_OGA) + col0)), z8 = *(const u32x4*)(PB + p_off((size_t)m, (br ? C_ZB : C_ZA) + col0));
                    const f32x4 gn0 = *(const f32x4*)(args.in[br ? 9 : 8] + col0), gn1 = *(const f32x4*)(args.in[br ? 9 : 8] + col0 + 4);
#pragma unroll
                    for (int e = 0; e < 4; ++e) { float v[2];
#pragma unroll
                        for (int k = 0; k < 2; ++k) { const float ov = __builtin_bit_cast(float, k ? (w[e] & 0xffff0000u) : (w[e] << 16)), og = __builtin_bit_cast(float, k ? (g8[e] & 0xffff0000u) : (g8[e] << 16)), z = __builtin_bit_cast(float, k ? (z8[e] & 0xffff0000u) : (z8[e] << 16));
                            const float gnv = (e < 2 ? gn0 : gn1)[(2 * e + k) & 3];
                            v[k] = ov * rstd * gnv * sigm2(og) * (z * sigm2(z)); }
                        w[e] = cvt_pk_bf16(v[0], v[1]); }
                    *po = w;
                }
            }
        }
        if (BOTH(4)) GRID_BAR();
    }
    if (IN(5)) {
        { pg8::Gemm g8{(const bf16*)(ws + WS_H8), (const bf16*)(ws + WS_W8), M, 2 * D, D, 0, 0, 0, (size_t)D * D}; SchedGate S8; S8.so.init(M, D, G, bx);
          EpiP8 E8{PB};
          pg8::gemm_phase<EpiP8, SchedGate, GEMM_ALIGN, GEMM_SP2, 1>(lds, g8, S8, E8); }
        BLOCK_BAR();
        pg8::Gemm g{OAB, WUT, M, D, 2 * DA, LDU, (size_t)M * LDU * 2, (size_t)D * LDU * 2}; SchedRev S; S.init(M, D, G, bx);
        EpiUp2 E{HBUF, make_rsrc(PB, P_BYTES)};
        for (int rep = 0; rep < PROBE_REP_P4; ++rep) pg8::gemm_phase<EpiUp2, SchedRev, GEMM_ALIGN, GEMM_SP2, 2, true>(lds, g, S, E);
        if (BOTH(5)) GRID_BAR();
    }

    if (IN(6)) {
        pg8::Gemm g{HBUF, WOT, M, D, D}; pg8::StaticOrder S; S.init(M, D, G, bx);
        EpiOut E{PB, RSS};
        for (int rep = 0; rep < PROBE_REP_P5; ++rep) pg8::gemm_phase<EpiOut, pg8::StaticOrder, GEMM_ALIGN, GEMM_SP2>(lds, g, S, E);
        if (BOTH(6)) GRID_BAR();
    }

    if (IN(7)) {
        const int gw = vcu * NWAVES + wave, NGW = G * NWAVES;
        const float* gpost = args.in[13];
        for (int m = gw; m < M; m += NGW) {
            const float ss = wave_sum(lane < NRS ? RSS[(size_t)m * NRS + lane] : 0.f);
            const float rstd = frsq(ss * (1.0f / D) + EPS);
            const f32x4* xr = (const f32x4*)(x + (size_t)m * D) + lane; f32x4* orow = (f32x4*)(args.out + (size_t)m * D) + lane; const u32x2* ob = (const u32x2*)(PB + (size_t)m * D) + lane;
#pragma unroll
            for (int jj = 0; jj < D / 256; ++jj) { const f32x4 xv = xr[64 * jj], gg = ((const f32x4*)gpost)[lane + 64 * jj]; const u32x2 w = ob[64 * jj];
                const f32x4 ov = (f32x4){__builtin_bit_cast(float, w.x << 16), __builtin_bit_cast(float, w.x & 0xffff0000u), __builtin_bit_cast(float, w.y << 16), __builtin_bit_cast(float, w.y & 0xffff0000u)};
                orow[64 * jj] = xv + ov * rstd * gg; }
        }
    }
#undef IN
#undef BOTH
}

#ifndef EMU
extern "C" void kernel_launch(void* const* d_in, const int* in_sizes, int n_in, void* d_out, int out_size, void* d_ws, size_t ws_size, hipStream_t stream) {
    static int grid = 0;
    if (grid == 0) {
        if (n_in != 14 || out_size != M * D || ws_size < WS_END) { fprintf(stderr, "kernel_launch: unexpected shapes (n_in %d, out %d, ws %zu < %zu)\n", n_in, out_size, ws_size, (size_t)WS_END); grid = -1; return; }
        int dev = 0, cus = 0, per_cu = 0;
        if (hipGetDevice(&dev) != hipSuccess || hipDeviceGetAttribute(&cus, hipDeviceAttributeMultiprocessorCount, dev) != hipSuccess) { grid = -1; return; }
        if (hipFuncSetAttribute((const void*)fwd_kernel, hipFuncAttributeMaxDynamicSharedMemorySize, LDS_BYTES) != hipSuccess) { fprintf(stderr, "kernel_launch: hipFuncSetAttribute failed\n"); grid = -1; return; }
        if (hipOccupancyMaxActiveBlocksPerMultiprocessor(&per_cu, (const void*)fwd_kernel, NTHREADS, LDS_BYTES) != hipSuccess || per_cu < 1) { fprintf(stderr, "kernel_launch: occupancy query says %d\n", per_cu); }
        (void)hipGetLastError();
        grid = cus;
    }
    if (grid < 0) return;
    (void)hipMemsetAsync((char*)d_ws + WS_CTL, 0, CTL_ZERO_BYTES, stream);
    Args a{};
    for (int i = 0; i < 14; ++i) a.in[i] = (const float*)d_in[i];
    a.out = (float*)d_out; a.ws = (unsigned char*)d_ws; a.ph_lo = 0; a.ph_hi = 8;
    hipLaunchKernelGGL(fwd_kernel, dim3(grid), dim3(NTHREADS), LDS_BYTES, stream, a);
}
#endif
```
